# Optimizing an MI355X kernel written in HIP

```python
import math
import jax, jax.numpy as jnp
from jax import lax
import numpy as np

D_MODEL = 1024
BATCH = 1
SEQ = 16384
DEPTH = 1

EPS = 1e-6
SSM_WIDTH = 512
SSM_GROUP = 16
SSM_GROUPS = SSM_WIDTH // SSM_GROUP
SSM_STATE = 64
DT_MIN = 1e-3
DT_MAX = 1e-1
NSA_HEADS = 8
NSA_KV_HEADS = 2
GQA_RATIO = NSA_HEADS // NSA_KV_HEADS
HEAD_DIM = 64
NSA_WIDTH = NSA_HEADS * HEAD_DIM
KV_WIDTH = NSA_KV_HEADS * HEAD_DIM
CMP_LEN = 32
CMP_STRIDE = 16
CMP_HIDDEN = 256
SLC_LEN = 64
N_SEL = 16
N_LOCAL = 2
WINDOW = 512
Q_BLOCK = 128
BIG = 1e4
REL_BUCKETS = 32
REL_MAX_DIST = 128
D_FF = -(-8 * D_MODEL // (3 * 256)) * 256

IN_SIZES = [SSM_WIDTH, NSA_WIDTH] + [KV_WIDTH] * 6 + [3 * NSA_HEADS, 2 * D_MODEL]
IN_COLS = sum(IN_SIZES)
IN_SPLITS = [int(v) for v in np.cumsum(IN_SIZES)[:-1]]

kernel_name = "hybrid_s5_nsa_gated_block"


def rmsnorm(x, g):
    x32 = x.astype(jnp.float32)
    y = x32 * lax.rsqrt(jnp.mean(x32 * x32, axis=-1, keepdims=True) + EPS)
    return (y * g.astype(jnp.float32)).astype(x.dtype)


def masked_softmax(logits, mask):
    l = jnp.where(mask, logits.astype(jnp.float32), -1e30)
    m = jnp.max(l, axis=-1, keepdims=True)
    p = jnp.exp(l - m) * mask
    return p / jnp.maximum(jnp.sum(p, axis=-1, keepdims=True), 1e-30)


def t5_bucket(dist):
    n = jnp.maximum(dist, 0)
    max_exact = REL_BUCKETS // 2
    nf = jnp.maximum(n, 1).astype(jnp.float32)
    large = max_exact + (jnp.log(nf / max_exact) / math.log(REL_MAX_DIST / max_exact)
                         * (REL_BUCKETS - max_exact)).astype(jnp.int32)
    large = jnp.minimum(large, REL_BUCKETS - 1)
    return jnp.where(n < max_exact, n, large)


def head_bias(rel_bias, dist):
    b = rel_bias.astype(jnp.float32)[t5_bucket(dist)]
    b = b.reshape(dist.shape + (NSA_KV_HEADS, GQA_RATIO))
    return jnp.transpose(b, (2, 3, 0, 1))


def s5_mixer(u, a_re, a_im, log_dt, b_re, b_im, c_re, c_im, d, w_glu):
    bsz, s, _ = u.shape
    f32 = jnp.float32
    lam = lax.complex(a_re.astype(f32), a_im.astype(f32))
    dt = jnp.exp(log_dt.astype(f32))[:, None]
    lam_bar = jnp.exp(lam * dt)
    b = lax.complex(b_re.astype(f32), b_im.astype(f32))
    b_bar = ((lam_bar - 1.0) / lam)[..., None] * b
    c = lax.complex(c_re.astype(f32), c_im.astype(f32))
    ug = u.astype(f32).reshape(bsz, s, SSM_GROUPS, SSM_GROUP)
    bu = jnp.einsum("bsgc,gpc->bsgp", ug.astype(jnp.complex64), b_bar)
    a = jnp.broadcast_to(lam_bar, bu.shape)

    def combine(e1, e2):
        a1, x1 = e1
        a2, x2 = e2
        return a1 * a2, a2 * x1 + x2

    _, states = lax.associative_scan(combine, (a, bu), axis=1)
    y = jnp.einsum("bsgp,gcp->bsgc", states, c).real \
        + d.astype(f32).reshape(SSM_GROUPS, SSM_GROUP) * ug
    y = y.reshape(bsz, s, SSM_WIDTH).astype(u.dtype)
    z = jax.nn.gelu(y)
    return z * jax.nn.sigmoid(z @ w_glu)


def compress(k, pos, w1, w2):
    bsz, s = k.shape[0], k.shape[1]
    n_cmp = (s - CMP_LEN) // CMP_STRIDE + 1
    idx = np.arange(n_cmp)[:, None] * CMP_STRIDE + np.arange(CMP_LEN)[None, :]
    blocks = k[:, idx] + pos[None, None, :, None, :]
    blocks = jnp.transpose(blocks, (0, 1, 3, 2, 4)).reshape(bsz, n_cmp, NSA_KV_HEADS, CMP_LEN * HEAD_DIM)
    return jax.nn.gelu(blocks @ w1) @ w2


def nsa_mixer(q, kc, vc, ks, vs, kw, vw, gates, rel_bias):
    bsz, s = q.shape[0], q.shape[1]
    n_cmp = kc.shape[1]
    n_slc = s // SLC_LEN
    n_sel = min(N_SEL, n_slc)
    n_qblk = s // Q_BLOCK
    cmp_end = jnp.asarray(np.arange(n_cmp) * CMP_STRIDE + CMP_LEN - 1, dtype=jnp.int32)
    ratio = SLC_LEN // CMP_STRIDE
    front = CMP_LEN // CMP_STRIDE - 1
    w_ov = [float(v) for v in np.convolve(np.ones(ratio), np.ones(CMP_LEN // CMP_STRIDE))]
    back = ratio * n_slc + len(w_ov) - 1 - front - n_cmp
    ks_t = jnp.transpose(ks.reshape(bsz, n_slc, SLC_LEN, NSA_KV_HEADS, HEAD_DIM), (0, 3, 1, 2, 4))
    vs_t = jnp.transpose(vs.reshape(bsz, n_slc, SLC_LEN, NSA_KV_HEADS, HEAD_DIM), (0, 3, 1, 2, 4))
    pad_w = ((0, 0), (WINDOW, 0), (0, 0), (0, 0))
    kw_pad = jnp.pad(kw, pad_w)
    vw_pad = jnp.pad(vw, pad_w)
    tab_t = rel_bias.astype(jnp.float32).T.reshape(NSA_KV_HEADS, GQA_RATIO, REL_BUCKETS)
    bi = jnp.arange(bsz).reshape(bsz, 1, 1, 1)
    gi = jnp.arange(NSA_KV_HEADS).reshape(1, NSA_KV_HEADS, 1, 1)
    gi6 = jnp.arange(NSA_KV_HEADS).reshape(1, NSA_KV_HEADS, 1, 1, 1, 1)
    ri6 = jnp.arange(GQA_RATIO).reshape(1, 1, GQA_RATIO, 1, 1, 1)
    blk = jnp.arange(n_slc)

    def block(i):
        s0 = i * Q_BLOCK
        t = s0 + jnp.arange(Q_BLOCK)
        qb = lax.dynamic_slice_in_dim(q, s0, Q_BLOCK, axis=1)
        gb = lax.dynamic_slice_in_dim(gates, s0, Q_BLOCK, axis=1)
        dist_c = t[:, None] - cmp_end[None, :]
        logit_c = jnp.einsum("bqgrd,bngd->bgrqn", qb, kc) + head_bias(rel_bias, dist_c)
        p_c = masked_softmax(logit_c, dist_c >= 0)
        o_c = jnp.einsum("bgrqn,bngd->bqgrd", p_c.astype(vc.dtype), vc)
        imp = jnp.pad(p_c.sum(axis=2), ((0, 0), (0, 0), (0, 0), (front, back)))
        p_slc = sum(w_ov[o] * imp[..., o:o + ratio * n_slc:ratio] for o in range(len(w_ov)))
        cur = t // SLC_LEN
        valid = blk[None, :] <= cur[:, None]
        forced = valid & ((blk[None, :] == 0) | (blk[None, :] >= cur[:, None] - (N_LOCAL - 1)))
        score = jnp.where(forced, BIG, jnp.where(valid, p_slc, -BIG))
        _, sel = lax.top_k(score, n_sel)
        ks_g = ks_t[bi, gi, sel]
        vs_g = vs_t[bi, gi, sel]
        pos_s = sel[..., None] * SLC_LEN + jnp.arange(SLC_LEN)
        dist_s = t[None, None, :, None, None] - pos_s
        bias_s = tab_t[gi6, ri6, t5_bucket(dist_s)[:, :, None]]
        logit_s = jnp.einsum("bqgrd,bgqksd->bgrqks", qb, ks_g) + bias_s
        kflat = n_sel * SLC_LEN
        p_s = masked_softmax(logit_s.reshape(bsz, NSA_KV_HEADS, GQA_RATIO, Q_BLOCK, kflat),
                             (dist_s >= 0).reshape(bsz, NSA_KV_HEADS, 1, Q_BLOCK, kflat))
        o_s = jnp.einsum("bgrqk,bgqkd->bqgrd", p_s.astype(vs.dtype),
                         vs_g.reshape(bsz, NSA_KV_HEADS, Q_BLOCK, kflat, HEAD_DIM))
        kwb = lax.dynamic_slice_in_dim(kw_pad, s0, WINDOW + Q_BLOCK, axis=1)
        vwb = lax.dynamic_slice_in_dim(vw_pad, s0, WINDOW + Q_BLOCK, axis=1)
        pos_w = s0 - WINDOW + jnp.arange(WINDOW + Q_BLOCK)
        dist_w = t[:, None] - pos_w[None, :]
        mask_w = (dist_w >= 0) & (dist_w < WINDOW) & (pos_w[None, :] >= 0)
        logit_w = jnp.einsum("bqgrd,bkgd->bgrqk", qb, kwb) + head_bias(rel_bias, dist_w)
        p_w = masked_softmax(logit_w, mask_w)
        o_w = jnp.einsum("bgrqk,bkgd->bqgrd", p_w.astype(vw.dtype), vwb)
        o = gb[..., 0:1] * o_c + gb[..., 1:2] * o_s + gb[..., 2:3] * o_w
        return o.reshape(bsz, Q_BLOCK, NSA_WIDTH)

    out = lax.map(block, jnp.arange(n_qblk))
    return jnp.transpose(out, (1, 0, 2, 3)).reshape(bsz, s, NSA_WIDTH)


def setup_inputs(seed: int = 0) -> dict:
    key = jax.random.key(seed)
    ks = jax.random.split(key, 32)
    nrm = lambda k, shape, scale: jax.random.normal(k, shape, jnp.float32) * scale
    L = DEPTH
    n_idx = jnp.arange(SSM_STATE, dtype=jnp.float32)
    return {
        "x": nrm(ks[0], (BATCH, SEQ, D_MODEL), 1.0),
        "norm_mix_g": 1.0 + nrm(ks[1], (L, D_MODEL), 0.01),
        "w_in": nrm(ks[2], (L, D_MODEL, IN_COLS), D_MODEL ** -0.5),
        "ssm_a_re": -0.5 + nrm(ks[3], (L, SSM_GROUPS, SSM_STATE), 0.01),
        "ssm_a_im": math.pi * n_idx + nrm(ks[4], (L, SSM_GROUPS, SSM_STATE), 0.01),
        "ssm_log_dt": jax.random.uniform(ks[5], (L, SSM_GROUPS), jnp.float32,
                                         math.log(DT_MIN), math.log(DT_MAX)),
        "ssm_b_re": nrm(ks[6], (L, SSM_GROUPS, SSM_STATE, SSM_GROUP), (2 * SSM_GROUP) ** -0.5),
        "ssm_b_im": nrm(ks[7], (L, SSM_GROUPS, SSM_STATE, SSM_GROUP), (2 * SSM_GROUP) ** -0.5),
        "ssm_c_re": nrm(ks[8], (L, SSM_GROUPS, SSM_GROUP, SSM_STATE), SSM_STATE ** -0.5),
        "ssm_c_im": nrm(ks[9], (L, SSM_GROUPS, SSM_GROUP, SSM_STATE), SSM_STATE ** -0.5),
        "ssm_d": nrm(ks[10], (L, SSM_WIDTH), 1.0),
        "ssm_w_glu": nrm(ks[11], (L, SSM_WIDTH, SSM_WIDTH), SSM_WIDTH ** -0.5),
        "w_up_ssm": nrm(ks[12], (L, SSM_WIDTH, D_MODEL), SSM_WIDTH ** -0.5),
        "cmp_pos_k": nrm(ks[13], (L, CMP_LEN, HEAD_DIM), 0.1),
        "cmp_pos_v": nrm(ks[14], (L, CMP_LEN, HEAD_DIM), 0.1),
        "cmp_w1_k": nrm(ks[15], (L, CMP_LEN * HEAD_DIM, CMP_HIDDEN), (CMP_LEN * HEAD_DIM) ** -0.5),
        "cmp_w2_k": nrm(ks[16], (L, CMP_HIDDEN, HEAD_DIM), CMP_HIDDEN ** -0.5),
        "cmp_w1_v": nrm(ks[17], (L, CMP_LEN * HEAD_DIM, CMP_HIDDEN), (CMP_LEN * HEAD_DIM) ** -0.5),
        "cmp_w2_v": nrm(ks[18], (L, CMP_HIDDEN, HEAD_DIM), CMP_HIDDEN ** -0.5),
        "rel_bias": nrm(ks[19], (REL_BUCKETS, NSA_HEADS), 0.5),
        "w_up_nsa": nrm(ks[20], (L, NSA_WIDTH, D_MODEL), NSA_WIDTH ** -0.5),
        "w_out": nrm(ks[21], (L, D_MODEL, D_MODEL), D_MODEL ** -0.5),
        "norm_ffn_g": 1.0 + nrm(ks[22], (L, D_MODEL), 0.01),
        "w_ffn_gate": nrm(ks[23], (L, D_MODEL, D_FF), D_MODEL ** -0.5),
        "w_ffn_up": nrm(ks[24], (L, D_MODEL, D_FF), D_MODEL ** -0.5),
        "w_ffn_down": nrm(ks[25], (L, D_FF, D_MODEL), D_FF ** -0.5),
        "norm_final_g": 1.0 + nrm(ks[26], (D_MODEL,), 0.01),
    }


def reference(x, norm_mix_g, w_in, ssm_a_re, ssm_a_im, ssm_log_dt, ssm_b_re, ssm_b_im,
              ssm_c_re, ssm_c_im, ssm_d, ssm_w_glu, w_up_ssm, cmp_pos_k, cmp_pos_v,
              cmp_w1_k, cmp_w2_k, cmp_w1_v, cmp_w2_v, rel_bias, w_up_nsa, w_out,
              norm_ffn_g, w_ffn_gate, w_ffn_up, w_ffn_down, norm_final_g):
    bsz, s, _ = x.shape
    kv_shape = (bsz, s, NSA_KV_HEADS, HEAD_DIM)
    for l in range(DEPTH):
        h = rmsnorm(x, norm_mix_g[l])
        proj = h @ w_in[l]
        u, q, kc_r, vc_r, ks_r, vs_r, kw_r, vw_r, g_nsa, g_br = jnp.split(proj, IN_SPLITS, axis=-1)
        y_a = s5_mixer(u, ssm_a_re[l], ssm_a_im[l], ssm_log_dt[l], ssm_b_re[l], ssm_b_im[l],
                       ssm_c_re[l], ssm_c_im[l], ssm_d[l], ssm_w_glu[l]) @ w_up_ssm[l]
        qh = q.reshape(bsz, s, NSA_KV_HEADS, GQA_RATIO, HEAD_DIM) * (HEAD_DIM ** -0.5)
        kc = compress(kc_r.reshape(kv_shape), cmp_pos_k[l], cmp_w1_k[l], cmp_w2_k[l])
        vc = compress(vc_r.reshape(kv_shape), cmp_pos_v[l], cmp_w1_v[l], cmp_w2_v[l])
        gates = jax.nn.sigmoid(g_nsa).reshape(bsz, s, NSA_KV_HEADS, GQA_RATIO, 3)
        y_b = nsa_mixer(qh, kc, vc, ks_r.reshape(kv_shape), vs_r.reshape(kv_shape),
                        kw_r.reshape(kv_shape), vw_r.reshape(kv_shape), gates, rel_bias) @ w_up_nsa[l]
        g_a, g_b = jnp.split(jax.nn.sigmoid(g_br), 2, axis=-1)
        x = x + (g_a * y_a + g_b * y_b) @ w_out[l]
        h = rmsnorm(x, norm_ffn_g[l])
        x = x + (jax.nn.silu(h @ w_ffn_gate[l]) * (h @ w_ffn_up[l])) @ w_ffn_down[l]
    return rmsnorm(x, norm_final_g)
```

```cpp
#include <hip/hip_runtime.h>
#include <hip/hip_cooperative_groups.h>
#include <cstdio>
#include <cstdint>
namespace cg = cooperative_groups;

#ifndef MK_N_LAUNCHES
#define MK_N_LAUNCHES 12
#endif

namespace pg8 {
#define PG8_LAS __attribute__((address_space(3)))
typedef unsigned short bf16_t;
typedef short bf16x8 __attribute__((ext_vector_type(8)));
typedef float f32x4 __attribute__((ext_vector_type(4)));
typedef unsigned u32x4 __attribute__((ext_vector_type(4)));
constexpr int BM = 256, BK = 64, HALF = 128, HTB = HALF * BK * 2, STAGE_BYTES = 8 * HTB, NXCD = 8, WGM = 8;

__host__ __device__ __forceinline__ int lds_byte(int r, int c) { const int st = (r >> 4) * 2 + (c >> 5), rr = r & 15, cc = c & 31, ob = rr * 64 + cc * 2; return st * 1024 + (ob ^ (((ob >> 9) & 1) << 5)); }
__host__ __device__ __forceinline__ void stage_rc(int b, int& R, int& C) { const int st = b / 1024, sb = b % 1024, swz = sb ^ (((sb >> 9) & 1) << 5); R = (st >> 1) * 16 + swz / 64; C = (st & 1) * 32 + (swz % 64) / 2; }
__host__ __device__ __forceinline__ int perm32(int rho) { const int n = rho >> 4, i = rho & 15; return 8 * (i >> 2) + 4 * n + (i & 3); }

struct Unit { int pm, pn, ks; };
struct Gemm { const bf16_t* A; const bf16_t* Bt; int M, N, K, ld; };

struct StaticOrder {
    static constexpr bool SINGLE = false;
    int nM, nN, nwg, G, c;
    __host__ __device__ void init(int M, int N, int G_, int c_) { nM = M / BM; nN = N / BM; nwg = nM * nN; G = G_; c = c_; }
    __host__ __device__ bool next(int i, Unit& u) const {
        const long L = (long)i * G + c; if (L >= nwg) return false;
        int wgid = (int)L; { const int q = nwg / NXCD, r = nwg % NXCD, xcd = wgid % NXCD, off = wgid / NXCD; wgid = (xcd < r ? xcd * (q + 1) : r * (q + 1) + (xcd - r) * q) + off; }
        const int nig = WGM * nN, gid = wgid / nig, fm = gid * WGM, gsz = (nM - fm) < WGM ? (nM - fm) : WGM;
        u.pm = fm + ((wgid % nig) % gsz); u.pn = (wgid % nig) / gsz; u.ks = 0; return true;
    }
};
struct CmpOrder {
    static constexpr bool SINGLE = true;
    int G, c, KS;
    __host__ __device__ bool next(int i, Unit& u) const {
        const int L = i * G + c; if (L >= 32 * KS) return false;
        const int tile = L / KS; u.ks = L % KS; u.pm = tile >> 1; u.pn = (tile & 1) + (u.pm >= 8 ? 2 : 0); return true;
    }
};

__device__ __forceinline__ unsigned cvt_pk_bf16(float lo, float hi) { unsigned r; asm volatile("v_cvt_pk_bf16_f32 %0, %1, %2" : "=v"(r) : "v"(lo), "v"(hi)); return r; }
__device__ __forceinline__ float bflo(unsigned w) { return __uint_as_float(w << 16); }
__device__ __forceinline__ float bfhi(unsigned w) { return __uint_as_float(w & 0xffff0000u); }
__device__ __forceinline__ float sigm(float x) { return __builtin_amdgcn_rcpf(1.0f + __expf(-x)); }

template <class Epi, class Sched>
__device__ __forceinline__ void gemm_phase(PG8_LAS unsigned char* lds, const Gemm g, const Sched& S, const Epi& E) {
    const int tid = threadIdx.x, wid = __builtin_amdgcn_readfirstlane(tid >> 6), lane = tid & 63, wr = wid >> 2, wc = wid & 3, fr = lane & 15, fq = lane >> 4;
    const int K = g.K, ld = g.ld, nt = K / BK;
    unsigned voffA[2], voffB[2];
#pragma unroll
    for (int i = 0; i < 2; ++i) { int R, C; stage_rc(tid * 16 + i * 8192, R, C); const int Rb = Epi::PERM ? ((R & ~31) + perm32(R & 31)) : R;
        voffA[i] = (unsigned)(R * ld + C) * 2u; voffB[i] = (unsigned)(Rb * ld + C) * 2u; }
    const size_t kstep = (size_t)(BK * 2);
    const size_t hstep = (size_t)HALF * ld * 2;
    const size_t tstep = 2 * hstep;
    const unsigned ldsw = (unsigned)wid * 1024u;
    const int aoff = lds_byte(wr * 64 + fr, fq * 8), boff = lds_byte(wc * 32 + fr, fq * 8);
#define PG8_SA(b, h) (((b) * 2 + (h)) * HTB)
#define PG8_SB(b, h) ((4 + (b) * 2 + (h)) * HTB)
#define PG8_STAGE(bufoff, gbase, voff) do { _Pragma("unroll") for (int _i = 0; _i < 2; ++_i) \
        __builtin_amdgcn_global_load_lds((const unsigned*)((const char*)(gbase) + (voff)[_i]), (PG8_LAS unsigned*)(lds + (bufoff) + ldsw + _i * 8192), 16, 0, 0); } while (0)
#define PG8_LDA(dst, b, h) do { _Pragma("unroll") for (int m = 0; m < 4; ++m) _Pragma("unroll") for (int k = 0; k < 2; ++k) dst[m][k] = *(const PG8_LAS bf16x8*)(lds + PG8_SA(b, h) + aoff + m * 2048 + k * 1024); } while (0)
#define PG8_LDB(dst, b, h) do { _Pragma("unroll") for (int n = 0; n < 2; ++n) _Pragma("unroll") for (int k = 0; k < 2; ++k) dst[n][k] = *(const PG8_LAS bf16x8*)(lds + PG8_SB(b, h) + boff + n * 2048 + k * 1024); } while (0)
#define PG8_MMA(ai, bj, At, Bt) do { __builtin_amdgcn_s_setprio(1); _Pragma("unroll") for (int m = 0; m < 4; ++m) _Pragma("unroll") for (int n = 0; n < 2; ++n) _Pragma("unroll") for (int k = 0; k < 2; ++k) \
        acc[ai][bj][m][n] = __builtin_amdgcn_mfma_f32_16x16x32_bf16(Bt[n][k], At[m][k], acc[ai][bj][m][n], 0, 0, 0); __builtin_amdgcn_s_setprio(0); } while (0)
#define PG8_WAIT_V(n) asm volatile("s_waitcnt vmcnt(" #n ")" ::: "memory")
#define PG8_WAIT_L(n) asm volatile("s_waitcnt lgkmcnt(" #n ")" ::: "memory")
#define PG8_BAR __builtin_amdgcn_s_barrier()
#define PG8_SCHED __builtin_amdgcn_sched_barrier(0)
    Unit cur, nxt; int ui = 0;
    if (!S.next(0, cur)) return;
    f32x4 acc[2][2][4][2];
#pragma unroll
    for (int a = 0; a < 2; ++a)
#pragma unroll
        for (int b = 0; b < 2; ++b)
#pragma unroll
            for (int m = 0; m < 4; ++m)
#pragma unroll
                for (int n = 0; n < 2; ++n) acc[a][b][m][n] = (f32x4){0.f, 0.f, 0.f, 0.f};
    bf16x8 At[4][2], B0[2][2], B1[2][2];
    const char* cA = (const char*)g.A + (size_t)cur.pm * tstep + (size_t)cur.ks * K * 2; const char* cB = (const char*)g.Bt + (size_t)cur.pn * tstep + (size_t)cur.ks * K * 2;
    PG8_STAGE(PG8_SB(0, 0), cB, voffB); PG8_STAGE(PG8_SB(0, 1), cB + hstep, voffB); PG8_STAGE(PG8_SA(0, 0), cA, voffA); PG8_STAGE(PG8_SA(0, 1), cA + hstep, voffA);
    if (wr == 1) PG8_BAR;
    PG8_WAIT_V(2); PG8_BAR;
    PG8_STAGE(PG8_SB(1, 0), cB + kstep, voffB); PG8_STAGE(PG8_SA(1, 0), cA + kstep, voffA); PG8_STAGE(PG8_SB(1, 1), cB + hstep + kstep, voffB);
    PG8_WAIT_V(6); PG8_BAR;
    for (;;) {
        const bool has_next = Sched::SINGLE ? false : S.next(ui + 1, nxt);
        const char* nA = has_next ? (const char*)g.A + (size_t)nxt.pm * tstep + (size_t)nxt.ks * K * 2 : cA; const char* nB = has_next ? (const char*)g.Bt + (size_t)nxt.pn * tstep + (size_t)nxt.ks * K * 2 : cB;
        for (int t = 0; t < nt; t += 2) {
            const bool last = (t == nt - 2);
            const char* a1 = cA + (size_t)(t + 1) * kstep;
            const char* a2 = last ? nA : cA + (size_t)(t + 2) * kstep; const char* b2 = last ? nB : cB + (size_t)(t + 2) * kstep;
            const char* a3 = a2 + kstep; const char* b3 = b2 + kstep;
            PG8_LDB(B0, 0, 0); PG8_LDB(B1, 0, 1); PG8_SCHED; PG8_LDA(At, 0, 0); PG8_STAGE(PG8_SA(1, 1), a1 + hstep, voffA);
            PG8_WAIT_V(8); PG8_WAIT_L(0); PG8_BAR; PG8_MMA(0, 0, At, B0); PG8_MMA(0, 1, At, B1); PG8_BAR; PG8_SCHED;
            PG8_LDA(At, 0, 1); PG8_STAGE(PG8_SB(0, 0), b2, voffB); PG8_STAGE(PG8_SB(0, 1), b2 + hstep, voffB); PG8_STAGE(PG8_SA(0, 0), a2, voffA);
            PG8_WAIT_V(8); PG8_WAIT_L(0); PG8_BAR; PG8_MMA(1, 0, At, B0); PG8_MMA(1, 1, At, B1); PG8_BAR; PG8_SCHED;
            PG8_LDB(B0, 1, 0); PG8_LDB(B1, 1, 1); PG8_SCHED; PG8_LDA(At, 1, 0); PG8_STAGE(PG8_SA(0, 1), a2 + hstep, voffA);
            PG8_WAIT_V(8); PG8_WAIT_L(0); PG8_BAR; PG8_MMA(0, 0, At, B0); PG8_MMA(0, 1, At, B1); PG8_BAR; PG8_SCHED;
            PG8_LDA(At, 1, 1); PG8_STAGE(PG8_SB(1, 0), b3, voffB); PG8_STAGE(PG8_SB(1, 1), b3 + hstep, voffB); PG8_STAGE(PG8_SA(1, 0), a3, voffA);
            PG8_WAIT_V(8); PG8_WAIT_L(0); PG8_BAR; PG8_MMA(1, 0, At, B0); PG8_MMA(1, 1, At, B1); PG8_BAR; PG8_SCHED;
        }
        if (wr == 0) PG8_BAR;
        E(acc, cur, wr, wc, fr, fq);
        if (!has_next) break;
#pragma unroll
        for (int a = 0; a < 2; ++a)
#pragma unroll
            for (int b = 0; b < 2; ++b)
#pragma unroll
                for (int m = 0; m < 4; ++m)
#pragma unroll
                    for (int n = 0; n < 2; ++n) acc[a][b][m][n] = (f32x4){0.f, 0.f, 0.f, 0.f};
        cur = nxt; cA = nA; cB = nB; ++ui;
        if (wr == 1) PG8_BAR;
    }
    PG8_WAIT_V(0);
    PG8_BAR;
#undef PG8_SA
#undef PG8_SB
#undef PG8_STAGE
#undef PG8_LDA
#undef PG8_LDB
#undef PG8_MMA
#undef PG8_WAIT_V
#undef PG8_WAIT_L
#undef PG8_BAR
#undef PG8_SCHED
}
}

constexpr int S = 16384, DM = 1024, INC = 3864, NPJ = 4096, SSW = 512, NSW = 512, HD = 64, DFF = 2816;
constexpr int NGRP = 32, NST = 64, NCMP = 1023;
constexpr int NWAVES = 8;
constexpr int NPH = 12;
constexpr int CMP_KS = 4;
constexpr float EPS = 1e-6f;

constexpr size_t MiB = 1u << 20;
constexpr size_t WS_CTL = 0;
constexpr size_t WS_TAB = 1 * MiB;
constexpr size_t TAB_BF = 0, TAB_CF = 128 * 1024, TAB_LAM = 256 * 1024, TAB_LAM256 = 272 * 1024, TAB_POSB = 288 * 1024;
constexpr size_t WS_F = 2 * MiB;
constexpr size_t WS_KVC = 3 * MiB;
constexpr size_t WS_WIN = 4 * MiB, WS_WGU = 12 * MiB, WS_WD = 23 * MiB, WS_WOUT = 29 * MiB, WS_WA = 31 * MiB, WS_WB = 32 * MiB, WS_WGLU = 33 * MiB, WS_WC1 = 34 * MiB;
constexpr size_t WS_XN = 36 * MiB;
constexpr size_t WS_Z = WS_XN, WS_ZG = WS_XN + 16 * MiB;
constexpr size_t WS_U = 68 * MiB, WS_O = WS_U;
constexpr size_t WS_Q = 84 * MiB;
constexpr size_t WS_KVH = 100 * MiB;
constexpr size_t WS_G = 124 * MiB;
constexpr size_t WS_GN = 188 * MiB;
constexpr size_t WS_MIX = 84 * MiB;
constexpr size_t WS_H = 100 * MiB;
constexpr size_t WS_END = 189 * MiB;

constexpr int LDS_BYTES = 147456;

#define GAS __attribute__((address_space(1)))
#define LAS __attribute__((address_space(3)))
typedef unsigned short bf16;
typedef unsigned v4u __attribute__((ext_vector_type(4)));
typedef float f32x4 __attribute__((ext_vector_type(4)));
typedef float f32x2 __attribute__((ext_vector_type(2)));
typedef float f32x16 __attribute__((ext_vector_type(16)));
typedef short bf16x8 __attribute__((ext_vector_type(8)));
#define LDS_WAIT() asm volatile("s_waitcnt lgkmcnt(0)" ::: "memory")
#define VM_WAIT() asm volatile("s_waitcnt vmcnt(0)" ::: "memory")
__device__ __forceinline__ unsigned f2bf(float f) { unsigned u = __builtin_bit_cast(unsigned, f); return (u + 0x7fffu + ((u >> 16) & 1u)) >> 16; }
__device__ __forceinline__ unsigned pk2(float lo, float hi) { return f2bf(lo) | (f2bf(hi) << 16); }
__device__ __forceinline__ float bf2f(bf16 v) { return __uint_as_float((unsigned)v << 16); }
using pg8::bflo; using pg8::bfhi; using pg8::sigm; using pg8::cvt_pk_bf16;
__device__ __forceinline__ float gelu_tanh(float y) {
    const float a = 0.7978845608028654f * (y + 0.044715f * y * y * y);
    const float e = __expf(2.0f * a);
    const float th = 1.0f - 2.0f * __builtin_amdgcn_rcpf(e + 1.0f);
    return 0.5f * y * (1.0f + th);
}
__device__ __forceinline__ float wave_sum(float v) {
#pragma unroll
    for (int o = 1; o < 64; o <<= 1) v += __shfl_xor(v, o);
    return v;
}
__device__ __forceinline__ float wave_max(float v) {
#pragma unroll
    for (int o = 1; o < 64; o <<= 1) v = fmaxf(v, __shfl_xor(v, o));
    return v;
}

struct Args { const float* in[27]; float* out; unsigned char* ws; int ph_lo, ph_hi; };

struct Frame {
    LAS unsigned char* lds;
    int tid, lane, wave, G, gw, ngw;
    float* out; unsigned char* ws;
};

using pg8::Unit; using pg8::BM; using pg8::HALF;
struct EpiProj {
    static constexpr bool PERM = true;
    bf16 *U, *Q, *KVH, *Gt, *GN;
    __device__ __forceinline__ void operator()(const f32x4 (&acc)[2][2][4][2], const Unit& u, int wr, int wc, int fr, int fq) const {
        const int row0 = u.pm * BM + wr * 64 + fr, pn = u.pn;
#pragma unroll
        for (int ai = 0; ai < 2; ++ai)
#pragma unroll
            for (int m = 0; m < 4; ++m) { const int row = row0 + ai * HALF + m * 16;
#pragma unroll
                for (int bj = 0; bj < 2; ++bj) { f32x4 v0 = acc[ai][bj][m][0], v1 = acc[ai][bj][m][1]; const int col = bj * HALF + wc * 32 + 8 * fq; bf16* dst;
                    if (pn < 2) dst = U + (size_t)row * 512 + pn * 256 + col;
                    else if (pn < 4) { v0 = v0 * 0.125f; v1 = v1 * 0.125f; dst = Q + (size_t)row * 512 + (pn - 2) * 256 + col; }
                    else if (pn < 7) dst = KVH + ((size_t)((pn - 4) * 4 + (col >> 6)) * S + row) * 64 + (col & 63);
                    else { v0 = (f32x4){sigm(v0[0]), sigm(v0[1]), sigm(v0[2]), sigm(v0[3])}; v1 = (f32x4){sigm(v1[0]), sigm(v1[1]), sigm(v1[2]), sigm(v1[3])};
                        if (pn < 15) dst = Gt + (size_t)row * 2048 + (pn - 7) * 256 + col; else { if (col >= 32) continue; dst = GN + (size_t)row * 32 + col; } }
                    v4u w; w.x = cvt_pk_bf16(v0[0], v0[1]); w.y = cvt_pk_bf16(v0[2], v0[3]); w.z = cvt_pk_bf16(v1[0], v1[1]); w.w = cvt_pk_bf16(v1[2], v1[3]);
                    *(v4u*)dst = w; } }
    }
};
struct EpiCmp {
    static constexpr bool PERM = false;
    float* C;
    __device__ __forceinline__ void operator()(const f32x4 (&acc)[2][2][4][2], const Unit& u, int wr, int wc, int fr, int fq) const {
        const int row0 = u.pm * BM + wr * 64 + fr, col0 = (u.pn & 1) * BM + wc * 32 + 4 * fq; float* base = C + (size_t)u.ks * 4096 * 512;
#pragma unroll
        for (int ai = 0; ai < 2; ++ai)
#pragma unroll
            for (int m = 0; m < 4; ++m) { float* rowp = base + (size_t)(row0 + ai * HALF + m * 16) * 512 + col0;
#pragma unroll
                for (int bj = 0; bj < 2; ++bj)
#pragma unroll
                    for (int n = 0; n < 2; ++n) *(f32x4*)(rowp + bj * HALF + n * 16) = acc[ai][bj][m][n]; }
    }
};
struct EpiGlu {
    static constexpr bool PERM = true;
    const bf16* Z; bf16* ZG;
    __device__ __forceinline__ void operator()(const f32x4 (&acc)[2][2][4][2], const Unit& u, int wr, int wc, int fr, int fq) const {
        const int row0 = u.pm * BM + wr * 64 + fr;
#pragma unroll
        for (int ai = 0; ai < 2; ++ai)
#pragma unroll
            for (int m = 0; m < 4; ++m) { const int row = row0 + ai * HALF + m * 16;
#pragma unroll
                for (int bj = 0; bj < 2; ++bj) { const f32x4 v0 = acc[ai][bj][m][0], v1 = acc[ai][bj][m][1]; const size_t off = (size_t)row * 512 + u.pn * BM + bj * HALF + wc * 32 + 8 * fq;
                    const v4u z = *(const v4u*)(Z + off); v4u w;
                    w.x = cvt_pk_bf16(bflo(z.x) * sigm(v0[0]), bfhi(z.x) * sigm(v0[1])); w.y = cvt_pk_bf16(bflo(z.y) * sigm(v0[2]), bfhi(z.y) * sigm(v0[3]));
                    w.z = cvt_pk_bf16(bflo(z.z) * sigm(v1[0]), bfhi(z.z) * sigm(v1[1])); w.w = cvt_pk_bf16(bflo(z.w) * sigm(v1[2]), bfhi(z.w) * sigm(v1[3]));
                    *(v4u*)(ZG + off) = w; } }
    }
};
template <bool FIRST> struct EpiMix {
    static constexpr bool PERM = true;
    const bf16* Gt; bf16* MIX;
    __device__ __forceinline__ void operator()(const f32x4 (&acc)[2][2][4][2], const Unit& u, int wr, int wc, int fr, int fq) const {
        const int row0 = u.pm * BM + wr * 64 + fr;
#pragma unroll
        for (int ai = 0; ai < 2; ++ai)
#pragma unroll
            for (int m = 0; m < 4; ++m) { const int row = row0 + ai * HALF + m * 16;
#pragma unroll
                for (int bj = 0; bj < 2; ++bj) { const f32x4 v0 = acc[ai][bj][m][0], v1 = acc[ai][bj][m][1]; const int col = u.pn * BM + bj * HALF + wc * 32 + 8 * fq;
                    const v4u gq = *(const v4u*)(Gt + (size_t)row * 2048 + (FIRST ? 0 : 1024) + col);
                    float r[8] = {bflo(gq.x) * v0[0], bfhi(gq.x) * v0[1], bflo(gq.y) * v0[2], bfhi(gq.y) * v0[3], bflo(gq.z) * v1[0], bfhi(gq.z) * v1[1], bflo(gq.w) * v1[2], bfhi(gq.w) * v1[3]};
                    bf16* dst = MIX + (size_t)row * 1024 + col;
                    if (!FIRST) { const v4u o = *(const v4u*)dst; r[0] += bflo(o.x); r[1] += bfhi(o.x); r[2] += bflo(o.y); r[3] += bfhi(o.y); r[4] += bflo(o.z); r[5] += bfhi(o.z); r[6] += bflo(o.w); r[7] += bfhi(o.w); }
                    v4u w; w.x = cvt_pk_bf16(r[0], r[1]); w.y = cvt_pk_bf16(r[2], r[3]); w.z = cvt_pk_bf16(r[4], r[5]); w.w = cvt_pk_bf16(r[6], r[7]);
                    *(v4u*)dst = w; } }
    }
};
struct EpiRes {
    static constexpr bool PERM = false;
    const float* base; float* out;
    __device__ __forceinline__ void operator()(const f32x4 (&acc)[2][2][4][2], const Unit& u, int wr, int wc, int fr, int fq) const {
        const int row0 = u.pm * BM + wr * 64 + fr, col0 = u.pn * BM + wc * 32 + 4 * fq;
#pragma unroll
        for (int ai = 0; ai < 2; ++ai)
#pragma unroll
            for (int m = 0; m < 4; ++m) { const size_t off = (size_t)(row0 + ai * HALF + m * 16) * 1024 + col0;
#pragma unroll
                for (int bj = 0; bj < 2; ++bj)
#pragma unroll
                    for (int n = 0; n < 2; ++n) { const f32x4 b = *(const f32x4*)(base + off + bj * HALF + n * 16); *(f32x4*)(out + off + bj * HALF + n * 16) = b + acc[ai][bj][m][n]; } }
    }
};
struct EpiFfn {
    static constexpr bool PERM = true;
    bf16* H;
    __device__ __forceinline__ void operator()(const f32x4 (&acc)[2][2][4][2], const Unit& u, int wr, int wc, int fr, int fq) const {
        const int row0 = u.pm * BM + wr * 64 + fr;
#pragma unroll
        for (int ai = 0; ai < 2; ++ai)
#pragma unroll
            for (int m = 0; m < 4; ++m) { const int row = row0 + ai * HALF + m * 16;
                float r[8];
#pragma unroll
                for (int n = 0; n < 2; ++n)
#pragma unroll
                    for (int e = 0; e < 4; ++e) { const float gt = acc[ai][0][m][n][e], up = acc[ai][1][m][n][e]; r[n * 4 + e] = gt * sigm(gt) * up; }
                v4u w; w.x = cvt_pk_bf16(r[0], r[1]); w.y = cvt_pk_bf16(r[2], r[3]); w.z = cvt_pk_bf16(r[4], r[5]); w.w = cvt_pk_bf16(r[6], r[7]);
                *(v4u*)(H + (size_t)row * DFF + u.pn * HALF + wc * 32 + 8 * fq) = w; }
    }
};

__device__ __forceinline__ void tr_item(const float* src, int ld, int ncols, bf16* dst, int dld, int drow, int kb, int nb, LAS float* scr, int lane) {
    const int k0 = 64 * kb, n0 = 32 * nb; const int c = n0 + (lane & 31); const bool ok = c < ncols;
#pragma unroll 8
    for (int i = 0; i < 32; ++i) { const int kk = 2 * i + (lane >> 5); scr[kk * 33 + (lane & 31)] = ok ? src[(size_t)(k0 + kk) * ld + c] : 0.f; }
    LDS_WAIT();
    const int cc = lane & 7;
#pragma unroll
    for (int j = 0; j < 4; ++j) { const int n = (lane >> 3) + 8 * j; const LAS float* s = scr + (8 * cc) * 33 + n;
        v4u o; o.x = pk2(s[0 * 33], s[1 * 33]); o.y = pk2(s[2 * 33], s[3 * 33]); o.z = pk2(s[4 * 33], s[5 * 33]); o.w = pk2(s[6 * 33], s[7 * 33]);
        *(v4u*)(dst + (size_t)(drow + n) * dld + k0 + 8 * cc) = o; }
    LDS_WAIT();
}
__device__ __forceinline__ void rms_row_to_bf16(const float* xrow, const float* gain, bf16* orow, int lane) {
    const f32x4* xr = (const f32x4*)xrow + lane; const f32x4* gr = (const f32x4*)gain + lane;
    f32x4 v[4]; float s = 0.f;
#pragma unroll
    for (int j = 0; j < 4; ++j) { v[j] = xr[64 * j]; s += (v[j].x * v[j].x + v[j].y * v[j].y) + (v[j].z * v[j].z + v[j].w * v[j].w); }
    const float rstd = 1.0f / sqrtf(wave_sum(s) * (1.f / DM) + EPS);
    unsigned long long* o8 = (unsigned long long*)orow + lane;
#pragma unroll
    for (int j = 0; j < 4; ++j) { const f32x4 gq = gr[64 * j];
        o8[64 * j] = (unsigned long long)pk2(v[j].x * rstd * gq.x, v[j].y * rstd * gq.y) | ((unsigned long long)pk2(v[j].z * rstd * gq.z, v[j].w * rstd * gq.w) << 32); }
}
__device__ __forceinline__ void rms_row_f32(float* xrow, const float* gain, int lane) {
    f32x4* xr = (f32x4*)xrow + lane; const f32x4* gr = (const f32x4*)gain + lane;
    f32x4 v[4]; float s = 0.f;
#pragma unroll
    for (int j = 0; j < 4; ++j) { v[j] = xr[64 * j]; s += (v[j].x * v[j].x + v[j].y * v[j].y) + (v[j].z * v[j].z + v[j].w * v[j].w); }
    const float rstd = 1.0f / sqrtf(wave_sum(s) * (1.f / DM) + EPS);
#pragma unroll
    for (int j = 0; j < 4; ++j) { const f32x4 gq = gr[64 * j]; xr[64 * j] = v[j] * rstd * gq; }
}
__device__ __forceinline__ void s5_tables(const Frame& F, const Args& args, int g) {
    const int lane = F.lane;
    const float* are = args.in[3]; const float* aim = args.in[4]; const float* ldt = args.in[5]; const float* bre = args.in[6]; const float* bim = args.in[7]; const float* cre = args.in[8]; const float* cim = args.in[9];
    const double dt = exp((double)ldt[g]);
    {   const int p = lane; const double ar = are[g * 64 + p], ai = aim[g * 64 + p];
        const double er = exp(ar * dt), lr = er * cos(ai * dt), li = er * sin(ai * dt);
        ((f32x2*)(F.ws + WS_TAB + TAB_LAM))[g * 64 + p] = (f32x2){(float)lr, (float)li};
        const double e2 = exp(ar * dt * 256.0), l2r = e2 * cos(ai * dt * 256.0), l2i = e2 * sin(ai * dt * 256.0);
        ((f32x2*)(F.ws + WS_TAB + TAB_LAM256))[g * 64 + p] = (f32x2){(float)l2r, (float)l2i}; }
#pragma unroll
    for (int nt = 0; nt < 4; ++nt) { const int col = 32 * nt + (lane & 31), p = col >> 1, ri = col & 1;
        const double ar = are[g * 64 + p], ai = aim[g * 64 + p];
        const double er = exp(ar * dt), lr = er * cos(ai * dt) - 1.0, li = er * sin(ai * dt);
        const double den = ar * ar + ai * ai, kr = (lr * ar + li * ai) / den, ki = (li * ar - lr * ai) / den;
        float v[8];
#pragma unroll
        for (int j = 0; j < 8; ++j) { const int c = 8 * (lane >> 5) + j; const double br = bre[(g * 64 + p) * 16 + c], bi = bim[(g * 64 + p) * 16 + c];
            v[j] = (float)(ri ? (kr * bi + ki * br) : (kr * br - ki * bi)); }
        v4u o; o.x = pk2(v[0], v[1]); o.y = pk2(v[2], v[3]); o.z = pk2(v[4], v[5]); o.w = pk2(v[6], v[7]);
        ((v4u*)(F.ws + WS_TAB + TAB_BF))[(g * 4 + nt) * 64 + lane] = o; }
#pragma unroll
    for (int ks = 0; ks < 4; ++ks) { const int ch = lane & 15; float v[8];
#pragma unroll
        for (int j = 0; j < 8; ++j) { const int k = 32 * ks + 8 * (lane >> 4) + j, p = k >> 1, ri = k & 1; v[j] = ri ? -cim[(g * 16 + ch) * 64 + p] : cre[(g * 16 + ch) * 64 + p]; }
        v4u o; o.x = pk2(v[0], v[1]); o.y = pk2(v[2], v[3]); o.z = pk2(v[4], v[5]); o.w = pk2(v[6], v[7]);
        ((v4u*)(F.ws + WS_TAB + TAB_CF))[(g * 4 + ks) * 64 + lane] = o; }
}
__device__ __forceinline__ void p0_prologue(const Frame& F, const Args& args) {
    LAS float* scr = (LAS float*)(F.lds + F.wave * 16384);
    const int gw = F.gw, NGW = F.ngw, lane = F.lane;
    if (gw < 32) s5_tables(F, args, gw);
    else if (gw < 32 + 128) {
        const int it = gw - 32, kv = it >> 6, part = (it >> 2) & 15, cgp = it & 3;
        const float* pos = kv ? args.in[14] : args.in[13]; const float* w1 = kv ? args.in[17] : args.in[15]; float a = 0.f;
        for (int r = 128 * part; r < 128 * part + 128; ++r) a += pos[r] * w1[(size_t)r * 256 + cgp * 64 + lane];
        ((float*)(F.ws + WS_TAB + TAB_POSB))[(kv * 16 + part) * 256 + cgp * 64 + lane] = a;
    }
    { v4u* z = (v4u*)(F.ws + WS_WIN + (size_t)3872 * 1024 * 2); const int n16 = 224 * 1024 * 2 / 16;
      for (int i = blockIdx.x * 512 + F.tid; i < n16; i += F.G * 512) z[i] = (v4u){0u, 0u, 0u, 0u}; }
    bf16* WIN = (bf16*)(F.ws + WS_WIN); bf16* WGU = (bf16*)(F.ws + WS_WGU); bf16* WD = (bf16*)(F.ws + WS_WD); bf16* WOUT = (bf16*)(F.ws + WS_WOUT);
    bf16* WA = (bf16*)(F.ws + WS_WA); bf16* WB = (bf16*)(F.ws + WS_WB); bf16* WGLU = (bf16*)(F.ws + WS_WGLU); bf16* WC1 = (bf16*)(F.ws + WS_WC1);
    constexpr int I1 = 16 * 56, I2 = 16 * 64, I3 = 16, IGLU = 8 * 16, IUP = 8 * 32, IOUT = 16 * 32, IFF = 16 * 88, IDN = 44 * 32, ICM = 16 * 8;
    constexpr int NITEMS = I1 + I2 + I3 + IGLU + 2 * IUP + IOUT + 2 * IFF + IDN + 4 * ICM;
    for (int it = gw; it < NITEMS; it += NGW) {
        int r = it;
        if (r < I1) { tr_item(args.in[2], INC, 1792, WIN, 1024, 32 * (r % 56), r / 56, r % 56, scr, lane); continue; } r -= I1;
        if (r < I2) { tr_item(args.in[2] + 1816, INC, 2048, WIN, 1024, 1792 + 32 * (r % 64), r / 64, r % 64, scr, lane); continue; } r -= I2;
        if (r < I3) { tr_item(args.in[2] + 1792, INC, 24, WIN, 1024, 3840, r, 0, scr, lane); continue; } r -= I3;
        if (r < IGLU) { tr_item(args.in[11], 512, 512, WGLU, 512, 32 * (r % 16), r / 16, r % 16, scr, lane); continue; } r -= IGLU;
        if (r < IUP) { tr_item(args.in[12], 1024, 1024, WA, 512, 32 * (r % 32), r / 32, r % 32, scr, lane); continue; } r -= IUP;
        if (r < IUP) { tr_item(args.in[20], 1024, 1024, WB, 512, 32 * (r % 32), r / 32, r % 32, scr, lane); continue; } r -= IUP;
        if (r < IOUT) { tr_item(args.in[21], 1024, 1024, WOUT, 1024, 32 * (r % 32), r / 32, r % 32, scr, lane); continue; } r -= IOUT;
        if (r < IFF) { const int nb = r % 88; tr_item(args.in[23], DFF, DFF, WGU, 1024, (nb >> 2) * 256 + (nb & 3) * 32, r / 88, nb, scr, lane); continue; } r -= IFF;
        if (r < IFF) { const int nb = r % 88; tr_item(args.in[24], DFF, DFF, WGU, 1024, (nb >> 2) * 256 + (nb & 3) * 32 + 128, r / 88, nb, scr, lane); continue; } r -= IFF;
        if (r < IDN) { tr_item(args.in[25], 1024, 1024, WD, DFF, 32 * (r % 32), r / 32, r % 32, scr, lane); continue; } r -= IDN;
        { const int q = r / ICM, rr = r % ICM;
          tr_item(((q >> 1) ? args.in[17] : args.in[15]) + (size_t)(q & 1) * 1024 * 256, 256, 256, WC1, 1024, q * 256 + 32 * (rr % 8), rr / 8, rr % 8, scr, lane); }
    }
    bf16* XN = (bf16*)(F.ws + WS_XN);
    for (int m = gw; m < S; m += NGW) rms_row_to_bf16(args.in[0] + (size_t)m * DM, args.in[1], XN + (size_t)m * DM, lane);
}

__device__ __forceinline__ int crow(int r, int hi) { return (r & 3) + 8 * (r >> 2) + 4 * hi; }
template <bool FINAL>
__device__ __forceinline__ void s5_unit(const Frame& F, const Args& args, int c, int g, LAS unsigned char* wl) {
    const int lane = F.lane, hi = lane >> 5;
    const bf16* U = (const bf16*)(F.ws + WS_U); bf16* Z = (bf16*)(F.ws + WS_Z);
    bf16x8 bfg[4], cfg[4];
#pragma unroll
    for (int nt = 0; nt < 4; ++nt) bfg[nt] = ((const bf16x8*)(F.ws + WS_TAB + TAB_BF))[(g * 4 + nt) * 64 + lane];
    const f32x2 lam = ((const f32x2*)(F.ws + WS_TAB + TAB_LAM))[g * 64 + lane];
    f32x2* Fst = (f32x2*)(F.ws + WS_F);
    float xr = 0.f, xi = 0.f, dsk = 0.f;
    if (FINAL) {
#pragma unroll
        for (int ks = 0; ks < 4; ++ks) cfg[ks] = ((const bf16x8*)(F.ws + WS_TAB + TAB_CF))[(g * 4 + ks) * 64 + lane];
        dsk = args.in[10][g * 16 + (lane & 15)];
        const f32x2 L2 = ((const f32x2*)(F.ws + WS_TAB + TAB_LAM256))[g * 64 + lane];
        for (int cp = 0; cp < c; ++cp) { const f32x2 f = Fst[(cp * 32 + g) * 64 + lane]; const float nr = L2.x * xr - L2.y * xi + f.x, ni = L2.x * xi + L2.y * xr + f.y; xr = nr; xi = ni; }
    }
    for (int sub = 0; sub < 8; ++sub) {
        const int t0 = c * 256 + sub * 32;
        const bf16x8 a = *(const bf16x8*)(U + (size_t)(t0 + (lane & 31)) * 512 + g * 16 + 8 * hi);
#pragma unroll
        for (int nt = 0; nt < 4; ++nt) { f32x16 acc = {}; acc = __builtin_amdgcn_mfma_f32_32x32x16_bf16(a, bfg[nt], acc, 0, 0, 0);
#pragma unroll
            for (int r = 0; r < 16; ++r) ((LAS float*)wl)[crow(r, hi) * 128 + 32 * nt + (lane & 31)] = acc[r]; }
        LDS_WAIT();
        f32x2 bu[32];
#pragma unroll
        for (int tk = 0; tk < 32; ++tk) bu[tk] = ((const LAS f32x2*)wl)[tk * 64 + lane];
        LDS_WAIT();
#pragma unroll
        for (int tk = 0; tk < 32; ++tk) { const float nr = lam.x * xr - lam.y * xi + bu[tk].x, ni = lam.x * xi + lam.y * xr + bu[tk].y; xr = nr; xi = ni;
            if (FINAL) ((LAS unsigned*)wl)[tk * 128 + lane] = pk2(xr, xi); }
        if (FINAL) {
            LDS_WAIT();
#pragma unroll
            for (int mt = 0; mt < 2; ++mt) { f32x4 y4 = {0.f, 0.f, 0.f, 0.f};
#pragma unroll
                for (int ks = 0; ks < 4; ++ks) { const bf16x8 xa = *(const LAS bf16x8*)(wl + (16 * mt + (lane & 15)) * 512 + (32 * ks + 8 * (lane >> 4)) * 2); y4 = __builtin_amdgcn_mfma_f32_16x16x32_bf16(xa, cfg[ks], y4, 0, 0, 0); }
#pragma unroll
                for (int r = 0; r < 4; ++r) { const size_t off = (size_t)(t0 + 16 * mt + 4 * (lane >> 4) + r) * 512 + g * 16 + (lane & 15);
                    const float y = y4[r] + dsk * bf2f(U[off]); Z[off] = (bf16)f2bf(gelu_tanh(y)); } }
            LDS_WAIT();
        }
    }
    if (!FINAL) Fst[(c * 32 + g) * 64 + lane] = (f32x2){xr, xi};
}

__device__ __forceinline__ void cmp_l2_unit(const Frame& F, const Args& args, int kv, int g, int n, LAS float* hb) {
    const int lane = F.lane; const float* P1 = F.out;
    const int rt = kv * 2048 + g * 1024 + n;
    const float* posb = (const float*)(F.ws + WS_TAB + TAB_POSB) + kv * 16 * 256;
#pragma unroll
    for (int i = 0; i < 4; ++i) { const int j = lane + 64 * i; float a = 0.f;
#pragma unroll
        for (int ks = 0; ks < CMP_KS; ++ks) a += P1[((size_t)ks * 4096 + rt) * 512 + j] + P1[((size_t)ks * 4096 + rt + 1) * 512 + 256 + j];
#pragma unroll
        for (int p = 0; p < 16; ++p) a += posb[p * 256 + j];
        hb[j] = gelu_tanh(a); }
    LDS_WAIT();
    const float* w2 = kv ? args.in[18] : args.in[16]; float o = 0.f;
#pragma unroll 8
    for (int j = 0; j < 256; ++j) o += hb[j] * w2[j * 64 + lane];
    ((float*)(F.ws + WS_KVC))[((size_t)(kv * 2 + g) * 1024 + n) * 64 + lane] = o;
    LDS_WAIT();
}

__device__ __forceinline__ void dot4_bf16(const bf16* kp, const LAS float* qs, float (&s)[4]) {
    s[0] = s[1] = s[2] = s[3] = 0.f;
    asm volatile("" ::: "memory");
#pragma unroll 2
    for (int c8 = 0; c8 < 8; ++c8) { const v4u w = ((const v4u*)kp)[c8]; const unsigned ww[4] = {w.x, w.y, w.z, w.w};
#pragma unroll
        for (int e = 0; e < 4; ++e) { const float k0 = bflo(ww[e]), k1 = bfhi(ww[e]); const f32x4 q0 = *(const LAS f32x4*)(qs + (c8 * 8 + e * 2) * 4), q1 = *(const LAS f32x4*)(qs + (c8 * 8 + e * 2 + 1) * 4);
#pragma unroll
            for (int r = 0; r < 4; ++r) s[r] += q0[r] * k0 + q1[r] * k1; } }
}
__device__ __forceinline__ void softmax4(LAS float* sc, int n, int lane) {
    float m[4] = {-1e30f, -1e30f, -1e30f, -1e30f};
    for (int i = lane; i < n; i += 64) { const f32x4 v = *(const LAS f32x4*)(sc + i * 4);
#pragma unroll
        for (int r = 0; r < 4; ++r) m[r] = fmaxf(m[r], v[r]); }
#pragma unroll
    for (int r = 0; r < 4; ++r) m[r] = wave_max(m[r]);
    float l[4] = {0.f, 0.f, 0.f, 0.f};
    for (int i = lane; i < n; i += 64) { f32x4 v = *(const LAS f32x4*)(sc + i * 4);
#pragma unroll
        for (int r = 0; r < 4; ++r) { v[r] = (v[r] > -1e29f) ? __expf(v[r] - m[r]) : 0.f; l[r] += v[r]; }
        *(LAS f32x4*)(sc + i * 4) = v; }
    float inv[4];
#pragma unroll
    for (int r = 0; r < 4; ++r) inv[r] = 1.0f / fmaxf(wave_sum(l[r]), 1e-30f);
    for (int i = lane; i < n; i += 64) { f32x4 v = *(const LAS f32x4*)(sc + i * 4);
#pragma unroll
        for (int r = 0; r < 4; ++r) v[r] *= inv[r];
        *(LAS f32x4*)(sc + i * 4) = v; }
    LDS_WAIT();
}
__device__ __forceinline__ void attn_naive_unit(const Frame& F, int t, int g, LAS unsigned char* wl, const LAS float* BT) {
    const int lane = F.lane;
    LAS float* sc = (LAS float*)wl; LAS float* qs = sc + 4096; LAS int* seli = (LAS int*)(qs + 256);
    const bf16* Q = (const bf16*)(F.ws + WS_Q); const bf16* KVH = (const bf16*)(F.ws + WS_KVH); const bf16* GN = (const bf16*)(F.ws + WS_GN);
    const float* KVC = (const float*)(F.ws + WS_KVC); bf16* O = (bf16*)(F.ws + WS_O);
#pragma unroll
    for (int r = 0; r < 4; ++r) qs[lane * 4 + r] = bf2f(Q[(size_t)t * 512 + (g * 4 + r) * 64 + lane]);
    LDS_WAIT();
    float gt[4][3];
#pragma unroll
    for (int r = 0; r < 4; ++r)
#pragma unroll
        for (int b = 0; b < 3; ++b) gt[r][b] = bf2f(GN[(size_t)t * 32 + (g * 4 + r) * 3 + b]);
    float oacc[4] = {0.f, 0.f, 0.f, 0.f};
    const int ncmp = t >= 31 ? min((t - 31) / 16 + 1, NCMP) : 0;
    for (int n = lane; n < ncmp; n += 64) {
        const f32x4* kp = (const f32x4*)(KVC + ((size_t)(0 + g) * 1024 + n) * 64); float s[4] = {0.f, 0.f, 0.f, 0.f};
        asm volatile("" ::: "memory");
#pragma unroll 4
        for (int d4 = 0; d4 < 16; ++d4) { const f32x4 kv = kp[d4];
#pragma unroll
            for (int e = 0; e < 4; ++e) { const f32x4 q = *(const LAS f32x4*)(qs + (d4 * 4 + e) * 4);
#pragma unroll
                for (int r = 0; r < 4; ++r) s[r] += q[r] * kv[e]; } }
        const int db = min(t - (16 * n + 31), 127);
        f32x4 v;
#pragma unroll
        for (int r = 0; r < 4; ++r) v[r] = s[r] + BT[(g * 4 + r) * 128 + db];
        *(LAS f32x4*)(sc + n * 4) = v;
    }
    LDS_WAIT();
    softmax4(sc, ncmp, lane);
    {   float oc[4] = {0.f, 0.f, 0.f, 0.f}; const float* vp = KVC + ((size_t)(2 + g) * 1024) * 64 + lane;
        for (int n = 0; n < ncmp; ++n) { const f32x4 p = *(const LAS f32x4*)(sc + n * 4); const float v = vp[(size_t)n * 64];
#pragma unroll
            for (int r = 0; r < 4; ++r) oc[r] += p[r] * v; }
#pragma unroll
        for (int r = 0; r < 4; ++r) oacc[r] += gt[r][0] * oc[r]; }
    const int cur = t >> 6; const int nsel = min(16, cur + 1);
    if (cur + 1 <= 16) { if (lane < nsel) seli[lane] = lane; }
    else {
        float sv[4];
#pragma unroll
        for (int i = 0; i < 4; ++i) { const int j = lane + 64 * i; float ps = 0.f;
            if (j <= cur) {
#pragma unroll
                for (int o = 0; o < 5; ++o) { const int n = 4 * j - 1 + o; float pn = 0.f;
                    if (n >= 0 && n < ncmp) { const f32x4 p = *(const LAS f32x4*)(sc + n * 4); pn = (p[0] + p[1]) + (p[2] + p[3]); }
                    ps += ((o == 0 || o == 4) ? 1.0f : 2.0f) * pn; }
                sv[i] = (j == 0 || j >= cur - 1) ? 1e4f : ps;
            } else sv[i] = -3e38f; }
        for (int it = 0; it < 16; ++it) {
            float bv = sv[0]; int bi = lane;
#pragma unroll
            for (int i = 1; i < 4; ++i) if (sv[i] > bv) { bv = sv[i]; bi = lane + 64 * i; }
#pragma unroll
            for (int o = 1; o < 64; o <<= 1) { const float ov = __shfl_xor(bv, o); const int oi = __shfl_xor(bi, o); if (ov > bv || (ov == bv && oi < bi)) { bv = ov; bi = oi; } }
            if (lane == 0) seli[it] = bi;
#pragma unroll
            for (int i = 0; i < 4; ++i) if (bi == lane + 64 * i) sv[i] = -3e38f;
        }
    }
    LDS_WAIT();
    for (int b = 0; b < nsel; ++b) { const int j = seli[b]; const int pos = j * 64 + lane, dist = t - pos; float s[4];
        dot4_bf16(KVH + ((size_t)(4 + g) * S + pos) * 64, qs, s);
        f32x4 v;
#pragma unroll
        for (int r = 0; r < 4; ++r) v[r] = dist >= 0 ? s[r] + BT[(g * 4 + r) * 128 + min(dist, 127)] : -1e30f;
        *(LAS f32x4*)(sc + (b * 64 + lane) * 4) = v; }
    LDS_WAIT();
    softmax4(sc, nsel * 64, lane);
    {   float os[4] = {0.f, 0.f, 0.f, 0.f}; const bf16* vb = KVH + ((size_t)(6 + g) * S) * 64 + lane;
        for (int b = 0; b < nsel; ++b) { const int j = seli[b];
            for (int kk = 0; kk < 64; ++kk) { const f32x4 p = *(const LAS f32x4*)(sc + (b * 64 + kk) * 4); const float v = bf2f(vb[(size_t)(j * 64 + kk) * 64]);
#pragma unroll
                for (int r = 0; r < 4; ++r) os[r] += p[r] * v; } }
#pragma unroll
        for (int r = 0; r < 4; ++r) oacc[r] += gt[r][1] * os[r]; }
    const int nwin = min(512, t + 1);
    for (int w = lane; w < nwin; w += 64) { const int pos = t - w; float s[4];
        dot4_bf16(KVH + ((size_t)(8 + g) * S + pos) * 64, qs, s);
        f32x4 v;
#pragma unroll
        for (int r = 0; r < 4; ++r) v[r] = s[r] + BT[(g * 4 + r) * 128 + min(w, 127)];
        *(LAS f32x4*)(sc + w * 4) = v; }
    LDS_WAIT();
    softmax4(sc, nwin, lane);
    {   float ow[4] = {0.f, 0.f, 0.f, 0.f}; const bf16* vb = KVH + ((size_t)(10 + g) * S) * 64 + lane;
        for (int w = 0; w < nwin; ++w) { const f32x4 p = *(const LAS f32x4*)(sc + w * 4); const float v = bf2f(vb[(size_t)(t - w) * 64]);
#pragma unroll
            for (int r = 0; r < 4; ++r) ow[r] += p[r] * v; }
#pragma unroll
        for (int r = 0; r < 4; ++r) oacc[r] += gt[r][2] * ow[r]; }
#pragma unroll
    for (int r = 0; r < 4; ++r) O[(size_t)t * 512 + (g * 4 + r) * 64 + lane] = (bf16)f2bf(oacc[r]);
    LDS_WAIT();
}

__global__ void __launch_bounds__(NWAVES * 64, 2) mk_fwd(Args args) {
    extern __shared__ __attribute__((aligned(16))) unsigned char lds_raw[];
    Frame F;
    F.lds = (LAS unsigned char*)lds_raw;
    F.tid = threadIdx.x; F.lane = F.tid & 63; F.wave = __builtin_amdgcn_readfirstlane(F.tid >> 6);
    F.G = gridDim.x; F.gw = blockIdx.x * NWAVES + F.wave; F.ngw = F.G * NWAVES;
    F.out = args.out; F.ws = args.ws;
    const int lo = args.ph_lo, hi = args.ph_hi;
#ifndef PHMASK
#define PHMASK 0xFFF
#endif
#define IN(k) (((PHMASK >> (k)) & 1) && lo <= (k) && (k) < hi)
#define SEAM(k) do { if (IN(k) && IN((k) + 1)) { cg::this_grid().sync(); } } while (0)
    unsigned char* ws = F.ws;
    if (IN(0)) { p0_prologue(F, args); }
    SEAM(0);
    if (IN(1)) {
        pg8::Gemm g{(const bf16*)(ws + WS_XN), (const bf16*)(ws + WS_WIN), S, NPJ, 1024, 1024}; pg8::StaticOrder So; So.init(S, NPJ, F.G, (int)blockIdx.x);
        EpiProj E{(bf16*)(ws + WS_U), (bf16*)(ws + WS_Q), (bf16*)(ws + WS_KVH), (bf16*)(ws + WS_G), (bf16*)(ws + WS_GN)};
        pg8::gemm_phase<EpiProj, pg8::StaticOrder>(F.lds, g, So, E);
    }
    SEAM(1);
    if (IN(2)) {
        for (int u = F.gw; u < 64 * 32; u += F.ngw) s5_unit<false>(F, args, u >> 5, u & 31, F.lds + F.wave * 16384);
        __syncthreads();
        pg8::Gemm g{(const bf16*)(ws + WS_KVH), (const bf16*)(ws + WS_WC1), 4096, 1024, 1024 / CMP_KS, 1024}; pg8::CmpOrder So{F.G, (int)blockIdx.x, CMP_KS};
        EpiCmp E{F.out};
        pg8::gemm_phase<EpiCmp, pg8::CmpOrder>(F.lds, g, So, E);
    }
    SEAM(2);
    if (IN(3)) {
        for (int u = F.gw; u < 64 * 32; u += F.ngw) s5_unit<true>(F, args, u >> 5, u & 31, F.lds + F.wave * 16384);
        for (int u = F.gw; u < 4 * NCMP; u += F.ngw) { const int kvg = u / NCMP, n = u % NCMP; cmp_l2_unit(F, args, kvg >> 1, kvg & 1, n, (LAS float*)(F.lds + F.wave * 16384)); }
    }
    SEAM(3);
    if (IN(4)) {
        LAS float* BT = (LAS float*)(F.lds + 8 * 17536);
        for (int i = F.tid; i < 8 * 128; i += NWAVES * 64) { const int h = i >> 7, d = i & 127;
            int bk = d; if (d >= 16) { bk = 16 + (int)(logf((float)d * (1.0f / 16.0f)) / 2.0794415416798357f * 16.0f); if (bk > 31) bk = 31; }
            BT[i] = args.in[19][bk * 8 + h]; }
        __syncthreads();
        for (int u = F.gw; u < S * 2; u += F.ngw) attn_naive_unit(F, u >> 1, u & 1, F.lds + F.wave * 17536, BT);
        __syncthreads();
    }
    SEAM(4);
    if (IN(5)) {
        pg8::Gemm g{(const bf16*)(ws + WS_Z), (const bf16*)(ws + WS_WGLU), S, 512, 512, 512}; pg8::StaticOrder So; So.init(S, 512, F.G, (int)blockIdx.x);
        EpiGlu E{(const bf16*)(ws + WS_Z), (bf16*)(ws + WS_ZG)};
        pg8::gemm_phase<EpiGlu, pg8::StaticOrder>(F.lds, g, So, E);
    }
    SEAM(5);
    if (IN(6)) {
        pg8::StaticOrder So; So.init(S, 1024, F.G, (int)blockIdx.x);
        { pg8::Gemm g{(const bf16*)(ws + WS_ZG), (const bf16*)(ws + WS_WA), S, 1024, 512, 512}; EpiMix<true> E{(const bf16*)(ws + WS_G), (bf16*)(ws + WS_MIX)};
          pg8::gemm_phase<EpiMix<true>, pg8::StaticOrder>(F.lds, g, So, E); }
        { pg8::Gemm g{(const bf16*)(ws + WS_O), (const bf16*)(ws + WS_WB), S, 1024, 512, 512}; EpiMix<false> E{(const bf16*)(ws + WS_G), (bf16*)(ws + WS_MIX)};
          pg8::gemm_phase<EpiMix<false>, pg8::StaticOrder>(F.lds, g, So, E); }
    }
    SEAM(6);
    if (IN(7)) {
        pg8::Gemm g{(const bf16*)(ws + WS_MIX), (const bf16*)(ws + WS_WOUT), S, 1024, 1024, 1024}; pg8::StaticOrder So; So.init(S, 1024, F.G, (int)blockIdx.x);
        EpiRes E{args.in[0], F.out};
        pg8::gemm_phase<EpiRes, pg8::StaticOrder>(F.lds, g, So, E);
    }
    SEAM(7);
    if (IN(8)) { bf16* XN = (bf16*)(ws + WS_XN); for (int m = F.gw; m < S; m += F.ngw) rms_row_to_bf16(F.out + (size_t)m * DM, args.in[22], XN + (size_t)m * DM, F.lane); }
    SEAM(8);
    if (IN(9)) {
        pg8::Gemm g{(const bf16*)(ws + WS_XN), (const bf16*)(ws + WS_WGU), S, 2 * DFF, 1024, 1024}; pg8::StaticOrder So; So.init(S, 2 * DFF, F.G, (int)blockIdx.x);
        EpiFfn E{(bf16*)(ws + WS_H)};
        pg8::gemm_phase<EpiFfn, pg8::StaticOrder>(F.lds, g, So, E);
    }
    SEAM(9);
    if (IN(10)) {
        pg8::Gemm g{(const bf16*)(ws + WS_H), (const bf16*)(ws + WS_WD), S, 1024, DFF, DFF}; pg8::StaticOrder So; So.init(S, 1024, F.G, (int)blockIdx.x);
        EpiRes E{F.out, F.out};
        pg8::gemm_phase<EpiRes, pg8::StaticOrder>(F.lds, g, So, E);
    }
    SEAM(10);
    if (IN(11)) { for (int m = F.gw; m < S; m += F.ngw) rms_row_f32(F.out + (size_t)m * DM, args.in[26], F.lane); }
#undef IN
#undef SEAM
}

extern "C" void kernel_launch(void* const* d_in, const int* in_sizes, int n_in, void* d_out, int out_size, void* d_ws, size_t ws_size, hipStream_t stream) {
    static int grid = 0;
    if (grid == 0) {
        if (n_in != 27 || out_size != S * DM || ws_size < WS_END) { fprintf(stderr, "kernel_launch: unexpected shapes (n_in %d out %d ws %zu)\n", n_in, out_size, ws_size); grid = -1; return; }
        int dev = 0, cus = 0, per_cu = 0;
        if (hipGetDevice(&dev) != hipSuccess || hipDeviceGetAttribute(&cus, hipDeviceAttributeMultiprocessorCount, dev) != hipSuccess) { grid = -1; return; }
        if (hipFuncSetAttribute((const void*)mk_fwd, hipFuncAttributeMaxDynamicSharedMemorySize, LDS_BYTES) != hipSuccess) { fprintf(stderr, "kernel_launch: hipFuncSetAttribute failed\n"); grid = -1; return; }
        if (hipOccupancyMaxActiveBlocksPerMultiprocessor(&per_cu, (const void*)mk_fwd, NWAVES * 64, LDS_BYTES) != hipSuccess || per_cu < 1) { fprintf(stderr, "kernel_launch: occupancy query says %d\n", per_cu); per_cu = 1; }
        (void)hipGetLastError();
        grid = cus * (per_cu < 1 ? 1 : 1);
    }
    if (grid < 0) return;
    Args a{};
    for (int i = 0; i < 27; ++i) a.in[i] = (const float*)d_in[i];
    a.out = (float*)d_out; a.ws = (unsigned char*)d_ws;
    if (MK_N_LAUNCHES == 1) {
        a.ph_lo = 0; a.ph_hi = NPH;
        void* kargs[] = {&a};
        hipError_t e = hipLaunchCooperativeKernel((const void*)mk_fwd, dim3(grid), dim3(NWAVES * 64), kargs, LDS_BYTES, stream);
        if (e != hipSuccess) fprintf(stderr, "kernel_launch: cooperative launch failed: %s (grid %d)\n", hipGetErrorString(e), grid);
    } else {
        for (int ph = 0; ph < NPH; ++ph) { a.ph_lo = ph; a.ph_hi = ph + 1; hipLaunchKernelGGL(mk_fwd, dim3(grid), dim3(NWAVES * 64), LDS_BYTES, stream, a); }
    }
}
```

```cpp
#include <hip/hip_runtime.h>
#include <hip/hip_cooperative_groups.h>
#include <cstdio>
#include <cstdint>
namespace cg = cooperative_groups;

#ifndef MK_N_LAUNCHES
#define MK_N_LAUNCHES 1
#endif

namespace pg8 {
#define PG8_LAS __attribute__((address_space(3)))
typedef unsigned short bf16_t;
typedef short bf16x8 __attribute__((ext_vector_type(8)));
typedef float f32x4 __attribute__((ext_vector_type(4)));
typedef unsigned u32x4 __attribute__((ext_vector_type(4)));
constexpr int BM = 256, BK = 64, HALF = 128, HTB = HALF * BK * 2, STAGE_BYTES = 8 * HTB, NXCD = 8, WGM = 8;

__host__ __device__ __forceinline__ int lds_byte(int r, int c) { const int st = (r >> 4) * 2 + (c >> 5), rr = r & 15, cc = c & 31, ob = rr * 64 + cc * 2; return st * 1024 + (ob ^ (((ob >> 9) & 1) << 5)); }
__host__ __device__ __forceinline__ void stage_rc(int b, int& R, int& C) { const int st = b / 1024, sb = b % 1024, swz = sb ^ (((sb >> 9) & 1) << 5); R = (st >> 1) * 16 + swz / 64; C = (st & 1) * 32 + (swz % 64) / 2; }
__host__ __device__ __forceinline__ int perm32(int rho) { const int n = rho >> 4, i = rho & 15; return 8 * (i >> 2) + 4 * n + (i & 3); }

struct Unit { int pm, pn, ks, seg; };
struct Gemm { const bf16_t* A; const bf16_t* Bt; int M, N, K, ld; const bf16_t* A2; const bf16_t* Bt2; };

struct StaticOrder {
    static constexpr bool SINGLE = false;
    int nM, nN, nwg, G, c;
    __host__ __device__ void init(int M, int N, int G_, int c_) { nM = M / BM; nN = N / BM; nwg = nM * nN; G = G_; c = c_; }
    __host__ __device__ bool next(int i, Unit& u) const {
        const long L = (long)i * G + c; if (L >= nwg) return false;
        int wgid = (int)L; { const int q = nwg / NXCD, r = nwg % NXCD, xcd = wgid % NXCD, off = wgid / NXCD; wgid = (xcd < r ? xcd * (q + 1) : r * (q + 1) + (xcd - r) * q) + off; }
        const int nig = WGM * nN, gid = wgid / nig, fm = gid * WGM, gsz = (nM - fm) < WGM ? (nM - fm) : WGM;
        u.pm = fm + ((wgid % nig) % gsz); u.pn = (wgid % nig) / gsz; u.ks = 0; u.seg = 0; return true;
    }
};
struct TwoSegOrder : StaticOrder {
    __host__ __device__ bool next(int i, Unit& u) const { if (!StaticOrder::next(i >> 1, u)) return false; u.seg = i & 1; return true; }
};
struct CmpOrder {
    static constexpr bool SINGLE = true;
    int G, c, KS;
    __host__ __device__ bool next(int i, Unit& u) const {
        const int L = i * G + c; if (L >= 32 * KS) return false;
        const int tile = L / KS; u.ks = L % KS; u.pm = tile >> 1; u.pn = (tile & 1) + (u.pm >= 8 ? 2 : 0); u.seg = 0; return true;
    }
};

typedef float f32x2_t __attribute__((ext_vector_type(2))); typedef __bf16 bf16x2_t __attribute__((ext_vector_type(2)));
__device__ __forceinline__ unsigned cvt_pk_bf16(float lo, float hi) { f32x2_t v = {lo, hi}; bf16x2_t b = __builtin_convertvector(v, bf16x2_t); return __builtin_bit_cast(unsigned, b); }
__device__ __forceinline__ float bflo(unsigned w) { return __uint_as_float(w << 16); }
__device__ __forceinline__ float bfhi(unsigned w) { return __uint_as_float(w & 0xffff0000u); }
__device__ __forceinline__ float sigm(float x) { return __builtin_amdgcn_rcpf(1.0f + __expf(-x)); }

template <class Epi, class Sched>
__device__ __forceinline__ void gemm_phase(PG8_LAS unsigned char* lds, const Gemm g, const Sched& S, const Epi& E) {
    const int tid = threadIdx.x, wid = __builtin_amdgcn_readfirstlane(tid >> 6), lane = tid & 63, wr = wid >> 2, wc = wid & 3, fr = lane & 15, fq = lane >> 4;
    const int K = g.K, ld = g.ld, nt = K / BK;
    unsigned voffA[2], voffB[2];
#pragma unroll
    for (int i = 0; i < 2; ++i) { int R, C; stage_rc(tid * 16 + i * 8192, R, C); const int Rb = Epi::PERM ? ((R & ~31) + perm32(R & 31)) : R;
        voffA[i] = (unsigned)(R * ld + C) * 2u; voffB[i] = (unsigned)(Rb * ld + C) * 2u; }
    const size_t kstep = (size_t)(BK * 2);
    const size_t hstep = (size_t)HALF * ld * 2;
    const size_t tstep = 2 * hstep;
    const unsigned ldsw = (unsigned)wid * 1024u;
    const int aoff = lds_byte(wr * 64 + fr, fq * 8), boff = lds_byte(wc * 32 + fr, fq * 8);
#define PG8_SA(b, h) (((b) * 2 + (h)) * HTB)
#define PG8_SB(b, h) ((4 + (b) * 2 + (h)) * HTB)
#define PG8_STAGE(bufoff, gbase, voff) do { _Pragma("unroll") for (int _i = 0; _i < 2; ++_i) \
        __builtin_amdgcn_global_load_lds((const unsigned*)((const char*)(gbase) + (voff)[_i]), (PG8_LAS unsigned*)(lds + (bufoff) + ldsw + _i * 8192), 16, 0, 0); } while (0)
#define PG8_LDA(dst, b, h) do { _Pragma("unroll") for (int m = 0; m < 4; ++m) _Pragma("unroll") for (int k = 0; k < 2; ++k) dst[m][k] = *(const PG8_LAS bf16x8*)(lds + PG8_SA(b, h) + aoff + m * 2048 + k * 1024); } while (0)
#define PG8_LDB(dst, b, h) do { _Pragma("unroll") for (int n = 0; n < 2; ++n) _Pragma("unroll") for (int k = 0; k < 2; ++k) dst[n][k] = *(const PG8_LAS bf16x8*)(lds + PG8_SB(b, h) + boff + n * 2048 + k * 1024); } while (0)
#define PG8_MMA(ai, bj, At, Bt) do { __builtin_amdgcn_s_setprio(1); _Pragma("unroll") for (int m = 0; m < 4; ++m) _Pragma("unroll") for (int n = 0; n < 2; ++n) _Pragma("unroll") for (int k = 0; k < 2; ++k) \
        acc[ai][bj][m][n] = __builtin_amdgcn_mfma_f32_16x16x32_bf16(Bt[n][k], At[m][k], acc[ai][bj][m][n], 0, 0, 0); __builtin_amdgcn_s_setprio(0); } while (0)
#define PG8_WAIT_V(n) asm volatile("s_waitcnt vmcnt(" #n ")" ::: "memory")
#define PG8_WAIT_L(n) asm volatile("s_waitcnt lgkmcnt(" #n ")" ::: "memory")
#define PG8_BAR __builtin_amdgcn_s_barrier()
#define PG8_SCHED __builtin_amdgcn_sched_barrier(0)
    Unit cur, nxt; int ui = 0;
    if (!S.next(0, cur)) return;
    f32x4 acc[2][2][4][2];
#pragma unroll
    for (int a = 0; a < 2; ++a)
#pragma unroll
        for (int b = 0; b < 2; ++b)
#pragma unroll
            for (int m = 0; m < 4; ++m)
#pragma unroll
                for (int n = 0; n < 2; ++n) acc[a][b][m][n] = (f32x4){0.f, 0.f, 0.f, 0.f};
    bf16x8 At[4][2], B0[2][2], B1[2][2];
    const char* cA = (const char*)(cur.seg ? g.A2 : g.A) + (size_t)cur.pm * tstep + (size_t)cur.ks * K * 2; const char* cB = (const char*)(cur.seg ? g.Bt2 : g.Bt) + (size_t)cur.pn * tstep + (size_t)cur.ks * K * 2;
    PG8_STAGE(PG8_SB(0, 0), cB, voffB); PG8_STAGE(PG8_SB(0, 1), cB + hstep, voffB); PG8_STAGE(PG8_SA(0, 0), cA, voffA); PG8_STAGE(PG8_SA(0, 1), cA + hstep, voffA);
    if (wr == 1) PG8_BAR;
    PG8_WAIT_V(2); PG8_BAR;
    PG8_STAGE(PG8_SB(1, 0), cB + kstep, voffB); PG8_STAGE(PG8_SA(1, 0), cA + kstep, voffA); PG8_STAGE(PG8_SB(1, 1), cB + hstep + kstep, voffB);
    PG8_WAIT_V(6); PG8_BAR;
    for (;;) {
        const bool has_next = Sched::SINGLE ? false : S.next(ui + 1, nxt);
        const char* nA = has_next ? (const char*)(nxt.seg ? g.A2 : g.A) + (size_t)nxt.pm * tstep + (size_t)nxt.ks * K * 2 : cA; const char* nB = has_next ? (const char*)(nxt.seg ? g.Bt2 : g.Bt) + (size_t)nxt.pn * tstep + (size_t)nxt.ks * K * 2 : cB;
        for (int t = 0; t < nt; t += 2) {
            const bool last = (t == nt - 2);
            const char* a1 = cA + (size_t)(t + 1) * kstep;
            const char* a2 = last ? nA : cA + (size_t)(t + 2) * kstep; const char* b2 = last ? nB : cB + (size_t)(t + 2) * kstep;
            const char* a3 = a2 + kstep; const char* b3 = b2 + kstep;
            PG8_LDB(B0, 0, 0); PG8_LDB(B1, 0, 1); PG8_SCHED; PG8_LDA(At, 0, 0); PG8_STAGE(PG8_SA(1, 1), a1 + hstep, voffA);
            PG8_WAIT_V(8); PG8_WAIT_L(0); PG8_BAR; PG8_MMA(0, 0, At, B0); PG8_MMA(0, 1, At, B1); PG8_BAR; PG8_SCHED;
            PG8_LDA(At, 0, 1); PG8_STAGE(PG8_SB(0, 0), b2, voffB); PG8_STAGE(PG8_SB(0, 1), b2 + hstep, voffB); PG8_STAGE(PG8_SA(0, 0), a2, voffA);
            PG8_WAIT_V(8); PG8_WAIT_L(0); PG8_BAR; PG8_MMA(1, 0, At, B0); PG8_MMA(1, 1, At, B1); PG8_BAR; PG8_SCHED;
            PG8_LDB(B0, 1, 0); PG8_LDB(B1, 1, 1); PG8_SCHED; PG8_LDA(At, 1, 0); PG8_STAGE(PG8_SA(0, 1), a2 + hstep, voffA);
            PG8_WAIT_V(8); PG8_WAIT_L(0); PG8_BAR; PG8_MMA(0, 0, At, B0); PG8_MMA(0, 1, At, B1); PG8_BAR; PG8_SCHED;
            PG8_LDA(At, 1, 1); PG8_STAGE(PG8_SB(1, 0), b3, voffB); PG8_STAGE(PG8_SB(1, 1), b3 + hstep, voffB); PG8_STAGE(PG8_SA(1, 0), a3, voffA);
            PG8_WAIT_V(8); PG8_WAIT_L(0); PG8_BAR; PG8_MMA(1, 0, At, B0); PG8_MMA(1, 1, At, B1); PG8_BAR; PG8_SCHED;
        }
        if (wr == 0) PG8_BAR;
        E(acc, cur, wr, wc, fr, fq);
        if (!has_next) break;
        if (!nxt.seg) {
#pragma unroll
        for (int a = 0; a < 2; ++a)
#pragma unroll
            for (int b = 0; b < 2; ++b)
#pragma unroll
                for (int m = 0; m < 4; ++m)
#pragma unroll
                    for (int n = 0; n < 2; ++n) acc[a][b][m][n] = (f32x4){0.f, 0.f, 0.f, 0.f}; }
        cur = nxt; cA = nA; cB = nB; ++ui;
        if (wr == 1) PG8_BAR;
    }
    PG8_WAIT_V(0);
    PG8_BAR;
#undef PG8_SA
#undef PG8_SB
#undef PG8_STAGE
#undef PG8_LDA
#undef PG8_LDB
#undef PG8_MMA
#undef PG8_WAIT_V
#undef PG8_WAIT_L
#undef PG8_BAR
#undef PG8_SCHED
}
}

constexpr int S = 16384, DM = 1024, INC = 3864, NPJ = 4096, SSW = 512, NSW = 512, HD = 64, DFF = 2816;
constexpr int NGRP = 32, NST = 64, NCMP = 1023;
constexpr int NWAVES = 8;
constexpr int NPH = 12;
constexpr int CMP_KS = 4;
constexpr float EPS = 1e-6f;

constexpr size_t MiB = 1u << 20;
constexpr size_t WS_CTL = 0;
constexpr size_t WS_TAB = 1 * MiB;
constexpr size_t TAB_BF = 0, TAB_CF = 128 * 1024, TAB_LAM = 256 * 1024, TAB_LAM256 = 272 * 1024, TAB_POSB = 288 * 1024;
constexpr size_t WS_SSP = 1 * MiB + 512 * 1024;
constexpr size_t WS_F = 2 * MiB;
constexpr size_t WS_KVC = 3 * MiB;
constexpr size_t WS_WIN = 4 * MiB, WS_WGU = 12 * MiB, WS_WD = 23 * MiB, WS_WOUT = 29 * MiB, WS_WA = 31 * MiB, WS_WB = 32 * MiB, WS_WGLU = 33 * MiB, WS_WC1 = 34 * MiB;
constexpr size_t WS_XN = 36 * MiB;
constexpr size_t WS_Z = WS_XN, WS_ZG = WS_XN + 16 * MiB;
constexpr size_t WS_U = 68 * MiB, WS_O = WS_U;
constexpr size_t WS_Q = 84 * MiB;
constexpr size_t WS_KVH = 100 * MiB;
constexpr size_t WS_G = 124 * MiB;
constexpr size_t WS_GN = 188 * MiB;
constexpr size_t WS_MIX = 84 * MiB;
constexpr size_t WS_H = 100 * MiB;
constexpr size_t WS_VTW = 189 * MiB;
constexpr size_t WS_VTS = 193 * MiB;
constexpr size_t WS_KCB = 197 * MiB;
constexpr size_t WS_VTC = 197 * MiB + 512 * 1024;
constexpr size_t WS_PSLAB = 198 * MiB;
constexpr size_t WS_END = 254 * MiB;

constexpr int LDS_BYTES = 163840;

#define GAS __attribute__((address_space(1)))
#define LAS __attribute__((address_space(3)))
typedef unsigned short bf16;
typedef unsigned v4u __attribute__((ext_vector_type(4)));
typedef float f32x4 __attribute__((ext_vector_type(4)));
typedef float f32x2 __attribute__((ext_vector_type(2)));
typedef float f32x16 __attribute__((ext_vector_type(16)));
typedef short bf16x8 __attribute__((ext_vector_type(8)));
#define LDS_WAIT() asm volatile("s_waitcnt lgkmcnt(0)" ::: "memory")
#define VM_WAIT() asm volatile("s_waitcnt vmcnt(0)" ::: "memory")
__device__ __forceinline__ unsigned f2bf(float f) { unsigned u = __builtin_bit_cast(unsigned, f); return (u + 0x7fffu + ((u >> 16) & 1u)) >> 16; }
__device__ __forceinline__ unsigned pk2(float lo, float hi) { return f2bf(lo) | (f2bf(hi) << 16); }
__device__ __forceinline__ float bf2f(bf16 v) { return __uint_as_float((unsigned)v << 16); }
using pg8::bflo; using pg8::bfhi; using pg8::sigm; using pg8::cvt_pk_bf16;
__device__ __forceinline__ float gelu_tanh(float y) {
    const float a = 0.7978845608028654f * (y + 0.044715f * y * y * y);
    const float e = __expf(2.0f * a);
    const float th = 1.0f - 2.0f * __builtin_amdgcn_rcpf(e + 1.0f);
    return 0.5f * y * (1.0f + th);
}
__device__ __forceinline__ float wave_sum(float v) {
#pragma unroll
    for (int o = 1; o < 64; o <<= 1) v += __shfl_xor(v, o);
    return v;
}
__device__ __forceinline__ float wave_max(float v) {
#pragma unroll
    for (int o = 1; o < 64; o <<= 1) v = fmaxf(v, __shfl_xor(v, o));
    return v;
}

struct Args { const float* in[27]; float* out; unsigned char* ws; int ph_lo, ph_hi; };

struct Frame {
    LAS unsigned char* lds;
    int tid, lane, wave, G, gw, ngw;
    float* out; unsigned char* ws;
};

using pg8::Unit; using pg8::BM; using pg8::HALF;
struct EpiProj {
    static constexpr bool PERM = true;
    bf16 *U, *Q, *KVH, *Gt, *GN;
    __device__ __forceinline__ void operator()(const f32x4 (&acc)[2][2][4][2], const Unit& u, int wr, int wc, int fr, int fq) const {
        const int row0 = u.pm * BM + wr * 64 + fr, pn = u.pn;
#pragma unroll
        for (int ai = 0; ai < 2; ++ai)
#pragma unroll
            for (int m = 0; m < 4; ++m) { const int row = row0 + ai * HALF + m * 16;
#pragma unroll
                for (int bj = 0; bj < 2; ++bj) { f32x4 v0 = acc[ai][bj][m][0], v1 = acc[ai][bj][m][1]; const int col = bj * HALF + wc * 32 + 8 * fq; bf16* dst;
                    if (pn < 2) dst = U + (size_t)row * 512 + pn * 256 + col;
                    else if (pn < 4) { v0 = v0 * (0.125f * 1.4426950408889634f); v1 = v1 * (0.125f * 1.4426950408889634f); dst = Q + (size_t)row * 512 + (pn - 2) * 256 + col; }
                    else if (pn < 7) dst = KVH + ((size_t)((pn - 4) * 4 + (col >> 6)) * S + row) * 64 + (col & 63);
                    else { v0 = (f32x4){sigm(v0[0]), sigm(v0[1]), sigm(v0[2]), sigm(v0[3])}; v1 = (f32x4){sigm(v1[0]), sigm(v1[1]), sigm(v1[2]), sigm(v1[3])};
                        if (pn < 15) dst = Gt + (size_t)row * 2048 + (pn - 7) * 256 + col; else { if (col >= 32) continue; dst = GN + (size_t)row * 32 + col; } }
                    v4u w; w.x = cvt_pk_bf16(v0[0], v0[1]); w.y = cvt_pk_bf16(v0[2], v0[3]); w.z = cvt_pk_bf16(v1[0], v1[1]); w.w = cvt_pk_bf16(v1[2], v1[3]);
                    *(v4u*)dst = w; } }
    }
};
struct EpiCmp {
    static constexpr bool PERM = false;
    float* C;
    __device__ __forceinline__ void operator()(const f32x4 (&acc)[2][2][4][2], const Unit& u, int wr, int wc, int fr, int fq) const {
        const int row0 = u.pm * BM + wr * 64 + fr, col0 = (u.pn & 1) * BM + wc * 32 + 4 * fq; float* base = C + (size_t)u.ks * 4096 * 512;
#pragma unroll
        for (int ai = 0; ai < 2; ++ai)
#pragma unroll
            for (int m = 0; m < 4; ++m) { float* rowp = base + (size_t)(row0 + ai * HALF + m * 16) * 512 + col0;
#pragma unroll
                for (int bj = 0; bj < 2; ++bj)
#pragma unroll
                    for (int n = 0; n < 2; ++n) *(f32x4*)(rowp + bj * HALF + n * 16) = acc[ai][bj][m][n]; }
    }
};
struct EpiGlu {
    static constexpr bool PERM = true;
    const bf16* Z; bf16* ZG;
    __device__ __forceinline__ void operator()(const f32x4 (&acc)[2][2][4][2], const Unit& u, int wr, int wc, int fr, int fq) const {
        const int row0 = u.pm * BM + wr * 64 + fr;
#pragma unroll
        for (int ai = 0; ai < 2; ++ai)
#pragma unroll
            for (int m = 0; m < 4; ++m) { const int row = row0 + ai * HALF + m * 16;
#pragma unroll
                for (int bj = 0; bj < 2; ++bj) { const f32x4 v0 = acc[ai][bj][m][0], v1 = acc[ai][bj][m][1]; const size_t off = (size_t)row * 512 + u.pn * BM + bj * HALF + wc * 32 + 8 * fq;
                    const v4u z = *(const v4u*)(Z + off); v4u w;
                    w.x = cvt_pk_bf16(bflo(z.x) * sigm(v0[0]), bfhi(z.x) * sigm(v0[1])); w.y = cvt_pk_bf16(bflo(z.y) * sigm(v0[2]), bfhi(z.y) * sigm(v0[3]));
                    w.z = cvt_pk_bf16(bflo(z.z) * sigm(v1[0]), bfhi(z.z) * sigm(v1[1])); w.w = cvt_pk_bf16(bflo(z.w) * sigm(v1[2]), bfhi(z.w) * sigm(v1[3]));
                    *(v4u*)(ZG + off) = w; } }
    }
};
struct EpiMix2 {
    static constexpr bool PERM = true;
    const bf16* Gt; bf16* MIX;
    __device__ __forceinline__ void operator()(f32x4 (&acc)[2][2][4][2], const Unit& u, int wr, int wc, int fr, int fq) const {
        const int row0 = u.pm * BM + wr * 64 + fr;
#pragma unroll
        for (int ai = 0; ai < 2; ++ai)
#pragma unroll
            for (int m = 0; m < 4; ++m) { const int row = row0 + ai * HALF + m * 16;
#pragma unroll
                for (int bj = 0; bj < 2; ++bj) { const int col = u.pn * BM + bj * HALF + wc * 32 + 8 * fq;
                    const v4u gb = *(const v4u*)(Gt + (size_t)row * 2048 + 1024 + col);
                    const float b8[8] = {bflo(gb.x), bfhi(gb.x), bflo(gb.y), bfhi(gb.y), bflo(gb.z), bfhi(gb.z), bflo(gb.w), bfhi(gb.w)};
                    if (u.seg == 0) { const v4u ga = *(const v4u*)(Gt + (size_t)row * 2048 + col);
                        const float a8[8] = {bflo(ga.x), bfhi(ga.x), bflo(ga.y), bfhi(ga.y), bflo(ga.z), bfhi(ga.z), bflo(ga.w), bfhi(ga.w)};
#pragma unroll
                        for (int e = 0; e < 4; ++e) { acc[ai][bj][m][0][e] *= a8[e] * __builtin_amdgcn_rcpf(b8[e]); acc[ai][bj][m][1][e] *= a8[4 + e] * __builtin_amdgcn_rcpf(b8[4 + e]); }
                    } else { const f32x4 v0 = acc[ai][bj][m][0], v1 = acc[ai][bj][m][1]; v4u w;
                        w.x = cvt_pk_bf16(v0[0] * b8[0], v0[1] * b8[1]); w.y = cvt_pk_bf16(v0[2] * b8[2], v0[3] * b8[3]); w.z = cvt_pk_bf16(v1[0] * b8[4], v1[1] * b8[5]); w.w = cvt_pk_bf16(v1[2] * b8[6], v1[3] * b8[7]);
                        *(v4u*)(MIX + (size_t)row * 1024 + col) = w; } } }
    }
};
struct EpiRes {
    static constexpr bool PERM = false;
    const float* base; float* out;
    __device__ __forceinline__ void operator()(const f32x4 (&acc)[2][2][4][2], const Unit& u, int wr, int wc, int fr, int fq) const {
        const int row0 = u.pm * BM + wr * 64 + fr, col0 = u.pn * BM + wc * 32 + 4 * fq;
#pragma unroll
        for (int ai = 0; ai < 2; ++ai)
#pragma unroll
            for (int m = 0; m < 4; ++m) { const size_t off = (size_t)(row0 + ai * HALF + m * 16) * 1024 + col0;
#pragma unroll
                for (int bj = 0; bj < 2; ++bj)
#pragma unroll
                    for (int n = 0; n < 2; ++n) { const f32x4 b = *(const f32x4*)(base + off + bj * HALF + n * 16); *(f32x4*)(out + off + bj * HALF + n * 16) = b + acc[ai][bj][m][n]; } }
    }
};
struct EpiResNorm {
    static constexpr bool PERM = false;
    const float* base; float* out; bf16* XN; float* SSP; LAS float* part;
    __device__ __forceinline__ void operator()(const f32x4 (&acc)[2][2][4][2], const Unit& u, int wr, int wc, int fr, int fq) const {
        const int row0 = u.pm * BM + wr * 64 + fr, col0 = u.pn * BM + wc * 32 + 4 * fq;
#pragma unroll
        for (int ai = 0; ai < 2; ++ai)
#pragma unroll
            for (int m = 0; m < 4; ++m) { const size_t off = (size_t)(row0 + ai * HALF + m * 16) * 1024 + col0; float ss = 0.f;
#pragma unroll
                for (int bj = 0; bj < 2; ++bj)
#pragma unroll
                    for (int n = 0; n < 2; ++n) { const f32x4 b = *(const f32x4*)(base + off + bj * HALF + n * 16); const f32x4 x1 = b + acc[ai][bj][m][n]; *(f32x4*)(out + off + bj * HALF + n * 16) = x1;
                        *(unsigned long long*)(XN + off + bj * HALF + n * 16) = (unsigned long long)cvt_pk_bf16(x1[0], x1[1]) | ((unsigned long long)cvt_pk_bf16(x1[2], x1[3]) << 32);
                        ss += (x1[0] * x1[0] + x1[1] * x1[1]) + (x1[2] * x1[2] + x1[3] * x1[3]); }
                ss += __shfl_xor(ss, 16); ss += __shfl_xor(ss, 32);
                if (fq == 0) part[(ai * HALF + wr * 64 + m * 16 + fr) * 4 + wc] = ss; }
        asm volatile("s_waitcnt lgkmcnt(0)" ::: "memory"); __builtin_amdgcn_s_barrier(); asm volatile("" ::: "memory");
        if (threadIdx.x < 256) { const f32x4 p = *(const LAS f32x4*)(part + threadIdx.x * 4); SSP[(size_t)(u.pm * BM + threadIdx.x) * 4 + u.pn] = (p[0] + p[1]) + (p[2] + p[3]); }
    }
};
struct EpiFfn {
    static constexpr bool PERM = true;
    bf16* H; const float* SSP;
    __device__ __forceinline__ void operator()(const f32x4 (&acc)[2][2][4][2], const Unit& u, int wr, int wc, int fr, int fq) const {
        const int row0 = u.pm * BM + wr * 64 + fr;
#pragma unroll
        for (int ai = 0; ai < 2; ++ai)
#pragma unroll
            for (int m = 0; m < 4; ++m) { const int row = row0 + ai * HALF + m * 16;
                const f32x4 sp = *(const f32x4*)(SSP + (size_t)row * 4); const float rs = 1.0f / sqrtf(((sp[0] + sp[1]) + (sp[2] + sp[3])) * (1.f / 1024.f) + 1e-6f);
                float r[8];
#pragma unroll
                for (int n = 0; n < 2; ++n)
#pragma unroll
                    for (int e = 0; e < 4; ++e) { const float gt = acc[ai][0][m][n][e] * rs, up = acc[ai][1][m][n][e] * rs; r[n * 4 + e] = gt * sigm(gt) * up; }
                v4u w; w.x = cvt_pk_bf16(r[0], r[1]); w.y = cvt_pk_bf16(r[2], r[3]); w.z = cvt_pk_bf16(r[4], r[5]); w.w = cvt_pk_bf16(r[6], r[7]);
                *(v4u*)(H + (size_t)row * DFF + u.pn * HALF + wc * 32 + 8 * fq) = w; }
    }
};

struct TrDesc { const float* src; bf16* dst; int ld, ncols, dld, drow, kb, nb; const float* gain; };
__device__ __forceinline__ void tr_load(const TrDesc& d, float (&v)[32], int lane) {
    const int k0 = 64 * d.kb, c = 32 * d.nb + (lane & 31); const bool ok = c < d.ncols; const float* p = d.src + (size_t)(k0 + (lane >> 5)) * d.ld + c;
#pragma unroll
    for (int i = 0; i < 32; ++i) v[i] = ok ? p[(size_t)(2 * i) * d.ld] : 0.f;
    if (d.gain) {
#pragma unroll
        for (int i = 0; i < 32; ++i) v[i] *= d.gain[k0 + 2 * i + (lane >> 5)]; }
}
__device__ __forceinline__ void tr_finish(const TrDesc& d, const float (&v)[32], LAS float* scr, int lane) {
#pragma unroll
    for (int i = 0; i < 32; ++i) scr[(2 * i + (lane >> 5)) * 33 + (lane & 31)] = v[i];
    LDS_WAIT();
    const int cc = lane & 7, k0 = 64 * d.kb;
#pragma unroll
    for (int j = 0; j < 4; ++j) { const int n = (lane >> 3) + 8 * j; const LAS float* s = scr + (8 * cc) * 33 + n;
        v4u o; o.x = pk2(s[0 * 33], s[1 * 33]); o.y = pk2(s[2 * 33], s[3 * 33]); o.z = pk2(s[4 * 33], s[5 * 33]); o.w = pk2(s[6 * 33], s[7 * 33]);
        *(v4u*)(d.dst + (size_t)(d.drow + n) * d.dld + k0 + 8 * cc) = o; }
    LDS_WAIT();
}
__device__ __forceinline__ void rms_row_to_bf16(const float* xrow, const float* gain, bf16* orow, int lane) {
    const f32x4* xr = (const f32x4*)xrow + lane; const f32x4* gr = (const f32x4*)gain + lane;
    f32x4 v[4]; float s = 0.f;
#pragma unroll
    for (int j = 0; j < 4; ++j) { v[j] = xr[64 * j]; s += (v[j].x * v[j].x + v[j].y * v[j].y) + (v[j].z * v[j].z + v[j].w * v[j].w); }
    const float rstd = 1.0f / sqrtf(wave_sum(s) * (1.f / DM) + EPS);
    unsigned long long* o8 = (unsigned long long*)orow + lane;
#pragma unroll
    for (int j = 0; j < 4; ++j) { const f32x4 gq = gr[64 * j];
        o8[64 * j] = (unsigned long long)pk2(v[j].x * rstd * gq.x, v[j].y * rstd * gq.y) | ((unsigned long long)pk2(v[j].z * rstd * gq.z, v[j].w * rstd * gq.w) << 32); }
}
__device__ __forceinline__ void rms_rows2_to_bf16(const float* x0, const float* x1, const float* gain, bf16* o0, bf16* o1, int lane) {
    const f32x4* xa = (const f32x4*)x0 + lane; const f32x4* xb = (const f32x4*)x1 + lane; const f32x4* gr = (const f32x4*)gain + lane;
    f32x4 va[4], vb[4]; float sa = 0.f, sb = 0.f;
#pragma unroll
    for (int j = 0; j < 4; ++j) { va[j] = xa[64 * j]; vb[j] = xb[64 * j]; }
#pragma unroll
    for (int j = 0; j < 4; ++j) { sa += (va[j].x * va[j].x + va[j].y * va[j].y) + (va[j].z * va[j].z + va[j].w * va[j].w); sb += (vb[j].x * vb[j].x + vb[j].y * vb[j].y) + (vb[j].z * vb[j].z + vb[j].w * vb[j].w); }
    const float ra = 1.0f / sqrtf(wave_sum(sa) * (1.f / DM) + EPS), rb = 1.0f / sqrtf(wave_sum(sb) * (1.f / DM) + EPS);
    unsigned long long* pa = (unsigned long long*)o0 + lane; unsigned long long* pb = (unsigned long long*)o1 + lane;
#pragma unroll
    for (int j = 0; j < 4; ++j) { const f32x4 gq = gr[64 * j];
        pa[64 * j] = (unsigned long long)pk2(va[j].x * ra * gq.x, va[j].y * ra * gq.y) | ((unsigned long long)pk2(va[j].z * ra * gq.z, va[j].w * ra * gq.w) << 32);
        pb[64 * j] = (unsigned long long)pk2(vb[j].x * rb * gq.x, vb[j].y * rb * gq.y) | ((unsigned long long)pk2(vb[j].z * rb * gq.z, vb[j].w * rb * gq.w) << 32); }
}
__device__ __forceinline__ void rms_row_f32(float* xrow, const float* gain, int lane) {
    f32x4* xr = (f32x4*)xrow + lane; const f32x4* gr = (const f32x4*)gain + lane;
    f32x4 v[4]; float s = 0.f;
#pragma unroll
    for (int j = 0; j < 4; ++j) { v[j] = xr[64 * j]; s += (v[j].x * v[j].x + v[j].y * v[j].y) + (v[j].z * v[j].z + v[j].w * v[j].w); }
    const float rstd = 1.0f / sqrtf(wave_sum(s) * (1.f / DM) + EPS);
#pragma unroll
    for (int j = 0; j < 4; ++j) { const f32x4 gq = gr[64 * j]; xr[64 * j] = v[j] * rstd * gq; }
}
__device__ __forceinline__ void s5_tables(const Frame& F, const Args& args, int g) {
    const int lane = F.lane;
    const float* are = args.in[3]; const float* aim = args.in[4]; const float* ldt = args.in[5]; const float* bre = args.in[6]; const float* bim = args.in[7]; const float* cre = args.in[8]; const float* cim = args.in[9];
    const double dt = exp((double)ldt[g]);
    {   const int p = lane; const double ar = are[g * 64 + p], ai = aim[g * 64 + p];
        const double er = exp(ar * dt), lr = er * cos(ai * dt), li = er * sin(ai * dt);
        ((f32x2*)(F.ws + WS_TAB + TAB_LAM))[g * 64 + p] = (f32x2){(float)lr, (float)li};
        const double e2 = exp(ar * dt * 256.0), l2r = e2 * cos(ai * dt * 256.0), l2i = e2 * sin(ai * dt * 256.0);
        ((f32x2*)(F.ws + WS_TAB + TAB_LAM256))[g * 64 + p] = (f32x2){(float)l2r, (float)l2i}; }
#pragma unroll
    for (int nt = 0; nt < 4; ++nt) { const int col = 32 * nt + (lane & 31), p = col >> 1, ri = col & 1;
        const double ar = are[g * 64 + p], ai = aim[g * 64 + p];
        const double er = exp(ar * dt), lr = er * cos(ai * dt) - 1.0, li = er * sin(ai * dt);
        const double den = ar * ar + ai * ai, kr = (lr * ar + li * ai) / den, ki = (li * ar - lr * ai) / den;
        float v[8];
#pragma unroll
        for (int j = 0; j < 8; ++j) { const int c = 8 * (lane >> 5) + j; const double br = bre[(g * 64 + p) * 16 + c], bi = bim[(g * 64 + p) * 16 + c];
            v[j] = (float)(ri ? (kr * bi + ki * br) : (kr * br - ki * bi)); }
        v4u o; o.x = pk2(v[0], v[1]); o.y = pk2(v[2], v[3]); o.z = pk2(v[4], v[5]); o.w = pk2(v[6], v[7]);
        ((v4u*)(F.ws + WS_TAB + TAB_BF))[(g * 4 + nt) * 64 + lane] = o; }
#pragma unroll
    for (int ks = 0; ks < 4; ++ks) { const int ch = lane & 15; float v[8];
#pragma unroll
        for (int j = 0; j < 8; ++j) { const int k = 32 * ks + 8 * (lane >> 4) + j, p = k >> 1, ri = k & 1; v[j] = ri ? -cim[(g * 16 + ch) * 64 + p] : cre[(g * 16 + ch) * 64 + p]; }
        v4u o; o.x = pk2(v[0], v[1]); o.y = pk2(v[2], v[3]); o.z = pk2(v[4], v[5]); o.w = pk2(v[6], v[7]);
        ((v4u*)(F.ws + WS_TAB + TAB_CF))[(g * 4 + ks) * 64 + lane] = o; }
}
__device__ __forceinline__ void p0_prologue(const Frame& F, const Args& args) {
    LAS float* scr = (LAS float*)(F.lds + F.wave * 16384);
    const int gw = F.gw, NGW = F.ngw, lane = F.lane;
    if (F.wave == 0 && blockIdx.x < 32) s5_tables(F, args, (int)blockIdx.x);
    else if (F.wave == 1 && blockIdx.x < 128) {
        const int it = (int)blockIdx.x, kv = it >> 6, part = (it >> 2) & 15, cgp = it & 3;
        const float* pos = kv ? args.in[14] : args.in[13]; const float* w1 = kv ? args.in[17] : args.in[15]; float a = 0.f;
#pragma unroll 1
        for (int r0 = 128 * part; r0 < 128 * part + 128; r0 += 32) { float wv[32];
#pragma unroll
            for (int i = 0; i < 32; ++i) wv[i] = w1[(size_t)(r0 + i) * 256 + cgp * 64 + lane];
#pragma unroll
            for (int i = 0; i < 32; ++i) a += pos[r0 + i] * wv[i]; }
        ((float*)(F.ws + WS_TAB + TAB_POSB))[(kv * 16 + part) * 256 + cgp * 64 + lane] = a;
    }
    { v4u* z = (v4u*)(F.ws + WS_WIN + (size_t)3872 * 1024 * 2); const int n16 = 224 * 1024 * 2 / 16;
      for (int i = blockIdx.x * 512 + F.tid; i < n16; i += F.G * 512) z[i] = (v4u){0u, 0u, 0u, 0u}; }
    bf16* WIN = (bf16*)(F.ws + WS_WIN); bf16* WGU = (bf16*)(F.ws + WS_WGU); bf16* WD = (bf16*)(F.ws + WS_WD); bf16* WOUT = (bf16*)(F.ws + WS_WOUT);
    bf16* WA = (bf16*)(F.ws + WS_WA); bf16* WB = (bf16*)(F.ws + WS_WB); bf16* WGLU = (bf16*)(F.ws + WS_WGLU); bf16* WC1 = (bf16*)(F.ws + WS_WC1);
    constexpr int I1 = 16 * 56, I2 = 16 * 64, I3 = 16, IGLU = 8 * 16, IUP = 8 * 32, IOUT = 16 * 32, IFF = 16 * 88, IDN = 44 * 32, ICM = 16 * 8;
    constexpr int NITEMS = I1 + I2 + I3 + IGLU + 2 * IUP + IOUT + 2 * IFF + IDN + 4 * ICM;
    auto desc = [&](int it) -> TrDesc {
        int r = it;
        if (r < I1) return TrDesc{args.in[2], WIN, INC, 1792, 1024, 32 * (r % 56), r / 56, r % 56, nullptr}; r -= I1;
        if (r < I2) return TrDesc{args.in[2] + 1816, WIN, INC, 2048, 1024, 1792 + 32 * (r % 64), r / 64, r % 64, nullptr}; r -= I2;
        if (r < I3) return TrDesc{args.in[2] + 1792, WIN, INC, 24, 1024, 3840, r, 0, nullptr}; r -= I3;
        if (r < IGLU) return TrDesc{args.in[11], WGLU, 512, 512, 512, 32 * (r % 16), r / 16, r % 16, nullptr}; r -= IGLU;
        if (r < IUP) return TrDesc{args.in[12], WA, 1024, 1024, 512, 32 * (r % 32), r / 32, r % 32, nullptr}; r -= IUP;
        if (r < IUP) return TrDesc{args.in[20], WB, 1024, 1024, 512, 32 * (r % 32), r / 32, r % 32, nullptr}; r -= IUP;
        if (r < IOUT) return TrDesc{args.in[21], WOUT, 1024, 1024, 1024, 32 * (r % 32), r / 32, r % 32, nullptr}; r -= IOUT;
        if (r < IFF) { const int nb = r % 88; return TrDesc{args.in[23], WGU, DFF, DFF, 1024, (nb >> 2) * 256 + (nb & 3) * 32, r / 88, nb, args.in[22]}; } r -= IFF;
        if (r < IFF) { const int nb = r % 88; return TrDesc{args.in[24], WGU, DFF, DFF, 1024, (nb >> 2) * 256 + (nb & 3) * 32 + 128, r / 88, nb, args.in[22]}; } r -= IFF;
        if (r < IDN) return TrDesc{args.in[25], WD, 1024, 1024, DFF, 32 * (r % 32), r / 32, r % 32, nullptr}; r -= IDN;
        const int q = r / ICM, rr = r % ICM;
        return TrDesc{((q >> 1) ? args.in[17] : args.in[15]) + (size_t)(q & 1) * 1024 * 256, WC1, 256, 256, 1024, q * 256 + 32 * (rr % 8), rr / 8, rr % 8, nullptr};
    };
    if (gw < NITEMS) {
        TrDesc dc = desc(gw); float vc[32]; tr_load(dc, vc, lane);
#pragma unroll 1
        for (int it = gw; it < NITEMS; it += NGW) {
            const bool more = it + NGW < NITEMS; TrDesc dn = desc(more ? it + NGW : it); float vn[32]; tr_load(dn, vn, lane);
            tr_finish(dc, vc, scr, lane);
            dc = dn;
#pragma unroll
            for (int i = 0; i < 32; ++i) vc[i] = vn[i];
        }
    }
    bf16* XN = (bf16*)(F.ws + WS_XN);
    for (int m = gw; m < S; m += 2 * NGW) rms_rows2_to_bf16(args.in[0] + (size_t)m * DM, args.in[0] + (size_t)(m + NGW) * DM, args.in[1], XN + (size_t)m * DM, XN + (size_t)(m + NGW) * DM, lane);
}

__device__ __forceinline__ int crow(int r, int hi) { return (r & 3) + 8 * (r >> 2) + 4 * hi; }
template <bool FINAL>
__device__ __forceinline__ void s5_unit(const Frame& F, const Args& args, int c, int g, LAS unsigned char* wl, LAS unsigned char* wx) {
    const int lane = F.lane, hi = lane >> 5;
    const bf16* U = (const bf16*)(F.ws + WS_U); bf16* Z = (bf16*)(F.ws + WS_Z);
    bf16x8 bfg[4], cfg[4], ua[8];
#pragma unroll
    for (int sub = 0; sub < 8; ++sub) ua[sub] = *(const bf16x8*)(U + (size_t)(c * 256 + sub * 32 + (lane & 31)) * 512 + g * 16 + 8 * hi);
#pragma unroll
    for (int nt = 0; nt < 4; ++nt) bfg[nt] = ((const bf16x8*)(F.ws + WS_TAB + TAB_BF))[(g * 4 + nt) * 64 + lane];
    const f32x2 lam = ((const f32x2*)(F.ws + WS_TAB + TAB_LAM))[g * 64 + lane];
    f32x2* Fst = (f32x2*)(F.ws + WS_F);
    float xr = 0.f, xi = 0.f, dsk = 0.f;
    if (FINAL) {
#pragma unroll
        for (int ks = 0; ks < 4; ++ks) cfg[ks] = ((const bf16x8*)(F.ws + WS_TAB + TAB_CF))[(g * 4 + ks) * 64 + lane];
        dsk = args.in[10][g * 16 + (lane & 15)];
        const f32x2 L2 = ((const f32x2*)(F.ws + WS_TAB + TAB_LAM256))[g * 64 + lane];
        for (int cp = 0; cp < c; ++cp) { const f32x2 f = Fst[(cp * 32 + g) * 64 + lane]; const float nr = L2.x * xr - L2.y * xi + f.x, ni = L2.x * xi + L2.y * xr + f.y; xr = nr; xi = ni; }
    }
#pragma unroll
    for (int sub = 0; sub < 8; ++sub) {
        const int t0 = c * 256 + sub * 32;
        const bf16x8 a = ua[sub];
        if (FINAL) *(LAS bf16x8*)(wx + (lane & 31) * 32 + hi * 16) = a;
#pragma unroll
        for (int nt = 0; nt < 4; ++nt) { f32x16 acc = {}; acc = __builtin_amdgcn_mfma_f32_32x32x16_bf16(a, bfg[nt], acc, 0, 0, 0);
#pragma unroll
            for (int r = 0; r < 16; ++r) ((LAS float*)wl)[crow(r, hi) * 128 + 32 * nt + (lane & 31)] = acc[r]; }
        LDS_WAIT();
        f32x2 bu[32];
#pragma unroll
        for (int tk = 0; tk < 32; ++tk) bu[tk] = ((const LAS f32x2*)wl)[tk * 64 + lane];
        LDS_WAIT();
#pragma unroll
        for (int tk = 0; tk < 32; ++tk) { const float nr = lam.x * xr - lam.y * xi + bu[tk].x, ni = lam.x * xi + lam.y * xr + bu[tk].y; xr = nr; xi = ni;
            if (FINAL) ((LAS unsigned*)wl)[tk * 128 + ((lane + 4 * tk) & 63)] = pk2(xr, xi); }
        if (FINAL) {
            LDS_WAIT();
            LAS unsigned short* zt = (LAS unsigned short*)(wx + 1024);
#pragma unroll
            for (int mt = 0; mt < 2; ++mt) { f32x4 y4 = {0.f, 0.f, 0.f, 0.f}; const int row = 16 * mt + (lane & 15);
#pragma unroll
                for (int ks = 0; ks < 4; ++ks) { const bf16x8 xa = *(const LAS bf16x8*)(wl + row * 512 + ((64 * ks + 16 * (lane >> 4) + 16 * row) & 255)); y4 = __builtin_amdgcn_mfma_f32_16x16x32_bf16(xa, cfg[ks], y4, 0, 0, 0); }
#pragma unroll
                for (int r = 0; r < 4; ++r) { const int tok = 16 * mt + 4 * (lane >> 4) + r; const float uu = bf2f(((const LAS unsigned short*)wx)[tok * 16 + (lane & 15)]);
                    zt[tok * 16 + (lane & 15)] = (unsigned short)f2bf(gelu_tanh(y4[r] + dsk * uu)); } }
            LDS_WAIT();
            *(v4u*)(Z + (size_t)(t0 + (lane >> 1)) * 512 + g * 16 + 8 * (lane & 1)) = *(const LAS v4u*)(wx + 1024 + lane * 16);
            LDS_WAIT();
        }
    }
    if (!FINAL) Fst[(c * 32 + g) * 64 + lane] = (f32x2){xr, xi};
}

__device__ __forceinline__ int krow(int s, int h, int j) { return 16 * s + 8 * (j >> 2) + 4 * h + (j & 3); }
__device__ __forceinline__ void cmp_l2_unit(const Frame& F, const Args& args, int kv, int g, int n, LAS float* hb) {
    const int lane = F.lane; const float* P1 = F.out;
    float o = 0.f;
    if (n < NCMP) {
        const int rt = kv * 2048 + g * 1024 + n;
        const float* posb = (const float*)(F.ws + WS_TAB + TAB_POSB) + kv * 16 * 256;
#pragma unroll
        for (int i = 0; i < 4; ++i) { const int j = lane + 64 * i; float a = 0.f;
#pragma unroll
            for (int ks = 0; ks < CMP_KS; ++ks) a += P1[((size_t)ks * 4096 + rt) * 512 + j] + P1[((size_t)ks * 4096 + rt + 1) * 512 + 256 + j];
#pragma unroll
            for (int p = 0; p < 16; ++p) a += posb[p * 256 + j];
            hb[j] = gelu_tanh(a); }
        LDS_WAIT();
        const float* w2 = kv ? args.in[18] : args.in[16];
#pragma unroll 8
        for (int j = 0; j < 256; ++j) o += hb[j] * w2[j * 64 + lane];
    }
    if (kv == 0) ((bf16*)(F.ws + WS_KCB))[((size_t)g * 1024 + n) * 64 + lane] = (bf16)f2bf(o);
    else { const int grp = n >> 5, kk = n & 31, sx = kk >> 4, rem = kk & 15, hh = (rem >> 2) & 1, j = ((rem >> 3) << 2) | (rem & 3), d0 = lane >> 5, ln = hh * 32 + (lane & 31);
        ((bf16*)(F.ws + WS_VTC))[((((size_t)(g * 32 + grp) * 2 + d0) * 2 + sx) * 64 + ln) * 8 + j] = (bf16)f2bf(o); }
    LDS_WAIT();
}
__device__ __forceinline__ void vtw_item(const Frame& F, int g, int grp) {
    const int lane = F.lane, hi = lane >> 5; const bf16* V = (const bf16*)(F.ws + WS_KVH) + (size_t)(10 + g) * S * 64;
#pragma unroll
    for (int d0 = 0; d0 < 2; ++d0)
#pragma unroll
        for (int sx = 0; sx < 2; ++sx) { unsigned w[4];
#pragma unroll
            for (int jj = 0; jj < 4; ++jj) { const bf16 a = V[(size_t)(32 * grp + krow(sx, hi, 2 * jj)) * 64 + 32 * d0 + (lane & 31)], b = V[(size_t)(32 * grp + krow(sx, hi, 2 * jj + 1)) * 64 + 32 * d0 + (lane & 31)]; w[jj] = (unsigned)a | ((unsigned)b << 16); }
            ((v4u*)(F.ws + WS_VTW))[(((size_t)(g * 512 + grp) * 2 + d0) * 2 + sx) * 64 + lane] = (v4u){w[0], w[1], w[2], w[3]}; }
}
__device__ __forceinline__ int kap(int ks, int q, int j) { return 16 * (2 * ks + (j >> 2)) + 4 * q + (j & 3); }
__device__ __forceinline__ void vts_item(const Frame& F, int g, int blk) {
    const int lane = F.lane, q = lane >> 4; const bf16* V = (const bf16*)(F.ws + WS_KVH) + (size_t)(6 + g) * S * 64;
#pragma unroll
    for (int dt = 0; dt < 4; ++dt)
#pragma unroll
        for (int ks = 0; ks < 2; ++ks) { unsigned w[4];
#pragma unroll
            for (int jj = 0; jj < 4; ++jj) { const bf16 a = V[(size_t)(64 * blk + kap(ks, q, 2 * jj)) * 64 + 16 * dt + (lane & 15)], b = V[(size_t)(64 * blk + kap(ks, q, 2 * jj + 1)) * 64 + 16 * dt + (lane & 15)]; w[jj] = (unsigned)a | ((unsigned)b << 16); }
            ((v4u*)(F.ws + WS_VTS))[(((size_t)(g * 256 + blk) * 4 + dt) * 2 + ks) * 64 + lane] = (v4u){w[0], w[1], w[2], w[3]}; }
}

constexpr int AT_SC = 0;
constexpr int AT_SEL = 67584;
constexpr int AT_CNT = AT_SEL + 4096;
constexpr int AT_LIST = AT_CNT + 1024;
constexpr int AT_BT = AT_LIST + 32768;
constexpr int AT_PARK = AT_BT + 4096;
constexpr int AT_TILE = AT_PARK + 32768;
constexpr int AT_END = AT_TILE + 16384;
static_assert(AT_END <= LDS_BYTES - 64, "attention LDS map");
constexpr int PSLOTS = 832, PSLAB = 458752;
constexpr int PML_OFF = PSLOTS * 512;
constexpr int SCS = 264;

__device__ __forceinline__ bf16x8 pack8(float a0, float a1, float a2, float a3, float a4, float a5, float a6, float a7) {
    v4u w; w.x = cvt_pk_bf16(a0, a1); w.y = cvt_pk_bf16(a2, a3); w.z = cvt_pk_bf16(a4, a5); w.w = cvt_pk_bf16(a6, a7); return __builtin_bit_cast(bf16x8, w);
}
__device__ __forceinline__ float xmax32(float v) { auto r = __builtin_amdgcn_permlane32_swap(__float_as_uint(v), __float_as_uint(v), false, false); return fmaxf(__uint_as_float(r[0]), __uint_as_float(r[1])); }
__device__ __forceinline__ float xsum32(float v) { auto r = __builtin_amdgcn_permlane32_swap(__float_as_uint(v), __float_as_uint(v), false, false); return __uint_as_float(r[0]) + __uint_as_float(r[1]); }
__device__ __forceinline__ float xmax16(float v) { auto r = __builtin_amdgcn_permlane16_swap(__float_as_uint(v), __float_as_uint(v), false, false); return fmaxf(__uint_as_float(r[0]), __uint_as_float(r[1])); }
__device__ __forceinline__ float xsum16(float v) { auto r = __builtin_amdgcn_permlane16_swap(__float_as_uint(v), __float_as_uint(v), false, false); return __uint_as_float(r[0]) + __uint_as_float(r[1]); }
__device__ __forceinline__ float max16(const f32x16& a) {
    const float m0 = fmaxf(fmaxf(a[0], a[1]), fmaxf(a[2], a[3])), m1 = fmaxf(fmaxf(a[4], a[5]), fmaxf(a[6], a[7])), m2 = fmaxf(fmaxf(a[8], a[9]), fmaxf(a[10], a[11])), m3 = fmaxf(fmaxf(a[12], a[13]), fmaxf(a[14], a[15]));
    return fmaxf(fmaxf(m0, m1), fmaxf(m2, m3)); }
__device__ __forceinline__ float sum16(const f32x16& a) {
    const float s0 = (a[0] + a[1]) + (a[2] + a[3]), s1 = (a[4] + a[5]) + (a[6] + a[7]), s2 = (a[8] + a[9]) + (a[10] + a[11]), s3 = (a[12] + a[13]) + (a[14] + a[15]);
    return (s0 + s1) + (s2 + s3); }
__device__ __forceinline__ int fenc(float f) { int k = __float_as_int(f); return k ^ ((k >> 31) & 0x7fffffff); }
__device__ __forceinline__ float fdec(int k) { return __int_as_float(k ^ ((k >> 31) & 0x7fffffff)); }
#define MFMA32(a, b, c) __builtin_amdgcn_mfma_f32_32x32x16_bf16((a), (b), (c), 0, 0, 0)
#define MFMA16(a, b, c) __builtin_amdgcn_mfma_f32_16x16x32_bf16((a), (b), (c), 0, 0, 0)
#define DPPI(x, ctrl) __builtin_amdgcn_update_dpp(0, (x), (ctrl), 0xF, 0xF, false)

struct AttnPtrs { const bf16* Q; const bf16* KCB; const bf16x8* VTC; const bf16* KW; const bf16x8* VTW; const bf16* KS; const bf16x8* VTS; const bf16* GN; bf16* O; };

__device__ __forceinline__ void attn_stageA(const AttnPtrs& P, int lane, int wave, int tile0, int g, LAS unsigned char* lds) {
    const int hi = lane >> 5, c32 = lane & 31, ti = c32 >> 2, hr = c32 & 3, h = g * 4 + hr, t0 = tile0 + 8 * wave, t = t0 + ti;
    LAS float* scores = (LAS float*)(lds + AT_SC) + (8 * wave) * SCS; const LAS float* BT = (const LAS float*)(lds + AT_BT); LAS int* sel = (LAS int*)(lds + AT_SEL) + (8 * wave) * 16;
    for (int k = lane; k < 8 * SCS / 4; k += 64) ((LAS f32x4*)scores)[k] = (f32x4){0.f, 0.f, 0.f, 0.f};
    bf16x8 bq[4];
#pragma unroll
    for (int ks = 0; ks < 4; ++ks) bq[ks] = *(const bf16x8*)(P.Q + (size_t)t * 512 + h * 64 + 16 * ks + 8 * hi);
    const float cb = BT[h * 128 + 127];
    const float g0 = bf2f(P.GN[(size_t)t * 32 + h * 3 + 0]), g2 = bf2f(P.GN[(size_t)t * 32 + h * 3 + 2]);
    LDS_WAIT();
    const int tid = wave * 64 + lane; LAS unsigned char* tb = lds + AT_TILE;
    const int ldrow = tid >> 3, ldch = tid & 7; const unsigned stoff = (tid < 256) ? (unsigned)(ldrow * 128 + ((ldch ^ (ldrow & 7)) << 4)) : (unsigned)(8192 + (tid - 256) * 16);
    const unsigned kof = (unsigned)(c32 * 128), ksw = (unsigned)(c32 & 7);
#define KFRAG(buf, ks) (*(const LAS bf16x8*)(tb + (buf) * 4096 + kof + ((((ks) * 2 + hi) ^ ksw) << 4)))
#define VFRAG(buf, f) (*(const LAS bf16x8*)(tb + 8192 + (buf) * 4096 + ((f) * 64 + lane) * 16))
#define STAGE_LOAD(Kp, kmax, VTp, gmax, n0v) ((tid < 256) ? *(const v4u*)((Kp) + (size_t)min((n0v) + ldrow, (kmax)) * 64 + ldch * 8) : *(const v4u*)((VTp) + (size_t)min((n0v) >> 5, (gmax)) * 256 + (tid - 256)))
#define STAGE_WRITE(v, buf) (*(LAS v4u*)(tb + (buf) * 4096 + stoff) = (v))
#define PVACC(o0v, o1v, buf, a) do { const bf16x8 p0_ = pack8(a[0], a[1], a[2], a[3], a[4], a[5], a[6], a[7]), p1_ = pack8(a[8], a[9], a[10], a[11], a[12], a[13], a[14], a[15]); \
        o0v = MFMA32(VFRAG(buf, 0), p0_, o0v); o0v = MFMA32(VFRAG(buf, 1), p1_, o0v); o1v = MFMA32(VFRAG(buf, 2), p0_, o1v); o1v = MFMA32(VFRAG(buf, 3), p1_, o1v); } while (0)
    constexpr float SM_THR = 8.0f;
#define REF_EVENT(a, mref, started, d, fs) { const float tm_ = xmax32(max16(a)); const bool need_ = started ? (tm_ > SM_THR) : (tm_ > -1e29f); d = 0.f; fs = 1.f; \
        if (__any(need_)) { d = need_ ? tm_ : 0.f; fs = (need_ && started) ? __builtin_amdgcn_exp2f(-d) : 1.f; mref += d; started = started || need_; _Pragma("unroll") for (int r = 0; r < 16; ++r) a[r] -= d; } }
    const int ncb = (tile0 + 63 >= 31) ? min((tile0 + 63 - 31) / 16 + 1, NCMP) : 0, ntc = (ncb + 31) >> 5;
    const int nfar = (t0 >= 144) ? (t0 - 144) / 16 + 1 : 0;
#define CSCORE(a, buf, n0v, farv, refv) do { { const float ini_ = ((farv) ? cb : 0.f) - (refv); _Pragma("unroll") for (int r = 0; r < 16; ++r) a[r] = ini_; } \
        _Pragma("unroll") for (int ks = 0; ks < 4; ++ks) a = MFMA32(KFRAG(buf, ks), bq[ks], a); \
        if (!(farv)) { _Pragma("unroll") for (int r = 0; r < 16; ++r) { const int dist = t - (16 * ((n0v) + crow(r, hi)) + 31); const float bt = BT[h * 128 + min(max(dist, 0), 127)]; a[r] = dist >= 0 ? a[r] + bt : -1e30f; } } } while (0)
#define STAGE_PROLOGUE(Kp, kmax, VTp, gmax, nbase, ntl) v4u RA, RB; { RA = STAGE_LOAD(Kp, kmax, VTp, gmax, nbase); STAGE_WRITE(RA, 0); RB = STAGE_LOAD(Kp, kmax, VTp, gmax, (nbase) + 32 * min(1, (ntl) - 1)); __syncthreads(); }
    float mc = 0.f, lc = 0.f; bool stc = false;
    if (ntc > 0) {
        STAGE_PROLOGUE(P.KCB, 1023, P.VTC, 31, 0, ntc)
#define C1STEP(iv, BUF, RL, RW) { const int i = (iv); if (i >= ntc) break; const int n0 = 32 * i; RL = STAGE_LOAD(P.KCB, 1023, P.VTC, 31, 32 * min(i + 2, ntc - 1)); \
            const bool far = (n0 + 32 <= nfar); f32x16 a; CSCORE(a, BUF, n0, far, mc); \
            float d_, fs_; REF_EVENT(a, mc, stc, d_, fs_) lc *= fs_; \
            _Pragma("unroll") for (int r = 0; r < 16; ++r) a[r] = __builtin_amdgcn_exp2f(a[r]); \
            lc += xsum32(sum16(a)); STAGE_WRITE(RW, (BUF) ^ 1); __syncthreads(); }
        for (int ib = 0; ; ib += 2) { C1STEP(ib, 0, RA, RB) C1STEP(ib + 1, 1, RB, RA) }
#undef C1STEP
    }
    {   const float invl = 1.0f / fmaxf(lc, 1e-30f); f32x16 oc0 = {}, oc1 = {}; float carry = 0.f;
#define CIMP(a, n0v) do { float mq[4], cq[4]; \
            _Pragma("unroll") for (int qg = 0; qg < 4; ++qg) { float mv = (2.0f * (a[4 * qg] + a[4 * qg + 1] + a[4 * qg + 2]) + a[4 * qg + 3]) * invl, cv = a[4 * qg + 3] * invl; \
                mv += __int_as_float(DPPI(__float_as_int(mv), 0xB1)); mv += __int_as_float(DPPI(__float_as_int(mv), 0x4E)); \
                cv += __int_as_float(DPPI(__float_as_int(cv), 0xB1)); cv += __int_as_float(DPPI(__float_as_int(cv), 0x4E)); mq[qg] = mv; cq[qg] = cv; } \
            float oth[4]; \
            _Pragma("unroll") for (int qg = 0; qg < 4; ++qg) { auto rr = __builtin_amdgcn_permlane32_swap(__float_as_uint(cq[qg]), __float_as_uint(cq[qg]), false, false); oth[qg] = __uint_as_float(hi ? rr[0] : rr[1]); } \
            _Pragma("unroll") for (int qg = 0; qg < 4; ++qg) { const float tot = mq[qg] + (hi ? oth[qg] : (qg ? oth[qg - 1] : carry)); if (hr == 0) scores[ti * SCS + (((n0v) + 8 * qg + 4 * hi) >> 2)] = tot; } \
            carry = oth[3]; } while (0)
        if (ntc > 0) {
            STAGE_PROLOGUE(P.KCB, 1023, P.VTC, 31, 0, ntc)
#define C2STEP(iv, BUF, RL, RW) { const int i = (iv); if (i >= ntc) break; const int n0 = 32 * i; RL = STAGE_LOAD(P.KCB, 1023, P.VTC, 31, 32 * min(i + 2, ntc - 1)); \
                const bool far = (n0 + 32 <= nfar); f32x16 a; CSCORE(a, BUF, n0, far, mc); \
                _Pragma("unroll") for (int r = 0; r < 16; ++r) a[r] = __builtin_amdgcn_exp2f(a[r]); \
                CIMP(a, n0); PVACC(oc0, oc1, BUF, a); STAGE_WRITE(RW, (BUF) ^ 1); __syncthreads(); }
            for (int ib = 0; ; ib += 2) { C2STEP(ib, 0, RA, RB) C2STEP(ib + 1, 1, RB, RA) }
#undef C2STEP
            { const int jn = ntc * 8; if (jn < 256 && hi == 0 && hr == 0) scores[ti * SCS + jn] = carry; }
        }
#undef CIMP
        {   LAS unsigned char* park = lds + AT_PARK + (((8 * wave + ti) * 4 + hr) * 64) * 2;
            const float gs = g0 * invl;
#pragma unroll
            for (int d0 = 0; d0 < 2; ++d0)
#pragma unroll
                for (int r4 = 0; r4 < 4; ++r4) { const f32x16& Wd = d0 ? oc1 : oc0; const int dim = 32 * d0 + 8 * r4 + 4 * hi;
                    *(LAS unsigned long long*)(park + dim * 2) = (unsigned long long)cvt_pk_bf16(Wd[4 * r4] * gs, Wd[4 * r4 + 1] * gs) | ((unsigned long long)cvt_pk_bf16(Wd[4 * r4 + 2] * gs, Wd[4 * r4 + 3] * gs) << 32); } } }
#undef CSCORE
    {   float mw = 0.f, lw = 0.f; bool stw = false; f32x16 o0 = {}, o1 = {};
        const int nlo = max(t0 - 511, 0) & ~31, nhi = (t0 + 7) & ~31;
        const int nlb = max(tile0 - 511, 0) & ~31, ntw = (((tile0 + 63) & ~31) - nlb) / 32 + 1;
        STAGE_PROLOGUE(P.KW, S - 1, P.VTW, 511, nlb, ntw)
#define WSTEP(iv, BUF, RL, RW) { const int i = (iv); if (i >= ntw) break; const int n0 = nlb + 32 * i; RL = STAGE_LOAD(P.KW, S - 1, P.VTW, 511, nlb + 32 * min(i + 2, ntw - 1)); \
            if (n0 >= nlo && n0 <= nhi) { const bool mid = (n0 >= t0 - 504) && (n0 <= t0 - 144); \
                f32x16 a; { const float ini_ = (mid ? cb : 0.f) - mw; _Pragma("unroll") for (int r = 0; r < 16; ++r) a[r] = ini_; } \
                _Pragma("unroll") for (int ks = 0; ks < 4; ++ks) a = MFMA32(KFRAG(BUF, ks), bq[ks], a); \
                if (!mid) { _Pragma("unroll") for (int r = 0; r < 16; ++r) { const int dist = t - (n0 + crow(r, hi)); const float bt = BT[h * 128 + min(max(dist, 0), 127)]; a[r] = (dist >= 0 && dist < 512) ? a[r] + bt : -1e30f; } } \
                float d_, fs_; REF_EVENT(a, mw, stw, d_, fs_) if (fs_ != 1.f || d_ != 0.f) { lw *= fs_; o0 = o0 * fs_; o1 = o1 * fs_; } \
                _Pragma("unroll") for (int r = 0; r < 16; ++r) a[r] = __builtin_amdgcn_exp2f(a[r]); \
                lw += xsum32(sum16(a)); PVACC(o0, o1, BUF, a); } \
            STAGE_WRITE(RW, (BUF) ^ 1); __syncthreads(); }
        for (int ib = 0; ; ib += 2) { WSTEP(ib, 0, RA, RB) WSTEP(ib + 1, 1, RB, RA) }
#undef WSTEP
        const float sc = g2 / fmaxf(lw, 1e-30f);
        LAS unsigned char* park = lds + AT_PARK + (((8 * wave + ti) * 4 + hr) * 64) * 2;
#pragma unroll
        for (int d0 = 0; d0 < 2; ++d0)
#pragma unroll
            for (int r4 = 0; r4 < 4; ++r4) { const f32x16& Od = d0 ? o1 : o0; const int dim = 32 * d0 + 8 * r4 + 4 * hi; const unsigned long long w = *(const LAS unsigned long long*)(park + dim * 2); const unsigned lo = (unsigned)w, hw = (unsigned)(w >> 32);
                *(LAS unsigned long long*)(park + dim * 2) = (unsigned long long)cvt_pk_bf16(bflo(lo) + Od[4 * r4] * sc, bfhi(lo) + Od[4 * r4 + 1] * sc) | ((unsigned long long)cvt_pk_bf16(bflo(hw) + Od[4 * r4 + 2] * sc, bfhi(hw) + Od[4 * r4 + 3] * sc) << 32); } }
#undef REF_EVENT
#undef STAGE_PROLOGUE
#undef PVACC
#undef KFRAG
#undef VFRAG
#undef STAGE_LOAD
#undef STAGE_WRITE
    LDS_WAIT();
    {   const int cur = tile0 >> 6, i = lane >> 3, s8 = lane & 7;
        if (cur + 1 <= 16) { for (int e = lane; e < 8 * 16; e += 64) sel[e] = e & 15; }
        else {
            float sv[32];
#pragma unroll
            for (int k = 0; k < 32; ++k) { const int j = s8 + 8 * k; sv[k] = (j >= 1 && j <= cur - 2) ? scores[i * SCS + j] : -3e38f; }
            if (s8 == 0) { sel[i * 16 + 0] = 0; sel[i * 16 + 1] = cur - 1; sel[i * 16 + 2] = cur; }
            for (int it = 3; it < 16; ++it) {
                float bv = sv[0]; int bj = s8;
#pragma unroll
                for (int k = 1; k < 32; ++k) if (sv[k] > bv) { bv = sv[k]; bj = s8 + 8 * k; }
#define SEL_STEP(ctrl) { const float ov = __int_as_float(DPPI(__float_as_int(bv), ctrl)); const int oj = DPPI(bj, ctrl); if (ov > bv || (ov == bv && oj < bj)) { bv = ov; bj = oj; } }
                SEL_STEP(0xB1) SEL_STEP(0x4E) SEL_STEP(0x141)
#undef SEL_STEP
                if (s8 == 0) sel[i * 16 + it] = bj;
#pragma unroll
                for (int k = 0; k < 32; ++k) if (bj == s8 + 8 * k) sv[k] = -3e38f;
            }
        }
    }
}

__device__ __forceinline__ void s_scores(const bf16x8 (&kf)[8], const bf16x8 q0, const bf16x8 q1, bool cst, float cbs, const LAS float* BT, int hs, int tt, int j, int q, f32x4 (&sa)[4]) {
#pragma unroll
    for (int mt = 0; mt < 4; ++mt) { const float ini = cst ? cbs : 0.f; sa[mt] = (f32x4){ini, ini, ini, ini}; sa[mt] = MFMA16(kf[mt * 2], q0, sa[mt]); sa[mt] = MFMA16(kf[mt * 2 + 1], q1, sa[mt]); }
    if (!cst) {
#pragma unroll
        for (int mt = 0; mt < 4; ++mt)
#pragma unroll
            for (int r = 0; r < 4; ++r) { const int dist = tt - (64 * j + 16 * mt + 4 * q + r); const float bt = BT[hs * 128 + min(max(dist, 0), 127)]; sa[mt][r] = dist >= 0 ? sa[mt][r] + bt : -1e30f; } }
}
template <bool MASKED> __device__ __forceinline__ void s_softmax(f32x4 (&sa)[4], float& tm, float& ls) {
    tm = sa[0][0];
#pragma unroll
    for (int mt = 0; mt < 4; ++mt)
#pragma unroll
        for (int r = 0; r < 4; ++r) tm = fmaxf(tm, sa[mt][r]);
    tm = xmax32(xmax16(tm)); ls = 0.f;
#pragma unroll
    for (int mt = 0; mt < 4; ++mt)
#pragma unroll
        for (int r = 0; r < 4; ++r) { const float e = __builtin_amdgcn_exp2f(sa[mt][r] - tm); sa[mt][r] = (!MASKED || sa[mt][r] > -1e29f) ? e : 0.f; ls += sa[mt][r]; }
    ls = xsum32(xsum16(ls));
}
__device__ __forceinline__ void load_kf(const AttnPtrs& P, int lane, int j, bf16x8 (&kf)[8]) {
    const bf16* kp = P.KS + (size_t)(64 * j + (lane & 15)) * 64 + 8 * (lane >> 4);
#pragma unroll
    for (int mt = 0; mt < 4; ++mt) { kf[mt * 2] = *(const bf16x8*)(kp + (size_t)mt * 16 * 64); kf[mt * 2 + 1] = *(const bf16x8*)(kp + (size_t)mt * 16 * 64 + 32); }
}
__device__ __forceinline__ void load_vf(const AttnPtrs& P, int lane, int j, bf16x8 (&vf)[8]) {
    const bf16x8* vt = P.VTS + (size_t)j * 8 * 64 + lane;
#pragma unroll
    for (int e = 0; e < 8; ++e) vf[e] = vt[e * 64];
}
__device__ __forceinline__ void attn_stageB(const AttnPtrs& P, int lane, int wave, int tile0, int g, LAS unsigned char* lds, unsigned char* slab) {
    const int T = tile0 >> 6, c = lane & 15, q = lane >> 4, hd = c & 3, hs = g * 4 + hd;
    if (T <= 15) return;
    const LAS unsigned* cnt = (const LAS unsigned*)(lds + AT_CNT); const LAS unsigned short* list = (const LAS unsigned short*)(lds + AT_LIST); const LAS float* BT = (const LAS float*)(lds + AT_BT);
    const float cbs = BT[hs * 128 + 127];
#define NEXT_BLK(jv, nv) do { nv = 0; for (jv += 8; jv <= T - 2; jv += 8) { nv = (int)__builtin_amdgcn_readfirstlane((int)cnt[jv]); if (nv > 0) break; } } while (0)
    int jc = 1 + wave - 8, nc = 0; NEXT_BLK(jc, nc); if (jc > T - 2) return;
    int jn = jc, nn = 0; NEXT_BLK(jn, nn);
    bf16x8 kf[8], vf[8], kn[8];
    load_kf(P, lane, jc, kf); load_vf(P, lane, jc, vf);
    load_kf(P, lane, min(jn, T - 2), kn);
    int ch = 0;
    int sl; bool valid; bf16x8 q0, q1;
    { const int sidx = (c >> 2); valid = sidx < nc; sl = (int)list[jc * 64 + (valid ? sidx : 0)]; const int tt = tile0 + sl / 13;
      q0 = *(const bf16x8*)(P.Q + (size_t)tt * 512 + hs * 64 + 8 * q); q1 = *(const bf16x8*)(P.Q + (size_t)tt * 512 + hs * 64 + 32 + 8 * q); }
#pragma unroll 1
    for (;;) {
        const bool same = (ch + 1) * 4 < nc; const bool more = same || (jn <= T - 2);
        const int jx = same ? jc : min(jn, T - 2), chx = same ? ch + 1 : 0, nx = same ? nc : nn;
        int sln; bool validn; bf16x8 q0n, q1n;
        { const int sidx = 4 * chx + (c >> 2); validn = sidx < nx; sln = (int)list[jx * 64 + (validn ? sidx : 0)]; const int tt = tile0 + sln / 13;
          q0n = *(const bf16x8*)(P.Q + (size_t)tt * 512 + hs * 64 + 8 * q); q1n = *(const bf16x8*)(P.Q + (size_t)tt * 512 + hs * 64 + 32 + 8 * q); }
        {   const int tt = tile0 + sl / 13; const bool cst = (jc <= T - 3);
            f32x4 sa[4]; s_scores(kf, q0, q1, cst, cbs, BT, hs, tt, jc, q, sa);
            float tm, ls; s_softmax<false>(sa, tm, ls);
            const bf16x8 p0 = pack8(sa[0][0], sa[0][1], sa[0][2], sa[0][3], sa[1][0], sa[1][1], sa[1][2], sa[1][3]), p1 = pack8(sa[2][0], sa[2][1], sa[2][2], sa[2][3], sa[3][0], sa[3][1], sa[3][2], sa[3][3]);
            unsigned char* po = slab + ((size_t)(sl * 4 + hd) * 64 + 4 * q) * 2;
#pragma unroll
            for (int dt = 0; dt < 4; ++dt) { f32x4 oa = {0.f, 0.f, 0.f, 0.f}; oa = MFMA16(vf[dt * 2], p0, oa); oa = MFMA16(vf[dt * 2 + 1], p1, oa);
                if (valid) *(unsigned long long*)(po + dt * 32) = (unsigned long long)cvt_pk_bf16(oa[0], oa[1]) | ((unsigned long long)cvt_pk_bf16(oa[2], oa[3]) << 32); }
            if (valid && q == 0) *(f32x2*)(slab + PML_OFF + (size_t)(sl * 4 + hd) * 8) = (f32x2){tm, ls}; }
        if (!more) break;
        if (!same) {
#pragma unroll
            for (int e = 0; e < 8; ++e) kf[e] = kn[e];
            jc = jn; nc = nn; load_vf(P, lane, jc, vf); NEXT_BLK(jn, nn);
            load_kf(P, lane, min(jn, T - 2), kn); }
        ch = chx; sl = sln; valid = validn; q0 = q0n; q1 = q1n;
    }
#undef NEXT_BLK
}
struct SState { float M, L; f32x4 O[4]; };
__device__ __forceinline__ void s_merge(SState& st, float m, float l, const f32x4 (&o)[4]) {
    const float mn = fmaxf(st.M, m), a0 = __builtin_amdgcn_exp2f(st.M - mn), a1 = __builtin_amdgcn_exp2f(m - mn);
    st.L = st.L * a0 + l * a1; st.M = mn;
#pragma unroll
    for (int dt = 0; dt < 4; ++dt) st.O[dt] = st.O[dt] * a0 + o[dt] * a1;
}
__device__ __forceinline__ void attn_stageC_forced(const AttnPtrs& P, int lane, int wave, int tile0, int g, LAS unsigned char* lds, SState (&st)[2]) {
    const int T = tile0 >> 6, c = lane & 15, q = lane >> 4, hd = c & 3, hs = g * 4 + hd; const LAS float* BT = (const LAS float*)(lds + AT_BT); const float cbs = BT[hs * 128 + 127];
    bf16x8 q0[2], q1[2];
#pragma unroll
    for (int k = 0; k < 2; ++k) { const int tt = tile0 + 8 * wave + 4 * k + (c >> 2); q0[k] = *(const bf16x8*)(P.Q + (size_t)tt * 512 + hs * 64 + 8 * q); q1[k] = *(const bf16x8*)(P.Q + (size_t)tt * 512 + hs * 64 + 32 + 8 * q);
        st[k].M = -1e30f; st[k].L = 0.f;
#pragma unroll
        for (int dt = 0; dt < 4; ++dt) st[k].O[dt] = (f32x4){0.f, 0.f, 0.f, 0.f}; }
    const int nf = T <= 15 ? T + 1 : 3;
    auto fblk = [&](int it) -> int { return T <= 15 ? it : (it == 0 ? 0 : (it == 1 ? T - 1 : T)); };
    bf16x8 kf[8], vf[8]; load_kf(P, lane, fblk(0), kf); load_vf(P, lane, fblk(0), vf);
#pragma unroll 1
    for (int it = 0; it < nf; ++it) { const int j = fblk(it);
        bf16x8 kn[8]; load_kf(P, lane, fblk(min(it + 1, nf - 1)), kn);
        const bool cst = (j <= T - 3);
#pragma unroll
        for (int k = 0; k < 2; ++k) { const int tt = tile0 + 8 * wave + 4 * k + (c >> 2);
            f32x4 sa[4]; s_scores(kf, q0[k], q1[k], cst, cbs, BT, hs, tt, j, q, sa);
            float tm, ls; s_softmax<true>(sa, tm, ls);
            const bf16x8 p0 = pack8(sa[0][0], sa[0][1], sa[0][2], sa[0][3], sa[1][0], sa[1][1], sa[1][2], sa[1][3]), p1 = pack8(sa[2][0], sa[2][1], sa[2][2], sa[2][3], sa[3][0], sa[3][1], sa[3][2], sa[3][3]);
            f32x4 ob[4];
#pragma unroll
            for (int dt = 0; dt < 4; ++dt) { ob[dt] = (f32x4){0.f, 0.f, 0.f, 0.f}; ob[dt] = MFMA16(vf[dt * 2], p0, ob[dt]); ob[dt] = MFMA16(vf[dt * 2 + 1], p1, ob[dt]); }
            s_merge(st[k], tm, ls, ob); }
#pragma unroll
        for (int e = 0; e < 8; ++e) kf[e] = kn[e];
        if (it + 1 < nf) load_vf(P, lane, fblk(it + 1), vf);
    }
}
__device__ __forceinline__ void attn_stageC_merge(const AttnPtrs& P, int lane, int wave, int tile0, int g, LAS unsigned char* lds, const unsigned char* slab, SState (&st)[2]) {
    const int T = tile0 >> 6, c = lane & 15, q = lane >> 4, hd = c & 3, hs = g * 4 + hd;
#pragma unroll
    for (int k = 0; k < 2; ++k) { const int tok = 8 * wave + 4 * k + (c >> 2), tt = tile0 + tok;
        if (T > 15) {
#pragma unroll
            for (int b0 = 0; b0 < 13; b0 += 7) {
                unsigned long long mlw[7], ow[7][4];
#pragma unroll
                for (int bb = 0; bb < 7; ++bb) if (b0 + bb < 13) { const int sl = tok * 13 + b0 + bb;
                    mlw[bb] = __hip_atomic_load((const unsigned long long*)(slab + PML_OFF + (size_t)(sl * 4 + hd) * 8), __ATOMIC_RELAXED, __HIP_MEMORY_SCOPE_AGENT);
                    const unsigned char* po = slab + ((size_t)(sl * 4 + hd) * 64 + 4 * q) * 2;
#pragma unroll
                    for (int dt = 0; dt < 4; ++dt) ow[bb][dt] = __hip_atomic_load((const unsigned long long*)(po + dt * 32), __ATOMIC_RELAXED, __HIP_MEMORY_SCOPE_AGENT); }
#pragma unroll
                for (int bb = 0; bb < 7; ++bb) if (b0 + bb < 13) { f32x4 ob[4];
#pragma unroll
                    for (int dt = 0; dt < 4; ++dt) { const unsigned lo = (unsigned)ow[bb][dt], hw = (unsigned)(ow[bb][dt] >> 32); ob[dt] = (f32x4){bflo(lo), bfhi(lo), bflo(hw), bfhi(hw)}; }
                    s_merge(st[k], __uint_as_float((unsigned)mlw[bb]), __uint_as_float((unsigned)(mlw[bb] >> 32)), ob); } } }
        const float g1 = bf2f(P.GN[(size_t)tt * 32 + hs * 3 + 1]) / fmaxf(st[k].L, 1e-30f);
        const LAS unsigned char* park = lds + AT_PARK + ((tok * 4 + hd) * 64 + 4 * q) * 2;
#pragma unroll
        for (int dt = 0; dt < 4; ++dt) { const unsigned long long w = *(const LAS unsigned long long*)(park + dt * 32); const unsigned lo = (unsigned)w, hw = (unsigned)(w >> 32);
            const unsigned o0 = cvt_pk_bf16(bflo(lo) + g1 * st[k].O[dt][0], bfhi(lo) + g1 * st[k].O[dt][1]), o1 = cvt_pk_bf16(bflo(hw) + g1 * st[k].O[dt][2], bfhi(hw) + g1 * st[k].O[dt][3]);
            *(unsigned long long*)(P.O + (size_t)tt * 512 + hs * 64 + 16 * dt + 4 * q) = (unsigned long long)o0 | ((unsigned long long)o1 << 32); } }
}
__device__ __forceinline__ void attn_tile(const Frame& F, unsigned char* ws, int tile, int g, unsigned soff) {
    int lane = F.lane; asm volatile("" : "+v"(lane));
    const int wave = F.wave, tile0 = tile * 64, T = tile; LAS unsigned char* lds = F.lds;
    if (F.tid < 256) ((LAS unsigned*)(lds + AT_CNT))[F.tid] = 0u;
    AttnPtrs P;
    {   const bf16* KVH = (const bf16*)(ws + WS_KVH);
        P.Q = (const bf16*)(ws + WS_Q); P.KCB = (const bf16*)(ws + WS_KCB) + (size_t)g * 1024 * 64; P.VTC = (const bf16x8*)(ws + WS_VTC) + (size_t)g * 32 * 4 * 64;
        P.KW = KVH + (size_t)(8 + g) * S * 64; P.VTW = (const bf16x8*)(ws + WS_VTW) + (size_t)g * 512 * 4 * 64; P.GN = (const bf16*)(ws + WS_GN);
        P.KS = nullptr; P.VTS = nullptr; P.O = nullptr; }
    attn_stageA(P, lane, wave, tile0, g, lds);
    __syncthreads();
    unsigned char* ws2 = ws;
    {   const bf16* KVH = (const bf16*)(ws2 + WS_KVH);
        P.Q = (const bf16*)(ws2 + WS_Q); P.KS = KVH + (size_t)(4 + g) * S * 64; P.VTS = (const bf16x8*)(ws2 + WS_VTS) + (size_t)g * 256 * 8 * 64; P.GN = (const bf16*)(ws2 + WS_GN); P.O = (bf16*)(ws2 + WS_O);
        P.KCB = nullptr; P.VTC = nullptr; P.KW = nullptr; P.VTW = nullptr; }
    unsigned char* slab = ((blockIdx.x < 128) ? (unsigned char*)F.out : ws2 + WS_PSLAB) + soff;
    if (T > 15) {
        LAS unsigned* cnt = (LAS unsigned*)(lds + AT_CNT); LAS unsigned short* list = (LAS unsigned short*)(lds + AT_LIST); const LAS int* sel = (const LAS int*)(lds + AT_SEL);
        const int tok = F.tid >> 3;
#pragma unroll
        for (int e = 0; e < 2; ++e) { const int b = (F.tid & 7) * 2 + e;
            if (b >= 3) { const int j = sel[tok * 16 + b]; const unsigned pos = __hip_atomic_fetch_add(&cnt[j], 1u, __ATOMIC_RELAXED, __HIP_MEMORY_SCOPE_WORKGROUP); list[j * 64 + pos] = (unsigned short)(tok * 13 + b - 3); } }
        __syncthreads(); }
    attn_stageB(P, lane, wave, tile0, g, lds, slab);
    SState st[2];
    attn_stageC_forced(P, lane, wave, tile0, g, lds, st);
    asm volatile("s_waitcnt vmcnt(0)" ::: "memory");
    __syncthreads();
    attn_stageC_merge(P, lane, wave, tile0, g, lds, slab, st);
    __syncthreads();
}

#define XB_TMO      128
#define XB_XCNT(j)  (256  + 64 * (j))
#define XB_XSUB(j)  (1280 + 64 * (j))
#define XB_XGEN(j)  (2304 + 64 * (j))
#define XB_TOP      3328
#define XB_TOPGEN   3392
#define XCD_BAR_WORDS 3456
#define XB_SPIN_CAP (1u << 22)
__device__ __forceinline__ unsigned xb_ld(unsigned* p)              { return __hip_atomic_load(p, __ATOMIC_RELAXED, __HIP_MEMORY_SCOPE_AGENT); }
__device__ __forceinline__ unsigned xb_add(unsigned* p, unsigned v) { return __hip_atomic_fetch_add(p, v, __ATOMIC_RELAXED, __HIP_MEMORY_SCOPE_AGENT); }
__device__ __forceinline__ unsigned xb_xcc_id() { return (unsigned)__builtin_amdgcn_s_getreg((3 << 11) | 20) & 0xFu; }
#define XB_SPIN(cond, bar) do { unsigned _sp = 0; while (cond) { __builtin_amdgcn_s_sleep(1); \
    if ((++_sp & 255u) == 0u) { if (xb_ld(&(bar)[XB_TMO])) break; if (_sp > XB_SPIN_CAP) { atomicAdd(&(bar)[XB_TMO], 1u); break; } } } } while (0)
struct XcdBarrier { unsigned* bar; unsigned x; volatile LAS unsigned* st; };
__device__ __forceinline__ XcdBarrier xcd_barrier_post(unsigned* bar, volatile LAS unsigned* st) {
    XcdBarrier b; b.bar = bar; b.x = xb_xcc_id(); b.st = st;
    if (threadIdx.x == 0) (void)xb_add(&bar[XB_XCNT(b.x)], 1u);
    return b;
}
__device__ __forceinline__ void xcd_barrier_complete(unsigned* bar, unsigned x, unsigned& nloc, unsigned& nx) {
    const unsigned G = gridDim.x * gridDim.y * gridDim.z;
    unsigned sum, cnt, mine, sp = 0u;
    for (;;) {
        sum = 0u; cnt = 0u; mine = 0u;
#pragma unroll
        for (unsigned j = 0; j < 16; ++j) { const unsigned c = xb_ld(&bar[XB_XCNT(j)]); sum += c; cnt += (c > 0u) ? 1u : 0u; mine = (j == x) ? c : mine; }
        if (sum == G) break;
        __builtin_amdgcn_s_sleep(1);
        if ((++sp & 255u) == 0u) { if (xb_ld(&bar[XB_TMO])) break; if (sp > XB_SPIN_CAP) { atomicAdd(&bar[XB_TMO], 1u); break; } }
    }
    nloc = mine > 0u ? mine : 1u; nx = cnt > 0u ? cnt : 1u;
}
__device__ __forceinline__ void xcd_barrier(const XcdBarrier& b) {
    asm volatile("s_waitcnt vmcnt(0)" ::: "memory");
    __syncthreads();
    if (threadIdx.x == 0) {
        unsigned* bar = b.bar;
        __builtin_amdgcn_s_waitcnt(0);
        unsigned nloc = b.st[0], nx = b.st[1];
        if (nloc == 0u) { xcd_barrier_complete(bar, b.x, nloc, nx); b.st[0] = nloc; b.st[1] = nx; }
        const unsigned old = xb_add(&bar[XB_XSUB(b.x)], 1u);
        const unsigned gen = old / nloc;
        if (old + 1u == (gen + 1u) * nloc) {
            __builtin_amdgcn_fence(__ATOMIC_RELEASE, "agent");
            asm volatile("s_waitcnt vmcnt(0)" ::: "memory");
            const unsigned og = xb_add(&bar[XB_TOP], 1u);
            const unsigned tg = og / nx;
            if (og + 1u == (tg + 1u) * nx) xb_add(&bar[XB_TOPGEN], 1u);
            else XB_SPIN(xb_ld(&bar[XB_TOPGEN]) == tg, bar);
            __builtin_amdgcn_fence(__ATOMIC_ACQUIRE, "agent");
            xb_add(&bar[XB_XGEN(b.x)], 1u);
            asm volatile("s_waitcnt vmcnt(0)" ::: "memory");
        } else {
            XB_SPIN(xb_ld(&bar[XB_XGEN(b.x)]) == gen, bar);
            __builtin_amdgcn_fence(__ATOMIC_ACQUIRE, "agent");
            asm volatile("s_waitcnt vmcnt(0)" ::: "memory");
        }
    }
    __syncthreads();
}

__global__ void __launch_bounds__(NWAVES * 64, 2) mk_fwd(Args args) {
    extern __shared__ __attribute__((aligned(16))) unsigned char lds_raw[];
    Frame F;
    F.lds = (LAS unsigned char*)lds_raw;
#define REFRESH() do { int t_ = threadIdx.x; asm volatile("" : "+v"(t_)); F.tid = t_; F.lane = t_ & 63; F.wave = __builtin_amdgcn_readfirstlane(t_ >> 6); F.gw = blockIdx.x * NWAVES + F.wave; } while (0)
    F.G = gridDim.x; F.ngw = F.G * NWAVES; REFRESH();
    F.out = args.out; F.ws = args.ws;
    const int lo = args.ph_lo, hi = args.ph_hi;
#define IN(k) (lo <= (k) && (k) < hi)
#ifndef USE_CG_SYNC
#define USE_CG_SYNC 0
#endif
    volatile LAS unsigned* bst = (volatile LAS unsigned*)(F.lds + LDS_BYTES - 64);
    if (F.tid < 16) bst[F.tid] = 0u;
    __syncthreads();
    XcdBarrier gbar; gbar.bar = (unsigned*)(F.ws + WS_CTL); gbar.x = 0; gbar.st = bst;
    if (!USE_CG_SYNC && hi - lo > 1) gbar = xcd_barrier_post((unsigned*)(F.ws + WS_CTL), bst);
#define SEAM(k) do { if (IN(k) && IN((k) + 1)) { if (USE_CG_SYNC) cg::this_grid().sync(); else xcd_barrier(gbar); } } while (0)
    unsigned char* ws = F.ws;
    if (IN(0)) { REFRESH(); p0_prologue(F, args); }
    SEAM(0);
    if (IN(1)) { REFRESH();
        pg8::Gemm g{(const bf16*)(ws + WS_XN), (const bf16*)(ws + WS_WIN), S, NPJ, 1024, 1024}; pg8::StaticOrder So; So.init(S, NPJ, F.G, (int)blockIdx.x);
        EpiProj E{(bf16*)(ws + WS_U), (bf16*)(ws + WS_Q), (bf16*)(ws + WS_KVH), (bf16*)(ws + WS_G), (bf16*)(ws + WS_GN)};
        pg8::gemm_phase<EpiProj, pg8::StaticOrder>(F.lds, g, So, E);
    }
    SEAM(1);
    if (IN(2)) { REFRESH();
        for (int u = F.gw; u < 64 * 32; u += F.ngw) s5_unit<false>(F, args, u >> 5, u & 31, F.lds + F.wave * 16384, F.lds + 131072 + F.wave * 2048);
        __syncthreads();
        pg8::Gemm g{(const bf16*)(ws + WS_KVH), (const bf16*)(ws + WS_WC1), 4096, 1024, 1024 / CMP_KS, 1024}; pg8::CmpOrder So{F.G, (int)blockIdx.x, CMP_KS};
        EpiCmp E{F.out};
        pg8::gemm_phase<EpiCmp, pg8::CmpOrder>(F.lds, g, So, E);
    }
    SEAM(2);
    if (IN(3)) { REFRESH();
        for (int u = F.gw; u < 64 * 32; u += F.ngw) s5_unit<true>(F, args, u >> 5, u & 31, F.lds + F.wave * 16384, F.lds + 131072 + F.wave * 2048);
        for (int u = F.gw; u < 4 * 1024; u += F.ngw) { const int kvg = u >> 10, n = u & 1023; cmp_l2_unit(F, args, kvg >> 1, kvg & 1, n, (LAS float*)(F.lds + F.wave * 16384)); }
        for (int u = F.gw; u < 2 * 512; u += F.ngw) vtw_item(F, u >> 9, u & 511);
        for (int u = F.gw; u < 2 * 256; u += F.ngw) vts_item(F, u >> 8, u & 255);
    }
    SEAM(3);
    if (IN(4)) { REFRESH();
        LAS float* BT = (LAS float*)(F.lds + AT_BT);
        for (int i = F.tid; i < 8 * 128; i += NWAVES * 64) { const int h = i >> 7, d = i & 127;
            int bk = d; if (d >= 16) { bk = 16 + (int)(logf((float)d * (1.0f / 16.0f)) / 2.0794415416798357f * 16.0f); if (bk > 31) bk = 31; }
            BT[i] = args.in[19][bk * 8 + h] * 1.4426950408889634f; }
        __syncthreads();
        for (int u = blockIdx.x; u < 256; u += F.G) {
#pragma unroll 1
            for (int g = 0; g < 2; ++g) { const int ta = ((u & 7) << 5) | (u >> 3);
                const int tile = g ? 255 - ta : ta;
                const unsigned soff = (unsigned)__builtin_amdgcn_readfirstlane((int)((blockIdx.x & 127u) * (unsigned)PSLAB));
                attn_tile(F, ws, tile, g, soff); } }
    }
    SEAM(4);
    if (IN(5)) { REFRESH();
        pg8::Gemm g{(const bf16*)(ws + WS_Z), (const bf16*)(ws + WS_WGLU), S, 512, 512, 512}; pg8::StaticOrder So; So.init(S, 512, F.G, (int)blockIdx.x);
        EpiGlu E{(const bf16*)(ws + WS_Z), (bf16*)(ws + WS_ZG)};
        pg8::gemm_phase<EpiGlu, pg8::StaticOrder>(F.lds, g, So, E);
    }
    SEAM(5);
    if (IN(6)) { REFRESH();
        pg8::TwoSegOrder So; So.init(S, 1024, F.G, (int)blockIdx.x);
        pg8::Gemm g{(const bf16*)(ws + WS_ZG), (const bf16*)(ws + WS_WA), S, 1024, 512, 512, (const bf16*)(ws + WS_O), (const bf16*)(ws + WS_WB)}; EpiMix2 E{(const bf16*)(ws + WS_G), (bf16*)(ws + WS_MIX)};
        pg8::gemm_phase<EpiMix2, pg8::TwoSegOrder>(F.lds, g, So, E);
    }
    SEAM(6);
    if (IN(7)) { REFRESH();
        pg8::Gemm g{(const bf16*)(ws + WS_MIX), (const bf16*)(ws + WS_WOUT), S, 1024, 1024, 1024}; pg8::StaticOrder So; So.init(S, 1024, F.G, (int)blockIdx.x);
        EpiResNorm E{args.in[0], F.out, (bf16*)(ws + WS_XN), (float*)(ws + WS_SSP), (LAS float*)(F.lds + pg8::STAGE_BYTES)};
        pg8::gemm_phase<EpiResNorm, pg8::StaticOrder>(F.lds, g, So, E);
    }
    SEAM(7);
    if (IN(9)) { REFRESH();
        pg8::Gemm g{(const bf16*)(ws + WS_XN), (const bf16*)(ws + WS_WGU), S, 2 * DFF, 1024, 1024}; pg8::StaticOrder So; So.init(S, 2 * DFF, F.G, (int)blockIdx.x);
        EpiFfn E{(bf16*)(ws + WS_H), (const float*)(ws + WS_SSP)};
        pg8::gemm_phase<EpiFfn, pg8::StaticOrder>(F.lds, g, So, E);
    }
    SEAM(9);
    if (IN(10)) { REFRESH();
        pg8::Gemm g{(const bf16*)(ws + WS_H), (const bf16*)(ws + WS_WD), S, 1024, DFF, DFF}; pg8::StaticOrder So; So.init(S, 1024, F.G, (int)blockIdx.x);
        EpiRes E{F.out, F.out};
        pg8::gemm_phase<EpiRes, pg8::StaticOrder>(F.lds, g, So, E);
    }
    SEAM(10);
    if (IN(11)) { REFRESH(); for (int m = F.gw; m < S; m += F.ngw) rms_row_f32(F.out + (size_t)m * DM, args.in[26], F.lane); }
#undef IN
#undef SEAM
}

extern "C" void kernel_launch(void* const* d_in, const int* in_sizes, int n_in, void* d_out, int out_size, void* d_ws, size_t ws_size, hipStream_t stream) {
    static int grid = 0;
    if (grid == 0) {
        if (n_in != 27 || out_size != S * DM || ws_size < WS_END) { fprintf(stderr, "kernel_launch: unexpected shapes (n_in %d out %d ws %zu)\n", n_in, out_size, ws_size); grid = -1; return; }
        int dev = 0, cus = 0, per_cu = 0;
        if (hipGetDevice(&dev) != hipSuccess || hipDeviceGetAttribute(&cus, hipDeviceAttributeMultiprocessorCount, dev) != hipSuccess) { grid = -1; return; }
        if (hipFuncSetAttribute((const void*)mk_fwd, hipFuncAttributeMaxDynamicSharedMemorySize, LDS_BYTES) != hipSuccess) { fprintf(stderr, "kernel_launch: hipFuncSetAttribute failed\n"); grid = -1; return; }
        if (hipOccupancyMaxActiveBlocksPerMultiprocessor(&per_cu, (const void*)mk_fwd, NWAVES * 64, LDS_BYTES) != hipSuccess || per_cu < 1) { fprintf(stderr, "kernel_launch: occupancy query says %d\n", per_cu); per_cu = 1; }
        (void)hipGetLastError();
        grid = cus * (per_cu < 1 ? 1 : 1);
    }
    if (grid < 0) return;
    if (hipMemsetAsync((char*)d_ws + WS_CTL, 0, 16384, stream) != hipSuccess) { fprintf(stderr, "kernel_launch: hipMemsetAsync failed\n"); return; }
    Args a{};
    for (int i = 0; i < 27; ++i) a.in[i] = (const float*)d_in[i];
    a.out = (float*)d_out; a.ws = (unsigned char*)d_ws;
    if (MK_N_LAUNCHES == 1) {
        a.ph_lo = 0; a.ph_hi = NPH;
        void* kargs[] = {&a};
        hipError_t e = hipLaunchCooperativeKernel((const void*)mk_fwd, dim3(grid), dim3(NWAVES * 64), kargs, LDS_BYTES, stream);
        if (e != hipSuccess) fprintf(stderr, "kernel_launch: cooperative launch failed: %s (grid %d)\n", hipGetErrorString(e), grid);
    } else {
        for (int ph = 0; ph < NPH; ++ph) { a.ph_lo = ph; a.ph_hi = ph + 1; hipLaunchKernelGGL(mk_fwd, dim3(grid), dim3(NWAVES * 64), LDS_BYTES, stream, a); }
    }
}
```

```cpp
#include <hip/hip_runtime.h>
#include <hip/hip_cooperative_groups.h>
#include <cstdio>
#include <cstdint>
namespace cg = cooperative_groups;

#ifndef MK_N_LAUNCHES
#define MK_N_LAUNCHES 1
#endif

namespace pg8 {
#define PG8_LAS __attribute__((address_space(3)))
typedef unsigned short bf16_t;
typedef short bf16x8 __attribute__((ext_vector_type(8)));
typedef float f32x4 __attribute__((ext_vector_type(4)));
typedef unsigned u32x4 __attribute__((ext_vector_type(4)));
constexpr int BM = 256, BK = 64, HALF = 128, HTB = HALF * BK * 2, STAGE_BYTES = 8 * HTB, NXCD = 8, WGM = 8;

__host__ __device__ __forceinline__ int lds_byte(int r, int c) { const int st = (r >> 4) * 2 + (c >> 5), rr = r & 15, cc = c & 31, ob = rr * 64 + cc * 2; return st * 1024 + (ob ^ (((ob >> 9) & 1) << 5)); }
__host__ __device__ __forceinline__ void stage_rc(int b, int& R, int& C) { const int st = b / 1024, sb = b % 1024, swz = sb ^ (((sb >> 9) & 1) << 5); R = (st >> 1) * 16 + swz / 64; C = (st & 1) * 32 + (swz % 64) / 2; }
__host__ __device__ __forceinline__ int perm32(int rho) { const int n = rho >> 4, i = rho & 15; return 8 * (i >> 2) + 4 * n + (i & 3); }

struct Unit { int pm, pn, ks, seg; };
struct Gemm { const bf16_t* A; const bf16_t* Bt; int M, N, K, ld; const bf16_t* A2; const bf16_t* Bt2; };

struct StaticOrder {
    static constexpr bool SINGLE = false;
    int nM, nN, nwg, G, c;
    __host__ __device__ void init(int M, int N, int G_, int c_) { nM = M / BM; nN = N / BM; nwg = nM * nN; G = G_; c = c_; }
    __host__ __device__ bool next(int i, Unit& u) const {
        const long L = (long)i * G + c; if (L >= nwg) return false;
        int wgid = (int)L; { const int q = nwg / NXCD, r = nwg % NXCD, xcd = wgid % NXCD, off = wgid / NXCD; wgid = (xcd < r ? xcd * (q + 1) : r * (q + 1) + (xcd - r) * q) + off; }
        const int nig = WGM * nN, gid = wgid / nig, fm = gid * WGM, gsz = (nM - fm) < WGM ? (nM - fm) : WGM;
        u.pm = fm + ((wgid % nig) % gsz); u.pn = (wgid % nig) / gsz; u.ks = 0; u.seg = 0; return true;
    }
};
struct TwoSegOrder : StaticOrder {
    __host__ __device__ bool next(int i, Unit& u) const { if (!StaticOrder::next(i >> 1, u)) return false; u.seg = i & 1; return true; }
};
struct CmpOrder {
    static constexpr bool SINGLE = true;
    int G, c, KS;
    __host__ __device__ bool next(int i, Unit& u) const {
        const int L = i * G + c; if (L >= 32 * KS) return false;
        const int tile = L / KS; u.ks = L % KS; u.pm = tile >> 1; u.pn = (tile & 1) + (u.pm >= 8 ? 2 : 0); u.seg = 0; return true;
    }
};

typedef float f32x2_t __attribute__((ext_vector_type(2))); typedef __bf16 bf16x2_t __attribute__((ext_vector_type(2)));
__device__ __forceinline__ unsigned cvt_pk_bf16(float lo, float hi) { f32x2_t v = {lo, hi}; bf16x2_t b = __builtin_convertvector(v, bf16x2_t); return __builtin_bit_cast(unsigned, b); }
__device__ __forceinline__ float bflo(unsigned w) { return __uint_as_float(w << 16); }
__device__ __forceinline__ float bfhi(unsigned w) { return __uint_as_float(w & 0xffff0000u); }
__device__ __forceinline__ float sigm(float x) { return __builtin_amdgcn_rcpf(1.0f + __expf(-x)); }

template <class Epi, class Sched>
__device__ __forceinline__ void gemm_phase(PG8_LAS unsigned char* lds, const Gemm g, const Sched& S, const Epi& E) {
    const int tid = threadIdx.x, wid = __builtin_amdgcn_readfirstlane(tid >> 6), lane = tid & 63, wr = wid >> 2, wc = wid & 3, fr = lane & 15, fq = lane >> 4;
    const int K = g.K, ld = g.ld, nt = K / BK;
    unsigned voffA[2], voffB[2];
#pragma unroll
    for (int i = 0; i < 2; ++i) { int R, C; stage_rc(tid * 16 + i * 8192, R, C); const int Rb = Epi::PERM ? ((R & ~31) + perm32(R & 31)) : R;
        voffA[i] = (unsigned)(R * ld + C) * 2u; voffB[i] = (unsigned)(Rb * ld + C) * 2u; }
    const size_t kstep = (size_t)(BK * 2);
    const size_t hstep = (size_t)HALF * ld * 2;
    const size_t tstep = 2 * hstep;
    const unsigned ldsw = (unsigned)wid * 1024u;
    const int aoff = lds_byte(wr * 64 + fr, fq * 8), boff = lds_byte(wc * 32 + fr, fq * 8);
#define PG8_SA(b, h) (((b) * 2 + (h)) * HTB)
#define PG8_SB(b, h) ((4 + (b) * 2 + (h)) * HTB)
#define PG8_STAGE(bufoff, gbase, voff) do { _Pragma("unroll") for (int _i = 0; _i < 2; ++_i) \
        __builtin_amdgcn_global_load_lds((const unsigned*)((const char*)(gbase) + (voff)[_i]), (PG8_LAS unsigned*)(lds + (bufoff) + ldsw + _i * 8192), 16, 0, 0); } while (0)
#define PG8_LDA(dst, b, h) do { _Pragma("unroll") for (int m = 0; m < 4; ++m) _Pragma("unroll") for (int k = 0; k < 2; ++k) dst[m][k] = *(const PG8_LAS bf16x8*)(lds + PG8_SA(b, h) + aoff + m * 2048 + k * 1024); } while (0)
#define PG8_LDB(dst, b, h) do { _Pragma("unroll") for (int n = 0; n < 2; ++n) _Pragma("unroll") for (int k = 0; k < 2; ++k) dst[n][k] = *(const PG8_LAS bf16x8*)(lds + PG8_SB(b, h) + boff + n * 2048 + k * 1024); } while (0)
#define PG8_MMA(ai, bj, At, Bt) do { __builtin_amdgcn_s_setprio(1); _Pragma("unroll") for (int m = 0; m < 4; ++m) _Pragma("unroll") for (int n = 0; n < 2; ++n) _Pragma("unroll") for (int k = 0; k < 2; ++k) \
        acc[ai][bj][m][n] = __builtin_amdgcn_mfma_f32_16x16x32_bf16(Bt[n][k], At[m][k], acc[ai][bj][m][n], 0, 0, 0); __builtin_amdgcn_s_setprio(0); } while (0)
#define PG8_WAIT_V(n) asm volatile("s_waitcnt vmcnt(" #n ")" ::: "memory")
#define PG8_WAIT_L(n) asm volatile("s_waitcnt lgkmcnt(" #n ")" ::: "memory")
#define PG8_BAR __builtin_amdgcn_s_barrier()
#define PG8_SCHED __builtin_amdgcn_sched_barrier(0)
    Unit cur, nxt; int ui = 0;
    if (!S.next(0, cur)) return;
    f32x4 acc[2][2][4][2];
#pragma unroll
    for (int a = 0; a < 2; ++a)
#pragma unroll
        for (int b = 0; b < 2; ++b)
#pragma unroll
            for (int m = 0; m < 4; ++m)
#pragma unroll
                for (int n = 0; n < 2; ++n) acc[a][b][m][n] = (f32x4){0.f, 0.f, 0.f, 0.f};
    bf16x8 At[4][2], B0[2][2], B1[2][2];
    const char* cA = (const char*)(cur.seg ? g.A2 : g.A) + (size_t)cur.pm * tstep + (size_t)cur.ks * K * 2; const char* cB = (const char*)(cur.seg ? g.Bt2 : g.Bt) + (size_t)cur.pn * tstep + (size_t)cur.ks * K * 2;
    PG8_STAGE(PG8_SB(0, 0), cB, voffB); PG8_STAGE(PG8_SB(0, 1), cB + hstep, voffB); PG8_STAGE(PG8_SA(0, 0), cA, voffA); PG8_STAGE(PG8_SA(0, 1), cA + hstep, voffA);
    if (wr == 1) PG8_BAR;
    PG8_WAIT_V(2); PG8_BAR;
    PG8_STAGE(PG8_SB(1, 0), cB + kstep, voffB); PG8_STAGE(PG8_SA(1, 0), cA + kstep, voffA); PG8_STAGE(PG8_SB(1, 1), cB + hstep + kstep, voffB);
    PG8_WAIT_V(6); PG8_BAR;
    for (;;) {
        const bool has_next = Sched::SINGLE ? false : S.next(ui + 1, nxt);
        const char* nA = has_next ? (const char*)(nxt.seg ? g.A2 : g.A) + (size_t)nxt.pm * tstep + (size_t)nxt.ks * K * 2 : cA; const char* nB = has_next ? (const char*)(nxt.seg ? g.Bt2 : g.Bt) + (size_t)nxt.pn * tstep + (size_t)nxt.ks * K * 2 : cB;
        for (int t = 0; t < nt; t += 2) {
            const bool last = (t == nt - 2);
            const char* a1 = cA + (size_t)(t + 1) * kstep;
            const char* a2 = last ? nA : cA + (size_t)(t + 2) * kstep; const char* b2 = last ? nB : cB + (size_t)(t + 2) * kstep;
            const char* a3 = a2 + kstep; const char* b3 = b2 + kstep;
            PG8_LDB(B0, 0, 0); PG8_LDB(B1, 0, 1); PG8_SCHED; PG8_LDA(At, 0, 0); PG8_STAGE(PG8_SA(1, 1), a1 + hstep, voffA);
            PG8_WAIT_V(8); PG8_WAIT_L(0); PG8_BAR; PG8_MMA(0, 0, At, B0); PG8_MMA(0, 1, At, B1); PG8_BAR; PG8_SCHED;
            PG8_LDA(At, 0, 1); PG8_STAGE(PG8_SB(0, 0), b2, voffB); PG8_STAGE(PG8_SB(0, 1), b2 + hstep, voffB); PG8_STAGE(PG8_SA(0, 0), a2, voffA);
            PG8_WAIT_V(8); PG8_WAIT_L(0); PG8_BAR; PG8_MMA(1, 0, At, B0); PG8_MMA(1, 1, At, B1); PG8_BAR; PG8_SCHED;
            PG8_LDB(B0, 1, 0); PG8_LDB(B1, 1, 1); PG8_SCHED; PG8_LDA(At, 1, 0); PG8_STAGE(PG8_SA(0, 1), a2 + hstep, voffA);
            PG8_WAIT_V(8); PG8_WAIT_L(0); PG8_BAR; PG8_MMA(0, 0, At, B0); PG8_MMA(0, 1, At, B1); PG8_BAR; PG8_SCHED;
            PG8_LDA(At, 1, 1); PG8_STAGE(PG8_SB(1, 0), b3, voffB); PG8_STAGE(PG8_SB(1, 1), b3 + hstep, voffB); PG8_STAGE(PG8_SA(1, 0), a3, voffA);
            PG8_WAIT_V(8); PG8_WAIT_L(0); PG8_BAR; PG8_MMA(1, 0, At, B0); PG8_MMA(1, 1, At, B1); PG8_BAR; PG8_SCHED;
        }
        if (wr == 0) PG8_BAR;
        E(acc, cur, wr, wc, fr, fq);
        if (!has_next) break;
        if (!nxt.seg) {
#pragma unroll
        for (int a = 0; a < 2; ++a)
#pragma unroll
            for (int b = 0; b < 2; ++b)
#pragma unroll
                for (int m = 0; m < 4; ++m)
#pragma unroll
                    for (int n = 0; n < 2; ++n) acc[a][b][m][n] = (f32x4){0.f, 0.f, 0.f, 0.f}; }
        cur = nxt; cA = nA; cB = nB; ++ui;
        if (wr == 1) PG8_BAR;
    }
    PG8_WAIT_V(0);
    PG8_BAR;
#undef PG8_SA
#undef PG8_SB
#undef PG8_STAGE
#undef PG8_LDA
#undef PG8_LDB
#undef PG8_MMA
#undef PG8_WAIT_V
#undef PG8_WAIT_L
#undef PG8_BAR
#undef PG8_SCHED
}
}

constexpr int S = 16384, DM = 1024, INC = 3864, NPJ = 4096, SSW = 512, NSW = 512, HD = 64, DFF = 2816;
constexpr int NGRP = 32, NST = 64, NCMP = 1023;
constexpr int NWAVES = 8;
constexpr int NPH = 12;
constexpr int CMP_KS = 4;
constexpr float EPS = 1e-6f;

constexpr size_t MiB = 1u << 20;
constexpr size_t WS_CTL = 0;
constexpr size_t WS_TAB = 1 * MiB;
constexpr size_t TAB_BF = 0, TAB_CF = 128 * 1024, TAB_LAM = 256 * 1024, TAB_LAM256 = 272 * 1024, TAB_POSB = 288 * 1024;
constexpr size_t WS_SSP = 1 * MiB + 512 * 1024;
constexpr size_t WS_F = 2 * MiB;
constexpr size_t WS_KVC = 3 * MiB;
constexpr size_t WS_WIN = 4 * MiB, WS_WGU = 12 * MiB, WS_WD = 23 * MiB, WS_WOUT = 29 * MiB, WS_WA = 31 * MiB, WS_WB = 32 * MiB, WS_WGLU = 33 * MiB, WS_WC1 = 34 * MiB;
constexpr size_t WS_XN = 36 * MiB;
constexpr size_t WS_Z = WS_XN, WS_ZG = WS_XN + 16 * MiB;
constexpr size_t WS_U = 68 * MiB, WS_O = WS_U;
constexpr size_t WS_Q = 84 * MiB;
constexpr size_t WS_KVH = 100 * MiB;
constexpr size_t WS_G = 124 * MiB;
constexpr size_t WS_GN = 188 * MiB;
constexpr size_t WS_MIX = 84 * MiB;
constexpr size_t WS_H = 100 * MiB;
constexpr size_t WS_VTW = 189 * MiB;
constexpr size_t WS_VTS = 193 * MiB;
constexpr size_t WS_KCB = 197 * MiB;
constexpr size_t WS_VTC = 197 * MiB + 512 * 1024;
constexpr size_t WS_PSLAB = 198 * MiB;
constexpr size_t WS_END = 254 * MiB;

constexpr int LDS_BYTES = 163840;

#define GAS __attribute__((address_space(1)))
#define LAS __attribute__((address_space(3)))
typedef unsigned short bf16;
typedef unsigned v4u __attribute__((ext_vector_type(4)));
typedef float f32x4 __attribute__((ext_vector_type(4)));
typedef float f32x2 __attribute__((ext_vector_type(2)));
typedef float f32x16 __attribute__((ext_vector_type(16)));
typedef short bf16x8 __attribute__((ext_vector_type(8)));
#define LDS_WAIT() asm volatile("s_waitcnt lgkmcnt(0)" ::: "memory")
#define VM_WAIT() asm volatile("s_waitcnt vmcnt(0)" ::: "memory")
__device__ __forceinline__ unsigned f2bf(float f) { unsigned u = __builtin_bit_cast(unsigned, f); return (u + 0x7fffu + ((u >> 16) & 1u)) >> 16; }
__device__ __forceinline__ unsigned pk2(float lo, float hi) { return f2bf(lo) | (f2bf(hi) << 16); }
__device__ __forceinline__ float bf2f(bf16 v) { return __uint_as_float((unsigned)v << 16); }
using pg8::bflo; using pg8::bfhi; using pg8::sigm; using pg8::cvt_pk_bf16;
__device__ __forceinline__ float gelu_tanh(float y) {
    const float a = 0.7978845608028654f * (y + 0.044715f * y * y * y);
    const float e = __expf(2.0f * a);
    const float th = 1.0f - 2.0f * __builtin_amdgcn_rcpf(e + 1.0f);
    return 0.5f * y * (1.0f + th);
}
__device__ __forceinline__ float wave_sum(float v) {
#pragma unroll
    for (int o = 1; o < 64; o <<= 1) v += __shfl_xor(v, o);
    return v;
}
__device__ __forceinline__ float wave_max(float v) {
#pragma unroll
    for (int o = 1; o < 64; o <<= 1) v = fmaxf(v, __shfl_xor(v, o));
    return v;
}

struct Args { const float* in[27]; float* out; unsigned char* ws; int ph_lo, ph_hi; };

struct Frame {
    LAS unsigned char* lds;
    int tid, lane, wave, G, gw, ngw;
    float* out; unsigned char* ws;
};

using pg8::Unit; using pg8::BM; using pg8::HALF;
struct EpiProj {
    static constexpr bool PERM = true;
    bf16 *U, *Q, *KVH, *Gt, *GN;
    __device__ __forceinline__ void operator()(const f32x4 (&acc)[2][2][4][2], const Unit& u, int wr, int wc, int fr, int fq) const {
        const int row0 = u.pm * BM + wr * 64 + fr, pn = u.pn;
#pragma unroll
        for (int ai = 0; ai < 2; ++ai)
#pragma unroll
            for (int m = 0; m < 4; ++m) { const int row = row0 + ai * HALF + m * 16;
#pragma unroll
                for (int bj = 0; bj < 2; ++bj) { f32x4 v0 = acc[ai][bj][m][0], v1 = acc[ai][bj][m][1]; const int col = bj * HALF + wc * 32 + 8 * fq; bf16* dst;
                    if (pn < 2) dst = U + (size_t)row * 512 + pn * 256 + col;
                    else if (pn < 4) { v0 = v0 * (0.125f * 1.4426950408889634f); v1 = v1 * (0.125f * 1.4426950408889634f); dst = Q + (size_t)row * 512 + (pn - 2) * 256 + col; }
                    else if (pn < 7) dst = KVH + ((size_t)((pn - 4) * 4 + (col >> 6)) * S + row) * 64 + (col & 63);
                    else { v0 = (f32x4){sigm(v0[0]), sigm(v0[1]), sigm(v0[2]), sigm(v0[3])}; v1 = (f32x4){sigm(v1[0]), sigm(v1[1]), sigm(v1[2]), sigm(v1[3])};
                        if (pn < 15) dst = Gt + (size_t)row * 2048 + (pn - 7) * 256 + col; else { if (col >= 32) continue; dst = GN + (size_t)row * 32 + col; } }
                    v4u w; w.x = cvt_pk_bf16(v0[0], v0[1]); w.y = cvt_pk_bf16(v0[2], v0[3]); w.z = cvt_pk_bf16(v1[0], v1[1]); w.w = cvt_pk_bf16(v1[2], v1[3]);
                    *(v4u*)dst = w; } }
    }
};
struct EpiCmp {
    static constexpr bool PERM = false;
    float* C;
    __device__ __forceinline__ void operator()(const f32x4 (&acc)[2][2][4][2], const Unit& u, int wr, int wc, int fr, int fq) const {
        const int row0 = u.pm * BM + wr * 64 + fr, col0 = (u.pn & 1) * BM + wc * 32 + 4 * fq; float* base = C + (size_t)u.ks * 4096 * 512;
#pragma unroll
        for (int ai = 0; ai < 2; ++ai)
#pragma unroll
            for (int m = 0; m < 4; ++m) { float* rowp = base + (size_t)(row0 + ai * HALF + m * 16) * 512 + col0;
#pragma unroll
                for (int bj = 0; bj < 2; ++bj)
#pragma unroll
                    for (int n = 0; n < 2; ++n) *(f32x4*)(rowp + bj * HALF + n * 16) = acc[ai][bj][m][n]; }
    }
};
struct EpiGlu {
    static constexpr bool PERM = true;
    const bf16* Z; bf16* ZG;
    __device__ __forceinline__ void operator()(const f32x4 (&acc)[2][2][4][2], const Unit& u, int wr, int wc, int fr, int fq) const {
        const int row0 = u.pm * BM + wr * 64 + fr;
#pragma unroll
        for (int ai = 0; ai < 2; ++ai)
#pragma unroll
            for (int m = 0; m < 4; ++m) { const int row = row0 + ai * HALF + m * 16;
#pragma unroll
                for (int bj = 0; bj < 2; ++bj) { const f32x4 v0 = acc[ai][bj][m][0], v1 = acc[ai][bj][m][1]; const size_t off = (size_t)row * 512 + u.pn * BM + bj * HALF + wc * 32 + 8 * fq;
                    const v4u z = *(const v4u*)(Z + off); v4u w;
                    w.x = cvt_pk_bf16(bflo(z.x) * sigm(v0[0]), bfhi(z.x) * sigm(v0[1])); w.y = cvt_pk_bf16(bflo(z.y) * sigm(v0[2]), bfhi(z.y) * sigm(v0[3]));
                    w.z = cvt_pk_bf16(bflo(z.z) * sigm(v1[0]), bfhi(z.z) * sigm(v1[1])); w.w = cvt_pk_bf16(bflo(z.w) * sigm(v1[2]), bfhi(z.w) * sigm(v1[3]));
                    *(v4u*)(ZG + off) = w; } }
    }
};
struct EpiMix2 {
    static constexpr bool PERM = true;
    const bf16* Gt; bf16* MIX;
    __device__ __forceinline__ void operator()(f32x4 (&acc)[2][2][4][2], const Unit& u, int wr, int wc, int fr, int fq) const {
        const int row0 = u.pm * BM + wr * 64 + fr;
#pragma unroll
        for (int ai = 0; ai < 2; ++ai)
#pragma unroll
            for (int m = 0; m < 4; ++m) { const int row = row0 + ai * HALF + m * 16;
#pragma unroll
                for (int bj = 0; bj < 2; ++bj) { const int col = u.pn * BM + bj * HALF + wc * 32 + 8 * fq;
                    const v4u gb = *(const v4u*)(Gt + (size_t)row * 2048 + 1024 + col);
                    const float b8[8] = {bflo(gb.x), bfhi(gb.x), bflo(gb.y), bfhi(gb.y), bflo(gb.z), bfhi(gb.z), bflo(gb.w), bfhi(gb.w)};
                    if (u.seg == 0) { const v4u ga = *(const v4u*)(Gt + (size_t)row * 2048 + col);
                        const float a8[8] = {bflo(ga.x), bfhi(ga.x), bflo(ga.y), bfhi(ga.y), bflo(ga.z), bfhi(ga.z), bflo(ga.w), bfhi(ga.w)};
#pragma unroll
                        for (int e = 0; e < 4; ++e) { acc[ai][bj][m][0][e] *= a8[e] * __builtin_amdgcn_rcpf(b8[e]); acc[ai][bj][m][1][e] *= a8[4 + e] * __builtin_amdgcn_rcpf(b8[4 + e]); }
                    } else { const f32x4 v0 = acc[ai][bj][m][0], v1 = acc[ai][bj][m][1]; v4u w;
                        w.x = cvt_pk_bf16(v0[0] * b8[0], v0[1] * b8[1]); w.y = cvt_pk_bf16(v0[2] * b8[2], v0[3] * b8[3]); w.z = cvt_pk_bf16(v1[0] * b8[4], v1[1] * b8[5]); w.w = cvt_pk_bf16(v1[2] * b8[6], v1[3] * b8[7]);
                        *(v4u*)(MIX + (size_t)row * 1024 + col) = w; } } }
    }
};
struct EpiRes {
    static constexpr bool PERM = false;
    const float* base; float* out;
    __device__ __forceinline__ void operator()(const f32x4 (&acc)[2][2][4][2], const Unit& u, int wr, int wc, int fr, int fq) const {
        const int row0 = u.pm * BM + wr * 64 + fr, col0 = u.pn * BM + wc * 32 + 4 * fq;
#pragma unroll
        for (int ai = 0; ai < 2; ++ai)
#pragma unroll
            for (int m = 0; m < 4; ++m) { const size_t off = (size_t)(row0 + ai * HALF + m * 16) * 1024 + col0;
#pragma unroll
                for (int bj = 0; bj < 2; ++bj)
#pragma unroll
                    for (int n = 0; n < 2; ++n) { const f32x4 b = *(const f32x4*)(base + off + bj * HALF + n * 16); *(f32x4*)(out + off + bj * HALF + n * 16) = b + acc[ai][bj][m][n]; } }
    }
};
struct EpiResNorm {
    static constexpr bool PERM = false;
    const float* base; float* out; bf16* XN; float* SSP; LAS float* part;
    __device__ __forceinline__ void operator()(const f32x4 (&acc)[2][2][4][2], const Unit& u, int wr, int wc, int fr, int fq) const {
        const int row0 = u.pm * BM + wr * 64 + fr, col0 = u.pn * BM + wc * 32 + 4 * fq;
#pragma unroll
        for (int ai = 0; ai < 2; ++ai)
#pragma unroll
            for (int m = 0; m < 4; ++m) { const size_t off = (size_t)(row0 + ai * HALF + m * 16) * 1024 + col0; float ss = 0.f;
#pragma unroll
                for (int bj = 0; bj < 2; ++bj)
#pragma unroll
                    for (int n = 0; n < 2; ++n) { const f32x4 b = *(const f32x4*)(base + off + bj * HALF + n * 16); const f32x4 x1 = b + acc[ai][bj][m][n]; *(f32x4*)(out + off + bj * HALF + n * 16) = x1;
                        *(unsigned long long*)(XN + off + bj * HALF + n * 16) = (unsigned long long)cvt_pk_bf16(x1[0], x1[1]) | ((unsigned long long)cvt_pk_bf16(x1[2], x1[3]) << 32);
                        ss += (x1[0] * x1[0] + x1[1] * x1[1]) + (x1[2] * x1[2] + x1[3] * x1[3]); }
                ss += __shfl_xor(ss, 16); ss += __shfl_xor(ss, 32);
                if (fq == 0) part[(ai * HALF + wr * 64 + m * 16 + fr) * 4 + wc] = ss; }
        asm volatile("s_waitcnt lgkmcnt(0)" ::: "memory"); __builtin_amdgcn_s_barrier(); asm volatile("" ::: "memory");
        if (threadIdx.x < 256) { const f32x4 p = *(const LAS f32x4*)(part + threadIdx.x * 4); SSP[(size_t)(u.pm * BM + threadIdx.x) * 4 + u.pn] = (p[0] + p[1]) + (p[2] + p[3]); }
    }
};
struct EpiFfn {
    static constexpr bool PERM = true;
    bf16* H; const float* SSP;
    __device__ __forceinline__ void operator()(const f32x4 (&acc)[2][2][4][2], const Unit& u, int wr, int wc, int fr, int fq) const {
        const int row0 = u.pm * BM + wr * 64 + fr;
#pragma unroll
        for (int ai = 0; ai < 2; ++ai)
#pragma unroll
            for (int m = 0; m < 4; ++m) { const int row = row0 + ai * HALF + m * 16;
                const f32x4 sp = *(const f32x4*)(SSP + (size_t)row * 4); const float rs = 1.0f / sqrtf(((sp[0] + sp[1]) + (sp[2] + sp[3])) * (1.f / 1024.f) + 1e-6f);
                float r[8];
#pragma unroll
                for (int n = 0; n < 2; ++n)
#pragma unroll
                    for (int e = 0; e < 4; ++e) { const float gt = acc[ai][0][m][n][e] * rs, up = acc[ai][1][m][n][e] * rs; r[n * 4 + e] = gt * sigm(gt) * up; }
                v4u w; w.x = cvt_pk_bf16(r[0], r[1]); w.y = cvt_pk_bf16(r[2], r[3]); w.z = cvt_pk_bf16(r[4], r[5]); w.w = cvt_pk_bf16(r[6], r[7]);
                *(v4u*)(H + (size_t)row * DFF + u.pn * HALF + wc * 32 + 8 * fq) = w; }
    }
};

struct TrDesc { const float* src; bf16* dst; int ld, ncols, dld, drow, kb, nb; const float* gain; };
__device__ __forceinline__ void tr_load(const TrDesc& d, float (&v)[32], int lane) {
    const int k0 = 64 * d.kb, c = 32 * d.nb + (lane & 31); const bool ok = c < d.ncols; const float* p = d.src + (size_t)(k0 + (lane >> 5)) * d.ld + c;
#pragma unroll
    for (int i = 0; i < 32; ++i) v[i] = ok ? p[(size_t)(2 * i) * d.ld] : 0.f;
    if (d.gain) {
#pragma unroll
        for (int i = 0; i < 32; ++i) v[i] *= d.gain[k0 + 2 * i + (lane >> 5)]; }
}
__device__ __forceinline__ void tr_finish(const TrDesc& d, const float (&v)[32], LAS float* scr, int lane) {
#pragma unroll
    for (int i = 0; i < 32; ++i) scr[(2 * i + (lane >> 5)) * 33 + (lane & 31)] = v[i];
    LDS_WAIT();
    const int cc = lane & 7, k0 = 64 * d.kb;
#pragma unroll
    for (int j = 0; j < 4; ++j) { const int n = (lane >> 3) + 8 * j; const LAS float* s = scr + (8 * cc) * 33 + n;
        v4u o; o.x = pk2(s[0 * 33], s[1 * 33]); o.y = pk2(s[2 * 33], s[3 * 33]); o.z = pk2(s[4 * 33], s[5 * 33]); o.w = pk2(s[6 * 33], s[7 * 33]);
        *(v4u*)(d.dst + (size_t)(d.drow + n) * d.dld + k0 + 8 * cc) = o; }
    LDS_WAIT();
}
__device__ __forceinline__ void rms_row_to_bf16(const float* xrow, const float* gain, bf16* orow, int lane) {
    const f32x4* xr = (const f32x4*)xrow + lane; const f32x4* gr = (const f32x4*)gain + lane;
    f32x4 v[4]; float s = 0.f;
#pragma unroll
    for (int j = 0; j < 4; ++j) { v[j] = xr[64 * j]; s += (v[j].x * v[j].x + v[j].y * v[j].y) + (v[j].z * v[j].z + v[j].w * v[j].w); }
    const float rstd = 1.0f / sqrtf(wave_sum(s) * (1.f / DM) + EPS);
    unsigned long long* o8 = (unsigned long long*)orow + lane;
#pragma unroll
    for (int j = 0; j < 4; ++j) { const f32x4 gq = gr[64 * j];
        o8[64 * j] = (unsigned long long)pk2(v[j].x * rstd * gq.x, v[j].y * rstd * gq.y) | ((unsigned long long)pk2(v[j].z * rstd * gq.z, v[j].w * rstd * gq.w) << 32); }
}
__device__ __forceinline__ void rms_rows2_to_bf16(const float* x0, const float* x1, const float* gain, bf16* o0, bf16* o1, int lane) {
    const f32x4* xa = (const f32x4*)x0 + lane; const f32x4* xb = (const f32x4*)x1 + lane; const f32x4* gr = (const f32x4*)gain + lane;
    f32x4 va[4], vb[4]; float sa = 0.f, sb = 0.f;
#pragma unroll
    for (int j = 0; j < 4; ++j) { va[j] = xa[64 * j]; vb[j] = xb[64 * j]; }
#pragma unroll
    for (int j = 0; j < 4; ++j) { sa += (va[j].x * va[j].x + va[j].y * va[j].y) + (va[j].z * va[j].z + va[j].w * va[j].w); sb += (vb[j].x * vb[j].x + vb[j].y * vb[j].y) + (vb[j].z * vb[j].z + vb[j].w * vb[j].w); }
    const float ra = 1.0f / sqrtf(wave_sum(sa) * (1.f / DM) + EPS), rb = 1.0f / sqrtf(wave_sum(sb) * (1.f / DM) + EPS);
    unsigned long long* pa = (unsigned long long*)o0 + lane; unsigned long long* pb = (unsigned long long*)o1 + lane;
#pragma unroll
    for (int j = 0; j < 4; ++j) { const f32x4 gq = gr[64 * j];
        pa[64 * j] = (unsigned long long)pk2(va[j].x * ra * gq.x, va[j].y * ra * gq.y) | ((unsigned long long)pk2(va[j].z * ra * gq.z, va[j].w * ra * gq.w) << 32);
        pb[64 * j] = (unsigned long long)pk2(vb[j].x * rb * gq.x, vb[j].y * rb * gq.y) | ((unsigned long long)pk2(vb[j].z * rb * gq.z, vb[j].w * rb * gq.w) << 32); }
}
__device__ __forceinline__ void rms_row_f32(float* xrow, const float* gain, int lane) {
    f32x4* xr = (f32x4*)xrow + lane; const f32x4* gr = (const f32x4*)gain + lane;
    f32x4 v[4]; float s = 0.f;
#pragma unroll
    for (int j = 0; j < 4; ++j) { v[j] = xr[64 * j]; s += (v[j].x * v[j].x + v[j].y * v[j].y) + (v[j].z * v[j].z + v[j].w * v[j].w); }
    const float rstd = 1.0f / sqrtf(wave_sum(s) * (1.f / DM) + EPS);
#pragma unroll
    for (int j = 0; j < 4; ++j) { const f32x4 gq = gr[64 * j]; xr[64 * j] = v[j] * rstd * gq; }
}
__device__ __forceinline__ void s5_tables(const Frame& F, const Args& args, int g) {
    const int lane = F.lane;
    const float* are = args.in[3]; const float* aim = args.in[4]; const float* ldt = args.in[5]; const float* bre = args.in[6]; const float* bim = args.in[7]; const float* cre = args.in[8]; const float* cim = args.in[9];
    const double dt = exp((double)ldt[g]);
    {   const int p = lane; const double ar = are[g * 64 + p], ai = aim[g * 64 + p];
        const double er = exp(ar * dt), lr = er * cos(ai * dt), li = er * sin(ai * dt);
        ((f32x2*)(F.ws + WS_TAB + TAB_LAM))[g * 64 + p] = (f32x2){(float)lr, (float)li};
        const double e2 = exp(ar * dt * 256.0), l2r = e2 * cos(ai * dt * 256.0), l2i = e2 * sin(ai * dt * 256.0);
        ((f32x2*)(F.ws + WS_TAB + TAB_LAM256))[g * 64 + p] = (f32x2){(float)l2r, (float)l2i}; }
#pragma unroll
    for (int nt = 0; nt < 4; ++nt) { const int col = 32 * nt + (lane & 31), p = col >> 1, ri = col & 1;
        const double ar = are[g * 64 + p], ai = aim[g * 64 + p];
        const double er = exp(ar * dt), lr = er * cos(ai * dt) - 1.0, li = er * sin(ai * dt);
        const double den = ar * ar + ai * ai, kr = (lr * ar + li * ai) / den, ki = (li * ar - lr * ai) / den;
        float v[8];
#pragma unroll
        for (int j = 0; j < 8; ++j) { const int c = 8 * (lane >> 5) + j; const double br = bre[(g * 64 + p) * 16 + c], bi = bim[(g * 64 + p) * 16 + c];
            v[j] = (float)(ri ? (kr * bi + ki * br) : (kr * br - ki * bi)); }
        v4u o; o.x = pk2(v[0], v[1]); o.y = pk2(v[2], v[3]); o.z = pk2(v[4], v[5]); o.w = pk2(v[6], v[7]);
        ((v4u*)(F.ws + WS_TAB + TAB_BF))[(g * 4 + nt) * 64 + lane] = o; }
#pragma unroll
    for (int ks = 0; ks < 4; ++ks) { const int ch = lane & 15; float v[8];
#pragma unroll
        for (int j = 0; j < 8; ++j) { const int k = 32 * ks + 8 * (lane >> 4) + j, p = k >> 1, ri = k & 1; v[j] = ri ? -cim[(g * 16 + ch) * 64 + p] : cre[(g * 16 + ch) * 64 + p]; }
        v4u o; o.x = pk2(v[0], v[1]); o.y = pk2(v[2], v[3]); o.z = pk2(v[4], v[5]); o.w = pk2(v[6], v[7]);
        ((v4u*)(F.ws + WS_TAB + TAB_CF))[(g * 4 + ks) * 64 + lane] = o; }
}
__device__ __forceinline__ void p0_prologue(const Frame& F, const Args& args) {
    LAS float* scr = (LAS float*)(F.lds + F.wave * 16384);
    const int gw = F.gw, NGW = F.ngw, lane = F.lane;
    if (F.wave == 0 && blockIdx.x < 32) s5_tables(F, args, (int)blockIdx.x);
    else if (F.wave == 1 && blockIdx.x < 128) {
        const int it = (int)blockIdx.x, kv = it >> 6, part = (it >> 2) & 15, cgp = it & 3;
        const float* pos = kv ? args.in[14] : args.in[13]; const float* w1 = kv ? args.in[17] : args.in[15]; float a = 0.f;
#pragma unroll 1
        for (int r0 = 128 * part; r0 < 128 * part + 128; r0 += 32) { float wv[32];
#pragma unroll
            for (int i = 0; i < 32; ++i) wv[i] = w1[(size_t)(r0 + i) * 256 + cgp * 64 + lane];
#pragma unroll
            for (int i = 0; i < 32; ++i) a += pos[r0 + i] * wv[i]; }
        ((float*)(F.ws + WS_TAB + TAB_POSB))[(kv * 16 + part) * 256 + cgp * 64 + lane] = a;
    }
    { v4u* z = (v4u*)(F.ws + WS_WIN + (size_t)3872 * 1024 * 2); const int n16 = 224 * 1024 * 2 / 16;
      for (int i = blockIdx.x * 512 + F.tid; i < n16; i += F.G * 512) z[i] = (v4u){0u, 0u, 0u, 0u}; }
    bf16* WIN = (bf16*)(F.ws + WS_WIN); bf16* WGU = (bf16*)(F.ws + WS_WGU); bf16* WD = (bf16*)(F.ws + WS_WD); bf16* WOUT = (bf16*)(F.ws + WS_WOUT);
    bf16* WA = (bf16*)(F.ws + WS_WA); bf16* WB = (bf16*)(F.ws + WS_WB); bf16* WGLU = (bf16*)(F.ws + WS_WGLU); bf16* WC1 = (bf16*)(F.ws + WS_WC1);
    constexpr int I1 = 16 * 56, I2 = 16 * 64, I3 = 16, IGLU = 8 * 16, IUP = 8 * 32, IOUT = 16 * 32, IFF = 16 * 88, IDN = 44 * 32, ICM = 16 * 8;
    constexpr int NITEMS = I1 + I2 + I3 + IGLU + 2 * IUP + IOUT + 2 * IFF + IDN + 4 * ICM;
    auto desc = [&](int it) -> TrDesc {
        int r = it;
        if (r < I1) return TrDesc{args.in[2], WIN, INC, 1792, 1024, 32 * (r % 56), r / 56, r % 56, nullptr}; r -= I1;
        if (r < I2) return TrDesc{args.in[2] + 1816, WIN, INC, 2048, 1024, 1792 + 32 * (r % 64), r / 64, r % 64, nullptr}; r -= I2;
        if (r < I3) return TrDesc{args.in[2] + 1792, WIN, INC, 24, 1024, 3840, r, 0, nullptr}; r -= I3;
        if (r < IGLU) return TrDesc{args.in[11], WGLU, 512, 512, 512, 32 * (r % 16), r / 16, r % 16, nullptr}; r -= IGLU;
        if (r < IUP) return TrDesc{args.in[12], WA, 1024, 1024, 512, 32 * (r % 32), r / 32, r % 32, nullptr}; r -= IUP;
        if (r < IUP) return TrDesc{args.in[20], WB, 1024, 1024, 512, 32 * (r % 32), r / 32, r % 32, nullptr}; r -= IUP;
        if (r < IOUT) return TrDesc{args.in[21], WOUT, 1024, 1024, 1024, 32 * (r % 32), r / 32, r % 32, nullptr}; r -= IOUT;
        if (r < IFF) { const int nb = r % 88; return TrDesc{args.in[23], WGU, DFF, DFF, 1024, (nb >> 2) * 256 + (nb & 3) * 32, r / 88, nb, args.in[22]}; } r -= IFF;
        if (r < IFF) { const int nb = r % 88; return TrDesc{args.in[24], WGU, DFF, DFF, 1024, (nb >> 2) * 256 + (nb & 3) * 32 + 128, r / 88, nb, args.in[22]}; } r -= IFF;
        if (r < IDN) return TrDesc{args.in[25], WD, 1024, 1024, DFF, 32 * (r % 32), r / 32, r % 32, nullptr}; r -= IDN;
        const int q = r / ICM, rr = r % ICM;
        return TrDesc{((q >> 1) ? args.in[17] : args.in[15]) + (size_t)(q & 1) * 1024 * 256, WC1, 256, 256, 1024, q * 256 + 32 * (rr % 8), rr / 8, rr % 8, nullptr};
    };
    if (gw < NITEMS) {
        TrDesc dc = desc(gw); float vc[32]; tr_load(dc, vc, lane);
#pragma unroll 1
        for (int it = gw; it < NITEMS; it += NGW) {
            const bool more = it + NGW < NITEMS; TrDesc dn = desc(more ? it + NGW : it); float vn[32]; tr_load(dn, vn, lane);
            tr_finish(dc, vc, scr, lane);
            dc = dn;
#pragma unroll
            for (int i = 0; i < 32; ++i) vc[i] = vn[i];
        }
    }
    bf16* XN = (bf16*)(F.ws + WS_XN);
    for (int m = gw; m < S; m += 2 * NGW) rms_rows2_to_bf16(args.in[0] + (size_t)m * DM, args.in[0] + (size_t)(m + NGW) * DM, args.in[1], XN + (size_t)m * DM, XN + (size_t)(m + NGW) * DM, lane);
}

__device__ __forceinline__ int crow(int r, int hi) { return (r & 3) + 8 * (r >> 2) + 4 * hi; }
template <bool FINAL>
__device__ __forceinline__ void s5_unit(const Frame& F, const Args& args, int c, int g, LAS unsigned char* wl, LAS unsigned char* wx) {
    const int lane = F.lane, hi = lane >> 5;
    const bf16* U = (const bf16*)(F.ws + WS_U); bf16* Z = (bf16*)(F.ws + WS_Z);
    bf16x8 bfg[4], cfg[4], ua[8];
#pragma unroll
    for (int sub = 0; sub < 8; ++sub) ua[sub] = *(const bf16x8*)(U + (size_t)(c * 256 + sub * 32 + (lane & 31)) * 512 + g * 16 + 8 * hi);
#pragma unroll
    for (int nt = 0; nt < 4; ++nt) bfg[nt] = ((const bf16x8*)(F.ws + WS_TAB + TAB_BF))[(g * 4 + nt) * 64 + lane];
    const f32x2 lam = ((const f32x2*)(F.ws + WS_TAB + TAB_LAM))[g * 64 + lane];
    f32x2* Fst = (f32x2*)(F.ws + WS_F);
    float xr = 0.f, xi = 0.f, dsk = 0.f;
    if (FINAL) {
#pragma unroll
        for (int ks = 0; ks < 4; ++ks) cfg[ks] = ((const bf16x8*)(F.ws + WS_TAB + TAB_CF))[(g * 4 + ks) * 64 + lane];
        dsk = args.in[10][g * 16 + (lane & 15)];
        const f32x2 L2 = ((const f32x2*)(F.ws + WS_TAB + TAB_LAM256))[g * 64 + lane];
        for (int cp = 0; cp < c; ++cp) { const f32x2 f = Fst[(cp * 32 + g) * 64 + lane]; const float nr = L2.x * xr - L2.y * xi + f.x, ni = L2.x * xi + L2.y * xr + f.y; xr = nr; xi = ni; }
    }
#pragma unroll
    for (int sub = 0; sub < 8; ++sub) {
        const int t0 = c * 256 + sub * 32;
        const bf16x8 a = ua[sub];
        if (FINAL) *(LAS bf16x8*)(wx + (lane & 31) * 32 + hi * 16) = a;
#pragma unroll
        for (int nt = 0; nt < 4; ++nt) { f32x16 acc = {}; acc = __builtin_amdgcn_mfma_f32_32x32x16_bf16(a, bfg[nt], acc, 0, 0, 0);
#pragma unroll
            for (int r = 0; r < 16; ++r) ((LAS float*)wl)[crow(r, hi) * 128 + 32 * nt + (lane & 31)] = acc[r]; }
        LDS_WAIT();
        f32x2 bu[32];
#pragma unroll
        for (int tk = 0; tk < 32; ++tk) bu[tk] = ((const LAS f32x2*)wl)[tk * 64 + lane];
        LDS_WAIT();
#pragma unroll
        for (int tk = 0; tk < 32; ++tk) { const float nr = lam.x * xr - lam.y * xi + bu[tk].x, ni = lam.x * xi + lam.y * xr + bu[tk].y; xr = nr; xi = ni;
            if (FINAL) ((LAS unsigned*)wl)[tk * 128 + ((lane + 4 * tk) & 63)] = pk2(xr, xi); }
        if (FINAL) {
            LDS_WAIT();
            LAS unsigned short* zt = (LAS unsigned short*)(wx + 1024);
#pragma unroll
            for (int mt = 0; mt < 2; ++mt) { f32x4 y4 = {0.f, 0.f, 0.f, 0.f}; const int row = 16 * mt + (lane & 15);
#pragma unroll
                for (int ks = 0; ks < 4; ++ks) { const bf16x8 xa = *(const LAS bf16x8*)(wl + row * 512 + ((64 * ks + 16 * (lane >> 4) + 16 * row) & 255)); y4 = __builtin_amdgcn_mfma_f32_16x16x32_bf16(xa, cfg[ks], y4, 0, 0, 0); }
#pragma unroll
                for (int r = 0; r < 4; ++r) { const int tok = 16 * mt + 4 * (lane >> 4) + r; const float uu = bf2f(((const LAS unsigned short*)wx)[tok * 16 + (lane & 15)]);
                    zt[tok * 16 + (lane & 15)] = (unsigned short)f2bf(gelu_tanh(y4[r] + dsk * uu)); } }
            LDS_WAIT();
            *(v4u*)(Z + (size_t)(t0 + (lane >> 1)) * 512 + g * 16 + 8 * (lane & 1)) = *(const LAS v4u*)(wx + 1024 + lane * 16);
            LDS_WAIT();
        }
    }
    if (!FINAL) Fst[(c * 32 + g) * 64 + lane] = (f32x2){xr, xi};
}

__device__ __forceinline__ int krow(int s, int h, int j) { return 16 * s + 8 * (j >> 2) + 4 * h + (j & 3); }
__device__ __forceinline__ void cmp_l2_unit(const Frame& F, const Args& args, int kv, int g, int n, LAS float* hb) {
    const int lane = F.lane; const float* P1 = F.out;
    float o = 0.f;
    if (n < NCMP) {
        const int rt = kv * 2048 + g * 1024 + n;
        const float* posb = (const float*)(F.ws + WS_TAB + TAB_POSB) + kv * 16 * 256;
#pragma unroll
        for (int i = 0; i < 4; ++i) { const int j = lane + 64 * i; float a = 0.f;
#pragma unroll
            for (int ks = 0; ks < CMP_KS; ++ks) a += P1[((size_t)ks * 4096 + rt) * 512 + j] + P1[((size_t)ks * 4096 + rt + 1) * 512 + 256 + j];
#pragma unroll
            for (int p = 0; p < 16; ++p) a += posb[p * 256 + j];
            hb[j] = gelu_tanh(a); }
        LDS_WAIT();
        const float* w2 = kv ? args.in[18] : args.in[16];
#pragma unroll 8
        for (int j = 0; j < 256; ++j) o += hb[j] * w2[j * 64 + lane];
    }
    if (kv == 0) ((bf16*)(F.ws + WS_KCB))[((size_t)g * 1024 + n) * 64 + lane] = (bf16)f2bf(o);
    else { const int grp = n >> 5, kk = n & 31, sx = kk >> 4, rem = kk & 15, hh = (rem >> 2) & 1, j = ((rem >> 3) << 2) | (rem & 3), d0 = lane >> 5, ln = hh * 32 + (lane & 31);
        ((bf16*)(F.ws + WS_VTC))[((((size_t)(g * 32 + grp) * 2 + d0) * 2 + sx) * 64 + ln) * 8 + j] = (bf16)f2bf(o); }
    LDS_WAIT();
}
__device__ __forceinline__ void vtw_item(const Frame& F, int g, int grp) {
    const int lane = F.lane, hi = lane >> 5; const bf16* V = (const bf16*)(F.ws + WS_KVH) + (size_t)(10 + g) * S * 64;
#pragma unroll
    for (int d0 = 0; d0 < 2; ++d0)
#pragma unroll
        for (int sx = 0; sx < 2; ++sx) { unsigned w[4];
#pragma unroll
            for (int jj = 0; jj < 4; ++jj) { const bf16 a = V[(size_t)(32 * grp + krow(sx, hi, 2 * jj)) * 64 + 32 * d0 + (lane & 31)], b = V[(size_t)(32 * grp + krow(sx, hi, 2 * jj + 1)) * 64 + 32 * d0 + (lane & 31)]; w[jj] = (unsigned)a | ((unsigned)b << 16); }
            ((v4u*)(F.ws + WS_VTW))[(((size_t)(g * 512 + grp) * 2 + d0) * 2 + sx) * 64 + lane] = (v4u){w[0], w[1], w[2], w[3]}; }
}
__device__ __forceinline__ int kap(int ks, int q, int j) { return 16 * (2 * ks + (j >> 2)) + 4 * q + (j & 3); }
__device__ __forceinline__ void vts_item(const Frame& F, int g, int blk) {
    const int lane = F.lane, q = lane >> 4; const bf16* V = (const bf16*)(F.ws + WS_KVH) + (size_t)(6 + g) * S * 64;
#pragma unroll
    for (int dt = 0; dt < 4; ++dt)
#pragma unroll
        for (int ks = 0; ks < 2; ++ks) { unsigned w[4];
#pragma unroll
            for (int jj = 0; jj < 4; ++jj) { const bf16 a = V[(size_t)(64 * blk + kap(ks, q, 2 * jj)) * 64 + 16 * dt + (lane & 15)], b = V[(size_t)(64 * blk + kap(ks, q, 2 * jj + 1)) * 64 + 16 * dt + (lane & 15)]; w[jj] = (unsigned)a | ((unsigned)b << 16); }
            ((v4u*)(F.ws + WS_VTS))[(((size_t)(g * 256 + blk) * 4 + dt) * 2 + ks) * 64 + lane] = (v4u){w[0], w[1], w[2], w[3]}; }
}

constexpr int AT_SC = 0;
constexpr int AT_SEL = 67584;
constexpr int AT_CNT = AT_SEL + 4096;
constexpr int AT_LIST = AT_CNT + 1024;
constexpr int AT_BT = AT_LIST + 32768;
constexpr int AT_PARK = AT_BT + 4096;
constexpr int AT_TILE = AT_PARK + 32768;
constexpr int AT_END = AT_TILE + 16384;
static_assert(AT_END <= LDS_BYTES - 64, "attention LDS map");
constexpr int PSLOTS = 832, PSLAB = 458752;
constexpr int PML_OFF = PSLOTS * 512;
constexpr int SCS = 264;

__device__ __forceinline__ bf16x8 pack8(float a0, float a1, float a2, float a3, float a4, float a5, float a6, float a7) {
    v4u w; w.x = cvt_pk_bf16(a0, a1); w.y = cvt_pk_bf16(a2, a3); w.z = cvt_pk_bf16(a4, a5); w.w = cvt_pk_bf16(a6, a7); return __builtin_bit_cast(bf16x8, w);
}
__device__ __forceinline__ float xmax32(float v) { auto r = __builtin_amdgcn_permlane32_swap(__float_as_uint(v), __float_as_uint(v), false, false); return fmaxf(__uint_as_float(r[0]), __uint_as_float(r[1])); }
__device__ __forceinline__ float xsum32(float v) { auto r = __builtin_amdgcn_permlane32_swap(__float_as_uint(v), __float_as_uint(v), false, false); return __uint_as_float(r[0]) + __uint_as_float(r[1]); }
__device__ __forceinline__ float xmax16(float v) { auto r = __builtin_amdgcn_permlane16_swap(__float_as_uint(v), __float_as_uint(v), false, false); return fmaxf(__uint_as_float(r[0]), __uint_as_float(r[1])); }
__device__ __forceinline__ float xsum16(float v) { auto r = __builtin_amdgcn_permlane16_swap(__float_as_uint(v), __float_as_uint(v), false, false); return __uint_as_float(r[0]) + __uint_as_float(r[1]); }
__device__ __forceinline__ float max16(const f32x16& a) {
    const float m0 = fmaxf(fmaxf(a[0], a[1]), fmaxf(a[2], a[3])), m1 = fmaxf(fmaxf(a[4], a[5]), fmaxf(a[6], a[7])), m2 = fmaxf(fmaxf(a[8], a[9]), fmaxf(a[10], a[11])), m3 = fmaxf(fmaxf(a[12], a[13]), fmaxf(a[14], a[15]));
    return fmaxf(fmaxf(m0, m1), fmaxf(m2, m3)); }
__device__ __forceinline__ float sum16(const f32x16& a) {
    const float s0 = (a[0] + a[1]) + (a[2] + a[3]), s1 = (a[4] + a[5]) + (a[6] + a[7]), s2 = (a[8] + a[9]) + (a[10] + a[11]), s3 = (a[12] + a[13]) + (a[14] + a[15]);
    return (s0 + s1) + (s2 + s3); }
__device__ __forceinline__ int fenc(float f) { int k = __float_as_int(f); return k ^ ((k >> 31) & 0x7fffffff); }
__device__ __forceinline__ float fdec(int k) { return __int_as_float(k ^ ((k >> 31) & 0x7fffffff)); }
#define MFMA32(a, b, c) __builtin_amdgcn_mfma_f32_32x32x16_bf16((a), (b), (c), 0, 0, 0)
#define MFMA16(a, b, c) __builtin_amdgcn_mfma_f32_16x16x32_bf16((a), (b), (c), 0, 0, 0)
#define DPPI(x, ctrl) __builtin_amdgcn_update_dpp(0, (x), (ctrl), 0xF, 0xF, false)

struct AttnPtrs { const bf16* Q; const bf16* KCB; const bf16x8* VTC; const bf16* KW; const bf16x8* VTW; const bf16* KS; const bf16x8* VTS; const bf16* GN; bf16* O; };

__device__ __forceinline__ void attn_stageA(const AttnPtrs& P, int lane, int wave, int tile0, int g, LAS unsigned char* lds) {
    const int hi = lane >> 5, c32 = lane & 31, ti = c32 >> 2, hr = c32 & 3, h = g * 4 + hr, t0 = tile0 + 8 * wave, t = t0 + ti;
    LAS float* scores = (LAS float*)(lds + AT_SC) + (8 * wave) * SCS; const LAS float* BT = (const LAS float*)(lds + AT_BT); LAS int* sel = (LAS int*)(lds + AT_SEL) + (8 * wave) * 16;
    for (int k = lane; k < 8 * SCS / 4; k += 64) ((LAS f32x4*)scores)[k] = (f32x4){0.f, 0.f, 0.f, 0.f};
    bf16x8 bq[4];
#pragma unroll
    for (int ks = 0; ks < 4; ++ks) bq[ks] = *(const bf16x8*)(P.Q + (size_t)t * 512 + h * 64 + 16 * ks + 8 * hi);
    const float cb = BT[h * 128 + 127];
    const float g0 = bf2f(P.GN[(size_t)t * 32 + h * 3 + 0]), g2 = bf2f(P.GN[(size_t)t * 32 + h * 3 + 2]);
    LDS_WAIT();
    const int tid = wave * 64 + lane; LAS unsigned char* tb = lds + AT_TILE;
    const int ldrow = tid >> 3, ldch = tid & 7; const unsigned stoff = (tid < 256) ? (unsigned)(ldrow * 128 + ((ldch ^ (ldrow & 7)) << 4)) : (unsigned)(8192 + (tid - 256) * 16);
    const unsigned kof = (unsigned)(c32 * 128), ksw = (unsigned)(c32 & 7);
#define KFRAG(buf, ks) (*(const LAS bf16x8*)(tb + (buf) * 4096 + kof + ((((ks) * 2 + hi) ^ ksw) << 4)))
#define VFRAG(buf, f) (*(const LAS bf16x8*)(tb + 8192 + (buf) * 4096 + ((f) * 64 + lane) * 16))
#define STAGE_LOAD(Kp, kmax, VTp, gmax, n0v) ((tid < 256) ? *(const v4u*)((Kp) + (size_t)min((n0v) + ldrow, (kmax)) * 64 + ldch * 8) : *(const v4u*)((VTp) + (size_t)min((n0v) >> 5, (gmax)) * 256 + (tid - 256)))
#define STAGE_WRITE(v, buf) (*(LAS v4u*)(tb + (buf) * 4096 + stoff) = (v))
#define PVACC(o0v, o1v, buf, a) do { const bf16x8 p0_ = pack8(a[0], a[1], a[2], a[3], a[4], a[5], a[6], a[7]), p1_ = pack8(a[8], a[9], a[10], a[11], a[12], a[13], a[14], a[15]); \
        o0v = MFMA32(VFRAG(buf, 0), p0_, o0v); o0v = MFMA32(VFRAG(buf, 1), p1_, o0v); o1v = MFMA32(VFRAG(buf, 2), p0_, o1v); o1v = MFMA32(VFRAG(buf, 3), p1_, o1v); } while (0)
    constexpr float SM_THR = 8.0f;
#define REF_EVENT(a, mref, started, d, fs) { const float tm_ = xmax32(max16(a)); const bool need_ = started ? (tm_ > SM_THR) : (tm_ > -1e29f); d = 0.f; fs = 1.f; \
        if (__any(need_)) { d = need_ ? tm_ : 0.f; fs = (need_ && started) ? __builtin_amdgcn_exp2f(-d) : 1.f; mref += d; started = started || need_; _Pragma("unroll") for (int r = 0; r < 16; ++r) a[r] -= d; } }
    const int ncb = (tile0 + 63 >= 31) ? min((tile0 + 63 - 31) / 16 + 1, NCMP) : 0, ntc = (ncb + 31) >> 5;
    const int nfar = (t0 >= 144) ? (t0 - 144) / 16 + 1 : 0;
#define CSCORE(a, buf, n0v, farv, refv) do { { const float ini_ = ((farv) ? cb : 0.f) - (refv); _Pragma("unroll") for (int r = 0; r < 16; ++r) a[r] = ini_; } \
        _Pragma("unroll") for (int ks = 0; ks < 4; ++ks) a = MFMA32(KFRAG(buf, ks), bq[ks], a); \
        if (!(farv)) { _Pragma("unroll") for (int r = 0; r < 16; ++r) { const int dist = t - (16 * ((n0v) + crow(r, hi)) + 31); const float bt = BT[h * 128 + min(max(dist, 0), 127)]; a[r] = dist >= 0 ? a[r] + bt : -1e30f; } } } while (0)
#define STAGE_PROLOGUE(Kp, kmax, VTp, gmax, nbase, ntl) v4u RA, RB; { RA = STAGE_LOAD(Kp, kmax, VTp, gmax, nbase); STAGE_WRITE(RA, 0); RB = STAGE_LOAD(Kp, kmax, VTp, gmax, (nbase) + 32 * min(1, (ntl) - 1)); __syncthreads(); }
    float mc = 0.f, lc = 0.f; bool stc = false;
    if (ntc > 0) {
        STAGE_PROLOGUE(P.KCB, 1023, P.VTC, 31, 0, ntc)
#define C1STEP(iv, BUF, RL, RW) { const int i = (iv); if (i >= ntc) break; const int n0 = 32 * i; RL = STAGE_LOAD(P.KCB, 1023, P.VTC, 31, 32 * min(i + 2, ntc - 1)); \
            const bool far = (n0 + 32 <= nfar); f32x16 a; CSCORE(a, BUF, n0, far, mc); \
            float d_, fs_; REF_EVENT(a, mc, stc, d_, fs_) lc *= fs_; \
            _Pragma("unroll") for (int r = 0; r < 16; ++r) a[r] = __builtin_amdgcn_exp2f(a[r]); \
            lc += xsum32(sum16(a)); STAGE_WRITE(RW, (BUF) ^ 1); __syncthreads(); }
        for (int ib = 0; ; ib += 2) { C1STEP(ib, 0, RA, RB) C1STEP(ib + 1, 1, RB, RA) }
#undef C1STEP
    }
    {   const float invl = 1.0f / fmaxf(lc, 1e-30f); f32x16 oc0 = {}, oc1 = {}; float carry = 0.f;
#define CIMP(a, n0v) do { float mq[4], cq[4]; \
            _Pragma("unroll") for (int qg = 0; qg < 4; ++qg) { float mv = (2.0f * (a[4 * qg] + a[4 * qg + 1] + a[4 * qg + 2]) + a[4 * qg + 3]) * invl, cv = a[4 * qg + 3] * invl; \
                mv += __int_as_float(DPPI(__float_as_int(mv), 0xB1)); mv += __int_as_float(DPPI(__float_as_int(mv), 0x4E)); \
                cv += __int_as_float(DPPI(__float_as_int(cv), 0xB1)); cv += __int_as_float(DPPI(__float_as_int(cv), 0x4E)); mq[qg] = mv; cq[qg] = cv; } \
            float oth[4]; \
            _Pragma("unroll") for (int qg = 0; qg < 4; ++qg) { auto rr = __builtin_amdgcn_permlane32_swap(__float_as_uint(cq[qg]), __float_as_uint(cq[qg]), false, false); oth[qg] = __uint_as_float(hi ? rr[0] : rr[1]); } \
            _Pragma("unroll") for (int qg = 0; qg < 4; ++qg) { const float tot = mq[qg] + (hi ? oth[qg] : (qg ? oth[qg - 1] : carry)); if (hr == 0) scores[ti * SCS + (((n0v) + 8 * qg + 4 * hi) >> 2)] = tot; } \
            carry = oth[3]; } while (0)
        if (ntc > 0) {
            STAGE_PROLOGUE(P.KCB, 1023, P.VTC, 31, 0, ntc)
#define C2STEP(iv, BUF, RL, RW) { const int i = (iv); if (i >= ntc) break; const int n0 = 32 * i; RL = STAGE_LOAD(P.KCB, 1023, P.VTC, 31, 32 * min(i + 2, ntc - 1)); \
                const bool far = (n0 + 32 <= nfar); f32x16 a; CSCORE(a, BUF, n0, far, mc); \
                _Pragma("unroll") for (int r = 0; r < 16; ++r) a[r] = __builtin_amdgcn_exp2f(a[r]); \
                CIMP(a, n0); PVACC(oc0, oc1, BUF, a); STAGE_WRITE(RW, (BUF) ^ 1); __syncthreads(); }
            for (int ib = 0; ; ib += 2) { C2STEP(ib, 0, RA, RB) C2STEP(ib + 1, 1, RB, RA) }
#undef C2STEP
            { const int jn = ntc * 8; if (jn < 256 && hi == 0 && hr == 0) scores[ti * SCS + jn] = carry; }
        }
#undef CIMP
        {   LAS unsigned char* park = lds + AT_PARK + (((8 * wave + ti) * 4 + hr) * 64) * 2;
            const float gs = g0 * invl;
#pragma unroll
            for (int d0 = 0; d0 < 2; ++d0)
#pragma unroll
                for (int r4 = 0; r4 < 4; ++r4) { const f32x16& Wd = d0 ? oc1 : oc0; const int dim = 32 * d0 + 8 * r4 + 4 * hi;
                    *(LAS unsigned long long*)(park + dim * 2) = (unsigned long long)cvt_pk_bf16(Wd[4 * r4] * gs, Wd[4 * r4 + 1] * gs) | ((unsigned long long)cvt_pk_bf16(Wd[4 * r4 + 2] * gs, Wd[4 * r4 + 3] * gs) << 32); } } }
#undef CSCORE
    {   float mw = 0.f, lw = 0.f; bool stw = false; f32x16 o0 = {}, o1 = {};
        const int nlo = max(t0 - 511, 0) & ~31, nhi = (t0 + 7) & ~31;
        const int nlb = max(tile0 - 511, 0) & ~31, ntw = (((tile0 + 63) & ~31) - nlb) / 32 + 1;
        STAGE_PROLOGUE(P.KW, S - 1, P.VTW, 511, nlb, ntw)
#define WSTEP(iv, BUF, RL, RW) { const int i = (iv); if (i >= ntw) break; const int n0 = nlb + 32 * i; RL = STAGE_LOAD(P.KW, S - 1, P.VTW, 511, nlb + 32 * min(i + 2, ntw - 1)); \
            if (n0 >= nlo && n0 <= nhi) { const bool mid = (n0 >= t0 - 504) && (n0 <= t0 - 144); \
                f32x16 a; { const float ini_ = (mid ? cb : 0.f) - mw; _Pragma("unroll") for (int r = 0; r < 16; ++r) a[r] = ini_; } \
                _Pragma("unroll") for (int ks = 0; ks < 4; ++ks) a = MFMA32(KFRAG(BUF, ks), bq[ks], a); \
                if (!mid) { _Pragma("unroll") for (int r = 0; r < 16; ++r) { const int dist = t - (n0 + crow(r, hi)); const float bt = BT[h * 128 + min(max(dist, 0), 127)]; a[r] = (dist >= 0 && dist < 512) ? a[r] + bt : -1e30f; } } \
                float d_, fs_; REF_EVENT(a, mw, stw, d_, fs_) if (fs_ != 1.f || d_ != 0.f) { lw *= fs_; o0 = o0 * fs_; o1 = o1 * fs_; } \
                _Pragma("unroll") for (int r = 0; r < 16; ++r) a[r] = __builtin_amdgcn_exp2f(a[r]); \
                lw += xsum32(sum16(a)); PVACC(o0, o1, BUF, a); } \
            STAGE_WRITE(RW, (BUF) ^ 1); __syncthreads(); }
        for (int ib = 0; ; ib += 2) { WSTEP(ib, 0, RA, RB) WSTEP(ib + 1, 1, RB, RA) }
#undef WSTEP
        const float sc = g2 / fmaxf(lw, 1e-30f);
        LAS unsigned char* park = lds + AT_PARK + (((8 * wave + ti) * 4 + hr) * 64) * 2;
#pragma unroll
        for (int d0 = 0; d0 < 2; ++d0)
#pragma unroll
            for (int r4 = 0; r4 < 4; ++r4) { const f32x16& Od = d0 ? o1 : o0; const int dim = 32 * d0 + 8 * r4 + 4 * hi; const unsigned long long w = *(const LAS unsigned long long*)(park + dim * 2); const unsigned lo = (unsigned)w, hw = (unsigned)(w >> 32);
                *(LAS unsigned long long*)(park + dim * 2) = (unsigned long long)cvt_pk_bf16(bflo(lo) + Od[4 * r4] * sc, bfhi(lo) + Od[4 * r4 + 1] * sc) | ((unsigned long long)cvt_pk_bf16(bflo(hw) + Od[4 * r4 + 2] * sc, bfhi(hw) + Od[4 * r4 + 3] * sc) << 32); } }
#undef REF_EVENT
#undef STAGE_PROLOGUE
#undef PVACC
#undef KFRAG
#undef VFRAG
#undef STAGE_LOAD
#undef STAGE_WRITE
    LDS_WAIT();
    {   const int cur = tile0 >> 6, i = lane >> 3, s8 = lane & 7;
        if (cur + 1 <= 16) { for (int e = lane; e < 8 * 16; e += 64) sel[e] = e & 15; }
        else {
            float sv[32];
#pragma unroll
            for (int k = 0; k < 32; ++k) { const int j = s8 + 8 * k; sv[k] = (j >= 1 && j <= cur - 2) ? scores[i * SCS + j] : -3e38f; }
            if (s8 == 0) { sel[i * 16 + 0] = 0; sel[i * 16 + 1] = cur - 1; sel[i * 16 + 2] = cur; }
            for (int it = 3; it < 16; ++it) {
                float bv = sv[0]; int bj = s8;
#pragma unroll
                for (int k = 1; k < 32; ++k) if (sv[k] > bv) { bv = sv[k]; bj = s8 + 8 * k; }
#define SEL_STEP(ctrl) { const float ov = __int_as_float(DPPI(__float_as_int(bv), ctrl)); const int oj = DPPI(bj, ctrl); if (ov > bv || (ov == bv && oj < bj)) { bv = ov; bj = oj; } }
                SEL_STEP(0xB1) SEL_STEP(0x4E) SEL_STEP(0x141)
#undef SEL_STEP
                if (s8 == 0) sel[i * 16 + it] = bj;
#pragma unroll
                for (int k = 0; k < 32; ++k) if (bj == s8 + 8 * k) sv[k] = -3e38f;
            }
        }
    }
}

__device__ __forceinline__ void s_scores(const bf16x8 (&kf)[8], const bf16x8 q0, const bf16x8 q1, bool cst, float cbs, const LAS float* BT, int hs, int tt, int j, int q, f32x4 (&sa)[4]) {
#pragma unroll
    for (int mt = 0; mt < 4; ++mt) { const float ini = cst ? cbs : 0.f; sa[mt] = (f32x4){ini, ini, ini, ini}; sa[mt] = MFMA16(kf[mt * 2], q0, sa[mt]); sa[mt] = MFMA16(kf[mt * 2 + 1], q1, sa[mt]); }
    if (!cst) {
#pragma unroll
        for (int mt = 0; mt < 4; ++mt)
#pragma unroll
            for (int r = 0; r < 4; ++r) { const int dist = tt - (64 * j + 16 * mt + 4 * q + r); const float bt = BT[hs * 128 + min(max(dist, 0), 127)]; sa[mt][r] = dist >= 0 ? sa[mt][r] + bt : -1e30f; } }
}
template <bool MASKED> __device__ __forceinline__ void s_softmax(f32x4 (&sa)[4], float& tm, float& ls) {
    tm = sa[0][0];
#pragma unroll
    for (int mt = 0; mt < 4; ++mt)
#pragma unroll
        for (int r = 0; r < 4; ++r) tm = fmaxf(tm, sa[mt][r]);
    tm = xmax32(xmax16(tm)); ls = 0.f;
#pragma unroll
    for (int mt = 0; mt < 4; ++mt)
#pragma unroll
        for (int r = 0; r < 4; ++r) { const float e = __builtin_amdgcn_exp2f(sa[mt][r] - tm); sa[mt][r] = (!MASKED || sa[mt][r] > -1e29f) ? e : 0.f; ls += sa[mt][r]; }
    ls = xsum32(xsum16(ls));
}
__device__ __forceinline__ void load_kf(const AttnPtrs& P, int lane, int j, bf16x8 (&kf)[8]) {
    const bf16* kp = P.KS + (size_t)(64 * j + (lane & 15)) * 64 + 8 * (lane >> 4);
#pragma unroll
    for (int mt = 0; mt < 4; ++mt) { kf[mt * 2] = *(const bf16x8*)(kp + (size_t)mt * 16 * 64); kf[mt * 2 + 1] = *(const bf16x8*)(kp + (size_t)mt * 16 * 64 + 32); }
}
__device__ __forceinline__ void load_vf(const AttnPtrs& P, int lane, int j, bf16x8 (&vf)[8]) {
    const bf16x8* vt = P.VTS + (size_t)j * 8 * 64 + lane;
#pragma unroll
    for (int e = 0; e < 8; ++e) vf[e] = vt[e * 64];
}
__device__ __forceinline__ void attn_stageB(const AttnPtrs& P, int lane, int wave, int tile0, int g, LAS unsigned char* lds, unsigned char* slab) {
    const int T = tile0 >> 6, c = lane & 15, q = lane >> 4, hd = c & 3, hs = g * 4 + hd;
    if (T <= 15) return;
    const LAS unsigned* cnt = (const LAS unsigned*)(lds + AT_CNT); const LAS unsigned short* list = (const LAS unsigned short*)(lds + AT_LIST); const LAS float* BT = (const LAS float*)(lds + AT_BT);
    const float cbs = BT[hs * 128 + 127];
#define NEXT_BLK(jv, nv) do { nv = 0; for (jv += 8; jv <= T - 2; jv += 8) { nv = (int)__builtin_amdgcn_readfirstlane((int)cnt[jv]); if (nv > 0) break; } } while (0)
    int jc = 1 + wave - 8, nc = 0; NEXT_BLK(jc, nc); if (jc > T - 2) return;
    int jn = jc, nn = 0; NEXT_BLK(jn, nn);
    bf16x8 kf[8], vf[8], kn[8];
    load_kf(P, lane, jc, kf); load_vf(P, lane, jc, vf);
    load_kf(P, lane, min(jn, T - 2), kn);
    int ch = 0;
    int sl; bool valid; bf16x8 q0, q1;
    { const int sidx = (c >> 2); valid = sidx < nc; sl = (int)list[jc * 64 + (valid ? sidx : 0)]; const int tt = tile0 + sl / 13;
      q0 = *(const bf16x8*)(P.Q + (size_t)tt * 512 + hs * 64 + 8 * q); q1 = *(const bf16x8*)(P.Q + (size_t)tt * 512 + hs * 64 + 32 + 8 * q); }
#pragma unroll 1
    for (;;) {
        const bool same = (ch + 1) * 4 < nc; const bool more = same || (jn <= T - 2);
        const int jx = same ? jc : min(jn, T - 2), chx = same ? ch + 1 : 0, nx = same ? nc : nn;
        int sln; bool validn; bf16x8 q0n, q1n;
        { const int sidx = 4 * chx + (c >> 2); validn = sidx < nx; sln = (int)list[jx * 64 + (validn ? sidx : 0)]; const int tt = tile0 + sln / 13;
          q0n = *(const bf16x8*)(P.Q + (size_t)tt * 512 + hs * 64 + 8 * q); q1n = *(const bf16x8*)(P.Q + (size_t)tt * 512 + hs * 64 + 32 + 8 * q); }
        {   const int tt = tile0 + sl / 13; const bool cst = (jc <= T - 3);
            f32x4 sa[4]; s_scores(kf, q0, q1, cst, cbs, BT, hs, tt, jc, q, sa);
            float tm, ls; s_softmax<false>(sa, tm, ls);
            const bf16x8 p0 = pack8(sa[0][0], sa[0][1], sa[0][2], sa[0][3], sa[1][0], sa[1][1], sa[1][2], sa[1][3]), p1 = pack8(sa[2][0], sa[2][1], sa[2][2], sa[2][3], sa[3][0], sa[3][1], sa[3][2], sa[3][3]);
            unsigned char* po = slab + ((size_t)(sl * 4 + hd) * 64 + 16 * q) * 2;
            unsigned pw[8];
#pragma unroll
            for (int dt = 0; dt < 4; ++dt) { f32x4 oa = {0.f, 0.f, 0.f, 0.f}; oa = MFMA16(vf[dt * 2], p0, oa); oa = MFMA16(vf[dt * 2 + 1], p1, oa); pw[2 * dt] = cvt_pk_bf16(oa[0], oa[1]); pw[2 * dt + 1] = cvt_pk_bf16(oa[2], oa[3]); }
            if (valid) { *(v4u*)po = (v4u){pw[0], pw[1], pw[2], pw[3]}; *(v4u*)(po + 16) = (v4u){pw[4], pw[5], pw[6], pw[7]}; }
            if (valid && q == 0) *(f32x2*)(slab + PML_OFF + (size_t)(sl * 4 + hd) * 8) = (f32x2){tm, ls}; }
        if (!more) break;
        if (!same) {
#pragma unroll
            for (int e = 0; e < 8; ++e) kf[e] = kn[e];
            jc = jn; nc = nn; load_vf(P, lane, jc, vf); NEXT_BLK(jn, nn);
            load_kf(P, lane, min(jn, T - 2), kn); }
        ch = chx; sl = sln; valid = validn; q0 = q0n; q1 = q1n;
    }
#undef NEXT_BLK
}
struct SState { float M, L; f32x4 O[4]; };
__device__ __forceinline__ void s_merge(SState& st, float m, float l, const f32x4 (&o)[4]) {
    const float mn = fmaxf(st.M, m), a0 = __builtin_amdgcn_exp2f(st.M - mn), a1 = __builtin_amdgcn_exp2f(m - mn);
    st.L = st.L * a0 + l * a1; st.M = mn;
#pragma unroll
    for (int dt = 0; dt < 4; ++dt) st.O[dt] = st.O[dt] * a0 + o[dt] * a1;
}
__device__ __forceinline__ void attn_stageC_forced(const AttnPtrs& P, int lane, int wave, int tile0, int g, LAS unsigned char* lds, SState (&st)[2]) {
    const int T = tile0 >> 6, c = lane & 15, q = lane >> 4, hd = c & 3, hs = g * 4 + hd; const LAS float* BT = (const LAS float*)(lds + AT_BT); const float cbs = BT[hs * 128 + 127];
    bf16x8 q0[2], q1[2];
#pragma unroll
    for (int k = 0; k < 2; ++k) { const int tt = tile0 + 8 * wave + 4 * k + (c >> 2); q0[k] = *(const bf16x8*)(P.Q + (size_t)tt * 512 + hs * 64 + 8 * q); q1[k] = *(const bf16x8*)(P.Q + (size_t)tt * 512 + hs * 64 + 32 + 8 * q);
        st[k].M = -1e30f; st[k].L = 0.f;
#pragma unroll
        for (int dt = 0; dt < 4; ++dt) st[k].O[dt] = (f32x4){0.f, 0.f, 0.f, 0.f}; }
    const int nf = T <= 15 ? T + 1 : 3;
    auto fblk = [&](int it) -> int { return T <= 15 ? it : (it == 0 ? 0 : (it == 1 ? T - 1 : T)); };
    bf16x8 kf[8], vf[8]; load_kf(P, lane, fblk(0), kf); load_vf(P, lane, fblk(0), vf);
#pragma unroll 1
    for (int it = 0; it < nf; ++it) { const int j = fblk(it);
        bf16x8 kn[8]; load_kf(P, lane, fblk(min(it + 1, nf - 1)), kn);
        const bool cst = (j <= T - 3);
#pragma unroll
        for (int k = 0; k < 2; ++k) { const int tt = tile0 + 8 * wave + 4 * k + (c >> 2);
            f32x4 sa[4]; s_scores(kf, q0[k], q1[k], cst, cbs, BT, hs, tt, j, q, sa);
            float tm, ls; s_softmax<true>(sa, tm, ls);
            const bf16x8 p0 = pack8(sa[0][0], sa[0][1], sa[0][2], sa[0][3], sa[1][0], sa[1][1], sa[1][2], sa[1][3]), p1 = pack8(sa[2][0], sa[2][1], sa[2][2], sa[2][3], sa[3][0], sa[3][1], sa[3][2], sa[3][3]);
            f32x4 ob[4];
#pragma unroll
            for (int dt = 0; dt < 4; ++dt) { ob[dt] = (f32x4){0.f, 0.f, 0.f, 0.f}; ob[dt] = MFMA16(vf[dt * 2], p0, ob[dt]); ob[dt] = MFMA16(vf[dt * 2 + 1], p1, ob[dt]); }
            s_merge(st[k], tm, ls, ob); }
#pragma unroll
        for (int e = 0; e < 8; ++e) kf[e] = kn[e];
        if (it + 1 < nf) load_vf(P, lane, fblk(it + 1), vf);
    }
}
__device__ __forceinline__ void attn_stageC_merge(const AttnPtrs& P, int lane, int wave, int tile0, int g, LAS unsigned char* lds, const unsigned char* slab, SState (&st)[2]) {
    const int T = tile0 >> 6, c = lane & 15, q = lane >> 4, hd = c & 3, hs = g * 4 + hd;
#pragma unroll
    for (int k = 0; k < 2; ++k) { const int tok = 8 * wave + 4 * k + (c >> 2), tt = tile0 + tok;
        if (T > 15) {
#pragma unroll
            for (int b0 = 0; b0 < 13; b0 += 7) {
                f32x2 mlv[7]; v4u ow[7][2];
#pragma unroll
                for (int bb = 0; bb < 7; ++bb) if (b0 + bb < 13) { const int sl = tok * 13 + b0 + bb;
                    mlv[bb] = *(const f32x2*)(slab + PML_OFF + (size_t)(sl * 4 + hd) * 8);
                    const unsigned char* po = slab + ((size_t)(sl * 4 + hd) * 64 + 16 * q) * 2; ow[bb][0] = *(const v4u*)po; ow[bb][1] = *(const v4u*)(po + 16); }
#pragma unroll
                for (int bb = 0; bb < 7; ++bb) if (b0 + bb < 13) { f32x4 ob[4];
                    ob[0] = (f32x4){bflo(ow[bb][0].x), bfhi(ow[bb][0].x), bflo(ow[bb][0].y), bfhi(ow[bb][0].y)}; ob[1] = (f32x4){bflo(ow[bb][0].z), bfhi(ow[bb][0].z), bflo(ow[bb][0].w), bfhi(ow[bb][0].w)};
                    ob[2] = (f32x4){bflo(ow[bb][1].x), bfhi(ow[bb][1].x), bflo(ow[bb][1].y), bfhi(ow[bb][1].y)}; ob[3] = (f32x4){bflo(ow[bb][1].z), bfhi(ow[bb][1].z), bflo(ow[bb][1].w), bfhi(ow[bb][1].w)};
                    s_merge(st[k], mlv[bb].x, mlv[bb].y, ob); } } }
        const float g1 = bf2f(P.GN[(size_t)tt * 32 + hs * 3 + 1]) / fmaxf(st[k].L, 1e-30f);
        const LAS unsigned char* park = lds + AT_PARK + ((tok * 4 + hd) * 64 + 4 * q) * 2;
#pragma unroll
        for (int dt = 0; dt < 4; ++dt) { const unsigned long long w = *(const LAS unsigned long long*)(park + dt * 32); const unsigned lo = (unsigned)w, hw = (unsigned)(w >> 32);
            const unsigned o0 = cvt_pk_bf16(bflo(lo) + g1 * st[k].O[dt][0], bfhi(lo) + g1 * st[k].O[dt][1]), o1 = cvt_pk_bf16(bflo(hw) + g1 * st[k].O[dt][2], bfhi(hw) + g1 * st[k].O[dt][3]);
            *(unsigned long long*)(P.O + (size_t)tt * 512 + hs * 64 + 16 * dt + 4 * q) = (unsigned long long)o0 | ((unsigned long long)o1 << 32); } }
}
__device__ __forceinline__ void attn_tile(const Frame& F, unsigned char* ws, int tile, int g, unsigned soff) {
    int lane = F.lane; asm volatile("" : "+v"(lane));
    const int wave = F.wave, tile0 = tile * 64, T = tile; LAS unsigned char* lds = F.lds;
    if (F.tid < 256) ((LAS unsigned*)(lds + AT_CNT))[F.tid] = 0u;
    AttnPtrs P;
    {   const bf16* KVH = (const bf16*)(ws + WS_KVH);
        P.Q = (const bf16*)(ws + WS_Q); P.KCB = (const bf16*)(ws + WS_KCB) + (size_t)g * 1024 * 64; P.VTC = (const bf16x8*)(ws + WS_VTC) + (size_t)g * 32 * 4 * 64;
        P.KW = KVH + (size_t)(8 + g) * S * 64; P.VTW = (const bf16x8*)(ws + WS_VTW) + (size_t)g * 512 * 4 * 64; P.GN = (const bf16*)(ws + WS_GN);
        P.KS = nullptr; P.VTS = nullptr; P.O = nullptr; }
    attn_stageA(P, lane, wave, tile0, g, lds);
    __syncthreads();
    unsigned char* ws2 = ws;
    {   const bf16* KVH = (const bf16*)(ws2 + WS_KVH);
        P.Q = (const bf16*)(ws2 + WS_Q); P.KS = KVH + (size_t)(4 + g) * S * 64; P.VTS = (const bf16x8*)(ws2 + WS_VTS) + (size_t)g * 256 * 8 * 64; P.GN = (const bf16*)(ws2 + WS_GN); P.O = (bf16*)(ws2 + WS_O);
        P.KCB = nullptr; P.VTC = nullptr; P.KW = nullptr; P.VTW = nullptr; }
    unsigned char* slab = ((blockIdx.x < 128) ? (unsigned char*)F.out : ws2 + WS_PSLAB) + soff;
    if (T > 15) {
        LAS unsigned* cnt = (LAS unsigned*)(lds + AT_CNT); LAS unsigned short* list = (LAS unsigned short*)(lds + AT_LIST); const LAS int* sel = (const LAS int*)(lds + AT_SEL);
        const int tok = F.tid >> 3;
#pragma unroll
        for (int e = 0; e < 2; ++e) { const int b = (F.tid & 7) * 2 + e;
            if (b >= 3) { const int j = sel[tok * 16 + b]; const unsigned pos = __hip_atomic_fetch_add(&cnt[j], 1u, __ATOMIC_RELAXED, __HIP_MEMORY_SCOPE_WORKGROUP); list[j * 64 + pos] = (unsigned short)(tok * 13 + b - 3); } }
        __syncthreads(); }
    attn_stageB(P, lane, wave, tile0, g, lds, slab);
    SState st[2];
    attn_stageC_forced(P, lane, wave, tile0, g, lds, st);
    asm volatile("s_waitcnt vmcnt(0)" ::: "memory");
    __syncthreads();
    __builtin_amdgcn_fence(__ATOMIC_ACQUIRE, "agent");
    attn_stageC_merge(P, lane, wave, tile0, g, lds, slab, st);
    __syncthreads();
}

#define XB_TMO      128
#define XB_XCNT(j)  (256  + 64 * (j))
#define XB_XSUB(j)  (1280 + 64 * (j))
#define XB_XGEN(j)  (2304 + 64 * (j))
#define XB_TOP      3328
#define XB_TOPGEN   3392
#define XCD_BAR_WORDS 3456
#define XB_SPIN_CAP (1u << 22)
__device__ __forceinline__ unsigned xb_ld(unsigned* p)              { return __hip_atomic_load(p, __ATOMIC_RELAXED, __HIP_MEMORY_SCOPE_AGENT); }
__device__ __forceinline__ unsigned xb_add(unsigned* p, unsigned v) { return __hip_atomic_fetch_add(p, v, __ATOMIC_RELAXED, __HIP_MEMORY_SCOPE_AGENT); }
__device__ __forceinline__ unsigned xb_xcc_id() { return (unsigned)__builtin_amdgcn_s_getreg((3 << 11) | 20) & 0xFu; }
#define XB_SPIN(cond, bar) do { unsigned _sp = 0; while (cond) { __builtin_amdgcn_s_sleep(1); \
    if ((++_sp & 255u) == 0u) { if (xb_ld(&(bar)[XB_TMO])) break; if (_sp > XB_SPIN_CAP) { atomicAdd(&(bar)[XB_TMO], 1u); break; } } } } while (0)
struct XcdBarrier { unsigned* bar; unsigned x; volatile LAS unsigned* st; };
__device__ __forceinline__ XcdBarrier xcd_barrier_post(unsigned* bar, volatile LAS unsigned* st) {
    XcdBarrier b; b.bar = bar; b.x = xb_xcc_id(); b.st = st;
    if (threadIdx.x == 0) (void)xb_add(&bar[XB_XCNT(b.x)], 1u);
    return b;
}
__device__ __forceinline__ void xcd_barrier_complete(unsigned* bar, unsigned x, unsigned& nloc, unsigned& nx) {
    const unsigned G = gridDim.x * gridDim.y * gridDim.z;
    unsigned sum, cnt, mine, sp = 0u;
    for (;;) {
        sum = 0u; cnt = 0u; mine = 0u;
#pragma unroll
        for (unsigned j = 0; j < 16; ++j) { const unsigned c = xb_ld(&bar[XB_XCNT(j)]); sum += c; cnt += (c > 0u) ? 1u : 0u; mine = (j == x) ? c : mine; }
        if (sum == G) break;
        __builtin_amdgcn_s_sleep(1);
        if ((++sp & 255u) == 0u) { if (xb_ld(&bar[XB_TMO])) break; if (sp > XB_SPIN_CAP) { atomicAdd(&bar[XB_TMO], 1u); break; } }
    }
    nloc = mine > 0u ? mine : 1u; nx = cnt > 0u ? cnt : 1u;
}
__device__ __forceinline__ void xcd_barrier(const XcdBarrier& b) {
    asm volatile("s_waitcnt vmcnt(0)" ::: "memory");
    __syncthreads();
    if (threadIdx.x == 0) {
        unsigned* bar = b.bar;
        __builtin_amdgcn_s_waitcnt(0);
        unsigned nloc = b.st[0], nx = b.st[1];
        if (nloc == 0u) { xcd_barrier_complete(bar, b.x, nloc, nx); b.st[0] = nloc; b.st[1] = nx; }
        const unsigned old = xb_add(&bar[XB_XSUB(b.x)], 1u);
        const unsigned gen = old / nloc;
        if (old + 1u == (gen + 1u) * nloc) {
            __builtin_amdgcn_fence(__ATOMIC_RELEASE, "agent");
            asm volatile("s_waitcnt vmcnt(0)" ::: "memory");
            const unsigned og = xb_add(&bar[XB_TOP], 1u);
            const unsigned tg = og / nx;
            if (og + 1u == (tg + 1u) * nx) xb_add(&bar[XB_TOPGEN], 1u);
            else XB_SPIN(xb_ld(&bar[XB_TOPGEN]) == tg, bar);
            __builtin_amdgcn_fence(__ATOMIC_ACQUIRE, "agent");
            xb_add(&bar[XB_XGEN(b.x)], 1u);
            asm volatile("s_waitcnt vmcnt(0)" ::: "memory");
        } else {
            XB_SPIN(xb_ld(&bar[XB_XGEN(b.x)]) == gen, bar);
            __builtin_amdgcn_fence(__ATOMIC_ACQUIRE, "agent");
            asm volatile("s_waitcnt vmcnt(0)" ::: "memory");
        }
    }
    __syncthreads();
}

__global__ void __launch_bounds__(NWAVES * 64, 2) mk_fwd(Args args) {
    extern __shared__ __attribute__((aligned(16))) unsigned char lds_raw[];
    Frame F;
    F.lds = (LAS unsigned char*)lds_raw;
#define REFRESH() do { int t_ = threadIdx.x; asm volatile("" : "+v"(t_)); F.tid = t_; F.lane = t_ & 63; F.wave = __builtin_amdgcn_readfirstlane(t_ >> 6); F.gw = blockIdx.x * NWAVES + F.wave; } while (0)
    F.G = gridDim.x; F.ngw = F.G * NWAVES; REFRESH();
    F.out = args.out; F.ws = args.ws;
    const int lo = args.ph_lo, hi = args.ph_hi;
#define IN(k) (lo <= (k) && (k) < hi)
#ifndef USE_CG_SYNC
#define USE_CG_SYNC 0
#endif
    volatile LAS unsigned* bst = (volatile LAS unsigned*)(F.lds + LDS_BYTES - 64);
    if (F.tid < 16) bst[F.tid] = 0u;
    __syncthreads();
    XcdBarrier gbar; gbar.bar = (unsigned*)(F.ws + WS_CTL); gbar.x = 0; gbar.st = bst;
    if (!USE_CG_SYNC && hi - lo > 1) gbar = xcd_barrier_post((unsigned*)(F.ws + WS_CTL), bst);
#define SEAM(k) do { if (IN(k) && IN((k) + 1)) { if (USE_CG_SYNC) cg::this_grid().sync(); else xcd_barrier(gbar); } } while (0)
    unsigned char* ws = F.ws;
    if (IN(0)) { REFRESH(); p0_prologue(F, args); }
    SEAM(0);
    if (IN(1)) { REFRESH();
        pg8::Gemm g{(const bf16*)(ws + WS_XN), (const bf16*)(ws + WS_WIN), S, NPJ, 1024, 1024}; pg8::StaticOrder So; So.init(S, NPJ, F.G, (int)blockIdx.x);
        EpiProj E{(bf16*)(ws + WS_U), (bf16*)(ws + WS_Q), (bf16*)(ws + WS_KVH), (bf16*)(ws + WS_G), (bf16*)(ws + WS_GN)};
        pg8::gemm_phase<EpiProj, pg8::StaticOrder>(F.lds, g, So, E);
    }
    SEAM(1);
    if (IN(2)) { REFRESH();
        for (int u = F.gw; u < 64 * 32; u += F.ngw) s5_unit<false>(F, args, u >> 5, u & 31, F.lds + F.wave * 16384, F.lds + 131072 + F.wave * 2048);
        __syncthreads();
        pg8::Gemm g{(const bf16*)(ws + WS_KVH), (const bf16*)(ws + WS_WC1), 4096, 1024, 1024 / CMP_KS, 1024}; pg8::CmpOrder So{F.G, (int)blockIdx.x, CMP_KS};
        EpiCmp E{F.out};
        pg8::gemm_phase<EpiCmp, pg8::CmpOrder>(F.lds, g, So, E);
    }
    SEAM(2);
    if (IN(3)) { REFRESH();
        for (int u = F.gw; u < 64 * 32; u += F.ngw) s5_unit<true>(F, args, u >> 5, u & 31, F.lds + F.wave * 16384, F.lds + 131072 + F.wave * 2048);
        for (int u = F.gw; u < 4 * 1024; u += F.ngw) { const int kvg = u >> 10, n = u & 1023; cmp_l2_unit(F, args, kvg >> 1, kvg & 1, n, (LAS float*)(F.lds + F.wave * 16384)); }
        for (int u = F.gw; u < 2 * 512; u += F.ngw) vtw_item(F, u >> 9, u & 511);
        for (int u = F.gw; u < 2 * 256; u += F.ngw) vts_item(F, u >> 8, u & 255);
    }
    SEAM(3);
    if (IN(4)) { REFRESH();
        LAS float* BT = (LAS float*)(F.lds + AT_BT);
        for (int i = F.tid; i < 8 * 128; i += NWAVES * 64) { const int h = i >> 7, d = i & 127;
            int bk = d; if (d >= 16) { bk = 16 + (int)(logf((float)d * (1.0f / 16.0f)) / 2.0794415416798357f * 16.0f); if (bk > 31) bk = 31; }
            BT[i] = args.in[19][bk * 8 + h] * 1.4426950408889634f; }
        __syncthreads();
        for (int u = blockIdx.x; u < 256; u += F.G) {
#pragma unroll 1
            for (int g = 0; g < 2; ++g) { const int ta = ((u & 7) << 5) | (u >> 3);
                const int tile = g ? 255 - ta : ta;
                const unsigned soff = (unsigned)__builtin_amdgcn_readfirstlane((int)((blockIdx.x & 127u) * (unsigned)PSLAB));
                attn_tile(F, ws, tile, g, soff); } }
    }
    SEAM(4);
    if (IN(5)) { REFRESH();
        pg8::Gemm g{(const bf16*)(ws + WS_Z), (const bf16*)(ws + WS_WGLU), S, 512, 512, 512}; pg8::StaticOrder So; So.init(S, 512, F.G, (int)blockIdx.x);
        EpiGlu E{(const bf16*)(ws + WS_Z), (bf16*)(ws + WS_ZG)};
        pg8::gemm_phase<EpiGlu, pg8::StaticOrder>(F.lds, g, So, E);
    }
    SEAM(5);
    if (IN(6)) { REFRESH();
        pg8::TwoSegOrder So; So.init(S, 1024, F.G, (int)blockIdx.x);
        pg8::Gemm g{(const bf16*)(ws + WS_ZG), (const bf16*)(ws + WS_WA), S, 1024, 512, 512, (const bf16*)(ws + WS_O), (const bf16*)(ws + WS_WB)}; EpiMix2 E{(const bf16*)(ws + WS_G), (bf16*)(ws + WS_MIX)};
        pg8::gemm_phase<EpiMix2, pg8::TwoSegOrder>(F.lds, g, So, E);
    }
    SEAM(6);
    if (IN(7)) { REFRESH();
        pg8::Gemm g{(const bf16*)(ws + WS_MIX), (const bf16*)(ws + WS_WOUT), S, 1024, 1024, 1024}; pg8::StaticOrder So; So.init(S, 1024, F.G, (int)blockIdx.x);
        EpiResNorm E{args.in[0], F.out, (bf16*)(ws + WS_XN), (float*)(ws + WS_SSP), (LAS float*)(F.lds + pg8::STAGE_BYTES)};
        pg8::gemm_phase<EpiResNorm, pg8::StaticOrder>(F.lds, g, So, E);
    }
    SEAM(7);
    if (IN(9)) { REFRESH();
        pg8::Gemm g{(const bf16*)(ws + WS_XN), (const bf16*)(ws + WS_WGU), S, 2 * DFF, 1024, 1024}; pg8::StaticOrder So; So.init(S, 2 * DFF, F.G, (int)blockIdx.x);
        EpiFfn E{(bf16*)(ws + WS_H), (const float*)(ws + WS_SSP)};
        pg8::gemm_phase<EpiFfn, pg8::StaticOrder>(F.lds, g, So, E);
    }
    SEAM(9);
    if (IN(10)) { REFRESH();
        pg8::Gemm g{(const bf16*)(ws + WS_H), (const bf16*)(ws + WS_WD), S, 1024, DFF, DFF}; pg8::StaticOrder So; So.init(S, 1024, F.G, (int)blockIdx.x);
        EpiRes E{F.out, F.out};
        pg8::gemm_phase<EpiRes, pg8::StaticOrder>(F.lds, g, So, E);
    }
    SEAM(10);
    if (IN(11)) { REFRESH(); for (int m = F.gw; m < S; m += F.ngw) rms_row_f32(F.out + (size_t)m * DM, args.in[26], F.lane); }
#undef IN
#undef SEAM
}

extern "C" void kernel_launch(void* const* d_in, const int* in_sizes, int n_in, void* d_out, int out_size, void* d_ws, size_t ws_size, hipStream_t stream) {
    static int grid = 0;
    if (grid == 0) {
        if (n_in != 27 || out_size != S * DM || ws_size < WS_END) { fprintf(stderr, "kernel_launch: unexpected shapes (n_in %d out %d ws %zu)\n", n_in, out_size, ws_size); grid = -1; return; }
        int dev = 0, cus = 0, per_cu = 0;
        if (hipGetDevice(&dev) != hipSuccess || hipDeviceGetAttribute(&cus, hipDeviceAttributeMultiprocessorCount, dev) != hipSuccess) { grid = -1; return; }
        if (hipFuncSetAttribute((const void*)mk_fwd, hipFuncAttributeMaxDynamicSharedMemorySize, LDS_BYTES) != hipSuccess) { fprintf(stderr, "kernel_launch: hipFuncSetAttribute failed\n"); grid = -1; return; }
        if (hipOccupancyMaxActiveBlocksPerMultiprocessor(&per_cu, (const void*)mk_fwd, NWAVES * 64, LDS_BYTES) != hipSuccess || per_cu < 1) { fprintf(stderr, "kernel_launch: occupancy query says %d\n", per_cu); per_cu = 1; }
        (void)hipGetLastError();
        grid = cus * (per_cu < 1 ? 1 : 1);
    }
    if (grid < 0) return;
    if (hipMemsetAsync((char*)d_ws + WS_CTL, 0, 16384, stream) != hipSuccess) { fprintf(stderr, "kernel_launch: hipMemsetAsync failed\n"); return; }
    Args a{};
    for (int i = 0; i < 27; ++i) a.in[i] = (const float*)d_in[i];
    a.out = (float*)d_out; a.ws = (unsigned char*)d_ws;
    if (MK_N_LAUNCHES == 1) {
        a.ph_lo = 0; a.ph_hi = NPH;
        void* kargs[] = {&a};
        hipError_t e = hipLaunchCooperativeKernel((const void*)mk_fwd, dim3(grid), dim3(NWAVES * 64), kargs, LDS_BYTES, stream);
        if (e != hipSuccess) fprintf(stderr, "kernel_launch: cooperative launch failed: %s (grid %d)\n", hipGetErrorString(e), grid);
    } else {
        for (int ph = 0; ph < NPH; ++ph) { a.ph_lo = ph; a.ph_hi = ph + 1; hipLaunchKernelGGL(mk_fwd, dim3(grid), dim3(NWAVES * 64), LDS_BYTES, stream, a); }
    }
}
```

```cpp
#include <hip/hip_runtime.h>
#include <hip/hip_cooperative_groups.h>
#include <cstdio>
#include <cstdint>
namespace cg = cooperative_groups;

#ifndef MK_N_LAUNCHES
#define MK_N_LAUNCHES 1
#endif

namespace pg8 {
#define PG8_LAS __attribute__((address_space(3)))
typedef unsigned short bf16_t;
typedef short bf16x8 __attribute__((ext_vector_type(8)));
typedef float f32x4 __attribute__((ext_vector_type(4)));
typedef unsigned u32x4 __attribute__((ext_vector_type(4)));
constexpr int BM = 256, BK = 64, HALF = 128, HTB = HALF * BK * 2, STAGE_BYTES = 8 * HTB, NXCD = 8, WGM = 8;

__host__ __device__ __forceinline__ int lds_byte(int r, int c) { const int st = (r >> 4) * 2 + (c >> 5), rr = r & 15, cc = c & 31, ob = rr * 64 + cc * 2; return st * 1024 + (ob ^ (((ob >> 9) & 1) << 5)); }
__host__ __device__ __forceinline__ void stage_rc(int b, int& R, int& C) { const int st = b / 1024, sb = b % 1024, swz = sb ^ (((sb >> 9) & 1) << 5); R = (st >> 1) * 16 + swz / 64; C = (st & 1) * 32 + (swz % 64) / 2; }
__host__ __device__ __forceinline__ int perm32(int rho) { const int n = rho >> 4, i = rho & 15; return 8 * (i >> 2) + 4 * n + (i & 3); }

struct Unit { int pm, pn, ks, seg; };
struct Gemm { const bf16_t* A; const bf16_t* Bt; int M, N, K, ld; const bf16_t* A2; const bf16_t* Bt2; };

struct StaticOrder {
    static constexpr bool SINGLE = false;
    int nM, nN, nwg, G, c;
    __host__ __device__ void init(int M, int N, int G_, int c_) { nM = M / BM; nN = N / BM; nwg = nM * nN; G = G_; c = c_; }
    __host__ __device__ bool next(int i, Unit& u) const {
        const long L = (long)i * G + c; if (L >= nwg) return false;
        int wgid = (int)L; { const int q = nwg / NXCD, r = nwg % NXCD, xcd = wgid % NXCD, off = wgid / NXCD; wgid = (xcd < r ? xcd * (q + 1) : r * (q + 1) + (xcd - r) * q) + off; }
        const int nig = WGM * nN, gid = wgid / nig, fm = gid * WGM, gsz = (nM - fm) < WGM ? (nM - fm) : WGM;
        u.pm = fm + ((wgid % nig) % gsz); u.pn = (wgid % nig) / gsz; u.ks = 0; u.seg = 0; return true;
    }
};
struct TwoSegOrder : StaticOrder {
    __host__ __device__ bool next(int i, Unit& u) const { if (!StaticOrder::next(i >> 1, u)) return false; u.seg = i & 1; return true; }
};
struct CmpOrder {
    static constexpr bool SINGLE = true;
    int G, c, KS;
    __host__ __device__ bool next(int i, Unit& u) const {
        const int L = i * G + c; if (L >= 32 * KS) return false;
        const int tile = L / KS; u.ks = L % KS; u.pm = tile >> 1; u.pn = (tile & 1) + (u.pm >= 8 ? 2 : 0); u.seg = 0; return true;
    }
};

typedef float f32x2_t __attribute__((ext_vector_type(2))); typedef __bf16 bf16x2_t __attribute__((ext_vector_type(2)));
__device__ __forceinline__ unsigned cvt_pk_bf16(float lo, float hi) { f32x2_t v = {lo, hi}; bf16x2_t b = __builtin_convertvector(v, bf16x2_t); return __builtin_bit_cast(unsigned, b); }
__device__ __forceinline__ float bflo(unsigned w) { return __uint_as_float(w << 16); }
__device__ __forceinline__ float bfhi(unsigned w) { return __uint_as_float(w & 0xffff0000u); }
__device__ __forceinline__ float sigm(float x) { return __builtin_amdgcn_rcpf(1.0f + __expf(-x)); }

template <class Epi, class Sched>
__device__ __forceinline__ void gemm_phase(PG8_LAS unsigned char* lds, const Gemm g, const Sched& S, const Epi& E) {
    const int tid = threadIdx.x, wid = __builtin_amdgcn_readfirstlane(tid >> 6), lane = tid & 63, wr = wid >> 2, wc = wid & 3, fr = lane & 15, fq = lane >> 4;
    const int K = g.K, ld = g.ld, nt = K / BK;
    unsigned voffA[2], voffB[2];
#pragma unroll
    for (int i = 0; i < 2; ++i) { int R, C; stage_rc(tid * 16 + i * 8192, R, C); const int Rb = Epi::PERM ? ((R & ~31) + perm32(R & 31)) : R;
        voffA[i] = (unsigned)(R * ld + C) * 2u; voffB[i] = (unsigned)(Rb * ld + C) * 2u; }
    const size_t kstep = (size_t)(BK * 2);
    const size_t hstep = (size_t)HALF * ld * 2;
    const size_t tstep = 2 * hstep;
    const unsigned ldsw = (unsigned)wid * 1024u;
    const int aoff = lds_byte(wr * 64 + fr, fq * 8), boff = lds_byte(wc * 32 + fr, fq * 8);
#define PG8_SA(b, h) (((b) * 2 + (h)) * HTB)
#define PG8_SB(b, h) ((4 + (b) * 2 + (h)) * HTB)
#define PG8_STAGE(bufoff, gbase, voff) do { _Pragma("unroll") for (int _i = 0; _i < 2; ++_i) \
        __builtin_amdgcn_global_load_lds((const unsigned*)((const char*)(gbase) + (voff)[_i]), (PG8_LAS unsigned*)(lds + (bufoff) + ldsw + _i * 8192), 16, 0, 0); } while (0)
#define PG8_LDA(dst, b, h) do { _Pragma("unroll") for (int m = 0; m < 4; ++m) _Pragma("unroll") for (int k = 0; k < 2; ++k) dst[m][k] = *(const PG8_LAS bf16x8*)(lds + PG8_SA(b, h) + aoff + m * 2048 + k * 1024); } while (0)
#define PG8_LDB(dst, b, h) do { _Pragma("unroll") for (int n = 0; n < 2; ++n) _Pragma("unroll") for (int k = 0; k < 2; ++k) dst[n][k] = *(const PG8_LAS bf16x8*)(lds + PG8_SB(b, h) + boff + n * 2048 + k * 1024); } while (0)
#define PG8_MMA(ai, bj, At, Bt) do { __builtin_amdgcn_s_setprio(1); _Pragma("unroll") for (int m = 0; m < 4; ++m) _Pragma("unroll") for (int n = 0; n < 2; ++n) _Pragma("unroll") for (int k = 0; k < 2; ++k) \
        acc[ai][bj][m][n] = __builtin_amdgcn_mfma_f32_16x16x32_bf16(Bt[n][k], At[m][k], acc[ai][bj][m][n], 0, 0, 0); __builtin_amdgcn_s_setprio(0); } while (0)
#define PG8_WAIT_V(n) asm volatile("s_waitcnt vmcnt(" #n ")" ::: "memory")
#define PG8_WAIT_L(n) asm volatile("s_waitcnt lgkmcnt(" #n ")" ::: "memory")
#define PG8_BAR __builtin_amdgcn_s_barrier()
#define PG8_SCHED __builtin_amdgcn_sched_barrier(0)
    Unit cur, nxt; int ui = 0;
    if (!S.next(0, cur)) return;
    f32x4 acc[2][2][4][2];
#pragma unroll
    for (int a = 0; a < 2; ++a)
#pragma unroll
        for (int b = 0; b < 2; ++b)
#pragma unroll
            for (int m = 0; m < 4; ++m)
#pragma unroll
                for (int n = 0; n < 2; ++n) acc[a][b][m][n] = (f32x4){0.f, 0.f, 0.f, 0.f};
    bf16x8 At[4][2], B0[2][2], B1[2][2];
    const char* cA = (const char*)(cur.seg ? g.A2 : g.A) + (size_t)cur.pm * tstep + (size_t)cur.ks * K * 2; const char* cB = (const char*)(cur.seg ? g.Bt2 : g.Bt) + (size_t)cur.pn * tstep + (size_t)cur.ks * K * 2;
    PG8_STAGE(PG8_SB(0, 0), cB, voffB); PG8_STAGE(PG8_SB(0, 1), cB + hstep, voffB); PG8_STAGE(PG8_SA(0, 0), cA, voffA); PG8_STAGE(PG8_SA(0, 1), cA + hstep, voffA);
    if (wr == 1) PG8_BAR;
    PG8_WAIT_V(2); PG8_BAR;
    PG8_STAGE(PG8_SB(1, 0), cB + kstep, voffB); PG8_STAGE(PG8_SA(1, 0), cA + kstep, voffA); PG8_STAGE(PG8_SB(1, 1), cB + hstep + kstep, voffB);
    PG8_WAIT_V(6); PG8_BAR;
    for (;;) {
        const bool has_next = Sched::SINGLE ? false : S.next(ui + 1, nxt);
        const char* nA = has_next ? (const char*)(nxt.seg ? g.A2 : g.A) + (size_t)nxt.pm * tstep + (size_t)nxt.ks * K * 2 : cA; const char* nB = has_next ? (const char*)(nxt.seg ? g.Bt2 : g.Bt) + (size_t)nxt.pn * tstep + (size_t)nxt.ks * K * 2 : cB;
        for (int t = 0; t < nt; t += 2) {
            const bool last = (t == nt - 2);
            const char* a1 = cA + (size_t)(t + 1) * kstep;
            const char* a2 = last ? nA : cA + (size_t)(t + 2) * kstep; const char* b2 = last ? nB : cB + (size_t)(t + 2) * kstep;
            const char* a3 = a2 + kstep; const char* b3 = b2 + kstep;
            PG8_LDB(B0, 0, 0); PG8_LDB(B1, 0, 1); PG8_SCHED; PG8_LDA(At, 0, 0); PG8_STAGE(PG8_SA(1, 1), a1 + hstep, voffA);
            PG8_WAIT_V(8); PG8_WAIT_L(0); PG8_BAR; PG8_MMA(0, 0, At, B0); PG8_MMA(0, 1, At, B1); PG8_BAR; PG8_SCHED;
            PG8_LDA(At, 0, 1); PG8_STAGE(PG8_SB(0, 0), b2, voffB); PG8_STAGE(PG8_SB(0, 1), b2 + hstep, voffB); PG8_STAGE(PG8_SA(0, 0), a2, voffA);
            PG8_WAIT_V(8); PG8_WAIT_L(0); PG8_BAR; PG8_MMA(1, 0, At, B0); PG8_MMA(1, 1, At, B1); PG8_BAR; PG8_SCHED;
            PG8_LDB(B0, 1, 0); PG8_LDB(B1, 1, 1); PG8_SCHED; PG8_LDA(At, 1, 0); PG8_STAGE(PG8_SA(0, 1), a2 + hstep, voffA);
            PG8_WAIT_V(8); PG8_WAIT_L(0); PG8_BAR; PG8_MMA(0, 0, At, B0); PG8_MMA(0, 1, At, B1); PG8_BAR; PG8_SCHED;
            PG8_LDA(At, 1, 1); PG8_STAGE(PG8_SB(1, 0), b3, voffB); PG8_STAGE(PG8_SB(1, 1), b3 + hstep, voffB); PG8_STAGE(PG8_SA(1, 0), a3, voffA);
            PG8_WAIT_V(8); PG8_WAIT_L(0); PG8_BAR; PG8_MMA(1, 0, At, B0); PG8_MMA(1, 1, At, B1); PG8_BAR; PG8_SCHED;
        }
        if (wr == 0) PG8_BAR;
        E(acc, cur, wr, wc, fr, fq);
        if (!has_next) break;
        if (!nxt.seg) {
#pragma unroll
        for (int a = 0; a < 2; ++a)
#pragma unroll
            for (int b = 0; b < 2; ++b)
#pragma unroll
                for (int m = 0; m < 4; ++m)
#pragma unroll
                    for (int n = 0; n < 2; ++n) acc[a][b][m][n] = (f32x4){0.f, 0.f, 0.f, 0.f}; }
        cur = nxt; cA = nA; cB = nB; ++ui;
        if (wr == 1) PG8_BAR;
    }
    PG8_WAIT_V(0);
    PG8_BAR;
#undef PG8_SA
#undef PG8_SB
#undef PG8_STAGE
#undef PG8_LDA
#undef PG8_LDB
#undef PG8_MMA
#undef PG8_WAIT_V
#undef PG8_WAIT_L
#undef PG8_BAR
#undef PG8_SCHED
}
}

constexpr int S = 16384, DM = 1024, INC = 3864, NPJ = 4096, SSW = 512, NSW = 512, HD = 64, DFF = 2816;
constexpr int NGRP = 32, NST = 64, NCMP = 1023;
constexpr int NWAVES = 8;
constexpr int NPH = 12;
constexpr int CMP_KS = 4;
constexpr float EPS = 1e-6f;

constexpr size_t MiB = 1u << 20;
constexpr size_t WS_CTL = 0;
constexpr size_t WS_TAB = 1 * MiB;
constexpr size_t TAB_BF = 0, TAB_CF = 128 * 1024, TAB_LAM = 256 * 1024, TAB_LAM256 = 272 * 1024, TAB_POSB = 288 * 1024;
constexpr size_t WS_SSP = 1 * MiB + 512 * 1024;
constexpr size_t WS_F = 2 * MiB;
constexpr size_t WS_KVC = 3 * MiB;
constexpr size_t WS_WIN = 4 * MiB, WS_WGU = 12 * MiB, WS_WD = 23 * MiB, WS_WOUT = 29 * MiB, WS_WA = 31 * MiB, WS_WB = 32 * MiB, WS_WGLU = 33 * MiB, WS_WC1 = 34 * MiB;
constexpr size_t WS_XN = 36 * MiB;
constexpr size_t WS_Z = WS_XN, WS_ZG = WS_XN + 16 * MiB;
constexpr size_t WS_U = 68 * MiB, WS_O = WS_U;
constexpr size_t WS_Q = 84 * MiB;
constexpr size_t WS_KVH = 100 * MiB;
constexpr size_t WS_G = 124 * MiB;
constexpr size_t WS_GN = 188 * MiB;
constexpr size_t WS_MIX = 84 * MiB;
constexpr size_t WS_H = 100 * MiB;
constexpr size_t WS_VTW = 189 * MiB;
constexpr size_t WS_VTS = 193 * MiB;
constexpr size_t WS_KCB = 197 * MiB;
constexpr size_t WS_VTC = 197 * MiB + 512 * 1024;
constexpr size_t WS_PSLAB = 198 * MiB;
constexpr size_t WS_END = 254 * MiB;

constexpr int LDS_BYTES = 163840;

#define GAS __attribute__((address_space(1)))
#define LAS __attribute__((address_space(3)))
typedef unsigned short bf16;
typedef unsigned v4u __attribute__((ext_vector_type(4)));
typedef float f32x4 __attribute__((ext_vector_type(4)));
typedef float f32x2 __attribute__((ext_vector_type(2)));
typedef float f32x16 __attribute__((ext_vector_type(16)));
typedef short bf16x8 __attribute__((ext_vector_type(8)));
#define LDS_WAIT() asm volatile("s_waitcnt lgkmcnt(0)" ::: "memory")
#define VM_WAIT() asm volatile("s_waitcnt vmcnt(0)" ::: "memory")
__device__ __forceinline__ unsigned f2bf(float f) { unsigned u = __builtin_bit_cast(unsigned, f); return (u + 0x7fffu + ((u >> 16) & 1u)) >> 16; }
__device__ __forceinline__ unsigned pk2(float lo, float hi) { return f2bf(lo) | (f2bf(hi) << 16); }
__device__ __forceinline__ float bf2f(bf16 v) { return __uint_as_float((unsigned)v << 16); }
using pg8::bflo; using pg8::bfhi; using pg8::sigm; using pg8::cvt_pk_bf16;
__device__ __forceinline__ float gelu_tanh(float y) {
    const float a = 0.7978845608028654f * (y + 0.044715f * y * y * y);
    const float e = __expf(2.0f * a);
    const float th = 1.0f - 2.0f * __builtin_amdgcn_rcpf(e + 1.0f);
    return 0.5f * y * (1.0f + th);
}
__device__ __forceinline__ float wave_sum(float v) {
#pragma unroll
    for (int o = 1; o < 64; o <<= 1) v += __shfl_xor(v, o);
    return v;
}
__device__ __forceinline__ float wave_max(float v) {
#pragma unroll
    for (int o = 1; o < 64; o <<= 1) v = fmaxf(v, __shfl_xor(v, o));
    return v;
}

struct Args { const float* in[27]; float* out; unsigned char* ws; int ph_lo, ph_hi; };

struct Frame {
    LAS unsigned char* lds;
    int tid, lane, wave, G, gw, ngw;
    float* out; unsigned char* ws;
};

using pg8::Unit; using pg8::BM; using pg8::HALF;
struct EpiProj {
    static constexpr bool PERM = true;
    bf16 *U, *Q, *KVH, *Gt, *GN;
    __device__ __forceinline__ void operator()(const f32x4 (&acc)[2][2][4][2], const Unit& u, int wr, int wc, int fr, int fq) const {
        const int row0 = u.pm * BM + wr * 64 + fr, pn = u.pn;
#pragma unroll
        for (int ai = 0; ai < 2; ++ai)
#pragma unroll
            for (int m = 0; m < 4; ++m) { const int row = row0 + ai * HALF + m * 16;
#pragma unroll
                for (int bj = 0; bj < 2; ++bj) { f32x4 v0 = acc[ai][bj][m][0], v1 = acc[ai][bj][m][1]; const int col = bj * HALF + wc * 32 + 8 * fq; bf16* dst;
                    if (pn < 2) dst = U + (size_t)row * 512 + pn * 256 + col;
                    else if (pn < 4) { v0 = v0 * (0.125f * 1.4426950408889634f); v1 = v1 * (0.125f * 1.4426950408889634f); dst = Q + (size_t)row * 512 + (pn - 2) * 256 + col; }
                    else if (pn < 7) dst = KVH + ((size_t)((pn - 4) * 4 + (col >> 6)) * S + row) * 64 + (col & 63);
                    else { v0 = (f32x4){sigm(v0[0]), sigm(v0[1]), sigm(v0[2]), sigm(v0[3])}; v1 = (f32x4){sigm(v1[0]), sigm(v1[1]), sigm(v1[2]), sigm(v1[3])};
                        if (pn < 15) dst = Gt + (size_t)row * 2048 + (pn - 7) * 256 + col; else { if (col >= 32) continue; dst = GN + (size_t)row * 32 + col; } }
                    v4u w; w.x = cvt_pk_bf16(v0[0], v0[1]); w.y = cvt_pk_bf16(v0[2], v0[3]); w.z = cvt_pk_bf16(v1[0], v1[1]); w.w = cvt_pk_bf16(v1[2], v1[3]);
                    *(v4u*)dst = w; } }
    }
};
struct EpiCmp {
    static constexpr bool PERM = false;
    float* C;
    __device__ __forceinline__ void operator()(const f32x4 (&acc)[2][2][4][2], const Unit& u, int wr, int wc, int fr, int fq) const {
        const int row0 = u.pm * BM + wr * 64 + fr, col0 = (u.pn & 1) * BM + wc * 32 + 4 * fq; float* base = C + (size_t)u.ks * 4096 * 512;
#pragma unroll
        for (int ai = 0; ai < 2; ++ai)
#pragma unroll
            for (int m = 0; m < 4; ++m) { float* rowp = base + (size_t)(row0 + ai * HALF + m * 16) * 512 + col0;
#pragma unroll
                for (int bj = 0; bj < 2; ++bj)
#pragma unroll
                    for (int n = 0; n < 2; ++n) *(f32x4*)(rowp + bj * HALF + n * 16) = acc[ai][bj][m][n]; }
    }
};
struct EpiGlu {
    static constexpr bool PERM = true;
    const bf16* Z; bf16* ZG;
    __device__ __forceinline__ void operator()(const f32x4 (&acc)[2][2][4][2], const Unit& u, int wr, int wc, int fr, int fq) const {
        const int row0 = u.pm * BM + wr * 64 + fr;
#pragma unroll
        for (int ai = 0; ai < 2; ++ai)
#pragma unroll
            for (int m = 0; m < 4; ++m) { const int row = row0 + ai * HALF + m * 16;
#pragma unroll
                for (int bj = 0; bj < 2; ++bj) { const f32x4 v0 = acc[ai][bj][m][0], v1 = acc[ai][bj][m][1]; const size_t off = (size_t)row * 512 + u.pn * BM + bj * HALF + wc * 32 + 8 * fq;
                    const v4u z = *(const v4u*)(Z + off); v4u w;
                    w.x = cvt_pk_bf16(bflo(z.x) * sigm(v0[0]), bfhi(z.x) * sigm(v0[1])); w.y = cvt_pk_bf16(bflo(z.y) * sigm(v0[2]), bfhi(z.y) * sigm(v0[3]));
                    w.z = cvt_pk_bf16(bflo(z.z) * sigm(v1[0]), bfhi(z.z) * sigm(v1[1])); w.w = cvt_pk_bf16(bflo(z.w) * sigm(v1[2]), bfhi(z.w) * sigm(v1[3]));
                    *(v4u*)(ZG + off) = w; } }
    }
};
struct EpiMix2 {
    static constexpr bool PERM = true;
    const bf16* Gt; bf16* MIX;
    __device__ __forceinline__ void operator()(f32x4 (&acc)[2][2][4][2], const Unit& u, int wr, int wc, int fr, int fq) const {
        const int row0 = u.pm * BM + wr * 64 + fr;
#pragma unroll
        for (int ai = 0; ai < 2; ++ai)
#pragma unroll
            for (int m = 0; m < 4; ++m) { const int row = row0 + ai * HALF + m * 16;
#pragma unroll
                for (int bj = 0; bj < 2; ++bj) { const int col = u.pn * BM + bj * HALF + wc * 32 + 8 * fq;
                    const v4u gb = *(const v4u*)(Gt + (size_t)row * 2048 + 1024 + col);
                    const float b8[8] = {bflo(gb.x), bfhi(gb.x), bflo(gb.y), bfhi(gb.y), bflo(gb.z), bfhi(gb.z), bflo(gb.w), bfhi(gb.w)};
                    if (u.seg == 0) { const v4u ga = *(const v4u*)(Gt + (size_t)row * 2048 + col);
                        const float a8[8] = {bflo(ga.x), bfhi(ga.x), bflo(ga.y), bfhi(ga.y), bflo(ga.z), bfhi(ga.z), bflo(ga.w), bfhi(ga.w)};
#pragma unroll
                        for (int e = 0; e < 4; ++e) { acc[ai][bj][m][0][e] *= a8[e] * __builtin_amdgcn_rcpf(b8[e]); acc[ai][bj][m][1][e] *= a8[4 + e] * __builtin_amdgcn_rcpf(b8[4 + e]); }
                    } else { const f32x4 v0 = acc[ai][bj][m][0], v1 = acc[ai][bj][m][1]; v4u w;
                        w.x = cvt_pk_bf16(v0[0] * b8[0], v0[1] * b8[1]); w.y = cvt_pk_bf16(v0[2] * b8[2], v0[3] * b8[3]); w.z = cvt_pk_bf16(v1[0] * b8[4], v1[1] * b8[5]); w.w = cvt_pk_bf16(v1[2] * b8[6], v1[3] * b8[7]);
                        *(v4u*)(MIX + (size_t)row * 1024 + col) = w; } } }
    }
};
struct EpiRes {
    static constexpr bool PERM = false;
    const float* base; float* out;
    __device__ __forceinline__ void operator()(const f32x4 (&acc)[2][2][4][2], const Unit& u, int wr, int wc, int fr, int fq) const {
        const int row0 = u.pm * BM + wr * 64 + fr, col0 = u.pn * BM + wc * 32 + 4 * fq;
#pragma unroll
        for (int ai = 0; ai < 2; ++ai)
#pragma unroll
            for (int m = 0; m < 4; ++m) { const size_t off = (size_t)(row0 + ai * HALF + m * 16) * 1024 + col0;
#pragma unroll
                for (int bj = 0; bj < 2; ++bj)
#pragma unroll
                    for (int n = 0; n < 2; ++n) { const f32x4 b = *(const f32x4*)(base + off + bj * HALF + n * 16); *(f32x4*)(out + off + bj * HALF + n * 16) = b + acc[ai][bj][m][n]; } }
    }
};
struct EpiResNorm {
    static constexpr bool PERM = false;
    const float* base; float* out; bf16* XN; float* SSP; LAS float* part;
    __device__ __forceinline__ void operator()(const f32x4 (&acc)[2][2][4][2], const Unit& u, int wr, int wc, int fr, int fq) const {
        const int row0 = u.pm * BM + wr * 64 + fr, col0 = u.pn * BM + wc * 32 + 4 * fq;
#pragma unroll
        for (int ai = 0; ai < 2; ++ai)
#pragma unroll
            for (int m = 0; m < 4; ++m) { const size_t off = (size_t)(row0 + ai * HALF + m * 16) * 1024 + col0; float ss = 0.f;
#pragma unroll
                for (int bj = 0; bj < 2; ++bj)
#pragma unroll
                    for (int n = 0; n < 2; ++n) { const f32x4 b = *(const f32x4*)(base + off + bj * HALF + n * 16); const f32x4 x1 = b + acc[ai][bj][m][n]; *(f32x4*)(out + off + bj * HALF + n * 16) = x1;
                        *(unsigned long long*)(XN + off + bj * HALF + n * 16) = (unsigned long long)cvt_pk_bf16(x1[0], x1[1]) | ((unsigned long long)cvt_pk_bf16(x1[2], x1[3]) << 32);
                        ss += (x1[0] * x1[0] + x1[1] * x1[1]) + (x1[2] * x1[2] + x1[3] * x1[3]); }
                ss += __shfl_xor(ss, 16); ss += __shfl_xor(ss, 32);
                if (fq == 0) part[(ai * HALF + wr * 64 + m * 16 + fr) * 4 + wc] = ss; }
        asm volatile("s_waitcnt lgkmcnt(0)" ::: "memory"); __builtin_amdgcn_s_barrier(); asm volatile("" ::: "memory");
        if (threadIdx.x < 256) { const f32x4 p = *(const LAS f32x4*)(part + threadIdx.x * 4); SSP[(size_t)(u.pm * BM + threadIdx.x) * 4 + u.pn] = (p[0] + p[1]) + (p[2] + p[3]); }
    }
};
struct EpiFfn {
    static constexpr bool PERM = true;
    bf16* H; const float* SSP;
    __device__ __forceinline__ void operator()(const f32x4 (&acc)[2][2][4][2], const Unit& u, int wr, int wc, int fr, int fq) const {
        const int row0 = u.pm * BM + wr * 64 + fr;
#pragma unroll
        for (int ai = 0; ai < 2; ++ai)
#pragma unroll
            for (int m = 0; m < 4; ++m) { const int row = row0 + ai * HALF + m * 16;
                const f32x4 sp = *(const f32x4*)(SSP + (size_t)row * 4); const float rs = 1.0f / sqrtf(((sp[0] + sp[1]) + (sp[2] + sp[3])) * (1.f / 1024.f) + 1e-6f);
                float r[8];
#pragma unroll
                for (int n = 0; n < 2; ++n)
#pragma unroll
                    for (int e = 0; e < 4; ++e) { const float gt = acc[ai][0][m][n][e] * rs, up = acc[ai][1][m][n][e] * rs; r[n * 4 + e] = gt * sigm(gt) * up; }
                v4u w; w.x = cvt_pk_bf16(r[0], r[1]); w.y = cvt_pk_bf16(r[2], r[3]); w.z = cvt_pk_bf16(r[4], r[5]); w.w = cvt_pk_bf16(r[6], r[7]);
                *(v4u*)(H + (size_t)row * DFF + u.pn * HALF + wc * 32 + 8 * fq) = w; }
    }
};

struct TrDesc { const float* src; bf16* dst; int ld, ncols, dld, drow, kb, nb; const float* gain; };
__device__ __forceinline__ void tr_load(const TrDesc& d, float (&v)[32], int lane) {
    const int k0 = 64 * d.kb, c = 32 * d.nb + (lane & 31); const bool ok = c < d.ncols; const float* p = d.src + (size_t)(k0 + (lane >> 5)) * d.ld + c;
#pragma unroll
    for (int i = 0; i < 32; ++i) v[i] = ok ? p[(size_t)(2 * i) * d.ld] : 0.f;
    if (d.gain) {
#pragma unroll
        for (int i = 0; i < 32; ++i) v[i] *= d.gain[k0 + 2 * i + (lane >> 5)]; }
}
__device__ __forceinline__ void tr_finish(const TrDesc& d, const float (&v)[32], LAS float* scr, int lane) {
#pragma unroll
    for (int i = 0; i < 32; ++i) scr[(2 * i + (lane >> 5)) * 33 + (lane & 31)] = v[i];
    LDS_WAIT();
    const int cc = lane & 7, k0 = 64 * d.kb;
#pragma unroll
    for (int j = 0; j < 4; ++j) { const int n = (lane >> 3) + 8 * j; const LAS float* s = scr + (8 * cc) * 33 + n;
        v4u o; o.x = pk2(s[0 * 33], s[1 * 33]); o.y = pk2(s[2 * 33], s[3 * 33]); o.z = pk2(s[4 * 33], s[5 * 33]); o.w = pk2(s[6 * 33], s[7 * 33]);
        *(v4u*)(d.dst + (size_t)(d.drow + n) * d.dld + k0 + 8 * cc) = o; }
    LDS_WAIT();
}
__device__ __forceinline__ void rms_row_to_bf16(const float* xrow, const float* gain, bf16* orow, int lane) {
    const f32x4* xr = (const f32x4*)xrow + lane; const f32x4* gr = (const f32x4*)gain + lane;
    f32x4 v[4]; float s = 0.f;
#pragma unroll
    for (int j = 0; j < 4; ++j) { v[j] = xr[64 * j]; s += (v[j].x * v[j].x + v[j].y * v[j].y) + (v[j].z * v[j].z + v[j].w * v[j].w); }
    const float rstd = 1.0f / sqrtf(wave_sum(s) * (1.f / DM) + EPS);
    unsigned long long* o8 = (unsigned long long*)orow + lane;
#pragma unroll
    for (int j = 0; j < 4; ++j) { const f32x4 gq = gr[64 * j];
        o8[64 * j] = (unsigned long long)pk2(v[j].x * rstd * gq.x, v[j].y * rstd * gq.y) | ((unsigned long long)pk2(v[j].z * rstd * gq.z, v[j].w * rstd * gq.w) << 32); }
}
__device__ __forceinline__ void rms_rows2_to_bf16(const float* x0, const float* x1, const float* gain, bf16* o0, bf16* o1, int lane) {
    const f32x4* xa = (const f32x4*)x0 + lane; const f32x4* xb = (const f32x4*)x1 + lane; const f32x4* gr = (const f32x4*)gain + lane;
    f32x4 va[4], vb[4]; float sa = 0.f, sb = 0.f;
#pragma unroll
    for (int j = 0; j < 4; ++j) { va[j] = xa[64 * j]; vb[j] = xb[64 * j]; }
#pragma unroll
    for (int j = 0; j < 4; ++j) { sa += (va[j].x * va[j].x + va[j].y * va[j].y) + (va[j].z * va[j].z + va[j].w * va[j].w); sb += (vb[j].x * vb[j].x + vb[j].y * vb[j].y) + (vb[j].z * vb[j].z + vb[j].w * vb[j].w); }
    const float ra = 1.0f / sqrtf(wave_sum(sa) * (1.f / DM) + EPS), rb = 1.0f / sqrtf(wave_sum(sb) * (1.f / DM) + EPS);
    unsigned long long* pa = (unsigned long long*)o0 + lane; unsigned long long* pb = (unsigned long long*)o1 + lane;
#pragma unroll
    for (int j = 0; j < 4; ++j) { const f32x4 gq = gr[64 * j];
        pa[64 * j] = (unsigned long long)pk2(va[j].x * ra * gq.x, va[j].y * ra * gq.y) | ((unsigned long long)pk2(va[j].z * ra * gq.z, va[j].w * ra * gq.w) << 32);
        pb[64 * j] = (unsigned long long)pk2(vb[j].x * rb * gq.x, vb[j].y * rb * gq.y) | ((unsigned long long)pk2(vb[j].z * rb * gq.z, vb[j].w * rb * gq.w) << 32); }
}
__device__ __forceinline__ void rms_row_f32(float* xrow, const float* gain, int lane) {
    f32x4* xr = (f32x4*)xrow + lane; const f32x4* gr = (const f32x4*)gain + lane;
    f32x4 v[4]; float s = 0.f;
#pragma unroll
    for (int j = 0; j < 4; ++j) { v[j] = xr[64 * j]; s += (v[j].x * v[j].x + v[j].y * v[j].y) + (v[j].z * v[j].z + v[j].w * v[j].w); }
    const float rstd = 1.0f / sqrtf(wave_sum(s) * (1.f / DM) + EPS);
#pragma unroll
    for (int j = 0; j < 4; ++j) { const f32x4 gq = gr[64 * j]; xr[64 * j] = v[j] * rstd * gq; }
}
__device__ __forceinline__ void s5_tables(const Frame& F, const Args& args, int g) {
    const int lane = F.lane;
    const float* are = args.in[3]; const float* aim = args.in[4]; const float* ldt = args.in[5]; const float* bre = args.in[6]; const float* bim = args.in[7]; const float* cre = args.in[8]; const float* cim = args.in[9];
    const double dt = exp((double)ldt[g]);
    {   const int p = lane; const double ar = are[g * 64 + p], ai = aim[g * 64 + p];
        const double er = exp(ar * dt), lr = er * cos(ai * dt), li = er * sin(ai * dt);
        ((f32x2*)(F.ws + WS_TAB + TAB_LAM))[g * 64 + p] = (f32x2){(float)lr, (float)li};
        const double e2 = exp(ar * dt * 256.0), l2r = e2 * cos(ai * dt * 256.0), l2i = e2 * sin(ai * dt * 256.0);
        ((f32x2*)(F.ws + WS_TAB + TAB_LAM256))[g * 64 + p] = (f32x2){(float)l2r, (float)l2i}; }
#pragma unroll
    for (int nt = 0; nt < 4; ++nt) { const int col = 32 * nt + (lane & 31), p = col >> 1, ri = col & 1;
        const double ar = are[g * 64 + p], ai = aim[g * 64 + p];
        const double er = exp(ar * dt), lr = er * cos(ai * dt) - 1.0, li = er * sin(ai * dt);
        const double den = ar * ar + ai * ai, kr = (lr * ar + li * ai) / den, ki = (li * ar - lr * ai) / den;
        float v[8];
#pragma unroll
        for (int j = 0; j < 8; ++j) { const int c = 8 * (lane >> 5) + j; const double br = bre[(g * 64 + p) * 16 + c], bi = bim[(g * 64 + p) * 16 + c];
            v[j] = (float)(ri ? (kr * bi + ki * br) : (kr * br - ki * bi)); }
        v4u o; o.x = pk2(v[0], v[1]); o.y = pk2(v[2], v[3]); o.z = pk2(v[4], v[5]); o.w = pk2(v[6], v[7]);
        ((v4u*)(F.ws + WS_TAB + TAB_BF))[(g * 4 + nt) * 64 + lane] = o; }
#pragma unroll
    for (int ks = 0; ks < 4; ++ks) { const int ch = lane & 15; float v[8];
#pragma unroll
        for (int j = 0; j < 8; ++j) { const int k = 32 * ks + 8 * (lane >> 4) + j, p = k >> 1, ri = k & 1; v[j] = ri ? -cim[(g * 16 + ch) * 64 + p] : cre[(g * 16 + ch) * 64 + p]; }
        v4u o; o.x = pk2(v[0], v[1]); o.y = pk2(v[2], v[3]); o.z = pk2(v[4], v[5]); o.w = pk2(v[6], v[7]);
        ((v4u*)(F.ws + WS_TAB + TAB_CF))[(g * 4 + ks) * 64 + lane] = o; }
}
__device__ __forceinline__ void p0_prologue(const Frame& F, const Args& args) {
    LAS float* scr = (LAS float*)(F.lds + F.wave * 16384);
    const int gw = F.gw, NGW = F.ngw, lane = F.lane;
    if (F.wave == 0 && blockIdx.x < 32) s5_tables(F, args, (int)blockIdx.x);
    else if (F.wave == 1 && blockIdx.x < 128) {
        const int it = (int)blockIdx.x, kv = it >> 6, part = (it >> 2) & 15, cgp = it & 3;
        const float* pos = kv ? args.in[14] : args.in[13]; const float* w1 = kv ? args.in[17] : args.in[15]; float a = 0.f;
#pragma unroll 1
        for (int r0 = 128 * part; r0 < 128 * part + 128; r0 += 32) { float wv[32];
#pragma unroll
            for (int i = 0; i < 32; ++i) wv[i] = w1[(size_t)(r0 + i) * 256 + cgp * 64 + lane];
#pragma unroll
            for (int i = 0; i < 32; ++i) a += pos[r0 + i] * wv[i]; }
        ((float*)(F.ws + WS_TAB + TAB_POSB))[(kv * 16 + part) * 256 + cgp * 64 + lane] = a;
    }
    { v4u* z = (v4u*)(F.ws + WS_WIN + (size_t)3872 * 1024 * 2); const int n16 = 224 * 1024 * 2 / 16;
      for (int i = blockIdx.x * 512 + F.tid; i < n16; i += F.G * 512) z[i] = (v4u){0u, 0u, 0u, 0u}; }
    bf16* WIN = (bf16*)(F.ws + WS_WIN); bf16* WGU = (bf16*)(F.ws + WS_WGU); bf16* WD = (bf16*)(F.ws + WS_WD); bf16* WOUT = (bf16*)(F.ws + WS_WOUT);
    bf16* WA = (bf16*)(F.ws + WS_WA); bf16* WB = (bf16*)(F.ws + WS_WB); bf16* WGLU = (bf16*)(F.ws + WS_WGLU); bf16* WC1 = (bf16*)(F.ws + WS_WC1);
    constexpr int I1 = 16 * 56, I2 = 16 * 64, I3 = 16, IGLU = 8 * 16, IUP = 8 * 32, IOUT = 16 * 32, IFF = 16 * 88, IDN = 44 * 32, ICM = 16 * 8;
    constexpr int NITEMS = I1 + I2 + I3 + IGLU + 2 * IUP + IOUT + 2 * IFF + IDN + 4 * ICM;
    auto desc = [&](int it) -> TrDesc {
        int r = it;
        if (r < I1) return TrDesc{args.in[2], WIN, INC, 1792, 1024, 32 * (r % 56), r / 56, r % 56, nullptr}; r -= I1;
        if (r < I2) return TrDesc{args.in[2] + 1816, WIN, INC, 2048, 1024, 1792 + 32 * (r % 64), r / 64, r % 64, nullptr}; r -= I2;
        if (r < I3) return TrDesc{args.in[2] + 1792, WIN, INC, 24, 1024, 3840, r, 0, nullptr}; r -= I3;
        if (r < IGLU) return TrDesc{args.in[11], WGLU, 512, 512, 512, 32 * (r % 16), r / 16, r % 16, nullptr}; r -= IGLU;
        if (r < IUP) return TrDesc{args.in[12], WA, 1024, 1024, 512, 32 * (r % 32), r / 32, r % 32, nullptr}; r -= IUP;
        if (r < IUP) return TrDesc{args.in[20], WB, 1024, 1024, 512, 32 * (r % 32), r / 32, r % 32, nullptr}; r -= IUP;
        if (r < IOUT) return TrDesc{args.in[21], WOUT, 1024, 1024, 1024, 32 * (r % 32), r / 32, r % 32, nullptr}; r -= IOUT;
        if (r < IFF) { const int nb = r % 88; return TrDesc{args.in[23], WGU, DFF, DFF, 1024, (nb >> 2) * 256 + (nb & 3) * 32, r / 88, nb, args.in[22]}; } r -= IFF;
        if (r < IFF) { const int nb = r % 88; return TrDesc{args.in[24], WGU, DFF, DFF, 1024, (nb >> 2) * 256 + (nb & 3) * 32 + 128, r / 88, nb, args.in[22]}; } r -= IFF;
        if (r < IDN) return TrDesc{args.in[25], WD, 1024, 1024, DFF, 32 * (r % 32), r / 32, r % 32, nullptr}; r -= IDN;
        const int q = r / ICM, rr = r % ICM;
        return TrDesc{((q >> 1) ? args.in[17] : args.in[15]) + (size_t)(q & 1) * 1024 * 256, WC1, 256, 256, 1024, q * 256 + 32 * (rr % 8), rr / 8, rr % 8, nullptr};
    };
    if (gw < NITEMS) {
        TrDesc dc = desc(gw); float vc[32]; tr_load(dc, vc, lane);
#pragma unroll 1
        for (int it = gw; it < NITEMS; it += NGW) {
            const bool more = it + NGW < NITEMS; TrDesc dn = desc(more ? it + NGW : it); float vn[32]; tr_load(dn, vn, lane);
            tr_finish(dc, vc, scr, lane);
            dc = dn;
#pragma unroll
            for (int i = 0; i < 32; ++i) vc[i] = vn[i];
        }
    }
    bf16* XN = (bf16*)(F.ws + WS_XN);
    for (int m = gw; m < S; m += 2 * NGW) rms_rows2_to_bf16(args.in[0] + (size_t)m * DM, args.in[0] + (size_t)(m + NGW) * DM, args.in[1], XN + (size_t)m * DM, XN + (size_t)(m + NGW) * DM, lane);
}

__device__ __forceinline__ int crow(int r, int hi) { return (r & 3) + 8 * (r >> 2) + 4 * hi; }
template <bool FINAL>
__device__ __forceinline__ void s5_unit(const Frame& F, const Args& args, int c, int g, LAS unsigned char* wl, LAS unsigned char* wx) {
    const int lane = F.lane, hi = lane >> 5;
    const bf16* U = (const bf16*)(F.ws + WS_U); bf16* Z = (bf16*)(F.ws + WS_Z);
    bf16x8 bfg[4], cfg[4], ua[8];
#pragma unroll
    for (int sub = 0; sub < 8; ++sub) ua[sub] = *(const bf16x8*)(U + (size_t)(c * 256 + sub * 32 + (lane & 31)) * 512 + g * 16 + 8 * hi);
#pragma unroll
    for (int nt = 0; nt < 4; ++nt) bfg[nt] = ((const bf16x8*)(F.ws + WS_TAB + TAB_BF))[(g * 4 + nt) * 64 + lane];
    const f32x2 lam = ((const f32x2*)(F.ws + WS_TAB + TAB_LAM))[g * 64 + lane];
    f32x2* Fst = (f32x2*)(F.ws + WS_F);
    float xr = 0.f, xi = 0.f, dsk = 0.f;
    if (FINAL) {
#pragma unroll
        for (int ks = 0; ks < 4; ++ks) cfg[ks] = ((const bf16x8*)(F.ws + WS_TAB + TAB_CF))[(g * 4 + ks) * 64 + lane];
        dsk = args.in[10][g * 16 + (lane & 15)];
        const f32x2 L2 = ((const f32x2*)(F.ws + WS_TAB + TAB_LAM256))[g * 64 + lane];
        for (int cp = 0; cp < c; ++cp) { const f32x2 f = Fst[(cp * 32 + g) * 64 + lane]; const float nr = L2.x * xr - L2.y * xi + f.x, ni = L2.x * xi + L2.y * xr + f.y; xr = nr; xi = ni; }
    }
#pragma unroll
    for (int sub = 0; sub < 8; ++sub) {
        const int t0 = c * 256 + sub * 32;
        const bf16x8 a = ua[sub];
        if (FINAL) *(LAS bf16x8*)(wx + (lane & 31) * 32 + hi * 16) = a;
#pragma unroll
        for (int nt = 0; nt < 4; ++nt) { f32x16 acc = {}; acc = __builtin_amdgcn_mfma_f32_32x32x16_bf16(a, bfg[nt], acc, 0, 0, 0);
#pragma unroll
            for (int r = 0; r < 16; ++r) ((LAS float*)wl)[crow(r, hi) * 128 + 32 * nt + (lane & 31)] = acc[r]; }
        LDS_WAIT();
        f32x2 bu[32];
#pragma unroll
        for (int tk = 0; tk < 32; ++tk) bu[tk] = ((const LAS f32x2*)wl)[tk * 64 + lane];
        LDS_WAIT();
#pragma unroll
        for (int tk = 0; tk < 32; ++tk) { const float nr = lam.x * xr - lam.y * xi + bu[tk].x, ni = lam.x * xi + lam.y * xr + bu[tk].y; xr = nr; xi = ni;
            if (FINAL) ((LAS unsigned*)wl)[tk * 128 + ((lane + 4 * tk) & 63)] = pk2(xr, xi); }
        if (FINAL) {
            LDS_WAIT();
            LAS unsigned short* zt = (LAS unsigned short*)(wx + 1024);
#pragma unroll
            for (int mt = 0; mt < 2; ++mt) { f32x4 y4 = {0.f, 0.f, 0.f, 0.f}; const int row = 16 * mt + (lane & 15);
#pragma unroll
                for (int ks = 0; ks < 4; ++ks) { const bf16x8 xa = *(const LAS bf16x8*)(wl + row * 512 + ((64 * ks + 16 * (lane >> 4) + 16 * row) & 255)); y4 = __builtin_amdgcn_mfma_f32_16x16x32_bf16(xa, cfg[ks], y4, 0, 0, 0); }
#pragma unroll
                for (int r = 0; r < 4; ++r) { const int tok = 16 * mt + 4 * (lane >> 4) + r; const float uu = bf2f(((const LAS unsigned short*)wx)[tok * 16 + (lane & 15)]);
                    zt[tok * 16 + (lane & 15)] = (unsigned short)f2bf(gelu_tanh(y4[r] + dsk * uu)); } }
            LDS_WAIT();
            *(v4u*)(Z + (size_t)(t0 + (lane >> 1)) * 512 + g * 16 + 8 * (lane & 1)) = *(const LAS v4u*)(wx + 1024 + lane * 16);
            LDS_WAIT();
        }
    }
    if (!FINAL) Fst[(c * 32 + g) * 64 + lane] = (f32x2){xr, xi};
}

__device__ __forceinline__ int krow(int s, int h, int j) { return 16 * s + 8 * (j >> 2) + 4 * h + (j & 3); }
__device__ __forceinline__ void cmp_l2_unit(const Frame& F, const Args& args, int kv, int g, int n, LAS float* hb, const LAS float* w2s) {
    const int lane = F.lane; const float* P1 = F.out;
    float o = 0.f;
    if (n < NCMP) {
        const int rt = kv * 2048 + g * 1024 + n;
        const float* posb = (const float*)(F.ws + WS_TAB + TAB_POSB) + kv * 16 * 256;
#pragma unroll
        for (int i = 0; i < 4; ++i) { const int j = lane + 64 * i; float a = 0.f;
#pragma unroll
            for (int ks = 0; ks < CMP_KS; ++ks) a += P1[((size_t)ks * 4096 + rt) * 512 + j] + P1[((size_t)ks * 4096 + rt + 1) * 512 + 256 + j];
#pragma unroll
            for (int p = 0; p < 16; ++p) a += posb[p * 256 + j];
            hb[j] = gelu_tanh(a); }
        LDS_WAIT();
#pragma unroll 8
        for (int j = 0; j < 256; ++j) o += hb[j] * w2s[j * 64 + lane];
    }
    if (kv == 0) ((bf16*)(F.ws + WS_KCB))[((size_t)g * 1024 + n) * 64 + lane] = (bf16)f2bf(o);
    else { const int grp = n >> 5, kk = n & 31, sx = kk >> 4, rem = kk & 15, hh = (rem >> 2) & 1, j = ((rem >> 3) << 2) | (rem & 3), d0 = lane >> 5, ln = hh * 32 + (lane & 31);
        ((bf16*)(F.ws + WS_VTC))[((((size_t)(g * 32 + grp) * 2 + d0) * 2 + sx) * 64 + ln) * 8 + j] = (bf16)f2bf(o); }
    LDS_WAIT();
}
__device__ __forceinline__ void vtw_item(const Frame& F, int g, int grp) {
    const int lane = F.lane, hi = lane >> 5; const bf16* V = (const bf16*)(F.ws + WS_KVH) + (size_t)(10 + g) * S * 64;
#pragma unroll
    for (int d0 = 0; d0 < 2; ++d0)
#pragma unroll
        for (int sx = 0; sx < 2; ++sx) { unsigned w[4];
#pragma unroll
            for (int jj = 0; jj < 4; ++jj) { const bf16 a = V[(size_t)(32 * grp + krow(sx, hi, 2 * jj)) * 64 + 32 * d0 + (lane & 31)], b = V[(size_t)(32 * grp + krow(sx, hi, 2 * jj + 1)) * 64 + 32 * d0 + (lane & 31)]; w[jj] = (unsigned)a | ((unsigned)b << 16); }
            ((v4u*)(F.ws + WS_VTW))[(((size_t)(g * 512 + grp) * 2 + d0) * 2 + sx) * 64 + lane] = (v4u){w[0], w[1], w[2], w[3]}; }
}
__device__ __forceinline__ int kap(int ks, int q, int j) { return 16 * (2 * ks + (j >> 2)) + 4 * q + (j & 3); }
__device__ __forceinline__ void vts_item(const Frame& F, int g, int blk) {
    const int lane = F.lane, q = lane >> 4; const bf16* V = (const bf16*)(F.ws + WS_KVH) + (size_t)(6 + g) * S * 64;
#pragma unroll
    for (int dt = 0; dt < 4; ++dt)
#pragma unroll
        for (int ks = 0; ks < 2; ++ks) { unsigned w[4];
#pragma unroll
            for (int jj = 0; jj < 4; ++jj) { const bf16 a = V[(size_t)(64 * blk + kap(ks, q, 2 * jj)) * 64 + 16 * dt + (lane & 15)], b = V[(size_t)(64 * blk + kap(ks, q, 2 * jj + 1)) * 64 + 16 * dt + (lane & 15)]; w[jj] = (unsigned)a | ((unsigned)b << 16); }
            ((v4u*)(F.ws + WS_VTS))[(((size_t)(g * 256 + blk) * 4 + dt) * 2 + ks) * 64 + lane] = (v4u){w[0], w[1], w[2], w[3]}; }
}

constexpr int AT_SC = 0;
constexpr int AT_SEL = 67584;
constexpr int AT_CNT = AT_SEL + 4096;
constexpr int AT_LIST = AT_CNT + 1024;
constexpr int AT_BT = AT_LIST + 32768;
constexpr int AT_PARK = AT_BT + 4096;
constexpr int AT_TILE = AT_PARK + 32768;
constexpr int AT_END = AT_TILE + 16384;
static_assert(AT_END <= LDS_BYTES - 64, "attention LDS map");
constexpr int PSLOTS = 832, PSLAB = 458752;
constexpr int PML_OFF = PSLOTS * 512;
constexpr int SCS = 264;

__device__ __forceinline__ bf16x8 pack8(float a0, float a1, float a2, float a3, float a4, float a5, float a6, float a7) {
    v4u w; w.x = cvt_pk_bf16(a0, a1); w.y = cvt_pk_bf16(a2, a3); w.z = cvt_pk_bf16(a4, a5); w.w = cvt_pk_bf16(a6, a7); return __builtin_bit_cast(bf16x8, w);
}
__device__ __forceinline__ float xmax32(float v) { auto r = __builtin_amdgcn_permlane32_swap(__float_as_uint(v), __float_as_uint(v), false, false); return fmaxf(__uint_as_float(r[0]), __uint_as_float(r[1])); }
__device__ __forceinline__ float xsum32(float v) { auto r = __builtin_amdgcn_permlane32_swap(__float_as_uint(v), __float_as_uint(v), false, false); return __uint_as_float(r[0]) + __uint_as_float(r[1]); }
__device__ __forceinline__ float xmax16(float v) { auto r = __builtin_amdgcn_permlane16_swap(__float_as_uint(v), __float_as_uint(v), false, false); return fmaxf(__uint_as_float(r[0]), __uint_as_float(r[1])); }
__device__ __forceinline__ float xsum16(float v) { auto r = __builtin_amdgcn_permlane16_swap(__float_as_uint(v), __float_as_uint(v), false, false); return __uint_as_float(r[0]) + __uint_as_float(r[1]); }
__device__ __forceinline__ float max16(const f32x16& a) {
    const float m0 = fmaxf(fmaxf(a[0], a[1]), fmaxf(a[2], a[3])), m1 = fmaxf(fmaxf(a[4], a[5]), fmaxf(a[6], a[7])), m2 = fmaxf(fmaxf(a[8], a[9]), fmaxf(a[10], a[11])), m3 = fmaxf(fmaxf(a[12], a[13]), fmaxf(a[14], a[15]));
    return fmaxf(fmaxf(m0, m1), fmaxf(m2, m3)); }
__device__ __forceinline__ float sum16(const f32x16& a) {
    const float s0 = (a[0] + a[1]) + (a[2] + a[3]), s1 = (a[4] + a[5]) + (a[6] + a[7]), s2 = (a[8] + a[9]) + (a[10] + a[11]), s3 = (a[12] + a[13]) + (a[14] + a[15]);
    return (s0 + s1) + (s2 + s3); }
__device__ __forceinline__ int fenc(float f) { int k = __float_as_int(f); return k ^ ((k >> 31) & 0x7fffffff); }
__device__ __forceinline__ float fdec(int k) { return __int_as_float(k ^ ((k >> 31) & 0x7fffffff)); }
#define MFMA32(a, b, c) __builtin_amdgcn_mfma_f32_32x32x16_bf16((a), (b), (c), 0, 0, 0)
#define MFMA16(a, b, c) __builtin_amdgcn_mfma_f32_16x16x32_bf16((a), (b), (c), 0, 0, 0)
#define DPPI(x, ctrl) __builtin_amdgcn_update_dpp(0, (x), (ctrl), 0xF, 0xF, false)

struct AttnPtrs { const bf16* Q; const bf16* KCB; const bf16x8* VTC; const bf16* KW; const bf16x8* VTW; const bf16* KS; const bf16x8* VTS; const bf16* GN; bf16* O; };

__device__ __forceinline__ void attn_stageA(const AttnPtrs& P, int lane, int wave, int tile0, int g, LAS unsigned char* lds) {
    const int hi = lane >> 5, c32 = lane & 31, ti = c32 >> 2, hr = c32 & 3, h = g * 4 + hr, t0 = tile0 + 8 * wave, t = t0 + ti;
    LAS float* scores = (LAS float*)(lds + AT_SC) + (8 * wave) * SCS; const LAS float* BT = (const LAS float*)(lds + AT_BT); LAS int* sel = (LAS int*)(lds + AT_SEL) + (8 * wave) * 16;
    for (int k = lane; k < 8 * SCS / 4; k += 64) ((LAS f32x4*)scores)[k] = (f32x4){0.f, 0.f, 0.f, 0.f};
    bf16x8 bq[4];
#pragma unroll
    for (int ks = 0; ks < 4; ++ks) bq[ks] = *(const bf16x8*)(P.Q + (size_t)t * 512 + h * 64 + 16 * ks + 8 * hi);
    const float cb = BT[h * 128 + 127];
    const float g0 = bf2f(P.GN[(size_t)t * 32 + h * 3 + 0]), g2 = bf2f(P.GN[(size_t)t * 32 + h * 3 + 2]);
    LDS_WAIT();
    const int tid = wave * 64 + lane; LAS unsigned char* tb = lds + AT_TILE;
    const int ldrow = tid >> 3, ldch = tid & 7; const unsigned stoff = (tid < 256) ? (unsigned)(ldrow * 128 + ((ldch ^ (ldrow & 7)) << 4)) : (unsigned)(8192 + (tid - 256) * 16);
    const unsigned kof = (unsigned)(c32 * 128), ksw = (unsigned)(c32 & 7);
#define KFRAG(buf, ks) (*(const LAS bf16x8*)(tb + (buf) * 4096 + kof + ((((ks) * 2 + hi) ^ ksw) << 4)))
#define VFRAG(buf, f) (*(const LAS bf16x8*)(tb + 8192 + (buf) * 4096 + ((f) * 64 + lane) * 16))
#define STAGE_LOAD(Kp, kmax, VTp, gmax, n0v) ((tid < 256) ? *(const v4u*)((Kp) + (size_t)min((n0v) + ldrow, (kmax)) * 64 + ldch * 8) : *(const v4u*)((VTp) + (size_t)min((n0v) >> 5, (gmax)) * 256 + (tid - 256)))
#define STAGE_WRITE(v, buf) (*(LAS v4u*)(tb + (buf) * 4096 + stoff) = (v))
#define PVACC(o0v, o1v, buf, a) do { const bf16x8 p0_ = pack8(a[0], a[1], a[2], a[3], a[4], a[5], a[6], a[7]), p1_ = pack8(a[8], a[9], a[10], a[11], a[12], a[13], a[14], a[15]); \
        o0v = MFMA32(VFRAG(buf, 0), p0_, o0v); o0v = MFMA32(VFRAG(buf, 1), p1_, o0v); o1v = MFMA32(VFRAG(buf, 2), p0_, o1v); o1v = MFMA32(VFRAG(buf, 3), p1_, o1v); } while (0)
    constexpr float SM_THR = 8.0f;
#define REF_EVENT(a, mref, started, d, fs) { const float tm_ = xmax32(max16(a)); const bool need_ = started ? (tm_ > SM_THR) : (tm_ > -1e29f); d = 0.f; fs = 1.f; \
        if (__any(need_)) { d = need_ ? tm_ : 0.f; fs = (need_ && started) ? __builtin_amdgcn_exp2f(-d) : 1.f; mref += d; started = started || need_; _Pragma("unroll") for (int r = 0; r < 16; ++r) a[r] -= d; } }
    const int ncb = (tile0 + 63 >= 31) ? min((tile0 + 63 - 31) / 16 + 1, NCMP) : 0, ntc = (ncb + 31) >> 5;
    const int nfar = (t0 >= 144) ? (t0 - 144) / 16 + 1 : 0;
#define CSCORE(a, buf, n0v, farv, refv) do { { const float ini_ = ((farv) ? cb : 0.f) - (refv); _Pragma("unroll") for (int r = 0; r < 16; ++r) a[r] = ini_; } \
        _Pragma("unroll") for (int ks = 0; ks < 4; ++ks) a = MFMA32(KFRAG(buf, ks), bq[ks], a); \
        if (!(farv)) { _Pragma("unroll") for (int r = 0; r < 16; ++r) { const int dist = t - (16 * ((n0v) + crow(r, hi)) + 31); const float bt = BT[h * 128 + min(max(dist, 0), 127)]; a[r] = dist >= 0 ? a[r] + bt : -1e30f; } } } while (0)
#define STAGE_PROLOGUE(Kp, kmax, VTp, gmax, nbase, ntl) v4u RA, RB; { RA = STAGE_LOAD(Kp, kmax, VTp, gmax, nbase); STAGE_WRITE(RA, 0); RB = STAGE_LOAD(Kp, kmax, VTp, gmax, (nbase) + 32 * min(1, (ntl) - 1)); __syncthreads(); }
    float mc = 0.f, lc = 0.f; bool stc = false;
    if (ntc > 0) {
        STAGE_PROLOGUE(P.KCB, 1023, P.VTC, 31, 0, ntc)
#define C1STEP(iv, BUF, RL, RW) { const int i = (iv); if (i >= ntc) break; const int n0 = 32 * i; RL = STAGE_LOAD(P.KCB, 1023, P.VTC, 31, 32 * min(i + 2, ntc - 1)); \
            const bool far = (n0 + 32 <= nfar); f32x16 a; CSCORE(a, BUF, n0, far, mc); \
            float d_, fs_; REF_EVENT(a, mc, stc, d_, fs_) lc *= fs_; \
            _Pragma("unroll") for (int r = 0; r < 16; ++r) a[r] = __builtin_amdgcn_exp2f(a[r]); \
            lc += xsum32(sum16(a)); STAGE_WRITE(RW, (BUF) ^ 1); __syncthreads(); }
        for (int ib = 0; ; ib += 2) { C1STEP(ib, 0, RA, RB) C1STEP(ib + 1, 1, RB, RA) }
#undef C1STEP
    }
    {   const float invl = 1.0f / fmaxf(lc, 1e-30f); f32x16 oc0 = {}, oc1 = {}; float carry = 0.f;
#define CIMP(a, n0v) do { float mq[4], cq[4]; \
            _Pragma("unroll") for (int qg = 0; qg < 4; ++qg) { float mv = (2.0f * (a[4 * qg] + a[4 * qg + 1] + a[4 * qg + 2]) + a[4 * qg + 3]) * invl, cv = a[4 * qg + 3] * invl; \
                mv += __int_as_float(DPPI(__float_as_int(mv), 0xB1)); mv += __int_as_float(DPPI(__float_as_int(mv), 0x4E)); \
                cv += __int_as_float(DPPI(__float_as_int(cv), 0xB1)); cv += __int_as_float(DPPI(__float_as_int(cv), 0x4E)); mq[qg] = mv; cq[qg] = cv; } \
            float oth[4]; \
            _Pragma("unroll") for (int qg = 0; qg < 4; ++qg) { auto rr = __builtin_amdgcn_permlane32_swap(__float_as_uint(cq[qg]), __float_as_uint(cq[qg]), false, false); oth[qg] = __uint_as_float(hi ? rr[0] : rr[1]); } \
            _Pragma("unroll") for (int qg = 0; qg < 4; ++qg) { const float tot = mq[qg] + (hi ? oth[qg] : (qg ? oth[qg - 1] : carry)); if (hr == 0) scores[ti * SCS + (((n0v) + 8 * qg + 4 * hi) >> 2)] = tot; } \
            carry = oth[3]; } while (0)
        if (ntc > 0) {
            STAGE_PROLOGUE(P.KCB, 1023, P.VTC, 31, 0, ntc)
#define C2STEP(iv, BUF, RL, RW) { const int i = (iv); if (i >= ntc) break; const int n0 = 32 * i; RL = STAGE_LOAD(P.KCB, 1023, P.VTC, 31, 32 * min(i + 2, ntc - 1)); \
                const bool far = (n0 + 32 <= nfar); f32x16 a; CSCORE(a, BUF, n0, far, mc); \
                _Pragma("unroll") for (int r = 0; r < 16; ++r) a[r] = __builtin_amdgcn_exp2f(a[r]); \
                CIMP(a, n0); PVACC(oc0, oc1, BUF, a); STAGE_WRITE(RW, (BUF) ^ 1); __syncthreads(); }
            for (int ib = 0; ; ib += 2) { C2STEP(ib, 0, RA, RB) C2STEP(ib + 1, 1, RB, RA) }
#undef C2STEP
            { const int jn = ntc * 8; if (jn < 256 && hi == 0 && hr == 0) scores[ti * SCS + jn] = carry; }
        }
#undef CIMP
        {   LAS unsigned char* park = lds + AT_PARK + (((8 * wave + ti) * 4 + hr) * 64) * 2;
            const float gs = g0 * invl;
#pragma unroll
            for (int d0 = 0; d0 < 2; ++d0)
#pragma unroll
                for (int r4 = 0; r4 < 4; ++r4) { const f32x16& Wd = d0 ? oc1 : oc0; const int dim = 32 * d0 + 8 * r4 + 4 * hi;
                    *(LAS unsigned long long*)(park + dim * 2) = (unsigned long long)cvt_pk_bf16(Wd[4 * r4] * gs, Wd[4 * r4 + 1] * gs) | ((unsigned long long)cvt_pk_bf16(Wd[4 * r4 + 2] * gs, Wd[4 * r4 + 3] * gs) << 32); } } }
#undef CSCORE
    {   float mw = 0.f, lw = 0.f; bool stw = false; f32x16 o0 = {}, o1 = {};
        const int nlo = max(t0 - 511, 0) & ~31, nhi = (t0 + 7) & ~31;
        const int nlb = max(tile0 - 511, 0) & ~31, ntw = (((tile0 + 63) & ~31) - nlb) / 32 + 1;
        STAGE_PROLOGUE(P.KW, S - 1, P.VTW, 511, nlb, ntw)
#define WSTEP(iv, BUF, RL, RW) { const int i = (iv); if (i >= ntw) break; const int n0 = nlb + 32 * i; RL = STAGE_LOAD(P.KW, S - 1, P.VTW, 511, nlb + 32 * min(i + 2, ntw - 1)); \
            if (n0 >= nlo && n0 <= nhi) { const bool mid = (n0 >= t0 - 504) && (n0 <= t0 - 144); \
                f32x16 a; { const float ini_ = (mid ? cb : 0.f) - mw; _Pragma("unroll") for (int r = 0; r < 16; ++r) a[r] = ini_; } \
                _Pragma("unroll") for (int ks = 0; ks < 4; ++ks) a = MFMA32(KFRAG(BUF, ks), bq[ks], a); \
                if (!mid) { _Pragma("unroll") for (int r = 0; r < 16; ++r) { const int dist = t - (n0 + crow(r, hi)); const float bt = BT[h * 128 + min(max(dist, 0), 127)]; a[r] = (dist >= 0 && dist < 512) ? a[r] + bt : -1e30f; } } \
                float d_, fs_; REF_EVENT(a, mw, stw, d_, fs_) if (fs_ != 1.f || d_ != 0.f) { lw *= fs_; o0 = o0 * fs_; o1 = o1 * fs_; } \
                _Pragma("unroll") for (int r = 0; r < 16; ++r) a[r] = __builtin_amdgcn_exp2f(a[r]); \
                lw += xsum32(sum16(a)); PVACC(o0, o1, BUF, a); } \
            STAGE_WRITE(RW, (BUF) ^ 1); __syncthreads(); }
        for (int ib = 0; ; ib += 2) { WSTEP(ib, 0, RA, RB) WSTEP(ib + 1, 1, RB, RA) }
#undef WSTEP
        const float sc = g2 / fmaxf(lw, 1e-30f);
        LAS unsigned char* park = lds + AT_PARK + (((8 * wave + ti) * 4 + hr) * 64) * 2;
#pragma unroll
        for (int d0 = 0; d0 < 2; ++d0)
#pragma unroll
            for (int r4 = 0; r4 < 4; ++r4) { const f32x16& Od = d0 ? o1 : o0; const int dim = 32 * d0 + 8 * r4 + 4 * hi; const unsigned long long w = *(const LAS unsigned long long*)(park + dim * 2); const unsigned lo = (unsigned)w, hw = (unsigned)(w >> 32);
                *(LAS unsigned long long*)(park + dim * 2) = (unsigned long long)cvt_pk_bf16(bflo(lo) + Od[4 * r4] * sc, bfhi(lo) + Od[4 * r4 + 1] * sc) | ((unsigned long long)cvt_pk_bf16(bflo(hw) + Od[4 * r4 + 2] * sc, bfhi(hw) + Od[4 * r4 + 3] * sc) << 32); } }
#undef REF_EVENT
#undef STAGE_PROLOGUE
#undef PVACC
#undef KFRAG
#undef VFRAG
#undef STAGE_LOAD
#undef STAGE_WRITE
    LDS_WAIT();
    {   const int cur = tile0 >> 6, i = lane >> 3, s8 = lane & 7;
        if (cur + 1 <= 16) { for (int e = lane; e < 8 * 16; e += 64) sel[e] = e & 15; }
        else {
            float sv[32];
#pragma unroll
            for (int k = 0; k < 32; ++k) { const int j = s8 + 8 * k; sv[k] = (j >= 1 && j <= cur - 2) ? scores[i * SCS + j] : -3e38f; }
            if (s8 == 0) { sel[i * 16 + 0] = 0; sel[i * 16 + 1] = cur - 1; sel[i * 16 + 2] = cur; }
            for (int it = 3; it < 16; ++it) {
                float bv = sv[0]; int bj = s8;
#pragma unroll
                for (int k = 1; k < 32; ++k) if (sv[k] > bv) { bv = sv[k]; bj = s8 + 8 * k; }
#define SEL_STEP(ctrl) { const float ov = __int_as_float(DPPI(__float_as_int(bv), ctrl)); const int oj = DPPI(bj, ctrl); if (ov > bv || (ov == bv && oj < bj)) { bv = ov; bj = oj; } }
                SEL_STEP(0xB1) SEL_STEP(0x4E) SEL_STEP(0x141)
#undef SEL_STEP
                if (s8 == 0) sel[i * 16 + it] = bj;
#pragma unroll
                for (int k = 0; k < 32; ++k) if (bj == s8 + 8 * k) sv[k] = -3e38f;
            }
        }
    }
}

__device__ __forceinline__ void s_scores(const bf16x8 (&kf)[8], const bf16x8 q0, const bf16x8 q1, bool cst, float cbs, const LAS float* BT, int hs, int tt, int j, int q, f32x4 (&sa)[4]) {
#pragma unroll
    for (int mt = 0; mt < 4; ++mt) { const float ini = cst ? cbs : 0.f; sa[mt] = (f32x4){ini, ini, ini, ini}; sa[mt] = MFMA16(kf[mt * 2], q0, sa[mt]); sa[mt] = MFMA16(kf[mt * 2 + 1], q1, sa[mt]); }
    if (!cst) {
#pragma unroll
        for (int mt = 0; mt < 4; ++mt)
#pragma unroll
            for (int r = 0; r < 4; ++r) { const int dist = tt - (64 * j + 16 * mt + 4 * q + r); const float bt = BT[hs * 128 + min(max(dist, 0), 127)]; sa[mt][r] = dist >= 0 ? sa[mt][r] + bt : -1e30f; } }
}
template <bool MASKED> __device__ __forceinline__ void s_softmax(f32x4 (&sa)[4], float& tm, float& ls) {
    tm = sa[0][0];
#pragma unroll
    for (int mt = 0; mt < 4; ++mt)
#pragma unroll
        for (int r = 0; r < 4; ++r) tm = fmaxf(tm, sa[mt][r]);
    tm = xmax32(xmax16(tm)); ls = 0.f;
#pragma unroll
    for (int mt = 0; mt < 4; ++mt)
#pragma unroll
        for (int r = 0; r < 4; ++r) { const float e = __builtin_amdgcn_exp2f(sa[mt][r] - tm); sa[mt][r] = (!MASKED || sa[mt][r] > -1e29f) ? e : 0.f; ls += sa[mt][r]; }
    ls = xsum32(xsum16(ls));
}
__device__ __forceinline__ void load_kf(const AttnPtrs& P, int lane, int j, bf16x8 (&kf)[8]) {
    const bf16* kp = P.KS + (size_t)(64 * j + (lane & 15)) * 64 + 8 * (lane >> 4);
#pragma unroll
    for (int mt = 0; mt < 4; ++mt) { kf[mt * 2] = *(const bf16x8*)(kp + (size_t)mt * 16 * 64); kf[mt * 2 + 1] = *(const bf16x8*)(kp + (size_t)mt * 16 * 64 + 32); }
}
__device__ __forceinline__ void load_vf(const AttnPtrs& P, int lane, int j, bf16x8 (&vf)[8]) {
    const bf16x8* vt = P.VTS + (size_t)j * 8 * 64 + lane;
#pragma unroll
    for (int e = 0; e < 8; ++e) vf[e] = vt[e * 64];
}
__device__ __forceinline__ void attn_stageB(const AttnPtrs& P, int lane, int wave, int tile0, int g, LAS unsigned char* lds, unsigned char* slab) {
    const int T = tile0 >> 6, c = lane & 15, q = lane >> 4, hd = c & 3, hs = g * 4 + hd;
    if (T <= 15) return;
    const LAS unsigned* cnt = (const LAS unsigned*)(lds + AT_CNT); const LAS unsigned short* list = (const LAS unsigned short*)(lds + AT_LIST); const LAS float* BT = (const LAS float*)(lds + AT_BT);
    const float cbs = BT[hs * 128 + 127];
#define NEXT_BLK(jv, nv) do { nv = 0; for (jv += 8; jv <= T - 2; jv += 8) { nv = (int)__builtin_amdgcn_readfirstlane((int)cnt[jv]); if (nv > 0) break; } } while (0)
    int jc = 1 + wave - 8, nc = 0; NEXT_BLK(jc, nc); if (jc > T - 2) return;
    int jn = jc, nn = 0; NEXT_BLK(jn, nn);
    bf16x8 kf[8], vf[8], kn[8];
    load_kf(P, lane, jc, kf); load_vf(P, lane, jc, vf);
    load_kf(P, lane, min(jn, T - 2), kn);
    int ch = 0;
    int sl; bool valid; bf16x8 q0, q1;
    { const int sidx = (c >> 2); valid = sidx < nc; sl = (int)list[jc * 64 + (valid ? sidx : 0)]; const int tt = tile0 + sl / 13;
      q0 = *(const bf16x8*)(P.Q + (size_t)tt * 512 + hs * 64 + 8 * q); q1 = *(const bf16x8*)(P.Q + (size_t)tt * 512 + hs * 64 + 32 + 8 * q); }
#pragma unroll 1
    for (;;) {
        const bool same = (ch + 1) * 4 < nc; const bool more = same || (jn <= T - 2);
        const int jx = same ? jc : min(jn, T - 2), chx = same ? ch + 1 : 0, nx = same ? nc : nn;
        int sln; bool validn; bf16x8 q0n, q1n;
        { const int sidx = 4 * chx + (c >> 2); validn = sidx < nx; sln = (int)list[jx * 64 + (validn ? sidx : 0)]; const int tt = tile0 + sln / 13;
          q0n = *(const bf16x8*)(P.Q + (size_t)tt * 512 + hs * 64 + 8 * q); q1n = *(const bf16x8*)(P.Q + (size_t)tt * 512 + hs * 64 + 32 + 8 * q); }
        {   const int tt = tile0 + sl / 13; const bool cst = (jc <= T - 3);
            f32x4 sa[4]; s_scores(kf, q0, q1, cst, cbs, BT, hs, tt, jc, q, sa);
            float tm, ls; s_softmax<false>(sa, tm, ls);
            const bf16x8 p0 = pack8(sa[0][0], sa[0][1], sa[0][2], sa[0][3], sa[1][0], sa[1][1], sa[1][2], sa[1][3]), p1 = pack8(sa[2][0], sa[2][1], sa[2][2], sa[2][3], sa[3][0], sa[3][1], sa[3][2], sa[3][3]);
            unsigned char* po = slab + ((size_t)(sl * 4 + hd) * 64 + 16 * q) * 2;
            unsigned pw[8];
#pragma unroll
            for (int dt = 0; dt < 4; ++dt) { f32x4 oa = {0.f, 0.f, 0.f, 0.f}; oa = MFMA16(vf[dt * 2], p0, oa); oa = MFMA16(vf[dt * 2 + 1], p1, oa); pw[2 * dt] = cvt_pk_bf16(oa[0], oa[1]); pw[2 * dt + 1] = cvt_pk_bf16(oa[2], oa[3]); }
            if (valid) { *(v4u*)po = (v4u){pw[0], pw[1], pw[2], pw[3]}; *(v4u*)(po + 16) = (v4u){pw[4], pw[5], pw[6], pw[7]}; }
            if (valid && q == 0) *(f32x2*)(slab + PML_OFF + (size_t)(sl * 4 + hd) * 8) = (f32x2){tm, ls}; }
        if (!more) break;
        if (!same) {
#pragma unroll
            for (int e = 0; e < 8; ++e) kf[e] = kn[e];
            jc = jn; nc = nn; load_vf(P, lane, jc, vf); NEXT_BLK(jn, nn);
            load_kf(P, lane, min(jn, T - 2), kn); }
        ch = chx; sl = sln; valid = validn; q0 = q0n; q1 = q1n;
    }
#undef NEXT_BLK
}
struct SState { float M, L; f32x4 O[4]; };
__device__ __forceinline__ void s_merge(SState& st, float m, float l, const f32x4 (&o)[4]) {
    const float mn = fmaxf(st.M, m), a0 = __builtin_amdgcn_exp2f(st.M - mn), a1 = __builtin_amdgcn_exp2f(m - mn);
    st.L = st.L * a0 + l * a1; st.M = mn;
#pragma unroll
    for (int dt = 0; dt < 4; ++dt) st.O[dt] = st.O[dt] * a0 + o[dt] * a1;
}
__device__ __forceinline__ void attn_stageC_forced(const AttnPtrs& P, int lane, int wave, int tile0, int g, LAS unsigned char* lds, SState (&st)[2]) {
    const int T = tile0 >> 6, c = lane & 15, q = lane >> 4, hd = c & 3, hs = g * 4 + hd; const LAS float* BT = (const LAS float*)(lds + AT_BT); const float cbs = BT[hs * 128 + 127];
    bf16x8 q0[2], q1[2];
#pragma unroll
    for (int k = 0; k < 2; ++k) { const int tt = tile0 + 8 * wave + 4 * k + (c >> 2); q0[k] = *(const bf16x8*)(P.Q + (size_t)tt * 512 + hs * 64 + 8 * q); q1[k] = *(const bf16x8*)(P.Q + (size_t)tt * 512 + hs * 64 + 32 + 8 * q);
        st[k].M = -1e30f; st[k].L = 0.f;
#pragma unroll
        for (int dt = 0; dt < 4; ++dt) st[k].O[dt] = (f32x4){0.f, 0.f, 0.f, 0.f}; }
    const int nf = T <= 15 ? T + 1 : 3;
    auto fblk = [&](int it) -> int { return T <= 15 ? it : (it == 0 ? 0 : (it == 1 ? T - 1 : T)); };
    bf16x8 kf[8], vf[8]; load_kf(P, lane, fblk(0), kf); load_vf(P, lane, fblk(0), vf);
#pragma unroll 1
    for (int it = 0; it < nf; ++it) { const int j = fblk(it);
        bf16x8 kn[8]; load_kf(P, lane, fblk(min(it + 1, nf - 1)), kn);
        const bool cst = (j <= T - 3);
#pragma unroll
        for (int k = 0; k < 2; ++k) { const int tt = tile0 + 8 * wave + 4 * k + (c >> 2);
            f32x4 sa[4]; s_scores(kf, q0[k], q1[k], cst, cbs, BT, hs, tt, j, q, sa);
            float tm, ls; s_softmax<true>(sa, tm, ls);
            const bf16x8 p0 = pack8(sa[0][0], sa[0][1], sa[0][2], sa[0][3], sa[1][0], sa[1][1], sa[1][2], sa[1][3]), p1 = pack8(sa[2][0], sa[2][1], sa[2][2], sa[2][3], sa[3][0], sa[3][1], sa[3][2], sa[3][3]);
            f32x4 ob[4];
#pragma unroll
            for (int dt = 0; dt < 4; ++dt) { ob[dt] = (f32x4){0.f, 0.f, 0.f, 0.f}; ob[dt] = MFMA16(vf[dt * 2], p0, ob[dt]); ob[dt] = MFMA16(vf[dt * 2 + 1], p1, ob[dt]); }
            s_merge(st[k], tm, ls, ob); }
#pragma unroll
        for (int e = 0; e < 8; ++e) kf[e] = kn[e];
        if (it + 1 < nf) load_vf(P, lane, fblk(it + 1), vf);
    }
}
__device__ __forceinline__ void attn_stageC_merge(const AttnPtrs& P, int lane, int wave, int tile0, int g, LAS unsigned char* lds, const unsigned char* slab, SState (&st)[2]) {
    const int T = tile0 >> 6, c = lane & 15, q = lane >> 4, hd = c & 3, hs = g * 4 + hd;
#pragma unroll
    for (int k = 0; k < 2; ++k) { const int tok = 8 * wave + 4 * k + (c >> 2), tt = tile0 + tok;
        if (T > 15) {
#pragma unroll
            for (int b0 = 0; b0 < 13; b0 += 7) {
                f32x2 mlv[7]; v4u ow[7][2];
#pragma unroll
                for (int bb = 0; bb < 7; ++bb) if (b0 + bb < 13) { const int sl = tok * 13 + b0 + bb;
                    mlv[bb] = *(const f32x2*)(slab + PML_OFF + (size_t)(sl * 4 + hd) * 8);
                    const unsigned char* po = slab + ((size_t)(sl * 4 + hd) * 64 + 16 * q) * 2; ow[bb][0] = *(const v4u*)po; ow[bb][1] = *(const v4u*)(po + 16); }
#pragma unroll
                for (int bb = 0; bb < 7; ++bb) if (b0 + bb < 13) { f32x4 ob[4];
                    ob[0] = (f32x4){bflo(ow[bb][0].x), bfhi(ow[bb][0].x), bflo(ow[bb][0].y), bfhi(ow[bb][0].y)}; ob[1] = (f32x4){bflo(ow[bb][0].z), bfhi(ow[bb][0].z), bflo(ow[bb][0].w), bfhi(ow[bb][0].w)};
                    ob[2] = (f32x4){bflo(ow[bb][1].x), bfhi(ow[bb][1].x), bflo(ow[bb][1].y), bfhi(ow[bb][1].y)}; ob[3] = (f32x4){bflo(ow[bb][1].z), bfhi(ow[bb][1].z), bflo(ow[bb][1].w), bfhi(ow[bb][1].w)};
                    s_merge(st[k], mlv[bb].x, mlv[bb].y, ob); } } }
        const float g1 = bf2f(P.GN[(size_t)tt * 32 + hs * 3 + 1]) / fmaxf(st[k].L, 1e-30f);
        const LAS unsigned char* park = lds + AT_PARK + ((tok * 4 + hd) * 64 + 4 * q) * 2;
#pragma unroll
        for (int dt = 0; dt < 4; ++dt) { const unsigned long long w = *(const LAS unsigned long long*)(park + dt * 32); const unsigned lo = (unsigned)w, hw = (unsigned)(w >> 32);
            const unsigned o0 = cvt_pk_bf16(bflo(lo) + g1 * st[k].O[dt][0], bfhi(lo) + g1 * st[k].O[dt][1]), o1 = cvt_pk_bf16(bflo(hw) + g1 * st[k].O[dt][2], bfhi(hw) + g1 * st[k].O[dt][3]);
            *(unsigned long long*)(P.O + (size_t)tt * 512 + hs * 64 + 16 * dt + 4 * q) = (unsigned long long)o0 | ((unsigned long long)o1 << 32); } }
}
__device__ __forceinline__ void attn_tile(const Frame& F, unsigned char* ws, int tile, int g, unsigned soff) {
    int lane = F.lane; asm volatile("" : "+v"(lane));
    const int wave = F.wave, tile0 = tile * 64, T = tile; LAS unsigned char* lds = F.lds;
    if (F.tid < 256) ((LAS unsigned*)(lds + AT_CNT))[F.tid] = 0u;
    AttnPtrs P;
    {   const bf16* KVH = (const bf16*)(ws + WS_KVH);
        P.Q = (const bf16*)(ws + WS_Q); P.KCB = (const bf16*)(ws + WS_KCB) + (size_t)g * 1024 * 64; P.VTC = (const bf16x8*)(ws + WS_VTC) + (size_t)g * 32 * 4 * 64;
        P.KW = KVH + (size_t)(8 + g) * S * 64; P.VTW = (const bf16x8*)(ws + WS_VTW) + (size_t)g * 512 * 4 * 64; P.GN = (const bf16*)(ws + WS_GN);
        P.KS = nullptr; P.VTS = nullptr; P.O = nullptr; }
    attn_stageA(P, lane, wave, tile0, g, lds);
    __syncthreads();
    unsigned char* ws2 = ws;
    {   const bf16* KVH = (const bf16*)(ws2 + WS_KVH);
        P.Q = (const bf16*)(ws2 + WS_Q); P.KS = KVH + (size_t)(4 + g) * S * 64; P.VTS = (const bf16x8*)(ws2 + WS_VTS) + (size_t)g * 256 * 8 * 64; P.GN = (const bf16*)(ws2 + WS_GN); P.O = (bf16*)(ws2 + WS_O);
        P.KCB = nullptr; P.VTC = nullptr; P.KW = nullptr; P.VTW = nullptr; }
    unsigned char* slab = ((blockIdx.x < 128) ? (unsigned char*)F.out : ws2 + WS_PSLAB) + soff;
    if (T > 15) {
        LAS unsigned* cnt = (LAS unsigned*)(lds + AT_CNT); LAS unsigned short* list = (LAS unsigned short*)(lds + AT_LIST); const LAS int* sel = (const LAS int*)(lds + AT_SEL);
        const int tok = F.tid >> 3;
#pragma unroll
        for (int e = 0; e < 2; ++e) { const int b = (F.tid & 7) * 2 + e;
            if (b >= 3) { const int j = sel[tok * 16 + b]; const unsigned pos = __hip_atomic_fetch_add(&cnt[j], 1u, __ATOMIC_RELAXED, __HIP_MEMORY_SCOPE_WORKGROUP); list[j * 64 + pos] = (unsigned short)(tok * 13 + b - 3); } }
        __syncthreads(); }
    attn_stageB(P, lane, wave, tile0, g, lds, slab);
    SState st[2];
    attn_stageC_forced(P, lane, wave, tile0, g, lds, st);
    asm volatile("s_waitcnt vmcnt(0)" ::: "memory");
    __syncthreads();
    __builtin_amdgcn_fence(__ATOMIC_ACQUIRE, "agent");
    attn_stageC_merge(P, lane, wave, tile0, g, lds, slab, st);
    __syncthreads();
}

#define XB_TMO      128
#define XB_XCNT(j)  (256  + 64 * (j))
#define XB_XSUB(j)  (1280 + 64 * (j))
#define XB_XGEN(j)  (2304 + 64 * (j))
#define XB_TOP      3328
#define XB_TOPGEN   3392
#define XCD_BAR_WORDS 3456
#define XB_SPIN_CAP (1u << 22)
__device__ __forceinline__ unsigned xb_ld(unsigned* p)              { return __hip_atomic_load(p, __ATOMIC_RELAXED, __HIP_MEMORY_SCOPE_AGENT); }
__device__ __forceinline__ unsigned xb_add(unsigned* p, unsigned v) { return __hip_atomic_fetch_add(p, v, __ATOMIC_RELAXED, __HIP_MEMORY_SCOPE_AGENT); }
__device__ __forceinline__ unsigned xb_xcc_id() { return (unsigned)__builtin_amdgcn_s_getreg((3 << 11) | 20) & 0xFu; }
#define XB_SPIN(cond, bar) do { unsigned _sp = 0; while (cond) { __builtin_amdgcn_s_sleep(1); \
    if ((++_sp & 255u) == 0u) { if (xb_ld(&(bar)[XB_TMO])) break; if (_sp > XB_SPIN_CAP) { atomicAdd(&(bar)[XB_TMO], 1u); break; } } } } while (0)
struct XcdBarrier { unsigned* bar; unsigned x; volatile LAS unsigned* st; };
__device__ __forceinline__ XcdBarrier xcd_barrier_post(unsigned* bar, volatile LAS unsigned* st) {
    XcdBarrier b; b.bar = bar; b.x = xb_xcc_id(); b.st = st;
    if (threadIdx.x == 0) (void)xb_add(&bar[XB_XCNT(b.x)], 1u);
    return b;
}
__device__ __forceinline__ void xcd_barrier_complete(unsigned* bar, unsigned x, unsigned& nloc, unsigned& nx) {
    const unsigned G = gridDim.x * gridDim.y * gridDim.z;
    unsigned sum, cnt, mine, sp = 0u;
    for (;;) {
        sum = 0u; cnt = 0u; mine = 0u;
#pragma unroll
        for (unsigned j = 0; j < 16; ++j) { const unsigned c = xb_ld(&bar[XB_XCNT(j)]); sum += c; cnt += (c > 0u) ? 1u : 0u; mine = (j == x) ? c : mine; }
        if (sum == G) break;
        __builtin_amdgcn_s_sleep(1);
        if ((++sp & 255u) == 0u) { if (xb_ld(&bar[XB_TMO])) break; if (sp > XB_SPIN_CAP) { atomicAdd(&bar[XB_TMO], 1u); break; } }
    }
    nloc = mine > 0u ? mine : 1u; nx = cnt > 0u ? cnt : 1u;
}
__device__ __forceinline__ void xcd_barrier(const XcdBarrier& b) {
    asm volatile("s_waitcnt vmcnt(0)" ::: "memory");
    __syncthreads();
    if (threadIdx.x == 0) {
        unsigned* bar = b.bar;
        __builtin_amdgcn_s_waitcnt(0);
        unsigned nloc = b.st[0], nx = b.st[1];
        if (nloc == 0u) { xcd_barrier_complete(bar, b.x, nloc, nx); b.st[0] = nloc; b.st[1] = nx; }
        const unsigned old = xb_add(&bar[XB_XSUB(b.x)], 1u);
        const unsigned gen = old / nloc;
        if (old + 1u == (gen + 1u) * nloc) {
            __builtin_amdgcn_fence(__ATOMIC_RELEASE, "agent");
            asm volatile("s_waitcnt vmcnt(0)" ::: "memory");
            const unsigned og = xb_add(&bar[XB_TOP], 1u);
            const unsigned tg = og / nx;
            if (og + 1u == (tg + 1u) * nx) xb_add(&bar[XB_TOPGEN], 1u);
            else XB_SPIN(xb_ld(&bar[XB_TOPGEN]) == tg, bar);
            __builtin_amdgcn_fence(__ATOMIC_ACQUIRE, "agent");
            xb_add(&bar[XB_XGEN(b.x)], 1u);
            asm volatile("s_waitcnt vmcnt(0)" ::: "memory");
        } else {
            XB_SPIN(xb_ld(&bar[XB_XGEN(b.x)]) == gen, bar);
            __builtin_amdgcn_fence(__ATOMIC_ACQUIRE, "agent");
            asm volatile("s_waitcnt vmcnt(0)" ::: "memory");
        }
    }
    __syncthreads();
}

__global__ void __launch_bounds__(NWAVES * 64, 2) mk_fwd(Args args) {
    extern __shared__ __attribute__((aligned(16))) unsigned char lds_raw[];
    Frame F;
    F.lds = (LAS unsigned char*)lds_raw;
#define REFRESH() do { int t_ = threadIdx.x; asm volatile("" : "+v"(t_)); F.tid = t_; F.lane = t_ & 63; F.wave = __builtin_amdgcn_readfirstlane(t_ >> 6); F.gw = blockIdx.x * NWAVES + F.wave; } while (0)
    F.G = gridDim.x; F.ngw = F.G * NWAVES; REFRESH();
    F.out = args.out; F.ws = args.ws;
    const int lo = args.ph_lo, hi = args.ph_hi;
#define IN(k) (lo <= (k) && (k) < hi)
#ifndef USE_CG_SYNC
#define USE_CG_SYNC 0
#endif
    volatile LAS unsigned* bst = (volatile LAS unsigned*)(F.lds + LDS_BYTES - 64);
    if (F.tid < 16) bst[F.tid] = 0u;
    __syncthreads();
    XcdBarrier gbar; gbar.bar = (unsigned*)(F.ws + WS_CTL); gbar.x = 0; gbar.st = bst;
    if (!USE_CG_SYNC && hi - lo > 1) gbar = xcd_barrier_post((unsigned*)(F.ws + WS_CTL), bst);
#define SEAM(k) do { if (IN(k) && IN((k) + 1)) { if (USE_CG_SYNC) cg::this_grid().sync(); else xcd_barrier(gbar); } } while (0)
    unsigned char* ws = F.ws;
    if (IN(0)) { REFRESH(); p0_prologue(F, args); }
    SEAM(0);
    if (IN(1)) { REFRESH();
        pg8::Gemm g{(const bf16*)(ws + WS_XN), (const bf16*)(ws + WS_WIN), S, NPJ, 1024, 1024}; pg8::StaticOrder So; So.init(S, NPJ, F.G, (int)blockIdx.x);
        EpiProj E{(bf16*)(ws + WS_U), (bf16*)(ws + WS_Q), (bf16*)(ws + WS_KVH), (bf16*)(ws + WS_G), (bf16*)(ws + WS_GN)};
        pg8::gemm_phase<EpiProj, pg8::StaticOrder>(F.lds, g, So, E);
    }
    SEAM(1);
    if (IN(2)) { REFRESH();
        for (int u = F.gw; u < 64 * 32; u += F.ngw) s5_unit<false>(F, args, u >> 5, u & 31, F.lds + F.wave * 16384, F.lds + 131072 + F.wave * 2048);
        __syncthreads();
        pg8::Gemm g{(const bf16*)(ws + WS_KVH), (const bf16*)(ws + WS_WC1), 4096, 1024, 1024 / CMP_KS, 1024}; pg8::CmpOrder So{F.G, (int)blockIdx.x, CMP_KS};
        EpiCmp E{F.out};
        pg8::gemm_phase<EpiCmp, pg8::CmpOrder>(F.lds, g, So, E);
    }
    SEAM(2);
    if (IN(3)) { REFRESH();
        for (int u = F.gw; u < 64 * 32; u += F.ngw) s5_unit<true>(F, args, u >> 5, u & 31, F.lds + F.wave * 16384, F.lds + 131072 + F.wave * 2048);
        for (int u0 = 0; u0 < 4 * 1024; u0 += F.ngw) { const int u = u0 + F.gw; const int kvb = (u0 + (int)blockIdx.x * NWAVES) >> 11;
            __syncthreads();
            { const float* w2 = kvb ? args.in[18] : args.in[16]; LAS f32x4* wd = (LAS f32x4*)(F.lds + 8 * 2048); for (int e = F.tid; e < 256 * 64 / 4; e += NWAVES * 64) wd[e] = ((const f32x4*)w2)[e]; }
            __syncthreads();
            if (u < 4 * 1024) { const int kvg = u >> 10, n = u & 1023; cmp_l2_unit(F, args, kvg >> 1, kvg & 1, n, (LAS float*)(F.lds + F.wave * 2048), (const LAS float*)(F.lds + 8 * 2048)); } }
        __syncthreads();
        for (int u = F.gw; u < 2 * 512; u += F.ngw) vtw_item(F, u >> 9, u & 511);
        for (int u = F.gw; u < 2 * 256; u += F.ngw) vts_item(F, u >> 8, u & 255);
    }
    SEAM(3);
    if (IN(4)) { REFRESH();
        LAS float* BT = (LAS float*)(F.lds + AT_BT);
        for (int i = F.tid; i < 8 * 128; i += NWAVES * 64) { const int h = i >> 7, d = i & 127;
            int bk = d; if (d >= 16) { bk = 16 + (int)(logf((float)d * (1.0f / 16.0f)) / 2.0794415416798357f * 16.0f); if (bk > 31) bk = 31; }
            BT[i] = args.in[19][bk * 8 + h] * 1.4426950408889634f; }
        __syncthreads();
        for (int u = blockIdx.x; u < 256; u += F.G) {
#pragma unroll 1
            for (int g = 0; g < 2; ++g) { const int ta = ((u & 7) << 5) | (u >> 3);
                const int tile = g ? 255 - ta : ta;
                const unsigned soff = (unsigned)__builtin_amdgcn_readfirstlane((int)((blockIdx.x & 127u) * (unsigned)PSLAB));
                attn_tile(F, ws, tile, g, soff); } }
    }
    SEAM(4);
    if (IN(5)) { REFRESH();
        pg8::Gemm g{(const bf16*)(ws + WS_Z), (const bf16*)(ws + WS_WGLU), S, 512, 512, 512}; pg8::StaticOrder So; So.init(S, 512, F.G, (int)blockIdx.x);
        EpiGlu E{(const bf16*)(ws + WS_Z), (bf16*)(ws + WS_ZG)};
        pg8::gemm_phase<EpiGlu, pg8::StaticOrder>(F.lds, g, So, E);
    }
    SEAM(5);
    if (IN(6)) { REFRESH();
        pg8::TwoSegOrder So; So.init(S, 1024, F.G, (int)blockIdx.x);
        pg8::Gemm g{(const bf16*)(ws + WS_ZG), (const bf16*)(ws + WS_WA), S, 1024, 512, 512, (const bf16*)(ws + WS_O), (const bf16*)(ws + WS_WB)}; EpiMix2 E{(const bf16*)(ws + WS_G), (bf16*)(ws + WS_MIX)};
        pg8::gemm_phase<EpiMix2, pg8::TwoSegOrder>(F.lds, g, So, E);
    }
    SEAM(6);
    if (IN(7)) { REFRESH();
        pg8::Gemm g{(const bf16*)(ws + WS_MIX), (const bf16*)(ws + WS_WOUT), S, 1024, 1024, 1024}; pg8::StaticOrder So; So.init(S, 1024, F.G, (int)blockIdx.x);
        EpiResNorm E{args.in[0], F.out, (bf16*)(ws + WS_XN), (float*)(ws + WS_SSP), (LAS float*)(F.lds + pg8::STAGE_BYTES)};
        pg8::gemm_phase<EpiResNorm, pg8::StaticOrder>(F.lds, g, So, E);
    }
    SEAM(7);
    if (IN(9)) { REFRESH();
        pg8::Gemm g{(const bf16*)(ws + WS_XN), (const bf16*)(ws + WS_WGU), S, 2 * DFF, 1024, 1024}; pg8::StaticOrder So; So.init(S, 2 * DFF, F.G, (int)blockIdx.x);
        EpiFfn E{(bf16*)(ws + WS_H), (const float*)(ws + WS_SSP)};
        pg8::gemm_phase<EpiFfn, pg8::StaticOrder>(F.lds, g, So, E);
    }
    SEAM(9);
    if (IN(10)) { REFRESH();
        pg8::Gemm g{(const bf16*)(ws + WS_H), (const bf16*)(ws + WS_WD), S, 1024, DFF, DFF}; pg8::StaticOrder So; So.init(S, 1024, F.G, (int)blockIdx.x);
        EpiRes E{F.out, F.out};
        pg8::gemm_phase<EpiRes, pg8::StaticOrder>(F.lds, g, So, E);
    }
    SEAM(10);
    if (IN(11)) { REFRESH(); for (int m = F.gw; m < S; m += F.ngw) rms_row_f32(F.out + (size_t)m * DM, args.in[26], F.lane); }
#undef IN
#undef SEAM
}

extern "C" void kernel_launch(void* const* d_in, const int* in_sizes, int n_in, void* d_out, int out_size, void* d_ws, size_t ws_size, hipStream_t stream) {
    static int grid = 0;
    if (grid == 0) {
        if (n_in != 27 || out_size != S * DM || ws_size < WS_END) { fprintf(stderr, "kernel_launch: unexpected shapes (n_in %d out %d ws %zu)\n", n_in, out_size, ws_size); grid = -1; return; }
        int dev = 0, cus = 0, per_cu = 0;
        if (hipGetDevice(&dev) != hipSuccess || hipDeviceGetAttribute(&cus, hipDeviceAttributeMultiprocessorCount, dev) != hipSuccess) { grid = -1; return; }
        if (hipFuncSetAttribute((const void*)mk_fwd, hipFuncAttributeMaxDynamicSharedMemorySize, LDS_BYTES) != hipSuccess) { fprintf(stderr, "kernel_launch: hipFuncSetAttribute failed\n"); grid = -1; return; }
        if (hipOccupancyMaxActiveBlocksPerMultiprocessor(&per_cu, (const void*)mk_fwd, NWAVES * 64, LDS_BYTES) != hipSuccess || per_cu < 1) { fprintf(stderr, "kernel_launch: occupancy query says %d\n", per_cu); per_cu = 1; }
        (void)hipGetLastError();
        grid = cus * (per_cu < 1 ? 1 : 1);
    }
    if (grid < 0) return;
    if (hipMemsetAsync((char*)d_ws + WS_CTL, 0, 16384, stream) != hipSuccess) { fprintf(stderr, "kernel_launch: hipMemsetAsync failed\n"); return; }
    Args a{};
    for (int i = 0; i < 27; ++i) a.in[i] = (const float*)d_in[i];
    a.out = (float*)d_out; a.ws = (unsigned char*)d_ws;
    if (MK_N_LAUNCHES == 1) {
        a.ph_lo = 0; a.ph_hi = NPH;
        void* kargs[] = {&a};
        hipError_t e = hipLaunchCooperativeKernel((const void*)mk_fwd, dim3(grid), dim3(NWAVES * 64), kargs, LDS_BYTES, stream);
        if (e != hipSuccess) fprintf(stderr, "kernel_launch: cooperative launch failed: %s (grid %d)\n", hipGetErrorString(e), grid);
    } else {
        for (int ph = 0; ph < NPH; ++ph) { a.ph_lo = ph; a.ph_hi = ph + 1; hipLaunchKernelGGL(mk_fwd, dim3(grid), dim3(NWAVES * 64), LDS_BYTES, stream, a); }
    }
}
```

```cpp
#include <hip/hip_runtime.h>
#include <hip/hip_cooperative_groups.h>
#include <cstdio>
#include <cstdint>
namespace cg = cooperative_groups;

#ifndef MK_N_LAUNCHES
#define MK_N_LAUNCHES 1
#endif

namespace pg8 {
#define PG8_LAS __attribute__((address_space(3)))
typedef unsigned short bf16_t;
typedef short bf16x8 __attribute__((ext_vector_type(8)));
typedef float f32x4 __attribute__((ext_vector_type(4)));
typedef unsigned u32x4 __attribute__((ext_vector_type(4)));
constexpr int BM = 256, BK = 64, HALF = 128, HTB = HALF * BK * 2, STAGE_BYTES = 8 * HTB, NXCD = 8, WGM = 8;

__host__ __device__ __forceinline__ int lds_byte(int r, int c) { const int st = (r >> 4) * 2 + (c >> 5), rr = r & 15, cc = c & 31, ob = rr * 64 + cc * 2; return st * 1024 + (ob ^ (((ob >> 9) & 1) << 5)); }
__host__ __device__ __forceinline__ void stage_rc(int b, int& R, int& C) { const int st = b / 1024, sb = b % 1024, swz = sb ^ (((sb >> 9) & 1) << 5); R = (st >> 1) * 16 + swz / 64; C = (st & 1) * 32 + (swz % 64) / 2; }
__host__ __device__ __forceinline__ int perm32(int rho) { const int n = rho >> 4, i = rho & 15; return 8 * (i >> 2) + 4 * n + (i & 3); }

struct Unit { int pm, pn, ks, seg; };
struct Gemm { const bf16_t* A; const bf16_t* Bt; int M, N, K, ld; const bf16_t* A2; const bf16_t* Bt2; };

struct StaticOrder {
    static constexpr bool SINGLE = false;
    int nM, nN, nwg, G, c;
    __host__ __device__ void init(int M, int N, int G_, int c_) { nM = M / BM; nN = N / BM; nwg = nM * nN; G = G_; c = c_; }
    __host__ __device__ bool next(int i, Unit& u) const {
        const long L = (long)i * G + c; if (L >= nwg) return false;
        int wgid = (int)L; { const int q = nwg / NXCD, r = nwg % NXCD, xcd = wgid % NXCD, off = wgid / NXCD; wgid = (xcd < r ? xcd * (q + 1) : r * (q + 1) + (xcd - r) * q) + off; }
        const int nig = WGM * nN, gid = wgid / nig, fm = gid * WGM, gsz = (nM - fm) < WGM ? (nM - fm) : WGM;
        u.pm = fm + ((wgid % nig) % gsz); u.pn = (wgid % nig) / gsz; u.ks = 0; u.seg = 0; return true;
    }
};
struct TwoSegOrder : StaticOrder {
    __host__ __device__ bool next(int i, Unit& u) const { if (!StaticOrder::next(i >> 1, u)) return false; u.seg = i & 1; return true; }
};
struct CmpOrder {
    static constexpr bool SINGLE = true;
    int G, c, KS;
    __host__ __device__ bool next(int i, Unit& u) const {
        const int L = i * G + c; if (L >= 32 * KS) return false;
        const int tile = L / KS; u.ks = L % KS; u.pm = tile >> 1; u.pn = (tile & 1) + (u.pm >= 8 ? 2 : 0); u.seg = 0; return true;
    }
};

typedef float f32x2_t __attribute__((ext_vector_type(2))); typedef __bf16 bf16x2_t __attribute__((ext_vector_type(2)));
__device__ __forceinline__ unsigned cvt_pk_bf16(float lo, float hi) { f32x2_t v = {lo, hi}; bf16x2_t b = __builtin_convertvector(v, bf16x2_t); return __builtin_bit_cast(unsigned, b); }
__device__ __forceinline__ float bflo(unsigned w) { return __uint_as_float(w << 16); }
__device__ __forceinline__ float bfhi(unsigned w) { return __uint_as_float(w & 0xffff0000u); }
__device__ __forceinline__ float sigm(float x) { return __builtin_amdgcn_rcpf(1.0f + __expf(-x)); }

template <class Epi, class Sched>
__device__ __forceinline__ void gemm_phase(PG8_LAS unsigned char* lds, const Gemm g, const Sched& S, const Epi& E) {
    const int tid = threadIdx.x, wid = __builtin_amdgcn_readfirstlane(tid >> 6), lane = tid & 63, wr = wid >> 2, wc = wid & 3, fr = lane & 15, fq = lane >> 4;
    const int K = g.K, ld = g.ld, nt = K / BK;
    unsigned voffA[2], voffB[2];
#pragma unroll
    for (int i = 0; i < 2; ++i) { int R, C; stage_rc(tid * 16 + i * 8192, R, C); const int Rb = Epi::PERM ? ((R & ~31) + perm32(R & 31)) : R;
        voffA[i] = (unsigned)(R * ld + C) * 2u; voffB[i] = (unsigned)(Rb * ld + C) * 2u; }
    const size_t kstep = (size_t)(BK * 2);
    const size_t hstep = (size_t)HALF * ld * 2;
    const size_t tstep = 2 * hstep;
    const unsigned ldsw = (unsigned)wid * 1024u;
    const int aoff = lds_byte(wr * 64 + fr, fq * 8), boff = lds_byte(wc * 32 + fr, fq * 8);
#define PG8_SA(b, h) (((b) * 2 + (h)) * HTB)
#define PG8_SB(b, h) ((4 + (b) * 2 + (h)) * HTB)
#define PG8_STAGE(bufoff, gbase, voff) do { _Pragma("unroll") for (int _i = 0; _i < 2; ++_i) \
        __builtin_amdgcn_global_load_lds((const unsigned*)((const char*)(gbase) + (voff)[_i]), (PG8_LAS unsigned*)(lds + (bufoff) + ldsw + _i * 8192), 16, 0, 0); } while (0)
#define PG8_LDA(dst, b, h) do { _Pragma("unroll") for (int m = 0; m < 4; ++m) _Pragma("unroll") for (int k = 0; k < 2; ++k) dst[m][k] = *(const PG8_LAS bf16x8*)(lds + PG8_SA(b, h) + aoff + m * 2048 + k * 1024); } while (0)
#define PG8_LDB(dst, b, h) do { _Pragma("unroll") for (int n = 0; n < 2; ++n) _Pragma("unroll") for (int k = 0; k < 2; ++k) dst[n][k] = *(const PG8_LAS bf16x8*)(lds + PG8_SB(b, h) + boff + n * 2048 + k * 1024); } while (0)
#define PG8_MMA(ai, bj, At, Bt) do { __builtin_amdgcn_s_setprio(1); _Pragma("unroll") for (int m = 0; m < 4; ++m) _Pragma("unroll") for (int n = 0; n < 2; ++n) _Pragma("unroll") for (int k = 0; k < 2; ++k) \
        acc[ai][bj][m][n] = __builtin_amdgcn_mfma_f32_16x16x32_bf16(Bt[n][k], At[m][k], acc[ai][bj][m][n], 0, 0, 0); __builtin_amdgcn_s_setprio(0); } while (0)
#define PG8_WAIT_V(n) asm volatile("s_waitcnt vmcnt(" #n ")" ::: "memory")
#define PG8_WAIT_L(n) asm volatile("s_waitcnt lgkmcnt(" #n ")" ::: "memory")
#define PG8_BAR __builtin_amdgcn_s_barrier()
#define PG8_SCHED __builtin_amdgcn_sched_barrier(0)
    Unit cur, nxt; int ui = 0;
    if (!S.next(0, cur)) return;
    f32x4 acc[2][2][4][2];
#pragma unroll
    for (int a = 0; a < 2; ++a)
#pragma unroll
        for (int b = 0; b < 2; ++b)
#pragma unroll
            for (int m = 0; m < 4; ++m)
#pragma unroll
                for (int n = 0; n < 2; ++n) acc[a][b][m][n] = (f32x4){0.f, 0.f, 0.f, 0.f};
    bf16x8 At[4][2], B0[2][2], B1[2][2];
    const char* cA = (const char*)(cur.seg ? g.A2 : g.A) + (size_t)cur.pm * tstep + (size_t)cur.ks * K * 2; const char* cB = (const char*)(cur.seg ? g.Bt2 : g.Bt) + (size_t)cur.pn * tstep + (size_t)cur.ks * K * 2;
    PG8_STAGE(PG8_SB(0, 0), cB, voffB); PG8_STAGE(PG8_SB(0, 1), cB + hstep, voffB); PG8_STAGE(PG8_SA(0, 0), cA, voffA); PG8_STAGE(PG8_SA(0, 1), cA + hstep, voffA);
    if (wr == 1) PG8_BAR;
    PG8_WAIT_V(2); PG8_BAR;
    PG8_STAGE(PG8_SB(1, 0), cB + kstep, voffB); PG8_STAGE(PG8_SA(1, 0), cA + kstep, voffA); PG8_STAGE(PG8_SB(1, 1), cB + hstep + kstep, voffB);
    PG8_WAIT_V(6); PG8_BAR;
    for (;;) {
        const bool has_next = Sched::SINGLE ? false : S.next(ui + 1, nxt);
        const char* nA = has_next ? (const char*)(nxt.seg ? g.A2 : g.A) + (size_t)nxt.pm * tstep + (size_t)nxt.ks * K * 2 : cA; const char* nB = has_next ? (const char*)(nxt.seg ? g.Bt2 : g.Bt) + (size_t)nxt.pn * tstep + (size_t)nxt.ks * K * 2 : cB;
        for (int t = 0; t < nt; t += 2) {
            const bool last = (t == nt - 2);
            const char* a1 = cA + (size_t)(t + 1) * kstep;
            const char* a2 = last ? nA : cA + (size_t)(t + 2) * kstep; const char* b2 = last ? nB : cB + (size_t)(t + 2) * kstep;
            const char* a3 = a2 + kstep; const char* b3 = b2 + kstep;
            PG8_LDB(B0, 0, 0); PG8_LDB(B1, 0, 1); PG8_SCHED; PG8_LDA(At, 0, 0); PG8_STAGE(PG8_SA(1, 1), a1 + hstep, voffA);
            PG8_WAIT_V(8); PG8_WAIT_L(0); PG8_BAR; PG8_MMA(0, 0, At, B0); PG8_MMA(0, 1, At, B1); PG8_BAR; PG8_SCHED;
            PG8_LDA(At, 0, 1); PG8_STAGE(PG8_SB(0, 0), b2, voffB); PG8_STAGE(PG8_SB(0, 1), b2 + hstep, voffB); PG8_STAGE(PG8_SA(0, 0), a2, voffA);
            PG8_WAIT_V(8); PG8_WAIT_L(0); PG8_BAR; PG8_MMA(1, 0, At, B0); PG8_MMA(1, 1, At, B1); PG8_BAR; PG8_SCHED;
            PG8_LDB(B0, 1, 0); PG8_LDB(B1, 1, 1); PG8_SCHED; PG8_LDA(At, 1, 0); PG8_STAGE(PG8_SA(0, 1), a2 + hstep, voffA);
            PG8_WAIT_V(8); PG8_WAIT_L(0); PG8_BAR; PG8_MMA(0, 0, At, B0); PG8_MMA(0, 1, At, B1); PG8_BAR; PG8_SCHED;
            PG8_LDA(At, 1, 1); PG8_STAGE(PG8_SB(1, 0), b3, voffB); PG8_STAGE(PG8_SB(1, 1), b3 + hstep, voffB); PG8_STAGE(PG8_SA(1, 0), a3, voffA);
            PG8_WAIT_V(8); PG8_WAIT_L(0); PG8_BAR; PG8_MMA(1, 0, At, B0); PG8_MMA(1, 1, At, B1); PG8_BAR; PG8_SCHED;
        }
        if (wr == 0) PG8_BAR;
        E(acc, cur, wr, wc, fr, fq);
        if (!has_next) break;
        if (!nxt.seg) {
#pragma unroll
        for (int a = 0; a < 2; ++a)
#pragma unroll
            for (int b = 0; b < 2; ++b)
#pragma unroll
                for (int m = 0; m < 4; ++m)
#pragma unroll
                    for (int n = 0; n < 2; ++n) acc[a][b][m][n] = (f32x4){0.f, 0.f, 0.f, 0.f}; }
        cur = nxt; cA = nA; cB = nB; ++ui;
        if (wr == 1) PG8_BAR;
    }
    PG8_WAIT_V(0);
    PG8_BAR;
#undef PG8_SA
#undef PG8_SB
#undef PG8_STAGE
#undef PG8_LDA
#undef PG8_LDB
#undef PG8_MMA
#undef PG8_WAIT_V
#undef PG8_WAIT_L
#undef PG8_BAR
#undef PG8_SCHED
}
}

constexpr int S = 16384, DM = 1024, INC = 3864, NPJ = 4096, SSW = 512, NSW = 512, HD = 64, DFF = 2816;
constexpr int NGRP = 32, NST = 64, NCMP = 1023;
constexpr int NWAVES = 8;
constexpr int NPH = 12;
constexpr int CMP_KS = 4;
constexpr float EPS = 1e-6f;

constexpr size_t MiB = 1u << 20;
constexpr size_t WS_CTL = 0;
constexpr size_t WS_TAB = 1 * MiB;
constexpr size_t TAB_BF = 0, TAB_CF = 128 * 1024, TAB_LAM = 256 * 1024, TAB_LAM256 = 272 * 1024, TAB_POSB = 288 * 1024;
constexpr size_t WS_SSP = 1 * MiB + 512 * 1024;
constexpr size_t WS_F = 2 * MiB;
constexpr size_t WS_KVC = 3 * MiB;
constexpr size_t WS_WIN = 4 * MiB, WS_WGU = 12 * MiB, WS_WD = 23 * MiB, WS_WOUT = 29 * MiB, WS_WA = 31 * MiB, WS_WB = 32 * MiB, WS_WGLU = 33 * MiB, WS_WC1 = 34 * MiB;
constexpr size_t WS_XN = 36 * MiB;
constexpr size_t WS_Z = WS_XN, WS_ZG = WS_XN + 16 * MiB;
constexpr size_t WS_U = 68 * MiB, WS_O = WS_U;
constexpr size_t WS_Q = 84 * MiB;
constexpr size_t WS_KVH = 100 * MiB;
constexpr size_t WS_G = 124 * MiB;
constexpr size_t WS_GN = 188 * MiB;
constexpr size_t WS_MIX = 84 * MiB;
constexpr size_t WS_H = 100 * MiB;
constexpr size_t WS_VTW = 189 * MiB;
constexpr size_t WS_VTS = 193 * MiB;
constexpr size_t WS_KCB = 197 * MiB;
constexpr size_t WS_VTC = 197 * MiB + 512 * 1024;
constexpr size_t WS_PSLAB = 198 * MiB;
constexpr size_t WS_END = 254 * MiB;

constexpr int LDS_BYTES = 163840;

#define GAS __attribute__((address_space(1)))
#define LAS __attribute__((address_space(3)))
typedef unsigned short bf16;
typedef unsigned v4u __attribute__((ext_vector_type(4)));
typedef float f32x4 __attribute__((ext_vector_type(4)));
typedef float f32x2 __attribute__((ext_vector_type(2)));
typedef float f32x16 __attribute__((ext_vector_type(16)));
typedef short bf16x8 __attribute__((ext_vector_type(8)));
#define LDS_WAIT() asm volatile("s_waitcnt lgkmcnt(0)" ::: "memory")
#define VM_WAIT() asm volatile("s_waitcnt vmcnt(0)" ::: "memory")
__device__ __forceinline__ unsigned f2bf(float f) { unsigned u = __builtin_bit_cast(unsigned, f); return (u + 0x7fffu + ((u >> 16) & 1u)) >> 16; }
__device__ __forceinline__ unsigned pk2(float lo, float hi) { return f2bf(lo) | (f2bf(hi) << 16); }
__device__ __forceinline__ float bf2f(bf16 v) { return __uint_as_float((unsigned)v << 16); }
using pg8::bflo; using pg8::bfhi; using pg8::sigm; using pg8::cvt_pk_bf16;
__device__ __forceinline__ float gelu_tanh(float y) {
    const float a = 0.7978845608028654f * (y + 0.044715f * y * y * y);
    const float e = __expf(2.0f * a);
    const float th = 1.0f - 2.0f * __builtin_amdgcn_rcpf(e + 1.0f);
    return 0.5f * y * (1.0f + th);
}
__device__ __forceinline__ float wave_sum(float v) {
#pragma unroll
    for (int o = 1; o < 64; o <<= 1) v += __shfl_xor(v, o);
    return v;
}
__device__ __forceinline__ float wave_max(float v) {
#pragma unroll
    for (int o = 1; o < 64; o <<= 1) v = fmaxf(v, __shfl_xor(v, o));
    return v;
}

struct Args { const float* in[27]; float* out; unsigned char* ws; int ph_lo, ph_hi; };

struct Frame {
    LAS unsigned char* lds;
    int tid, lane, wave, G, gw, ngw;
    float* out; unsigned char* ws;
};

using pg8::Unit; using pg8::BM; using pg8::HALF;
struct EpiProj {
    static constexpr bool PERM = true;
    bf16 *U, *Q, *KVH, *Gt, *GN;
    __device__ __forceinline__ void operator()(const f32x4 (&acc)[2][2][4][2], const Unit& u, int wr, int wc, int fr, int fq) const {
        const int row0 = u.pm * BM + wr * 64 + fr, pn = u.pn;
#pragma unroll
        for (int ai = 0; ai < 2; ++ai)
#pragma unroll
            for (int m = 0; m < 4; ++m) { const int row = row0 + ai * HALF + m * 16;
#pragma unroll
                for (int bj = 0; bj < 2; ++bj) { f32x4 v0 = acc[ai][bj][m][0], v1 = acc[ai][bj][m][1]; const int col = bj * HALF + wc * 32 + 8 * fq; bf16* dst;
                    if (pn < 2) dst = U + (size_t)row * 512 + pn * 256 + col;
                    else if (pn < 4) { v0 = v0 * (0.125f * 1.4426950408889634f); v1 = v1 * (0.125f * 1.4426950408889634f); dst = Q + (size_t)row * 512 + (pn - 2) * 256 + col; }
                    else if (pn < 7) dst = KVH + ((size_t)((pn - 4) * 4 + (col >> 6)) * S + row) * 64 + (col & 63);
                    else { v0 = (f32x4){sigm(v0[0]), sigm(v0[1]), sigm(v0[2]), sigm(v0[3])}; v1 = (f32x4){sigm(v1[0]), sigm(v1[1]), sigm(v1[2]), sigm(v1[3])};
                        if (pn < 15) dst = Gt + (size_t)row * 2048 + (pn - 7) * 256 + col; else { if (col >= 32) continue; dst = GN + (size_t)row * 32 + col; } }
                    v4u w; w.x = cvt_pk_bf16(v0[0], v0[1]); w.y = cvt_pk_bf16(v0[2], v0[3]); w.z = cvt_pk_bf16(v1[0], v1[1]); w.w = cvt_pk_bf16(v1[2], v1[3]);
                    *(v4u*)dst = w; } }
    }
};
struct EpiCmp {
    static constexpr bool PERM = false;
    float* C;
    __device__ __forceinline__ void operator()(const f32x4 (&acc)[2][2][4][2], const Unit& u, int wr, int wc, int fr, int fq) const {
        const int row0 = u.pm * BM + wr * 64 + fr, col0 = (u.pn & 1) * BM + wc * 32 + 4 * fq; float* base = C + (size_t)u.ks * 4096 * 512;
#pragma unroll
        for (int ai = 0; ai < 2; ++ai)
#pragma unroll
            for (int m = 0; m < 4; ++m) { float* rowp = base + (size_t)(row0 + ai * HALF + m * 16) * 512 + col0;
#pragma unroll
                for (int bj = 0; bj < 2; ++bj)
#pragma unroll
                    for (int n = 0; n < 2; ++n) *(f32x4*)(rowp + bj * HALF + n * 16) = acc[ai][bj][m][n]; }
    }
};
struct EpiGlu {
    static constexpr bool PERM = true;
    const bf16* Z; bf16* ZG;
    __device__ __forceinline__ void operator()(const f32x4 (&acc)[2][2][4][2], const Unit& u, int wr, int wc, int fr, int fq) const {
        const int row0 = u.pm * BM + wr * 64 + fr;
#pragma unroll
        for (int ai = 0; ai < 2; ++ai)
#pragma unroll
            for (int m = 0; m < 4; ++m) { const int row = row0 + ai * HALF + m * 16;
#pragma unroll
                for (int bj = 0; bj < 2; ++bj) { const f32x4 v0 = acc[ai][bj][m][0], v1 = acc[ai][bj][m][1]; const size_t off = (size_t)row * 512 + u.pn * BM + bj * HALF + wc * 32 + 8 * fq;
                    const v4u z = *(const v4u*)(Z + off); v4u w;
                    w.x = cvt_pk_bf16(bflo(z.x) * sigm(v0[0]), bfhi(z.x) * sigm(v0[1])); w.y = cvt_pk_bf16(bflo(z.y) * sigm(v0[2]), bfhi(z.y) * sigm(v0[3]));
                    w.z = cvt_pk_bf16(bflo(z.z) * sigm(v1[0]), bfhi(z.z) * sigm(v1[1])); w.w = cvt_pk_bf16(bflo(z.w) * sigm(v1[2]), bfhi(z.w) * sigm(v1[3]));
                    *(v4u*)(ZG + off) = w; } }
    }
};
struct EpiMix2 {
    static constexpr bool PERM = true;
    const bf16* Gt; bf16* MIX;
    __device__ __forceinline__ void operator()(f32x4 (&acc)[2][2][4][2], const Unit& u, int wr, int wc, int fr, int fq) const {
        const int row0 = u.pm * BM + wr * 64 + fr;
#pragma unroll
        for (int ai = 0; ai < 2; ++ai)
#pragma unroll
            for (int m = 0; m < 4; ++m) { const int row = row0 + ai * HALF + m * 16;
#pragma unroll
                for (int bj = 0; bj < 2; ++bj) { const int col = u.pn * BM + bj * HALF + wc * 32 + 8 * fq;
                    const v4u gb = *(const v4u*)(Gt + (size_t)row * 2048 + 1024 + col);
                    const float b8[8] = {bflo(gb.x), bfhi(gb.x), bflo(gb.y), bfhi(gb.y), bflo(gb.z), bfhi(gb.z), bflo(gb.w), bfhi(gb.w)};
                    if (u.seg == 0) { const v4u ga = *(const v4u*)(Gt + (size_t)row * 2048 + col);
                        const float a8[8] = {bflo(ga.x), bfhi(ga.x), bflo(ga.y), bfhi(ga.y), bflo(ga.z), bfhi(ga.z), bflo(ga.w), bfhi(ga.w)};
#pragma unroll
                        for (int e = 0; e < 4; ++e) { acc[ai][bj][m][0][e] *= a8[e] * __builtin_amdgcn_rcpf(b8[e]); acc[ai][bj][m][1][e] *= a8[4 + e] * __builtin_amdgcn_rcpf(b8[4 + e]); }
                    } else { const f32x4 v0 = acc[ai][bj][m][0], v1 = acc[ai][bj][m][1]; v4u w;
                        w.x = cvt_pk_bf16(v0[0] * b8[0], v0[1] * b8[1]); w.y = cvt_pk_bf16(v0[2] * b8[2], v0[3] * b8[3]); w.z = cvt_pk_bf16(v1[0] * b8[4], v1[1] * b8[5]); w.w = cvt_pk_bf16(v1[2] * b8[6], v1[3] * b8[7]);
                        *(v4u*)(MIX + (size_t)row * 1024 + col) = w; } } }
    }
};
struct EpiRes {
    static constexpr bool PERM = false;
    const float* base; float* out;
    __device__ __forceinline__ void operator()(const f32x4 (&acc)[2][2][4][2], const Unit& u, int wr, int wc, int fr, int fq) const {
        const int row0 = u.pm * BM + wr * 64 + fr, col0 = u.pn * BM + wc * 32 + 4 * fq;
#pragma unroll
        for (int ai = 0; ai < 2; ++ai)
#pragma unroll
            for (int m = 0; m < 4; ++m) { const size_t off = (size_t)(row0 + ai * HALF + m * 16) * 1024 + col0;
#pragma unroll
                for (int bj = 0; bj < 2; ++bj)
#pragma unroll
                    for (int n = 0; n < 2; ++n) { const f32x4 b = *(const f32x4*)(base + off + bj * HALF + n * 16); *(f32x4*)(out + off + bj * HALF + n * 16) = b + acc[ai][bj][m][n]; } }
    }
};
struct EpiResNorm {
    static constexpr bool PERM = false;
    const float* base; float* out; bf16* XN; float* SSP; LAS float* part;
    __device__ __forceinline__ void operator()(const f32x4 (&acc)[2][2][4][2], const Unit& u, int wr, int wc, int fr, int fq) const {
        const int row0 = u.pm * BM + wr * 64 + fr, col0 = u.pn * BM + wc * 32 + 4 * fq;
#pragma unroll
        for (int ai = 0; ai < 2; ++ai)
#pragma unroll
            for (int m = 0; m < 4; ++m) { const size_t off = (size_t)(row0 + ai * HALF + m * 16) * 1024 + col0; float ss = 0.f;
#pragma unroll
                for (int bj = 0; bj < 2; ++bj)
#pragma unroll
                    for (int n = 0; n < 2; ++n) { const f32x4 b = *(const f32x4*)(base + off + bj * HALF + n * 16); const f32x4 x1 = b + acc[ai][bj][m][n]; *(f32x4*)(out + off + bj * HALF + n * 16) = x1;
                        *(unsigned long long*)(XN + off + bj * HALF + n * 16) = (unsigned long long)cvt_pk_bf16(x1[0], x1[1]) | ((unsigned long long)cvt_pk_bf16(x1[2], x1[3]) << 32);
                        ss += (x1[0] * x1[0] + x1[1] * x1[1]) + (x1[2] * x1[2] + x1[3] * x1[3]); }
                ss += __shfl_xor(ss, 16); ss += __shfl_xor(ss, 32);
                if (fq == 0) part[(ai * HALF + wr * 64 + m * 16 + fr) * 4 + wc] = ss; }
        asm volatile("s_waitcnt lgkmcnt(0)" ::: "memory"); __builtin_amdgcn_s_barrier(); asm volatile("" ::: "memory");
        if (threadIdx.x < 256) { const f32x4 p = *(const LAS f32x4*)(part + threadIdx.x * 4); SSP[(size_t)(u.pm * BM + threadIdx.x) * 4 + u.pn] = (p[0] + p[1]) + (p[2] + p[3]); }
    }
};
struct EpiFfn {
    static constexpr bool PERM = true;
    bf16* H; const float* SSP;
    __device__ __forceinline__ void operator()(const f32x4 (&acc)[2][2][4][2], const Unit& u, int wr, int wc, int fr, int fq) const {
        const int row0 = u.pm * BM + wr * 64 + fr;
#pragma unroll
        for (int ai = 0; ai < 2; ++ai)
#pragma unroll
            for (int m = 0; m < 4; ++m) { const int row = row0 + ai * HALF + m * 16;
                const f32x4 sp = *(const f32x4*)(SSP + (size_t)row * 4); const float rs = 1.0f / sqrtf(((sp[0] + sp[1]) + (sp[2] + sp[3])) * (1.f / 1024.f) + 1e-6f);
                float r[8];
#pragma unroll
                for (int n = 0; n < 2; ++n)
#pragma unroll
                    for (int e = 0; e < 4; ++e) { const float gt = acc[ai][0][m][n][e] * rs, up = acc[ai][1][m][n][e] * rs; r[n * 4 + e] = gt * sigm(gt) * up; }
                v4u w; w.x = cvt_pk_bf16(r[0], r[1]); w.y = cvt_pk_bf16(r[2], r[3]); w.z = cvt_pk_bf16(r[4], r[5]); w.w = cvt_pk_bf16(r[6], r[7]);
                *(v4u*)(H + (size_t)row * DFF + u.pn * HALF + wc * 32 + 8 * fq) = w; }
    }
};

struct TrDesc { const float* src; bf16* dst; int ld, ncols, dld, drow, kb, nb; const float* gain; };
__device__ __forceinline__ void tr_load(const TrDesc& d, float (&v)[32], int lane) {
    const int k0 = 64 * d.kb, c = 32 * d.nb + (lane & 31); const bool ok = c < d.ncols; const float* p = d.src + (size_t)(k0 + (lane >> 5)) * d.ld + c;
#pragma unroll
    for (int i = 0; i < 32; ++i) v[i] = ok ? p[(size_t)(2 * i) * d.ld] : 0.f;
    if (d.gain) {
#pragma unroll
        for (int i = 0; i < 32; ++i) v[i] *= d.gain[k0 + 2 * i + (lane >> 5)]; }
}
__device__ __forceinline__ void tr_finish(const TrDesc& d, const float (&v)[32], LAS float* scr, int lane) {
#pragma unroll
    for (int i = 0; i < 32; ++i) scr[(2 * i + (lane >> 5)) * 33 + (lane & 31)] = v[i];
    LDS_WAIT();
    const int cc = lane & 7, k0 = 64 * d.kb;
#pragma unroll
    for (int j = 0; j < 4; ++j) { const int n = (lane >> 3) + 8 * j; const LAS float* s = scr + (8 * cc) * 33 + n;
        v4u o; o.x = pk2(s[0 * 33], s[1 * 33]); o.y = pk2(s[2 * 33], s[3 * 33]); o.z = pk2(s[4 * 33], s[5 * 33]); o.w = pk2(s[6 * 33], s[7 * 33]);
        *(v4u*)(d.dst + (size_t)(d.drow + n) * d.dld + k0 + 8 * cc) = o; }
    LDS_WAIT();
}
__device__ __forceinline__ void rms_row_to_bf16(const float* xrow, const float* gain, bf16* orow, int lane) {
    const f32x4* xr = (const f32x4*)xrow + lane; const f32x4* gr = (const f32x4*)gain + lane;
    f32x4 v[4]; float s = 0.f;
#pragma unroll
    for (int j = 0; j < 4; ++j) { v[j] = xr[64 * j]; s += (v[j].x * v[j].x + v[j].y * v[j].y) + (v[j].z * v[j].z + v[j].w * v[j].w); }
    const float rstd = 1.0f / sqrtf(wave_sum(s) * (1.f / DM) + EPS);
    unsigned long long* o8 = (unsigned long long*)orow + lane;
#pragma unroll
    for (int j = 0; j < 4; ++j) { const f32x4 gq = gr[64 * j];
        o8[64 * j] = (unsigned long long)pk2(v[j].x * rstd * gq.x, v[j].y * rstd * gq.y) | ((unsigned long long)pk2(v[j].z * rstd * gq.z, v[j].w * rstd * gq.w) << 32); }
}
__device__ __forceinline__ void rms_rows2_to_bf16(const float* x0, const float* x1, const float* gain, bf16* o0, bf16* o1, int lane) {
    const f32x4* xa = (const f32x4*)x0 + lane; const f32x4* xb = (const f32x4*)x1 + lane; const f32x4* gr = (const f32x4*)gain + lane;
    f32x4 va[4], vb[4]; float sa = 0.f, sb = 0.f;
#pragma unroll
    for (int j = 0; j < 4; ++j) { va[j] = xa[64 * j]; vb[j] = xb[64 * j]; }
#pragma unroll
    for (int j = 0; j < 4; ++j) { sa += (va[j].x * va[j].x + va[j].y * va[j].y) + (va[j].z * va[j].z + va[j].w * va[j].w); sb += (vb[j].x * vb[j].x + vb[j].y * vb[j].y) + (vb[j].z * vb[j].z + vb[j].w * vb[j].w); }
    const float ra = 1.0f / sqrtf(wave_sum(sa) * (1.f / DM) + EPS), rb = 1.0f / sqrtf(wave_sum(sb) * (1.f / DM) + EPS);
    unsigned long long* pa = (unsigned long long*)o0 + lane; unsigned long long* pb = (unsigned long long*)o1 + lane;
#pragma unroll
    for (int j = 0; j < 4; ++j) { const f32x4 gq = gr[64 * j];
        pa[64 * j] = (unsigned long long)pk2(va[j].x * ra * gq.x, va[j].y * ra * gq.y) | ((unsigned long long)pk2(va[j].z * ra * gq.z, va[j].w * ra * gq.w) << 32);
        pb[64 * j] = (unsigned long long)pk2(vb[j].x * rb * gq.x, vb[j].y * rb * gq.y) | ((unsigned long long)pk2(vb[j].z * rb * gq.z, vb[j].w * rb * gq.w) << 32); }
}
__device__ __forceinline__ void rms_row_f32(float* xrow, const float* gain, int lane) {
    f32x4* xr = (f32x4*)xrow + lane; const f32x4* gr = (const f32x4*)gain + lane;
    f32x4 v[4]; float s = 0.f;
#pragma unroll
    for (int j = 0; j < 4; ++j) { v[j] = xr[64 * j]; s += (v[j].x * v[j].x + v[j].y * v[j].y) + (v[j].z * v[j].z + v[j].w * v[j].w); }
    const float rstd = 1.0f / sqrtf(wave_sum(s) * (1.f / DM) + EPS);
#pragma unroll
    for (int j = 0; j < 4; ++j) { const f32x4 gq = gr[64 * j]; xr[64 * j] = v[j] * rstd * gq; }
}
__device__ __forceinline__ void s5_tables(const Frame& F, const Args& args, int g) {
    const int lane = F.lane;
    const float* are = args.in[3]; const float* aim = args.in[4]; const float* ldt = args.in[5]; const float* bre = args.in[6]; const float* bim = args.in[7]; const float* cre = args.in[8]; const float* cim = args.in[9];
    const double dt = exp((double)ldt[g]);
    {   const int p = lane; const double ar = are[g * 64 + p], ai = aim[g * 64 + p];
        const double er = exp(ar * dt), lr = er * cos(ai * dt), li = er * sin(ai * dt);
        ((f32x2*)(F.ws + WS_TAB + TAB_LAM))[g * 64 + p] = (f32x2){(float)lr, (float)li};
        const double e2 = exp(ar * dt * 256.0), l2r = e2 * cos(ai * dt * 256.0), l2i = e2 * sin(ai * dt * 256.0);
        ((f32x2*)(F.ws + WS_TAB + TAB_LAM256))[g * 64 + p] = (f32x2){(float)l2r, (float)l2i}; }
#pragma unroll
    for (int nt = 0; nt < 4; ++nt) { const int col = 32 * nt + (lane & 31), p = col >> 1, ri = col & 1;
        const double ar = are[g * 64 + p], ai = aim[g * 64 + p];
        const double er = exp(ar * dt), lr = er * cos(ai * dt) - 1.0, li = er * sin(ai * dt);
        const double den = ar * ar + ai * ai, kr = (lr * ar + li * ai) / den, ki = (li * ar - lr * ai) / den;
        float v[8];
#pragma unroll
        for (int j = 0; j < 8; ++j) { const int c = 8 * (lane >> 5) + j; const double br = bre[(g * 64 + p) * 16 + c], bi = bim[(g * 64 + p) * 16 + c];
            v[j] = (float)(ri ? (kr * bi + ki * br) : (kr * br - ki * bi)); }
        v4u o; o.x = pk2(v[0], v[1]); o.y = pk2(v[2], v[3]); o.z = pk2(v[4], v[5]); o.w = pk2(v[6], v[7]);
        ((v4u*)(F.ws + WS_TAB + TAB_BF))[(g * 4 + nt) * 64 + lane] = o; }
#pragma unroll
    for (int ks = 0; ks < 4; ++ks) { const int ch = lane & 15; float v[8];
#pragma unroll
        for (int j = 0; j < 8; ++j) { const int k = 32 * ks + 8 * (lane >> 4) + j, p = k >> 1, ri = k & 1; v[j] = ri ? -cim[(g * 16 + ch) * 64 + p] : cre[(g * 16 + ch) * 64 + p]; }
        v4u o; o.x = pk2(v[0], v[1]); o.y = pk2(v[2], v[3]); o.z = pk2(v[4], v[5]); o.w = pk2(v[6], v[7]);
        ((v4u*)(F.ws + WS_TAB + TAB_CF))[(g * 4 + ks) * 64 + lane] = o; }
}
__device__ __forceinline__ void p0_prologue(const Frame& F, const Args& args) {
    LAS float* scr = (LAS float*)(F.lds + F.wave * 16384);
    const int gw = F.gw, NGW = F.ngw, lane = F.lane;
    if (F.wave == 0 && blockIdx.x < 32) s5_tables(F, args, (int)blockIdx.x);
    else if (F.wave == 1 && blockIdx.x < 128) {
        const int it = (int)blockIdx.x, kv = it >> 6, part = (it >> 2) & 15, cgp = it & 3;
        const float* pos = kv ? args.in[14] : args.in[13]; const float* w1 = kv ? args.in[17] : args.in[15]; float a = 0.f;
#pragma unroll 1
        for (int r0 = 128 * part; r0 < 128 * part + 128; r0 += 32) { float wv[32];
#pragma unroll
            for (int i = 0; i < 32; ++i) wv[i] = w1[(size_t)(r0 + i) * 256 + cgp * 64 + lane];
#pragma unroll
            for (int i = 0; i < 32; ++i) a += pos[r0 + i] * wv[i]; }
        ((float*)(F.ws + WS_TAB + TAB_POSB))[(kv * 16 + part) * 256 + cgp * 64 + lane] = a;
    }
    { v4u* z = (v4u*)(F.ws + WS_WIN + (size_t)3872 * 1024 * 2); const int n16 = 224 * 1024 * 2 / 16;
      for (int i = blockIdx.x * 512 + F.tid; i < n16; i += F.G * 512) z[i] = (v4u){0u, 0u, 0u, 0u}; }
    bf16* WIN = (bf16*)(F.ws + WS_WIN); bf16* WGU = (bf16*)(F.ws + WS_WGU); bf16* WD = (bf16*)(F.ws + WS_WD); bf16* WOUT = (bf16*)(F.ws + WS_WOUT);
    bf16* WA = (bf16*)(F.ws + WS_WA); bf16* WB = (bf16*)(F.ws + WS_WB); bf16* WGLU = (bf16*)(F.ws + WS_WGLU); bf16* WC1 = (bf16*)(F.ws + WS_WC1);
    constexpr int I1 = 16 * 56, I2 = 16 * 64, I3 = 16, IGLU = 8 * 16, IUP = 8 * 32, IOUT = 16 * 32, IFF = 16 * 88, IDN = 44 * 32, ICM = 16 * 8;
    constexpr int NITEMS = I1 + I2 + I3 + IGLU + 2 * IUP + IOUT + 2 * IFF + IDN + 4 * ICM;
    auto desc = [&](int it) -> TrDesc {
        int r = it;
        if (r < I1) return TrDesc{args.in[2], WIN, INC, 1792, 1024, 32 * (r % 56), r / 56, r % 56, nullptr}; r -= I1;
        if (r < I2) return TrDesc{args.in[2] + 1816, WIN, INC, 2048, 1024, 1792 + 32 * (r % 64), r / 64, r % 64, nullptr}; r -= I2;
        if (r < I3) return TrDesc{args.in[2] + 1792, WIN, INC, 24, 1024, 3840, r, 0, nullptr}; r -= I3;
        if (r < IGLU) return TrDesc{args.in[11], WGLU, 512, 512, 512, 32 * (r % 16), r / 16, r % 16, nullptr}; r -= IGLU;
        if (r < IUP) return TrDesc{args.in[12], WA, 1024, 1024, 512, 32 * (r % 32), r / 32, r % 32, nullptr}; r -= IUP;
        if (r < IUP) return TrDesc{args.in[20], WB, 1024, 1024, 512, 32 * (r % 32), r / 32, r % 32, nullptr}; r -= IUP;
        if (r < IOUT) return TrDesc{args.in[21], WOUT, 1024, 1024, 1024, 32 * (r % 32), r / 32, r % 32, nullptr}; r -= IOUT;
        if (r < IFF) { const int nb = r % 88; return TrDesc{args.in[23], WGU, DFF, DFF, 1024, (nb >> 2) * 256 + (nb & 3) * 32, r / 88, nb, args.in[22]}; } r -= IFF;
        if (r < IFF) { const int nb = r % 88; return TrDesc{args.in[24], WGU, DFF, DFF, 1024, (nb >> 2) * 256 + (nb & 3) * 32 + 128, r / 88, nb, args.in[22]}; } r -= IFF;
        if (r < IDN) return TrDesc{args.in[25], WD, 1024, 1024, DFF, 32 * (r % 32), r / 32, r % 32, nullptr}; r -= IDN;
        const int q = r / ICM, rr = r % ICM;
        return TrDesc{((q >> 1) ? args.in[17] : args.in[15]) + (size_t)(q & 1) * 1024 * 256, WC1, 256, 256, 1024, q * 256 + 32 * (rr % 8), rr / 8, rr % 8, nullptr};
    };
    if (gw < NITEMS) {
        TrDesc dc = desc(gw); float vc[32]; tr_load(dc, vc, lane);
#pragma unroll 1
        for (int it = gw; it < NITEMS; it += NGW) {
            const bool more = it + NGW < NITEMS; TrDesc dn = desc(more ? it + NGW : it); float vn[32]; tr_load(dn, vn, lane);
            tr_finish(dc, vc, scr, lane);
            dc = dn;
#pragma unroll
            for (int i = 0; i < 32; ++i) vc[i] = vn[i];
        }
    }
    bf16* XN = (bf16*)(F.ws + WS_XN);
    for (int m = gw; m < S; m += 2 * NGW) rms_rows2_to_bf16(args.in[0] + (size_t)m * DM, args.in[0] + (size_t)(m + NGW) * DM, args.in[1], XN + (size_t)m * DM, XN + (size_t)(m + NGW) * DM, lane);
}

__device__ __forceinline__ int crow(int r, int hi) { return (r & 3) + 8 * (r >> 2) + 4 * hi; }
template <bool FINAL>
__device__ __forceinline__ void s5_unit(const Frame& F, const Args& args, int c, int g, LAS unsigned char* wl, LAS unsigned char* wx) {
    const int lane = F.lane, hi = lane >> 5;
    const bf16* U = (const bf16*)(F.ws + WS_U); bf16* Z = (bf16*)(F.ws + WS_Z);
    bf16x8 bfg[4], cfg[4], ua[8];
#pragma unroll
    for (int sub = 0; sub < 8; ++sub) ua[sub] = *(const bf16x8*)(U + (size_t)(c * 256 + sub * 32 + (lane & 31)) * 512 + g * 16 + 8 * hi);
#pragma unroll
    for (int nt = 0; nt < 4; ++nt) bfg[nt] = ((const bf16x8*)(F.ws + WS_TAB + TAB_BF))[(g * 4 + nt) * 64 + lane];
    const f32x2 lam = ((const f32x2*)(F.ws + WS_TAB + TAB_LAM))[g * 64 + lane];
    f32x2* Fst = (f32x2*)(F.ws + WS_F);
    float xr = 0.f, xi = 0.f, dsk = 0.f;
    if (FINAL) {
#pragma unroll
        for (int ks = 0; ks < 4; ++ks) cfg[ks] = ((const bf16x8*)(F.ws + WS_TAB + TAB_CF))[(g * 4 + ks) * 64 + lane];
        dsk = args.in[10][g * 16 + (lane & 15)];
        const f32x2 L2 = ((const f32x2*)(F.ws + WS_TAB + TAB_LAM256))[g * 64 + lane];
        for (int cp = 0; cp < c; ++cp) { const f32x2 f = Fst[(cp * 32 + g) * 64 + lane]; const float nr = L2.x * xr - L2.y * xi + f.x, ni = L2.x * xi + L2.y * xr + f.y; xr = nr; xi = ni; }
    }
#pragma unroll
    for (int sub = 0; sub < 8; ++sub) {
        const int t0 = c * 256 + sub * 32;
        const bf16x8 a = ua[sub];
        if (FINAL) *(LAS bf16x8*)(wx + (lane & 31) * 32 + hi * 16) = a;
#pragma unroll
        for (int nt = 0; nt < 4; ++nt) { f32x16 acc = {}; acc = __builtin_amdgcn_mfma_f32_32x32x16_bf16(a, bfg[nt], acc, 0, 0, 0);
#pragma unroll
            for (int r = 0; r < 16; ++r) ((LAS float*)wl)[crow(r, hi) * 128 + 32 * nt + (lane & 31)] = acc[r]; }
        LDS_WAIT();
        f32x2 bu[32];
#pragma unroll
        for (int tk = 0; tk < 32; ++tk) bu[tk] = ((const LAS f32x2*)wl)[tk * 64 + lane];
        LDS_WAIT();
#pragma unroll
        for (int tk = 0; tk < 32; ++tk) { const float nr = lam.x * xr - lam.y * xi + bu[tk].x, ni = lam.x * xi + lam.y * xr + bu[tk].y; xr = nr; xi = ni;
            if (FINAL) ((LAS unsigned*)wl)[tk * 128 + ((lane + 4 * tk) & 63)] = pk2(xr, xi); }
        if (FINAL) {
            LDS_WAIT();
            LAS unsigned short* zt = (LAS unsigned short*)(wx + 1024);
#pragma unroll
            for (int mt = 0; mt < 2; ++mt) { f32x4 y4 = {0.f, 0.f, 0.f, 0.f}; const int row = 16 * mt + (lane & 15);
#pragma unroll
                for (int ks = 0; ks < 4; ++ks) { const bf16x8 xa = *(const LAS bf16x8*)(wl + row * 512 + ((64 * ks + 16 * (lane >> 4) + 16 * row) & 255)); y4 = __builtin_amdgcn_mfma_f32_16x16x32_bf16(xa, cfg[ks], y4, 0, 0, 0); }
#pragma unroll
                for (int r = 0; r < 4; ++r) { const int tok = 16 * mt + 4 * (lane >> 4) + r; const float uu = bf2f(((const LAS unsigned short*)wx)[tok * 16 + (lane & 15)]);
                    zt[tok * 16 + (lane & 15)] = (unsigned short)f2bf(gelu_tanh(y4[r] + dsk * uu)); } }
            LDS_WAIT();
            *(v4u*)(Z + (size_t)(t0 + (lane >> 1)) * 512 + g * 16 + 8 * (lane & 1)) = *(const LAS v4u*)(wx + 1024 + lane * 16);
            LDS_WAIT();
        }
    }
    if (!FINAL) Fst[(c * 32 + g) * 64 + lane] = (f32x2){xr, xi};
}

__device__ __forceinline__ int krow(int s, int h, int j) { return 16 * s + 8 * (j >> 2) + 4 * h + (j & 3); }
__device__ __forceinline__ void cmp_l2_unit(const Frame& F, const Args& args, int kv, int g, int n, LAS float* hb, const LAS float* w2s) {
    const int lane = F.lane; const float* P1 = F.out;
    float o = 0.f;
    if (n < NCMP) {
        const int rt = kv * 2048 + g * 1024 + n;
        const float* posb = (const float*)(F.ws + WS_TAB + TAB_POSB) + kv * 16 * 256;
#pragma unroll
        for (int i = 0; i < 4; ++i) { const int j = lane + 64 * i; float a = 0.f;
#pragma unroll
            for (int ks = 0; ks < CMP_KS; ++ks) a += P1[((size_t)ks * 4096 + rt) * 512 + j] + P1[((size_t)ks * 4096 + rt + 1) * 512 + 256 + j];
#pragma unroll
            for (int p = 0; p < 16; ++p) a += posb[p * 256 + j];
            hb[j] = gelu_tanh(a); }
        LDS_WAIT();
#pragma unroll 8
        for (int j = 0; j < 256; ++j) o += hb[j] * w2s[j * 64 + lane];
    }
    if (kv == 0) ((bf16*)(F.ws + WS_KCB))[((size_t)g * 1024 + n) * 64 + lane] = (bf16)f2bf(o);
    else { const int grp = n >> 5, kk = n & 31, sx = kk >> 4, rem = kk & 15, hh = (rem >> 2) & 1, j = ((rem >> 3) << 2) | (rem & 3), d0 = lane >> 5, ln = hh * 32 + (lane & 31);
        ((bf16*)(F.ws + WS_VTC))[((((size_t)(g * 32 + grp) * 2 + d0) * 2 + sx) * 64 + ln) * 8 + j] = (bf16)f2bf(o); }
    LDS_WAIT();
}
__device__ __forceinline__ void vtw_item(const Frame& F, int g, int grp, LAS unsigned short* tl) {
    const int lane = F.lane, hi = lane >> 5; const bf16* V = (const bf16*)(F.ws + WS_KVH) + (size_t)(10 + g) * S * 64 + (size_t)32 * grp * 64;
#pragma unroll
    for (int e = 0; e < 4; ++e) ((LAS v4u*)tl)[lane + 64 * e] = ((const v4u*)V)[lane + 64 * e];
    LDS_WAIT();
#pragma unroll
    for (int d0 = 0; d0 < 2; ++d0)
#pragma unroll
        for (int sx = 0; sx < 2; ++sx) { unsigned w[4];
#pragma unroll
            for (int jj = 0; jj < 4; ++jj) { const unsigned a = tl[krow(sx, hi, 2 * jj) * 64 + 32 * d0 + (lane & 31)], b = tl[krow(sx, hi, 2 * jj + 1) * 64 + 32 * d0 + (lane & 31)]; w[jj] = a | (b << 16); }
            ((v4u*)(F.ws + WS_VTW))[(((size_t)(g * 512 + grp) * 2 + d0) * 2 + sx) * 64 + lane] = (v4u){w[0], w[1], w[2], w[3]}; }
    LDS_WAIT();
}
__device__ __forceinline__ int kap(int ks, int q, int j) { return 16 * (2 * ks + (j >> 2)) + 4 * q + (j & 3); }
__device__ __forceinline__ void vts_item(const Frame& F, int g, int blk, LAS unsigned short* tl) {
    const int lane = F.lane, q = lane >> 4; const bf16* V = (const bf16*)(F.ws + WS_KVH) + (size_t)(6 + g) * S * 64 + (size_t)64 * blk * 64;
#pragma unroll
    for (int e = 0; e < 8; ++e) ((LAS v4u*)tl)[lane + 64 * e] = ((const v4u*)V)[lane + 64 * e];
    LDS_WAIT();
#pragma unroll
    for (int dt = 0; dt < 4; ++dt)
#pragma unroll
        for (int ks = 0; ks < 2; ++ks) { unsigned w[4];
#pragma unroll
            for (int jj = 0; jj < 4; ++jj) { const unsigned a = tl[kap(ks, q, 2 * jj) * 64 + 16 * dt + (lane & 15)], b = tl[kap(ks, q, 2 * jj + 1) * 64 + 16 * dt + (lane & 15)]; w[jj] = a | (b << 16); }
            ((v4u*)(F.ws + WS_VTS))[(((size_t)(g * 256 + blk) * 4 + dt) * 2 + ks) * 64 + lane] = (v4u){w[0], w[1], w[2], w[3]}; }
    LDS_WAIT();
}

constexpr int AT_SC = 0;
constexpr int AT_SEL = 67584;
constexpr int AT_CNT = AT_SEL + 4096;
constexpr int AT_LIST = AT_CNT + 1024;
constexpr int AT_BT = AT_LIST + 32768;
constexpr int AT_PARK = AT_BT + 4096;
constexpr int AT_TILE = AT_PARK + 32768;
constexpr int AT_END = AT_TILE + 16384;
static_assert(AT_END <= LDS_BYTES - 64, "attention LDS map");
constexpr int PSLOTS = 832, PSLAB = 458752;
constexpr int PML_OFF = PSLOTS * 512;
constexpr int SCS = 264;

__device__ __forceinline__ bf16x8 pack8(float a0, float a1, float a2, float a3, float a4, float a5, float a6, float a7) {
    v4u w; w.x = cvt_pk_bf16(a0, a1); w.y = cvt_pk_bf16(a2, a3); w.z = cvt_pk_bf16(a4, a5); w.w = cvt_pk_bf16(a6, a7); return __builtin_bit_cast(bf16x8, w);
}
__device__ __forceinline__ float xmax32(float v) { auto r = __builtin_amdgcn_permlane32_swap(__float_as_uint(v), __float_as_uint(v), false, false); return fmaxf(__uint_as_float(r[0]), __uint_as_float(r[1])); }
__device__ __forceinline__ float xsum32(float v) { auto r = __builtin_amdgcn_permlane32_swap(__float_as_uint(v), __float_as_uint(v), false, false); return __uint_as_float(r[0]) + __uint_as_float(r[1]); }
__device__ __forceinline__ float xmax16(float v) { auto r = __builtin_amdgcn_permlane16_swap(__float_as_uint(v), __float_as_uint(v), false, false); return fmaxf(__uint_as_float(r[0]), __uint_as_float(r[1])); }
__device__ __forceinline__ float xsum16(float v) { auto r = __builtin_amdgcn_permlane16_swap(__float_as_uint(v), __float_as_uint(v), false, false); return __uint_as_float(r[0]) + __uint_as_float(r[1]); }
__device__ __forceinline__ float max16(const f32x16& a) {
    const float m0 = fmaxf(fmaxf(a[0], a[1]), fmaxf(a[2], a[3])), m1 = fmaxf(fmaxf(a[4], a[5]), fmaxf(a[6], a[7])), m2 = fmaxf(fmaxf(a[8], a[9]), fmaxf(a[10], a[11])), m3 = fmaxf(fmaxf(a[12], a[13]), fmaxf(a[14], a[15]));
    return fmaxf(fmaxf(m0, m1), fmaxf(m2, m3)); }
__device__ __forceinline__ float sum16(const f32x16& a) {
    const float s0 = (a[0] + a[1]) + (a[2] + a[3]), s1 = (a[4] + a[5]) + (a[6] + a[7]), s2 = (a[8] + a[9]) + (a[10] + a[11]), s3 = (a[12] + a[13]) + (a[14] + a[15]);
    return (s0 + s1) + (s2 + s3); }
__device__ __forceinline__ int fenc(float f) { int k = __float_as_int(f); return k ^ ((k >> 31) & 0x7fffffff); }
__device__ __forceinline__ float fdec(int k) { return __int_as_float(k ^ ((k >> 31) & 0x7fffffff)); }
#define MFMA32(a, b, c) __builtin_amdgcn_mfma_f32_32x32x16_bf16((a), (b), (c), 0, 0, 0)
#define MFMA16(a, b, c) __builtin_amdgcn_mfma_f32_16x16x32_bf16((a), (b), (c), 0, 0, 0)
#define DPPI(x, ctrl) __builtin_amdgcn_update_dpp(0, (x), (ctrl), 0xF, 0xF, false)

struct AttnPtrs { const bf16* Q; const bf16* KCB; const bf16x8* VTC; const bf16* KW; const bf16x8* VTW; const bf16* KS; const bf16x8* VTS; const bf16* GN; bf16* O; };

__device__ __forceinline__ void attn_stageA(const AttnPtrs& P, int lane, int wave, int tile0, int g, LAS unsigned char* lds) {
    const int hi = lane >> 5, c32 = lane & 31, ti = c32 >> 2, hr = c32 & 3, h = g * 4 + hr, t0 = tile0 + 8 * wave, t = t0 + ti;
    LAS float* scores = (LAS float*)(lds + AT_SC) + (8 * wave) * SCS; const LAS float* BT = (const LAS float*)(lds + AT_BT); LAS int* sel = (LAS int*)(lds + AT_SEL) + (8 * wave) * 16;
    for (int k = lane; k < 8 * SCS / 4; k += 64) ((LAS f32x4*)scores)[k] = (f32x4){0.f, 0.f, 0.f, 0.f};
    bf16x8 bq[4];
#pragma unroll
    for (int ks = 0; ks < 4; ++ks) bq[ks] = *(const bf16x8*)(P.Q + (size_t)t * 512 + h * 64 + 16 * ks + 8 * hi);
    const float cb = BT[h * 128 + 127];
    const float g0 = bf2f(P.GN[(size_t)t * 32 + h * 3 + 0]), g2 = bf2f(P.GN[(size_t)t * 32 + h * 3 + 2]);
    LDS_WAIT();
    const int tid = wave * 64 + lane; LAS unsigned char* tb = lds + AT_TILE;
    const int ldrow = tid >> 3, ldch = tid & 7; const unsigned stoff = (tid < 256) ? (unsigned)(ldrow * 128 + ((ldch ^ (ldrow & 7)) << 4)) : (unsigned)(8192 + (tid - 256) * 16);
    const unsigned kof = (unsigned)(c32 * 128), ksw = (unsigned)(c32 & 7);
#define KFRAG(buf, ks) (*(const LAS bf16x8*)(tb + (buf) * 4096 + kof + ((((ks) * 2 + hi) ^ ksw) << 4)))
#define VFRAG(buf, f) (*(const LAS bf16x8*)(tb + 8192 + (buf) * 4096 + ((f) * 64 + lane) * 16))
#define STAGE_LOAD(Kp, kmax, VTp, gmax, n0v) ((tid < 256) ? *(const v4u*)((Kp) + (size_t)min((n0v) + ldrow, (kmax)) * 64 + ldch * 8) : *(const v4u*)((VTp) + (size_t)min((n0v) >> 5, (gmax)) * 256 + (tid - 256)))
#define STAGE_WRITE(v, buf) (*(LAS v4u*)(tb + (buf) * 4096 + stoff) = (v))
#define PVACC(o0v, o1v, buf, a) do { const bf16x8 p0_ = pack8(a[0], a[1], a[2], a[3], a[4], a[5], a[6], a[7]), p1_ = pack8(a[8], a[9], a[10], a[11], a[12], a[13], a[14], a[15]); \
        o0v = MFMA32(VFRAG(buf, 0), p0_, o0v); o0v = MFMA32(VFRAG(buf, 1), p1_, o0v); o1v = MFMA32(VFRAG(buf, 2), p0_, o1v); o1v = MFMA32(VFRAG(buf, 3), p1_, o1v); } while (0)
    constexpr float SM_THR = 8.0f;
#define REF_EVENT(a, mref, started, d, fs) { const float tm_ = xmax32(max16(a)); const bool need_ = started ? (tm_ > SM_THR) : (tm_ > -1e29f); d = 0.f; fs = 1.f; \
        if (__any(need_)) { d = need_ ? tm_ : 0.f; fs = (need_ && started) ? __builtin_amdgcn_exp2f(-d) : 1.f; mref += d; started = started || need_; _Pragma("unroll") for (int r = 0; r < 16; ++r) a[r] -= d; } }
    const int ncb = (tile0 + 63 >= 31) ? min((tile0 + 63 - 31) / 16 + 1, NCMP) : 0, ntc = (ncb + 31) >> 5;
    const int nfar = (t0 >= 144) ? (t0 - 144) / 16 + 1 : 0;
#define CSCORE(a, buf, n0v, farv, refv) do { { const float ini_ = ((farv) ? cb : 0.f) - (refv); _Pragma("unroll") for (int r = 0; r < 16; ++r) a[r] = ini_; } \
        _Pragma("unroll") for (int ks = 0; ks < 4; ++ks) a = MFMA32(KFRAG(buf, ks), bq[ks], a); \
        if (!(farv)) { _Pragma("unroll") for (int r = 0; r < 16; ++r) { const int dist = t - (16 * ((n0v) + crow(r, hi)) + 31); const float bt = BT[h * 128 + min(max(dist, 0), 127)]; a[r] = dist >= 0 ? a[r] + bt : -1e30f; } } } while (0)
#define STAGE_PROLOGUE(Kp, kmax, VTp, gmax, nbase, ntl) v4u RA, RB; { RA = STAGE_LOAD(Kp, kmax, VTp, gmax, nbase); STAGE_WRITE(RA, 0); RB = STAGE_LOAD(Kp, kmax, VTp, gmax, (nbase) + 32 * min(1, (ntl) - 1)); __syncthreads(); }
    float mc = 0.f, lc = 0.f; bool stc = false;
    if (ntc > 0) {
        STAGE_PROLOGUE(P.KCB, 1023, P.VTC, 31, 0, ntc)
#define C1STEP(iv, BUF, RL, RW) { const int i = (iv); if (i >= ntc) break; const int n0 = 32 * i; RL = STAGE_LOAD(P.KCB, 1023, P.VTC, 31, 32 * min(i + 2, ntc - 1)); \
            const bool far = (n0 + 32 <= nfar); f32x16 a; CSCORE(a, BUF, n0, far, mc); \
            float d_, fs_; REF_EVENT(a, mc, stc, d_, fs_) lc *= fs_; \
            _Pragma("unroll") for (int r = 0; r < 16; ++r) a[r] = __builtin_amdgcn_exp2f(a[r]); \
            lc += xsum32(sum16(a)); STAGE_WRITE(RW, (BUF) ^ 1); __syncthreads(); }
        for (int ib = 0; ; ib += 2) { C1STEP(ib, 0, RA, RB) C1STEP(ib + 1, 1, RB, RA) }
#undef C1STEP
    }
    {   const float invl = 1.0f / fmaxf(lc, 1e-30f); f32x16 oc0 = {}, oc1 = {}; float carry = 0.f;
#define CIMP(a, n0v) do { float mq[4], cq[4]; \
            _Pragma("unroll") for (int qg = 0; qg < 4; ++qg) { float mv = (2.0f * (a[4 * qg] + a[4 * qg + 1] + a[4 * qg + 2]) + a[4 * qg + 3]) * invl, cv = a[4 * qg + 3] * invl; \
                mv += __int_as_float(DPPI(__float_as_int(mv), 0xB1)); mv += __int_as_float(DPPI(__float_as_int(mv), 0x4E)); \
                cv += __int_as_float(DPPI(__float_as_int(cv), 0xB1)); cv += __int_as_float(DPPI(__float_as_int(cv), 0x4E)); mq[qg] = mv; cq[qg] = cv; } \
            float oth[4]; \
            _Pragma("unroll") for (int qg = 0; qg < 4; ++qg) { auto rr = __builtin_amdgcn_permlane32_swap(__float_as_uint(cq[qg]), __float_as_uint(cq[qg]), false, false); oth[qg] = __uint_as_float(hi ? rr[0] : rr[1]); } \
            _Pragma("unroll") for (int qg = 0; qg < 4; ++qg) { const float tot = mq[qg] + (hi ? oth[qg] : (qg ? oth[qg - 1] : carry)); if (hr == 0) scores[ti * SCS + (((n0v) + 8 * qg + 4 * hi) >> 2)] = tot; } \
            carry = oth[3]; } while (0)
        if (ntc > 0) {
            STAGE_PROLOGUE(P.KCB, 1023, P.VTC, 31, 0, ntc)
#define C2STEP(iv, BUF, RL, RW) { const int i = (iv); if (i >= ntc) break; const int n0 = 32 * i; RL = STAGE_LOAD(P.KCB, 1023, P.VTC, 31, 32 * min(i + 2, ntc - 1)); \
                const bool far = (n0 + 32 <= nfar); f32x16 a; CSCORE(a, BUF, n0, far, mc); \
                _Pragma("unroll") for (int r = 0; r < 16; ++r) a[r] = __builtin_amdgcn_exp2f(a[r]); \
                CIMP(a, n0); PVACC(oc0, oc1, BUF, a); STAGE_WRITE(RW, (BUF) ^ 1); __syncthreads(); }
            for (int ib = 0; ; ib += 2) { C2STEP(ib, 0, RA, RB) C2STEP(ib + 1, 1, RB, RA) }
#undef C2STEP
            { const int jn = ntc * 8; if (jn < 256 && hi == 0 && hr == 0) scores[ti * SCS + jn] = carry; }
        }
#undef CIMP
        {   LAS unsigned char* park = lds + AT_PARK + (((8 * wave + ti) * 4 + hr) * 64) * 2;
            const float gs = g0 * invl;
#pragma unroll
            for (int d0 = 0; d0 < 2; ++d0)
#pragma unroll
                for (int r4 = 0; r4 < 4; ++r4) { const f32x16& Wd = d0 ? oc1 : oc0; const int dim = 32 * d0 + 8 * r4 + 4 * hi;
                    *(LAS unsigned long long*)(park + dim * 2) = (unsigned long long)cvt_pk_bf16(Wd[4 * r4] * gs, Wd[4 * r4 + 1] * gs) | ((unsigned long long)cvt_pk_bf16(Wd[4 * r4 + 2] * gs, Wd[4 * r4 + 3] * gs) << 32); } } }
#undef CSCORE
    {   float mw = 0.f, lw = 0.f; bool stw = false; f32x16 o0 = {}, o1 = {};
        const int nlo = max(t0 - 511, 0) & ~31, nhi = (t0 + 7) & ~31;
        const int nlb = max(tile0 - 511, 0) & ~31, ntw = (((tile0 + 63) & ~31) - nlb) / 32 + 1;
        STAGE_PROLOGUE(P.KW, S - 1, P.VTW, 511, nlb, ntw)
#define WSTEP(iv, BUF, RL, RW) { const int i = (iv); if (i >= ntw) break; const int n0 = nlb + 32 * i; RL = STAGE_LOAD(P.KW, S - 1, P.VTW, 511, nlb + 32 * min(i + 2, ntw - 1)); \
            if (n0 >= nlo && n0 <= nhi) { const bool mid = (n0 >= t0 - 504) && (n0 <= t0 - 144); \
                f32x16 a; { const float ini_ = (mid ? cb : 0.f) - mw; _Pragma("unroll") for (int r = 0; r < 16; ++r) a[r] = ini_; } \
                _Pragma("unroll") for (int ks = 0; ks < 4; ++ks) a = MFMA32(KFRAG(BUF, ks), bq[ks], a); \
                if (!mid) { _Pragma("unroll") for (int r = 0; r < 16; ++r) { const int dist = t - (n0 + crow(r, hi)); const float bt = BT[h * 128 + min(max(dist, 0), 127)]; a[r] = (dist >= 0 && dist < 512) ? a[r] + bt : -1e30f; } } \
                float d_, fs_; REF_EVENT(a, mw, stw, d_, fs_) if (fs_ != 1.f || d_ != 0.f) { lw *= fs_; o0 = o0 * fs_; o1 = o1 * fs_; } \
                _Pragma("unroll") for (int r = 0; r < 16; ++r) a[r] = __builtin_amdgcn_exp2f(a[r]); \
                lw += xsum32(sum16(a)); PVACC(o0, o1, BUF, a); } \
            STAGE_WRITE(RW, (BUF) ^ 1); __syncthreads(); }
        for (int ib = 0; ; ib += 2) { WSTEP(ib, 0, RA, RB) WSTEP(ib + 1, 1, RB, RA) }
#undef WSTEP
        const float sc = g2 / fmaxf(lw, 1e-30f);
        LAS unsigned char* park = lds + AT_PARK + (((8 * wave + ti) * 4 + hr) * 64) * 2;
#pragma unroll
        for (int d0 = 0; d0 < 2; ++d0)
#pragma unroll
            for (int r4 = 0; r4 < 4; ++r4) { const f32x16& Od = d0 ? o1 : o0; const int dim = 32 * d0 + 8 * r4 + 4 * hi; const unsigned long long w = *(const LAS unsigned long long*)(park + dim * 2); const unsigned lo = (unsigned)w, hw = (unsigned)(w >> 32);
                *(LAS unsigned long long*)(park + dim * 2) = (unsigned long long)cvt_pk_bf16(bflo(lo) + Od[4 * r4] * sc, bfhi(lo) + Od[4 * r4 + 1] * sc) | ((unsigned long long)cvt_pk_bf16(bflo(hw) + Od[4 * r4 + 2] * sc, bfhi(hw) + Od[4 * r4 + 3] * sc) << 32); } }
#undef REF_EVENT
#undef STAGE_PROLOGUE
#undef PVACC
#undef KFRAG
#undef VFRAG
#undef STAGE_LOAD
#undef STAGE_WRITE
    LDS_WAIT();
    {   const int cur = tile0 >> 6, i = lane >> 3, s8 = lane & 7;
        if (cur + 1 <= 16) { for (int e = lane; e < 8 * 16; e += 64) sel[e] = e & 15; }
        else {
            float sv[32];
#pragma unroll
            for (int k = 0; k < 32; ++k) { const int j = s8 + 8 * k; sv[k] = (j >= 1 && j <= cur - 2) ? scores[i * SCS + j] : -3e38f; }
            if (s8 == 0) { sel[i * 16 + 0] = 0; sel[i * 16 + 1] = cur - 1; sel[i * 16 + 2] = cur; }
            for (int it = 3; it < 16; ++it) {
                float bv = sv[0]; int bj = s8;
#pragma unroll
                for (int k = 1; k < 32; ++k) if (sv[k] > bv) { bv = sv[k]; bj = s8 + 8 * k; }
#define SEL_STEP(ctrl) { const float ov = __int_as_float(DPPI(__float_as_int(bv), ctrl)); const int oj = DPPI(bj, ctrl); if (ov > bv || (ov == bv && oj < bj)) { bv = ov; bj = oj; } }
                SEL_STEP(0xB1) SEL_STEP(0x4E) SEL_STEP(0x141)
#undef SEL_STEP
                if (s8 == 0) sel[i * 16 + it] = bj;
#pragma unroll
                for (int k = 0; k < 32; ++k) if (bj == s8 + 8 * k) sv[k] = -3e38f;
            }
        }
    }
}

__device__ __forceinline__ void s_scores(const bf16x8 (&kf)[8], const bf16x8 q0, const bf16x8 q1, bool cst, float cbs, const LAS float* BT, int hs, int tt, int j, int q, f32x4 (&sa)[4]) {
#pragma unroll
    for (int mt = 0; mt < 4; ++mt) { const float ini = cst ? cbs : 0.f; sa[mt] = (f32x4){ini, ini, ini, ini}; sa[mt] = MFMA16(kf[mt * 2], q0, sa[mt]); sa[mt] = MFMA16(kf[mt * 2 + 1], q1, sa[mt]); }
    if (!cst) {
#pragma unroll
        for (int mt = 0; mt < 4; ++mt)
#pragma unroll
            for (int r = 0; r < 4; ++r) { const int dist = tt - (64 * j + 16 * mt + 4 * q + r); const float bt = BT[hs * 128 + min(max(dist, 0), 127)]; sa[mt][r] = dist >= 0 ? sa[mt][r] + bt : -1e30f; } }
}
template <bool MASKED> __device__ __forceinline__ void s_softmax(f32x4 (&sa)[4], float& tm, float& ls) {
    tm = sa[0][0];
#pragma unroll
    for (int mt = 0; mt < 4; ++mt)
#pragma unroll
        for (int r = 0; r < 4; ++r) tm = fmaxf(tm, sa[mt][r]);
    tm = xmax32(xmax16(tm)); ls = 0.f;
#pragma unroll
    for (int mt = 0; mt < 4; ++mt)
#pragma unroll
        for (int r = 0; r < 4; ++r) { const float e = __builtin_amdgcn_exp2f(sa[mt][r] - tm); sa[mt][r] = (!MASKED || sa[mt][r] > -1e29f) ? e : 0.f; ls += sa[mt][r]; }
    ls = xsum32(xsum16(ls));
}
__device__ __forceinline__ void load_kf(const AttnPtrs& P, int lane, int j, bf16x8 (&kf)[8]) {
    const bf16* kp = P.KS + (size_t)(64 * j + (lane & 15)) * 64 + 8 * (lane >> 4);
#pragma unroll
    for (int mt = 0; mt < 4; ++mt) { kf[mt * 2] = *(const bf16x8*)(kp + (size_t)mt * 16 * 64); kf[mt * 2 + 1] = *(const bf16x8*)(kp + (size_t)mt * 16 * 64 + 32); }
}
__device__ __forceinline__ void load_vf(const AttnPtrs& P, int lane, int j, bf16x8 (&vf)[8]) {
    const bf16x8* vt = P.VTS + (size_t)j * 8 * 64 + lane;
#pragma unroll
    for (int e = 0; e < 8; ++e) vf[e] = vt[e * 64];
}
__device__ __forceinline__ void attn_stageB(const AttnPtrs& P, int lane, int wave, int tile0, int g, LAS unsigned char* lds, unsigned char* slab) {
    const int T = tile0 >> 6, c = lane & 15, q = lane >> 4, hd = c & 3, hs = g * 4 + hd;
    if (T <= 15) return;
    const LAS unsigned* cnt = (const LAS unsigned*)(lds + AT_CNT); const LAS unsigned short* list = (const LAS unsigned short*)(lds + AT_LIST); const LAS float* BT = (const LAS float*)(lds + AT_BT);
    const float cbs = BT[hs * 128 + 127];
#define NEXT_BLK(jv, nv) do { nv = 0; for (jv += 8; jv <= T - 2; jv += 8) { nv = (int)__builtin_amdgcn_readfirstlane((int)cnt[jv]); if (nv > 0) break; } } while (0)
    int jc = 1 + wave - 8, nc = 0; NEXT_BLK(jc, nc); if (jc > T - 2) return;
    int jn = jc, nn = 0; NEXT_BLK(jn, nn);
    bf16x8 kf[8], vf[8], kn[8];
    load_kf(P, lane, jc, kf); load_vf(P, lane, jc, vf);
    load_kf(P, lane, min(jn, T - 2), kn);
    int ch = 0;
    int sl; bool valid; bf16x8 q0, q1;
    { const int sidx = (c >> 2); valid = sidx < nc; sl = (int)list[jc * 64 + (valid ? sidx : 0)]; const int tt = tile0 + sl / 13;
      q0 = *(const bf16x8*)(P.Q + (size_t)tt * 512 + hs * 64 + 8 * q); q1 = *(const bf16x8*)(P.Q + (size_t)tt * 512 + hs * 64 + 32 + 8 * q); }
#pragma unroll 1
    for (;;) {
        const bool same = (ch + 1) * 4 < nc; const bool more = same || (jn <= T - 2);
        const int jx = same ? jc : min(jn, T - 2), chx = same ? ch + 1 : 0, nx = same ? nc : nn;
        int sln; bool validn; bf16x8 q0n, q1n;
        { const int sidx = 4 * chx + (c >> 2); validn = sidx < nx; sln = (int)list[jx * 64 + (validn ? sidx : 0)]; const int tt = tile0 + sln / 13;
          q0n = *(const bf16x8*)(P.Q + (size_t)tt * 512 + hs * 64 + 8 * q); q1n = *(const bf16x8*)(P.Q + (size_t)tt * 512 + hs * 64 + 32 + 8 * q); }
        {   const int tt = tile0 + sl / 13; const bool cst = (jc <= T - 3);
            f32x4 sa[4]; s_scores(kf, q0, q1, cst, cbs, BT, hs, tt, jc, q, sa);
            float tm, ls; s_softmax<false>(sa, tm, ls);
            const bf16x8 p0 = pack8(sa[0][0], sa[0][1], sa[0][2], sa[0][3], sa[1][0], sa[1][1], sa[1][2], sa[1][3]), p1 = pack8(sa[2][0], sa[2][1], sa[2][2], sa[2][3], sa[3][0], sa[3][1], sa[3][2], sa[3][3]);
            unsigned char* po = slab + ((size_t)(sl * 4 + hd) * 64 + 16 * q) * 2;
            unsigned pw[8];
#pragma unroll
            for (int dt = 0; dt < 4; ++dt) { f32x4 oa = {0.f, 0.f, 0.f, 0.f}; oa = MFMA16(vf[dt * 2], p0, oa); oa = MFMA16(vf[dt * 2 + 1], p1, oa); pw[2 * dt] = cvt_pk_bf16(oa[0], oa[1]); pw[2 * dt + 1] = cvt_pk_bf16(oa[2], oa[3]); }
            if (valid) { *(v4u*)po = (v4u){pw[0], pw[1], pw[2], pw[3]}; *(v4u*)(po + 16) = (v4u){pw[4], pw[5], pw[6], pw[7]}; }
            if (valid && q == 0) *(f32x2*)(slab + PML_OFF + (size_t)(sl * 4 + hd) * 8) = (f32x2){tm, ls}; }
        if (!more) break;
        if (!same) {
#pragma unroll
            for (int e = 0; e < 8; ++e) kf[e] = kn[e];
            jc = jn; nc = nn; load_vf(P, lane, jc, vf); NEXT_BLK(jn, nn);
            load_kf(P, lane, min(jn, T - 2), kn); }
        ch = chx; sl = sln; valid = validn; q0 = q0n; q1 = q1n;
    }
#undef NEXT_BLK
}
struct SState { float M, L; f32x4 O[4]; };
__device__ __forceinline__ void s_merge(SState& st, float m, float l, const f32x4 (&o)[4]) {
    const float mn = fmaxf(st.M, m), a0 = __builtin_amdgcn_exp2f(st.M - mn), a1 = __builtin_amdgcn_exp2f(m - mn);
    st.L = st.L * a0 + l * a1; st.M = mn;
#pragma unroll
    for (int dt = 0; dt < 4; ++dt) st.O[dt] = st.O[dt] * a0 + o[dt] * a1;
}
__device__ __forceinline__ void attn_stageC_forced(const AttnPtrs& P, int lane, int wave, int tile0, int g, LAS unsigned char* lds, SState (&st)[2]) {
    const int T = tile0 >> 6, c = lane & 15, q = lane >> 4, hd = c & 3, hs = g * 4 + hd; const LAS float* BT = (const LAS float*)(lds + AT_BT); const float cbs = BT[hs * 128 + 127];
    bf16x8 q0[2], q1[2];
#pragma unroll
    for (int k = 0; k < 2; ++k) { const int tt = tile0 + 8 * wave + 4 * k + (c >> 2); q0[k] = *(const bf16x8*)(P.Q + (size_t)tt * 512 + hs * 64 + 8 * q); q1[k] = *(const bf16x8*)(P.Q + (size_t)tt * 512 + hs * 64 + 32 + 8 * q);
        st[k].M = -1e30f; st[k].L = 0.f;
#pragma unroll
        for (int dt = 0; dt < 4; ++dt) st[k].O[dt] = (f32x4){0.f, 0.f, 0.f, 0.f}; }
    const int nf = T <= 15 ? T + 1 : 3;
    auto fblk = [&](int it) -> int { return T <= 15 ? it : (it == 0 ? 0 : (it == 1 ? T - 1 : T)); };
    bf16x8 kf[8], vf[8]; load_kf(P, lane, fblk(0), kf); load_vf(P, lane, fblk(0), vf);
#pragma unroll 1
    for (int it = 0; it < nf; ++it) { const int j = fblk(it);
        bf16x8 kn[8]; load_kf(P, lane, fblk(min(it + 1, nf - 1)), kn);
        const bool cst = (j <= T - 3);
#pragma unroll
        for (int k = 0; k < 2; ++k) { const int tt = tile0 + 8 * wave + 4 * k + (c >> 2);
            f32x4 sa[4]; s_scores(kf, q0[k], q1[k], cst, cbs, BT, hs, tt, j, q, sa);
            float tm, ls; s_softmax<true>(sa, tm, ls);
            const bf16x8 p0 = pack8(sa[0][0], sa[0][1], sa[0][2], sa[0][3], sa[1][0], sa[1][1], sa[1][2], sa[1][3]), p1 = pack8(sa[2][0], sa[2][1], sa[2][2], sa[2][3], sa[3][0], sa[3][1], sa[3][2], sa[3][3]);
            f32x4 ob[4];
#pragma unroll
            for (int dt = 0; dt < 4; ++dt) { ob[dt] = (f32x4){0.f, 0.f, 0.f, 0.f}; ob[dt] = MFMA16(vf[dt * 2], p0, ob[dt]); ob[dt] = MFMA16(vf[dt * 2 + 1], p1, ob[dt]); }
            s_merge(st[k], tm, ls, ob); }
#pragma unroll
        for (int e = 0; e < 8; ++e) kf[e] = kn[e];
        if (it + 1 < nf) load_vf(P, lane, fblk(it + 1), vf);
    }
}
__device__ __forceinline__ void attn_stageC_merge(const AttnPtrs& P, int lane, int wave, int tile0, int g, LAS unsigned char* lds, const unsigned char* slab, SState (&st)[2]) {
    const int T = tile0 >> 6, c = lane & 15, q = lane >> 4, hd = c & 3, hs = g * 4 + hd;
#pragma unroll
    for (int k = 0; k < 2; ++k) { const int tok = 8 * wave + 4 * k + (c >> 2), tt = tile0 + tok;
        if (T > 15) {
#pragma unroll
            for (int b0 = 0; b0 < 13; b0 += 7) {
                f32x2 mlv[7]; v4u ow[7][2];
#pragma unroll
                for (int bb = 0; bb < 7; ++bb) if (b0 + bb < 13) { const int sl = tok * 13 + b0 + bb;
                    mlv[bb] = *(const f32x2*)(slab + PML_OFF + (size_t)(sl * 4 + hd) * 8);
                    const unsigned char* po = slab + ((size_t)(sl * 4 + hd) * 64 + 16 * q) * 2; ow[bb][0] = *(const v4u*)po; ow[bb][1] = *(const v4u*)(po + 16); }
#pragma unroll
                for (int bb = 0; bb < 7; ++bb) if (b0 + bb < 13) { f32x4 ob[4];
                    ob[0] = (f32x4){bflo(ow[bb][0].x), bfhi(ow[bb][0].x), bflo(ow[bb][0].y), bfhi(ow[bb][0].y)}; ob[1] = (f32x4){bflo(ow[bb][0].z), bfhi(ow[bb][0].z), bflo(ow[bb][0].w), bfhi(ow[bb][0].w)};
                    ob[2] = (f32x4){bflo(ow[bb][1].x), bfhi(ow[bb][1].x), bflo(ow[bb][1].y), bfhi(ow[bb][1].y)}; ob[3] = (f32x4){bflo(ow[bb][1].z), bfhi(ow[bb][1].z), bflo(ow[bb][1].w), bfhi(ow[bb][1].w)};
                    s_merge(st[k], mlv[bb].x, mlv[bb].y, ob); } } }
        const float g1 = bf2f(P.GN[(size_t)tt * 32 + hs * 3 + 1]) / fmaxf(st[k].L, 1e-30f);
        LAS unsigned char* park = lds + AT_PARK + ((tok * 4 + hd) * 64 + 4 * q) * 2;
#pragma unroll
        for (int dt = 0; dt < 4; ++dt) { const unsigned long long w = *(const LAS unsigned long long*)(park + dt * 32); const unsigned lo = (unsigned)w, hw = (unsigned)(w >> 32);
            const unsigned o0 = cvt_pk_bf16(bflo(lo) + g1 * st[k].O[dt][0], bfhi(lo) + g1 * st[k].O[dt][1]), o1 = cvt_pk_bf16(bflo(hw) + g1 * st[k].O[dt][2], bfhi(hw) + g1 * st[k].O[dt][3]);
            *(LAS unsigned long long*)(park + dt * 32) = (unsigned long long)o0 | ((unsigned long long)o1 << 32); } }
    LDS_WAIT();
#pragma unroll
    for (int e = 0; e < 4; ++e) { const int idx = lane + 64 * e, tokl = idx >> 5, piece = idx & 31;
        *(v4u*)((unsigned char*)P.O + (size_t)(tile0 + 8 * wave + tokl) * 1024 + g * 512 + piece * 16) = *(const LAS v4u*)(lds + AT_PARK + (8 * wave + tokl) * 512 + piece * 16); }
    LDS_WAIT();
}
__device__ __forceinline__ void attn_tile(const Frame& F, unsigned char* ws, int tile, int g, unsigned soff) {
    int lane = F.lane; asm volatile("" : "+v"(lane));
    const int wave = F.wave, tile0 = tile * 64, T = tile; LAS unsigned char* lds = F.lds;
    if (F.tid < 256) ((LAS unsigned*)(lds + AT_CNT))[F.tid] = 0u;
    AttnPtrs P;
    {   const bf16* KVH = (const bf16*)(ws + WS_KVH);
        P.Q = (const bf16*)(ws + WS_Q); P.KCB = (const bf16*)(ws + WS_KCB) + (size_t)g * 1024 * 64; P.VTC = (const bf16x8*)(ws + WS_VTC) + (size_t)g * 32 * 4 * 64;
        P.KW = KVH + (size_t)(8 + g) * S * 64; P.VTW = (const bf16x8*)(ws + WS_VTW) + (size_t)g * 512 * 4 * 64; P.GN = (const bf16*)(ws + WS_GN);
        P.KS = nullptr; P.VTS = nullptr; P.O = nullptr; }
    attn_stageA(P, lane, wave, tile0, g, lds);
    __syncthreads();
    unsigned char* ws2 = ws;
    {   const bf16* KVH = (const bf16*)(ws2 + WS_KVH);
        P.Q = (const bf16*)(ws2 + WS_Q); P.KS = KVH + (size_t)(4 + g) * S * 64; P.VTS = (const bf16x8*)(ws2 + WS_VTS) + (size_t)g * 256 * 8 * 64; P.GN = (const bf16*)(ws2 + WS_GN); P.O = (bf16*)(ws2 + WS_O);
        P.KCB = nullptr; P.VTC = nullptr; P.KW = nullptr; P.VTW = nullptr; }
    unsigned char* slab = ((blockIdx.x < 128) ? (unsigned char*)F.out : ws2 + WS_PSLAB) + soff;
    if (T > 15) {
        LAS unsigned* cnt = (LAS unsigned*)(lds + AT_CNT); LAS unsigned short* list = (LAS unsigned short*)(lds + AT_LIST); const LAS int* sel = (const LAS int*)(lds + AT_SEL);
        const int tok = F.tid >> 3;
#pragma unroll
        for (int e = 0; e < 2; ++e) { const int b = (F.tid & 7) * 2 + e;
            if (b >= 3) { const int j = sel[tok * 16 + b]; const unsigned pos = __hip_atomic_fetch_add(&cnt[j], 1u, __ATOMIC_RELAXED, __HIP_MEMORY_SCOPE_WORKGROUP); list[j * 64 + pos] = (unsigned short)(tok * 13 + b - 3); } }
        __syncthreads(); }
    attn_stageB(P, lane, wave, tile0, g, lds, slab);
    SState st[2];
    attn_stageC_forced(P, lane, wave, tile0, g, lds, st);
    asm volatile("s_waitcnt vmcnt(0)" ::: "memory");
    __syncthreads();
    __builtin_amdgcn_fence(__ATOMIC_ACQUIRE, "agent");
    attn_stageC_merge(P, lane, wave, tile0, g, lds, slab, st);
    __syncthreads();
}

#define XB_TMO      128
#define XB_XCNT(j)  (256  + 64 * (j))
#define XB_XSUB(j)  (1280 + 64 * (j))
#define XB_XGEN(j)  (2304 + 64 * (j))
#define XB_TOP      3328
#define XB_TOPGEN   3392
#define XCD_BAR_WORDS 3456
#define XB_SPIN_CAP (1u << 22)
__device__ __forceinline__ unsigned xb_ld(unsigned* p)              { return __hip_atomic_load(p, __ATOMIC_RELAXED, __HIP_MEMORY_SCOPE_AGENT); }
__device__ __forceinline__ unsigned xb_add(unsigned* p, unsigned v) { return __hip_atomic_fetch_add(p, v, __ATOMIC_RELAXED, __HIP_MEMORY_SCOPE_AGENT); }
__device__ __forceinline__ unsigned xb_xcc_id() { return (unsigned)__builtin_amdgcn_s_getreg((3 << 11) | 20) & 0xFu; }
#define XB_SPIN(cond, bar) do { unsigned _sp = 0; while (cond) { __builtin_amdgcn_s_sleep(1); \
    if ((++_sp & 255u) == 0u) { if (xb_ld(&(bar)[XB_TMO])) break; if (_sp > XB_SPIN_CAP) { atomicAdd(&(bar)[XB_TMO], 1u); break; } } } } while (0)
struct XcdBarrier { unsigned* bar; unsigned x; volatile LAS unsigned* st; };
__device__ __forceinline__ XcdBarrier xcd_barrier_post(unsigned* bar, volatile LAS unsigned* st) {
    XcdBarrier b; b.bar = bar; b.x = xb_xcc_id(); b.st = st;
    if (threadIdx.x == 0) (void)xb_add(&bar[XB_XCNT(b.x)], 1u);
    return b;
}
__device__ __forceinline__ void xcd_barrier_complete(unsigned* bar, unsigned x, unsigned& nloc, unsigned& nx) {
    const unsigned G = gridDim.x * gridDim.y * gridDim.z;
    unsigned sum, cnt, mine, sp = 0u;
    for (;;) {
        sum = 0u; cnt = 0u; mine = 0u;
#pragma unroll
        for (unsigned j = 0; j < 16; ++j) { const unsigned c = xb_ld(&bar[XB_XCNT(j)]); sum += c; cnt += (c > 0u) ? 1u : 0u; mine = (j == x) ? c : mine; }
        if (sum == G) break;
        __builtin_amdgcn_s_sleep(1);
        if ((++sp & 255u) == 0u) { if (xb_ld(&bar[XB_TMO])) break; if (sp > XB_SPIN_CAP) { atomicAdd(&bar[XB_TMO], 1u); break; } }
    }
    nloc = mine > 0u ? mine : 1u; nx = cnt > 0u ? cnt : 1u;
}
__device__ __forceinline__ void xcd_barrier(const XcdBarrier& b) {
    asm volatile("s_waitcnt vmcnt(0)" ::: "memory");
    __syncthreads();
    if (threadIdx.x == 0) {
        unsigned* bar = b.bar;
        __builtin_amdgcn_s_waitcnt(0);
        unsigned nloc = b.st[0], nx = b.st[1];
        if (nloc == 0u) { xcd_barrier_complete(bar, b.x, nloc, nx); b.st[0] = nloc; b.st[1] = nx; }
        const unsigned old = xb_add(&bar[XB_XSUB(b.x)], 1u);
        const unsigned gen = old / nloc;
        if (old + 1u == (gen + 1u) * nloc) {
            __builtin_amdgcn_fence(__ATOMIC_RELEASE, "agent");
            asm volatile("s_waitcnt vmcnt(0)" ::: "memory");
            const unsigned og = xb_add(&bar[XB_TOP], 1u);
            const unsigned tg = og / nx;
            if (og + 1u == (tg + 1u) * nx) xb_add(&bar[XB_TOPGEN], 1u);
            else XB_SPIN(xb_ld(&bar[XB_TOPGEN]) == tg, bar);
            __builtin_amdgcn_fence(__ATOMIC_ACQUIRE, "agent");
            xb_add(&bar[XB_XGEN(b.x)], 1u);
            asm volatile("s_waitcnt vmcnt(0)" ::: "memory");
        } else {
            XB_SPIN(xb_ld(&bar[XB_XGEN(b.x)]) == gen, bar);
            __builtin_amdgcn_fence(__ATOMIC_ACQUIRE, "agent");
            asm volatile("s_waitcnt vmcnt(0)" ::: "memory");
        }
    }
    __syncthreads();
}

__global__ void __launch_bounds__(NWAVES * 64, 2) mk_fwd(Args args) {
    extern __shared__ __attribute__((aligned(16))) unsigned char lds_raw[];
    Frame F;
    F.lds = (LAS unsigned char*)lds_raw;
#define REFRESH() do { int t_ = threadIdx.x; asm volatile("" : "+v"(t_)); F.tid = t_; F.lane = t_ & 63; F.wave = __builtin_amdgcn_readfirstlane(t_ >> 6); F.gw = blockIdx.x * NWAVES + F.wave; } while (0)
    F.G = gridDim.x; F.ngw = F.G * NWAVES; REFRESH();
    F.out = args.out; F.ws = args.ws;
    const int lo = args.ph_lo, hi = args.ph_hi;
#define IN(k) (lo <= (k) && (k) < hi)
#ifndef USE_CG_SYNC
#define USE_CG_SYNC 0
#endif
    volatile LAS unsigned* bst = (volatile LAS unsigned*)(F.lds + LDS_BYTES - 64);
    if (F.tid < 16) bst[F.tid] = 0u;
    __syncthreads();
    XcdBarrier gbar; gbar.bar = (unsigned*)(F.ws + WS_CTL); gbar.x = 0; gbar.st = bst;
    if (!USE_CG_SYNC && hi - lo > 1) gbar = xcd_barrier_post((unsigned*)(F.ws + WS_CTL), bst);
#define SEAM(k) do { if (IN(k) && IN((k) + 1)) { if (USE_CG_SYNC) cg::this_grid().sync(); else xcd_barrier(gbar); } } while (0)
    unsigned char* ws = F.ws;
    if (IN(0)) { REFRESH(); p0_prologue(F, args); }
    SEAM(0);
    if (IN(1)) { REFRESH();
        pg8::Gemm g{(const bf16*)(ws + WS_XN), (const bf16*)(ws + WS_WIN), S, NPJ, 1024, 1024}; pg8::StaticOrder So; So.init(S, NPJ, F.G, (int)blockIdx.x);
        EpiProj E{(bf16*)(ws + WS_U), (bf16*)(ws + WS_Q), (bf16*)(ws + WS_KVH), (bf16*)(ws + WS_G), (bf16*)(ws + WS_GN)};
        pg8::gemm_phase<EpiProj, pg8::StaticOrder>(F.lds, g, So, E);
    }
    SEAM(1);
    if (IN(2)) { REFRESH();
        for (int u = F.gw; u < 64 * 32; u += F.ngw) s5_unit<false>(F, args, u >> 5, u & 31, F.lds + F.wave * 16384, F.lds + 131072 + F.wave * 2048);
        __syncthreads();
        pg8::Gemm g{(const bf16*)(ws + WS_KVH), (const bf16*)(ws + WS_WC1), 4096, 1024, 1024 / CMP_KS, 1024}; pg8::CmpOrder So{F.G, (int)blockIdx.x, CMP_KS};
        EpiCmp E{F.out};
        pg8::gemm_phase<EpiCmp, pg8::CmpOrder>(F.lds, g, So, E);
    }
    SEAM(2);
    if (IN(3)) { REFRESH();
        for (int u = F.gw; u < 64 * 32; u += F.ngw) s5_unit<true>(F, args, u >> 5, u & 31, F.lds + F.wave * 16384, F.lds + 131072 + F.wave * 2048);
        for (int u0 = 0; u0 < 4 * 1024; u0 += F.ngw) { const int u = u0 + F.gw; const int kvb = (u0 + (int)blockIdx.x * NWAVES) >> 11;
            __syncthreads();
            { const float* w2 = kvb ? args.in[18] : args.in[16]; LAS f32x4* wd = (LAS f32x4*)(F.lds + 8 * 2048); for (int e = F.tid; e < 256 * 64 / 4; e += NWAVES * 64) wd[e] = ((const f32x4*)w2)[e]; }
            __syncthreads();
            if (u < 4 * 1024) { const int kvg = u >> 10, n = u & 1023; cmp_l2_unit(F, args, kvg >> 1, kvg & 1, n, (LAS float*)(F.lds + F.wave * 2048), (const LAS float*)(F.lds + 8 * 2048)); } }
        __syncthreads();
        for (int u = F.gw; u < 2 * 512; u += F.ngw) vtw_item(F, u >> 9, u & 511, (LAS unsigned short*)(F.lds + 81920 + F.wave * 8192));
        for (int u = F.gw; u < 2 * 256; u += F.ngw) vts_item(F, u >> 8, u & 255, (LAS unsigned short*)(F.lds + 81920 + F.wave * 8192));
    }
    SEAM(3);
    if (IN(4)) { REFRESH();
        LAS float* BT = (LAS float*)(F.lds + AT_BT);
        for (int i = F.tid; i < 8 * 128; i += NWAVES * 64) { const int h = i >> 7, d = i & 127;
            int bk = d; if (d >= 16) { bk = 16 + (int)(logf((float)d * (1.0f / 16.0f)) / 2.0794415416798357f * 16.0f); if (bk > 31) bk = 31; }
            BT[i] = args.in[19][bk * 8 + h] * 1.4426950408889634f; }
        __syncthreads();
        for (int u = blockIdx.x; u < 256; u += F.G) {
#pragma unroll 1
            for (int g = 0; g < 2; ++g) { const int ta = ((u & 7) << 5) | (u >> 3);
                const int tile = g ? 255 - ta : ta;
                const unsigned soff = (unsigned)__builtin_amdgcn_readfirstlane((int)((blockIdx.x & 127u) * (unsigned)PSLAB));
                attn_tile(F, ws, tile, g, soff); } }
    }
    SEAM(4);
    if (IN(5)) { REFRESH();
        pg8::Gemm g{(const bf16*)(ws + WS_Z), (const bf16*)(ws + WS_WGLU), S, 512, 512, 512}; pg8::StaticOrder So; So.init(S, 512, F.G, (int)blockIdx.x);
        EpiGlu E{(const bf16*)(ws + WS_Z), (bf16*)(ws + WS_ZG)};
        pg8::gemm_phase<EpiGlu, pg8::StaticOrder>(F.lds, g, So, E);
    }
    SEAM(5);
    if (IN(6)) { REFRESH();
        pg8::TwoSegOrder So; So.init(S, 1024, F.G, (int)blockIdx.x);
        pg8::Gemm g{(const bf16*)(ws + WS_ZG), (const bf16*)(ws + WS_WA), S, 1024, 512, 512, (const bf16*)(ws + WS_O), (const bf16*)(ws + WS_WB)}; EpiMix2 E{(const bf16*)(ws + WS_G), (bf16*)(ws + WS_MIX)};
        pg8::gemm_phase<EpiMix2, pg8::TwoSegOrder>(F.lds, g, So, E);
    }
    SEAM(6);
    if (IN(7)) { REFRESH();
        pg8::Gemm g{(const bf16*)(ws + WS_MIX), (const bf16*)(ws + WS_WOUT), S, 1024, 1024, 1024}; pg8::StaticOrder So; So.init(S, 1024, F.G, (int)blockIdx.x);
        EpiResNorm E{args.in[0], F.out, (bf16*)(ws + WS_XN), (float*)(ws + WS_SSP), (LAS float*)(F.lds + pg8::STAGE_BYTES)};
        pg8::gemm_phase<EpiResNorm, pg8::StaticOrder>(F.lds, g, So, E);
    }
    SEAM(7);
    if (IN(9)) { REFRESH();
        pg8::Gemm g{(const bf16*)(ws + WS_XN), (const bf16*)(ws + WS_WGU), S, 2 * DFF, 1024, 1024}; pg8::StaticOrder So; So.init(S, 2 * DFF, F.G, (int)blockIdx.x);
        EpiFfn E{(bf16*)(ws + WS_H), (const float*)(ws + WS_SSP)};
        pg8::gemm_phase<EpiFfn, pg8::StaticOrder>(F.lds, g, So, E);
    }
    SEAM(9);
    if (IN(10)) { REFRESH();
        pg8::Gemm g{(const bf16*)(ws + WS_H), (const bf16*)(ws + WS_WD), S, 1024, DFF, DFF}; pg8::StaticOrder So; So.init(S, 1024, F.G, (int)blockIdx.x);
        EpiRes E{F.out, F.out};
        pg8::gemm_phase<EpiRes, pg8::StaticOrder>(F.lds, g, So, E);
    }
    SEAM(10);
    if (IN(11)) { REFRESH(); for (int m = F.gw; m < S; m += F.ngw) rms_row_f32(F.out + (size_t)m * DM, args.in[26], F.lane); }
#undef IN
#undef SEAM
}

extern "C" void kernel_launch(void* const* d_in, const int* in_sizes, int n_in, void* d_out, int out_size, void* d_ws, size_t ws_size, hipStream_t stream) {
    static int grid = 0;
    if (grid == 0) {
        if (n_in != 27 || out_size != S * DM || ws_size < WS_END) { fprintf(stderr, "kernel_launch: unexpected shapes (n_in %d out %d ws %zu)\n", n_in, out_size, ws_size); grid = -1; return; }
        int dev = 0, cus = 0, per_cu = 0;
        if (hipGetDevice(&dev) != hipSuccess || hipDeviceGetAttribute(&cus, hipDeviceAttributeMultiprocessorCount, dev) != hipSuccess) { grid = -1; return; }
        if (hipFuncSetAttribute((const void*)mk_fwd, hipFuncAttributeMaxDynamicSharedMemorySize, LDS_BYTES) != hipSuccess) { fprintf(stderr, "kernel_launch: hipFuncSetAttribute failed\n"); grid = -1; return; }
        if (hipOccupancyMaxActiveBlocksPerMultiprocessor(&per_cu, (const void*)mk_fwd, NWAVES * 64, LDS_BYTES) != hipSuccess || per_cu < 1) { fprintf(stderr, "kernel_launch: occupancy query says %d\n", per_cu); per_cu = 1; }
        (void)hipGetLastError();
        grid = cus * (per_cu < 1 ? 1 : 1);
    }
    if (grid < 0) return;
    if (hipMemsetAsync((char*)d_ws + WS_CTL, 0, 16384, stream) != hipSuccess) { fprintf(stderr, "kernel_launch: hipMemsetAsync failed\n"); return; }
    Args a{};
    for (int i = 0; i < 27; ++i) a.in[i] = (const float*)d_in[i];
    a.out = (float*)d_out; a.ws = (unsigned char*)d_ws;
    if (MK_N_LAUNCHES == 1) {
        a.ph_lo = 0; a.ph_hi = NPH;
        void* kargs[] = {&a};
        hipError_t e = hipLaunchCooperativeKernel((const void*)mk_fwd, dim3(grid), dim3(NWAVES * 64), kargs, LDS_BYTES, stream);
        if (e != hipSuccess) fprintf(stderr, "kernel_launch: cooperative launch failed: %s (grid %d)\n", hipGetErrorString(e), grid);
    } else {
        for (int ph = 0; ph < NPH; ++ph) { a.ph_lo = ph; a.ph_hi = ph + 1; hipLaunchKernelGGL(mk_fwd, dim3(grid), dim3(NWAVES * 64), LDS_BYTES, stream, a); }
    }
}
```

```cpp
#include <hip/hip_runtime.h>
#include <hip/hip_cooperative_groups.h>
#include <cstdio>
#include <cstdint>
namespace cg = cooperative_groups;

#ifndef MK_N_LAUNCHES
#define MK_N_LAUNCHES 1
#endif

namespace pg8 {
#define PG8_LAS __attribute__((address_space(3)))
typedef unsigned short bf16_t;
typedef short bf16x8 __attribute__((ext_vector_type(8)));
typedef float f32x4 __attribute__((ext_vector_type(4)));
typedef unsigned u32x4 __attribute__((ext_vector_type(4)));
constexpr int BM = 256, BK = 64, HALF = 128, HTB = HALF * BK * 2, STAGE_BYTES = 8 * HTB, NXCD = 8, WGM = 8;

__host__ __device__ __forceinline__ int lds_byte(int r, int c) { const int st = (r >> 4) * 2 + (c >> 5), rr = r & 15, cc = c & 31, ob = rr * 64 + cc * 2; return st * 1024 + (ob ^ (((ob >> 9) & 1) << 5)); }
__host__ __device__ __forceinline__ void stage_rc(int b, int& R, int& C) { const int st = b / 1024, sb = b % 1024, swz = sb ^ (((sb >> 9) & 1) << 5); R = (st >> 1) * 16 + swz / 64; C = (st & 1) * 32 + (swz % 64) / 2; }
__host__ __device__ __forceinline__ int perm32(int rho) { const int n = rho >> 4, i = rho & 15; return 8 * (i >> 2) + 4 * n + (i & 3); }

struct Unit { int pm, pn, ks, seg; };
struct Gemm { const bf16_t* A; const bf16_t* Bt; int M, N, K, ld; const bf16_t* A2; const bf16_t* Bt2; };

struct StaticOrder {
    static constexpr bool SINGLE = false;
    int nM, nN, nwg, G, c;
    __host__ __device__ void init(int M, int N, int G_, int c_) { nM = M / BM; nN = N / BM; nwg = nM * nN; G = G_; c = c_; }
    __host__ __device__ bool next(int i, Unit& u) const {
        const long L = (long)i * G + c; if (L >= nwg) return false;
        int wgid = (int)L; { const int q = nwg / NXCD, r = nwg % NXCD, xcd = wgid % NXCD, off = wgid / NXCD; wgid = (xcd < r ? xcd * (q + 1) : r * (q + 1) + (xcd - r) * q) + off; }
        const int nig = WGM * nN, gid = wgid / nig, fm = gid * WGM, gsz = (nM - fm) < WGM ? (nM - fm) : WGM;
        u.pm = fm + ((wgid % nig) % gsz); u.pn = (wgid % nig) / gsz; u.ks = 0; u.seg = 0; return true;
    }
};
struct TwoSegOrder : StaticOrder {
    __host__ __device__ bool next(int i, Unit& u) const { if (!StaticOrder::next(i >> 1, u)) return false; u.seg = i & 1; return true; }
};
struct CmpOrder {
    static constexpr bool SINGLE = true;
    int G, c, KS;
    __host__ __device__ bool next(int i, Unit& u) const {
        const int L = i * G + c; if (L >= 32 * KS) return false;
        const int tile = L / KS; u.ks = L % KS; u.pm = tile >> 1; u.pn = (tile & 1) + (u.pm >= 8 ? 2 : 0); u.seg = 0; return true;
    }
};

typedef float f32x2_t __attribute__((ext_vector_type(2))); typedef __bf16 bf16x2_t __attribute__((ext_vector_type(2)));
__device__ __forceinline__ unsigned cvt_pk_bf16(float lo, float hi) { f32x2_t v = {lo, hi}; bf16x2_t b = __builtin_convertvector(v, bf16x2_t); return __builtin_bit_cast(unsigned, b); }
__device__ __forceinline__ float bflo(unsigned w) { return __uint_as_float(w << 16); }
__device__ __forceinline__ float bfhi(unsigned w) { return __uint_as_float(w & 0xffff0000u); }
__device__ __forceinline__ float sigm(float x) { return __builtin_amdgcn_rcpf(1.0f + __expf(-x)); }

template <class Epi, class Sched>
__device__ __forceinline__ void gemm_phase(PG8_LAS unsigned char* lds, const Gemm g, const Sched& S, const Epi& E) {
    const int tid = threadIdx.x, wid = __builtin_amdgcn_readfirstlane(tid >> 6), lane = tid & 63, wr = wid >> 2, wc = wid & 3, fr = lane & 15, fq = lane >> 4;
    const int K = g.K, ld = g.ld, nt = K / BK;
    unsigned voffA[2], voffB[2];
#pragma unroll
    for (int i = 0; i < 2; ++i) { int R, C; stage_rc(tid * 16 + i * 8192, R, C); const int Rb = Epi::PERM ? ((R & ~31) + perm32(R & 31)) : R;
        voffA[i] = (unsigned)(R * ld + C) * 2u; voffB[i] = (unsigned)(Rb * ld + C) * 2u; }
    const size_t kstep = (size_t)(BK * 2);
    const size_t hstep = (size_t)HALF * ld * 2;
    const size_t tstep = 2 * hstep;
    const unsigned ldsw = (unsigned)wid * 1024u;
    const int aoff = lds_byte(wr * 64 + fr, fq * 8), boff = lds_byte(wc * 32 + fr, fq * 8);
#define PG8_SA(b, h) (((b) * 2 + (h)) * HTB)
#define PG8_SB(b, h) ((4 + (b) * 2 + (h)) * HTB)
#define PG8_STAGE(bufoff, gbase, voff) do { _Pragma("unroll") for (int _i = 0; _i < 2; ++_i) \
        __builtin_amdgcn_global_load_lds((const unsigned*)((const char*)(gbase) + (voff)[_i]), (PG8_LAS unsigned*)(lds + (bufoff) + ldsw + _i * 8192), 16, 0, 0); } while (0)
#define PG8_LDA(dst, b, h) do { _Pragma("unroll") for (int m = 0; m < 4; ++m) _Pragma("unroll") for (int k = 0; k < 2; ++k) dst[m][k] = *(const PG8_LAS bf16x8*)(lds + PG8_SA(b, h) + aoff + m * 2048 + k * 1024); } while (0)
#define PG8_LDB(dst, b, h) do { _Pragma("unroll") for (int n = 0; n < 2; ++n) _Pragma("unroll") for (int k = 0; k < 2; ++k) dst[n][k] = *(const PG8_LAS bf16x8*)(lds + PG8_SB(b, h) + boff + n * 2048 + k * 1024); } while (0)
#define PG8_MMA(ai, bj, At, Bt) do { __builtin_amdgcn_s_setprio(1); _Pragma("unroll") for (int m = 0; m < 4; ++m) _Pragma("unroll") for (int n = 0; n < 2; ++n) _Pragma("unroll") for (int k = 0; k < 2; ++k) \
        acc[ai][bj][m][n] = __builtin_amdgcn_mfma_f32_16x16x32_bf16(Bt[n][k], At[m][k], acc[ai][bj][m][n], 0, 0, 0); __builtin_amdgcn_s_setprio(0); } while (0)
#define PG8_WAIT_V(n) asm volatile("s_waitcnt vmcnt(" #n ")" ::: "memory")
#define PG8_WAIT_L(n) asm volatile("s_waitcnt lgkmcnt(" #n ")" ::: "memory")
#define PG8_BAR __builtin_amdgcn_s_barrier()
#define PG8_SCHED __builtin_amdgcn_sched_barrier(0)
    Unit cur, nxt; int ui = 0;
    if (!S.next(0, cur)) return;
    f32x4 acc[2][2][4][2];
#pragma unroll
    for (int a = 0; a < 2; ++a)
#pragma unroll
        for (int b = 0; b < 2; ++b)
#pragma unroll
            for (int m = 0; m < 4; ++m)
#pragma unroll
                for (int n = 0; n < 2; ++n) acc[a][b][m][n] = (f32x4){0.f, 0.f, 0.f, 0.f};
    bf16x8 At[4][2], B0[2][2], B1[2][2];
    const char* cA = (const char*)(cur.seg ? g.A2 : g.A) + (size_t)cur.pm * tstep + (size_t)cur.ks * K * 2; const char* cB = (const char*)(cur.seg ? g.Bt2 : g.Bt) + (size_t)cur.pn * tstep + (size_t)cur.ks * K * 2;
    PG8_STAGE(PG8_SB(0, 0), cB, voffB); PG8_STAGE(PG8_SB(0, 1), cB + hstep, voffB); PG8_STAGE(PG8_SA(0, 0), cA, voffA); PG8_STAGE(PG8_SA(0, 1), cA + hstep, voffA);
    if (wr == 1) PG8_BAR;
    PG8_WAIT_V(2); PG8_BAR;
    PG8_STAGE(PG8_SB(1, 0), cB + kstep, voffB); PG8_STAGE(PG8_SA(1, 0), cA + kstep, voffA); PG8_STAGE(PG8_SB(1, 1), cB + hstep + kstep, voffB);
    PG8_WAIT_V(6); PG8_BAR;
    for (;;) {
        const bool has_next = Sched::SINGLE ? false : S.next(ui + 1, nxt);
        const char* nA = has_next ? (const char*)(nxt.seg ? g.A2 : g.A) + (size_t)nxt.pm * tstep + (size_t)nxt.ks * K * 2 : cA; const char* nB = has_next ? (const char*)(nxt.seg ? g.Bt2 : g.Bt) + (size_t)nxt.pn * tstep + (size_t)nxt.ks * K * 2 : cB;
        for (int t = 0; t < nt; t += 2) {
            const bool last = (t == nt - 2);
            const char* a1 = cA + (size_t)(t + 1) * kstep;
            const char* a2 = last ? nA : cA + (size_t)(t + 2) * kstep; const char* b2 = last ? nB : cB + (size_t)(t + 2) * kstep;
            const char* a3 = a2 + kstep; const char* b3 = b2 + kstep;
            PG8_LDB(B0, 0, 0); PG8_LDB(B1, 0, 1); PG8_SCHED; PG8_LDA(At, 0, 0); PG8_STAGE(PG8_SA(1, 1), a1 + hstep, voffA);
            PG8_WAIT_V(8); PG8_WAIT_L(0); PG8_BAR; PG8_MMA(0, 0, At, B0); PG8_MMA(0, 1, At, B1); PG8_BAR; PG8_SCHED;
            PG8_LDA(At, 0, 1); PG8_STAGE(PG8_SB(0, 0), b2, voffB); PG8_STAGE(PG8_SB(0, 1), b2 + hstep, voffB); PG8_STAGE(PG8_SA(0, 0), a2, voffA);
            PG8_WAIT_V(8); PG8_WAIT_L(0); PG8_BAR; PG8_MMA(1, 0, At, B0); PG8_MMA(1, 1, At, B1); PG8_BAR; PG8_SCHED;
            PG8_LDB(B0, 1, 0); PG8_LDB(B1, 1, 1); PG8_SCHED; PG8_LDA(At, 1, 0); PG8_STAGE(PG8_SA(0, 1), a2 + hstep, voffA);
            PG8_WAIT_V(8); PG8_WAIT_L(0); PG8_BAR; PG8_MMA(0, 0, At, B0); PG8_MMA(0, 1, At, B1); PG8_BAR; PG8_SCHED;
            PG8_LDA(At, 1, 1); PG8_STAGE(PG8_SB(1, 0), b3, voffB); PG8_STAGE(PG8_SB(1, 1), b3 + hstep, voffB); PG8_STAGE(PG8_SA(1, 0), a3, voffA);
            PG8_WAIT_V(8); PG8_WAIT_L(0); PG8_BAR; PG8_MMA(1, 0, At, B0); PG8_MMA(1, 1, At, B1); PG8_BAR; PG8_SCHED;
        }
        if (wr == 0) PG8_BAR;
        E(acc, cur, wr, wc, fr, fq);
        if (!has_next) break;
        if (!nxt.seg) {
#pragma unroll
        for (int a = 0; a < 2; ++a)
#pragma unroll
            for (int b = 0; b < 2; ++b)
#pragma unroll
                for (int m = 0; m < 4; ++m)
#pragma unroll
                    for (int n = 0; n < 2; ++n) acc[a][b][m][n] = (f32x4){0.f, 0.f, 0.f, 0.f}; }
        cur = nxt; cA = nA; cB = nB; ++ui;
        if (wr == 1) PG8_BAR;
    }
    PG8_WAIT_V(0);
    PG8_BAR;
#undef PG8_SA
#undef PG8_SB
#undef PG8_STAGE
#undef PG8_LDA
#undef PG8_LDB
#undef PG8_MMA
#undef PG8_WAIT_V
#undef PG8_WAIT_L
#undef PG8_BAR
#undef PG8_SCHED
}
}

constexpr int S = 16384, DM = 1024, INC = 3864, NPJ = 4096, SSW = 512, NSW = 512, HD = 64, DFF = 2816;
constexpr int NGRP = 32, NST = 64, NCMP = 1023;
constexpr int NWAVES = 8;
constexpr int NPH = 12;
constexpr int CMP_KS = 4;
constexpr float EPS = 1e-6f;

constexpr size_t MiB = 1u << 20;
constexpr size_t WS_CTL = 0;
constexpr size_t WS_TAB = 1 * MiB;
constexpr size_t TAB_BF = 0, TAB_CF = 128 * 1024, TAB_LAM = 256 * 1024, TAB_LAM256 = 272 * 1024, TAB_POSB = 288 * 1024;
constexpr size_t WS_SSP = 1 * MiB + 512 * 1024;
constexpr size_t WS_F = 2 * MiB;
constexpr size_t WS_KVC = 3 * MiB;
constexpr size_t WS_WIN = 4 * MiB, WS_WGU = 12 * MiB, WS_WD = 23 * MiB, WS_WOUT = 29 * MiB, WS_WA = 31 * MiB, WS_WB = 32 * MiB, WS_WGLU = 33 * MiB, WS_WC1 = 34 * MiB;
constexpr size_t WS_XN = 36 * MiB;
constexpr size_t WS_Z = WS_XN, WS_ZG = WS_XN + 16 * MiB;
constexpr size_t WS_U = 68 * MiB, WS_O = WS_U;
constexpr size_t WS_Q = 84 * MiB;
constexpr size_t WS_KVH = 100 * MiB;
constexpr size_t WS_G = 124 * MiB;
constexpr size_t WS_GN = 188 * MiB;
constexpr size_t WS_MIX = 84 * MiB;
constexpr size_t WS_H = 100 * MiB;
constexpr size_t WS_VTW = 189 * MiB;
constexpr size_t WS_VTS = 193 * MiB;
constexpr size_t WS_KCB = 197 * MiB;
constexpr size_t WS_VTC = 197 * MiB + 512 * 1024;
constexpr size_t WS_PSLAB = 198 * MiB;
constexpr size_t WS_END = 254 * MiB;

constexpr int LDS_BYTES = 163840;

#define GAS __attribute__((address_space(1)))
#define LAS __attribute__((address_space(3)))
typedef unsigned short bf16;
typedef unsigned v4u __attribute__((ext_vector_type(4)));
typedef float f32x4 __attribute__((ext_vector_type(4)));
typedef float f32x2 __attribute__((ext_vector_type(2)));
typedef float f32x16 __attribute__((ext_vector_type(16)));
typedef short bf16x8 __attribute__((ext_vector_type(8)));
#define LDS_WAIT() asm volatile("s_waitcnt lgkmcnt(0)" ::: "memory")
#define VM_WAIT() asm volatile("s_waitcnt vmcnt(0)" ::: "memory")
__device__ __forceinline__ unsigned f2bf(float f) { unsigned u = __builtin_bit_cast(unsigned, f); return (u + 0x7fffu + ((u >> 16) & 1u)) >> 16; }
__device__ __forceinline__ unsigned pk2(float lo, float hi) { return f2bf(lo) | (f2bf(hi) << 16); }
__device__ __forceinline__ float bf2f(bf16 v) { return __uint_as_float((unsigned)v << 16); }
using pg8::bflo; using pg8::bfhi; using pg8::sigm; using pg8::cvt_pk_bf16;
__device__ __forceinline__ float gelu_tanh(float y) {
    const float a = 0.7978845608028654f * (y + 0.044715f * y * y * y);
    const float e = __expf(2.0f * a);
    const float th = 1.0f - 2.0f * __builtin_amdgcn_rcpf(e + 1.0f);
    return 0.5f * y * (1.0f + th);
}
__device__ __forceinline__ float wave_sum(float v) {
#pragma unroll
    for (int o = 1; o < 64; o <<= 1) v += __shfl_xor(v, o);
    return v;
}
__device__ __forceinline__ float wave_max(float v) {
#pragma unroll
    for (int o = 1; o < 64; o <<= 1) v = fmaxf(v, __shfl_xor(v, o));
    return v;
}

struct Args { const float* in[27]; float* out; unsigned char* ws; int ph_lo, ph_hi; };

struct Frame {
    LAS unsigned char* lds;
    int tid, lane, wave, G, gw, ngw;
    float* out; unsigned char* ws;
};

using pg8::Unit; using pg8::BM; using pg8::HALF;
struct EpiProj {
    static constexpr bool PERM = true;
    bf16 *U, *Q, *KVH, *Gt, *GN;
    __device__ __forceinline__ void operator()(const f32x4 (&acc)[2][2][4][2], const Unit& u, int wr, int wc, int fr, int fq) const {
        const int row0 = u.pm * BM + wr * 64 + fr, pn = u.pn;
#pragma unroll
        for (int ai = 0; ai < 2; ++ai)
#pragma unroll
            for (int m = 0; m < 4; ++m) { const int row = row0 + ai * HALF + m * 16;
#pragma unroll
                for (int bj = 0; bj < 2; ++bj) { f32x4 v0 = acc[ai][bj][m][0], v1 = acc[ai][bj][m][1]; const int col = bj * HALF + wc * 32 + 8 * fq; bf16* dst;
                    if (pn < 2) dst = U + (size_t)row * 512 + pn * 256 + col;
                    else if (pn < 4) { v0 = v0 * (0.125f * 1.4426950408889634f); v1 = v1 * (0.125f * 1.4426950408889634f); dst = Q + (size_t)row * 512 + (pn - 2) * 256 + col; }
                    else if (pn < 7) dst = KVH + ((size_t)((pn - 4) * 4 + (col >> 6)) * S + row) * 64 + (col & 63);
                    else { v0 = (f32x4){sigm(v0[0]), sigm(v0[1]), sigm(v0[2]), sigm(v0[3])}; v1 = (f32x4){sigm(v1[0]), sigm(v1[1]), sigm(v1[2]), sigm(v1[3])};
                        if (pn < 15) dst = Gt + (size_t)row * 2048 + (pn - 7) * 256 + col; else { if (col >= 32) continue; dst = GN + (size_t)row * 32 + col; } }
                    v4u w; w.x = cvt_pk_bf16(v0[0], v0[1]); w.y = cvt_pk_bf16(v0[2], v0[3]); w.z = cvt_pk_bf16(v1[0], v1[1]); w.w = cvt_pk_bf16(v1[2], v1[3]);
                    *(v4u*)dst = w; } }
    }
};
struct EpiCmp {
    static constexpr bool PERM = false;
    float* C;
    __device__ __forceinline__ void operator()(const f32x4 (&acc)[2][2][4][2], const Unit& u, int wr, int wc, int fr, int fq) const {
        const int row0 = u.pm * BM + wr * 64 + fr, col0 = (u.pn & 1) * BM + wc * 32 + 4 * fq; float* base = C + (size_t)u.ks * 4096 * 512;
#pragma unroll
        for (int ai = 0; ai < 2; ++ai)
#pragma unroll
            for (int m = 0; m < 4; ++m) { float* rowp = base + (size_t)(row0 + ai * HALF + m * 16) * 512 + col0;
#pragma unroll
                for (int bj = 0; bj < 2; ++bj)
#pragma unroll
                    for (int n = 0; n < 2; ++n) *(f32x4*)(rowp + bj * HALF + n * 16) = acc[ai][bj][m][n]; }
    }
};
struct EpiGlu {
    static constexpr bool PERM = true;
    const bf16* Z; bf16* ZG;
    __device__ __forceinline__ void operator()(const f32x4 (&acc)[2][2][4][2], const Unit& u, int wr, int wc, int fr, int fq) const {
        const int row0 = u.pm * BM + wr * 64 + fr;
#pragma unroll
        for (int ai = 0; ai < 2; ++ai)
#pragma unroll
            for (int m = 0; m < 4; ++m) { const int row = row0 + ai * HALF + m * 16;
#pragma unroll
                for (int bj = 0; bj < 2; ++bj) { const f32x4 v0 = acc[ai][bj][m][0], v1 = acc[ai][bj][m][1]; const size_t off = (size_t)row * 512 + u.pn * BM + bj * HALF + wc * 32 + 8 * fq;
                    const v4u z = *(const v4u*)(Z + off); v4u w;
                    w.x = cvt_pk_bf16(bflo(z.x) * sigm(v0[0]), bfhi(z.x) * sigm(v0[1])); w.y = cvt_pk_bf16(bflo(z.y) * sigm(v0[2]), bfhi(z.y) * sigm(v0[3]));
                    w.z = cvt_pk_bf16(bflo(z.z) * sigm(v1[0]), bfhi(z.z) * sigm(v1[1])); w.w = cvt_pk_bf16(bflo(z.w) * sigm(v1[2]), bfhi(z.w) * sigm(v1[3]));
                    *(v4u*)(ZG + off) = w; } }
    }
};
struct EpiMix2 {
    static constexpr bool PERM = true;
    const bf16* Gt; bf16* MIX;
    __device__ __forceinline__ void operator()(f32x4 (&acc)[2][2][4][2], const Unit& u, int wr, int wc, int fr, int fq) const {
        const int row0 = u.pm * BM + wr * 64 + fr;
#pragma unroll
        for (int ai = 0; ai < 2; ++ai)
#pragma unroll
            for (int m = 0; m < 4; ++m) { const int row = row0 + ai * HALF + m * 16;
#pragma unroll
                for (int bj = 0; bj < 2; ++bj) { const int col = u.pn * BM + bj * HALF + wc * 32 + 8 * fq;
                    const v4u gb = *(const v4u*)(Gt + (size_t)row * 2048 + 1024 + col);
                    const float b8[8] = {bflo(gb.x), bfhi(gb.x), bflo(gb.y), bfhi(gb.y), bflo(gb.z), bfhi(gb.z), bflo(gb.w), bfhi(gb.w)};
                    if (u.seg == 0) { const v4u ga = *(const v4u*)(Gt + (size_t)row * 2048 + col);
                        const float a8[8] = {bflo(ga.x), bfhi(ga.x), bflo(ga.y), bfhi(ga.y), bflo(ga.z), bfhi(ga.z), bflo(ga.w), bfhi(ga.w)};
#pragma unroll
                        for (int e = 0; e < 4; ++e) { acc[ai][bj][m][0][e] *= a8[e] * __builtin_amdgcn_rcpf(b8[e]); acc[ai][bj][m][1][e] *= a8[4 + e] * __builtin_amdgcn_rcpf(b8[4 + e]); }
                    } else { const f32x4 v0 = acc[ai][bj][m][0], v1 = acc[ai][bj][m][1]; v4u w;
                        w.x = cvt_pk_bf16(v0[0] * b8[0], v0[1] * b8[1]); w.y = cvt_pk_bf16(v0[2] * b8[2], v0[3] * b8[3]); w.z = cvt_pk_bf16(v1[0] * b8[4], v1[1] * b8[5]); w.w = cvt_pk_bf16(v1[2] * b8[6], v1[3] * b8[7]);
                        *(v4u*)(MIX + (size_t)row * 1024 + col) = w; } } }
    }
};
struct EpiRes {
    static constexpr bool PERM = false;
    const float* base; float* out;
    __device__ __forceinline__ void operator()(const f32x4 (&acc)[2][2][4][2], const Unit& u, int wr, int wc, int fr, int fq) const {
        const int row0 = u.pm * BM + wr * 64 + fr, col0 = u.pn * BM + wc * 32 + 4 * fq;
#pragma unroll
        for (int ai = 0; ai < 2; ++ai)
#pragma unroll
            for (int m = 0; m < 4; ++m) { const size_t off = (size_t)(row0 + ai * HALF + m * 16) * 1024 + col0;
#pragma unroll
                for (int bj = 0; bj < 2; ++bj)
#pragma unroll
                    for (int n = 0; n < 2; ++n) { const f32x4 b = *(const f32x4*)(base + off + bj * HALF + n * 16); *(f32x4*)(out + off + bj * HALF + n * 16) = b + acc[ai][bj][m][n]; } }
    }
};
struct EpiResNorm {
    static constexpr bool PERM = false;
    const float* base; float* out; bf16* XN; float* SSP; LAS float* part;
    __device__ __forceinline__ void operator()(const f32x4 (&acc)[2][2][4][2], const Unit& u, int wr, int wc, int fr, int fq) const {
        const int row0 = u.pm * BM + wr * 64 + fr, col0 = u.pn * BM + wc * 32 + 4 * fq;
#pragma unroll
        for (int ai = 0; ai < 2; ++ai)
#pragma unroll
            for (int m = 0; m < 4; ++m) { const size_t off = (size_t)(row0 + ai * HALF + m * 16) * 1024 + col0; float ss = 0.f;
#pragma unroll
                for (int bj = 0; bj < 2; ++bj)
#pragma unroll
                    for (int n = 0; n < 2; ++n) { const f32x4 b = *(const f32x4*)(base + off + bj * HALF + n * 16); const f32x4 x1 = b + acc[ai][bj][m][n]; *(f32x4*)(out + off + bj * HALF + n * 16) = x1;
                        *(unsigned long long*)(XN + off + bj * HALF + n * 16) = (unsigned long long)cvt_pk_bf16(x1[0], x1[1]) | ((unsigned long long)cvt_pk_bf16(x1[2], x1[3]) << 32);
                        ss += (x1[0] * x1[0] + x1[1] * x1[1]) + (x1[2] * x1[2] + x1[3] * x1[3]); }
                ss += __shfl_xor(ss, 16); ss += __shfl_xor(ss, 32);
                if (fq == 0) part[(ai * HALF + wr * 64 + m * 16 + fr) * 4 + wc] = ss; }
        asm volatile("s_waitcnt lgkmcnt(0)" ::: "memory"); __builtin_amdgcn_s_barrier(); asm volatile("" ::: "memory");
        if (threadIdx.x < 256) { const f32x4 p = *(const LAS f32x4*)(part + threadIdx.x * 4); SSP[(size_t)(u.pm * BM + threadIdx.x) * 4 + u.pn] = (p[0] + p[1]) + (p[2] + p[3]); }
    }
};
struct EpiFfn {
    static constexpr bool PERM = true;
    bf16* H; const float* SSP;
    __device__ __forceinline__ void operator()(const f32x4 (&acc)[2][2][4][2], const Unit& u, int wr, int wc, int fr, int fq) const {
        const int row0 = u.pm * BM + wr * 64 + fr;
#pragma unroll
        for (int ai = 0; ai < 2; ++ai)
#pragma unroll
            for (int m = 0; m < 4; ++m) { const int row = row0 + ai * HALF + m * 16;
                const f32x4 sp = *(const f32x4*)(SSP + (size_t)row * 4); const float rs = 1.0f / sqrtf(((sp[0] + sp[1]) + (sp[2] + sp[3])) * (1.f / 1024.f) + 1e-6f);
                float r[8];
#pragma unroll
                for (int n = 0; n < 2; ++n)
#pragma unroll
                    for (int e = 0; e < 4; ++e) { const float gt = acc[ai][0][m][n][e] * rs, up = acc[ai][1][m][n][e] * rs; r[n * 4 + e] = gt * sigm(gt) * up; }
                v4u w; w.x = cvt_pk_bf16(r[0], r[1]); w.y = cvt_pk_bf16(r[2], r[3]); w.z = cvt_pk_bf16(r[4], r[5]); w.w = cvt_pk_bf16(r[6], r[7]);
                *(v4u*)(H + (size_t)row * DFF + u.pn * HALF + wc * 32 + 8 * fq) = w; }
    }
};

struct TrDesc { const float* src; bf16* dst; int ld, ncols, dld, drow, kb, nb; const float* gain; };
__device__ __forceinline__ void tr_load(const TrDesc& d, float (&v)[32], int lane) {
    const int k0 = 64 * d.kb, c = 32 * d.nb + (lane & 31); const bool ok = c < d.ncols; const float* p = d.src + (size_t)(k0 + (lane >> 5)) * d.ld + c;
#pragma unroll
    for (int i = 0; i < 32; ++i) v[i] = ok ? p[(size_t)(2 * i) * d.ld] : 0.f;
    if (d.gain) {
#pragma unroll
        for (int i = 0; i < 32; ++i) v[i] *= d.gain[k0 + 2 * i + (lane >> 5)]; }
}
__device__ __forceinline__ void tr_finish(const TrDesc& d, const float (&v)[32], LAS float* scr, int lane) {
#pragma unroll
    for (int i = 0; i < 32; ++i) scr[(2 * i + (lane >> 5)) * 33 + (lane & 31)] = v[i];
    LDS_WAIT();
    const int cc = lane & 7, k0 = 64 * d.kb;
#pragma unroll
    for (int j = 0; j < 4; ++j) { const int n = (lane >> 3) + 8 * j; const LAS float* s = scr + (8 * cc) * 33 + n;
        v4u o; o.x = pk2(s[0 * 33], s[1 * 33]); o.y = pk2(s[2 * 33], s[3 * 33]); o.z = pk2(s[4 * 33], s[5 * 33]); o.w = pk2(s[6 * 33], s[7 * 33]);
        *(v4u*)(d.dst + (size_t)(d.drow + n) * d.dld + k0 + 8 * cc) = o; }
    LDS_WAIT();
}
__device__ __forceinline__ void rms_row_to_bf16(const float* xrow, const float* gain, bf16* orow, int lane) {
    const f32x4* xr = (const f32x4*)xrow + lane; const f32x4* gr = (const f32x4*)gain + lane;
    f32x4 v[4]; float s = 0.f;
#pragma unroll
    for (int j = 0; j < 4; ++j) { v[j] = xr[64 * j]; s += (v[j].x * v[j].x + v[j].y * v[j].y) + (v[j].z * v[j].z + v[j].w * v[j].w); }
    const float rstd = 1.0f / sqrtf(wave_sum(s) * (1.f / DM) + EPS);
    unsigned long long* o8 = (unsigned long long*)orow + lane;
#pragma unroll
    for (int j = 0; j < 4; ++j) { const f32x4 gq = gr[64 * j];
        o8[64 * j] = (unsigned long long)pk2(v[j].x * rstd * gq.x, v[j].y * rstd * gq.y) | ((unsigned long long)pk2(v[j].z * rstd * gq.z, v[j].w * rstd * gq.w) << 32); }
}
__device__ __forceinline__ void rms_rows2_to_bf16(const float* x0, const float* x1, const float* gain, bf16* o0, bf16* o1, int lane) {
    const f32x4* xa = (const f32x4*)x0 + lane; const f32x4* xb = (const f32x4*)x1 + lane; const f32x4* gr = (const f32x4*)gain + lane;
    f32x4 va[4], vb[4]; float sa = 0.f, sb = 0.f;
#pragma unroll
    for (int j = 0; j < 4; ++j) { va[j] = xa[64 * j]; vb[j] = xb[64 * j]; }
#pragma unroll
    for (int j = 0; j < 4; ++j) { sa += (va[j].x * va[j].x + va[j].y * va[j].y) + (va[j].z * va[j].z + va[j].w * va[j].w); sb += (vb[j].x * vb[j].x + vb[j].y * vb[j].y) + (vb[j].z * vb[j].z + vb[j].w * vb[j].w); }
    const float ra = 1.0f / sqrtf(wave_sum(sa) * (1.f / DM) + EPS), rb = 1.0f / sqrtf(wave_sum(sb) * (1.f / DM) + EPS);
    unsigned long long* pa = (unsigned long long*)o0 + lane; unsigned long long* pb = (unsigned long long*)o1 + lane;
#pragma unroll
    for (int j = 0; j < 4; ++j) { const f32x4 gq = gr[64 * j];
        pa[64 * j] = (unsigned long long)pk2(va[j].x * ra * gq.x, va[j].y * ra * gq.y) | ((unsigned long long)pk2(va[j].z * ra * gq.z, va[j].w * ra * gq.w) << 32);
        pb[64 * j] = (unsigned long long)pk2(vb[j].x * rb * gq.x, vb[j].y * rb * gq.y) | ((unsigned long long)pk2(vb[j].z * rb * gq.z, vb[j].w * rb * gq.w) << 32); }
}
__device__ __forceinline__ void rms_row_f32(float* xrow, const float* gain, int lane) {
    f32x4* xr = (f32x4*)xrow + lane; const f32x4* gr = (const f32x4*)gain + lane;
    f32x4 v[4]; float s = 0.f;
#pragma unroll
    for (int j = 0; j < 4; ++j) { v[j] = xr[64 * j]; s += (v[j].x * v[j].x + v[j].y * v[j].y) + (v[j].z * v[j].z + v[j].w * v[j].w); }
    const float rstd = 1.0f / sqrtf(wave_sum(s) * (1.f / DM) + EPS);
#pragma unroll
    for (int j = 0; j < 4; ++j) { const f32x4 gq = gr[64 * j]; xr[64 * j] = v[j] * rstd * gq; }
}
__device__ __forceinline__ void s5_tables(const Frame& F, const Args& args, int g) {
    const int lane = F.lane;
    const float* are = args.in[3]; const float* aim = args.in[4]; const float* ldt = args.in[5]; const float* bre = args.in[6]; const float* bim = args.in[7]; const float* cre = args.in[8]; const float* cim = args.in[9];
    const double dt = exp((double)ldt[g]);
    {   const int p = lane; const double ar = are[g * 64 + p], ai = aim[g * 64 + p];
        const double er = exp(ar * dt), lr = er * cos(ai * dt), li = er * sin(ai * dt);
        ((f32x2*)(F.ws + WS_TAB + TAB_LAM))[g * 64 + p] = (f32x2){(float)lr, (float)li};
        const double e2 = exp(ar * dt * 256.0), l2r = e2 * cos(ai * dt * 256.0), l2i = e2 * sin(ai * dt * 256.0);
        ((f32x2*)(F.ws + WS_TAB + TAB_LAM256))[g * 64 + p] = (f32x2){(float)l2r, (float)l2i}; }
#pragma unroll
    for (int nt = 0; nt < 4; ++nt) { const int col = 32 * nt + (lane & 31), p = col >> 1, ri = col & 1;
        const double ar = are[g * 64 + p], ai = aim[g * 64 + p];
        const double er = exp(ar * dt), lr = er * cos(ai * dt) - 1.0, li = er * sin(ai * dt);
        const double den = ar * ar + ai * ai, kr = (lr * ar + li * ai) / den, ki = (li * ar - lr * ai) / den;
        float v[8];
#pragma unroll
        for (int j = 0; j < 8; ++j) { const int c = 8 * (lane >> 5) + j; const double br = bre[(g * 64 + p) * 16 + c], bi = bim[(g * 64 + p) * 16 + c];
            v[j] = (float)(ri ? (kr * bi + ki * br) : (kr * br - ki * bi)); }
        v4u o; o.x = pk2(v[0], v[1]); o.y = pk2(v[2], v[3]); o.z = pk2(v[4], v[5]); o.w = pk2(v[6], v[7]);
        ((v4u*)(F.ws + WS_TAB + TAB_BF))[(g * 4 + nt) * 64 + lane] = o; }
#pragma unroll
    for (int ks = 0; ks < 4; ++ks) { const int ch = lane & 15; float v[8];
#pragma unroll
        for (int j = 0; j < 8; ++j) { const int k = 32 * ks + 8 * (lane >> 4) + j, p = k >> 1, ri = k & 1; v[j] = ri ? -cim[(g * 16 + ch) * 64 + p] : cre[(g * 16 + ch) * 64 + p]; }
        v4u o; o.x = pk2(v[0], v[1]); o.y = pk2(v[2], v[3]); o.z = pk2(v[4], v[5]); o.w = pk2(v[6], v[7]);
        ((v4u*)(F.ws + WS_TAB + TAB_CF))[(g * 4 + ks) * 64 + lane] = o; }
}
__device__ __forceinline__ void p0_prologue(const Frame& F, const Args& args) {
    LAS float* scr = (LAS float*)(F.lds + F.wave * 16384);
    const int gw = F.gw, NGW = F.ngw, lane = F.lane;
    if (F.wave == 0 && blockIdx.x < 32) s5_tables(F, args, (int)blockIdx.x);
    else if (F.wave == 1 && blockIdx.x < 128) {
        const int it = (int)blockIdx.x, kv = it >> 6, part = (it >> 2) & 15, cgp = it & 3;
        const float* pos = kv ? args.in[14] : args.in[13]; const float* w1 = kv ? args.in[17] : args.in[15]; float a = 0.f;
#pragma unroll 1
        for (int r0 = 128 * part; r0 < 128 * part + 128; r0 += 32) { float wv[32];
#pragma unroll
            for (int i = 0; i < 32; ++i) wv[i] = w1[(size_t)(r0 + i) * 256 + cgp * 64 + lane];
#pragma unroll
            for (int i = 0; i < 32; ++i) a += pos[r0 + i] * wv[i]; }
        ((float*)(F.ws + WS_TAB + TAB_POSB))[(kv * 16 + part) * 256 + cgp * 64 + lane] = a;
    }
    { v4u* z = (v4u*)(F.ws + WS_WIN + (size_t)3872 * 1024 * 2); const int n16 = 224 * 1024 * 2 / 16;
      for (int i = blockIdx.x * 512 + F.tid; i < n16; i += F.G * 512) z[i] = (v4u){0u, 0u, 0u, 0u}; }
    bf16* WIN = (bf16*)(F.ws + WS_WIN); bf16* WGU = (bf16*)(F.ws + WS_WGU); bf16* WD = (bf16*)(F.ws + WS_WD); bf16* WOUT = (bf16*)(F.ws + WS_WOUT);
    bf16* WA = (bf16*)(F.ws + WS_WA); bf16* WB = (bf16*)(F.ws + WS_WB); bf16* WGLU = (bf16*)(F.ws + WS_WGLU); bf16* WC1 = (bf16*)(F.ws + WS_WC1);
    constexpr int I1 = 16 * 56, I2 = 16 * 64, I3 = 16, IGLU = 8 * 16, IUP = 8 * 32, IOUT = 16 * 32, IFF = 16 * 88, IDN = 44 * 32, ICM = 16 * 8;
    constexpr int NITEMS = I1 + I2 + I3 + IGLU + 2 * IUP + IOUT + 2 * IFF + IDN + 4 * ICM;
    auto desc = [&](int it) -> TrDesc {
        int r = it;
        if (r < I1) return TrDesc{args.in[2], WIN, INC, 1792, 1024, 32 * (r % 56), r / 56, r % 56, nullptr}; r -= I1;
        if (r < I2) return TrDesc{args.in[2] + 1816, WIN, INC, 2048, 1024, 1792 + 32 * (r % 64), r / 64, r % 64, nullptr}; r -= I2;
        if (r < I3) return TrDesc{args.in[2] + 1792, WIN, INC, 24, 1024, 3840, r, 0, nullptr}; r -= I3;
        if (r < IGLU) return TrDesc{args.in[11], WGLU, 512, 512, 512, 32 * (r % 16), r / 16, r % 16, nullptr}; r -= IGLU;
        if (r < IUP) return TrDesc{args.in[12], WA, 1024, 1024, 512, 32 * (r % 32), r / 32, r % 32, nullptr}; r -= IUP;
        if (r < IUP) return TrDesc{args.in[20], WB, 1024, 1024, 512, 32 * (r % 32), r / 32, r % 32, nullptr}; r -= IUP;
        if (r < IOUT) return TrDesc{args.in[21], WOUT, 1024, 1024, 1024, 32 * (r % 32), r / 32, r % 32, nullptr}; r -= IOUT;
        if (r < IFF) { const int nb = r % 88; return TrDesc{args.in[23], WGU, DFF, DFF, 1024, (nb >> 2) * 256 + (nb & 3) * 32, r / 88, nb, args.in[22]}; } r -= IFF;
        if (r < IFF) { const int nb = r % 88; return TrDesc{args.in[24], WGU, DFF, DFF, 1024, (nb >> 2) * 256 + (nb & 3) * 32 + 128, r / 88, nb, args.in[22]}; } r -= IFF;
        if (r < IDN) return TrDesc{args.in[25], WD, 1024, 1024, DFF, 32 * (r % 32), r / 32, r % 32, nullptr}; r -= IDN;
        const int q = r / ICM, rr = r % ICM;
        return TrDesc{((q >> 1) ? args.in[17] : args.in[15]) + (size_t)(q & 1) * 1024 * 256, WC1, 256, 256, 1024, q * 256 + 32 * (rr % 8), rr / 8, rr % 8, nullptr};
    };
    if (gw < NITEMS) {
        TrDesc dc = desc(gw); float vc[32]; tr_load(dc, vc, lane);
#pragma unroll 1
        for (int it = gw; it < NITEMS; it += NGW) {
            const bool more = it + NGW < NITEMS; TrDesc dn = desc(more ? it + NGW : it); float vn[32]; tr_load(dn, vn, lane);
            tr_finish(dc, vc, scr, lane);
            dc = dn;
#pragma unroll
            for (int i = 0; i < 32; ++i) vc[i] = vn[i];
        }
    }
    bf16* XN = (bf16*)(F.ws + WS_XN);
    for (int m = gw; m < S; m += 2 * NGW) rms_rows2_to_bf16(args.in[0] + (size_t)m * DM, args.in[0] + (size_t)(m + NGW) * DM, args.in[1], XN + (size_t)m * DM, XN + (size_t)(m + NGW) * DM, lane);
}

__device__ __forceinline__ int crow(int r, int hi) { return (r & 3) + 8 * (r >> 2) + 4 * hi; }
template <bool FINAL>
__device__ __forceinline__ void s5_unit(const Frame& F, const Args& args, int c, int g, LAS unsigned char* wl, LAS unsigned char* wx) {
    const int lane = F.lane, hi = lane >> 5;
    const bf16* U = (const bf16*)(F.ws + WS_U); bf16* Z = (bf16*)(F.ws + WS_Z);
    bf16x8 bfg[4], cfg[4], ua[8];
#pragma unroll
    for (int sub = 0; sub < 8; ++sub) ua[sub] = *(const bf16x8*)(U + (size_t)(c * 256 + sub * 32 + (lane & 31)) * 512 + g * 16 + 8 * hi);
#pragma unroll
    for (int nt = 0; nt < 4; ++nt) bfg[nt] = ((const bf16x8*)(F.ws + WS_TAB + TAB_BF))[(g * 4 + nt) * 64 + lane];
    const f32x2 lam = ((const f32x2*)(F.ws + WS_TAB + TAB_LAM))[g * 64 + lane];
    f32x2* Fst = (f32x2*)(F.ws + WS_F);
    float xr = 0.f, xi = 0.f, dsk = 0.f;
    if (FINAL) {
#pragma unroll
        for (int ks = 0; ks < 4; ++ks) cfg[ks] = ((const bf16x8*)(F.ws + WS_TAB + TAB_CF))[(g * 4 + ks) * 64 + lane];
        dsk = args.in[10][g * 16 + (lane & 15)];
        const f32x2 L2 = ((const f32x2*)(F.ws + WS_TAB + TAB_LAM256))[g * 64 + lane];
        for (int cp = 0; cp < c; ++cp) { const f32x2 f = Fst[(cp * 32 + g) * 64 + lane]; const float nr = L2.x * xr - L2.y * xi + f.x, ni = L2.x * xi + L2.y * xr + f.y; xr = nr; xi = ni; }
    }
#pragma unroll
    for (int sub = 0; sub < 8; ++sub) {
        const int t0 = c * 256 + sub * 32;
        const bf16x8 a = ua[sub];
        if (FINAL) *(LAS bf16x8*)(wx + (lane & 31) * 32 + hi * 16) = a;
#pragma unroll
        for (int nt = 0; nt < 4; ++nt) { f32x16 acc = {}; acc = __builtin_amdgcn_mfma_f32_32x32x16_bf16(a, bfg[nt], acc, 0, 0, 0);
#pragma unroll
            for (int r = 0; r < 16; ++r) ((LAS float*)wl)[crow(r, hi) * 128 + 32 * nt + (lane & 31)] = acc[r]; }
        LDS_WAIT();
        f32x2 bu[32];
#pragma unroll
        for (int tk = 0; tk < 32; ++tk) bu[tk] = ((const LAS f32x2*)wl)[tk * 64 + lane];
        LDS_WAIT();
#pragma unroll
        for (int tk = 0; tk < 32; ++tk) { const float nr = lam.x * xr - lam.y * xi + bu[tk].x, ni = lam.x * xi + lam.y * xr + bu[tk].y; xr = nr; xi = ni;
            if (FINAL) ((LAS unsigned*)wl)[tk * 128 + ((lane + 4 * tk) & 63)] = pk2(xr, xi); }
        if (FINAL) {
            LDS_WAIT();
            LAS unsigned short* zt = (LAS unsigned short*)(wx + 1024);
#pragma unroll
            for (int mt = 0; mt < 2; ++mt) { f32x4 y4 = {0.f, 0.f, 0.f, 0.f}; const int row = 16 * mt + (lane & 15);
#pragma unroll
                for (int ks = 0; ks < 4; ++ks) { const bf16x8 xa = *(const LAS bf16x8*)(wl + row * 512 + ((64 * ks + 16 * (lane >> 4) + 16 * row) & 255)); y4 = __builtin_amdgcn_mfma_f32_16x16x32_bf16(xa, cfg[ks], y4, 0, 0, 0); }
#pragma unroll
                for (int r = 0; r < 4; ++r) { const int tok = 16 * mt + 4 * (lane >> 4) + r; const float uu = bf2f(((const LAS unsigned short*)wx)[tok * 16 + (lane & 15)]);
                    zt[tok * 16 + (lane & 15)] = (unsigned short)f2bf(gelu_tanh(y4[r] + dsk * uu)); } }
            LDS_WAIT();
            *(v4u*)(Z + (size_t)(t0 + (lane >> 1)) * 512 + g * 16 + 8 * (lane & 1)) = *(const LAS v4u*)(wx + 1024 + lane * 16);
            LDS_WAIT();
        }
    }
    if (!FINAL) Fst[(c * 32 + g) * 64 + lane] = (f32x2){xr, xi};
}

__device__ __forceinline__ int krow(int s, int h, int j) { return 16 * s + 8 * (j >> 2) + 4 * h + (j & 3); }
__device__ __forceinline__ void cmp_l2_unit(const Frame& F, const Args& args, int kv, int g, int n, LAS float* hb, const LAS float* w2s) {
    const int lane = F.lane; const float* P1 = F.out;
    float o = 0.f;
    if (n < NCMP) {
        const int rt = kv * 2048 + g * 1024 + n;
        const float* posb = (const float*)(F.ws + WS_TAB + TAB_POSB) + kv * 16 * 256;
#pragma unroll
        for (int i = 0; i < 4; ++i) { const int j = lane + 64 * i; float a = 0.f;
#pragma unroll
            for (int ks = 0; ks < CMP_KS; ++ks) a += P1[((size_t)ks * 4096 + rt) * 512 + j] + P1[((size_t)ks * 4096 + rt + 1) * 512 + 256 + j];
#pragma unroll
            for (int p = 0; p < 16; ++p) a += posb[p * 256 + j];
            hb[j] = gelu_tanh(a); }
        LDS_WAIT();
#pragma unroll 8
        for (int j = 0; j < 256; ++j) o += hb[j] * w2s[j * 64 + lane];
    }
    if (kv == 0) ((bf16*)(F.ws + WS_KCB))[((size_t)g * 1024 + n) * 64 + lane] = (bf16)f2bf(o);
    else { const int grp = n >> 5, kk = n & 31, sx = kk >> 4, rem = kk & 15, hh = (rem >> 2) & 1, j = ((rem >> 3) << 2) | (rem & 3), d0 = lane >> 5, ln = hh * 32 + (lane & 31);
        ((bf16*)(F.ws + WS_VTC))[((((size_t)(g * 32 + grp) * 2 + d0) * 2 + sx) * 64 + ln) * 8 + j] = (bf16)f2bf(o); }
    LDS_WAIT();
}
__device__ __forceinline__ void vtw_item(const Frame& F, int g, int grp, LAS unsigned short* tl) {
    const int lane = F.lane, hi = lane >> 5; const bf16* V = (const bf16*)(F.ws + WS_KVH) + (size_t)(10 + g) * S * 64 + (size_t)32 * grp * 64;
#pragma unroll
    for (int e = 0; e < 4; ++e) ((LAS v4u*)tl)[lane + 64 * e] = ((const v4u*)V)[lane + 64 * e];
    LDS_WAIT();
#pragma unroll
    for (int d0 = 0; d0 < 2; ++d0)
#pragma unroll
        for (int sx = 0; sx < 2; ++sx) { unsigned w[4];
#pragma unroll
            for (int jj = 0; jj < 4; ++jj) { const unsigned a = tl[krow(sx, hi, 2 * jj) * 64 + 32 * d0 + (lane & 31)], b = tl[krow(sx, hi, 2 * jj + 1) * 64 + 32 * d0 + (lane & 31)]; w[jj] = a | (b << 16); }
            ((v4u*)(F.ws + WS_VTW))[(((size_t)(g * 512 + grp) * 2 + d0) * 2 + sx) * 64 + lane] = (v4u){w[0], w[1], w[2], w[3]}; }
    LDS_WAIT();
}
__device__ __forceinline__ int kap(int ks, int q, int j) { return 16 * (2 * ks + (j >> 2)) + 4 * q + (j & 3); }
__device__ __forceinline__ void vts_item(const Frame& F, int g, int blk, LAS unsigned short* tl) {
    const int lane = F.lane, q = lane >> 4; const bf16* V = (const bf16*)(F.ws + WS_KVH) + (size_t)(6 + g) * S * 64 + (size_t)64 * blk * 64;
#pragma unroll
    for (int e = 0; e < 8; ++e) ((LAS v4u*)tl)[lane + 64 * e] = ((const v4u*)V)[lane + 64 * e];
    LDS_WAIT();
#pragma unroll
    for (int dt = 0; dt < 4; ++dt)
#pragma unroll
        for (int ks = 0; ks < 2; ++ks) { unsigned w[4];
#pragma unroll
            for (int jj = 0; jj < 4; ++jj) { const unsigned a = tl[kap(ks, q, 2 * jj) * 64 + 16 * dt + (lane & 15)], b = tl[kap(ks, q, 2 * jj + 1) * 64 + 16 * dt + (lane & 15)]; w[jj] = a | (b << 16); }
            ((v4u*)(F.ws + WS_VTS))[(((size_t)(g * 256 + blk) * 4 + dt) * 2 + ks) * 64 + lane] = (v4u){w[0], w[1], w[2], w[3]}; }
    LDS_WAIT();
}

constexpr int AT_SC = 0;
constexpr int AT_SEL = 67584;
constexpr int AT_CNT = AT_SEL + 4096;
constexpr int AT_LIST = AT_CNT + 1024;
constexpr int AT_BT = AT_LIST + 32768;
constexpr int AT_PARK = AT_BT + 4096;
constexpr int AT_TILE = AT_PARK + 32768;
constexpr int AT_END = AT_TILE + 16384;
static_assert(AT_END <= LDS_BYTES - 64, "attention LDS map");
constexpr int PSLOTS = 832, PSLAB = 458752;
constexpr int PML_OFF = PSLOTS * 512;
constexpr int SCS = 264;
constexpr int XRN = 624;

__device__ __forceinline__ bf16x8 pack8(float a0, float a1, float a2, float a3, float a4, float a5, float a6, float a7) {
    v4u w; w.x = cvt_pk_bf16(a0, a1); w.y = cvt_pk_bf16(a2, a3); w.z = cvt_pk_bf16(a4, a5); w.w = cvt_pk_bf16(a6, a7); return __builtin_bit_cast(bf16x8, w);
}
__device__ __forceinline__ float xmax32(float v) { auto r = __builtin_amdgcn_permlane32_swap(__float_as_uint(v), __float_as_uint(v), false, false); return fmaxf(__uint_as_float(r[0]), __uint_as_float(r[1])); }
__device__ __forceinline__ float xsum32(float v) { auto r = __builtin_amdgcn_permlane32_swap(__float_as_uint(v), __float_as_uint(v), false, false); return __uint_as_float(r[0]) + __uint_as_float(r[1]); }
__device__ __forceinline__ float xmax16(float v) { auto r = __builtin_amdgcn_permlane16_swap(__float_as_uint(v), __float_as_uint(v), false, false); return fmaxf(__uint_as_float(r[0]), __uint_as_float(r[1])); }
__device__ __forceinline__ float xsum16(float v) { auto r = __builtin_amdgcn_permlane16_swap(__float_as_uint(v), __float_as_uint(v), false, false); return __uint_as_float(r[0]) + __uint_as_float(r[1]); }
__device__ __forceinline__ float max16(const f32x16& a) {
    const float m0 = fmaxf(fmaxf(a[0], a[1]), fmaxf(a[2], a[3])), m1 = fmaxf(fmaxf(a[4], a[5]), fmaxf(a[6], a[7])), m2 = fmaxf(fmaxf(a[8], a[9]), fmaxf(a[10], a[11])), m3 = fmaxf(fmaxf(a[12], a[13]), fmaxf(a[14], a[15]));
    return fmaxf(fmaxf(m0, m1), fmaxf(m2, m3)); }
__device__ __forceinline__ float sum16(const f32x16& a) {
    const float s0 = (a[0] + a[1]) + (a[2] + a[3]), s1 = (a[4] + a[5]) + (a[6] + a[7]), s2 = (a[8] + a[9]) + (a[10] + a[11]), s3 = (a[12] + a[13]) + (a[14] + a[15]);
    return (s0 + s1) + (s2 + s3); }
__device__ __forceinline__ int fenc(float f) { int k = __float_as_int(f); return k ^ ((k >> 31) & 0x7fffffff); }
__device__ __forceinline__ float fdec(int k) { return __int_as_float(k ^ ((k >> 31) & 0x7fffffff)); }
#define MFMA32(a, b, c) __builtin_amdgcn_mfma_f32_32x32x16_bf16((a), (b), (c), 0, 0, 0)
#define MFMA16(a, b, c) __builtin_amdgcn_mfma_f32_16x16x32_bf16((a), (b), (c), 0, 0, 0)
#define DPPI(x, ctrl) __builtin_amdgcn_update_dpp(0, (x), (ctrl), 0xF, 0xF, false)

struct AttnPtrs { const bf16* Q; const bf16* KCB; const bf16x8* VTC; const bf16* KW; const bf16x8* VTW; const bf16* KS; const bf16x8* VTS; const bf16* GN; bf16* O; };

__device__ __forceinline__ void attn_stageA(const AttnPtrs& P, int lane, int wave, int tile0, int g, LAS unsigned char* lds) {
    const int hi = lane >> 5, c32 = lane & 31, ti = c32 >> 2, hr = c32 & 3, h = g * 4 + hr, t0 = tile0 + 8 * wave, t = t0 + ti;
    LAS float* scores = (LAS float*)(lds + AT_SC) + (8 * wave) * SCS; const LAS float* BT = (const LAS float*)(lds + AT_BT); LAS int* sel = (LAS int*)(lds + AT_SEL) + (8 * wave) * 16;
    for (int k = lane; k < 8 * SCS / 4; k += 64) ((LAS f32x4*)scores)[k] = (f32x4){0.f, 0.f, 0.f, 0.f};
    bf16x8 bq[4];
#pragma unroll
    for (int ks = 0; ks < 4; ++ks) bq[ks] = *(const bf16x8*)(P.Q + (size_t)t * 512 + h * 64 + 16 * ks + 8 * hi);
    const float cb = BT[h * 128 + 127];
    const float g0 = bf2f(P.GN[(size_t)t * 32 + h * 3 + 0]), g2 = bf2f(P.GN[(size_t)t * 32 + h * 3 + 2]);
    {   LAS float* XR = (LAS float*)(lds + AT_LIST);
        for (int i = wave * 64 + lane; i < 4 * XRN; i += NWAVES * 64) { const int hh = i / XRN, d = 575 - (i - hh * XRN); XR[i] = (d < 0 || d >= 512) ? -1e30f : BT[(g * 4 + hh) * 128 + min(d, 127)]; } }
    LDS_WAIT();
    const int tid = wave * 64 + lane; LAS unsigned char* tb = lds + AT_TILE;
    const int ldrow = tid >> 3, ldch = tid & 7; const unsigned stoff = (tid < 256) ? (unsigned)(ldrow * 128 + ((ldch ^ (ldrow & 7)) << 4)) : (unsigned)(8192 + (tid - 256) * 16);
    const unsigned kof = (unsigned)(c32 * 128), ksw = (unsigned)(c32 & 7);
#define KFRAG(buf, ks) (*(const LAS bf16x8*)(tb + (buf) * 4096 + kof + ((((ks) * 2 + hi) ^ ksw) << 4)))
#define VFRAG(buf, f) (*(const LAS bf16x8*)(tb + 8192 + (buf) * 4096 + ((f) * 64 + lane) * 16))
#define STAGE_LOAD(Kp, kmax, VTp, gmax, n0v) ((tid < 256) ? *(const v4u*)((Kp) + (size_t)min((n0v) + ldrow, (kmax)) * 64 + ldch * 8) : *(const v4u*)((VTp) + (size_t)min((n0v) >> 5, (gmax)) * 256 + (tid - 256)))
#define STAGE_WRITE(v, buf) (*(LAS v4u*)(tb + (buf) * 4096 + stoff) = (v))
#define PVACC(o0v, o1v, buf, a) do { const bf16x8 p0_ = pack8(a[0], a[1], a[2], a[3], a[4], a[5], a[6], a[7]), p1_ = pack8(a[8], a[9], a[10], a[11], a[12], a[13], a[14], a[15]); \
        o0v = MFMA32(VFRAG(buf, 0), p0_, o0v); o0v = MFMA32(VFRAG(buf, 1), p1_, o0v); o1v = MFMA32(VFRAG(buf, 2), p0_, o1v); o1v = MFMA32(VFRAG(buf, 3), p1_, o1v); } while (0)
    constexpr float SM_THR = 8.0f;
#define REF_EVENT(a, mref, started, d, fs) { const float tm_ = xmax32(max16(a)); const bool need_ = started ? (tm_ > SM_THR) : (tm_ > -1e29f); d = 0.f; fs = 1.f; \
        if (__any(need_)) { d = need_ ? tm_ : 0.f; fs = (need_ && started) ? __builtin_amdgcn_exp2f(-d) : 1.f; mref += d; started = started || need_; _Pragma("unroll") for (int r = 0; r < 16; ++r) a[r] -= d; } }
    const int ncb = (tile0 + 63 >= 31) ? min((tile0 + 63 - 31) / 16 + 1, NCMP) : 0, ntc = (ncb + 31) >> 5;
    const int nfar = (t0 >= 144) ? (t0 - 144) / 16 + 1 : 0;
#define CSCORE(a, buf, n0v, farv, refv) do { { const float ini_ = ((farv) ? cb : 0.f) - (refv); _Pragma("unroll") for (int r = 0; r < 16; ++r) a[r] = ini_; } \
        _Pragma("unroll") for (int ks = 0; ks < 4; ++ks) a = MFMA32(KFRAG(buf, ks), bq[ks], a); \
        if (!(farv)) { _Pragma("unroll") for (int r = 0; r < 16; ++r) { const int dist = t - (16 * ((n0v) + crow(r, hi)) + 31); const float bt = BT[h * 128 + min(max(dist, 0), 127)]; a[r] = dist >= 0 ? a[r] + bt : -1e30f; } } } while (0)
#define STAGE_PROLOGUE(Kp, kmax, VTp, gmax, nbase, ntl) v4u RA, RB; { RA = STAGE_LOAD(Kp, kmax, VTp, gmax, nbase); STAGE_WRITE(RA, 0); RB = STAGE_LOAD(Kp, kmax, VTp, gmax, (nbase) + 32 * min(1, (ntl) - 1)); __syncthreads(); }
    float mc = 0.f, lc = 0.f; bool stc = false;
    if (ntc > 0) {
        STAGE_PROLOGUE(P.KCB, 1023, P.VTC, 31, 0, ntc)
#define C1STEP(iv, BUF, RL, RW) { const int i = (iv); if (i >= ntc) break; const int n0 = 32 * i; RL = STAGE_LOAD(P.KCB, 1023, P.VTC, 31, 32 * min(i + 2, ntc - 1)); \
            const bool far = (n0 + 32 <= nfar); f32x16 a; CSCORE(a, BUF, n0, far, mc); \
            float d_, fs_; REF_EVENT(a, mc, stc, d_, fs_) lc *= fs_; \
            _Pragma("unroll") for (int r = 0; r < 16; ++r) a[r] = __builtin_amdgcn_exp2f(a[r]); \
            lc += xsum32(sum16(a)); STAGE_WRITE(RW, (BUF) ^ 1); __syncthreads(); }
        for (int ib = 0; ; ib += 2) { C1STEP(ib, 0, RA, RB) C1STEP(ib + 1, 1, RB, RA) }
#undef C1STEP
    }
    {   const float invl = 1.0f / fmaxf(lc, 1e-30f); f32x16 oc0 = {}, oc1 = {}; float carry = 0.f;
#define CIMP(a, n0v) do { float mq[4], cq[4]; \
            _Pragma("unroll") for (int qg = 0; qg < 4; ++qg) { float mv = (2.0f * (a[4 * qg] + a[4 * qg + 1] + a[4 * qg + 2]) + a[4 * qg + 3]) * invl, cv = a[4 * qg + 3] * invl; \
                mv += __int_as_float(DPPI(__float_as_int(mv), 0xB1)); mv += __int_as_float(DPPI(__float_as_int(mv), 0x4E)); \
                cv += __int_as_float(DPPI(__float_as_int(cv), 0xB1)); cv += __int_as_float(DPPI(__float_as_int(cv), 0x4E)); mq[qg] = mv; cq[qg] = cv; } \
            float oth[4]; \
            _Pragma("unroll") for (int qg = 0; qg < 4; ++qg) { auto rr = __builtin_amdgcn_permlane32_swap(__float_as_uint(cq[qg]), __float_as_uint(cq[qg]), false, false); oth[qg] = __uint_as_float(hi ? rr[0] : rr[1]); } \
            _Pragma("unroll") for (int qg = 0; qg < 4; ++qg) { const float tot = mq[qg] + (hi ? oth[qg] : (qg ? oth[qg - 1] : carry)); if (hr == 0) scores[ti * SCS + (((n0v) + 8 * qg + 4 * hi) >> 2)] = tot; } \
            carry = oth[3]; } while (0)
        if (ntc > 0) {
            STAGE_PROLOGUE(P.KCB, 1023, P.VTC, 31, 0, ntc)
#define C2STEP(iv, BUF, RL, RW) { const int i = (iv); if (i >= ntc) break; const int n0 = 32 * i; RL = STAGE_LOAD(P.KCB, 1023, P.VTC, 31, 32 * min(i + 2, ntc - 1)); \
                const bool far = (n0 + 32 <= nfar); f32x16 a; CSCORE(a, BUF, n0, far, mc); \
                _Pragma("unroll") for (int r = 0; r < 16; ++r) a[r] = __builtin_amdgcn_exp2f(a[r]); \
                CIMP(a, n0); PVACC(oc0, oc1, BUF, a); STAGE_WRITE(RW, (BUF) ^ 1); __syncthreads(); }
            for (int ib = 0; ; ib += 2) { C2STEP(ib, 0, RA, RB) C2STEP(ib + 1, 1, RB, RA) }
#undef C2STEP
            { const int jn = ntc * 8; if (jn < 256 && hi == 0 && hr == 0) scores[ti * SCS + jn] = carry; }
        }
#undef CIMP
        {   LAS unsigned char* park = lds + AT_PARK + (((8 * wave + ti) * 4 + hr) * 64) * 2;
            const float gs = g0 * invl;
#pragma unroll
            for (int d0 = 0; d0 < 2; ++d0)
#pragma unroll
                for (int r4 = 0; r4 < 4; ++r4) { const f32x16& Wd = d0 ? oc1 : oc0; const int dim = 32 * d0 + 8 * r4 + 4 * hi;
                    *(LAS unsigned long long*)(park + dim * 2) = (unsigned long long)cvt_pk_bf16(Wd[4 * r4] * gs, Wd[4 * r4 + 1] * gs) | ((unsigned long long)cvt_pk_bf16(Wd[4 * r4 + 2] * gs, Wd[4 * r4 + 3] * gs) << 32); } } }
#undef CSCORE
    {   float mw = 0.f, lw = 0.f; bool stw = false; f32x16 o0 = {}, o1 = {};
        const int nlo = max(t0 - 511, 0) & ~31, nhi = (t0 + 7) & ~31;
        const int nlb = max(tile0 - 511, 0) & ~31, ntw = (((tile0 + 63) & ~31) - nlb) / 32 + 1;
        const LAS float* xrb = (const LAS float*)(lds + AT_LIST) + hr * XRN + (575 - ti + 4 * hi);
        STAGE_PROLOGUE(P.KW, S - 1, P.VTW, 511, nlb, ntw)
#define WSTEP(iv, BUF, RL, RW) { const int i = (iv); if (i >= ntw) break; const int n0 = nlb + 32 * i; RL = STAGE_LOAD(P.KW, S - 1, P.VTW, 511, nlb + 32 * min(i + 2, ntw - 1)); \
            if (n0 >= nlo && n0 <= nhi) { const bool mid = (n0 >= t0 - 504) && (n0 <= t0 - 144); \
                f32x16 a; if (mid) { const float ini_ = cb - mw; _Pragma("unroll") for (int r = 0; r < 16; ++r) a[r] = ini_; } \
                else { const LAS float* xr_ = xrb + (n0 - t0); _Pragma("unroll") for (int r = 0; r < 16; ++r) a[r] = xr_[(r & 3) + 8 * (r >> 2)] - mw; } \
                _Pragma("unroll") for (int ks = 0; ks < 4; ++ks) a = MFMA32(KFRAG(BUF, ks), bq[ks], a); \
                float d_, fs_; REF_EVENT(a, mw, stw, d_, fs_) if (fs_ != 1.f || d_ != 0.f) { lw *= fs_; o0 = o0 * fs_; o1 = o1 * fs_; } \
                _Pragma("unroll") for (int r = 0; r < 16; ++r) a[r] = __builtin_amdgcn_exp2f(a[r]); \
                lw += xsum32(sum16(a)); PVACC(o0, o1, BUF, a); } \
            STAGE_WRITE(RW, (BUF) ^ 1); __syncthreads(); }
        for (int ib = 0; ; ib += 2) { WSTEP(ib, 0, RA, RB) WSTEP(ib + 1, 1, RB, RA) }
#undef WSTEP
        const float sc = g2 / fmaxf(lw, 1e-30f);
        LAS unsigned char* park = lds + AT_PARK + (((8 * wave + ti) * 4 + hr) * 64) * 2;
#pragma unroll
        for (int d0 = 0; d0 < 2; ++d0)
#pragma unroll
            for (int r4 = 0; r4 < 4; ++r4) { const f32x16& Od = d0 ? o1 : o0; const int dim = 32 * d0 + 8 * r4 + 4 * hi; const unsigned long long w = *(const LAS unsigned long long*)(park + dim * 2); const unsigned lo = (unsigned)w, hw = (unsigned)(w >> 32);
                *(LAS unsigned long long*)(park + dim * 2) = (unsigned long long)cvt_pk_bf16(bflo(lo) + Od[4 * r4] * sc, bfhi(lo) + Od[4 * r4 + 1] * sc) | ((unsigned long long)cvt_pk_bf16(bflo(hw) + Od[4 * r4 + 2] * sc, bfhi(hw) + Od[4 * r4 + 3] * sc) << 32); } }
#undef REF_EVENT
#undef STAGE_PROLOGUE
#undef PVACC
#undef KFRAG
#undef VFRAG
#undef STAGE_LOAD
#undef STAGE_WRITE
    LDS_WAIT();
    {   const int cur = tile0 >> 6, i = lane >> 3, s8 = lane & 7;
        if (cur + 1 <= 16) { for (int e = lane; e < 8 * 16; e += 64) sel[e] = e & 15; }
        else {
            float sv[32];
#pragma unroll
            for (int k = 0; k < 32; ++k) { const int j = s8 + 8 * k; sv[k] = (j >= 1 && j <= cur - 2) ? scores[i * SCS + j] : -3e38f; }
            if (s8 == 0) { sel[i * 16 + 0] = 0; sel[i * 16 + 1] = cur - 1; sel[i * 16 + 2] = cur; }
            for (int it = 3; it < 16; ++it) {
                float bv = sv[0]; int bj = s8;
#pragma unroll
                for (int k = 1; k < 32; ++k) if (sv[k] > bv) { bv = sv[k]; bj = s8 + 8 * k; }
#define SEL_STEP(ctrl) { const float ov = __int_as_float(DPPI(__float_as_int(bv), ctrl)); const int oj = DPPI(bj, ctrl); if (ov > bv || (ov == bv && oj < bj)) { bv = ov; bj = oj; } }
                SEL_STEP(0xB1) SEL_STEP(0x4E) SEL_STEP(0x141)
#undef SEL_STEP
                if (s8 == 0) sel[i * 16 + it] = bj;
#pragma unroll
                for (int k = 0; k < 32; ++k) if (bj == s8 + 8 * k) sv[k] = -3e38f;
            }
        }
    }
}

__device__ __forceinline__ void s_scores(const bf16x8 (&kf)[8], const bf16x8 q0, const bf16x8 q1, bool cst, float cbs, const LAS float* BT, int hs, int tt, int j, int q, f32x4 (&sa)[4]) {
#pragma unroll
    for (int mt = 0; mt < 4; ++mt) { const float ini = cst ? cbs : 0.f; sa[mt] = (f32x4){ini, ini, ini, ini}; sa[mt] = MFMA16(kf[mt * 2], q0, sa[mt]); sa[mt] = MFMA16(kf[mt * 2 + 1], q1, sa[mt]); }
    if (!cst) {
#pragma unroll
        for (int mt = 0; mt < 4; ++mt)
#pragma unroll
            for (int r = 0; r < 4; ++r) { const int dist = tt - (64 * j + 16 * mt + 4 * q + r); const float bt = BT[hs * 128 + min(max(dist, 0), 127)]; sa[mt][r] = dist >= 0 ? sa[mt][r] + bt : -1e30f; } }
}
template <bool MASKED> __device__ __forceinline__ void s_softmax(f32x4 (&sa)[4], float& tm, float& ls) {
    tm = sa[0][0];
#pragma unroll
    for (int mt = 0; mt < 4; ++mt)
#pragma unroll
        for (int r = 0; r < 4; ++r) tm = fmaxf(tm, sa[mt][r]);
    tm = xmax32(xmax16(tm)); ls = 0.f;
#pragma unroll
    for (int mt = 0; mt < 4; ++mt)
#pragma unroll
        for (int r = 0; r < 4; ++r) { const float e = __builtin_amdgcn_exp2f(sa[mt][r] - tm); sa[mt][r] = (!MASKED || sa[mt][r] > -1e29f) ? e : 0.f; ls += sa[mt][r]; }
    ls = xsum32(xsum16(ls));
}
__device__ __forceinline__ void load_kf(const AttnPtrs& P, int lane, int j, bf16x8 (&kf)[8]) {
    const bf16* kp = P.KS + (size_t)(64 * j + (lane & 15)) * 64 + 8 * (lane >> 4);
#pragma unroll
    for (int mt = 0; mt < 4; ++mt) { kf[mt * 2] = *(const bf16x8*)(kp + (size_t)mt * 16 * 64); kf[mt * 2 + 1] = *(const bf16x8*)(kp + (size_t)mt * 16 * 64 + 32); }
}
__device__ __forceinline__ void load_vf(const AttnPtrs& P, int lane, int j, bf16x8 (&vf)[8]) {
    const bf16x8* vt = P.VTS + (size_t)j * 8 * 64 + lane;
#pragma unroll
    for (int e = 0; e < 8; ++e) vf[e] = vt[e * 64];
}
__device__ __forceinline__ void s_chunk(const bf16x8 (&kf)[8], const bf16x8 (&vf)[8], int j, int ch, int n, bool cst, float cbs, const LAS float* BT, const LAS unsigned short* list,
                                        const LAS unsigned char* qt, unsigned char* slab, int tile0, int c, int q, int hd, int hs) {
    const int sidx = 4 * ch + (c >> 2); const bool valid = sidx < n; const int sl = (int)list[j * 64 + (valid ? sidx : 0)]; const int tokl = sl / 13, r = tokl * 4 + hd;
    const LAS unsigned char* qr = qt + r * 128; const bf16x8 q0 = *(const LAS bf16x8*)(qr + ((q ^ (r & 7)) << 4)), q1 = *(const LAS bf16x8*)(qr + (((q + 4) ^ (r & 7)) << 4));
    f32x4 sa[4]; s_scores(kf, q0, q1, cst, cbs, BT, hs, tile0 + tokl, j, q, sa);
    float tm, ls; s_softmax<false>(sa, tm, ls);
    const bf16x8 p0 = pack8(sa[0][0], sa[0][1], sa[0][2], sa[0][3], sa[1][0], sa[1][1], sa[1][2], sa[1][3]), p1 = pack8(sa[2][0], sa[2][1], sa[2][2], sa[2][3], sa[3][0], sa[3][1], sa[3][2], sa[3][3]);
    unsigned char* po = slab + ((size_t)(sl * 4 + hd) * 64 + 16 * q) * 2;
    unsigned pw[8];
#pragma unroll
    for (int dt = 0; dt < 4; ++dt) { f32x4 oa = {0.f, 0.f, 0.f, 0.f}; oa = MFMA16(vf[dt * 2], p0, oa); oa = MFMA16(vf[dt * 2 + 1], p1, oa); pw[2 * dt] = cvt_pk_bf16(oa[0], oa[1]); pw[2 * dt + 1] = cvt_pk_bf16(oa[2], oa[3]); }
    if (valid) { *(v4u*)po = (v4u){pw[0], pw[1], pw[2], pw[3]}; *(v4u*)(po + 16) = (v4u){pw[4], pw[5], pw[6], pw[7]}; }
    if (valid && q == 0) *(f32x2*)(slab + PML_OFF + (size_t)(sl * 4 + hd) * 8) = (f32x2){tm, ls};
}
__device__ __forceinline__ void attn_stageB(const AttnPtrs& P, int lane, int wave, int tile0, int g, LAS unsigned char* lds, unsigned char* slab) {
    const int T = tile0 >> 6, c = lane & 15, q = lane >> 4, hd = c & 3, hs = g * 4 + hd;
    if (T <= 15) return;
    LAS unsigned* cnt = (LAS unsigned*)(lds + AT_CNT); const LAS unsigned short* list = (const LAS unsigned short*)(lds + AT_LIST); const LAS float* BT = (const LAS float*)(lds + AT_BT);
    const LAS unsigned char* qt = lds + AT_SC;
    const float cbs = BT[hs * 128 + 127];
#define GRAB_ISSUE(tv) { tv = 0; if (lane == 0) tv = (int)__hip_atomic_fetch_add(&cnt[0], 1u, __ATOMIC_RELAXED, __HIP_MEMORY_SCOPE_WORKGROUP); }
#define GRAB_TAKE(tv, jv, nv) { jv = (int)__builtin_amdgcn_readfirstlane(tv) + 1; nv = 0; if (jv <= T - 2) nv = (int)__builtin_amdgcn_readfirstlane((int)cnt[jv]); }
    bf16x8 KA[8], VA[8], KB[8], VB[8];
    int jc, nc, jn, nn;
    { int t0_, t1_; GRAB_ISSUE(t0_) GRAB_ISSUE(t1_) GRAB_TAKE(t0_, jc, nc) if (jc > T - 2) return; GRAB_TAKE(t1_, jn, nn) }
    load_kf(P, lane, jc, KA); load_vf(P, lane, jc, VA);
    load_kf(P, lane, min(jn, T - 2), KB); load_vf(P, lane, min(jn, T - 2), VB);
#define BSTEP(KX, VX) { int t2_; GRAB_ISSUE(t2_) \
        { const bool cst = (jc <= T - 3);        \
          if (nc > 0) s_chunk(KX, VX, jc, 0, nc, cst, cbs, BT, list, qt, slab, tile0, c, q, hd, hs); \
          if (nc > 4) s_chunk(KX, VX, jc, 1, nc, cst, cbs, BT, list, qt, slab, tile0, c, q, hd, hs); \
          if (nc > 8) { _Pragma("unroll 1") for (int ch = 2; 4 * ch < nc; ++ch) s_chunk(KX, VX, jc, ch, nc, cst, cbs, BT, list, qt, slab, tile0, c, q, hd, hs); } } \
        int j2_, n2_; GRAB_TAKE(t2_, j2_, n2_) \
        load_kf(P, lane, min(j2_, T - 2), KX); load_vf(P, lane, min(j2_, T - 2), VX); \
        jc = jn; nc = nn; jn = j2_; nn = n2_; }
    do { BSTEP(KA, VA) BSTEP(KB, VB) } while (jc <= T - 2);
#undef BSTEP
#undef GRAB_ISSUE
#undef GRAB_TAKE
}
struct SState { float M, L; f32x4 O[4]; };
__device__ __forceinline__ void s_merge(SState& st, float m, float l, const f32x4 (&o)[4]) {
    const float mn = fmaxf(st.M, m), a0 = __builtin_amdgcn_exp2f(st.M - mn), a1 = __builtin_amdgcn_exp2f(m - mn);
    st.L = st.L * a0 + l * a1; st.M = mn;
#pragma unroll
    for (int dt = 0; dt < 4; ++dt) st.O[dt] = st.O[dt] * a0 + o[dt] * a1;
}
__device__ __forceinline__ void attn_stageC_forced(const AttnPtrs& P, int lane, int wave, int tile0, int g, LAS unsigned char* lds, SState (&st)[2]) {
    const int T = tile0 >> 6, c = lane & 15, q = lane >> 4, hd = c & 3, hs = g * 4 + hd; const LAS float* BT = (const LAS float*)(lds + AT_BT); const float cbs = BT[hs * 128 + 127];
    bf16x8 q0[2], q1[2];
#pragma unroll
    for (int k = 0; k < 2; ++k) { const int tt = tile0 + 8 * wave + 4 * k + (c >> 2); q0[k] = *(const bf16x8*)(P.Q + (size_t)tt * 512 + hs * 64 + 8 * q); q1[k] = *(const bf16x8*)(P.Q + (size_t)tt * 512 + hs * 64 + 32 + 8 * q);
        st[k].M = -1e30f; st[k].L = 0.f;
#pragma unroll
        for (int dt = 0; dt < 4; ++dt) st[k].O[dt] = (f32x4){0.f, 0.f, 0.f, 0.f}; }
    const int nf = T <= 15 ? T + 1 : 3;
    auto fblk = [&](int it) -> int { return T <= 15 ? it : (it == 0 ? 0 : (it == 1 ? T - 1 : T)); };
    bf16x8 kf[8], vf[8]; load_kf(P, lane, fblk(0), kf); load_vf(P, lane, fblk(0), vf);
#pragma unroll 1
    for (int it = 0; it < nf; ++it) { const int j = fblk(it);
        bf16x8 kn[8]; load_kf(P, lane, fblk(min(it + 1, nf - 1)), kn);
        const bool cst = (j <= T - 3);
#pragma unroll
        for (int k = 0; k < 2; ++k) { const int tt = tile0 + 8 * wave + 4 * k + (c >> 2);
            f32x4 sa[4]; s_scores(kf, q0[k], q1[k], cst, cbs, BT, hs, tt, j, q, sa);
            float tm, ls; s_softmax<true>(sa, tm, ls);
            const bf16x8 p0 = pack8(sa[0][0], sa[0][1], sa[0][2], sa[0][3], sa[1][0], sa[1][1], sa[1][2], sa[1][3]), p1 = pack8(sa[2][0], sa[2][1], sa[2][2], sa[2][3], sa[3][0], sa[3][1], sa[3][2], sa[3][3]);
            f32x4 ob[4];
#pragma unroll
            for (int dt = 0; dt < 4; ++dt) { ob[dt] = (f32x4){0.f, 0.f, 0.f, 0.f}; ob[dt] = MFMA16(vf[dt * 2], p0, ob[dt]); ob[dt] = MFMA16(vf[dt * 2 + 1], p1, ob[dt]); }
            s_merge(st[k], tm, ls, ob); }
#pragma unroll
        for (int e = 0; e < 8; ++e) kf[e] = kn[e];
        if (it + 1 < nf) load_vf(P, lane, fblk(it + 1), vf);
    }
}
__device__ __forceinline__ void attn_stageC_merge(const AttnPtrs& P, int lane, int wave, int tile0, int g, LAS unsigned char* lds, const unsigned char* slab, SState (&st)[2]) {
    const int T = tile0 >> 6, c = lane & 15, q = lane >> 4, hd = c & 3, hs = g * 4 + hd;
#pragma unroll
    for (int k = 0; k < 2; ++k) { const int tok = 8 * wave + 4 * k + (c >> 2), tt = tile0 + tok;
        if (T > 15) {
#pragma unroll
            for (int b0 = 0; b0 < 13; b0 += 7) {
                f32x2 mlv[7]; v4u ow[7][2];
#pragma unroll
                for (int bb = 0; bb < 7; ++bb) if (b0 + bb < 13) { const int sl = tok * 13 + b0 + bb;
                    mlv[bb] = *(const f32x2*)(slab + PML_OFF + (size_t)(sl * 4 + hd) * 8);
                    const unsigned char* po = slab + ((size_t)(sl * 4 + hd) * 64 + 16 * q) * 2; ow[bb][0] = *(const v4u*)po; ow[bb][1] = *(const v4u*)(po + 16); }
#pragma unroll
                for (int bb = 0; bb < 7; ++bb) if (b0 + bb < 13) { f32x4 ob[4];
                    ob[0] = (f32x4){bflo(ow[bb][0].x), bfhi(ow[bb][0].x), bflo(ow[bb][0].y), bfhi(ow[bb][0].y)}; ob[1] = (f32x4){bflo(ow[bb][0].z), bfhi(ow[bb][0].z), bflo(ow[bb][0].w), bfhi(ow[bb][0].w)};
                    ob[2] = (f32x4){bflo(ow[bb][1].x), bfhi(ow[bb][1].x), bflo(ow[bb][1].y), bfhi(ow[bb][1].y)}; ob[3] = (f32x4){bflo(ow[bb][1].z), bfhi(ow[bb][1].z), bflo(ow[bb][1].w), bfhi(ow[bb][1].w)};
                    s_merge(st[k], mlv[bb].x, mlv[bb].y, ob); } } }
        const float g1 = bf2f(P.GN[(size_t)tt * 32 + hs * 3 + 1]) / fmaxf(st[k].L, 1e-30f);
        LAS unsigned char* park = lds + AT_PARK + ((tok * 4 + hd) * 64 + 4 * q) * 2;
#pragma unroll
        for (int dt = 0; dt < 4; ++dt) { const unsigned long long w = *(const LAS unsigned long long*)(park + dt * 32); const unsigned lo = (unsigned)w, hw = (unsigned)(w >> 32);
            const unsigned o0 = cvt_pk_bf16(bflo(lo) + g1 * st[k].O[dt][0], bfhi(lo) + g1 * st[k].O[dt][1]), o1 = cvt_pk_bf16(bflo(hw) + g1 * st[k].O[dt][2], bfhi(hw) + g1 * st[k].O[dt][3]);
            *(LAS unsigned long long*)(park + dt * 32) = (unsigned long long)o0 | ((unsigned long long)o1 << 32); } }
    LDS_WAIT();
#pragma unroll
    for (int e = 0; e < 4; ++e) { const int idx = lane + 64 * e, tokl = idx >> 5, piece = idx & 31;
        *(v4u*)((unsigned char*)P.O + (size_t)(tile0 + 8 * wave + tokl) * 1024 + g * 512 + piece * 16) = *(const LAS v4u*)(lds + AT_PARK + (8 * wave + tokl) * 512 + piece * 16); }
    LDS_WAIT();
}
__device__ __forceinline__ void attn_tile(const Frame& F, unsigned char* ws, int tile, int g, unsigned soff) {
    int lane = F.lane; asm volatile("" : "+v"(lane));
    const int wave = F.wave, tile0 = tile * 64, T = tile; LAS unsigned char* lds = F.lds;
    if (F.tid < 256) ((LAS unsigned*)(lds + AT_CNT))[F.tid] = 0u;
    AttnPtrs P;
    {   const bf16* KVH = (const bf16*)(ws + WS_KVH);
        P.Q = (const bf16*)(ws + WS_Q); P.KCB = (const bf16*)(ws + WS_KCB) + (size_t)g * 1024 * 64; P.VTC = (const bf16x8*)(ws + WS_VTC) + (size_t)g * 32 * 4 * 64;
        P.KW = KVH + (size_t)(8 + g) * S * 64; P.VTW = (const bf16x8*)(ws + WS_VTW) + (size_t)g * 512 * 4 * 64; P.GN = (const bf16*)(ws + WS_GN);
        P.KS = nullptr; P.VTS = nullptr; P.O = nullptr; }
    attn_stageA(P, lane, wave, tile0, g, lds);
    __syncthreads();
    unsigned char* ws2 = ws;
    {   const bf16* KVH = (const bf16*)(ws2 + WS_KVH);
        P.Q = (const bf16*)(ws2 + WS_Q); P.KS = KVH + (size_t)(4 + g) * S * 64; P.VTS = (const bf16x8*)(ws2 + WS_VTS) + (size_t)g * 256 * 8 * 64; P.GN = (const bf16*)(ws2 + WS_GN); P.O = (bf16*)(ws2 + WS_O);
        P.KCB = nullptr; P.VTC = nullptr; P.KW = nullptr; P.VTW = nullptr; }
    unsigned char* slab = ((blockIdx.x < 128) ? (unsigned char*)F.out : ws2 + WS_PSLAB) + soff;
    if (T > 15) {
        LAS unsigned* cnt = (LAS unsigned*)(lds + AT_CNT); LAS unsigned short* list = (LAS unsigned short*)(lds + AT_LIST); const LAS int* sel = (const LAS int*)(lds + AT_SEL);
        const int tok = F.tid >> 3;
        v4u qv[4];
#pragma unroll
        for (int e = 0; e < 4; ++e) { const int idx = F.tid + 512 * e, row = idx >> 3, piece = idx & 7; qv[e] = *(const v4u*)((const unsigned char*)P.Q + (size_t)(tile0 + (row >> 2)) * 1024 + g * 512 + (row & 3) * 128 + piece * 16); }
#pragma unroll
        for (int e = 0; e < 2; ++e) { const int b = (F.tid & 7) * 2 + e;
            if (b >= 3) { const int j = sel[tok * 16 + b]; const unsigned pos = __hip_atomic_fetch_add(&cnt[j], 1u, __ATOMIC_RELAXED, __HIP_MEMORY_SCOPE_WORKGROUP); list[j * 64 + pos] = (unsigned short)(tok * 13 + b - 3); } }
#pragma unroll
        for (int e = 0; e < 4; ++e) { const int idx = F.tid + 512 * e, row = idx >> 3, piece = idx & 7; *(LAS v4u*)(lds + AT_SC + row * 128 + ((piece ^ (row & 7)) << 4)) = qv[e]; }
        __syncthreads(); }
    attn_stageB(P, lane, wave, tile0, g, lds, slab);
    SState st[2];
    attn_stageC_forced(P, lane, wave, tile0, g, lds, st);
    asm volatile("s_waitcnt vmcnt(0)" ::: "memory");
    __syncthreads();
    __builtin_amdgcn_fence(__ATOMIC_ACQUIRE, "agent");
    attn_stageC_merge(P, lane, wave, tile0, g, lds, slab, st);
    __syncthreads();
}

#define XB_TMO      128
#define XB_XCNT(j)  (256  + 64 * (j))
#define XB_XSUB(j)  (1280 + 64 * (j))
#define XB_XGEN(j)  (2304 + 64 * (j))
#define XB_TOP      3328
#define XB_TOPGEN   3392
#define XCD_BAR_WORDS 3456
#define XB_SPIN_CAP (1u << 22)
__device__ __forceinline__ unsigned xb_ld(unsigned* p)              { return __hip_atomic_load(p, __ATOMIC_RELAXED, __HIP_MEMORY_SCOPE_AGENT); }
__device__ __forceinline__ unsigned xb_add(unsigned* p, unsigned v) { return __hip_atomic_fetch_add(p, v, __ATOMIC_RELAXED, __HIP_MEMORY_SCOPE_AGENT); }
__device__ __forceinline__ unsigned xb_xcc_id() { return (unsigned)__builtin_amdgcn_s_getreg((3 << 11) | 20) & 0xFu; }
#define XB_SPIN(cond, bar) do { unsigned _sp = 0; while (cond) { __builtin_amdgcn_s_sleep(1); \
    if ((++_sp & 255u) == 0u) { if (xb_ld(&(bar)[XB_TMO])) break; if (_sp > XB_SPIN_CAP) { atomicAdd(&(bar)[XB_TMO], 1u); break; } } } } while (0)
struct XcdBarrier { unsigned* bar; unsigned x; volatile LAS unsigned* st; };
__device__ __forceinline__ XcdBarrier xcd_barrier_post(unsigned* bar, volatile LAS unsigned* st) {
    XcdBarrier b; b.bar = bar; b.x = xb_xcc_id(); b.st = st;
    if (threadIdx.x == 0) (void)xb_add(&bar[XB_XCNT(b.x)], 1u);
    return b;
}
__device__ __forceinline__ void xcd_barrier_complete(unsigned* bar, unsigned x, unsigned& nloc, unsigned& nx) {
    const unsigned G = gridDim.x * gridDim.y * gridDim.z;
    unsigned sum, cnt, mine, sp = 0u;
    for (;;) {
        sum = 0u; cnt = 0u; mine = 0u;
#pragma unroll
        for (unsigned j = 0; j < 16; ++j) { const unsigned c = xb_ld(&bar[XB_XCNT(j)]); sum += c; cnt += (c > 0u) ? 1u : 0u; mine = (j == x) ? c : mine; }
        if (sum == G) break;
        __builtin_amdgcn_s_sleep(1);
        if ((++sp & 255u) == 0u) { if (xb_ld(&bar[XB_TMO])) break; if (sp > XB_SPIN_CAP) { atomicAdd(&bar[XB_TMO], 1u); break; } }
    }
    nloc = mine > 0u ? mine : 1u; nx = cnt > 0u ? cnt : 1u;
}
__device__ __forceinline__ void xcd_barrier(const XcdBarrier& b) {
    asm volatile("s_waitcnt vmcnt(0)" ::: "memory");
    __syncthreads();
    if (threadIdx.x == 0) {
        unsigned* bar = b.bar;
        __builtin_amdgcn_s_waitcnt(0);
        unsigned nloc = b.st[0], nx = b.st[1];
        if (nloc == 0u) { xcd_barrier_complete(bar, b.x, nloc, nx); b.st[0] = nloc; b.st[1] = nx; }
        const unsigned old = xb_add(&bar[XB_XSUB(b.x)], 1u);
        const unsigned gen = old / nloc;
        if (old + 1u == (gen + 1u) * nloc) {
            __builtin_amdgcn_fence(__ATOMIC_RELEASE, "agent");
            asm volatile("s_waitcnt vmcnt(0)" ::: "memory");
            const unsigned og = xb_add(&bar[XB_TOP], 1u);
            const unsigned tg = og / nx;
            if (og + 1u == (tg + 1u) * nx) xb_add(&bar[XB_TOPGEN], 1u);
            else XB_SPIN(xb_ld(&bar[XB_TOPGEN]) == tg, bar);
            __builtin_amdgcn_fence(__ATOMIC_ACQUIRE, "agent");
            xb_add(&bar[XB_XGEN(b.x)], 1u);
            asm volatile("s_waitcnt vmcnt(0)" ::: "memory");
        } else {
            XB_SPIN(xb_ld(&bar[XB_XGEN(b.x)]) == gen, bar);
            __builtin_amdgcn_fence(__ATOMIC_ACQUIRE, "agent");
            asm volatile("s_waitcnt vmcnt(0)" ::: "memory");
        }
    }
    __syncthreads();
}

__global__ void __launch_bounds__(NWAVES * 64, 2) mk_fwd(Args args) {
    extern __shared__ __attribute__((aligned(16))) unsigned char lds_raw[];
    Frame F;
    F.lds = (LAS unsigned char*)lds_raw;
#define REFRESH() do { int t_ = threadIdx.x; asm volatile("" : "+v"(t_)); F.tid = t_; F.lane = t_ & 63; F.wave = __builtin_amdgcn_readfirstlane(t_ >> 6); F.gw = blockIdx.x * NWAVES + F.wave; } while (0)
    F.G = gridDim.x; F.ngw = F.G * NWAVES; REFRESH();
    F.out = args.out; F.ws = args.ws;
    const int lo = args.ph_lo, hi = args.ph_hi;
#define IN(k) (lo <= (k) && (k) < hi)
#ifndef USE_CG_SYNC
#define USE_CG_SYNC 0
#endif
    volatile LAS unsigned* bst = (volatile LAS unsigned*)(F.lds + LDS_BYTES - 64);
    if (F.tid < 16) bst[F.tid] = 0u;
    __syncthreads();
    XcdBarrier gbar; gbar.bar = (unsigned*)(F.ws + WS_CTL); gbar.x = 0; gbar.st = bst;
    if (!USE_CG_SYNC && hi - lo > 1) gbar = xcd_barrier_post((unsigned*)(F.ws + WS_CTL), bst);
#define SEAM(k) do { if (IN(k) && IN((k) + 1)) { if (USE_CG_SYNC) cg::this_grid().sync(); else xcd_barrier(gbar); } } while (0)
    unsigned char* ws = F.ws;
    if (IN(0)) { REFRESH(); p0_prologue(F, args); }
    SEAM(0);
    if (IN(1)) { REFRESH();
        pg8::Gemm g{(const bf16*)(ws + WS_XN), (const bf16*)(ws + WS_WIN), S, NPJ, 1024, 1024}; pg8::StaticOrder So; So.init(S, NPJ, F.G, (int)blockIdx.x);
        EpiProj E{(bf16*)(ws + WS_U), (bf16*)(ws + WS_Q), (bf16*)(ws + WS_KVH), (bf16*)(ws + WS_G), (bf16*)(ws + WS_GN)};
        pg8::gemm_phase<EpiProj, pg8::StaticOrder>(F.lds, g, So, E);
    }
    SEAM(1);
    if (IN(2)) { REFRESH();
        for (int u = F.gw; u < 64 * 32; u += F.ngw) s5_unit<false>(F, args, u >> 5, u & 31, F.lds + F.wave * 16384, F.lds + 131072 + F.wave * 2048);
        __syncthreads();
        pg8::Gemm g{(const bf16*)(ws + WS_KVH), (const bf16*)(ws + WS_WC1), 4096, 1024, 1024 / CMP_KS, 1024}; pg8::CmpOrder So{F.G, (int)blockIdx.x, CMP_KS};
        EpiCmp E{F.out};
        pg8::gemm_phase<EpiCmp, pg8::CmpOrder>(F.lds, g, So, E);
    }
    SEAM(2);
    if (IN(3)) { REFRESH();
        for (int u = F.gw; u < 64 * 32; u += F.ngw) s5_unit<true>(F, args, u >> 5, u & 31, F.lds + F.wave * 16384, F.lds + 131072 + F.wave * 2048);
        for (int u0 = 0; u0 < 4 * 1024; u0 += F.ngw) { const int u = u0 + F.gw; const int kvb = (u0 + (int)blockIdx.x * NWAVES) >> 11;
            __syncthreads();
            { const float* w2 = kvb ? args.in[18] : args.in[16]; LAS f32x4* wd = (LAS f32x4*)(F.lds + 8 * 2048); for (int e = F.tid; e < 256 * 64 / 4; e += NWAVES * 64) wd[e] = ((const f32x4*)w2)[e]; }
            __syncthreads();
            if (u < 4 * 1024) { const int kvg = u >> 10, n = u & 1023; cmp_l2_unit(F, args, kvg >> 1, kvg & 1, n, (LAS float*)(F.lds + F.wave * 2048), (const LAS float*)(F.lds + 8 * 2048)); } }
        __syncthreads();
        for (int u = F.gw; u < 2 * 512; u += F.ngw) vtw_item(F, u >> 9, u & 511, (LAS unsigned short*)(F.lds + 81920 + F.wave * 8192));
        for (int u = F.gw; u < 2 * 256; u += F.ngw) vts_item(F, u >> 8, u & 255, (LAS unsigned short*)(F.lds + 81920 + F.wave * 8192));
    }
    SEAM(3);
    if (IN(4)) { REFRESH();
        LAS float* BT = (LAS float*)(F.lds + AT_BT);
        for (int i = F.tid; i < 8 * 128; i += NWAVES * 64) { const int h = i >> 7, d = i & 127;
            int bk = d; if (d >= 16) { bk = 16 + (int)(logf((float)d * (1.0f / 16.0f)) / 2.0794415416798357f * 16.0f); if (bk > 31) bk = 31; }
            BT[i] = args.in[19][bk * 8 + h] * 1.4426950408889634f; }
        __syncthreads();
        for (int u = blockIdx.x; u < 256; u += F.G) {
#pragma unroll 1
            for (int g = 0; g < 2; ++g) { const int ta = ((u & 7) << 5) | (u >> 3);
                const int tile = g ? 255 - ta : ta;
                const unsigned soff = (unsigned)__builtin_amdgcn_readfirstlane((int)((blockIdx.x & 127u) * (unsigned)PSLAB));
                attn_tile(F, ws, tile, g, soff); } }
    }
    SEAM(4);
    if (IN(5)) { REFRESH();
        pg8::Gemm g{(const bf16*)(ws + WS_Z), (const bf16*)(ws + WS_WGLU), S, 512, 512, 512}; pg8::StaticOrder So; So.init(S, 512, F.G, (int)blockIdx.x);
        EpiGlu E{(const bf16*)(ws + WS_Z), (bf16*)(ws + WS_ZG)};
        pg8::gemm_phase<EpiGlu, pg8::StaticOrder>(F.lds, g, So, E);
    }
    SEAM(5);
    if (IN(6)) { REFRESH();
        pg8::TwoSegOrder So; So.init(S, 1024, F.G, (int)blockIdx.x);
        pg8::Gemm g{(const bf16*)(ws + WS_ZG), (const bf16*)(ws + WS_WA), S, 1024, 512, 512, (const bf16*)(ws + WS_O), (const bf16*)(ws + WS_WB)}; EpiMix2 E{(const bf16*)(ws + WS_G), (bf16*)(ws + WS_MIX)};
        pg8::gemm_phase<EpiMix2, pg8::TwoSegOrder>(F.lds, g, So, E);
    }
    SEAM(6);
    if (IN(7)) { REFRESH();
        pg8::Gemm g{(const bf16*)(ws + WS_MIX), (const bf16*)(ws + WS_WOUT), S, 1024, 1024, 1024}; pg8::StaticOrder So; So.init(S, 1024, F.G, (int)blockIdx.x);
        EpiResNorm E{args.in[0], F.out, (bf16*)(ws + WS_XN), (float*)(ws + WS_SSP), (LAS float*)(F.lds + pg8::STAGE_BYTES)};
        pg8::gemm_phase<EpiResNorm, pg8::StaticOrder>(F.lds, g, So, E);
    }
    SEAM(7);
    if (IN(9)) { REFRESH();
        pg8::Gemm g{(const bf16*)(ws + WS_XN), (const bf16*)(ws + WS_WGU), S, 2 * DFF, 1024, 1024}; pg8::StaticOrder So; So.init(S, 2 * DFF, F.G, (int)blockIdx.x);
        EpiFfn E{(bf16*)(ws + WS_H), (const float*)(ws + WS_SSP)};
        pg8::gemm_phase<EpiFfn, pg8::StaticOrder>(F.lds, g, So, E);
    }
    SEAM(9);
    if (IN(10)) { REFRESH();
        pg8::Gemm g{(const bf16*)(ws + WS_H), (const bf16*)(ws + WS_WD), S, 1024, DFF, DFF}; pg8::StaticOrder So; So.init(S, 1024, F.G, (int)blockIdx.x);
        EpiRes E{F.out, F.out};
        pg8::gemm_phase<EpiRes, pg8::StaticOrder>(F.lds, g, So, E);
    }
    SEAM(10);
    if (IN(11)) { REFRESH(); for (int m = F.gw; m < S; m += F.ngw) rms_row_f32(F.out + (size_t)m * DM, args.in[26], F.lane); }
#undef IN
#undef SEAM
}

extern "C" void kernel_launch(void* const* d_in, const int* in_sizes, int n_in, void* d_out, int out_size, void* d_ws, size_t ws_size, hipStream_t stream) {
    static int grid = 0;
    if (grid == 0) {
        if (n_in != 27 || out_size != S * DM || ws_size < WS_END) { fprintf(stderr, "kernel_launch: unexpected shapes (n_in %d out %d ws %zu)\n", n_in, out_size, ws_size); grid = -1; return; }
        int dev = 0, cus = 0, per_cu = 0;
        if (hipGetDevice(&dev) != hipSuccess || hipDeviceGetAttribute(&cus, hipDeviceAttributeMultiprocessorCount, dev) != hipSuccess) { grid = -1; return; }
        if (hipFuncSetAttribute((const void*)mk_fwd, hipFuncAttributeMaxDynamicSharedMemorySize, LDS_BYTES) != hipSuccess) { fprintf(stderr, "kernel_launch: hipFuncSetAttribute failed\n"); grid = -1; return; }
        if (hipOccupancyMaxActiveBlocksPerMultiprocessor(&per_cu, (const void*)mk_fwd, NWAVES * 64, LDS_BYTES) != hipSuccess || per_cu < 1) { fprintf(stderr, "kernel_launch: occupancy query says %d\n", per_cu); per_cu = 1; }
        (void)hipGetLastError();
        grid = cus * (per_cu < 1 ? 1 : 1);
    }
    if (grid < 0) return;
    if (hipMemsetAsync((char*)d_ws + WS_CTL, 0, 16384, stream) != hipSuccess) { fprintf(stderr, "kernel_launch: hipMemsetAsync failed\n"); return; }
    Args a{};
    for (int i = 0; i < 27; ++i) a.in[i] = (const float*)d_in[i];
    a.out = (float*)d_out; a.ws = (unsigned char*)d_ws;
    if (MK_N_LAUNCHES == 1) {
        a.ph_lo = 0; a.ph_hi = NPH;
        void* kargs[] = {&a};
        hipError_t e = hipLaunchCooperativeKernel((const void*)mk_fwd, dim3(grid), dim3(NWAVES * 64), kargs, LDS_BYTES, stream);
        if (e != hipSuccess) fprintf(stderr, "kernel_launch: cooperative launch failed: %s (grid %d)\n", hipGetErrorString(e), grid);
    } else {
        for (int ph = 0; ph < NPH; ++ph) { a.ph_lo = ph; a.ph_hi = ph + 1; hipLaunchKernelGGL(mk_fwd, dim3(grid), dim3(NWAVES * 64), LDS_BYTES, stream, a); }
    }
}
```

```cpp
#include <hip/hip_runtime.h>
#include <hip/hip_cooperative_groups.h>
#include <cstdio>
#include <cstdint>
namespace cg = cooperative_groups;

#ifndef MK_N_LAUNCHES
#define MK_N_LAUNCHES 1
#endif

namespace pg8 {
#define PG8_LAS __attribute__((address_space(3)))
typedef unsigned short bf16_t;
typedef short bf16x8 __attribute__((ext_vector_type(8)));
typedef float f32x4 __attribute__((ext_vector_type(4)));
typedef unsigned u32x4 __attribute__((ext_vector_type(4)));
constexpr int BM = 256, BK = 64, HALF = 128, HTB = HALF * BK * 2, STAGE_BYTES = 8 * HTB, NXCD = 8, WGM = 8;

__host__ __device__ __forceinline__ int lds_byte(int r, int c) { const int st = (r >> 4) * 2 + (c >> 5), rr = r & 15, cc = c & 31, ob = rr * 64 + cc * 2; return st * 1024 + (ob ^ (((ob >> 9) & 1) << 5)); }
__host__ __device__ __forceinline__ void stage_rc(int b, int& R, int& C) { const int st = b / 1024, sb = b % 1024, swz = sb ^ (((sb >> 9) & 1) << 5); R = (st >> 1) * 16 + swz / 64; C = (st & 1) * 32 + (swz % 64) / 2; }
__host__ __device__ __forceinline__ int perm32(int rho) { const int n = rho >> 4, i = rho & 15; return 8 * (i >> 2) + 4 * n + (i & 3); }

struct Unit { int pm, pn, ks, seg; };
struct Gemm { const bf16_t* A; const bf16_t* Bt; int M, N, K, ld; const bf16_t* A2; const bf16_t* Bt2; };

struct StaticOrder {
    static constexpr bool SINGLE = false;
    int nM, nN, nwg, G, c;
    __host__ __device__ void init(int M, int N, int G_, int c_) { nM = M / BM; nN = N / BM; nwg = nM * nN; G = G_; c = c_; }
    __host__ __device__ bool next(int i, Unit& u) const {
        const long L = (long)i * G + c; if (L >= nwg) return false;
        int wgid = (int)L; { const int q = nwg / NXCD, r = nwg % NXCD, xcd = wgid % NXCD, off = wgid / NXCD; wgid = (xcd < r ? xcd * (q + 1) : r * (q + 1) + (xcd - r) * q) + off; }
        const int nig = WGM * nN, gid = wgid / nig, fm = gid * WGM, gsz = (nM - fm) < WGM ? (nM - fm) : WGM;
        u.pm = fm + ((wgid % nig) % gsz); u.pn = (wgid % nig) / gsz; u.ks = 0; u.seg = 0; return true;
    }
};
struct TwoSegOrder : StaticOrder {
    __host__ __device__ bool next(int i, Unit& u) const { if (!StaticOrder::next(i >> 1, u)) return false; u.seg = i & 1; return true; }
};
struct CmpOrder {
    static constexpr bool SINGLE = true;
    int G, c, KS;
    __host__ __device__ bool next(int i, Unit& u) const {
        const int L = i * G + c; if (L >= 32 * KS) return false;
        const int tile = L / KS; u.ks = L % KS; u.pm = tile >> 1; u.pn = (tile & 1) + (u.pm >= 8 ? 2 : 0); u.seg = 0; return true;
    }
};

typedef float f32x2_t __attribute__((ext_vector_type(2))); typedef __bf16 bf16x2_t __attribute__((ext_vector_type(2)));
__device__ __forceinline__ unsigned cvt_pk_bf16(float lo, float hi) { f32x2_t v = {lo, hi}; bf16x2_t b = __builtin_convertvector(v, bf16x2_t); return __builtin_bit_cast(unsigned, b); }
__device__ __forceinline__ float bflo(unsigned w) { return __uint_as_float(w << 16); }
__device__ __forceinline__ float bfhi(unsigned w) { return __uint_as_float(w & 0xffff0000u); }
__device__ __forceinline__ float sigm(float x) { return __builtin_amdgcn_rcpf(1.0f + __expf(-x)); }

template <class Epi, class Sched>
__device__ __forceinline__ void gemm_phase(PG8_LAS unsigned char* lds, const Gemm g, const Sched& S, const Epi& E) {
    const int tid = threadIdx.x, wid = __builtin_amdgcn_readfirstlane(tid >> 6), lane = tid & 63, wr = wid >> 2, wc = wid & 3, fr = lane & 15, fq = lane >> 4;
    const int K = g.K, ld = g.ld, nt = K / BK;
    unsigned voffA[2], voffB[2];
#pragma unroll
    for (int i = 0; i < 2; ++i) { int R, C; stage_rc(tid * 16 + i * 8192, R, C); const int Rb = Epi::PERM ? ((R & ~31) + perm32(R & 31)) : R;
        voffA[i] = (unsigned)(R * ld + C) * 2u; voffB[i] = (unsigned)(Rb * ld + C) * 2u; }
    const size_t kstep = (size_t)(BK * 2);
    const size_t hstep = (size_t)HALF * ld * 2;
    const size_t tstep = 2 * hstep;
    const unsigned ldsw = (unsigned)wid * 1024u;
    const int aoff = lds_byte(wr * 64 + fr, fq * 8), boff = lds_byte(wc * 32 + fr, fq * 8);
#define PG8_SA(b, h) (((b) * 2 + (h)) * HTB)
#define PG8_SB(b, h) ((4 + (b) * 2 + (h)) * HTB)
#define PG8_STAGE(bufoff, gbase, voff) do { _Pragma("unroll") for (int _i = 0; _i < 2; ++_i) \
        __builtin_amdgcn_global_load_lds((const unsigned*)((const char*)(gbase) + (voff)[_i]), (PG8_LAS unsigned*)(lds + (bufoff) + ldsw + _i * 8192), 16, 0, 0); } while (0)
#define PG8_LDA(dst, b, h) do { _Pragma("unroll") for (int m = 0; m < 4; ++m) _Pragma("unroll") for (int k = 0; k < 2; ++k) dst[m][k] = *(const PG8_LAS bf16x8*)(lds + PG8_SA(b, h) + aoff + m * 2048 + k * 1024); } while (0)
#define PG8_LDB(dst, b, h) do { _Pragma("unroll") for (int n = 0; n < 2; ++n) _Pragma("unroll") for (int k = 0; k < 2; ++k) dst[n][k] = *(const PG8_LAS bf16x8*)(lds + PG8_SB(b, h) + boff + n * 2048 + k * 1024); } while (0)
#define PG8_MMA(ai, bj, At, Bt) do { __builtin_amdgcn_s_setprio(1); _Pragma("unroll") for (int m = 0; m < 4; ++m) _Pragma("unroll") for (int n = 0; n < 2; ++n) _Pragma("unroll") for (int k = 0; k < 2; ++k) \
        acc[ai][bj][m][n] = __builtin_amdgcn_mfma_f32_16x16x32_bf16(Bt[n][k], At[m][k], acc[ai][bj][m][n], 0, 0, 0); __builtin_amdgcn_s_setprio(0); } while (0)
#define PG8_WAIT_V(n) asm volatile("s_waitcnt vmcnt(" #n ")" ::: "memory")
#define PG8_WAIT_L(n) asm volatile("s_waitcnt lgkmcnt(" #n ")" ::: "memory")
#define PG8_BAR __builtin_amdgcn_s_barrier()
#define PG8_SCHED __builtin_amdgcn_sched_barrier(0)
    Unit cur, nxt; int ui = 0;
    if (!S.next(0, cur)) return;
    f32x4 acc[2][2][4][2];
#pragma unroll
    for (int a = 0; a < 2; ++a)
#pragma unroll
        for (int b = 0; b < 2; ++b)
#pragma unroll
            for (int m = 0; m < 4; ++m)
#pragma unroll
                for (int n = 0; n < 2; ++n) acc[a][b][m][n] = (f32x4){0.f, 0.f, 0.f, 0.f};
    bf16x8 At[4][2], B0[2][2], B1[2][2];
    const char* cA = (const char*)(cur.seg ? g.A2 : g.A) + (size_t)cur.pm * tstep + (size_t)cur.ks * K * 2; const char* cB = (const char*)(cur.seg ? g.Bt2 : g.Bt) + (size_t)cur.pn * tstep + (size_t)cur.ks * K * 2;
    PG8_STAGE(PG8_SB(0, 0), cB, voffB); PG8_STAGE(PG8_SB(0, 1), cB + hstep, voffB); PG8_STAGE(PG8_SA(0, 0), cA, voffA); PG8_STAGE(PG8_SA(0, 1), cA + hstep, voffA);
    if (wr == 1) PG8_BAR;
    PG8_WAIT_V(2); PG8_BAR;
    PG8_STAGE(PG8_SB(1, 0), cB + kstep, voffB); PG8_STAGE(PG8_SA(1, 0), cA + kstep, voffA); PG8_STAGE(PG8_SB(1, 1), cB + hstep + kstep, voffB);
    PG8_WAIT_V(6); PG8_BAR;
    for (;;) {
        const bool has_next = Sched::SINGLE ? false : S.next(ui + 1, nxt);
        const char* nA = has_next ? (const char*)(nxt.seg ? g.A2 : g.A) + (size_t)nxt.pm * tstep + (size_t)nxt.ks * K * 2 : cA; const char* nB = has_next ? (const char*)(nxt.seg ? g.Bt2 : g.Bt) + (size_t)nxt.pn * tstep + (size_t)nxt.ks * K * 2 : cB;
        for (int t = 0; t < nt; t += 2) {
            const bool last = (t == nt - 2);
            const char* a1 = cA + (size_t)(t + 1) * kstep;
            const char* a2 = last ? nA : cA + (size_t)(t + 2) * kstep; const char* b2 = last ? nB : cB + (size_t)(t + 2) * kstep;
            const char* a3 = a2 + kstep; const char* b3 = b2 + kstep;
            PG8_LDB(B0, 0, 0); PG8_LDB(B1, 0, 1); PG8_SCHED; PG8_LDA(At, 0, 0); PG8_STAGE(PG8_SA(1, 1), a1 + hstep, voffA);
            PG8_WAIT_V(8); PG8_WAIT_L(0); PG8_BAR; PG8_MMA(0, 0, At, B0); PG8_MMA(0, 1, At, B1); PG8_BAR; PG8_SCHED;
            PG8_LDA(At, 0, 1); PG8_STAGE(PG8_SB(0, 0), b2, voffB); PG8_STAGE(PG8_SB(0, 1), b2 + hstep, voffB); PG8_STAGE(PG8_SA(0, 0), a2, voffA);
            PG8_WAIT_V(8); PG8_WAIT_L(0); PG8_BAR; PG8_MMA(1, 0, At, B0); PG8_MMA(1, 1, At, B1); PG8_BAR; PG8_SCHED;
            PG8_LDB(B0, 1, 0); PG8_LDB(B1, 1, 1); PG8_SCHED; PG8_LDA(At, 1, 0); PG8_STAGE(PG8_SA(0, 1), a2 + hstep, voffA);
            PG8_WAIT_V(8); PG8_WAIT_L(0); PG8_BAR; PG8_MMA(0, 0, At, B0); PG8_MMA(0, 1, At, B1); PG8_BAR; PG8_SCHED;
            PG8_LDA(At, 1, 1); PG8_STAGE(PG8_SB(1, 0), b3, voffB); PG8_STAGE(PG8_SB(1, 1), b3 + hstep, voffB); PG8_STAGE(PG8_SA(1, 0), a3, voffA);
            PG8_WAIT_V(8); PG8_WAIT_L(0); PG8_BAR; PG8_MMA(1, 0, At, B0); PG8_MMA(1, 1, At, B1); PG8_BAR; PG8_SCHED;
        }
        if (wr == 0) PG8_BAR;
        E(acc, cur, wr, wc, fr, fq);
        if (!has_next) break;
        if (!nxt.seg) {
#pragma unroll
        for (int a = 0; a < 2; ++a)
#pragma unroll
            for (int b = 0; b < 2; ++b)
#pragma unroll
                for (int m = 0; m < 4; ++m)
#pragma unroll
                    for (int n = 0; n < 2; ++n) acc[a][b][m][n] = (f32x4){0.f, 0.f, 0.f, 0.f}; }
        cur = nxt; cA = nA; cB = nB; ++ui;
        if (wr == 1) PG8_BAR;
    }
    PG8_WAIT_V(0);
    PG8_BAR;
#undef PG8_SA
#undef PG8_SB
#undef PG8_STAGE
#undef PG8_LDA
#undef PG8_LDB
#undef PG8_MMA
#undef PG8_WAIT_V
#undef PG8_WAIT_L
#undef PG8_BAR
#undef PG8_SCHED
}
}

constexpr int S = 16384, DM = 1024, INC = 3864, NPJ = 4096, SSW = 512, NSW = 512, HD = 64, DFF = 2816;
constexpr int NGRP = 32, NST = 64, NCMP = 1023;
constexpr int NWAVES = 8;
constexpr int NPH = 12;
constexpr int CMP_KS = 4;
constexpr float EPS = 1e-6f;

constexpr size_t MiB = 1u << 20;
constexpr size_t WS_CTL = 0;
constexpr size_t WS_TAB = 1 * MiB;
constexpr size_t TAB_BF = 0, TAB_CF = 128 * 1024, TAB_LAM = 256 * 1024, TAB_LAM256 = 272 * 1024, TAB_POSB = 288 * 1024;
constexpr size_t WS_SSP = 1 * MiB + 512 * 1024;
constexpr size_t WS_F = 2 * MiB;
constexpr size_t WS_KVC = 3 * MiB;
constexpr size_t WS_WIN = 4 * MiB, WS_WGU = 12 * MiB, WS_WD = 23 * MiB, WS_WOUT = 29 * MiB, WS_WA = 31 * MiB, WS_WB = 32 * MiB, WS_WGLU = 33 * MiB, WS_WC1 = 34 * MiB;
constexpr size_t WS_XN = 36 * MiB;
constexpr size_t WS_Z = WS_XN, WS_ZG = WS_XN + 16 * MiB;
constexpr size_t WS_U = 68 * MiB, WS_O = WS_U;
constexpr size_t WS_Q = 84 * MiB;
constexpr size_t WS_KVH = 100 * MiB;
constexpr size_t WS_G = 124 * MiB;
constexpr size_t WS_GN = 188 * MiB;
constexpr size_t WS_MIX = 84 * MiB;
constexpr size_t WS_H = 100 * MiB;
constexpr size_t WS_VTW = 189 * MiB;
constexpr size_t WS_VTS = 193 * MiB;
constexpr size_t WS_KCB = 197 * MiB;
constexpr size_t WS_VTC = 197 * MiB + 512 * 1024;
constexpr size_t WS_PSLAB = 198 * MiB;
constexpr size_t WS_END = 254 * MiB;

constexpr int LDS_BYTES = 163840;

#define GAS __attribute__((address_space(1)))
#define LAS __attribute__((address_space(3)))
typedef unsigned short bf16;
typedef unsigned v4u __attribute__((ext_vector_type(4)));
typedef float f32x4 __attribute__((ext_vector_type(4)));
typedef float f32x2 __attribute__((ext_vector_type(2)));
typedef float f32x16 __attribute__((ext_vector_type(16)));
typedef short bf16x8 __attribute__((ext_vector_type(8)));
#define LDS_WAIT() asm volatile("s_waitcnt lgkmcnt(0)" ::: "memory")
#define VM_WAIT() asm volatile("s_waitcnt vmcnt(0)" ::: "memory")
__device__ __forceinline__ unsigned f2bf(float f) { unsigned u = __builtin_bit_cast(unsigned, f); return (u + 0x7fffu + ((u >> 16) & 1u)) >> 16; }
__device__ __forceinline__ unsigned pk2(float lo, float hi) { return f2bf(lo) | (f2bf(hi) << 16); }
__device__ __forceinline__ float bf2f(bf16 v) { return __uint_as_float((unsigned)v << 16); }
using pg8::bflo; using pg8::bfhi; using pg8::sigm; using pg8::cvt_pk_bf16;
__device__ __forceinline__ float gelu_tanh(float y) {
    const float a = 0.7978845608028654f * (y + 0.044715f * y * y * y);
    const float e = __expf(2.0f * a);
    const float th = 1.0f - 2.0f * __builtin_amdgcn_rcpf(e + 1.0f);
    return 0.5f * y * (1.0f + th);
}
__device__ __forceinline__ float wave_sum(float v) {
#pragma unroll
    for (int o = 1; o < 64; o <<= 1) v += __shfl_xor(v, o);
    return v;
}
__device__ __forceinline__ float wave_max(float v) {
#pragma unroll
    for (int o = 1; o < 64; o <<= 1) v = fmaxf(v, __shfl_xor(v, o));
    return v;
}

struct Args { const float* in[27]; float* out; unsigned char* ws; int ph_lo, ph_hi; };

struct Frame {
    LAS unsigned char* lds;
    int tid, lane, wave, G, gw, ngw;
    float* out; unsigned char* ws;
};

using pg8::Unit; using pg8::BM; using pg8::HALF;
struct EpiProj {
    static constexpr bool PERM = true;
    bf16 *U, *Q, *KVH, *Gt, *GN;
    __device__ __forceinline__ void operator()(const f32x4 (&acc)[2][2][4][2], const Unit& u, int wr, int wc, int fr, int fq) const {
        const int row0 = u.pm * BM + wr * 64 + fr, pn = u.pn;
#pragma unroll
        for (int ai = 0; ai < 2; ++ai)
#pragma unroll
            for (int m = 0; m < 4; ++m) { const int row = row0 + ai * HALF + m * 16;
#pragma unroll
                for (int bj = 0; bj < 2; ++bj) { f32x4 v0 = acc[ai][bj][m][0], v1 = acc[ai][bj][m][1]; const int col = bj * HALF + wc * 32 + 8 * fq; bf16* dst;
                    if (pn < 2) dst = U + (size_t)row * 512 + pn * 256 + col;
                    else if (pn < 4) { v0 = v0 * (0.125f * 1.4426950408889634f); v1 = v1 * (0.125f * 1.4426950408889634f); dst = Q + (size_t)row * 512 + (pn - 2) * 256 + col; }
                    else if (pn < 7) dst = KVH + ((size_t)((pn - 4) * 4 + (col >> 6)) * S + row) * 64 + (col & 63);
                    else { v0 = (f32x4){sigm(v0[0]), sigm(v0[1]), sigm(v0[2]), sigm(v0[3])}; v1 = (f32x4){sigm(v1[0]), sigm(v1[1]), sigm(v1[2]), sigm(v1[3])};
                        if (pn < 15) dst = Gt + (size_t)row * 2048 + (pn - 7) * 256 + col; else { if (col >= 32) continue; dst = GN + (size_t)row * 32 + col; } }
                    v4u w; w.x = cvt_pk_bf16(v0[0], v0[1]); w.y = cvt_pk_bf16(v0[2], v0[3]); w.z = cvt_pk_bf16(v1[0], v1[1]); w.w = cvt_pk_bf16(v1[2], v1[3]);
                    *(v4u*)dst = w; } }
    }
};
struct EpiCmp {
    static constexpr bool PERM = false;
    float* C;
    __device__ __forceinline__ void operator()(const f32x4 (&acc)[2][2][4][2], const Unit& u, int wr, int wc, int fr, int fq) const {
        const int row0 = u.pm * BM + wr * 64 + fr, col0 = (u.pn & 1) * BM + wc * 32 + 4 * fq; float* base = C + (size_t)u.ks * 4096 * 512;
#pragma unroll
        for (int ai = 0; ai < 2; ++ai)
#pragma unroll
            for (int m = 0; m < 4; ++m) { float* rowp = base + (size_t)(row0 + ai * HALF + m * 16) * 512 + col0;
#pragma unroll
                for (int bj = 0; bj < 2; ++bj)
#pragma unroll
                    for (int n = 0; n < 2; ++n) *(f32x4*)(rowp + bj * HALF + n * 16) = acc[ai][bj][m][n]; }
    }
};
struct EpiGlu {
    static constexpr bool PERM = true;
    const bf16* Z; bf16* ZG;
    __device__ __forceinline__ void operator()(const f32x4 (&acc)[2][2][4][2], const Unit& u, int wr, int wc, int fr, int fq) const {
        const int row0 = u.pm * BM + wr * 64 + fr;
#pragma unroll
        for (int ai = 0; ai < 2; ++ai)
#pragma unroll
            for (int m = 0; m < 4; ++m) { const int row = row0 + ai * HALF + m * 16;
#pragma unroll
                for (int bj = 0; bj < 2; ++bj) { const f32x4 v0 = acc[ai][bj][m][0], v1 = acc[ai][bj][m][1]; const size_t off = (size_t)row * 512 + u.pn * BM + bj * HALF + wc * 32 + 8 * fq;
                    const v4u z = *(const v4u*)(Z + off); v4u w;
                    w.x = cvt_pk_bf16(bflo(z.x) * sigm(v0[0]), bfhi(z.x) * sigm(v0[1])); w.y = cvt_pk_bf16(bflo(z.y) * sigm(v0[2]), bfhi(z.y) * sigm(v0[3]));
                    w.z = cvt_pk_bf16(bflo(z.z) * sigm(v1[0]), bfhi(z.z) * sigm(v1[1])); w.w = cvt_pk_bf16(bflo(z.w) * sigm(v1[2]), bfhi(z.w) * sigm(v1[3]));
                    *(v4u*)(ZG + off) = w; } }
    }
};
struct EpiMix2 {
    static constexpr bool PERM = true;
    const bf16* Gt; bf16* MIX;
    __device__ __forceinline__ void operator()(f32x4 (&acc)[2][2][4][2], const Unit& u, int wr, int wc, int fr, int fq) const {
        const int row0 = u.pm * BM + wr * 64 + fr;
#pragma unroll
        for (int ai = 0; ai < 2; ++ai)
#pragma unroll
            for (int m = 0; m < 4; ++m) { const int row = row0 + ai * HALF + m * 16;
#pragma unroll
                for (int bj = 0; bj < 2; ++bj) { const int col = u.pn * BM + bj * HALF + wc * 32 + 8 * fq;
                    const v4u gb = *(const v4u*)(Gt + (size_t)row * 2048 + 1024 + col);
                    const float b8[8] = {bflo(gb.x), bfhi(gb.x), bflo(gb.y), bfhi(gb.y), bflo(gb.z), bfhi(gb.z), bflo(gb.w), bfhi(gb.w)};
                    if (u.seg == 0) { const v4u ga = *(const v4u*)(Gt + (size_t)row * 2048 + col);
                        const float a8[8] = {bflo(ga.x), bfhi(ga.x), bflo(ga.y), bfhi(ga.y), bflo(ga.z), bfhi(ga.z), bflo(ga.w), bfhi(ga.w)};
#pragma unroll
                        for (int e = 0; e < 4; ++e) { acc[ai][bj][m][0][e] *= a8[e] * __builtin_amdgcn_rcpf(b8[e]); acc[ai][bj][m][1][e] *= a8[4 + e] * __builtin_amdgcn_rcpf(b8[4 + e]); }
                    } else { const f32x4 v0 = acc[ai][bj][m][0], v1 = acc[ai][bj][m][1]; v4u w;
                        w.x = cvt_pk_bf16(v0[0] * b8[0], v0[1] * b8[1]); w.y = cvt_pk_bf16(v0[2] * b8[2], v0[3] * b8[3]); w.z = cvt_pk_bf16(v1[0] * b8[4], v1[1] * b8[5]); w.w = cvt_pk_bf16(v1[2] * b8[6], v1[3] * b8[7]);
                        *(v4u*)(MIX + (size_t)row * 1024 + col) = w; } } }
    }
};
struct EpiRes {
    static constexpr bool PERM = false;
    const float* base; float* out;
    __device__ __forceinline__ void operator()(const f32x4 (&acc)[2][2][4][2], const Unit& u, int wr, int wc, int fr, int fq) const {
        const int row0 = u.pm * BM + wr * 64 + fr, col0 = u.pn * BM + wc * 32 + 4 * fq;
#pragma unroll
        for (int ai = 0; ai < 2; ++ai)
#pragma unroll
            for (int m = 0; m < 4; ++m) { const size_t off = (size_t)(row0 + ai * HALF + m * 16) * 1024 + col0;
#pragma unroll
                for (int bj = 0; bj < 2; ++bj)
#pragma unroll
                    for (int n = 0; n < 2; ++n) { const f32x4 b = *(const f32x4*)(base + off + bj * HALF + n * 16); *(f32x4*)(out + off + bj * HALF + n * 16) = b + acc[ai][bj][m][n]; } }
    }
};
struct EpiResNorm {
    static constexpr bool PERM = false;
    const float* base; float* out; bf16* XN; float* SSP; LAS float* part;
    __device__ __forceinline__ void operator()(const f32x4 (&acc)[2][2][4][2], const Unit& u, int wr, int wc, int fr, int fq) const {
        const int row0 = u.pm * BM + wr * 64 + fr, col0 = u.pn * BM + wc * 32 + 4 * fq;
#pragma unroll
        for (int ai = 0; ai < 2; ++ai)
#pragma unroll
            for (int m = 0; m < 4; ++m) { const size_t off = (size_t)(row0 + ai * HALF + m * 16) * 1024 + col0; float ss = 0.f;
#pragma unroll
                for (int bj = 0; bj < 2; ++bj)
#pragma unroll
                    for (int n = 0; n < 2; ++n) { const f32x4 b = *(const f32x4*)(base + off + bj * HALF + n * 16); const f32x4 x1 = b + acc[ai][bj][m][n]; *(f32x4*)(out + off + bj * HALF + n * 16) = x1;
                        *(unsigned long long*)(XN + off + bj * HALF + n * 16) = (unsigned long long)cvt_pk_bf16(x1[0], x1[1]) | ((unsigned long long)cvt_pk_bf16(x1[2], x1[3]) << 32);
                        ss += (x1[0] * x1[0] + x1[1] * x1[1]) + (x1[2] * x1[2] + x1[3] * x1[3]); }
                ss += __shfl_xor(ss, 16); ss += __shfl_xor(ss, 32);
                if (fq == 0) part[(ai * HALF + wr * 64 + m * 16 + fr) * 4 + wc] = ss; }
        asm volatile("s_waitcnt lgkmcnt(0)" ::: "memory"); __builtin_amdgcn_s_barrier(); asm volatile("" ::: "memory");
        if (threadIdx.x < 256) { const f32x4 p = *(const LAS f32x4*)(part + threadIdx.x * 4); SSP[(size_t)(u.pm * BM + threadIdx.x) * 4 + u.pn] = (p[0] + p[1]) + (p[2] + p[3]); }
    }
};
struct EpiFfn {
    static constexpr bool PERM = true;
    bf16* H; const float* SSP;
    __device__ __forceinline__ void operator()(const f32x4 (&acc)[2][2][4][2], const Unit& u, int wr, int wc, int fr, int fq) const {
        const int row0 = u.pm * BM + wr * 64 + fr;
#pragma unroll
        for (int ai = 0; ai < 2; ++ai)
#pragma unroll
            for (int m = 0; m < 4; ++m) { const int row = row0 + ai * HALF + m * 16;
                const f32x4 sp = *(const f32x4*)(SSP + (size_t)row * 4); const float rs = 1.0f / sqrtf(((sp[0] + sp[1]) + (sp[2] + sp[3])) * (1.f / 1024.f) + 1e-6f);
                float r[8];
#pragma unroll
                for (int n = 0; n < 2; ++n)
#pragma unroll
                    for (int e = 0; e < 4; ++e) { const float gt = acc[ai][0][m][n][e] * rs, up = acc[ai][1][m][n][e] * rs; r[n * 4 + e] = gt * sigm(gt) * up; }
                v4u w; w.x = cvt_pk_bf16(r[0], r[1]); w.y = cvt_pk_bf16(r[2], r[3]); w.z = cvt_pk_bf16(r[4], r[5]); w.w = cvt_pk_bf16(r[6], r[7]);
                *(v4u*)(H + (size_t)row * DFF + u.pn * HALF + wc * 32 + 8 * fq) = w; }
    }
};

struct TrDesc { const float* src; bf16* dst; int ld, ncols, dld, drow, kb, nb; const float* gain; };
__device__ __forceinline__ void tr_load(const TrDesc& d, float (&v)[32], int lane) {
    const int k0 = 64 * d.kb, c = 32 * d.nb + (lane & 31); const bool ok = c < d.ncols; const float* p = d.src + (size_t)(k0 + (lane >> 5)) * d.ld + c;
#pragma unroll
    for (int i = 0; i < 32; ++i) v[i] = ok ? p[(size_t)(2 * i) * d.ld] : 0.f;
    if (d.gain) {
#pragma unroll
        for (int i = 0; i < 32; ++i) v[i] *= d.gain[k0 + 2 * i + (lane >> 5)]; }
}
__device__ __forceinline__ void tr_finish(const TrDesc& d, const float (&v)[32], LAS float* scr, int lane) {
#pragma unroll
    for (int i = 0; i < 32; ++i) scr[(2 * i + (lane >> 5)) * 33 + (lane & 31)] = v[i];
    LDS_WAIT();
    const int cc = lane & 7, k0 = 64 * d.kb;
#pragma unroll
    for (int j = 0; j < 4; ++j) { const int n = (lane >> 3) + 8 * j; const LAS float* s = scr + (8 * cc) * 33 + n;
        v4u o; o.x = pk2(s[0 * 33], s[1 * 33]); o.y = pk2(s[2 * 33], s[3 * 33]); o.z = pk2(s[4 * 33], s[5 * 33]); o.w = pk2(s[6 * 33], s[7 * 33]);
        *(v4u*)(d.dst + (size_t)(d.drow + n) * d.dld + k0 + 8 * cc) = o; }
    LDS_WAIT();
}
__device__ __forceinline__ void rms_row_to_bf16(const float* xrow, const float* gain, bf16* orow, int lane) {
    const f32x4* xr = (const f32x4*)xrow + lane; const f32x4* gr = (const f32x4*)gain + lane;
    f32x4 v[4]; float s = 0.f;
#pragma unroll
    for (int j = 0; j < 4; ++j) { v[j] = xr[64 * j]; s += (v[j].x * v[j].x + v[j].y * v[j].y) + (v[j].z * v[j].z + v[j].w * v[j].w); }
    const float rstd = 1.0f / sqrtf(wave_sum(s) * (1.f / DM) + EPS);
    unsigned long long* o8 = (unsigned long long*)orow + lane;
#pragma unroll
    for (int j = 0; j < 4; ++j) { const f32x4 gq = gr[64 * j];
        o8[64 * j] = (unsigned long long)pk2(v[j].x * rstd * gq.x, v[j].y * rstd * gq.y) | ((unsigned long long)pk2(v[j].z * rstd * gq.z, v[j].w * rstd * gq.w) << 32); }
}
__device__ __forceinline__ void rms_rows2_to_bf16(const float* x0, const float* x1, const float* gain, bf16* o0, bf16* o1, int lane) {
    const f32x4* xa = (const f32x4*)x0 + lane; const f32x4* xb = (const f32x4*)x1 + lane; const f32x4* gr = (const f32x4*)gain + lane;
    f32x4 va[4], vb[4]; float sa = 0.f, sb = 0.f;
#pragma unroll
    for (int j = 0; j < 4; ++j) { va[j] = xa[64 * j]; vb[j] = xb[64 * j]; }
#pragma unroll
    for (int j = 0; j < 4; ++j) { sa += (va[j].x * va[j].x + va[j].y * va[j].y) + (va[j].z * va[j].z + va[j].w * va[j].w); sb += (vb[j].x * vb[j].x + vb[j].y * vb[j].y) + (vb[j].z * vb[j].z + vb[j].w * vb[j].w); }
    const float ra = 1.0f / sqrtf(wave_sum(sa) * (1.f / DM) + EPS), rb = 1.0f / sqrtf(wave_sum(sb) * (1.f / DM) + EPS);
    unsigned long long* pa = (unsigned long long*)o0 + lane; unsigned long long* pb = (unsigned long long*)o1 + lane;
#pragma unroll
    for (int j = 0; j < 4; ++j) { const f32x4 gq = gr[64 * j];
        pa[64 * j] = (unsigned long long)pk2(va[j].x * ra * gq.x, va[j].y * ra * gq.y) | ((unsigned long long)pk2(va[j].z * ra * gq.z, va[j].w * ra * gq.w) << 32);
        pb[64 * j] = (unsigned long long)pk2(vb[j].x * rb * gq.x, vb[j].y * rb * gq.y) | ((unsigned long long)pk2(vb[j].z * rb * gq.z, vb[j].w * rb * gq.w) << 32); }
}
__device__ __forceinline__ void rms_row_f32(float* xrow, const float* gain, int lane) {
    f32x4* xr = (f32x4*)xrow + lane; const f32x4* gr = (const f32x4*)gain + lane;
    f32x4 v[4]; float s = 0.f;
#pragma unroll
    for (int j = 0; j < 4; ++j) { v[j] = xr[64 * j]; s += (v[j].x * v[j].x + v[j].y * v[j].y) + (v[j].z * v[j].z + v[j].w * v[j].w); }
    const float rstd = 1.0f / sqrtf(wave_sum(s) * (1.f / DM) + EPS);
#pragma unroll
    for (int j = 0; j < 4; ++j) { const f32x4 gq = gr[64 * j]; xr[64 * j] = v[j] * rstd * gq; }
}
__device__ __forceinline__ void s5_tables(const Frame& F, const Args& args, int g) {
    const int lane = F.lane;
    const float* are = args.in[3]; const float* aim = args.in[4]; const float* ldt = args.in[5]; const float* bre = args.in[6]; const float* bim = args.in[7]; const float* cre = args.in[8]; const float* cim = args.in[9];
    const double dt = exp((double)ldt[g]);
    {   const int p = lane; const double ar = are[g * 64 + p], ai = aim[g * 64 + p];
        const double er = exp(ar * dt), lr = er * cos(ai * dt), li = er * sin(ai * dt);
        ((f32x2*)(F.ws + WS_TAB + TAB_LAM))[g * 64 + p] = (f32x2){(float)lr, (float)li};
        const double e2 = exp(ar * dt * 256.0), l2r = e2 * cos(ai * dt * 256.0), l2i = e2 * sin(ai * dt * 256.0);
        ((f32x2*)(F.ws + WS_TAB + TAB_LAM256))[g * 64 + p] = (f32x2){(float)l2r, (float)l2i}; }
#pragma unroll
    for (int nt = 0; nt < 4; ++nt) { const int col = 32 * nt + (lane & 31), p = col >> 1, ri = col & 1;
        const double ar = are[g * 64 + p], ai = aim[g * 64 + p];
        const double er = exp(ar * dt), lr = er * cos(ai * dt) - 1.0, li = er * sin(ai * dt);
        const double den = ar * ar + ai * ai, kr = (lr * ar + li * ai) / den, ki = (li * ar - lr * ai) / den;
        float v[8];
#pragma unroll
        for (int j = 0; j < 8; ++j) { const int c = 8 * (lane >> 5) + j; const double br = bre[(g * 64 + p) * 16 + c], bi = bim[(g * 64 + p) * 16 + c];
            v[j] = (float)(ri ? (kr * bi + ki * br) : (kr * br - ki * bi)); }
        v4u o; o.x = pk2(v[0], v[1]); o.y = pk2(v[2], v[3]); o.z = pk2(v[4], v[5]); o.w = pk2(v[6], v[7]);
        ((v4u*)(F.ws + WS_TAB + TAB_BF))[(g * 4 + nt) * 64 + lane] = o; }
#pragma unroll
    for (int ks = 0; ks < 4; ++ks) { const int ch = lane & 15; float v[8];
#pragma unroll
        for (int j = 0; j < 8; ++j) { const int k = 32 * ks + 8 * (lane >> 4) + j, p = k >> 1, ri = k & 1; v[j] = ri ? -cim[(g * 16 + ch) * 64 + p] : cre[(g * 16 + ch) * 64 + p]; }
        v4u o; o.x = pk2(v[0], v[1]); o.y = pk2(v[2], v[3]); o.z = pk2(v[4], v[5]); o.w = pk2(v[6], v[7]);
        ((v4u*)(F.ws + WS_TAB + TAB_CF))[(g * 4 + ks) * 64 + lane] = o; }
}
__device__ __forceinline__ void p0_prologue(const Frame& F, const Args& args) {
    LAS float* scr = (LAS float*)(F.lds + F.wave * 16384);
    const int gw = F.gw, NGW = F.ngw, lane = F.lane;
    if (F.wave == 0 && blockIdx.x < 32) s5_tables(F, args, (int)blockIdx.x);
    else if (F.wave == 1 && blockIdx.x < 128) {
        const int it = (int)blockIdx.x, kv = it >> 6, part = (it >> 2) & 15, cgp = it & 3;
        const float* pos = kv ? args.in[14] : args.in[13]; const float* w1 = kv ? args.in[17] : args.in[15]; float a = 0.f;
#pragma unroll 1
        for (int r0 = 128 * part; r0 < 128 * part + 128; r0 += 32) { float wv[32];
#pragma unroll
            for (int i = 0; i < 32; ++i) wv[i] = w1[(size_t)(r0 + i) * 256 + cgp * 64 + lane];
#pragma unroll
            for (int i = 0; i < 32; ++i) a += pos[r0 + i] * wv[i]; }
        ((float*)(F.ws + WS_TAB + TAB_POSB))[(kv * 16 + part) * 256 + cgp * 64 + lane] = a;
    }
    { v4u* z = (v4u*)(F.ws + WS_WIN + (size_t)3872 * 1024 * 2); const int n16 = 224 * 1024 * 2 / 16;
      for (int i = blockIdx.x * 512 + F.tid; i < n16; i += F.G * 512) z[i] = (v4u){0u, 0u, 0u, 0u}; }
    bf16* WIN = (bf16*)(F.ws + WS_WIN); bf16* WGU = (bf16*)(F.ws + WS_WGU); bf16* WD = (bf16*)(F.ws + WS_WD); bf16* WOUT = (bf16*)(F.ws + WS_WOUT);
    bf16* WA = (bf16*)(F.ws + WS_WA); bf16* WB = (bf16*)(F.ws + WS_WB); bf16* WGLU = (bf16*)(F.ws + WS_WGLU); bf16* WC1 = (bf16*)(F.ws + WS_WC1);
    constexpr int I1 = 16 * 56, I2 = 16 * 64, I3 = 16, IGLU = 8 * 16, IUP = 8 * 32, IOUT = 16 * 32, IFF = 16 * 88, IDN = 44 * 32, ICM = 16 * 8;
    constexpr int NITEMS = I1 + I2 + I3 + IGLU + 2 * IUP + IOUT + 2 * IFF + IDN + 4 * ICM;
    auto desc = [&](int it) -> TrDesc {
        int r = it;
        if (r < I1) return TrDesc{args.in[2], WIN, INC, 1792, 1024, 32 * (r % 56), r / 56, r % 56, nullptr}; r -= I1;
        if (r < I2) return TrDesc{args.in[2] + 1816, WIN, INC, 2048, 1024, 1792 + 32 * (r % 64), r / 64, r % 64, nullptr}; r -= I2;
        if (r < I3) return TrDesc{args.in[2] + 1792, WIN, INC, 24, 1024, 3840, r, 0, nullptr}; r -= I3;
        if (r < IGLU) return TrDesc{args.in[11], WGLU, 512, 512, 512, 32 * (r % 16), r / 16, r % 16, nullptr}; r -= IGLU;
        if (r < IUP) return TrDesc{args.in[12], WA, 1024, 1024, 512, 32 * (r % 32), r / 32, r % 32, nullptr}; r -= IUP;
        if (r < IUP) return TrDesc{args.in[20], WB, 1024, 1024, 512, 32 * (r % 32), r / 32, r % 32, nullptr}; r -= IUP;
        if (r < IOUT) return TrDesc{args.in[21], WOUT, 1024, 1024, 1024, 32 * (r % 32), r / 32, r % 32, nullptr}; r -= IOUT;
        if (r < IFF) { const int nb = r % 88; return TrDesc{args.in[23], WGU, DFF, DFF, 1024, (nb >> 2) * 256 + (nb & 3) * 32, r / 88, nb, args.in[22]}; } r -= IFF;
        if (r < IFF) { const int nb = r % 88; return TrDesc{args.in[24], WGU, DFF, DFF, 1024, (nb >> 2) * 256 + (nb & 3) * 32 + 128, r / 88, nb, args.in[22]}; } r -= IFF;
        if (r < IDN) return TrDesc{args.in[25], WD, 1024, 1024, DFF, 32 * (r % 32), r / 32, r % 32, nullptr}; r -= IDN;
        const int q = r / ICM, rr = r % ICM;
        return TrDesc{((q >> 1) ? args.in[17] : args.in[15]) + (size_t)(q & 1) * 1024 * 256, WC1, 256, 256, 1024, q * 256 + 32 * (rr % 8), rr / 8, rr % 8, nullptr};
    };
    if (gw < NITEMS) {
        TrDesc dc = desc(gw); float vc[32]; tr_load(dc, vc, lane);
#pragma unroll 1
        for (int it = gw; it < NITEMS; it += NGW) {
            const bool more = it + NGW < NITEMS; TrDesc dn = desc(more ? it + NGW : it); float vn[32]; tr_load(dn, vn, lane);
            tr_finish(dc, vc, scr, lane);
            dc = dn;
#pragma unroll
            for (int i = 0; i < 32; ++i) vc[i] = vn[i];
        }
    }
    bf16* XN = (bf16*)(F.ws + WS_XN);
    for (int m = gw; m < S; m += 2 * NGW) rms_rows2_to_bf16(args.in[0] + (size_t)m * DM, args.in[0] + (size_t)(m + NGW) * DM, args.in[1], XN + (size_t)m * DM, XN + (size_t)(m + NGW) * DM, lane);
}

__device__ __forceinline__ int crow(int r, int hi) { return (r & 3) + 8 * (r >> 2) + 4 * hi; }
template <bool FINAL>
__device__ __forceinline__ void s5_unit(const Frame& F, const Args& args, int c, int g, LAS unsigned char* wl, LAS unsigned char* wx) {
    const int lane = F.lane, hi = lane >> 5;
    const bf16* U = (const bf16*)(F.ws + WS_U); bf16* Z = (bf16*)(F.ws + WS_Z);
    bf16x8 bfg[4], cfg[4], ua[8];
#pragma unroll
    for (int sub = 0; sub < 8; ++sub) ua[sub] = *(const bf16x8*)(U + (size_t)(c * 256 + sub * 32 + (lane & 31)) * 512 + g * 16 + 8 * hi);
#pragma unroll
    for (int nt = 0; nt < 4; ++nt) bfg[nt] = ((const bf16x8*)(F.ws + WS_TAB + TAB_BF))[(g * 4 + nt) * 64 + lane];
    const f32x2 lam = ((const f32x2*)(F.ws + WS_TAB + TAB_LAM))[g * 64 + lane];
    f32x2* Fst = (f32x2*)(F.ws + WS_F);
    float xr = 0.f, xi = 0.f, dsk = 0.f;
    if (FINAL) {
#pragma unroll
        for (int ks = 0; ks < 4; ++ks) cfg[ks] = ((const bf16x8*)(F.ws + WS_TAB + TAB_CF))[(g * 4 + ks) * 64 + lane];
        dsk = args.in[10][g * 16 + (lane & 15)];
        const f32x2 L2 = ((const f32x2*)(F.ws + WS_TAB + TAB_LAM256))[g * 64 + lane];
        for (int cp = 0; cp < c; ++cp) { const f32x2 f = Fst[(cp * 32 + g) * 64 + lane]; const float nr = L2.x * xr - L2.y * xi + f.x, ni = L2.x * xi + L2.y * xr + f.y; xr = nr; xi = ni; }
    }
#pragma unroll
    for (int sub = 0; sub < 8; ++sub) {
        const int t0 = c * 256 + sub * 32;
        const bf16x8 a = ua[sub];
        if (FINAL) *(LAS bf16x8*)(wx + (lane & 31) * 32 + hi * 16) = a;
#pragma unroll
        for (int nt = 0; nt < 4; ++nt) { f32x16 acc = {}; acc = __builtin_amdgcn_mfma_f32_32x32x16_bf16(a, bfg[nt], acc, 0, 0, 0);
#pragma unroll
            for (int r = 0; r < 16; ++r) ((LAS float*)wl)[crow(r, hi) * 128 + 32 * nt + (lane & 31)] = acc[r]; }
        LDS_WAIT();
        f32x2 bu[32];
#pragma unroll
        for (int tk = 0; tk < 32; ++tk) bu[tk] = ((const LAS f32x2*)wl)[tk * 64 + lane];
        LDS_WAIT();
#pragma unroll
        for (int tk = 0; tk < 32; ++tk) { const float nr = lam.x * xr - lam.y * xi + bu[tk].x, ni = lam.x * xi + lam.y * xr + bu[tk].y; xr = nr; xi = ni;
            if (FINAL) ((LAS unsigned*)wl)[tk * 128 + ((lane + 4 * tk) & 63)] = pk2(xr, xi); }
        if (FINAL) {
            LDS_WAIT();
            LAS unsigned short* zt = (LAS unsigned short*)(wx + 1024);
#pragma unroll
            for (int mt = 0; mt < 2; ++mt) { f32x4 y4 = {0.f, 0.f, 0.f, 0.f}; const int row = 16 * mt + (lane & 15);
#pragma unroll
                for (int ks = 0; ks < 4; ++ks) { const bf16x8 xa = *(const LAS bf16x8*)(wl + row * 512 + ((64 * ks + 16 * (lane >> 4) + 16 * row) & 255)); y4 = __builtin_amdgcn_mfma_f32_16x16x32_bf16(xa, cfg[ks], y4, 0, 0, 0); }
#pragma unroll
                for (int r = 0; r < 4; ++r) { const int tok = 16 * mt + 4 * (lane >> 4) + r; const float uu = bf2f(((const LAS unsigned short*)wx)[tok * 16 + (lane & 15)]);
                    zt[tok * 16 + (lane & 15)] = (unsigned short)f2bf(gelu_tanh(y4[r] + dsk * uu)); } }
            LDS_WAIT();
            *(v4u*)(Z + (size_t)(t0 + (lane >> 1)) * 512 + g * 16 + 8 * (lane & 1)) = *(const LAS v4u*)(wx + 1024 + lane * 16);
            LDS_WAIT();
        }
    }
    if (!FINAL) Fst[(c * 32 + g) * 64 + lane] = (f32x2){xr, xi};
}

__device__ __forceinline__ int krow(int s, int h, int j) { return 16 * s + 8 * (j >> 2) + 4 * h + (j & 3); }
__device__ __forceinline__ void cmp_l2_unit(const Frame& F, const Args& args, int kv, int g, int n, LAS float* hb, const LAS float* w2s) {
    const int lane = F.lane; const float* P1 = F.out;
    float o = 0.f;
    if (n < NCMP) {
        const int rt = kv * 2048 + g * 1024 + n;
        const float* posb = (const float*)(F.ws + WS_TAB + TAB_POSB) + kv * 16 * 256;
#pragma unroll
        for (int i = 0; i < 4; ++i) { const int j = lane + 64 * i; float a = 0.f;
#pragma unroll
            for (int ks = 0; ks < CMP_KS; ++ks) a += P1[((size_t)ks * 4096 + rt) * 512 + j] + P1[((size_t)ks * 4096 + rt + 1) * 512 + 256 + j];
#pragma unroll
            for (int p = 0; p < 16; ++p) a += posb[p * 256 + j];
            hb[j] = gelu_tanh(a); }
        LDS_WAIT();
#pragma unroll 8
        for (int j = 0; j < 256; ++j) o += hb[j] * w2s[j * 64 + lane];
    }
    if (kv == 0) ((bf16*)(F.ws + WS_KCB))[((size_t)g * 1024 + n) * 64 + lane] = (bf16)f2bf(o);
    else { const int grp = n >> 5, kk = n & 31, sx = kk >> 4, rem = kk & 15, hh = (rem >> 2) & 1, j = ((rem >> 3) << 2) | (rem & 3), d0 = lane >> 5, ln = hh * 32 + (lane & 31);
        ((bf16*)(F.ws + WS_VTC))[((((size_t)(g * 32 + grp) * 2 + d0) * 2 + sx) * 64 + ln) * 8 + j] = (bf16)f2bf(o); }
    LDS_WAIT();
}
__device__ __forceinline__ void vtw_item(const Frame& F, int g, int grp, LAS unsigned short* tl) {
    const int lane = F.lane, hi = lane >> 5; const bf16* V = (const bf16*)(F.ws + WS_KVH) + (size_t)(10 + g) * S * 64 + (size_t)32 * grp * 64;
#pragma unroll
    for (int e = 0; e < 4; ++e) ((LAS v4u*)tl)[lane + 64 * e] = ((const v4u*)V)[lane + 64 * e];
    LDS_WAIT();
#pragma unroll
    for (int d0 = 0; d0 < 2; ++d0)
#pragma unroll
        for (int sx = 0; sx < 2; ++sx) { unsigned w[4];
#pragma unroll
            for (int jj = 0; jj < 4; ++jj) { const unsigned a = tl[krow(sx, hi, 2 * jj) * 64 + 32 * d0 + (lane & 31)], b = tl[krow(sx, hi, 2 * jj + 1) * 64 + 32 * d0 + (lane & 31)]; w[jj] = a | (b << 16); }
            ((v4u*)(F.ws + WS_VTW))[(((size_t)(g * 512 + grp) * 2 + d0) * 2 + sx) * 64 + lane] = (v4u){w[0], w[1], w[2], w[3]}; }
    LDS_WAIT();
}
__device__ __forceinline__ int kap(int ks, int q, int j) { return 16 * (2 * ks + (j >> 2)) + 4 * q + (j & 3); }
__device__ __forceinline__ void vts_item(const Frame& F, int g, int blk, LAS unsigned short* tl) {
    const int lane = F.lane, q = lane >> 4; const bf16* V = (const bf16*)(F.ws + WS_KVH) + (size_t)(6 + g) * S * 64 + (size_t)64 * blk * 64;
#pragma unroll
    for (int e = 0; e < 8; ++e) ((LAS v4u*)tl)[lane + 64 * e] = ((const v4u*)V)[lane + 64 * e];
    LDS_WAIT();
#pragma unroll
    for (int dt = 0; dt < 4; ++dt)
#pragma unroll
        for (int ks = 0; ks < 2; ++ks) { unsigned w[4];
#pragma unroll
            for (int jj = 0; jj < 4; ++jj) { const unsigned a = tl[kap(ks, q, 2 * jj) * 64 + 16 * dt + (lane & 15)], b = tl[kap(ks, q, 2 * jj + 1) * 64 + 16 * dt + (lane & 15)]; w[jj] = a | (b << 16); }
            ((v4u*)(F.ws + WS_VTS))[(((size_t)(g * 256 + blk) * 4 + dt) * 2 + ks) * 64 + lane] = (v4u){w[0], w[1], w[2], w[3]}; }
    LDS_WAIT();
}

constexpr int AT_SC = 0;
constexpr int AT_SEL = 67584;
constexpr int AT_CNT = AT_SEL + 4096;
constexpr int AT_LIST = AT_CNT + 1024;
constexpr int AT_BT = AT_LIST + 32768;
constexpr int AT_PARK = AT_BT + 4096;
constexpr int AT_TILE = AT_PARK + 32768;
constexpr int AT_END = AT_TILE + 16384;
static_assert(AT_END <= LDS_BYTES - 64, "attention LDS map");
constexpr int PSLOTS = 832, PSLAB = 458752;
constexpr int PML_OFF = PSLOTS * 512;
constexpr int SCS = 264;
constexpr int XRN = 624;

__device__ __forceinline__ bf16x8 pack8(float a0, float a1, float a2, float a3, float a4, float a5, float a6, float a7) {
    v4u w; w.x = cvt_pk_bf16(a0, a1); w.y = cvt_pk_bf16(a2, a3); w.z = cvt_pk_bf16(a4, a5); w.w = cvt_pk_bf16(a6, a7); return __builtin_bit_cast(bf16x8, w);
}
__device__ __forceinline__ float xmax32(float v) { auto r = __builtin_amdgcn_permlane32_swap(__float_as_uint(v), __float_as_uint(v), false, false); return fmaxf(__uint_as_float(r[0]), __uint_as_float(r[1])); }
__device__ __forceinline__ float xsum32(float v) { auto r = __builtin_amdgcn_permlane32_swap(__float_as_uint(v), __float_as_uint(v), false, false); return __uint_as_float(r[0]) + __uint_as_float(r[1]); }
__device__ __forceinline__ float xmax16(float v) { auto r = __builtin_amdgcn_permlane16_swap(__float_as_uint(v), __float_as_uint(v), false, false); return fmaxf(__uint_as_float(r[0]), __uint_as_float(r[1])); }
__device__ __forceinline__ float xsum16(float v) { auto r = __builtin_amdgcn_permlane16_swap(__float_as_uint(v), __float_as_uint(v), false, false); return __uint_as_float(r[0]) + __uint_as_float(r[1]); }
__device__ __forceinline__ float max16(const f32x16& a) {
    const float m0 = fmaxf(fmaxf(a[0], a[1]), fmaxf(a[2], a[3])), m1 = fmaxf(fmaxf(a[4], a[5]), fmaxf(a[6], a[7])), m2 = fmaxf(fmaxf(a[8], a[9]), fmaxf(a[10], a[11])), m3 = fmaxf(fmaxf(a[12], a[13]), fmaxf(a[14], a[15]));
    return fmaxf(fmaxf(m0, m1), fmaxf(m2, m3)); }
__device__ __forceinline__ float sum16(const f32x16& a) {
    const float s0 = (a[0] + a[1]) + (a[2] + a[3]), s1 = (a[4] + a[5]) + (a[6] + a[7]), s2 = (a[8] + a[9]) + (a[10] + a[11]), s3 = (a[12] + a[13]) + (a[14] + a[15]);
    return (s0 + s1) + (s2 + s3); }
__device__ __forceinline__ int fenc(float f) { int k = __float_as_int(f); return k ^ ((k >> 31) & 0x7fffffff); }
__device__ __forceinline__ float fdec(int k) { return __int_as_float(k ^ ((k >> 31) & 0x7fffffff)); }
#define MFMA32(a, b, c) __builtin_amdgcn_mfma_f32_32x32x16_bf16((a), (b), (c), 0, 0, 0)
#define MFMA16(a, b, c) __builtin_amdgcn_mfma_f32_16x16x32_bf16((a), (b), (c), 0, 0, 0)
#define DPPI(x, ctrl) __builtin_amdgcn_update_dpp(0, (x), (ctrl), 0xF, 0xF, false)

struct AttnPtrs { const bf16* Q; const bf16* KCB; const bf16x8* VTC; const bf16* KW; const bf16x8* VTW; const bf16* KS; const bf16x8* VTS; const bf16* GN; bf16* O; };

__device__ __forceinline__ void attn_stageA(const AttnPtrs& P, int lane, int wave, int tile0, int g, LAS unsigned char* lds) {
    const int hi = lane >> 5, c32 = lane & 31, ti = c32 >> 2, hr = c32 & 3, h = g * 4 + hr, t0 = tile0 + 8 * wave, t = t0 + ti;
    LAS float* scores = (LAS float*)(lds + AT_SC) + (8 * wave) * SCS; const LAS float* BT = (const LAS float*)(lds + AT_BT); LAS int* sel = (LAS int*)(lds + AT_SEL) + (8 * wave) * 16;
    for (int k = lane; k < 8 * SCS / 4; k += 64) ((LAS f32x4*)scores)[k] = (f32x4){0.f, 0.f, 0.f, 0.f};
    bf16x8 bq[4];
#pragma unroll
    for (int ks = 0; ks < 4; ++ks) bq[ks] = *(const bf16x8*)(P.Q + (size_t)t * 512 + h * 64 + 16 * ks + 8 * hi);
    const float cb = BT[hr * 256 + 64];
    const float g0 = bf2f(P.GN[(size_t)t * 32 + h * 3 + 0]), g2 = bf2f(P.GN[(size_t)t * 32 + h * 3 + 2]);
    {   LAS float* XR = (LAS float*)(lds + AT_LIST);
        for (int i = wave * 64 + lane; i < 4 * XRN; i += NWAVES * 64) { const int hh = i / XRN, d = 575 - (i - hh * XRN); XR[i] = (d < 0 || d >= 512) ? -1e30f : BT[hh * 256 + 191 - min(d, 127)]; } }
    LDS_WAIT();
    const int tid = wave * 64 + lane; LAS unsigned char* tb = lds + AT_TILE;
    const int ldrow = tid >> 3, ldch = tid & 7; const unsigned stoff = (tid < 256) ? (unsigned)(ldrow * 128 + ((ldch ^ (ldrow & 7)) << 4)) : (unsigned)(8192 + (tid - 256) * 16);
    const unsigned kof = (unsigned)(c32 * 128), ksw = (unsigned)(c32 & 7);
#define KFRAG(buf, ks) (*(const LAS bf16x8*)(tb + (buf) * 4096 + kof + ((((ks) * 2 + hi) ^ ksw) << 4)))
#define VFRAG(buf, f) (*(const LAS bf16x8*)(tb + 8192 + (buf) * 4096 + ((f) * 64 + lane) * 16))
#define STAGE_LOAD(Kp, kmax, VTp, gmax, n0v) ((tid < 256) ? *(const v4u*)((Kp) + (size_t)min((n0v) + ldrow, (kmax)) * 64 + ldch * 8) : *(const v4u*)((VTp) + (size_t)min((n0v) >> 5, (gmax)) * 256 + (tid - 256)))
#define STAGE_WRITE(v, buf) (*(LAS v4u*)(tb + (buf) * 4096 + stoff) = (v))
#define PVACC(o0v, o1v, buf, a) do { const bf16x8 p0_ = pack8(a[0], a[1], a[2], a[3], a[4], a[5], a[6], a[7]), p1_ = pack8(a[8], a[9], a[10], a[11], a[12], a[13], a[14], a[15]); \
        o0v = MFMA32(VFRAG(buf, 0), p0_, o0v); o0v = MFMA32(VFRAG(buf, 1), p1_, o0v); o1v = MFMA32(VFRAG(buf, 2), p0_, o1v); o1v = MFMA32(VFRAG(buf, 3), p1_, o1v); } while (0)
    constexpr float SM_THR = 8.0f;
#define REF_EVENT(a, mref, started, d, fs) { const float tm_ = xmax32(max16(a)); const bool need_ = started ? (tm_ > SM_THR) : (tm_ > -1e29f); d = 0.f; fs = 1.f; \
        if (__any(need_)) { d = need_ ? tm_ : 0.f; fs = (need_ && started) ? __builtin_amdgcn_exp2f(-d) : 1.f; mref += d; started = started || need_; _Pragma("unroll") for (int r = 0; r < 16; ++r) a[r] -= d; } }
    const int ncb = (tile0 + 63 >= 31) ? min((tile0 + 63 - 31) / 16 + 1, NCMP) : 0, ntc = (ncb + 31) >> 5;
    const int nfar = (t0 >= 144) ? (t0 - 144) / 16 + 1 : 0;
#define CSCORE(a, buf, n0v, farv, refv) do { { const float ini_ = ((farv) ? cb : 0.f) - (refv); _Pragma("unroll") for (int r = 0; r < 16; ++r) a[r] = ini_; } \
        _Pragma("unroll") for (int ks = 0; ks < 4; ++ks) a = MFMA32(KFRAG(buf, ks), bq[ks], a); \
        if (!(farv)) { _Pragma("unroll") for (int r = 0; r < 16; ++r) { const int dist = t - (16 * ((n0v) + crow(r, hi)) + 31); a[r] += BT[hr * 256 + 191 - max(min(dist, 127), -1)]; } } } while (0)
#define STAGE_PROLOGUE(Kp, kmax, VTp, gmax, nbase, ntl) v4u RA, RB; { RA = STAGE_LOAD(Kp, kmax, VTp, gmax, nbase); STAGE_WRITE(RA, 0); RB = STAGE_LOAD(Kp, kmax, VTp, gmax, (nbase) + 32 * min(1, (ntl) - 1)); __syncthreads(); }
    float mc = 0.f, lc = 0.f; bool stc = false;
    if (ntc > 0) {
        STAGE_PROLOGUE(P.KCB, 1023, P.VTC, 31, 0, ntc)
#define C1STEP(iv, BUF, RL, RW) { const int i = (iv); if (i >= ntc) break; const int n0 = 32 * i; RL = STAGE_LOAD(P.KCB, 1023, P.VTC, 31, 32 * min(i + 2, ntc - 1)); \
            const bool far = (n0 + 32 <= nfar); f32x16 a; CSCORE(a, BUF, n0, far, mc); \
            float d_, fs_; REF_EVENT(a, mc, stc, d_, fs_) lc *= fs_; \
            _Pragma("unroll") for (int r = 0; r < 16; ++r) a[r] = __builtin_amdgcn_exp2f(a[r]); \
            lc += xsum32(sum16(a)); STAGE_WRITE(RW, (BUF) ^ 1); __syncthreads(); }
        for (int ib = 0; ; ib += 2) { C1STEP(ib, 0, RA, RB) C1STEP(ib + 1, 1, RB, RA) }
#undef C1STEP
    }
    {   const float invl = 1.0f / fmaxf(lc, 1e-30f); f32x16 oc0 = {}, oc1 = {}; float carry = 0.f;
#define CIMP(a, n0v) do { float mq[4], cq[4]; \
            _Pragma("unroll") for (int qg = 0; qg < 4; ++qg) { float mv = (2.0f * (a[4 * qg] + a[4 * qg + 1] + a[4 * qg + 2]) + a[4 * qg + 3]) * invl, cv = a[4 * qg + 3] * invl; \
                mv += __int_as_float(DPPI(__float_as_int(mv), 0xB1)); mv += __int_as_float(DPPI(__float_as_int(mv), 0x4E)); \
                cv += __int_as_float(DPPI(__float_as_int(cv), 0xB1)); cv += __int_as_float(DPPI(__float_as_int(cv), 0x4E)); mq[qg] = mv; cq[qg] = cv; } \
            float oth[4]; \
            _Pragma("unroll") for (int qg = 0; qg < 4; ++qg) { auto rr = __builtin_amdgcn_permlane32_swap(__float_as_uint(cq[qg]), __float_as_uint(cq[qg]), false, false); oth[qg] = __uint_as_float(hi ? rr[0] : rr[1]); } \
            _Pragma("unroll") for (int qg = 0; qg < 4; ++qg) { const float tot = mq[qg] + (hi ? oth[qg] : (qg ? oth[qg - 1] : carry)); if (hr == 0) scores[ti * SCS + (((n0v) + 8 * qg + 4 * hi) >> 2)] = tot; } \
            carry = oth[3]; } while (0)
        if (ntc > 0) {
            STAGE_PROLOGUE(P.KCB, 1023, P.VTC, 31, 0, ntc)
#define C2STEP(iv, BUF, RL, RW) { const int i = (iv); if (i >= ntc) break; const int n0 = 32 * i; RL = STAGE_LOAD(P.KCB, 1023, P.VTC, 31, 32 * min(i + 2, ntc - 1)); \
                const bool far = (n0 + 32 <= nfar); f32x16 a; CSCORE(a, BUF, n0, far, mc); \
                _Pragma("unroll") for (int r = 0; r < 16; ++r) a[r] = __builtin_amdgcn_exp2f(a[r]); \
                CIMP(a, n0); PVACC(oc0, oc1, BUF, a); STAGE_WRITE(RW, (BUF) ^ 1); __syncthreads(); }
            for (int ib = 0; ; ib += 2) { C2STEP(ib, 0, RA, RB) C2STEP(ib + 1, 1, RB, RA) }
#undef C2STEP
            { const int jn = ntc * 8; if (jn < 256 && hi == 0 && hr == 0) scores[ti * SCS + jn] = carry; }
        }
#undef CIMP
        {   LAS unsigned char* park = lds + AT_PARK + (((8 * wave + ti) * 4 + hr) * 64) * 2;
            const float gs = g0 * invl;
#pragma unroll
            for (int d0 = 0; d0 < 2; ++d0)
#pragma unroll
                for (int r4 = 0; r4 < 4; ++r4) { const f32x16& Wd = d0 ? oc1 : oc0; const int dim = 32 * d0 + 8 * r4 + 4 * hi;
                    *(LAS unsigned long long*)(park + dim * 2) = (unsigned long long)cvt_pk_bf16(Wd[4 * r4] * gs, Wd[4 * r4 + 1] * gs) | ((unsigned long long)cvt_pk_bf16(Wd[4 * r4 + 2] * gs, Wd[4 * r4 + 3] * gs) << 32); } } }
#undef CSCORE
    {   float mw = 0.f, lw = 0.f; bool stw = false; f32x16 o0 = {}, o1 = {};
        const int nlo = max(t0 - 511, 0) & ~31, nhi = (t0 + 7) & ~31;
        const int nlb = max(tile0 - 511, 0) & ~31, ntw = (((tile0 + 63) & ~31) - nlb) / 32 + 1;
        const LAS float* xrb = (const LAS float*)(lds + AT_LIST) + hr * XRN + (575 - ti + 4 * hi);
        STAGE_PROLOGUE(P.KW, S - 1, P.VTW, 511, nlb, ntw)
#define WSTEP(iv, BUF, RL, RW) { const int i = (iv); if (i >= ntw) break; const int n0 = nlb + 32 * i; RL = STAGE_LOAD(P.KW, S - 1, P.VTW, 511, nlb + 32 * min(i + 2, ntw - 1)); \
            if (n0 >= nlo && n0 <= nhi) { const bool mid = (n0 >= t0 - 504) && (n0 <= t0 - 144); \
                f32x16 a; if (mid) { const float ini_ = cb - mw; _Pragma("unroll") for (int r = 0; r < 16; ++r) a[r] = ini_; } \
                else { const LAS float* xr_ = xrb + (n0 - t0); _Pragma("unroll") for (int r = 0; r < 16; ++r) a[r] = xr_[(r & 3) + 8 * (r >> 2)] - mw; } \
                _Pragma("unroll") for (int ks = 0; ks < 4; ++ks) a = MFMA32(KFRAG(BUF, ks), bq[ks], a); \
                float d_, fs_; REF_EVENT(a, mw, stw, d_, fs_) if (fs_ != 1.f || d_ != 0.f) { lw *= fs_; o0 = o0 * fs_; o1 = o1 * fs_; } \
                _Pragma("unroll") for (int r = 0; r < 16; ++r) a[r] = __builtin_amdgcn_exp2f(a[r]); \
                lw += xsum32(sum16(a)); PVACC(o0, o1, BUF, a); } \
            STAGE_WRITE(RW, (BUF) ^ 1); __syncthreads(); }
        for (int ib = 0; ; ib += 2) { WSTEP(ib, 0, RA, RB) WSTEP(ib + 1, 1, RB, RA) }
#undef WSTEP
        const float sc = g2 / fmaxf(lw, 1e-30f);
        LAS unsigned char* park = lds + AT_PARK + (((8 * wave + ti) * 4 + hr) * 64) * 2;
#pragma unroll
        for (int d0 = 0; d0 < 2; ++d0)
#pragma unroll
            for (int r4 = 0; r4 < 4; ++r4) { const f32x16& Od = d0 ? o1 : o0; const int dim = 32 * d0 + 8 * r4 + 4 * hi; const unsigned long long w = *(const LAS unsigned long long*)(park + dim * 2); const unsigned lo = (unsigned)w, hw = (unsigned)(w >> 32);
                *(LAS unsigned long long*)(park + dim * 2) = (unsigned long long)cvt_pk_bf16(bflo(lo) + Od[4 * r4] * sc, bfhi(lo) + Od[4 * r4 + 1] * sc) | ((unsigned long long)cvt_pk_bf16(bflo(hw) + Od[4 * r4 + 2] * sc, bfhi(hw) + Od[4 * r4 + 3] * sc) << 32); } }
#undef REF_EVENT
#undef STAGE_PROLOGUE
#undef PVACC
#undef KFRAG
#undef VFRAG
#undef STAGE_LOAD
#undef STAGE_WRITE
    LDS_WAIT();
    {   const int cur = tile0 >> 6, i = lane >> 3, s8 = lane & 7;
        if (cur + 1 <= 16) { for (int e = lane; e < 8 * 16; e += 64) sel[e] = e & 15; }
        else {
            float sv[32];
#pragma unroll
            for (int k = 0; k < 32; ++k) { const int j = s8 + 8 * k; sv[k] = (j >= 1 && j <= cur - 2) ? scores[i * SCS + j] : -3e38f; }
            if (s8 == 0) { sel[i * 16 + 0] = 0; sel[i * 16 + 1] = cur - 1; sel[i * 16 + 2] = cur; }
            for (int it = 3; it < 16; ++it) {
                float bv = sv[0]; int bj = s8;
#pragma unroll
                for (int k = 1; k < 32; ++k) if (sv[k] > bv) { bv = sv[k]; bj = s8 + 8 * k; }
#define SEL_STEP(ctrl) { const float ov = __int_as_float(DPPI(__float_as_int(bv), ctrl)); const int oj = DPPI(bj, ctrl); if (ov > bv || (ov == bv && oj < bj)) { bv = ov; bj = oj; } }
                SEL_STEP(0xB1) SEL_STEP(0x4E) SEL_STEP(0x141)
#undef SEL_STEP
                if (s8 == 0) sel[i * 16 + it] = bj;
#pragma unroll
                for (int k = 0; k < 32; ++k) if (bj == s8 + 8 * k) sv[k] = -3e38f;
            }
        }
    }
}

__device__ __forceinline__ void s_scores(const bf16x8 (&kf)[8], const bf16x8 q0, const bf16x8 q1, bool cst, float cbs, const LAS float* BT, int hd, int tt, int j, int q, f32x4 (&sa)[4]) {
    if (cst) {
#pragma unroll
        for (int mt = 0; mt < 4; ++mt) sa[mt] = (f32x4){cbs, cbs, cbs, cbs}; }
    else { const LAS float* xb = BT + hd * 256 + (191 - tt + 64 * j + 4 * q);
#pragma unroll
        for (int mt = 0; mt < 4; ++mt)
#pragma unroll
            for (int r = 0; r < 4; ++r) sa[mt][r] = xb[16 * mt + r]; }
#pragma unroll
    for (int mt = 0; mt < 4; ++mt) { sa[mt] = MFMA16(kf[mt * 2], q0, sa[mt]); sa[mt] = MFMA16(kf[mt * 2 + 1], q1, sa[mt]); }
}
template <bool MASKED> __device__ __forceinline__ void s_softmax(f32x4 (&sa)[4], float& tm, float& ls) {
    tm = sa[0][0];
#pragma unroll
    for (int mt = 0; mt < 4; ++mt)
#pragma unroll
        for (int r = 0; r < 4; ++r) tm = fmaxf(tm, sa[mt][r]);
    tm = xmax32(xmax16(tm)); ls = 0.f;
#pragma unroll
    for (int mt = 0; mt < 4; ++mt)
#pragma unroll
        for (int r = 0; r < 4; ++r) { const float e = __builtin_amdgcn_exp2f(sa[mt][r] - tm); sa[mt][r] = (!MASKED || sa[mt][r] > -1e29f) ? e : 0.f; ls += sa[mt][r]; }
    ls = xsum32(xsum16(ls));
}
__device__ __forceinline__ void load_kf(const AttnPtrs& P, int lane, int j, bf16x8 (&kf)[8]) {
    const bf16* kp = P.KS + (size_t)(64 * j + (lane & 15)) * 64 + 8 * (lane >> 4);
#pragma unroll
    for (int mt = 0; mt < 4; ++mt) { kf[mt * 2] = *(const bf16x8*)(kp + (size_t)mt * 16 * 64); kf[mt * 2 + 1] = *(const bf16x8*)(kp + (size_t)mt * 16 * 64 + 32); }
}
__device__ __forceinline__ void load_vf(const AttnPtrs& P, int lane, int j, bf16x8 (&vf)[8]) {
    const bf16x8* vt = P.VTS + (size_t)j * 8 * 64 + lane;
#pragma unroll
    for (int e = 0; e < 8; ++e) vf[e] = vt[e * 64];
}
__device__ __forceinline__ void s_chunk(const bf16x8 (&kf)[8], const bf16x8 (&vf)[8], int j, int ch, int n, bool cst, float cbs, const LAS float* BT, const LAS unsigned short* list,
                                        const LAS unsigned char* qt, unsigned char* slab, int tile0, int c, int q, int hd, int hs) {
    const int sidx = 4 * ch + (c >> 2); const bool valid = sidx < n; const int sl = (int)list[j * 64 + (valid ? sidx : 0)]; const int tokl = sl / 13, r = tokl * 4 + hd;
    const LAS unsigned char* qr = qt + r * 128; const bf16x8 q0 = *(const LAS bf16x8*)(qr + ((q ^ (r & 7)) << 4)), q1 = *(const LAS bf16x8*)(qr + (((q + 4) ^ (r & 7)) << 4));
    f32x4 sa[4]; s_scores(kf, q0, q1, cst, cbs, BT, hd, tile0 + tokl, j, q, sa);
    float tm, ls; s_softmax<false>(sa, tm, ls);
    const bf16x8 p0 = pack8(sa[0][0], sa[0][1], sa[0][2], sa[0][3], sa[1][0], sa[1][1], sa[1][2], sa[1][3]), p1 = pack8(sa[2][0], sa[2][1], sa[2][2], sa[2][3], sa[3][0], sa[3][1], sa[3][2], sa[3][3]);
    unsigned char* po = slab + ((size_t)(sl * 4 + hd) * 64 + 16 * q) * 2;
    unsigned pw[8];
#pragma unroll
    for (int dt = 0; dt < 4; ++dt) { f32x4 oa = {0.f, 0.f, 0.f, 0.f}; oa = MFMA16(vf[dt * 2], p0, oa); oa = MFMA16(vf[dt * 2 + 1], p1, oa); pw[2 * dt] = cvt_pk_bf16(oa[0], oa[1]); pw[2 * dt + 1] = cvt_pk_bf16(oa[2], oa[3]); }
    if (valid) { *(v4u*)po = (v4u){pw[0], pw[1], pw[2], pw[3]}; *(v4u*)(po + 16) = (v4u){pw[4], pw[5], pw[6], pw[7]}; }
    if (valid && q == 0) *(f32x2*)(slab + PML_OFF + (size_t)(sl * 4 + hd) * 8) = (f32x2){tm, ls};
}
__device__ __forceinline__ void attn_stageB(const AttnPtrs& P, int lane, int wave, int tile0, int g, LAS unsigned char* lds, unsigned char* slab) {
    const int T = tile0 >> 6, c = lane & 15, q = lane >> 4, hd = c & 3, hs = g * 4 + hd;
    if (T <= 15) return;
    LAS unsigned* cnt = (LAS unsigned*)(lds + AT_CNT); const LAS unsigned short* list = (const LAS unsigned short*)(lds + AT_LIST); const LAS float* BT = (const LAS float*)(lds + AT_BT);
    const LAS unsigned char* qt = lds + AT_SC;
    const float cbs = BT[hd * 256 + 64];
#define GRAB_ISSUE(tv) { tv = 0; if (lane == 0) tv = (int)__hip_atomic_fetch_add(&cnt[0], 1u, __ATOMIC_RELAXED, __HIP_MEMORY_SCOPE_WORKGROUP); }
#define GRAB_TAKE(tv, jv, nv) { jv = (int)__builtin_amdgcn_readfirstlane(tv) + 1; nv = 0; if (jv <= T - 2) nv = (int)__builtin_amdgcn_readfirstlane((int)cnt[jv]); }
    bf16x8 KA[8], VA[8], KB[8], VB[8];
    int jc, nc, jn, nn;
    { int t0_, t1_; GRAB_ISSUE(t0_) GRAB_ISSUE(t1_) GRAB_TAKE(t0_, jc, nc) if (jc > T - 2) return; GRAB_TAKE(t1_, jn, nn) }
    load_kf(P, lane, jc, KA); load_vf(P, lane, jc, VA);
    load_kf(P, lane, min(jn, T - 2), KB); load_vf(P, lane, min(jn, T - 2), VB);
#define BSTEP(KX, VX) { int t2_; GRAB_ISSUE(t2_) \
        { const bool cst = (jc <= T - 3);        \
          if (nc > 0) s_chunk(KX, VX, jc, 0, nc, cst, cbs, BT, list, qt, slab, tile0, c, q, hd, hs); \
          if (nc > 4) s_chunk(KX, VX, jc, 1, nc, cst, cbs, BT, list, qt, slab, tile0, c, q, hd, hs); \
          if (nc > 8) { _Pragma("unroll 1") for (int ch = 2; 4 * ch < nc; ++ch) s_chunk(KX, VX, jc, ch, nc, cst, cbs, BT, list, qt, slab, tile0, c, q, hd, hs); } } \
        int j2_, n2_; GRAB_TAKE(t2_, j2_, n2_) \
        load_kf(P, lane, min(j2_, T - 2), KX); load_vf(P, lane, min(j2_, T - 2), VX); \
        jc = jn; nc = nn; jn = j2_; nn = n2_; }
    do { BSTEP(KA, VA) BSTEP(KB, VB) } while (jc <= T - 2);
#undef BSTEP
#undef GRAB_ISSUE
#undef GRAB_TAKE
}
struct SState { float M, L; f32x4 O[4]; };
__device__ __forceinline__ void s_merge(SState& st, float m, float l, const f32x4 (&o)[4]) {
    const float mn = fmaxf(st.M, m), a0 = __builtin_amdgcn_exp2f(st.M - mn), a1 = __builtin_amdgcn_exp2f(m - mn);
    st.L = st.L * a0 + l * a1; st.M = mn;
#pragma unroll
    for (int dt = 0; dt < 4; ++dt) st.O[dt] = st.O[dt] * a0 + o[dt] * a1;
}
__device__ __forceinline__ void attn_stageC_forced(const AttnPtrs& P, int lane, int wave, int tile0, int g, LAS unsigned char* lds, SState (&st)[2]) {
    const int T = tile0 >> 6, c = lane & 15, q = lane >> 4, hd = c & 3, hs = g * 4 + hd; const LAS float* BT = (const LAS float*)(lds + AT_BT); const float cbs = BT[hd * 256 + 64];
    bf16x8 q0[2], q1[2];
#pragma unroll
    for (int k = 0; k < 2; ++k) { const int tt = tile0 + 8 * wave + 4 * k + (c >> 2); q0[k] = *(const bf16x8*)(P.Q + (size_t)tt * 512 + hs * 64 + 8 * q); q1[k] = *(const bf16x8*)(P.Q + (size_t)tt * 512 + hs * 64 + 32 + 8 * q);
        st[k].M = -1e30f; st[k].L = 0.f;
#pragma unroll
        for (int dt = 0; dt < 4; ++dt) st[k].O[dt] = (f32x4){0.f, 0.f, 0.f, 0.f}; }
    const int nf = T <= 15 ? T + 1 : 3;
    auto fblk = [&](int it) -> int { return T <= 15 ? it : (it == 0 ? 0 : (it == 1 ? T - 1 : T)); };
    bf16x8 kf[8], vf[8]; load_kf(P, lane, fblk(0), kf); load_vf(P, lane, fblk(0), vf);
#pragma unroll 1
    for (int it = 0; it < nf; ++it) { const int j = fblk(it);
        bf16x8 kn[8]; load_kf(P, lane, fblk(min(it + 1, nf - 1)), kn);
        const bool cst = (j <= T - 3);
#pragma unroll
        for (int k = 0; k < 2; ++k) { const int tt = tile0 + 8 * wave + 4 * k + (c >> 2);
            f32x4 sa[4]; s_scores(kf, q0[k], q1[k], cst, cbs, BT, hd, tt, j, q, sa);
            float tm, ls; s_softmax<true>(sa, tm, ls);
            const bf16x8 p0 = pack8(sa[0][0], sa[0][1], sa[0][2], sa[0][3], sa[1][0], sa[1][1], sa[1][2], sa[1][3]), p1 = pack8(sa[2][0], sa[2][1], sa[2][2], sa[2][3], sa[3][0], sa[3][1], sa[3][2], sa[3][3]);
            f32x4 ob[4];
#pragma unroll
            for (int dt = 0; dt < 4; ++dt) { ob[dt] = (f32x4){0.f, 0.f, 0.f, 0.f}; ob[dt] = MFMA16(vf[dt * 2], p0, ob[dt]); ob[dt] = MFMA16(vf[dt * 2 + 1], p1, ob[dt]); }
            s_merge(st[k], tm, ls, ob); }
#pragma unroll
        for (int e = 0; e < 8; ++e) kf[e] = kn[e];
        if (it + 1 < nf) load_vf(P, lane, fblk(it + 1), vf);
    }
}
__device__ __forceinline__ void attn_stageC_forced_lds(const AttnPtrs& P, int lane, int wave, int tile0, int g, LAS unsigned char* lds, SState (&st)[2]) {
    const int T = tile0 >> 6, c = lane & 15, q = lane >> 4, hd = c & 3, hs = g * 4 + hd; const LAS float* BT = (const LAS float*)(lds + AT_BT); const float cbs = BT[hd * 256 + 64];
    bf16x8 q0[2], q1[2];
#pragma unroll
    for (int k = 0; k < 2; ++k) { const int r = (8 * wave + 4 * k + (c >> 2)) * 4 + hd; const LAS unsigned char* qr = lds + AT_SC + r * 128;
        q0[k] = *(const LAS bf16x8*)(qr + ((q ^ (r & 7)) << 4)); q1[k] = *(const LAS bf16x8*)(qr + (((q + 4) ^ (r & 7)) << 4));
        st[k].M = -1e30f; st[k].L = 0.f;
#pragma unroll
        for (int dt = 0; dt < 4; ++dt) st[k].O[dt] = (f32x4){0.f, 0.f, 0.f, 0.f}; }
#pragma unroll
    for (int it = 0; it < 3; ++it) { const int j = it == 0 ? 0 : (it == 1 ? T - 1 : T); const LAS unsigned char* fb = lds + (it == 2 ? AT_TILE : AT_SC + 32768 + 16384 * it);
        bf16x8 kf[8], vf[8];
#pragma unroll
        for (int mt = 0; mt < 4; ++mt) { const int row = 16 * mt + c; kf[mt * 2] = *(const LAS bf16x8*)(fb + row * 128 + ((q ^ (row & 7)) << 4)); kf[mt * 2 + 1] = *(const LAS bf16x8*)(fb + row * 128 + (((q + 4) ^ (row & 7)) << 4)); }
#pragma unroll
        for (int e = 0; e < 8; ++e) vf[e] = *(const LAS bf16x8*)(fb + 8192 + (e * 64 + lane) * 16);
        const bool cst = (it == 0);
#pragma unroll
        for (int k = 0; k < 2; ++k) { const int tt = tile0 + 8 * wave + 4 * k + (c >> 2);
            f32x4 sa[4]; s_scores(kf, q0[k], q1[k], cst, cbs, BT, hd, tt, j, q, sa);
            float tm, ls; s_softmax<true>(sa, tm, ls);
            const bf16x8 p0 = pack8(sa[0][0], sa[0][1], sa[0][2], sa[0][3], sa[1][0], sa[1][1], sa[1][2], sa[1][3]), p1 = pack8(sa[2][0], sa[2][1], sa[2][2], sa[2][3], sa[3][0], sa[3][1], sa[3][2], sa[3][3]);
            f32x4 ob[4];
#pragma unroll
            for (int dt = 0; dt < 4; ++dt) { ob[dt] = (f32x4){0.f, 0.f, 0.f, 0.f}; ob[dt] = MFMA16(vf[dt * 2], p0, ob[dt]); ob[dt] = MFMA16(vf[dt * 2 + 1], p1, ob[dt]); }
            s_merge(st[k], tm, ls, ob); } }
}
__device__ __forceinline__ void attn_stageC_merge(const AttnPtrs& P, int lane, int wave, int tile0, int g, LAS unsigned char* lds, const unsigned char* slab, SState (&st)[2]) {
    const int T = tile0 >> 6, c = lane & 15, q = lane >> 4, hd = c & 3, hs = g * 4 + hd;
#pragma unroll
    for (int k = 0; k < 2; ++k) { const int tok = 8 * wave + 4 * k + (c >> 2), tt = tile0 + tok;
        if (T > 15) {
#pragma unroll
            for (int b0 = 0; b0 < 13; b0 += 13) {
                f32x2 mlv[13]; v4u ow[13][2];
#pragma unroll
                for (int bb = 0; bb < 13; ++bb) if (b0 + bb < 13) { const int sl = tok * 13 + b0 + bb;
                    mlv[bb] = *(const f32x2*)(slab + PML_OFF + (size_t)(sl * 4 + hd) * 8);
                    const unsigned char* po = slab + ((size_t)(sl * 4 + hd) * 64 + 16 * q) * 2; ow[bb][0] = *(const v4u*)po; ow[bb][1] = *(const v4u*)(po + 16); }
#pragma unroll
                for (int bb = 0; bb < 13; ++bb) if (b0 + bb < 13) { f32x4 ob[4];
                    ob[0] = (f32x4){bflo(ow[bb][0].x), bfhi(ow[bb][0].x), bflo(ow[bb][0].y), bfhi(ow[bb][0].y)}; ob[1] = (f32x4){bflo(ow[bb][0].z), bfhi(ow[bb][0].z), bflo(ow[bb][0].w), bfhi(ow[bb][0].w)};
                    ob[2] = (f32x4){bflo(ow[bb][1].x), bfhi(ow[bb][1].x), bflo(ow[bb][1].y), bfhi(ow[bb][1].y)}; ob[3] = (f32x4){bflo(ow[bb][1].z), bfhi(ow[bb][1].z), bflo(ow[bb][1].w), bfhi(ow[bb][1].w)};
                    s_merge(st[k], mlv[bb].x, mlv[bb].y, ob); } } }
        const float g1 = bf2f(P.GN[(size_t)tt * 32 + hs * 3 + 1]) / fmaxf(st[k].L, 1e-30f);
        LAS unsigned char* park = lds + AT_PARK + ((tok * 4 + hd) * 64 + 4 * q) * 2;
#pragma unroll
        for (int dt = 0; dt < 4; ++dt) { const unsigned long long w = *(const LAS unsigned long long*)(park + dt * 32); const unsigned lo = (unsigned)w, hw = (unsigned)(w >> 32);
            const unsigned o0 = cvt_pk_bf16(bflo(lo) + g1 * st[k].O[dt][0], bfhi(lo) + g1 * st[k].O[dt][1]), o1 = cvt_pk_bf16(bflo(hw) + g1 * st[k].O[dt][2], bfhi(hw) + g1 * st[k].O[dt][3]);
            *(LAS unsigned long long*)(park + dt * 32) = (unsigned long long)o0 | ((unsigned long long)o1 << 32); } }
    LDS_WAIT();
#pragma unroll
    for (int e = 0; e < 4; ++e) { const int idx = lane + 64 * e, tokl = idx >> 5, piece = idx & 31;
        *(v4u*)((unsigned char*)P.O + (size_t)(tile0 + 8 * wave + tokl) * 1024 + g * 512 + piece * 16) = *(const LAS v4u*)(lds + AT_PARK + (8 * wave + tokl) * 512 + piece * 16); }
    LDS_WAIT();
}
__device__ __forceinline__ void attn_tile(const Frame& F, unsigned char* ws, const float* pbias, int tile, int g, unsigned soff) {
    int lane = F.lane; asm volatile("" : "+v"(lane));
    const int wave = F.wave, tile0 = tile * 64, T = tile; LAS unsigned char* lds = F.lds;
    if (F.tid < 256) ((LAS unsigned*)(lds + AT_CNT))[F.tid] = 0u;
    {   LAS float* BT = (LAS float*)(lds + AT_BT);
        for (int i = F.tid; i < 4 * 256; i += NWAVES * 64) { const int hh = i >> 8, d = 191 - (i & 255); float v = -1e30f;
            if (d >= 0) { const int dd = min(d, 127); int bk = dd; if (dd >= 16) { bk = 16 + (int)(logf((float)dd * (1.0f / 16.0f)) / 2.0794415416798357f * 16.0f); if (bk > 31) bk = 31; }
                v = pbias[bk * 8 + g * 4 + hh] * 1.4426950408889634f; }
            BT[i] = v; } }
    __syncthreads();
    AttnPtrs P;
    {   const bf16* KVH = (const bf16*)(ws + WS_KVH);
        P.Q = (const bf16*)(ws + WS_Q); P.KCB = (const bf16*)(ws + WS_KCB) + (size_t)g * 1024 * 64; P.VTC = (const bf16x8*)(ws + WS_VTC) + (size_t)g * 32 * 4 * 64;
        P.KW = KVH + (size_t)(8 + g) * S * 64; P.VTW = (const bf16x8*)(ws + WS_VTW) + (size_t)g * 512 * 4 * 64; P.GN = (const bf16*)(ws + WS_GN);
        P.KS = nullptr; P.VTS = nullptr; P.O = nullptr; }
    attn_stageA(P, lane, wave, tile0, g, lds);
    __syncthreads();
    unsigned char* ws2 = ws;
    {   const bf16* KVH = (const bf16*)(ws2 + WS_KVH);
        P.Q = (const bf16*)(ws2 + WS_Q); P.KS = KVH + (size_t)(4 + g) * S * 64; P.VTS = (const bf16x8*)(ws2 + WS_VTS) + (size_t)g * 256 * 8 * 64; P.GN = (const bf16*)(ws2 + WS_GN); P.O = (bf16*)(ws2 + WS_O);
        P.KCB = nullptr; P.VTC = nullptr; P.KW = nullptr; P.VTW = nullptr; }
    unsigned char* slab = ((blockIdx.x < 128) ? (unsigned char*)F.out : ws2 + WS_PSLAB) + soff;
    if (T > 15) {
        LAS unsigned* cnt = (LAS unsigned*)(lds + AT_CNT); LAS unsigned short* list = (LAS unsigned short*)(lds + AT_LIST); const LAS int* sel = (const LAS int*)(lds + AT_SEL);
        const int tok = F.tid >> 3;
        v4u qv[4];
#pragma unroll
        for (int e = 0; e < 4; ++e) { const int idx = F.tid + 512 * e, row = idx >> 3, piece = idx & 7; qv[e] = *(const v4u*)((const unsigned char*)P.Q + (size_t)(tile0 + (row >> 2)) * 1024 + g * 512 + (row & 3) * 128 + piece * 16); }
#pragma unroll
        for (int e = 0; e < 2; ++e) { const int b = (F.tid & 7) * 2 + e;
            if (b >= 3) { const int j = sel[tok * 16 + b]; const unsigned pos = __hip_atomic_fetch_add(&cnt[j], 1u, __ATOMIC_RELAXED, __HIP_MEMORY_SCOPE_WORKGROUP); list[j * 64 + pos] = (unsigned short)(tok * 13 + b - 3); } }
#pragma unroll
        for (int e = 0; e < 4; ++e) { const int idx = F.tid + 512 * e, row = idx >> 3, piece = idx & 7; *(LAS v4u*)(lds + AT_SC + row * 128 + ((piece ^ (row & 7)) << 4)) = qv[e]; }
        {   v4u fk[3], fv[3];
#pragma unroll
            for (int e = 0; e < 3; ++e) { const int j = e == 0 ? 0 : (e == 1 ? T - 1 : T); fk[e] = *(const v4u*)((const unsigned char*)P.KS + (size_t)j * 8192 + F.tid * 16); fv[e] = *(const v4u*)((const unsigned char*)P.VTS + (size_t)j * 8192 + F.tid * 16); }
            const int row = F.tid >> 3, piece = F.tid & 7;
#pragma unroll
            for (int e = 0; e < 3; ++e) { LAS unsigned char* fb = lds + (e == 2 ? AT_TILE : AT_SC + 32768 + 16384 * e); *(LAS v4u*)(fb + row * 128 + ((piece ^ (row & 7)) << 4)) = fk[e]; *(LAS v4u*)(fb + 8192 + F.tid * 16) = fv[e]; } }
        __syncthreads(); }
    attn_stageB(P, lane, wave, tile0, g, lds, slab);
    SState st[2];
    if (T > 15) attn_stageC_forced_lds(P, lane, wave, tile0, g, lds, st); else attn_stageC_forced(P, lane, wave, tile0, g, lds, st);
    asm volatile("s_waitcnt vmcnt(0)" ::: "memory");
    __syncthreads();
    __builtin_amdgcn_fence(__ATOMIC_ACQUIRE, "agent");
    attn_stageC_merge(P, lane, wave, tile0, g, lds, slab, st);
    __syncthreads();
}

#define XB_TMO      128
#define XB_XCNT(j)  (256  + 64 * (j))
#define XB_XSUB(j)  (1280 + 64 * (j))
#define XB_XGEN(j)  (2304 + 64 * (j))
#define XB_TOP      3328
#define XB_TOPGEN   3392
#define XCD_BAR_WORDS 3456
#define XB_SPIN_CAP (1u << 22)
__device__ __forceinline__ unsigned xb_ld(unsigned* p)              { return __hip_atomic_load(p, __ATOMIC_RELAXED, __HIP_MEMORY_SCOPE_AGENT); }
__device__ __forceinline__ unsigned xb_add(unsigned* p, unsigned v) { return __hip_atomic_fetch_add(p, v, __ATOMIC_RELAXED, __HIP_MEMORY_SCOPE_AGENT); }
__device__ __forceinline__ unsigned xb_xcc_id() { return (unsigned)__builtin_amdgcn_s_getreg((3 << 11) | 20) & 0xFu; }
#define XB_SPIN(cond, bar) do { unsigned _sp = 0; while (cond) { __builtin_amdgcn_s_sleep(1); \
    if ((++_sp & 255u) == 0u) { if (xb_ld(&(bar)[XB_TMO])) break; if (_sp > XB_SPIN_CAP) { atomicAdd(&(bar)[XB_TMO], 1u); break; } } } } while (0)
struct XcdBarrier { unsigned* bar; unsigned x; volatile LAS unsigned* st; };
__device__ __forceinline__ XcdBarrier xcd_barrier_post(unsigned* bar, volatile LAS unsigned* st) {
    XcdBarrier b; b.bar = bar; b.x = xb_xcc_id(); b.st = st;
    if (threadIdx.x == 0) (void)xb_add(&bar[XB_XCNT(b.x)], 1u);
    return b;
}
__device__ __forceinline__ void xcd_barrier_complete(unsigned* bar, unsigned x, unsigned& nloc, unsigned& nx) {
    const unsigned G = gridDim.x * gridDim.y * gridDim.z;
    unsigned sum, cnt, mine, sp = 0u;
    for (;;) {
        sum = 0u; cnt = 0u; mine = 0u;
#pragma unroll
        for (unsigned j = 0; j < 16; ++j) { const unsigned c = xb_ld(&bar[XB_XCNT(j)]); sum += c; cnt += (c > 0u) ? 1u : 0u; mine = (j == x) ? c : mine; }
        if (sum == G) break;
        __builtin_amdgcn_s_sleep(1);
        if ((++sp & 255u) == 0u) { if (xb_ld(&bar[XB_TMO])) break; if (sp > XB_SPIN_CAP) { atomicAdd(&bar[XB_TMO], 1u); break; } }
    }
    nloc = mine > 0u ? mine : 1u; nx = cnt > 0u ? cnt : 1u;
}
__device__ __forceinline__ void xcd_barrier(const XcdBarrier& b) {
    asm volatile("s_waitcnt vmcnt(0)" ::: "memory");
    __syncthreads();
    if (threadIdx.x == 0) {
        unsigned* bar = b.bar;
        __builtin_amdgcn_s_waitcnt(0);
        unsigned nloc = b.st[0], nx = b.st[1];
        if (nloc == 0u) { xcd_barrier_complete(bar, b.x, nloc, nx); b.st[0] = nloc; b.st[1] = nx; }
        const unsigned old = xb_add(&bar[XB_XSUB(b.x)], 1u);
        const unsigned gen = old / nloc;
        if (old + 1u == (gen + 1u) * nloc) {
            __builtin_amdgcn_fence(__ATOMIC_RELEASE, "agent");
            asm volatile("s_waitcnt vmcnt(0)" ::: "memory");
            const unsigned og = xb_add(&bar[XB_TOP], 1u);
            const unsigned tg = og / nx;
            if (og + 1u == (tg + 1u) * nx) xb_add(&bar[XB_TOPGEN], 1u);
            else XB_SPIN(xb_ld(&bar[XB_TOPGEN]) == tg, bar);
            __builtin_amdgcn_fence(__ATOMIC_ACQUIRE, "agent");
            xb_add(&bar[XB_XGEN(b.x)], 1u);
            asm volatile("s_waitcnt vmcnt(0)" ::: "memory");
        } else {
            XB_SPIN(xb_ld(&bar[XB_XGEN(b.x)]) == gen, bar);
            __builtin_amdgcn_fence(__ATOMIC_ACQUIRE, "agent");
            asm volatile("s_waitcnt vmcnt(0)" ::: "memory");
        }
    }
    __syncthreads();
}

__global__ void __launch_bounds__(NWAVES * 64, 2) mk_fwd(Args args) {
    extern __shared__ __attribute__((aligned(16))) unsigned char lds_raw[];
    Frame F;
    F.lds = (LAS unsigned char*)lds_raw;
#define REFRESH() do { int t_ = threadIdx.x; asm volatile("" : "+v"(t_)); F.tid = t_; F.lane = t_ & 63; F.wave = __builtin_amdgcn_readfirstlane(t_ >> 6); F.gw = blockIdx.x * NWAVES + F.wave; } while (0)
    F.G = gridDim.x; F.ngw = F.G * NWAVES; REFRESH();
    F.out = args.out; F.ws = args.ws;
    const int lo = args.ph_lo, hi = args.ph_hi;
#define IN(k) (lo <= (k) && (k) < hi)
#ifndef USE_CG_SYNC
#define USE_CG_SYNC 0
#endif
    volatile LAS unsigned* bst = (volatile LAS unsigned*)(F.lds + LDS_BYTES - 64);
    if (F.tid < 16) bst[F.tid] = 0u;
    __syncthreads();
    XcdBarrier gbar; gbar.bar = (unsigned*)(F.ws + WS_CTL); gbar.x = 0; gbar.st = bst;
    if (!USE_CG_SYNC && hi - lo > 1) gbar = xcd_barrier_post((unsigned*)(F.ws + WS_CTL), bst);
#define SEAM(k) do { if (IN(k) && IN((k) + 1)) { if (USE_CG_SYNC) cg::this_grid().sync(); else xcd_barrier(gbar); } } while (0)
    unsigned char* ws = F.ws;
    if (IN(0)) { REFRESH(); p0_prologue(F, args); }
    SEAM(0);
    if (IN(1)) { REFRESH();
        pg8::Gemm g{(const bf16*)(ws + WS_XN), (const bf16*)(ws + WS_WIN), S, NPJ, 1024, 1024}; pg8::StaticOrder So; So.init(S, NPJ, F.G, (int)blockIdx.x);
        EpiProj E{(bf16*)(ws + WS_U), (bf16*)(ws + WS_Q), (bf16*)(ws + WS_KVH), (bf16*)(ws + WS_G), (bf16*)(ws + WS_GN)};
        pg8::gemm_phase<EpiProj, pg8::StaticOrder>(F.lds, g, So, E);
    }
    SEAM(1);
    if (IN(2)) { REFRESH();
        for (int u = F.gw; u < 64 * 32; u += F.ngw) s5_unit<false>(F, args, u >> 5, u & 31, F.lds + F.wave * 16384, F.lds + 131072 + F.wave * 2048);
        __syncthreads();
        pg8::Gemm g{(const bf16*)(ws + WS_KVH), (const bf16*)(ws + WS_WC1), 4096, 1024, 1024 / CMP_KS, 1024}; pg8::CmpOrder So{F.G, (int)blockIdx.x, CMP_KS};
        EpiCmp E{F.out};
        pg8::gemm_phase<EpiCmp, pg8::CmpOrder>(F.lds, g, So, E);
    }
    SEAM(2);
    if (IN(3)) { REFRESH();
        for (int u = F.gw; u < 64 * 32; u += F.ngw) s5_unit<true>(F, args, u >> 5, u & 31, F.lds + F.wave * 16384, F.lds + 131072 + F.wave * 2048);
        for (int u0 = 0; u0 < 4 * 1024; u0 += F.ngw) { const int u = u0 + F.gw; const int kvb = (u0 + (int)blockIdx.x * NWAVES) >> 11;
            __syncthreads();
            { const float* w2 = kvb ? args.in[18] : args.in[16]; LAS f32x4* wd = (LAS f32x4*)(F.lds + 8 * 2048); for (int e = F.tid; e < 256 * 64 / 4; e += NWAVES * 64) wd[e] = ((const f32x4*)w2)[e]; }
            __syncthreads();
            if (u < 4 * 1024) { const int kvg = u >> 10, n = u & 1023; cmp_l2_unit(F, args, kvg >> 1, kvg & 1, n, (LAS float*)(F.lds + F.wave * 2048), (const LAS float*)(F.lds + 8 * 2048)); } }
        __syncthreads();
        for (int u = F.gw; u < 2 * 512; u += F.ngw) vtw_item(F, u >> 9, u & 511, (LAS unsigned short*)(F.lds + 81920 + F.wave * 8192));
        for (int u = F.gw; u < 2 * 256; u += F.ngw) vts_item(F, u >> 8, u & 255, (LAS unsigned short*)(F.lds + 81920 + F.wave * 8192));
    }
    SEAM(3);
    if (IN(4)) { REFRESH();
        for (int u = blockIdx.x; u < 256; u += F.G) {
#pragma unroll 1
            for (int g = 0; g < 2; ++g) { const int ta = ((u & 7) << 5) | (u >> 3);
                const int tile = g ? 255 - ta : ta;
                const unsigned soff = (unsigned)__builtin_amdgcn_readfirstlane((int)((blockIdx.x & 127u) * (unsigned)PSLAB));
                attn_tile(F, ws, args.in[19], tile, g, soff); } }
    }
    SEAM(4);
    if (IN(5)) { REFRESH();
        pg8::Gemm g{(const bf16*)(ws + WS_Z), (const bf16*)(ws + WS_WGLU), S, 512, 512, 512}; pg8::StaticOrder So; So.init(S, 512, F.G, (int)blockIdx.x);
        EpiGlu E{(const bf16*)(ws + WS_Z), (bf16*)(ws + WS_ZG)};
        pg8::gemm_phase<EpiGlu, pg8::StaticOrder>(F.lds, g, So, E);
    }
    SEAM(5);
    if (IN(6)) { REFRESH();
        pg8::TwoSegOrder So; So.init(S, 1024, F.G, (int)blockIdx.x);
        pg8::Gemm g{(const bf16*)(ws + WS_ZG), (const bf16*)(ws + WS_WA), S, 1024, 512, 512, (const bf16*)(ws + WS_O), (const bf16*)(ws + WS_WB)}; EpiMix2 E{(const bf16*)(ws + WS_G), (bf16*)(ws + WS_MIX)};
        pg8::gemm_phase<EpiMix2, pg8::TwoSegOrder>(F.lds, g, So, E);
    }
    SEAM(6);
    if (IN(7)) { REFRESH();
        pg8::Gemm g{(const bf16*)(ws + WS_MIX), (const bf16*)(ws + WS_WOUT), S, 1024, 1024, 1024}; pg8::StaticOrder So; So.init(S, 1024, F.G, (int)blockIdx.x);
        EpiResNorm E{args.in[0], F.out, (bf16*)(ws + WS_XN), (float*)(ws + WS_SSP), (LAS float*)(F.lds + pg8::STAGE_BYTES)};
        pg8::gemm_phase<EpiResNorm, pg8::StaticOrder>(F.lds, g, So, E);
    }
    SEAM(7);
    if (IN(9)) { REFRESH();
        pg8::Gemm g{(const bf16*)(ws + WS_XN), (const bf16*)(ws + WS_WGU), S, 2 * DFF, 1024, 1024}; pg8::StaticOrder So; So.init(S, 2 * DFF, F.G, (int)blockIdx.x);
        EpiFfn E{(bf16*)(ws + WS_H), (const float*)(ws + WS_SSP)};
        pg8::gemm_phase<EpiFfn, pg8::StaticOrder>(F.lds, g, So, E);
    }
    SEAM(9);
    if (IN(10)) { REFRESH();
        pg8::Gemm g{(const bf16*)(ws + WS_H), (const bf16*)(ws + WS_WD), S, 1024, DFF, DFF}; pg8::StaticOrder So; So.init(S, 1024, F.G, (int)blockIdx.x);
        EpiRes E{F.out, F.out};
        pg8::gemm_phase<EpiRes, pg8::StaticOrder>(F.lds, g, So, E);
    }
    SEAM(10);
    if (IN(11)) { REFRESH(); for (int m = F.gw; m < S; m += F.ngw) rms_row_f32(F.out + (size_t)m * DM, args.in[26], F.lane); }
#undef IN
#undef SEAM
}

extern "C" void kernel_launch(void* const* d_in, const int* in_sizes, int n_in, void* d_out, int out_size, void* d_ws, size_t ws_size, hipStream_t stream) {
    static int grid = 0;
    if (grid == 0) {
        if (n_in != 27 || out_size != S * DM || ws_size < WS_END) { fprintf(stderr, "kernel_launch: unexpected shapes (n_in %d out %d ws %zu)\n", n_in, out_size, ws_size); grid = -1; return; }
        int dev = 0, cus = 0, per_cu = 0;
        if (hipGetDevice(&dev) != hipSuccess || hipDeviceGetAttribute(&cus, hipDeviceAttributeMultiprocessorCount, dev) != hipSuccess) { grid = -1; return; }
        if (hipFuncSetAttribute((const void*)mk_fwd, hipFuncAttributeMaxDynamicSharedMemorySize, LDS_BYTES) != hipSuccess) { fprintf(stderr, "kernel_launch: hipFuncSetAttribute failed\n"); grid = -1; return; }
        if (hipOccupancyMaxActiveBlocksPerMultiprocessor(&per_cu, (const void*)mk_fwd, NWAVES * 64, LDS_BYTES) != hipSuccess || per_cu < 1) { fprintf(stderr, "kernel_launch: occupancy query says %d\n", per_cu); per_cu = 1; }
        (void)hipGetLastError();
        grid = cus * (per_cu < 1 ? 1 : 1);
    }
    if (grid < 0) return;
    if (hipMemsetAsync((char*)d_ws + WS_CTL, 0, 16384, stream) != hipSuccess) { fprintf(stderr, "kernel_launch: hipMemsetAsync failed\n"); return; }
    Args a{};
    for (int i = 0; i < 27; ++i) a.in[i] = (const float*)d_in[i];
    a.out = (float*)d_out; a.ws = (unsigned char*)d_ws;
    if (MK_N_LAUNCHES == 1) {
        a.ph_lo = 0; a.ph_hi = NPH;
        void* kargs[] = {&a};
        hipError_t e = hipLaunchCooperativeKernel((const void*)mk_fwd, dim3(grid), dim3(NWAVES * 64), kargs, LDS_BYTES, stream);
        if (e != hipSuccess) fprintf(stderr, "kernel_launch: cooperative launch failed: %s (grid %d)\n", hipGetErrorString(e), grid);
    } else {
        for (int ph = 0; ph < NPH; ++ph) { a.ph_lo = ph; a.ph_hi = ph + 1; hipLaunchKernelGGL(mk_fwd, dim3(grid), dim3(NWAVES * 64), LDS_BYTES, stream, a); }
    }
}
```

```cpp
#include <hip/hip_runtime.h>
#include <hip/hip_cooperative_groups.h>
#include <cstdio>
#include <cstdint>
namespace cg = cooperative_groups;

#ifndef MK_N_LAUNCHES
#define MK_N_LAUNCHES 1
#endif

namespace pg8 {
#define PG8_LAS __attribute__((address_space(3)))
typedef unsigned short bf16_t;
typedef short bf16x8 __attribute__((ext_vector_type(8)));
typedef float f32x4 __attribute__((ext_vector_type(4)));
typedef unsigned u32x4 __attribute__((ext_vector_type(4)));
constexpr int BM = 256, BK = 64, HALF = 128, HTB = HALF * BK * 2, STAGE_BYTES = 8 * HTB, NXCD = 8, WGM = 8;

__host__ __device__ __forceinline__ int lds_byte(int r, int c) { const int st = (r >> 4) * 2 + (c >> 5), rr = r & 15, cc = c & 31, ob = rr * 64 + cc * 2; return st * 1024 + (ob ^ (((ob >> 9) & 1) << 5)); }
__host__ __device__ __forceinline__ void stage_rc(int b, int& R, int& C) { const int st = b / 1024, sb = b % 1024, swz = sb ^ (((sb >> 9) & 1) << 5); R = (st >> 1) * 16 + swz / 64; C = (st & 1) * 32 + (swz % 64) / 2; }
__host__ __device__ __forceinline__ int perm32(int rho) { const int n = rho >> 4, i = rho & 15; return 8 * (i >> 2) + 4 * n + (i & 3); }

struct Unit { int pm, pn, ks, seg; };
struct Gemm { const bf16_t* A; const bf16_t* Bt; int M, N, K, ld; const bf16_t* A2; const bf16_t* Bt2; };

struct StaticOrder {
    static constexpr bool SINGLE = false;
    int nM, nN, nwg, G, c;
    __host__ __device__ void init(int M, int N, int G_, int c_) { nM = M / BM; nN = N / BM; nwg = nM * nN; G = G_; c = c_; }
    __host__ __device__ bool next(int i, Unit& u) const {
        const long L = (long)i * G + c; if (L >= nwg) return false;
        int wgid = (int)L; { const int q = nwg / NXCD, r = nwg % NXCD, xcd = wgid % NXCD, off = wgid / NXCD; wgid = (xcd < r ? xcd * (q + 1) : r * (q + 1) + (xcd - r) * q) + off; }
        const int nig = WGM * nN, gid = wgid / nig, fm = gid * WGM, gsz = (nM - fm) < WGM ? (nM - fm) : WGM;
        u.pm = fm + ((wgid % nig) % gsz); u.pn = (wgid % nig) / gsz; u.ks = 0; u.seg = 0; return true;
    }
};
struct TwoSegOrder : StaticOrder {
    __host__ __device__ bool next(int i, Unit& u) const { if (!StaticOrder::next(i >> 1, u)) return false; u.seg = i & 1; return true; }
};
struct CmpOrder {
    static constexpr bool SINGLE = true;
    int G, c, KS;
    __host__ __device__ bool next(int i, Unit& u) const {
        const int L = i * G + c; if (L >= 32 * KS) return false;
        const int tile = L / KS; u.ks = L % KS; u.pm = tile >> 1; u.pn = (tile & 1) + (u.pm >= 8 ? 2 : 0); u.seg = 0; return true;
    }
};

typedef float f32x2_t __attribute__((ext_vector_type(2))); typedef __bf16 bf16x2_t __attribute__((ext_vector_type(2)));
__device__ __forceinline__ unsigned cvt_pk_bf16(float lo, float hi) { f32x2_t v = {lo, hi}; bf16x2_t b = __builtin_convertvector(v, bf16x2_t); return __builtin_bit_cast(unsigned, b); }
__device__ __forceinline__ float bflo(unsigned w) { return __uint_as_float(w << 16); }
__device__ __forceinline__ float bfhi(unsigned w) { return __uint_as_float(w & 0xffff0000u); }
__device__ __forceinline__ float sigm(float x) { return __builtin_amdgcn_rcpf(1.0f + __expf(-x)); }

template <class Epi, class Sched>
__device__ __forceinline__ void gemm_phase(PG8_LAS unsigned char* lds, const Gemm g, const Sched& S, const Epi& E) {
    const int tid = threadIdx.x, wid = __builtin_amdgcn_readfirstlane(tid >> 6), lane = tid & 63, wr = wid >> 2, wc = wid & 3, fr = lane & 15, fq = lane >> 4;
    const int K = g.K, ld = g.ld, nt = K / BK;
    unsigned voffA[2], voffB[2];
#pragma unroll
    for (int i = 0; i < 2; ++i) { int R, C; stage_rc(tid * 16 + i * 8192, R, C); const int Rb = Epi::PERM ? ((R & ~31) + perm32(R & 31)) : R;
        voffA[i] = (unsigned)(R * ld + C) * 2u; voffB[i] = (unsigned)(Rb * ld + C) * 2u; }
    const size_t kstep = (size_t)(BK * 2);
    const size_t hstep = (size_t)HALF * ld * 2;
    const size_t tstep = 2 * hstep;
    const unsigned ldsw = (unsigned)wid * 1024u;
    const int aoff = lds_byte(wr * 64 + fr, fq * 8), boff = lds_byte(wc * 32 + fr, fq * 8);
#define PG8_SA(b, h) (((b) * 2 + (h)) * HTB)
#define PG8_SB(b, h) ((4 + (b) * 2 + (h)) * HTB)
#define PG8_STAGE(bufoff, gbase, voff) do { _Pragma("unroll") for (int _i = 0; _i < 2; ++_i) \
        __builtin_amdgcn_global_load_lds((const unsigned*)((const char*)(gbase) + (voff)[_i]), (PG8_LAS unsigned*)(lds + (bufoff) + ldsw + _i * 8192), 16, 0, 0); } while (0)
#define PG8_LDA(dst, b, h) do { _Pragma("unroll") for (int m = 0; m < 4; ++m) _Pragma("unroll") for (int k = 0; k < 2; ++k) dst[m][k] = *(const PG8_LAS bf16x8*)(lds + PG8_SA(b, h) + aoff + m * 2048 + k * 1024); } while (0)
#define PG8_LDB(dst, b, h) do { _Pragma("unroll") for (int n = 0; n < 2; ++n) _Pragma("unroll") for (int k = 0; k < 2; ++k) dst[n][k] = *(const PG8_LAS bf16x8*)(lds + PG8_SB(b, h) + boff + n * 2048 + k * 1024); } while (0)
#define PG8_MMA(ai, bj, At, Bt) do { __builtin_amdgcn_s_setprio(1); _Pragma("unroll") for (int m = 0; m < 4; ++m) _Pragma("unroll") for (int n = 0; n < 2; ++n) _Pragma("unroll") for (int k = 0; k < 2; ++k) \
        acc[ai][bj][m][n] = __builtin_amdgcn_mfma_f32_16x16x32_bf16(Bt[n][k], At[m][k], acc[ai][bj][m][n], 0, 0, 0); __builtin_amdgcn_s_setprio(0); } while (0)
#define PG8_WAIT_V(n) asm volatile("s_waitcnt vmcnt(" #n ")" ::: "memory")
#define PG8_WAIT_L(n) asm volatile("s_waitcnt lgkmcnt(" #n ")" ::: "memory")
#define PG8_BAR __builtin_amdgcn_s_barrier()
#define PG8_SCHED __builtin_amdgcn_sched_barrier(0)
    Unit cur, nxt; int ui = 0;
    if (!S.next(0, cur)) return;
    f32x4 acc[2][2][4][2];
#pragma unroll
    for (int a = 0; a < 2; ++a)
#pragma unroll
        for (int b = 0; b < 2; ++b)
#pragma unroll
            for (int m = 0; m < 4; ++m)
#pragma unroll
                for (int n = 0; n < 2; ++n) acc[a][b][m][n] = (f32x4){0.f, 0.f, 0.f, 0.f};
    bf16x8 At[4][2], B0[2][2], B1[2][2];
    const char* cA = (const char*)(cur.seg ? g.A2 : g.A) + (size_t)cur.pm * tstep + (size_t)cur.ks * K * 2; const char* cB = (const char*)(cur.seg ? g.Bt2 : g.Bt) + (size_t)cur.pn * tstep + (size_t)cur.ks * K * 2;
    PG8_STAGE(PG8_SB(0, 0), cB, voffB); PG8_STAGE(PG8_SB(0, 1), cB + hstep, voffB); PG8_STAGE(PG8_SA(0, 0), cA, voffA); PG8_STAGE(PG8_SA(0, 1), cA + hstep, voffA);
    if (wr == 1) PG8_BAR;
    PG8_WAIT_V(2); PG8_BAR;
    PG8_STAGE(PG8_SB(1, 0), cB + kstep, voffB); PG8_STAGE(PG8_SA(1, 0), cA + kstep, voffA); PG8_STAGE(PG8_SB(1, 1), cB + hstep + kstep, voffB);
    PG8_WAIT_V(6); PG8_BAR;
    for (;;) {
        const bool has_next = Sched::SINGLE ? false : S.next(ui + 1, nxt);
        const char* nA = has_next ? (const char*)(nxt.seg ? g.A2 : g.A) + (size_t)nxt.pm * tstep + (size_t)nxt.ks * K * 2 : cA; const char* nB = has_next ? (const char*)(nxt.seg ? g.Bt2 : g.Bt) + (size_t)nxt.pn * tstep + (size_t)nxt.ks * K * 2 : cB;
        for (int t = 0; t < nt; t += 2) {
            const bool last = (t == nt - 2);
            const char* a1 = cA + (size_t)(t + 1) * kstep;
            const char* a2 = last ? nA : cA + (size_t)(t + 2) * kstep; const char* b2 = last ? nB : cB + (size_t)(t + 2) * kstep;
            const char* a3 = a2 + kstep; const char* b3 = b2 + kstep;
            PG8_LDB(B0, 0, 0); PG8_LDB(B1, 0, 1); PG8_SCHED; PG8_LDA(At, 0, 0); PG8_STAGE(PG8_SA(1, 1), a1 + hstep, voffA);
            PG8_WAIT_V(8); PG8_WAIT_L(0); PG8_BAR; PG8_MMA(0, 0, At, B0); PG8_MMA(0, 1, At, B1); PG8_BAR; PG8_SCHED;
            PG8_LDA(At, 0, 1); PG8_STAGE(PG8_SB(0, 0), b2, voffB); PG8_STAGE(PG8_SB(0, 1), b2 + hstep, voffB); PG8_STAGE(PG8_SA(0, 0), a2, voffA);
            PG8_WAIT_V(8); PG8_WAIT_L(0); PG8_BAR; PG8_MMA(1, 0, At, B0); PG8_MMA(1, 1, At, B1); PG8_BAR; PG8_SCHED;
            PG8_LDB(B0, 1, 0); PG8_LDB(B1, 1, 1); PG8_SCHED; PG8_LDA(At, 1, 0); PG8_STAGE(PG8_SA(0, 1), a2 + hstep, voffA);
            PG8_WAIT_V(8); PG8_WAIT_L(0); PG8_BAR; PG8_MMA(0, 0, At, B0); PG8_MMA(0, 1, At, B1); PG8_BAR; PG8_SCHED;
            PG8_LDA(At, 1, 1); PG8_STAGE(PG8_SB(1, 0), b3, voffB); PG8_STAGE(PG8_SB(1, 1), b3 + hstep, voffB); PG8_STAGE(PG8_SA(1, 0), a3, voffA);
            PG8_WAIT_V(8); PG8_WAIT_L(0); PG8_BAR; PG8_MMA(1, 0, At, B0); PG8_MMA(1, 1, At, B1); PG8_BAR; PG8_SCHED;
        }
        if (wr == 0) PG8_BAR;
        E(acc, cur, wr, wc, fr, fq);
        if (!has_next) break;
        if (!nxt.seg) {
#pragma unroll
        for (int a = 0; a < 2; ++a)
#pragma unroll
            for (int b = 0; b < 2; ++b)
#pragma unroll
                for (int m = 0; m < 4; ++m)
#pragma unroll
                    for (int n = 0; n < 2; ++n) acc[a][b][m][n] = (f32x4){0.f, 0.f, 0.f, 0.f}; }
        cur = nxt; cA = nA; cB = nB; ++ui;
        if (wr == 1) PG8_BAR;
    }
    PG8_WAIT_V(0);
    PG8_BAR;
#undef PG8_SA
#undef PG8_SB
#undef PG8_STAGE
#undef PG8_LDA
#undef PG8_LDB
#undef PG8_MMA
#undef PG8_WAIT_V
#undef PG8_WAIT_L
#undef PG8_BAR
#undef PG8_SCHED
}
}

constexpr int S = 16384, DM = 1024, INC = 3864, NPJ = 4096, SSW = 512, NSW = 512, HD = 64, DFF = 2816;
constexpr int NGRP = 32, NST = 64, NCMP = 1023;
constexpr int NWAVES = 8;
constexpr int NPH = 12;
constexpr int CMP_KS = 4;
constexpr float EPS = 1e-6f;

constexpr size_t MiB = 1u << 20;
constexpr size_t WS_CTL = 0;
constexpr size_t WS_TAB = 1 * MiB;
constexpr size_t TAB_BF = 0, TAB_CF = 128 * 1024, TAB_LAM = 256 * 1024, TAB_LAM256 = 272 * 1024, TAB_POSB = 288 * 1024;
constexpr size_t WS_SSP = 1 * MiB + 512 * 1024;
constexpr size_t WS_F = 2 * MiB;
constexpr size_t WS_KVC = 3 * MiB;
constexpr size_t WS_WIN = 4 * MiB, WS_WGU = 12 * MiB, WS_WD = 23 * MiB, WS_WOUT = 29 * MiB, WS_WA = 31 * MiB, WS_WB = 32 * MiB, WS_WGLU = 33 * MiB, WS_WC1 = 34 * MiB;
constexpr size_t WS_XN = 36 * MiB;
constexpr size_t WS_Z = WS_XN, WS_ZG = WS_XN + 16 * MiB;
constexpr size_t WS_U = 68 * MiB, WS_O = WS_U;
constexpr size_t WS_Q = 84 * MiB;
constexpr size_t WS_KVH = 100 * MiB;
constexpr size_t WS_G = 124 * MiB;
constexpr size_t WS_GN = 188 * MiB;
constexpr size_t WS_MIX = 84 * MiB;
constexpr size_t WS_H = 100 * MiB;
constexpr size_t WS_VTW = 189 * MiB;
constexpr size_t WS_VTS = 193 * MiB;
constexpr size_t WS_KCB = 197 * MiB;
constexpr size_t WS_VTC = 197 * MiB + 512 * 1024;
constexpr size_t WS_PSLAB = 198 * MiB;
constexpr size_t WS_END = 254 * MiB;

constexpr int LDS_BYTES = 163840;

#define GAS __attribute__((address_space(1)))
#define LAS __attribute__((address_space(3)))
typedef unsigned short bf16;
typedef unsigned v4u __attribute__((ext_vector_type(4)));
typedef float f32x4 __attribute__((ext_vector_type(4)));
typedef float f32x2 __attribute__((ext_vector_type(2)));
typedef float f32x16 __attribute__((ext_vector_type(16)));
typedef short bf16x8 __attribute__((ext_vector_type(8)));
#define LDS_WAIT() asm volatile("s_waitcnt lgkmcnt(0)" ::: "memory")
#define VM_WAIT() asm volatile("s_waitcnt vmcnt(0)" ::: "memory")
__device__ __forceinline__ unsigned f2bf(float f) { unsigned u = __builtin_bit_cast(unsigned, f); return (u + 0x7fffu + ((u >> 16) & 1u)) >> 16; }
__device__ __forceinline__ unsigned pk2(float lo, float hi) { return f2bf(lo) | (f2bf(hi) << 16); }
__device__ __forceinline__ float bf2f(bf16 v) { return __uint_as_float((unsigned)v << 16); }
using pg8::bflo; using pg8::bfhi; using pg8::sigm; using pg8::cvt_pk_bf16;
__device__ __forceinline__ float gelu_tanh(float y) {
    const float a = 0.7978845608028654f * (y + 0.044715f * y * y * y);
    const float e = __expf(2.0f * a);
    const float th = 1.0f - 2.0f * __builtin_amdgcn_rcpf(e + 1.0f);
    return 0.5f * y * (1.0f + th);
}
__device__ __forceinline__ float wave_sum(float v) {
#pragma unroll
    for (int o = 1; o < 64; o <<= 1) v += __shfl_xor(v, o);
    return v;
}
__device__ __forceinline__ float wave_max(float v) {
#pragma unroll
    for (int o = 1; o < 64; o <<= 1) v = fmaxf(v, __shfl_xor(v, o));
    return v;
}

struct Args { const float* in[27]; float* out; unsigned char* ws; int ph_lo, ph_hi; };

struct Frame {
    LAS unsigned char* lds;
    int tid, lane, wave, G, gw, ngw;
    float* out; unsigned char* ws;
};

using pg8::Unit; using pg8::BM; using pg8::HALF;
struct EpiProj {
    static constexpr bool PERM = true;
    bf16 *U, *Q, *KVH, *Gt, *GN;
    __device__ __forceinline__ void operator()(const f32x4 (&acc)[2][2][4][2], const Unit& u, int wr, int wc, int fr, int fq) const {
        const int row0 = u.pm * BM + wr * 64 + fr, pn = u.pn;
#pragma unroll
        for (int ai = 0; ai < 2; ++ai)
#pragma unroll
            for (int m = 0; m < 4; ++m) { const int row = row0 + ai * HALF + m * 16;
#pragma unroll
                for (int bj = 0; bj < 2; ++bj) { f32x4 v0 = acc[ai][bj][m][0], v1 = acc[ai][bj][m][1]; const int col = bj * HALF + wc * 32 + 8 * fq; bf16* dst;
                    if (pn < 2) dst = U + (size_t)row * 512 + pn * 256 + col;
                    else if (pn < 4) { v0 = v0 * (0.125f * 1.4426950408889634f); v1 = v1 * (0.125f * 1.4426950408889634f); dst = Q + (size_t)row * 512 + (pn - 2) * 256 + col; }
                    else if (pn < 7) dst = KVH + ((size_t)((pn - 4) * 4 + (col >> 6)) * S + row) * 64 + (col & 63);
                    else { v0 = (f32x4){sigm(v0[0]), sigm(v0[1]), sigm(v0[2]), sigm(v0[3])}; v1 = (f32x4){sigm(v1[0]), sigm(v1[1]), sigm(v1[2]), sigm(v1[3])};
                        if (pn < 15) dst = Gt + (size_t)row * 2048 + (pn - 7) * 256 + col; else { if (col >= 32) continue; dst = GN + (size_t)row * 32 + col; } }
                    v4u w; w.x = cvt_pk_bf16(v0[0], v0[1]); w.y = cvt_pk_bf16(v0[2], v0[3]); w.z = cvt_pk_bf16(v1[0], v1[1]); w.w = cvt_pk_bf16(v1[2], v1[3]);
                    *(v4u*)dst = w; } }
    }
};
struct EpiCmp {
    static constexpr bool PERM = false;
    float* C;
    __device__ __forceinline__ void operator()(const f32x4 (&acc)[2][2][4][2], const Unit& u, int wr, int wc, int fr, int fq) const {
        const int row0 = u.pm * BM + wr * 64 + fr, col0 = (u.pn & 1) * BM + wc * 32 + 4 * fq; float* base = C + (size_t)u.ks * 4096 * 512;
#pragma unroll
        for (int ai = 0; ai < 2; ++ai)
#pragma unroll
            for (int m = 0; m < 4; ++m) { float* rowp = base + (size_t)(row0 + ai * HALF + m * 16) * 512 + col0;
#pragma unroll
                for (int bj = 0; bj < 2; ++bj)
#pragma unroll
                    for (int n = 0; n < 2; ++n) *(f32x4*)(rowp + bj * HALF + n * 16) = acc[ai][bj][m][n]; }
    }
};
struct EpiGlu {
    static constexpr bool PERM = true;
    const bf16* Z; bf16* ZG;
    __device__ __forceinline__ void operator()(const f32x4 (&acc)[2][2][4][2], const Unit& u, int wr, int wc, int fr, int fq) const {
        const int row0 = u.pm * BM + wr * 64 + fr;
#pragma unroll
        for (int ai = 0; ai < 2; ++ai)
#pragma unroll
            for (int m = 0; m < 4; ++m) { const int row = row0 + ai * HALF + m * 16;
#pragma unroll
                for (int bj = 0; bj < 2; ++bj) { const f32x4 v0 = acc[ai][bj][m][0], v1 = acc[ai][bj][m][1]; const size_t off = (size_t)row * 512 + u.pn * BM + bj * HALF + wc * 32 + 8 * fq;
                    const v4u z = *(const v4u*)(Z + off); v4u w;
                    w.x = cvt_pk_bf16(bflo(z.x) * sigm(v0[0]), bfhi(z.x) * sigm(v0[1])); w.y = cvt_pk_bf16(bflo(z.y) * sigm(v0[2]), bfhi(z.y) * sigm(v0[3]));
                    w.z = cvt_pk_bf16(bflo(z.z) * sigm(v1[0]), bfhi(z.z) * sigm(v1[1])); w.w = cvt_pk_bf16(bflo(z.w) * sigm(v1[2]), bfhi(z.w) * sigm(v1[3]));
                    *(v4u*)(ZG + off) = w; } }
    }
};
struct EpiMix2 {
    static constexpr bool PERM = true;
    const bf16* Gt; bf16* MIX;
    __device__ __forceinline__ void operator()(f32x4 (&acc)[2][2][4][2], const Unit& u, int wr, int wc, int fr, int fq) const {
        const int row0 = u.pm * BM + wr * 64 + fr;
#pragma unroll
        for (int ai = 0; ai < 2; ++ai)
#pragma unroll
            for (int m = 0; m < 4; ++m) { const int row = row0 + ai * HALF + m * 16;
#pragma unroll
                for (int bj = 0; bj < 2; ++bj) { const int col = u.pn * BM + bj * HALF + wc * 32 + 8 * fq;
                    const v4u gb = *(const v4u*)(Gt + (size_t)row * 2048 + 1024 + col);
                    const float b8[8] = {bflo(gb.x), bfhi(gb.x), bflo(gb.y), bfhi(gb.y), bflo(gb.z), bfhi(gb.z), bflo(gb.w), bfhi(gb.w)};
                    if (u.seg == 0) { const v4u ga = *(const v4u*)(Gt + (size_t)row * 2048 + col);
                        const float a8[8] = {bflo(ga.x), bfhi(ga.x), bflo(ga.y), bfhi(ga.y), bflo(ga.z), bfhi(ga.z), bflo(ga.w), bfhi(ga.w)};
#pragma unroll
                        for (int e = 0; e < 4; ++e) { acc[ai][bj][m][0][e] *= a8[e] * __builtin_amdgcn_rcpf(b8[e]); acc[ai][bj][m][1][e] *= a8[4 + e] * __builtin_amdgcn_rcpf(b8[4 + e]); }
                    } else { const f32x4 v0 = acc[ai][bj][m][0], v1 = acc[ai][bj][m][1]; v4u w;
                        w.x = cvt_pk_bf16(v0[0] * b8[0], v0[1] * b8[1]); w.y = cvt_pk_bf16(v0[2] * b8[2], v0[3] * b8[3]); w.z = cvt_pk_bf16(v1[0] * b8[4], v1[1] * b8[5]); w.w = cvt_pk_bf16(v1[2] * b8[6], v1[3] * b8[7]);
                        *(v4u*)(MIX + (size_t)row * 1024 + col) = w; } } }
    }
};
struct EpiRes {
    static constexpr bool PERM = false;
    const float* base; float* out;
    __device__ __forceinline__ void operator()(const f32x4 (&acc)[2][2][4][2], const Unit& u, int wr, int wc, int fr, int fq) const {
        const int row0 = u.pm * BM + wr * 64 + fr, col0 = u.pn * BM + wc * 32 + 4 * fq;
#pragma unroll
        for (int ai = 0; ai < 2; ++ai)
#pragma unroll
            for (int m = 0; m < 4; ++m) { const size_t off = (size_t)(row0 + ai * HALF + m * 16) * 1024 + col0;
#pragma unroll
                for (int bj = 0; bj < 2; ++bj)
#pragma unroll
                    for (int n = 0; n < 2; ++n) { const f32x4 b = *(const f32x4*)(base + off + bj * HALF + n * 16); *(f32x4*)(out + off + bj * HALF + n * 16) = b + acc[ai][bj][m][n]; } }
    }
};
struct EpiResNorm {
    static constexpr bool PERM = false;
    const float* base; float* out; bf16* XN; float* SSP; LAS float* part;
    __device__ __forceinline__ void operator()(const f32x4 (&acc)[2][2][4][2], const Unit& u, int wr, int wc, int fr, int fq) const {
        const int row0 = u.pm * BM + wr * 64 + fr, col0 = u.pn * BM + wc * 32 + 4 * fq;
#pragma unroll
        for (int ai = 0; ai < 2; ++ai)
#pragma unroll
            for (int m = 0; m < 4; ++m) { const size_t off = (size_t)(row0 + ai * HALF + m * 16) * 1024 + col0; float ss = 0.f;
#pragma unroll
                for (int bj = 0; bj < 2; ++bj)
#pragma unroll
                    for (int n = 0; n < 2; ++n) { const f32x4 b = *(const f32x4*)(base + off + bj * HALF + n * 16); const f32x4 x1 = b + acc[ai][bj][m][n]; *(f32x4*)(out + off + bj * HALF + n * 16) = x1;
                        *(unsigned long long*)(XN + off + bj * HALF + n * 16) = (unsigned long long)cvt_pk_bf16(x1[0], x1[1]) | ((unsigned long long)cvt_pk_bf16(x1[2], x1[3]) << 32);
                        ss += (x1[0] * x1[0] + x1[1] * x1[1]) + (x1[2] * x1[2] + x1[3] * x1[3]); }
                ss += __shfl_xor(ss, 16); ss += __shfl_xor(ss, 32);
                if (fq == 0) part[(ai * HALF + wr * 64 + m * 16 + fr) * 4 + wc] = ss; }
        asm volatile("s_waitcnt lgkmcnt(0)" ::: "memory"); __builtin_amdgcn_s_barrier(); asm volatile("" ::: "memory");
        if (threadIdx.x < 256) { const f32x4 p = *(const LAS f32x4*)(part + threadIdx.x * 4); SSP[(size_t)(u.pm * BM + threadIdx.x) * 4 + u.pn] = (p[0] + p[1]) + (p[2] + p[3]); }
    }
};
struct EpiFfn {
    static constexpr bool PERM = true;
    bf16* H; const float* SSP;
    __device__ __forceinline__ void operator()(const f32x4 (&acc)[2][2][4][2], const Unit& u, int wr, int wc, int fr, int fq) const {
        const int row0 = u.pm * BM + wr * 64 + fr;
#pragma unroll
        for (int ai = 0; ai < 2; ++ai)
#pragma unroll
            for (int m = 0; m < 4; ++m) { const int row = row0 + ai * HALF + m * 16;
                const f32x4 sp = *(const f32x4*)(SSP + (size_t)row * 4); const float rs = 1.0f / sqrtf(((sp[0] + sp[1]) + (sp[2] + sp[3])) * (1.f / 1024.f) + 1e-6f);
                float r[8];
#pragma unroll
                for (int n = 0; n < 2; ++n)
#pragma unroll
                    for (int e = 0; e < 4; ++e) { const float gt = acc[ai][0][m][n][e] * rs, up = acc[ai][1][m][n][e] * rs; r[n * 4 + e] = gt * sigm(gt) * up; }
                v4u w; w.x = cvt_pk_bf16(r[0], r[1]); w.y = cvt_pk_bf16(r[2], r[3]); w.z = cvt_pk_bf16(r[4], r[5]); w.w = cvt_pk_bf16(r[6], r[7]);
                *(v4u*)(H + (size_t)row * DFF + u.pn * HALF + wc * 32 + 8 * fq) = w; }
    }
};

struct TrDesc { const float* src; bf16* dst; int ld, ncols, dld, drow, kb, nb; const float* gain; };
__device__ __forceinline__ void tr_load(const TrDesc& d, float (&v)[32], int lane) {
    const int k0 = 64 * d.kb, c = 32 * d.nb + (lane & 31); const bool ok = c < d.ncols; const float* p = d.src + (size_t)(k0 + (lane >> 5)) * d.ld + c;
#pragma unroll
    for (int i = 0; i < 32; ++i) v[i] = ok ? p[(size_t)(2 * i) * d.ld] : 0.f;
    if (d.gain) {
#pragma unroll
        for (int i = 0; i < 32; ++i) v[i] *= d.gain[k0 + 2 * i + (lane >> 5)]; }
}
__device__ __forceinline__ void tr_finish(const TrDesc& d, const float (&v)[32], LAS float* scr, int lane) {
#pragma unroll
    for (int i = 0; i < 32; ++i) scr[(2 * i + (lane >> 5)) * 33 + (lane & 31)] = v[i];
    LDS_WAIT();
    const int cc = lane & 7, k0 = 64 * d.kb;
#pragma unroll
    for (int j = 0; j < 4; ++j) { const int n = (lane >> 3) + 8 * j; const LAS float* s = scr + (8 * cc) * 33 + n;
        v4u o; o.x = pk2(s[0 * 33], s[1 * 33]); o.y = pk2(s[2 * 33], s[3 * 33]); o.z = pk2(s[4 * 33], s[5 * 33]); o.w = pk2(s[6 * 33], s[7 * 33]);
        *(v4u*)(d.dst + (size_t)(d.drow + n) * d.dld + k0 + 8 * cc) = o; }
    LDS_WAIT();
}
__device__ __forceinline__ void rms_row_to_bf16(const float* xrow, const float* gain, bf16* orow, int lane) {
    const f32x4* xr = (const f32x4*)xrow + lane; const f32x4* gr = (const f32x4*)gain + lane;
    f32x4 v[4]; float s = 0.f;
#pragma unroll
    for (int j = 0; j < 4; ++j) { v[j] = xr[64 * j]; s += (v[j].x * v[j].x + v[j].y * v[j].y) + (v[j].z * v[j].z + v[j].w * v[j].w); }
    const float rstd = 1.0f / sqrtf(wave_sum(s) * (1.f / DM) + EPS);
    unsigned long long* o8 = (unsigned long long*)orow + lane;
#pragma unroll
    for (int j = 0; j < 4; ++j) { const f32x4 gq = gr[64 * j];
        o8[64 * j] = (unsigned long long)pk2(v[j].x * rstd * gq.x, v[j].y * rstd * gq.y) | ((unsigned long long)pk2(v[j].z * rstd * gq.z, v[j].w * rstd * gq.w) << 32); }
}
__device__ __forceinline__ void rms_rows2_to_bf16(const float* x0, const float* x1, const float* gain, bf16* o0, bf16* o1, int lane) {
    const f32x4* xa = (const f32x4*)x0 + lane; const f32x4* xb = (const f32x4*)x1 + lane; const f32x4* gr = (const f32x4*)gain + lane;
    f32x4 va[4], vb[4]; float sa = 0.f, sb = 0.f;
#pragma unroll
    for (int j = 0; j < 4; ++j) { va[j] = xa[64 * j]; vb[j] = xb[64 * j]; }
#pragma unroll
    for (int j = 0; j < 4; ++j) { sa += (va[j].x * va[j].x + va[j].y * va[j].y) + (va[j].z * va[j].z + va[j].w * va[j].w); sb += (vb[j].x * vb[j].x + vb[j].y * vb[j].y) + (vb[j].z * vb[j].z + vb[j].w * vb[j].w); }
    const float ra = 1.0f / sqrtf(wave_sum(sa) * (1.f / DM) + EPS), rb = 1.0f / sqrtf(wave_sum(sb) * (1.f / DM) + EPS);
    unsigned long long* pa = (unsigned long long*)o0 + lane; unsigned long long* pb = (unsigned long long*)o1 + lane;
#pragma unroll
    for (int j = 0; j < 4; ++j) { const f32x4 gq = gr[64 * j];
        pa[64 * j] = (unsigned long long)pk2(va[j].x * ra * gq.x, va[j].y * ra * gq.y) | ((unsigned long long)pk2(va[j].z * ra * gq.z, va[j].w * ra * gq.w) << 32);
        pb[64 * j] = (unsigned long long)pk2(vb[j].x * rb * gq.x, vb[j].y * rb * gq.y) | ((unsigned long long)pk2(vb[j].z * rb * gq.z, vb[j].w * rb * gq.w) << 32); }
}
__device__ __forceinline__ void rms_row_f32(float* xrow, const float* gain, int lane) {
    f32x4* xr = (f32x4*)xrow + lane; const f32x4* gr = (const f32x4*)gain + lane;
    f32x4 v[4]; float s = 0.f;
#pragma unroll
    for (int j = 0; j < 4; ++j) { v[j] = xr[64 * j]; s += (v[j].x * v[j].x + v[j].y * v[j].y) + (v[j].z * v[j].z + v[j].w * v[j].w); }
    const float rstd = 1.0f / sqrtf(wave_sum(s) * (1.f / DM) + EPS);
#pragma unroll
    for (int j = 0; j < 4; ++j) { const f32x4 gq = gr[64 * j]; xr[64 * j] = v[j] * rstd * gq; }
}
__device__ __forceinline__ void s5_tables(const Frame& F, const Args& args, int g) {
    const int lane = F.lane;
    const float* are = args.in[3]; const float* aim = args.in[4]; const float* ldt = args.in[5]; const float* bre = args.in[6]; const float* bim = args.in[7]; const float* cre = args.in[8]; const float* cim = args.in[9];
    const double dt = exp((double)ldt[g]);
    {   const int p = lane; const double ar = are[g * 64 + p], ai = aim[g * 64 + p];
        const double er = exp(ar * dt), lr = er * cos(ai * dt), li = er * sin(ai * dt);
        ((f32x2*)(F.ws + WS_TAB + TAB_LAM))[g * 64 + p] = (f32x2){(float)lr, (float)li};
        const double e2 = exp(ar * dt * 256.0), l2r = e2 * cos(ai * dt * 256.0), l2i = e2 * sin(ai * dt * 256.0);
        ((f32x2*)(F.ws + WS_TAB + TAB_LAM256))[g * 64 + p] = (f32x2){(float)l2r, (float)l2i}; }
#pragma unroll
    for (int nt = 0; nt < 4; ++nt) { const int col = 32 * nt + (lane & 31), p = col >> 1, ri = col & 1;
        const double ar = are[g * 64 + p], ai = aim[g * 64 + p];
        const double er = exp(ar * dt), lr = er * cos(ai * dt) - 1.0, li = er * sin(ai * dt);
        const double den = ar * ar + ai * ai, kr = (lr * ar + li * ai) / den, ki = (li * ar - lr * ai) / den;
        float v[8];
#pragma unroll
        for (int j = 0; j < 8; ++j) { const int c = 8 * (lane >> 5) + j; const double br = bre[(g * 64 + p) * 16 + c], bi = bim[(g * 64 + p) * 16 + c];
            v[j] = (float)(ri ? (kr * bi + ki * br) : (kr * br - ki * bi)); }
        v4u o; o.x = pk2(v[0], v[1]); o.y = pk2(v[2], v[3]); o.z = pk2(v[4], v[5]); o.w = pk2(v[6], v[7]);
        ((v4u*)(F.ws + WS_TAB + TAB_BF))[(g * 4 + nt) * 64 + lane] = o; }
#pragma unroll
    for (int ks = 0; ks < 4; ++ks) { const int ch = lane & 15; float v[8];
#pragma unroll
        for (int j = 0; j < 8; ++j) { const int k = 32 * ks + 8 * (lane >> 4) + j, p = k >> 1, ri = k & 1; v[j] = ri ? -cim[(g * 16 + ch) * 64 + p] : cre[(g * 16 + ch) * 64 + p]; }
        v4u o; o.x = pk2(v[0], v[1]); o.y = pk2(v[2], v[3]); o.z = pk2(v[4], v[5]); o.w = pk2(v[6], v[7]);
        ((v4u*)(F.ws + WS_TAB + TAB_CF))[(g * 4 + ks) * 64 + lane] = o; }
}
__device__ __forceinline__ void p0_prologue(const Frame& F, const Args& args) {
    LAS float* scr = (LAS float*)(F.lds + F.wave * 16384);
    const int gw = F.gw, NGW = F.ngw, lane = F.lane;
    if (F.wave == 0 && blockIdx.x < 32) s5_tables(F, args, (int)blockIdx.x);
    else if (F.wave == 1 && blockIdx.x < 128) {
        const int it = (int)blockIdx.x, kv = it >> 6, part = (it >> 2) & 15, cgp = it & 3;
        const float* pos = kv ? args.in[14] : args.in[13]; const float* w1 = kv ? args.in[17] : args.in[15]; float a = 0.f;
#pragma unroll 1
        for (int r0 = 128 * part; r0 < 128 * part + 128; r0 += 32) { float wv[32];
#pragma unroll
            for (int i = 0; i < 32; ++i) wv[i] = w1[(size_t)(r0 + i) * 256 + cgp * 64 + lane];
#pragma unroll
            for (int i = 0; i < 32; ++i) a += pos[r0 + i] * wv[i]; }
        ((float*)(F.ws + WS_TAB + TAB_POSB))[(kv * 16 + part) * 256 + cgp * 64 + lane] = a;
    }
    { v4u* z = (v4u*)(F.ws + WS_WIN + (size_t)3872 * 1024 * 2); const int n16 = 224 * 1024 * 2 / 16;
      for (int i = blockIdx.x * 512 + F.tid; i < n16; i += F.G * 512) z[i] = (v4u){0u, 0u, 0u, 0u}; }
    bf16* WIN = (bf16*)(F.ws + WS_WIN); bf16* WGU = (bf16*)(F.ws + WS_WGU); bf16* WD = (bf16*)(F.ws + WS_WD); bf16* WOUT = (bf16*)(F.ws + WS_WOUT);
    bf16* WA = (bf16*)(F.ws + WS_WA); bf16* WB = (bf16*)(F.ws + WS_WB); bf16* WGLU = (bf16*)(F.ws + WS_WGLU); bf16* WC1 = (bf16*)(F.ws + WS_WC1);
    constexpr int I1 = 16 * 56, I2 = 16 * 64, I3 = 16, IGLU = 8 * 16, IUP = 8 * 32, IOUT = 16 * 32, IFF = 16 * 88, IDN = 44 * 32, ICM = 16 * 8;
    constexpr int NITEMS = I1 + I2 + I3 + IGLU + 2 * IUP + IOUT + 2 * IFF + IDN + 4 * ICM;
    auto desc = [&](int it) -> TrDesc {
        int r = it;
        if (r < I1) return TrDesc{args.in[2], WIN, INC, 1792, 1024, 32 * (r % 56), r / 56, r % 56, nullptr}; r -= I1;
        if (r < I2) return TrDesc{args.in[2] + 1816, WIN, INC, 2048, 1024, 1792 + 32 * (r % 64), r / 64, r % 64, nullptr}; r -= I2;
        if (r < I3) return TrDesc{args.in[2] + 1792, WIN, INC, 24, 1024, 3840, r, 0, nullptr}; r -= I3;
        if (r < IGLU) return TrDesc{args.in[11], WGLU, 512, 512, 512, 32 * (r % 16), r / 16, r % 16, nullptr}; r -= IGLU;
        if (r < IUP) return TrDesc{args.in[12], WA, 1024, 1024, 512, 32 * (r % 32), r / 32, r % 32, nullptr}; r -= IUP;
        if (r < IUP) return TrDesc{args.in[20], WB, 1024, 1024, 512, 32 * (r % 32), r / 32, r % 32, nullptr}; r -= IUP;
        if (r < IOUT) return TrDesc{args.in[21], WOUT, 1024, 1024, 1024, 32 * (r % 32), r / 32, r % 32, nullptr}; r -= IOUT;
        if (r < IFF) { const int nb = r % 88; return TrDesc{args.in[23], WGU, DFF, DFF, 1024, (nb >> 2) * 256 + (nb & 3) * 32, r / 88, nb, args.in[22]}; } r -= IFF;
        if (r < IFF) { const int nb = r % 88; return TrDesc{args.in[24], WGU, DFF, DFF, 1024, (nb >> 2) * 256 + (nb & 3) * 32 + 128, r / 88, nb, args.in[22]}; } r -= IFF;
        if (r < IDN) return TrDesc{args.in[25], WD, 1024, 1024, DFF, 32 * (r % 32), r / 32, r % 32, nullptr}; r -= IDN;
        const int q = r / ICM, rr = r % ICM;
        return TrDesc{((q >> 1) ? args.in[17] : args.in[15]) + (size_t)(q & 1) * 1024 * 256, WC1, 256, 256, 1024, q * 256 + 32 * (rr % 8), rr / 8, rr % 8, nullptr};
    };
    if (gw < NITEMS) {
        TrDesc dc = desc(gw); float vc[32]; tr_load(dc, vc, lane);
#pragma unroll 1
        for (int it = gw; it < NITEMS; it += NGW) {
            const bool more = it + NGW < NITEMS; TrDesc dn = desc(more ? it + NGW : it); float vn[32]; tr_load(dn, vn, lane);
            tr_finish(dc, vc, scr, lane);
            dc = dn;
#pragma unroll
            for (int i = 0; i < 32; ++i) vc[i] = vn[i];
        }
    }
    bf16* XN = (bf16*)(F.ws + WS_XN);
    for (int m = gw; m < S; m += 2 * NGW) rms_rows2_to_bf16(args.in[0] + (size_t)m * DM, args.in[0] + (size_t)(m + NGW) * DM, args.in[1], XN + (size_t)m * DM, XN + (size_t)(m + NGW) * DM, lane);
}

__device__ __forceinline__ int crow(int r, int hi) { return (r & 3) + 8 * (r >> 2) + 4 * hi; }
template <bool FINAL>
__device__ __forceinline__ void s5_unit(const Frame& F, const Args& args, int c, int g, LAS unsigned char* wl, LAS unsigned char* wx) {
    const int lane = F.lane, hi = lane >> 5;
    const bf16* U = (const bf16*)(F.ws + WS_U); bf16* Z = (bf16*)(F.ws + WS_Z);
    bf16x8 bfg[4], cfg[4], ua[8];
#pragma unroll
    for (int sub = 0; sub < 8; ++sub) ua[sub] = *(const bf16x8*)(U + (size_t)(c * 256 + sub * 32 + (lane & 31)) * 512 + g * 16 + 8 * hi);
#pragma unroll
    for (int nt = 0; nt < 4; ++nt) bfg[nt] = ((const bf16x8*)(F.ws + WS_TAB + TAB_BF))[(g * 4 + nt) * 64 + lane];
    const f32x2 lam = ((const f32x2*)(F.ws + WS_TAB + TAB_LAM))[g * 64 + lane];
    f32x2* Fst = (f32x2*)(F.ws + WS_F);
    float xr = 0.f, xi = 0.f, dsk = 0.f;
    if (FINAL) {
#pragma unroll
        for (int ks = 0; ks < 4; ++ks) cfg[ks] = ((const bf16x8*)(F.ws + WS_TAB + TAB_CF))[(g * 4 + ks) * 64 + lane];
        dsk = args.in[10][g * 16 + (lane & 15)];
        const f32x2 L2 = ((const f32x2*)(F.ws + WS_TAB + TAB_LAM256))[g * 64 + lane];
        for (int cp = 0; cp < c; ++cp) { const f32x2 f = Fst[(cp * 32 + g) * 64 + lane]; const float nr = L2.x * xr - L2.y * xi + f.x, ni = L2.x * xi + L2.y * xr + f.y; xr = nr; xi = ni; }
    }
#pragma unroll
    for (int sub = 0; sub < 8; ++sub) {
        const int t0 = c * 256 + sub * 32;
        const bf16x8 a = ua[sub];
        if (FINAL) *(LAS bf16x8*)(wx + (lane & 31) * 32 + hi * 16) = a;
#pragma unroll
        for (int nt = 0; nt < 4; ++nt) { f32x16 acc = {}; acc = __builtin_amdgcn_mfma_f32_32x32x16_bf16(a, bfg[nt], acc, 0, 0, 0);
#pragma unroll
            for (int r = 0; r < 16; ++r) ((LAS float*)wl)[crow(r, hi) * 128 + 32 * nt + (lane & 31)] = acc[r]; }
        LDS_WAIT();
        f32x2 bu[32];
#pragma unroll
        for (int tk = 0; tk < 32; ++tk) bu[tk] = ((const LAS f32x2*)wl)[tk * 64 + lane];
        LDS_WAIT();
#pragma unroll
        for (int tk = 0; tk < 32; ++tk) { const float nr = lam.x * xr - lam.y * xi + bu[tk].x, ni = lam.x * xi + lam.y * xr + bu[tk].y; xr = nr; xi = ni;
            if (FINAL) ((LAS unsigned*)wl)[tk * 128 + ((lane + 4 * tk) & 63)] = pk2(xr, xi); }
        if (FINAL) {
            LDS_WAIT();
            LAS unsigned short* zt = (LAS unsigned short*)(wx + 1024);
#pragma unroll
            for (int mt = 0; mt < 2; ++mt) { f32x4 y4 = {0.f, 0.f, 0.f, 0.f}; const int row = 16 * mt + (lane & 15);
#pragma unroll
                for (int ks = 0; ks < 4; ++ks) { const bf16x8 xa = *(const LAS bf16x8*)(wl + row * 512 + ((64 * ks + 16 * (lane >> 4) + 16 * row) & 255)); y4 = __builtin_amdgcn_mfma_f32_16x16x32_bf16(xa, cfg[ks], y4, 0, 0, 0); }
#pragma unroll
                for (int r = 0; r < 4; ++r) { const int tok = 16 * mt + 4 * (lane >> 4) + r; const float uu = bf2f(((const LAS unsigned short*)wx)[tok * 16 + (lane & 15)]);
                    zt[tok * 16 + (lane & 15)] = (unsigned short)f2bf(gelu_tanh(y4[r] + dsk * uu)); } }
            LDS_WAIT();
            *(v4u*)(Z + (size_t)(t0 + (lane >> 1)) * 512 + g * 16 + 8 * (lane & 1)) = *(const LAS v4u*)(wx + 1024 + lane * 16);
            LDS_WAIT();
        }
    }
    if (!FINAL) Fst[(c * 32 + g) * 64 + lane] = (f32x2){xr, xi};
}

__device__ __forceinline__ int krow(int s, int h, int j) { return 16 * s + 8 * (j >> 2) + 4 * h + (j & 3); }
__device__ __forceinline__ void cmp_l2_unit(const Frame& F, const Args& args, int kv, int g, int n, LAS float* hb, const LAS float* w2s) {
    const int lane = F.lane; const float* P1 = F.out;
    float o = 0.f;
    if (n < NCMP) {
        const int rt = kv * 2048 + g * 1024 + n;
        const float* posb = (const float*)(F.ws + WS_TAB + TAB_POSB) + kv * 16 * 256;
#pragma unroll
        for (int i = 0; i < 4; ++i) { const int j = lane + 64 * i; float a = 0.f;
#pragma unroll
            for (int ks = 0; ks < CMP_KS; ++ks) a += P1[((size_t)ks * 4096 + rt) * 512 + j] + P1[((size_t)ks * 4096 + rt + 1) * 512 + 256 + j];
#pragma unroll
            for (int p = 0; p < 16; ++p) a += posb[p * 256 + j];
            hb[j] = gelu_tanh(a); }
        LDS_WAIT();
#pragma unroll 8
        for (int j = 0; j < 256; ++j) o += hb[j] * w2s[j * 64 + lane];
    }
    if (kv == 0) ((bf16*)(F.ws + WS_KCB))[((size_t)g * 1024 + n) * 64 + lane] = (bf16)f2bf(o);
    else { const int grp = n >> 5, kk = n & 31, sx = kk >> 4, rem = kk & 15, hh = (rem >> 2) & 1, j = ((rem >> 3) << 2) | (rem & 3), d0 = lane >> 5, ln = hh * 32 + (lane & 31);
        ((bf16*)(F.ws + WS_VTC))[((((size_t)(g * 32 + grp) * 2 + d0) * 2 + sx) * 64 + ln) * 8 + j] = (bf16)f2bf(o); }
    LDS_WAIT();
}
__device__ __forceinline__ void vtw_item(const Frame& F, int g, int grp, LAS unsigned short* tl) {
    const int lane = F.lane, hi = lane >> 5; const bf16* V = (const bf16*)(F.ws + WS_KVH) + (size_t)(10 + g) * S * 64 + (size_t)32 * grp * 64;
#pragma unroll
    for (int e = 0; e < 4; ++e) ((LAS v4u*)tl)[lane + 64 * e] = ((const v4u*)V)[lane + 64 * e];
    LDS_WAIT();
#pragma unroll
    for (int d0 = 0; d0 < 2; ++d0)
#pragma unroll
        for (int sx = 0; sx < 2; ++sx) { unsigned w[4];
#pragma unroll
            for (int jj = 0; jj < 4; ++jj) { const unsigned a = tl[krow(sx, hi, 2 * jj) * 64 + 32 * d0 + (lane & 31)], b = tl[krow(sx, hi, 2 * jj + 1) * 64 + 32 * d0 + (lane & 31)]; w[jj] = a | (b << 16); }
            ((v4u*)(F.ws + WS_VTW))[(((size_t)(g * 512 + grp) * 2 + d0) * 2 + sx) * 64 + lane] = (v4u){w[0], w[1], w[2], w[3]}; }
    LDS_WAIT();
}
__device__ __forceinline__ int kap(int ks, int q, int j) { return 16 * (2 * ks + (j >> 2)) + 4 * q + (j & 3); }
__device__ __forceinline__ void vts_item(const Frame& F, int g, int blk, LAS unsigned short* tl) {
    const int lane = F.lane, q = lane >> 4; const bf16* V = (const bf16*)(F.ws + WS_KVH) + (size_t)(6 + g) * S * 64 + (size_t)64 * blk * 64;
#pragma unroll
    for (int e = 0; e < 8; ++e) ((LAS v4u*)tl)[lane + 64 * e] = ((const v4u*)V)[lane + 64 * e];
    LDS_WAIT();
#pragma unroll
    for (int dt = 0; dt < 4; ++dt)
#pragma unroll
        for (int ks = 0; ks < 2; ++ks) { unsigned w[4];
#pragma unroll
            for (int jj = 0; jj < 4; ++jj) { const unsigned a = tl[kap(ks, q, 2 * jj) * 64 + 16 * dt + (lane & 15)], b = tl[kap(ks, q, 2 * jj + 1) * 64 + 16 * dt + (lane & 15)]; w[jj] = a | (b << 16); }
            ((v4u*)(F.ws + WS_VTS))[(((size_t)(g * 256 + blk) * 4 + dt) * 2 + ks) * 64 + lane] = (v4u){w[0], w[1], w[2], w[3]}; }
    LDS_WAIT();
}

constexpr int AT_SC = 0;
constexpr int AT_SEL = 67584;
constexpr int AT_CNT = AT_SEL + 4096;
constexpr int AT_LIST = AT_CNT + 1024;
constexpr int AT_BT = AT_LIST + 32768;
constexpr int AT_PARK = AT_BT + 4096;
constexpr int AT_TILE = AT_PARK + 32768;
constexpr int AT_END = AT_TILE + 16384;
static_assert(AT_END <= LDS_BYTES - 64, "attention LDS map");
constexpr int PSLOTS = 832, PSLAB = 458752;
constexpr int PML_OFF = PSLOTS * 512;
constexpr int SCS = 264;
constexpr int XRN = 624;

__device__ __forceinline__ bf16x8 pack8(float a0, float a1, float a2, float a3, float a4, float a5, float a6, float a7) {
    v4u w; w.x = cvt_pk_bf16(a0, a1); w.y = cvt_pk_bf16(a2, a3); w.z = cvt_pk_bf16(a4, a5); w.w = cvt_pk_bf16(a6, a7); return __builtin_bit_cast(bf16x8, w);
}
__device__ __forceinline__ float xmax32(float v) { auto r = __builtin_amdgcn_permlane32_swap(__float_as_uint(v), __float_as_uint(v), false, false); return fmaxf(__uint_as_float(r[0]), __uint_as_float(r[1])); }
__device__ __forceinline__ float xsum32(float v) { auto r = __builtin_amdgcn_permlane32_swap(__float_as_uint(v), __float_as_uint(v), false, false); return __uint_as_float(r[0]) + __uint_as_float(r[1]); }
__device__ __forceinline__ float xmax16(float v) { auto r = __builtin_amdgcn_permlane16_swap(__float_as_uint(v), __float_as_uint(v), false, false); return fmaxf(__uint_as_float(r[0]), __uint_as_float(r[1])); }
__device__ __forceinline__ float xsum16(float v) { auto r = __builtin_amdgcn_permlane16_swap(__float_as_uint(v), __float_as_uint(v), false, false); return __uint_as_float(r[0]) + __uint_as_float(r[1]); }
__device__ __forceinline__ float max16(const f32x16& a) {
    const float m0 = fmaxf(fmaxf(a[0], a[1]), fmaxf(a[2], a[3])), m1 = fmaxf(fmaxf(a[4], a[5]), fmaxf(a[6], a[7])), m2 = fmaxf(fmaxf(a[8], a[9]), fmaxf(a[10], a[11])), m3 = fmaxf(fmaxf(a[12], a[13]), fmaxf(a[14], a[15]));
    return fmaxf(fmaxf(m0, m1), fmaxf(m2, m3)); }
__device__ __forceinline__ float sum16(const f32x16& a) {
    const float s0 = (a[0] + a[1]) + (a[2] + a[3]), s1 = (a[4] + a[5]) + (a[6] + a[7]), s2 = (a[8] + a[9]) + (a[10] + a[11]), s3 = (a[12] + a[13]) + (a[14] + a[15]);
    return (s0 + s1) + (s2 + s3); }
__device__ __forceinline__ int fenc(float f) { int k = __float_as_int(f); return k ^ ((k >> 31) & 0x7fffffff); }
__device__ __forceinline__ float fdec(int k) { return __int_as_float(k ^ ((k >> 31) & 0x7fffffff)); }
#define MFMA32(a, b, c) __builtin_amdgcn_mfma_f32_32x32x16_bf16((a), (b), (c), 0, 0, 0)
#define MFMA16(a, b, c) __builtin_amdgcn_mfma_f32_16x16x32_bf16((a), (b), (c), 0, 0, 0)
#define DPPI(x, ctrl) __builtin_amdgcn_update_dpp(0, (x), (ctrl), 0xF, 0xF, false)

struct AttnPtrs { const bf16* Q; const bf16* KCB; const bf16x8* VTC; const bf16* KW; const bf16x8* VTW; const bf16* KS; const bf16x8* VTS; const bf16* GN; bf16* O; };

__device__ __forceinline__ void attn_stageA(const AttnPtrs& P, int lane, int wave, int tile0, int g, LAS unsigned char* lds) {
    const int hi = lane >> 5, c32 = lane & 31, ti = c32 >> 2, hr = c32 & 3, h = g * 4 + hr, t0 = tile0 + 8 * wave, t = t0 + ti;
    LAS float* scores = (LAS float*)(lds + AT_SC) + (8 * wave) * SCS; const LAS float* BT = (const LAS float*)(lds + AT_BT); LAS int* sel = (LAS int*)(lds + AT_SEL) + (8 * wave) * 16;
    for (int k = lane; k < 8 * SCS / 4; k += 64) ((LAS f32x4*)scores)[k] = (f32x4){0.f, 0.f, 0.f, 0.f};
    bf16x8 bq[4];
#pragma unroll
    for (int ks = 0; ks < 4; ++ks) bq[ks] = *(const bf16x8*)(P.Q + (size_t)t * 512 + h * 64 + 16 * ks + 8 * hi);
    const float cb = BT[hr * 256 + 64];
    const float g0 = bf2f(P.GN[(size_t)t * 32 + h * 3 + 0]), g2 = bf2f(P.GN[(size_t)t * 32 + h * 3 + 2]);
    {   LAS float* XR = (LAS float*)(lds + AT_LIST);
        for (int i = wave * 64 + lane; i < 4 * XRN; i += NWAVES * 64) { const int hh = i / XRN, d = 575 - (i - hh * XRN); XR[i] = (d < 0 || d >= 512) ? -1e30f : BT[hh * 256 + 191 - min(d, 127)]; } }
    LDS_WAIT();
    const int tid = wave * 64 + lane; LAS unsigned char* tb = lds + AT_TILE;
    const int ldrow = tid >> 3, ldch = tid & 7; const unsigned stoff = (tid < 256) ? (unsigned)(ldrow * 128 + ((ldch ^ (ldrow & 7)) << 4)) : (unsigned)(8192 + (tid - 256) * 16);
    const unsigned kof = (unsigned)(c32 * 128), ksw = (unsigned)(c32 & 7);
#define KFRAG(buf, ks) (*(const LAS bf16x8*)(tb + (buf) * 4096 + kof + ((((ks) * 2 + hi) ^ ksw) << 4)))
#define VFRAG(buf, f) (*(const LAS bf16x8*)(tb + 8192 + (buf) * 4096 + ((f) * 64 + lane) * 16))
#define STAGE_LOAD(Kp, kmax, VTp, gmax, n0v) ((tid < 256) ? *(const v4u*)((Kp) + (size_t)min((n0v) + ldrow, (kmax)) * 64 + ldch * 8) : *(const v4u*)((VTp) + (size_t)min((n0v) >> 5, (gmax)) * 256 + (tid - 256)))
#define STAGE_WRITE(v, buf) (*(LAS v4u*)(tb + (buf) * 4096 + stoff) = (v))
#define FRAG_WAIT(fr) asm volatile("s_waitcnt lgkmcnt(0)" : "+v"(fr[0]), "+v"(fr[1]), "+v"(fr[2]), "+v"(fr[3]) :: "memory")
#define KLOAD(kfr, buf) bf16x8 kfr[4]; { _Pragma("unroll") for (int ks = 0; ks < 4; ++ks) kfr[ks] = KFRAG(buf, ks); FRAG_WAIT(kfr); }
#define VLOAD(vfr, buf) bf16x8 vfr[4]; { _Pragma("unroll") for (int f = 0; f < 4; ++f) vfr[f] = VFRAG(buf, f); }
#define PVACC(o0v, o1v, vfr, a) do { const bf16x8 p0_ = pack8(a[0], a[1], a[2], a[3], a[4], a[5], a[6], a[7]), p1_ = pack8(a[8], a[9], a[10], a[11], a[12], a[13], a[14], a[15]); FRAG_WAIT(vfr); \
        o0v = MFMA32(vfr[0], p0_, o0v); o0v = MFMA32(vfr[1], p1_, o0v); o1v = MFMA32(vfr[2], p0_, o1v); o1v = MFMA32(vfr[3], p1_, o1v); } while (0)
    constexpr float SM_THR = 8.0f;
#define REF_EVENT(a, mref, started, d, fs) { const float tm_ = xmax32(max16(a)); const bool need_ = started ? (tm_ > SM_THR) : (tm_ > -1e29f); d = 0.f; fs = 1.f; \
        if (__any(need_)) { d = need_ ? tm_ : 0.f; fs = (need_ && started) ? __builtin_amdgcn_exp2f(-d) : 1.f; mref += d; started = started || need_; _Pragma("unroll") for (int r = 0; r < 16; ++r) a[r] -= d; } }
    const int ncb = (tile0 + 63 >= 31) ? min((tile0 + 63 - 31) / 16 + 1, NCMP) : 0, ntc = (ncb + 31) >> 5;
    const int nfar = (t0 >= 144) ? (t0 - 144) / 16 + 1 : 0;
#define CSCORE(a, buf, n0v, farv, refv) do { KLOAD(kfr_, buf) { const float ini_ = ((farv) ? cb : 0.f) - (refv); _Pragma("unroll") for (int r = 0; r < 16; ++r) a[r] = ini_; } \
        _Pragma("unroll") for (int ks = 0; ks < 4; ++ks) a = MFMA32(kfr_[ks], bq[ks], a); \
        if (!(farv)) { _Pragma("unroll") for (int r = 0; r < 16; ++r) { const int dist = t - (16 * ((n0v) + crow(r, hi)) + 31); a[r] += BT[hr * 256 + 191 - max(min(dist, 127), -1)]; } } } while (0)
#define STAGE_PROLOGUE(Kp, kmax, VTp, gmax, nbase, ntl) v4u RA, RB; { RA = STAGE_LOAD(Kp, kmax, VTp, gmax, nbase); STAGE_WRITE(RA, 0); RB = STAGE_LOAD(Kp, kmax, VTp, gmax, (nbase) + 32 * min(1, (ntl) - 1)); __syncthreads(); }
    float mc = 0.f, lc = 0.f; bool stc = false;
    if (ntc > 0) {
        STAGE_PROLOGUE(P.KCB, 1023, P.VTC, 31, 0, ntc)
#define C1STEP(iv, BUF, RL, RW) { const int i = (iv); if (i >= ntc) break; const int n0 = 32 * i; RL = STAGE_LOAD(P.KCB, 1023, P.VTC, 31, 32 * min(i + 2, ntc - 1)); \
            const bool far = (n0 + 32 <= nfar); f32x16 a; CSCORE(a, BUF, n0, far, mc); \
            float d_, fs_; REF_EVENT(a, mc, stc, d_, fs_) lc *= fs_; \
            _Pragma("unroll") for (int r = 0; r < 16; ++r) a[r] = __builtin_amdgcn_exp2f(a[r]); \
            lc += xsum32(sum16(a)); STAGE_WRITE(RW, (BUF) ^ 1); __syncthreads(); }
        for (int ib = 0; ; ib += 2) { C1STEP(ib, 0, RA, RB) C1STEP(ib + 1, 1, RB, RA) }
#undef C1STEP
    }
    {   const float invl = 1.0f / fmaxf(lc, 1e-30f); f32x16 oc0 = {}, oc1 = {}; float carry = 0.f;
#define CIMP(a, n0v) do { float mq[4], cq[4]; \
            _Pragma("unroll") for (int qg = 0; qg < 4; ++qg) { float mv = (2.0f * (a[4 * qg] + a[4 * qg + 1] + a[4 * qg + 2]) + a[4 * qg + 3]) * invl, cv = a[4 * qg + 3] * invl; \
                mv += __int_as_float(DPPI(__float_as_int(mv), 0xB1)); mv += __int_as_float(DPPI(__float_as_int(mv), 0x4E)); \
                cv += __int_as_float(DPPI(__float_as_int(cv), 0xB1)); cv += __int_as_float(DPPI(__float_as_int(cv), 0x4E)); mq[qg] = mv; cq[qg] = cv; } \
            float oth[4]; \
            _Pragma("unroll") for (int qg = 0; qg < 4; ++qg) { auto rr = __builtin_amdgcn_permlane32_swap(__float_as_uint(cq[qg]), __float_as_uint(cq[qg]), false, false); oth[qg] = __uint_as_float(hi ? rr[0] : rr[1]); } \
            _Pragma("unroll") for (int qg = 0; qg < 4; ++qg) { const float tot = mq[qg] + (hi ? oth[qg] : (qg ? oth[qg - 1] : carry)); if (hr == 0) scores[ti * SCS + (((n0v) + 8 * qg + 4 * hi) >> 2)] = tot; } \
            carry = oth[3]; } while (0)
        if (ntc > 0) {
            STAGE_PROLOGUE(P.KCB, 1023, P.VTC, 31, 0, ntc)
#define C2STEP(iv, BUF, RL, RW) { const int i = (iv); if (i >= ntc) break; const int n0 = 32 * i; RL = STAGE_LOAD(P.KCB, 1023, P.VTC, 31, 32 * min(i + 2, ntc - 1)); \
                const bool far = (n0 + 32 <= nfar); f32x16 a; CSCORE(a, BUF, n0, far, mc); VLOAD(vfr_, BUF) \
                _Pragma("unroll") for (int r = 0; r < 16; ++r) a[r] = __builtin_amdgcn_exp2f(a[r]); \
                CIMP(a, n0); PVACC(oc0, oc1, vfr_, a); STAGE_WRITE(RW, (BUF) ^ 1); __syncthreads(); }
            for (int ib = 0; ; ib += 2) { C2STEP(ib, 0, RA, RB) C2STEP(ib + 1, 1, RB, RA) }
#undef C2STEP
            { const int jn = ntc * 8; if (jn < 256 && hi == 0 && hr == 0) scores[ti * SCS + jn] = carry; }
        }
#undef CIMP
        {   LAS unsigned char* park = lds + AT_PARK + (((8 * wave + ti) * 4 + hr) * 64) * 2;
            const float gs = g0 * invl;
#pragma unroll
            for (int d0 = 0; d0 < 2; ++d0)
#pragma unroll
                for (int r4 = 0; r4 < 4; ++r4) { const f32x16& Wd = d0 ? oc1 : oc0; const int dim = 32 * d0 + 8 * r4 + 4 * hi;
                    *(LAS unsigned long long*)(park + dim * 2) = (unsigned long long)cvt_pk_bf16(Wd[4 * r4] * gs, Wd[4 * r4 + 1] * gs) | ((unsigned long long)cvt_pk_bf16(Wd[4 * r4 + 2] * gs, Wd[4 * r4 + 3] * gs) << 32); } } }
#undef CSCORE
    {   float mw = 0.f, lw = 0.f; bool stw = false; f32x16 o0 = {}, o1 = {};
        const int nlo = max(t0 - 511, 0) & ~31, nhi = (t0 + 7) & ~31;
        const int nlb = max(tile0 - 511, 0) & ~31, ntw = (((tile0 + 63) & ~31) - nlb) / 32 + 1;
        const LAS float* xrb = (const LAS float*)(lds + AT_LIST) + hr * XRN + (575 - ti + 4 * hi);
        STAGE_PROLOGUE(P.KW, S - 1, P.VTW, 511, nlb, ntw)
#define WSTEP(iv, BUF, RL, RW) { const int i = (iv); if (i >= ntw) break; const int n0 = nlb + 32 * i; RL = STAGE_LOAD(P.KW, S - 1, P.VTW, 511, nlb + 32 * min(i + 2, ntw - 1)); \
            if (n0 >= nlo && n0 <= nhi) { const bool mid = (n0 >= t0 - 504) && (n0 <= t0 - 144); \
                f32x16 a; if (mid) { const float ini_ = cb - mw; _Pragma("unroll") for (int r = 0; r < 16; ++r) a[r] = ini_; } \
                else { const LAS float* xr_ = xrb + (n0 - t0); _Pragma("unroll") for (int r = 0; r < 16; ++r) a[r] = xr_[(r & 3) + 8 * (r >> 2)] - mw; } \
                { KLOAD(kfr_, BUF) _Pragma("unroll") for (int ks = 0; ks < 4; ++ks) a = MFMA32(kfr_[ks], bq[ks], a); } VLOAD(vfr_, BUF) \
                float d_, fs_; REF_EVENT(a, mw, stw, d_, fs_) if (fs_ != 1.f || d_ != 0.f) { lw *= fs_; o0 = o0 * fs_; o1 = o1 * fs_; } \
                _Pragma("unroll") for (int r = 0; r < 16; ++r) a[r] = __builtin_amdgcn_exp2f(a[r]); \
                lw += xsum32(sum16(a)); PVACC(o0, o1, vfr_, a); } \
            STAGE_WRITE(RW, (BUF) ^ 1); __syncthreads(); }
        for (int ib = 0; ; ib += 2) { WSTEP(ib, 0, RA, RB) WSTEP(ib + 1, 1, RB, RA) }
#undef WSTEP
        const float sc = g2 / fmaxf(lw, 1e-30f);
        LAS unsigned char* park = lds + AT_PARK + (((8 * wave + ti) * 4 + hr) * 64) * 2;
#pragma unroll
        for (int d0 = 0; d0 < 2; ++d0)
#pragma unroll
            for (int r4 = 0; r4 < 4; ++r4) { const f32x16& Od = d0 ? o1 : o0; const int dim = 32 * d0 + 8 * r4 + 4 * hi; const unsigned long long w = *(const LAS unsigned long long*)(park + dim * 2); const unsigned lo = (unsigned)w, hw = (unsigned)(w >> 32);
                *(LAS unsigned long long*)(park + dim * 2) = (unsigned long long)cvt_pk_bf16(bflo(lo) + Od[4 * r4] * sc, bfhi(lo) + Od[4 * r4 + 1] * sc) | ((unsigned long long)cvt_pk_bf16(bflo(hw) + Od[4 * r4 + 2] * sc, bfhi(hw) + Od[4 * r4 + 3] * sc) << 32); } }
#undef REF_EVENT
#undef STAGE_PROLOGUE
#undef PVACC
#undef KLOAD
#undef FRAG_WAIT
#undef VLOAD
#undef KFRAG
#undef VFRAG
#undef STAGE_LOAD
#undef STAGE_WRITE
    LDS_WAIT();
    {   const int cur = tile0 >> 6, i = lane >> 3, s8 = lane & 7;
        if (cur + 1 <= 16) { for (int e = lane; e < 8 * 16; e += 64) sel[e] = e & 15; }
        else {
            float sv[32];
#pragma unroll
            for (int k = 0; k < 32; ++k) { const int j = s8 + 8 * k; sv[k] = (j >= 1 && j <= cur - 2) ? scores[i * SCS + j] : -3e38f; }
            if (s8 == 0) { sel[i * 16 + 0] = 0; sel[i * 16 + 1] = cur - 1; sel[i * 16 + 2] = cur; }
            for (int it = 3; it < 16; ++it) {
                float bv = sv[0]; int bj = s8;
#pragma unroll
                for (int k = 1; k < 32; ++k) if (sv[k] > bv) { bv = sv[k]; bj = s8 + 8 * k; }
#define SEL_STEP(ctrl) { const float ov = __int_as_float(DPPI(__float_as_int(bv), ctrl)); const int oj = DPPI(bj, ctrl); if (ov > bv || (ov == bv && oj < bj)) { bv = ov; bj = oj; } }
                SEL_STEP(0xB1) SEL_STEP(0x4E) SEL_STEP(0x141)
#undef SEL_STEP
                if (s8 == 0) sel[i * 16 + it] = bj;
#pragma unroll
                for (int k = 0; k < 32; ++k) if (bj == s8 + 8 * k) sv[k] = -3e38f;
            }
        }
    }
}

__device__ __forceinline__ void s_scores(const bf16x8 (&kf)[8], const bf16x8 q0, const bf16x8 q1, bool cst, float cbs, const LAS float* BT, int hd, int tt, int j, int q, float sub, f32x4 (&sa)[4]) {
    if (cst) {
#pragma unroll
        for (int mt = 0; mt < 4; ++mt) { const float ini = cbs - sub; sa[mt] = (f32x4){ini, ini, ini, ini}; } }
    else { const LAS float* xb = BT + hd * 256 + (191 - tt + 64 * j + 4 * q);
#pragma unroll
        for (int mt = 0; mt < 4; ++mt)
#pragma unroll
            for (int r = 0; r < 4; ++r) sa[mt][r] = xb[16 * mt + r] - sub; }
#pragma unroll
    for (int mt = 0; mt < 4; ++mt) { sa[mt] = MFMA16(kf[mt * 2], q0, sa[mt]); sa[mt] = MFMA16(kf[mt * 2 + 1], q1, sa[mt]); }
}
template <bool MASKED> __device__ __forceinline__ void s_softmax(f32x4 (&sa)[4], float& tm, float& ls) {
    tm = sa[0][0];
#pragma unroll
    for (int mt = 0; mt < 4; ++mt)
#pragma unroll
        for (int r = 0; r < 4; ++r) tm = fmaxf(tm, sa[mt][r]);
    tm = xmax32(xmax16(tm)); ls = 0.f;
#pragma unroll
    for (int mt = 0; mt < 4; ++mt)
#pragma unroll
        for (int r = 0; r < 4; ++r) { const float e = __builtin_amdgcn_exp2f(sa[mt][r] - tm); sa[mt][r] = (!MASKED || sa[mt][r] > -1e29f) ? e : 0.f; ls += sa[mt][r]; }
    ls = xsum32(xsum16(ls));
}
__device__ __forceinline__ void load_kf(const AttnPtrs& P, int lane, int j, bf16x8 (&kf)[8]) {
    const bf16* kp = P.KS + (size_t)(64 * j + (lane & 15)) * 64 + 8 * (lane >> 4);
#pragma unroll
    for (int mt = 0; mt < 4; ++mt) { kf[mt * 2] = *(const bf16x8*)(kp + (size_t)mt * 16 * 64); kf[mt * 2 + 1] = *(const bf16x8*)(kp + (size_t)mt * 16 * 64 + 32); }
}
__device__ __forceinline__ void load_vf(const AttnPtrs& P, int lane, int j, bf16x8 (&vf)[8]) {
    const bf16x8* vt = P.VTS + (size_t)j * 8 * 64 + lane;
#pragma unroll
    for (int e = 0; e < 8; ++e) vf[e] = vt[e * 64];
}
__device__ __forceinline__ void s_chunk(const bf16x8 (&kf)[8], const bf16x8 (&vf)[8], int j, int ch, int n, bool cst, float cbs, const LAS float* BT, const LAS unsigned short* list,
                                        const LAS unsigned char* qt, unsigned char* slab, int tile0, int c, int q, int hd, int hs) {
    const int sidx = 4 * ch + (c >> 2); const bool valid = sidx < n; const int sl = (int)list[j * 64 + (valid ? sidx : 0)]; const int tokl = sl / 13, r = tokl * 4 + hd;
    const LAS unsigned char* qr = qt + r * 128; const bf16x8 q0 = *(const LAS bf16x8*)(qr + ((q ^ (r & 7)) << 4)), q1 = *(const LAS bf16x8*)(qr + (((q + 4) ^ (r & 7)) << 4));
    float tm = ((const LAS float*)(qt + 65536))[r], ls; f32x4 sa[4]; bool second = false;
#pragma unroll 1
    for (;;) {
        s_scores(kf, q0, q1, cst, cbs, BT, hd, tile0 + tokl, j, q, tm, sa);
        if (second) { float mx = sa[0][0];
#pragma unroll
            for (int mt = 0; mt < 4; ++mt)
#pragma unroll
                for (int r4 = 0; r4 < 4; ++r4) mx = fmaxf(mx, sa[mt][r4]);
            mx = xmax32(xmax16(mx)); tm += mx;
#pragma unroll
            for (int mt = 0; mt < 4; ++mt)
#pragma unroll
                for (int r4 = 0; r4 < 4; ++r4) sa[mt][r4] -= mx; }
        ls = 0.f;
#pragma unroll
        for (int mt = 0; mt < 4; ++mt)
#pragma unroll
            for (int r4 = 0; r4 < 4; ++r4) { sa[mt][r4] = __builtin_amdgcn_exp2f(sa[mt][r4]); ls += sa[mt][r4]; }
        ls = xsum32(xsum16(ls));
        if (second || !__any(!(ls < 1e30f))) break;
        second = true; }
    const bf16x8 p0 = pack8(sa[0][0], sa[0][1], sa[0][2], sa[0][3], sa[1][0], sa[1][1], sa[1][2], sa[1][3]), p1 = pack8(sa[2][0], sa[2][1], sa[2][2], sa[2][3], sa[3][0], sa[3][1], sa[3][2], sa[3][3]);
    unsigned char* po = slab + ((size_t)(sl * 4 + hd) * 64 + 16 * q) * 2;
    unsigned pw[8];
#pragma unroll
    for (int dt = 0; dt < 4; ++dt) { f32x4 oa = {0.f, 0.f, 0.f, 0.f}; oa = MFMA16(vf[dt * 2], p0, oa); oa = MFMA16(vf[dt * 2 + 1], p1, oa); pw[2 * dt] = cvt_pk_bf16(oa[0], oa[1]); pw[2 * dt + 1] = cvt_pk_bf16(oa[2], oa[3]); }
    if (valid) { *(v4u*)po = (v4u){pw[0], pw[1], pw[2], pw[3]}; *(v4u*)(po + 16) = (v4u){pw[4], pw[5], pw[6], pw[7]}; }
    if (valid && q == 0) *(f32x2*)(slab + PML_OFF + (size_t)(sl * 4 + hd) * 8) = (f32x2){tm, ls};
}
__device__ __forceinline__ void attn_stageB(const AttnPtrs& P, int lane, int wave, int tile0, int g, LAS unsigned char* lds, unsigned char* slab) {
    const int T = tile0 >> 6, c = lane & 15, q = lane >> 4, hd = c & 3, hs = g * 4 + hd;
    if (T <= 15) return;
    LAS unsigned* cnt = (LAS unsigned*)(lds + AT_CNT); const LAS unsigned short* list = (const LAS unsigned short*)(lds + AT_LIST); const LAS float* BT = (const LAS float*)(lds + AT_BT);
    const LAS unsigned char* qt = lds + AT_SC;
    const float cbs = BT[hd * 256 + 64];
#define GRAB_ISSUE(tv) { tv = 0; if (lane == 0) tv = (int)__hip_atomic_fetch_add(&cnt[0], 1u, __ATOMIC_RELAXED, __HIP_MEMORY_SCOPE_WORKGROUP); }
#define GRAB_TAKE(tv, jv, nv) { jv = (int)__builtin_amdgcn_readfirstlane(tv) + 1; nv = 0; if (jv <= T - 2) nv = (int)__builtin_amdgcn_readfirstlane((int)cnt[jv]); }
    bf16x8 KA[8], VA[8], KB[8], VB[8];
    int jc, nc, jn, nn;
    { int t0_, t1_; GRAB_ISSUE(t0_) GRAB_ISSUE(t1_) GRAB_TAKE(t0_, jc, nc) if (jc > T - 2) return; GRAB_TAKE(t1_, jn, nn) }
    load_kf(P, lane, jc, KA); load_vf(P, lane, jc, VA);
    load_kf(P, lane, min(jn, T - 2), KB); load_vf(P, lane, min(jn, T - 2), VB);
#define BSTEP(KX, VX) { int t2_; GRAB_ISSUE(t2_) \
        { const bool cst = (jc <= T - 3);        \
          if (nc > 0) s_chunk(KX, VX, jc, 0, nc, cst, cbs, BT, list, qt, slab, tile0, c, q, hd, hs); \
          if (nc > 4) s_chunk(KX, VX, jc, 1, nc, cst, cbs, BT, list, qt, slab, tile0, c, q, hd, hs); \
          if (nc > 8) { _Pragma("unroll 1") for (int ch = 2; 4 * ch < nc; ++ch) s_chunk(KX, VX, jc, ch, nc, cst, cbs, BT, list, qt, slab, tile0, c, q, hd, hs); } } \
        int j2_, n2_; GRAB_TAKE(t2_, j2_, n2_) \
        load_kf(P, lane, min(j2_, T - 2), KX); load_vf(P, lane, min(j2_, T - 2), VX); \
        jc = jn; nc = nn; jn = j2_; nn = n2_; }
    do { BSTEP(KA, VA) BSTEP(KB, VB) } while (jc <= T - 2);
#undef BSTEP
#undef GRAB_ISSUE
#undef GRAB_TAKE
}
struct SState { float M, L; f32x4 O[4]; };
__device__ __forceinline__ void s_merge(SState& st, float m, float l, const f32x4 (&o)[4]) {
    const float mn = fmaxf(st.M, m), a0 = __builtin_amdgcn_exp2f(st.M - mn), a1 = __builtin_amdgcn_exp2f(m - mn);
    st.L = st.L * a0 + l * a1; st.M = mn;
#pragma unroll
    for (int dt = 0; dt < 4; ++dt) st.O[dt] = st.O[dt] * a0 + o[dt] * a1;
}
__device__ __forceinline__ void attn_stageC_forced(const AttnPtrs& P, int lane, int wave, int tile0, int g, LAS unsigned char* lds, SState (&st)[2]) {
    const int T = tile0 >> 6, c = lane & 15, q = lane >> 4, hd = c & 3, hs = g * 4 + hd; const LAS float* BT = (const LAS float*)(lds + AT_BT); const float cbs = BT[hd * 256 + 64];
    bf16x8 q0[2], q1[2];
#pragma unroll
    for (int k = 0; k < 2; ++k) { const int tt = tile0 + 8 * wave + 4 * k + (c >> 2); q0[k] = *(const bf16x8*)(P.Q + (size_t)tt * 512 + hs * 64 + 8 * q); q1[k] = *(const bf16x8*)(P.Q + (size_t)tt * 512 + hs * 64 + 32 + 8 * q);
        st[k].M = -1e30f; st[k].L = 0.f;
#pragma unroll
        for (int dt = 0; dt < 4; ++dt) st[k].O[dt] = (f32x4){0.f, 0.f, 0.f, 0.f}; }
    const int nf = T <= 15 ? T + 1 : 3;
    auto fblk = [&](int it) -> int { return T <= 15 ? it : (it == 0 ? 0 : (it == 1 ? T - 1 : T)); };
    bf16x8 kf[8], vf[8]; load_kf(P, lane, fblk(0), kf); load_vf(P, lane, fblk(0), vf);
#pragma unroll 1
    for (int it = 0; it < nf; ++it) { const int j = fblk(it);
        bf16x8 kn[8]; load_kf(P, lane, fblk(min(it + 1, nf - 1)), kn);
        const bool cst = (j <= T - 3);
#pragma unroll
        for (int k = 0; k < 2; ++k) { const int tt = tile0 + 8 * wave + 4 * k + (c >> 2);
            f32x4 sa[4]; s_scores(kf, q0[k], q1[k], cst, cbs, BT, hd, tt, j, q, 0.f, sa);
            float tm, ls; s_softmax<true>(sa, tm, ls);
            const bf16x8 p0 = pack8(sa[0][0], sa[0][1], sa[0][2], sa[0][3], sa[1][0], sa[1][1], sa[1][2], sa[1][3]), p1 = pack8(sa[2][0], sa[2][1], sa[2][2], sa[2][3], sa[3][0], sa[3][1], sa[3][2], sa[3][3]);
            f32x4 ob[4];
#pragma unroll
            for (int dt = 0; dt < 4; ++dt) { ob[dt] = (f32x4){0.f, 0.f, 0.f, 0.f}; ob[dt] = MFMA16(vf[dt * 2], p0, ob[dt]); ob[dt] = MFMA16(vf[dt * 2 + 1], p1, ob[dt]); }
            s_merge(st[k], tm, ls, ob); }
#pragma unroll
        for (int e = 0; e < 8; ++e) kf[e] = kn[e];
        if (it + 1 < nf) load_vf(P, lane, fblk(it + 1), vf);
    }
}
__device__ __forceinline__ void attn_stageC_forced_lds(const AttnPtrs& P, int lane, int wave, int tile0, int g, LAS unsigned char* lds, SState (&st)[2]) {
    const int T = tile0 >> 6, c = lane & 15, q = lane >> 4, hd = c & 3, hs = g * 4 + hd; const LAS float* BT = (const LAS float*)(lds + AT_BT); const float cbs = BT[hd * 256 + 64];
    bf16x8 q0[2], q1[2];
#pragma unroll
    for (int k = 0; k < 2; ++k) { const int r = (8 * wave + 4 * k + (c >> 2)) * 4 + hd; const LAS unsigned char* qr = lds + AT_SC + r * 128;
        q0[k] = *(const LAS bf16x8*)(qr + ((q ^ (r & 7)) << 4)); q1[k] = *(const LAS bf16x8*)(qr + (((q + 4) ^ (r & 7)) << 4));
        st[k].M = -1e30f; st[k].L = 0.f;
#pragma unroll
        for (int dt = 0; dt < 4; ++dt) st[k].O[dt] = (f32x4){0.f, 0.f, 0.f, 0.f}; }
#pragma unroll
    for (int it = 0; it < 3; ++it) { const int j = it == 0 ? 0 : (it == 1 ? T - 1 : T); const LAS unsigned char* fb = lds + (it == 2 ? AT_TILE : AT_SC + 32768 + 16384 * it);
        bf16x8 kf[8], vf[8];
#pragma unroll
        for (int mt = 0; mt < 4; ++mt) { const int row = 16 * mt + c; kf[mt * 2] = *(const LAS bf16x8*)(fb + row * 128 + ((q ^ (row & 7)) << 4)); kf[mt * 2 + 1] = *(const LAS bf16x8*)(fb + row * 128 + (((q + 4) ^ (row & 7)) << 4)); }
#pragma unroll
        for (int e = 0; e < 8; ++e) vf[e] = *(const LAS bf16x8*)(fb + 8192 + (e * 64 + lane) * 16);
        const bool cst = (it == 0);
#pragma unroll
        for (int k = 0; k < 2; ++k) { const int tt = tile0 + 8 * wave + 4 * k + (c >> 2);
            f32x4 sa[4]; s_scores(kf, q0[k], q1[k], cst, cbs, BT, hd, tt, j, q, 0.f, sa);
            float tm, ls; s_softmax<true>(sa, tm, ls);
            const bf16x8 p0 = pack8(sa[0][0], sa[0][1], sa[0][2], sa[0][3], sa[1][0], sa[1][1], sa[1][2], sa[1][3]), p1 = pack8(sa[2][0], sa[2][1], sa[2][2], sa[2][3], sa[3][0], sa[3][1], sa[3][2], sa[3][3]);
            f32x4 ob[4];
#pragma unroll
            for (int dt = 0; dt < 4; ++dt) { ob[dt] = (f32x4){0.f, 0.f, 0.f, 0.f}; ob[dt] = MFMA16(vf[dt * 2], p0, ob[dt]); ob[dt] = MFMA16(vf[dt * 2 + 1], p1, ob[dt]); }
            s_merge(st[k], tm, ls, ob); } }
}
__device__ __forceinline__ void attn_stageC_merge(const AttnPtrs& P, int lane, int wave, int tile0, int g, LAS unsigned char* lds, const unsigned char* slab, SState (&st)[2]) {
    const int T = tile0 >> 6, c = lane & 15, q = lane >> 4, hd = c & 3, hs = g * 4 + hd;
#pragma unroll
    for (int k = 0; k < 2; ++k) { const int tok = 8 * wave + 4 * k + (c >> 2), tt = tile0 + tok;
        if (T > 15) {
#pragma unroll
            for (int b0 = 0; b0 < 13; b0 += 13) {
                f32x2 mlv[13]; v4u ow[13][2];
#pragma unroll
                for (int bb = 0; bb < 13; ++bb) if (b0 + bb < 13) { const int sl = tok * 13 + b0 + bb;
                    mlv[bb] = *(const f32x2*)(slab + PML_OFF + (size_t)(sl * 4 + hd) * 8);
                    const unsigned char* po = slab + ((size_t)(sl * 4 + hd) * 64 + 16 * q) * 2; ow[bb][0] = *(const v4u*)po; ow[bb][1] = *(const v4u*)(po + 16); }
#pragma unroll
                for (int bb = 0; bb < 13; ++bb) if (b0 + bb < 13) { f32x4 ob[4];
                    ob[0] = (f32x4){bflo(ow[bb][0].x), bfhi(ow[bb][0].x), bflo(ow[bb][0].y), bfhi(ow[bb][0].y)}; ob[1] = (f32x4){bflo(ow[bb][0].z), bfhi(ow[bb][0].z), bflo(ow[bb][0].w), bfhi(ow[bb][0].w)};
                    ob[2] = (f32x4){bflo(ow[bb][1].x), bfhi(ow[bb][1].x), bflo(ow[bb][1].y), bfhi(ow[bb][1].y)}; ob[3] = (f32x4){bflo(ow[bb][1].z), bfhi(ow[bb][1].z), bflo(ow[bb][1].w), bfhi(ow[bb][1].w)};
                    s_merge(st[k], mlv[bb].x, mlv[bb].y, ob); } } }
        const float g1 = bf2f(P.GN[(size_t)tt * 32 + hs * 3 + 1]) / fmaxf(st[k].L, 1e-30f);
        LAS unsigned char* park = lds + AT_PARK + ((tok * 4 + hd) * 64 + 4 * q) * 2;
#pragma unroll
        for (int dt = 0; dt < 4; ++dt) { const unsigned long long w = *(const LAS unsigned long long*)(park + dt * 32); const unsigned lo = (unsigned)w, hw = (unsigned)(w >> 32);
            const unsigned o0 = cvt_pk_bf16(bflo(lo) + g1 * st[k].O[dt][0], bfhi(lo) + g1 * st[k].O[dt][1]), o1 = cvt_pk_bf16(bflo(hw) + g1 * st[k].O[dt][2], bfhi(hw) + g1 * st[k].O[dt][3]);
            *(LAS unsigned long long*)(park + dt * 32) = (unsigned long long)o0 | ((unsigned long long)o1 << 32); } }
    LDS_WAIT();
#pragma unroll
    for (int e = 0; e < 4; ++e) { const int idx = lane + 64 * e, tokl = idx >> 5, piece = idx & 31;
        *(v4u*)((unsigned char*)P.O + (size_t)(tile0 + 8 * wave + tokl) * 1024 + g * 512 + piece * 16) = *(const LAS v4u*)(lds + AT_PARK + (8 * wave + tokl) * 512 + piece * 16); }
    LDS_WAIT();
}
__device__ __forceinline__ void attn_tile(const Frame& F, unsigned char* ws, const float* pbias, int tile, int g, unsigned soff) {
    int lane = F.lane; asm volatile("" : "+v"(lane));
    const int wave = F.wave, tile0 = tile * 64, T = tile; LAS unsigned char* lds = F.lds;
    if (F.tid < 256) ((LAS unsigned*)(lds + AT_CNT))[F.tid] = 0u;
    {   LAS float* BT = (LAS float*)(lds + AT_BT);
        for (int i = F.tid; i < 4 * 256; i += NWAVES * 64) { const int hh = i >> 8, d = 191 - (i & 255); float v = -1e30f;
            if (d >= 0) { const int dd = min(d, 127); int bk = dd; if (dd >= 16) { bk = 16 + (int)(logf((float)dd * (1.0f / 16.0f)) / 2.0794415416798357f * 16.0f); if (bk > 31) bk = 31; }
                v = pbias[bk * 8 + g * 4 + hh] * 1.4426950408889634f; }
            BT[i] = v; } }
    __syncthreads();
    AttnPtrs P;
    {   const bf16* KVH = (const bf16*)(ws + WS_KVH);
        P.Q = (const bf16*)(ws + WS_Q); P.KCB = (const bf16*)(ws + WS_KCB) + (size_t)g * 1024 * 64; P.VTC = (const bf16x8*)(ws + WS_VTC) + (size_t)g * 32 * 4 * 64;
        P.KW = KVH + (size_t)(8 + g) * S * 64; P.VTW = (const bf16x8*)(ws + WS_VTW) + (size_t)g * 512 * 4 * 64; P.GN = (const bf16*)(ws + WS_GN);
        P.KS = nullptr; P.VTS = nullptr; P.O = nullptr; }
    attn_stageA(P, lane, wave, tile0, g, lds);
    __syncthreads();
    unsigned char* ws2 = ws;
    {   const bf16* KVH = (const bf16*)(ws2 + WS_KVH);
        P.Q = (const bf16*)(ws2 + WS_Q); P.KS = KVH + (size_t)(4 + g) * S * 64; P.VTS = (const bf16x8*)(ws2 + WS_VTS) + (size_t)g * 256 * 8 * 64; P.GN = (const bf16*)(ws2 + WS_GN); P.O = (bf16*)(ws2 + WS_O);
        P.KCB = nullptr; P.VTC = nullptr; P.KW = nullptr; P.VTW = nullptr; }
    unsigned char* slab = ((blockIdx.x < 128) ? (unsigned char*)F.out : ws2 + WS_PSLAB) + soff;
    if (T > 15) {
        LAS unsigned* cnt = (LAS unsigned*)(lds + AT_CNT); LAS unsigned short* list = (LAS unsigned short*)(lds + AT_LIST); const LAS int* sel = (const LAS int*)(lds + AT_SEL);
        const int tok = F.tid >> 3;
        v4u qv[4];
#pragma unroll
        for (int e = 0; e < 4; ++e) { const int idx = F.tid + 512 * e, row = idx >> 3, piece = idx & 7; qv[e] = *(const v4u*)((const unsigned char*)P.Q + (size_t)(tile0 + (row >> 2)) * 1024 + g * 512 + (row & 3) * 128 + piece * 16); }
#pragma unroll
        for (int e = 0; e < 2; ++e) { const int b = (F.tid & 7) * 2 + e;
            if (b >= 3) { const int j = sel[tok * 16 + b]; const unsigned pos = __hip_atomic_fetch_add(&cnt[j], 1u, __ATOMIC_RELAXED, __HIP_MEMORY_SCOPE_WORKGROUP); list[j * 64 + pos] = (unsigned short)(tok * 13 + b - 3); } }
#pragma unroll
        for (int e = 0; e < 4; ++e) { const int idx = F.tid + 512 * e, row = idx >> 3, piece = idx & 7; *(LAS v4u*)(lds + AT_SC + row * 128 + ((piece ^ (row & 7)) << 4)) = qv[e]; }
        {   v4u fk[3], fv[3];
#pragma unroll
            for (int e = 0; e < 3; ++e) { const int j = e == 0 ? 0 : (e == 1 ? T - 1 : T); fk[e] = *(const v4u*)((const unsigned char*)P.KS + (size_t)j * 8192 + F.tid * 16); fv[e] = *(const v4u*)((const unsigned char*)P.VTS + (size_t)j * 8192 + F.tid * 16); }
            const int row = F.tid >> 3, piece = F.tid & 7;
#pragma unroll
            for (int e = 0; e < 3; ++e) { LAS unsigned char* fb = lds + (e == 2 ? AT_TILE : AT_SC + 32768 + 16384 * e); *(LAS v4u*)(fb + row * 128 + ((piece ^ (row & 7)) << 4)) = fk[e]; *(LAS v4u*)(fb + 8192 + F.tid * 16) = fv[e]; } }
        __syncthreads(); }
    SState st[2];
    if (T > 15) { attn_stageC_forced_lds(P, lane, wave, tile0, g, lds, st);
        if (lane < 16) {
#pragma unroll
            for (int k = 0; k < 2; ++k) ((LAS float*)(lds + AT_SC + 65536))[(8 * wave + 4 * k + (lane >> 2)) * 4 + (lane & 3)] = st[k].M; }
        __syncthreads(); }
    else attn_stageC_forced(P, lane, wave, tile0, g, lds, st);
    attn_stageB(P, lane, wave, tile0, g, lds, slab);
    asm volatile("s_waitcnt vmcnt(0)" ::: "memory");
    __syncthreads();
    __builtin_amdgcn_fence(__ATOMIC_ACQUIRE, "agent");
    attn_stageC_merge(P, lane, wave, tile0, g, lds, slab, st);
    __syncthreads();
}

#define XB_TMO      128
#define XB_XCNT(j)  (256  + 64 * (j))
#define XB_XSUB(j)  (1280 + 64 * (j))
#define XB_XGEN(j)  (2304 + 64 * (j))
#define XB_TOP      3328
#define XB_TOPGEN   3392
#define XCD_BAR_WORDS 3456
#define XB_SPIN_CAP (1u << 22)
__device__ __forceinline__ unsigned xb_ld(unsigned* p)              { return __hip_atomic_load(p, __ATOMIC_RELAXED, __HIP_MEMORY_SCOPE_AGENT); }
__device__ __forceinline__ unsigned xb_add(unsigned* p, unsigned v) { return __hip_atomic_fetch_add(p, v, __ATOMIC_RELAXED, __HIP_MEMORY_SCOPE_AGENT); }
__device__ __forceinline__ unsigned xb_xcc_id() { return (unsigned)__builtin_amdgcn_s_getreg((3 << 11) | 20) & 0xFu; }
#define XB_SPIN(cond, bar) do { unsigned _sp = 0; while (cond) { __builtin_amdgcn_s_sleep(1); \
    if ((++_sp & 255u) == 0u) { if (xb_ld(&(bar)[XB_TMO])) break; if (_sp > XB_SPIN_CAP) { atomicAdd(&(bar)[XB_TMO], 1u); break; } } } } while (0)
struct XcdBarrier { unsigned* bar; unsigned x; volatile LAS unsigned* st; };
__device__ __forceinline__ XcdBarrier xcd_barrier_post(unsigned* bar, volatile LAS unsigned* st) {
    XcdBarrier b; b.bar = bar; b.x = xb_xcc_id(); b.st = st;
    if (threadIdx.x == 0) (void)xb_add(&bar[XB_XCNT(b.x)], 1u);
    return b;
}
__device__ __forceinline__ void xcd_barrier_complete(unsigned* bar, unsigned x, unsigned& nloc, unsigned& nx) {
    const unsigned G = gridDim.x * gridDim.y * gridDim.z;
    unsigned sum, cnt, mine, sp = 0u;
    for (;;) {
        sum = 0u; cnt = 0u; mine = 0u;
#pragma unroll
        for (unsigned j = 0; j < 16; ++j) { const unsigned c = xb_ld(&bar[XB_XCNT(j)]); sum += c; cnt += (c > 0u) ? 1u : 0u; mine = (j == x) ? c : mine; }
        if (sum == G) break;
        __builtin_amdgcn_s_sleep(1);
        if ((++sp & 255u) == 0u) { if (xb_ld(&bar[XB_TMO])) break; if (sp > XB_SPIN_CAP) { atomicAdd(&bar[XB_TMO], 1u); break; } }
    }
    nloc = mine > 0u ? mine : 1u; nx = cnt > 0u ? cnt : 1u;
}
__device__ __forceinline__ void xcd_barrier(const XcdBarrier& b) {
    asm volatile("s_waitcnt vmcnt(0)" ::: "memory");
    __syncthreads();
    if (threadIdx.x == 0) {
        unsigned* bar = b.bar;
        __builtin_amdgcn_s_waitcnt(0);
        unsigned nloc = b.st[0], nx = b.st[1];
        if (nloc == 0u) { xcd_barrier_complete(bar, b.x, nloc, nx); b.st[0] = nloc; b.st[1] = nx; }
        const unsigned old = xb_add(&bar[XB_XSUB(b.x)], 1u);
        const unsigned gen = old / nloc;
        if (old + 1u == (gen + 1u) * nloc) {
            __builtin_amdgcn_fence(__ATOMIC_RELEASE, "agent");
            asm volatile("s_waitcnt vmcnt(0)" ::: "memory");
            const unsigned og = xb_add(&bar[XB_TOP], 1u);
            const unsigned tg = og / nx;
            if (og + 1u == (tg + 1u) * nx) xb_add(&bar[XB_TOPGEN], 1u);
            else XB_SPIN(xb_ld(&bar[XB_TOPGEN]) == tg, bar);
            __builtin_amdgcn_fence(__ATOMIC_ACQUIRE, "agent");
            xb_add(&bar[XB_XGEN(b.x)], 1u);
            asm volatile("s_waitcnt vmcnt(0)" ::: "memory");
        } else {
            XB_SPIN(xb_ld(&bar[XB_XGEN(b.x)]) == gen, bar);
            __builtin_amdgcn_fence(__ATOMIC_ACQUIRE, "agent");
            asm volatile("s_waitcnt vmcnt(0)" ::: "memory");
        }
    }
    __syncthreads();
}

__global__ void __launch_bounds__(NWAVES * 64, 2) mk_fwd(Args args) {
    extern __shared__ __attribute__((aligned(16))) unsigned char lds_raw[];
    Frame F;
    F.lds = (LAS unsigned char*)lds_raw;
#define REFRESH() do { int t_ = threadIdx.x; asm volatile("" : "+v"(t_)); F.tid = t_; F.lane = t_ & 63; F.wave = __builtin_amdgcn_readfirstlane(t_ >> 6); F.gw = blockIdx.x * NWAVES + F.wave; } while (0)
    F.G = gridDim.x; F.ngw = F.G * NWAVES; REFRESH();
    F.out = args.out; F.ws = args.ws;
    const int lo = args.ph_lo, hi = args.ph_hi;
#define IN(k) (lo <= (k) && (k) < hi)
#ifndef USE_CG_SYNC
#define USE_CG_SYNC 0
#endif
    volatile LAS unsigned* bst = (volatile LAS unsigned*)(F.lds + LDS_BYTES - 64);
    if (F.tid < 16) bst[F.tid] = 0u;
    __syncthreads();
    XcdBarrier gbar; gbar.bar = (unsigned*)(F.ws + WS_CTL); gbar.x = 0; gbar.st = bst;
    if (!USE_CG_SYNC && hi - lo > 1) gbar = xcd_barrier_post((unsigned*)(F.ws + WS_CTL), bst);
#define SEAM(k) do { if (IN(k) && IN((k) + 1)) { if (USE_CG_SYNC) cg::this_grid().sync(); else xcd_barrier(gbar); } } while (0)
    unsigned char* ws = F.ws;
    if (IN(0)) { REFRESH(); p0_prologue(F, args); }
    SEAM(0);
    if (IN(1)) { REFRESH();
        pg8::Gemm g{(const bf16*)(ws + WS_XN), (const bf16*)(ws + WS_WIN), S, NPJ, 1024, 1024}; pg8::StaticOrder So; So.init(S, NPJ, F.G, (int)blockIdx.x);
        EpiProj E{(bf16*)(ws + WS_U), (bf16*)(ws + WS_Q), (bf16*)(ws + WS_KVH), (bf16*)(ws + WS_G), (bf16*)(ws + WS_GN)};
        pg8::gemm_phase<EpiProj, pg8::StaticOrder>(F.lds, g, So, E);
    }
    SEAM(1);
    if (IN(2)) { REFRESH();
        for (int u = F.gw; u < 64 * 32; u += F.ngw) s5_unit<false>(F, args, u >> 5, u & 31, F.lds + F.wave * 16384, F.lds + 131072 + F.wave * 2048);
        __syncthreads();
        pg8::Gemm g{(const bf16*)(ws + WS_KVH), (const bf16*)(ws + WS_WC1), 4096, 1024, 1024 / CMP_KS, 1024}; pg8::CmpOrder So{F.G, (int)blockIdx.x, CMP_KS};
        EpiCmp E{F.out};
        pg8::gemm_phase<EpiCmp, pg8::CmpOrder>(F.lds, g, So, E);
    }
    SEAM(2);
    if (IN(3)) { REFRESH();
        for (int u = F.gw; u < 64 * 32; u += F.ngw) s5_unit<true>(F, args, u >> 5, u & 31, F.lds + F.wave * 16384, F.lds + 131072 + F.wave * 2048);
        for (int u0 = 0; u0 < 4 * 1024; u0 += F.ngw) { const int u = u0 + F.gw; const int kvb = (u0 + (int)blockIdx.x * NWAVES) >> 11;
            __syncthreads();
            { const float* w2 = kvb ? args.in[18] : args.in[16]; LAS f32x4* wd = (LAS f32x4*)(F.lds + 8 * 2048); for (int e = F.tid; e < 256 * 64 / 4; e += NWAVES * 64) wd[e] = ((const f32x4*)w2)[e]; }
            __syncthreads();
            if (u < 4 * 1024) { const int kvg = u >> 10, n = u & 1023; cmp_l2_unit(F, args, kvg >> 1, kvg & 1, n, (LAS float*)(F.lds + F.wave * 2048), (const LAS float*)(F.lds + 8 * 2048)); } }
        __syncthreads();
        for (int u = F.gw; u < 2 * 512; u += F.ngw) vtw_item(F, u >> 9, u & 511, (LAS unsigned short*)(F.lds + 81920 + F.wave * 8192));
        for (int u = F.gw; u < 2 * 256; u += F.ngw) vts_item(F, u >> 8, u & 255, (LAS unsigned short*)(F.lds + 81920 + F.wave * 8192));
    }
    SEAM(3);
    if (IN(4)) { REFRESH();
        for (int u = blockIdx.x; u < 256; u += F.G) {
#pragma unroll 1
            for (int g = 0; g < 2; ++g) { const int ta = ((u & 7) << 5) | (u >> 3);
                const int tile = g ? 255 - ta : ta;
                const unsigned soff = (unsigned)__builtin_amdgcn_readfirstlane((int)((blockIdx.x & 127u) * (unsigned)PSLAB));
                attn_tile(F, ws, args.in[19], tile, g, soff); } }
    }
    SEAM(4);
    if (IN(5)) { REFRESH();
        pg8::Gemm g{(const bf16*)(ws + WS_Z), (const bf16*)(ws + WS_WGLU), S, 512, 512, 512}; pg8::StaticOrder So; So.init(S, 512, F.G, (int)blockIdx.x);
        EpiGlu E{(const bf16*)(ws + WS_Z), (bf16*)(ws + WS_ZG)};
        pg8::gemm_phase<EpiGlu, pg8::StaticOrder>(F.lds, g, So, E);
    }
    SEAM(5);
    if (IN(6)) { REFRESH();
        pg8::TwoSegOrder So; So.init(S, 1024, F.G, (int)blockIdx.x);
        pg8::Gemm g{(const bf16*)(ws + WS_ZG), (const bf16*)(ws + WS_WA), S, 1024, 512, 512, (const bf16*)(ws + WS_O), (const bf16*)(ws + WS_WB)}; EpiMix2 E{(const bf16*)(ws + WS_G), (bf16*)(ws + WS_MIX)};
        pg8::gemm_phase<EpiMix2, pg8::TwoSegOrder>(F.lds, g, So, E);
    }
    SEAM(6);
    if (IN(7)) { REFRESH();
        pg8::Gemm g{(const bf16*)(ws + WS_MIX), (const bf16*)(ws + WS_WOUT), S, 1024, 1024, 1024}; pg8::StaticOrder So; So.init(S, 1024, F.G, (int)blockIdx.x);
        EpiResNorm E{args.in[0], F.out, (bf16*)(ws + WS_XN), (float*)(ws + WS_SSP), (LAS float*)(F.lds + pg8::STAGE_BYTES)};
        pg8::gemm_phase<EpiResNorm, pg8::StaticOrder>(F.lds, g, So, E);
    }
    SEAM(7);
    if (IN(9)) { REFRESH();
        pg8::Gemm g{(const bf16*)(ws + WS_XN), (const bf16*)(ws + WS_WGU), S, 2 * DFF, 1024, 1024}; pg8::StaticOrder So; So.init(S, 2 * DFF, F.G, (int)blockIdx.x);
        EpiFfn E{(bf16*)(ws + WS_H), (const float*)(ws + WS_SSP)};
        pg8::gemm_phase<EpiFfn, pg8::StaticOrder>(F.lds, g, So, E);
    }
    SEAM(9);
    if (IN(10)) { REFRESH();
        pg8::Gemm g{(const bf16*)(ws + WS_H), (const bf16*)(ws + WS_WD), S, 1024, DFF, DFF}; pg8::StaticOrder So; So.init(S, 1024, F.G, (int)blockIdx.x);
        EpiRes E{F.out, F.out};
        pg8::gemm_phase<EpiRes, pg8::StaticOrder>(F.lds, g, So, E);
    }
    SEAM(10);
    if (IN(11)) { REFRESH(); for (int m = F.gw; m < S; m += F.ngw) rms_row_f32(F.out + (size_t)m * DM, args.in[26], F.lane); }
#undef IN
#undef SEAM
}

extern "C" void kernel_launch(void* const* d_in, const int* in_sizes, int n_in, void* d_out, int out_size, void* d_ws, size_t ws_size, hipStream_t stream) {
    static int grid = 0;
    if (grid == 0) {
        if (n_in != 27 || out_size != S * DM || ws_size < WS_END) { fprintf(stderr, "kernel_launch: unexpected shapes (n_in %d out %d ws %zu)\n", n_in, out_size, ws_size); grid = -1; return; }
        int dev = 0, cus = 0, per_cu = 0;
        if (hipGetDevice(&dev) != hipSuccess || hipDeviceGetAttribute(&cus, hipDeviceAttributeMultiprocessorCount, dev) != hipSuccess) { grid = -1; return; }
        if (hipFuncSetAttribute((const void*)mk_fwd, hipFuncAttributeMaxDynamicSharedMemorySize, LDS_BYTES) != hipSuccess) { fprintf(stderr, "kernel_launch: hipFuncSetAttribute failed\n"); grid = -1; return; }
        if (hipOccupancyMaxActiveBlocksPerMultiprocessor(&per_cu, (const void*)mk_fwd, NWAVES * 64, LDS_BYTES) != hipSuccess || per_cu < 1) { fprintf(stderr, "kernel_launch: occupancy query says %d\n", per_cu); per_cu = 1; }
        (void)hipGetLastError();
        grid = cus * (per_cu < 1 ? 1 : 1);
    }
    if (grid < 0) return;
    if (hipMemsetAsync((char*)d_ws + WS_CTL, 0, 16384, stream) != hipSuccess) { fprintf(stderr, "kernel_launch: hipMemsetAsync failed\n"); return; }
    Args a{};
    for (int i = 0; i < 27; ++i) a.in[i] = (const float*)d_in[i];
    a.out = (float*)d_out; a.ws = (unsigned char*)d_ws;
    if (MK_N_LAUNCHES == 1) {
        a.ph_lo = 0; a.ph_hi = NPH;
        void* kargs[] = {&a};
        hipError_t e = hipLaunchCooperativeKernel((const void*)mk_fwd, dim3(grid), dim3(NWAVES * 64), kargs, LDS_BYTES, stream);
        if (e != hipSuccess) fprintf(stderr, "kernel_launch: cooperative launch failed: %s (grid %d)\n", hipGetErrorString(e), grid);
    } else {
        for (int ph = 0; ph < NPH; ++ph) { a.ph_lo = ph; a.ph_hi = ph + 1; hipLaunchKernelGGL(mk_fwd, dim3(grid), dim3(NWAVES * 64), LDS_BYTES, stream, a); }
    }
}
```

```cpp
#include <hip/hip_runtime.h>
#include <hip/hip_cooperative_groups.h>
#include <cstdio>
#include <cstdint>
namespace cg = cooperative_groups;

#ifndef MK_N_LAUNCHES
#define MK_N_LAUNCHES 1
#endif

namespace pg8 {
#define PG8_LAS __attribute__((address_space(3)))
typedef unsigned short bf16_t;
typedef short bf16x8 __attribute__((ext_vector_type(8)));
typedef float f32x4 __attribute__((ext_vector_type(4)));
typedef unsigned u32x4 __attribute__((ext_vector_type(4)));
constexpr int BM = 256, BK = 64, HALF = 128, HTB = HALF * BK * 2, STAGE_BYTES = 8 * HTB, NXCD = 8, WGM = 8;

__host__ __device__ __forceinline__ int lds_byte(int r, int c) { const int st = (r >> 4) * 2 + (c >> 5), rr = r & 15, cc = c & 31, ob = rr * 64 + cc * 2; return st * 1024 + (ob ^ (((ob >> 9) & 1) << 5)); }
__host__ __device__ __forceinline__ void stage_rc(int b, int& R, int& C) { const int st = b / 1024, sb = b % 1024, swz = sb ^ (((sb >> 9) & 1) << 5); R = (st >> 1) * 16 + swz / 64; C = (st & 1) * 32 + (swz % 64) / 2; }
__host__ __device__ __forceinline__ int perm32(int rho) { const int n = rho >> 4, i = rho & 15; return 8 * (i >> 2) + 4 * n + (i & 3); }

struct Unit { int pm, pn, ks, seg; };
struct Gemm { const bf16_t* A; const bf16_t* Bt; int M, N, K, ld; const bf16_t* A2; const bf16_t* Bt2; };

struct StaticOrder {
    static constexpr bool SINGLE = false;
    int nM, nN, nwg, G, c;
    __host__ __device__ void init(int M, int N, int G_, int c_) { nM = M / BM; nN = N / BM; nwg = nM * nN; G = G_; c = c_; }
    __host__ __device__ bool next(int i, Unit& u) const {
        const long L = (long)i * G + c; if (L >= nwg) return false;
        int wgid = (int)L; { const int q = nwg / NXCD, r = nwg % NXCD, xcd = wgid % NXCD, off = wgid / NXCD; wgid = (xcd < r ? xcd * (q + 1) : r * (q + 1) + (xcd - r) * q) + off; }
        const int nig = WGM * nN, gid = wgid / nig, fm = gid * WGM, gsz = (nM - fm) < WGM ? (nM - fm) : WGM;
        u.pm = fm + ((wgid % nig) % gsz); u.pn = (wgid % nig) / gsz; u.ks = 0; u.seg = 0; return true;
    }
};
struct TwoSegOrder : StaticOrder {
    __host__ __device__ bool next(int i, Unit& u) const { if (!StaticOrder::next(i >> 1, u)) return false; u.seg = i & 1; return true; }
};
struct CmpOrder {
    static constexpr bool SINGLE = true;
    int G, c, KS;
    __host__ __device__ bool next(int i, Unit& u) const {
        const int L = i * G + c; if (L >= 32 * KS) return false;
        const int tile = L / KS; u.ks = L % KS; u.pm = tile >> 1; u.pn = (tile & 1) + (u.pm >= 8 ? 2 : 0); u.seg = 0; return true;
    }
};

typedef float f32x2_t __attribute__((ext_vector_type(2))); typedef __bf16 bf16x2_t __attribute__((ext_vector_type(2)));
__device__ __forceinline__ unsigned cvt_pk_bf16(float lo, float hi) { f32x2_t v = {lo, hi}; bf16x2_t b = __builtin_convertvector(v, bf16x2_t); return __builtin_bit_cast(unsigned, b); }
__device__ __forceinline__ float bflo(unsigned w) { return __uint_as_float(w << 16); }
__device__ __forceinline__ float bfhi(unsigned w) { return __uint_as_float(w & 0xffff0000u); }
__device__ __forceinline__ float sigm(float x) { return __builtin_amdgcn_rcpf(1.0f + __expf(-x)); }

template <class Epi, class Sched>
__device__ __forceinline__ void gemm_phase(PG8_LAS unsigned char* lds, const Gemm g, const Sched& S, const Epi& E) {
    const int tid = threadIdx.x, wid = __builtin_amdgcn_readfirstlane(tid >> 6), lane = tid & 63, wr = wid >> 2, wc = wid & 3, fr = lane & 15, fq = lane >> 4;
    const int K = g.K, ld = g.ld, nt = K / BK;
    unsigned voffA[2], voffB[2];
#pragma unroll
    for (int i = 0; i < 2; ++i) { int R, C; stage_rc(tid * 16 + i * 8192, R, C); const int Rb = Epi::PERM ? ((R & ~31) + perm32(R & 31)) : R;
        voffA[i] = (unsigned)(R * ld + C) * 2u; voffB[i] = (unsigned)(Rb * ld + C) * 2u; }
    const size_t kstep = (size_t)(BK * 2);
    const size_t hstep = (size_t)HALF * ld * 2;
    const size_t tstep = 2 * hstep;
    const unsigned ldsw = (unsigned)wid * 1024u;
    const int aoff = lds_byte(wr * 64 + fr, fq * 8), boff = lds_byte(wc * 32 + fr, fq * 8);
#define PG8_SA(b, h) (((b) * 2 + (h)) * HTB)
#define PG8_SB(b, h) ((4 + (b) * 2 + (h)) * HTB)
#define PG8_STAGE(bufoff, gbase, voff) do { _Pragma("unroll") for (int _i = 0; _i < 2; ++_i) \
        __builtin_amdgcn_global_load_lds((const unsigned*)((const char*)(gbase) + (voff)[_i]), (PG8_LAS unsigned*)(lds + (bufoff) + ldsw + _i * 8192), 16, 0, 0); } while (0)
#define PG8_LDA(dst, b, h) do { _Pragma("unroll") for (int m = 0; m < 4; ++m) _Pragma("unroll") for (int k = 0; k < 2; ++k) dst[m][k] = *(const PG8_LAS bf16x8*)(lds + PG8_SA(b, h) + aoff + m * 2048 + k * 1024); } while (0)
#define PG8_LDB(dst, b, h) do { _Pragma("unroll") for (int n = 0; n < 2; ++n) _Pragma("unroll") for (int k = 0; k < 2; ++k) dst[n][k] = *(const PG8_LAS bf16x8*)(lds + PG8_SB(b, h) + boff + n * 2048 + k * 1024); } while (0)
#define PG8_MMA(ai, bj, At, Bt) do { __builtin_amdgcn_s_setprio(1); _Pragma("unroll") for (int m = 0; m < 4; ++m) _Pragma("unroll") for (int n = 0; n < 2; ++n) _Pragma("unroll") for (int k = 0; k < 2; ++k) \
        acc[ai][bj][m][n] = __builtin_amdgcn_mfma_f32_16x16x32_bf16(Bt[n][k], At[m][k], acc[ai][bj][m][n], 0, 0, 0); __builtin_amdgcn_s_setprio(0); } while (0)
#define PG8_WAIT_V(n) asm volatile("s_waitcnt vmcnt(" #n ")" ::: "memory")
#define PG8_WAIT_L(n) asm volatile("s_waitcnt lgkmcnt(" #n ")" ::: "memory")
#define PG8_BAR __builtin_amdgcn_s_barrier()
#define PG8_SCHED __builtin_amdgcn_sched_barrier(0)
    Unit cur, nxt; int ui = 0;
    if (!S.next(0, cur)) return;
    f32x4 acc[2][2][4][2];
#pragma unroll
    for (int a = 0; a < 2; ++a)
#pragma unroll
        for (int b = 0; b < 2; ++b)
#pragma unroll
            for (int m = 0; m < 4; ++m)
#pragma unroll
                for (int n = 0; n < 2; ++n) acc[a][b][m][n] = (f32x4){0.f, 0.f, 0.f, 0.f};
    bf16x8 At[4][2], B0[2][2], B1[2][2];
    const char* cA = (const char*)(cur.seg ? g.A2 : g.A) + (size_t)cur.pm * tstep + (size_t)cur.ks * K * 2; const char* cB = (const char*)(cur.seg ? g.Bt2 : g.Bt) + (size_t)cur.pn * tstep + (size_t)cur.ks * K * 2;
    PG8_STAGE(PG8_SB(0, 0), cB, voffB); PG8_STAGE(PG8_SB(0, 1), cB + hstep, voffB); PG8_STAGE(PG8_SA(0, 0), cA, voffA); PG8_STAGE(PG8_SA(0, 1), cA + hstep, voffA);
    if (wr == 1) PG8_BAR;
    PG8_WAIT_V(2); PG8_BAR;
    PG8_STAGE(PG8_SB(1, 0), cB + kstep, voffB); PG8_STAGE(PG8_SA(1, 0), cA + kstep, voffA); PG8_STAGE(PG8_SB(1, 1), cB + hstep + kstep, voffB);
    PG8_WAIT_V(6); PG8_BAR;
    for (;;) {
        const bool has_next = Sched::SINGLE ? false : S.next(ui + 1, nxt);
        const char* nA = has_next ? (const char*)(nxt.seg ? g.A2 : g.A) + (size_t)nxt.pm * tstep + (size_t)nxt.ks * K * 2 : cA; const char* nB = has_next ? (const char*)(nxt.seg ? g.Bt2 : g.Bt) + (size_t)nxt.pn * tstep + (size_t)nxt.ks * K * 2 : cB;
        for (int t = 0; t < nt; t += 2) {
            const bool last = (t == nt - 2);
            const char* a1 = cA + (size_t)(t + 1) * kstep;
            const char* a2 = last ? nA : cA + (size_t)(t + 2) * kstep; const char* b2 = last ? nB : cB + (size_t)(t + 2) * kstep;
            const char* a3 = a2 + kstep; const char* b3 = b2 + kstep;
            PG8_LDB(B0, 0, 0); PG8_LDB(B1, 0, 1); PG8_SCHED; PG8_LDA(At, 0, 0); PG8_STAGE(PG8_SA(1, 1), a1 + hstep, voffA);
            PG8_WAIT_V(8); PG8_WAIT_L(0); PG8_BAR; PG8_MMA(0, 0, At, B0); PG8_MMA(0, 1, At, B1); PG8_BAR; PG8_SCHED;
            PG8_LDA(At, 0, 1); PG8_STAGE(PG8_SB(0, 0), b2, voffB); PG8_STAGE(PG8_SB(0, 1), b2 + hstep, voffB); PG8_STAGE(PG8_SA(0, 0), a2, voffA);
            PG8_WAIT_V(8); PG8_WAIT_L(0); PG8_BAR; PG8_MMA(1, 0, At, B0); PG8_MMA(1, 1, At, B1); PG8_BAR; PG8_SCHED;
            PG8_LDB(B0, 1, 0); PG8_LDB(B1, 1, 1); PG8_SCHED; PG8_LDA(At, 1, 0); PG8_STAGE(PG8_SA(0, 1), a2 + hstep, voffA);
            PG8_WAIT_V(8); PG8_WAIT_L(0); PG8_BAR; PG8_MMA(0, 0, At, B0); PG8_MMA(0, 1, At, B1); PG8_BAR; PG8_SCHED;
            PG8_LDA(At, 1, 1); PG8_STAGE(PG8_SB(1, 0), b3, voffB); PG8_STAGE(PG8_SB(1, 1), b3 + hstep, voffB); PG8_STAGE(PG8_SA(1, 0), a3, voffA);
            PG8_WAIT_V(8); PG8_WAIT_L(0); PG8_BAR; PG8_MMA(1, 0, At, B0); PG8_MMA(1, 1, At, B1); PG8_BAR; PG8_SCHED;
        }
        if (wr == 0) PG8_BAR;
        E(acc, cur, wr, wc, fr, fq);
        if (!has_next) break;
        if (!nxt.seg) {
#pragma unroll
        for (int a = 0; a < 2; ++a)
#pragma unroll
            for (int b = 0; b < 2; ++b)
#pragma unroll
                for (int m = 0; m < 4; ++m)
#pragma unroll
                    for (int n = 0; n < 2; ++n) acc[a][b][m][n] = (f32x4){0.f, 0.f, 0.f, 0.f}; }
        cur = nxt; cA = nA; cB = nB; ++ui;
        if (wr == 1) PG8_BAR;
    }
    PG8_WAIT_V(0);
    PG8_BAR;
#undef PG8_SA
#undef PG8_SB
#undef PG8_STAGE
#undef PG8_LDA
#undef PG8_LDB
#undef PG8_MMA
#undef PG8_WAIT_V
#undef PG8_WAIT_L
#undef PG8_BAR
#undef PG8_SCHED
}
}

constexpr int S = 16384, DM = 1024, INC = 3864, NPJ = 4096, SSW = 512, NSW = 512, HD = 64, DFF = 2816;
constexpr int NGRP = 32, NST = 64, NCMP = 1023;
constexpr int NWAVES = 8;
constexpr int NPH = 12;
constexpr int CMP_KS = 4;
constexpr float EPS = 1e-6f;

constexpr size_t MiB = 1u << 20;
constexpr size_t WS_CTL = 0;
constexpr size_t WS_TAB = 1 * MiB;
constexpr size_t TAB_BF = 0, TAB_CF = 128 * 1024, TAB_LAM = 256 * 1024, TAB_LAM256 = 272 * 1024, TAB_POSB = 288 * 1024;
constexpr size_t WS_SSP = 1 * MiB + 512 * 1024;
constexpr size_t WS_F = 2 * MiB;
constexpr size_t WS_KVC = 3 * MiB;
constexpr size_t WS_WIN = 4 * MiB, WS_WGU = 12 * MiB, WS_WD = 23 * MiB, WS_WOUT = 29 * MiB, WS_WA = 31 * MiB, WS_WB = 32 * MiB, WS_WGLU = 33 * MiB, WS_WC1 = 34 * MiB;
constexpr size_t WS_XN = 36 * MiB;
constexpr size_t WS_Z = WS_XN, WS_ZG = WS_XN + 16 * MiB;
constexpr size_t WS_U = 68 * MiB, WS_O = WS_U;
constexpr size_t WS_Q = 84 * MiB;
constexpr size_t WS_KVH = 100 * MiB;
constexpr size_t WS_G = 124 * MiB;
constexpr size_t WS_GN = 188 * MiB;
constexpr size_t WS_MIX = 84 * MiB;
constexpr size_t WS_H = 100 * MiB;
constexpr size_t WS_VTW = 189 * MiB;
constexpr size_t WS_VTS = 193 * MiB;
constexpr size_t WS_KCB = 197 * MiB;
constexpr size_t WS_VTC = 197 * MiB + 512 * 1024;
constexpr size_t WS_PSLAB = 198 * MiB;
constexpr size_t WS_END = 254 * MiB;

constexpr int LDS_BYTES = 163840;

#define GAS __attribute__((address_space(1)))
#define LAS __attribute__((address_space(3)))
typedef unsigned short bf16;
typedef unsigned v4u __attribute__((ext_vector_type(4)));
typedef float f32x4 __attribute__((ext_vector_type(4)));
typedef float f32x2 __attribute__((ext_vector_type(2)));
typedef float f32x16 __attribute__((ext_vector_type(16)));
typedef short bf16x8 __attribute__((ext_vector_type(8)));
#define LDS_WAIT() asm volatile("s_waitcnt lgkmcnt(0)" ::: "memory")
#define VM_WAIT() asm volatile("s_waitcnt vmcnt(0)" ::: "memory")
typedef float f32x2c_t __attribute__((ext_vector_type(2))); typedef __bf16 bf16x2c_t __attribute__((ext_vector_type(2)));
__device__ __forceinline__ unsigned pk2(float lo, float hi) { f32x2c_t v = {lo, hi}; bf16x2c_t b = __builtin_convertvector(v, bf16x2c_t); return __builtin_bit_cast(unsigned, b); }
__device__ __forceinline__ unsigned f2bf(float f) { return pk2(f, 0.f) & 0xffffu; }
__device__ __forceinline__ float bf2f(bf16 v) { return __uint_as_float((unsigned)v << 16); }
using pg8::bflo; using pg8::bfhi; using pg8::sigm; using pg8::cvt_pk_bf16;
__device__ __forceinline__ float gelu_tanh(float y) {
    const float a = 0.7978845608028654f * (y + 0.044715f * y * y * y);
    const float e = __expf(2.0f * a);
    const float th = 1.0f - 2.0f * __builtin_amdgcn_rcpf(e + 1.0f);
    return 0.5f * y * (1.0f + th);
}
__device__ __forceinline__ float wave_sum(float v) {
#pragma unroll
    for (int o = 1; o < 64; o <<= 1) v += __shfl_xor(v, o);
    return v;
}
__device__ __forceinline__ float wave_max(float v) {
#pragma unroll
    for (int o = 1; o < 64; o <<= 1) v = fmaxf(v, __shfl_xor(v, o));
    return v;
}

struct Args { const float* in[27]; float* out; unsigned char* ws; int ph_lo, ph_hi; };

struct Frame {
    LAS unsigned char* lds;
    int tid, lane, wave, G, gw, ngw;
    float* out; unsigned char* ws;
};

using pg8::Unit; using pg8::BM; using pg8::HALF;
struct EpiProj {
    static constexpr bool PERM = true;
    bf16 *U, *Q, *KVH, *Gt, *GN;
    __device__ __forceinline__ void operator()(const f32x4 (&acc)[2][2][4][2], const Unit& u, int wr, int wc, int fr, int fq) const {
        const int row0 = u.pm * BM + wr * 64 + fr, pn = u.pn;
#pragma unroll
        for (int ai = 0; ai < 2; ++ai)
#pragma unroll
            for (int m = 0; m < 4; ++m) { const int row = row0 + ai * HALF + m * 16;
#pragma unroll
                for (int bj = 0; bj < 2; ++bj) { f32x4 v0 = acc[ai][bj][m][0], v1 = acc[ai][bj][m][1]; const int col = bj * HALF + wc * 32 + 8 * fq; bf16* dst;
                    if (pn < 2) dst = U + (size_t)row * 512 + pn * 256 + col;
                    else if (pn < 4) { v0 = v0 * (0.125f * 1.4426950408889634f); v1 = v1 * (0.125f * 1.4426950408889634f); dst = Q + (size_t)row * 512 + (pn - 2) * 256 + col; }
                    else if (pn < 7) dst = KVH + ((size_t)((pn - 4) * 4 + (col >> 6)) * S + row) * 64 + (col & 63);
                    else { v0 = (f32x4){sigm(v0[0]), sigm(v0[1]), sigm(v0[2]), sigm(v0[3])}; v1 = (f32x4){sigm(v1[0]), sigm(v1[1]), sigm(v1[2]), sigm(v1[3])};
                        if (pn < 15) dst = Gt + (size_t)row * 2048 + (pn - 7) * 256 + col; else { if (col >= 32) continue; dst = GN + (size_t)row * 32 + col; } }
                    v4u w; w.x = cvt_pk_bf16(v0[0], v0[1]); w.y = cvt_pk_bf16(v0[2], v0[3]); w.z = cvt_pk_bf16(v1[0], v1[1]); w.w = cvt_pk_bf16(v1[2], v1[3]);
                    *(v4u*)dst = w; } }
    }
};
struct EpiCmp {
    static constexpr bool PERM = false;
    float* C;
    __device__ __forceinline__ void operator()(const f32x4 (&acc)[2][2][4][2], const Unit& u, int wr, int wc, int fr, int fq) const {
        const int row0 = u.pm * BM + wr * 64 + fr, col0 = (u.pn & 1) * BM + wc * 32 + 4 * fq; float* base = C + (size_t)u.ks * 4096 * 512;
#pragma unroll
        for (int ai = 0; ai < 2; ++ai)
#pragma unroll
            for (int m = 0; m < 4; ++m) { float* rowp = base + (size_t)(row0 + ai * HALF + m * 16) * 512 + col0;
#pragma unroll
                for (int bj = 0; bj < 2; ++bj)
#pragma unroll
                    for (int n = 0; n < 2; ++n) *(f32x4*)(rowp + bj * HALF + n * 16) = acc[ai][bj][m][n]; }
    }
};
struct EpiGlu {
    static constexpr bool PERM = true;
    const bf16* Z; bf16* ZG;
    __device__ __forceinline__ void operator()(const f32x4 (&acc)[2][2][4][2], const Unit& u, int wr, int wc, int fr, int fq) const {
        const int row0 = u.pm * BM + wr * 64 + fr;
#pragma unroll
        for (int ai = 0; ai < 2; ++ai)
#pragma unroll
            for (int m = 0; m < 4; ++m) { const int row = row0 + ai * HALF + m * 16;
#pragma unroll
                for (int bj = 0; bj < 2; ++bj) { const f32x4 v0 = acc[ai][bj][m][0], v1 = acc[ai][bj][m][1]; const size_t off = (size_t)row * 512 + u.pn * BM + bj * HALF + wc * 32 + 8 * fq;
                    const v4u z = *(const v4u*)(Z + off); v4u w;
                    w.x = cvt_pk_bf16(bflo(z.x) * sigm(v0[0]), bfhi(z.x) * sigm(v0[1])); w.y = cvt_pk_bf16(bflo(z.y) * sigm(v0[2]), bfhi(z.y) * sigm(v0[3]));
                    w.z = cvt_pk_bf16(bflo(z.z) * sigm(v1[0]), bfhi(z.z) * sigm(v1[1])); w.w = cvt_pk_bf16(bflo(z.w) * sigm(v1[2]), bfhi(z.w) * sigm(v1[3]));
                    *(v4u*)(ZG + off) = w; } }
    }
};
struct EpiMix2 {
    static constexpr bool PERM = true;
    const bf16* Gt; bf16* MIX;
    __device__ __forceinline__ void operator()(f32x4 (&acc)[2][2][4][2], const Unit& u, int wr, int wc, int fr, int fq) const {
        const int row0 = u.pm * BM + wr * 64 + fr;
#pragma unroll
        for (int ai = 0; ai < 2; ++ai)
#pragma unroll
            for (int m = 0; m < 4; ++m) { const int row = row0 + ai * HALF + m * 16;
#pragma unroll
                for (int bj = 0; bj < 2; ++bj) { const int col = u.pn * BM + bj * HALF + wc * 32 + 8 * fq;
                    const v4u gb = *(const v4u*)(Gt + (size_t)row * 2048 + 1024 + col);
                    const float b8[8] = {bflo(gb.x), bfhi(gb.x), bflo(gb.y), bfhi(gb.y), bflo(gb.z), bfhi(gb.z), bflo(gb.w), bfhi(gb.w)};
                    if (u.seg == 0) { const v4u ga = *(const v4u*)(Gt + (size_t)row * 2048 + col);
                        const float a8[8] = {bflo(ga.x), bfhi(ga.x), bflo(ga.y), bfhi(ga.y), bflo(ga.z), bfhi(ga.z), bflo(ga.w), bfhi(ga.w)};
#pragma unroll
                        for (int e = 0; e < 4; ++e) { acc[ai][bj][m][0][e] *= a8[e] * __builtin_amdgcn_rcpf(b8[e]); acc[ai][bj][m][1][e] *= a8[4 + e] * __builtin_amdgcn_rcpf(b8[4 + e]); }
                    } else { const f32x4 v0 = acc[ai][bj][m][0], v1 = acc[ai][bj][m][1]; v4u w;
                        w.x = cvt_pk_bf16(v0[0] * b8[0], v0[1] * b8[1]); w.y = cvt_pk_bf16(v0[2] * b8[2], v0[3] * b8[3]); w.z = cvt_pk_bf16(v1[0] * b8[4], v1[1] * b8[5]); w.w = cvt_pk_bf16(v1[2] * b8[6], v1[3] * b8[7]);
                        *(v4u*)(MIX + (size_t)row * 1024 + col) = w; } } }
    }
};
struct EpiRes {
    static constexpr bool PERM = false;
    const float* base; float* out;
    __device__ __forceinline__ void operator()(const f32x4 (&acc)[2][2][4][2], const Unit& u, int wr, int wc, int fr, int fq) const {
        const int row0 = u.pm * BM + wr * 64 + fr, col0 = u.pn * BM + wc * 32 + 4 * fq;
#pragma unroll
        for (int ai = 0; ai < 2; ++ai)
#pragma unroll
            for (int m = 0; m < 4; ++m) { const size_t off = (size_t)(row0 + ai * HALF + m * 16) * 1024 + col0;
#pragma unroll
                for (int bj = 0; bj < 2; ++bj)
#pragma unroll
                    for (int n = 0; n < 2; ++n) { const f32x4 b = *(const f32x4*)(base + off + bj * HALF + n * 16); *(f32x4*)(out + off + bj * HALF + n * 16) = b + acc[ai][bj][m][n]; } }
    }
};
struct EpiResNorm {
    static constexpr bool PERM = false;
    const float* base; float* out; bf16* XN; float* SSP; LAS float* part;
    __device__ __forceinline__ void operator()(const f32x4 (&acc)[2][2][4][2], const Unit& u, int wr, int wc, int fr, int fq) const {
        const int row0 = u.pm * BM + wr * 64 + fr, col0 = u.pn * BM + wc * 32 + 4 * fq;
#pragma unroll
        for (int ai = 0; ai < 2; ++ai)
#pragma unroll
            for (int m = 0; m < 4; ++m) { const size_t off = (size_t)(row0 + ai * HALF + m * 16) * 1024 + col0; float ss = 0.f;
#pragma unroll
                for (int bj = 0; bj < 2; ++bj)
#pragma unroll
                    for (int n = 0; n < 2; ++n) { const f32x4 b = *(const f32x4*)(base + off + bj * HALF + n * 16); const f32x4 x1 = b + acc[ai][bj][m][n]; *(f32x4*)(out + off + bj * HALF + n * 16) = x1;
                        *(unsigned long long*)(XN + off + bj * HALF + n * 16) = (unsigned long long)cvt_pk_bf16(x1[0], x1[1]) | ((unsigned long long)cvt_pk_bf16(x1[2], x1[3]) << 32);
                        ss += (x1[0] * x1[0] + x1[1] * x1[1]) + (x1[2] * x1[2] + x1[3] * x1[3]); }
                ss += __shfl_xor(ss, 16); ss += __shfl_xor(ss, 32);
                if (fq == 0) part[(ai * HALF + wr * 64 + m * 16 + fr) * 4 + wc] = ss; }
        asm volatile("s_waitcnt lgkmcnt(0)" ::: "memory"); __builtin_amdgcn_s_barrier(); asm volatile("" ::: "memory");
        if (threadIdx.x < 256) { const f32x4 p = *(const LAS f32x4*)(part + threadIdx.x * 4); SSP[(size_t)(u.pm * BM + threadIdx.x) * 4 + u.pn] = (p[0] + p[1]) + (p[2] + p[3]); }
    }
};
struct EpiFfn {
    static constexpr bool PERM = true;
    bf16* H; const float* SSP;
    __device__ __forceinline__ void operator()(const f32x4 (&acc)[2][2][4][2], const Unit& u, int wr, int wc, int fr, int fq) const {
        const int row0 = u.pm * BM + wr * 64 + fr;
#pragma unroll
        for (int ai = 0; ai < 2; ++ai)
#pragma unroll
            for (int m = 0; m < 4; ++m) { const int row = row0 + ai * HALF + m * 16;
                const f32x4 sp = *(const f32x4*)(SSP + (size_t)row * 4); const float rs = 1.0f / sqrtf(((sp[0] + sp[1]) + (sp[2] + sp[3])) * (1.f / 1024.f) + 1e-6f);
                float r[8];
#pragma unroll
                for (int n = 0; n < 2; ++n)
#pragma unroll
                    for (int e = 0; e < 4; ++e) { const float gt = acc[ai][0][m][n][e] * rs, up = acc[ai][1][m][n][e] * rs; r[n * 4 + e] = gt * sigm(gt) * up; }
                v4u w; w.x = cvt_pk_bf16(r[0], r[1]); w.y = cvt_pk_bf16(r[2], r[3]); w.z = cvt_pk_bf16(r[4], r[5]); w.w = cvt_pk_bf16(r[6], r[7]);
                *(v4u*)(H + (size_t)row * DFF + u.pn * HALF + wc * 32 + 8 * fq) = w; }
    }
};

struct TrDesc { const float* src; bf16* dst; int ld, ncols, dld, drow, kb, nb; const float* gain; };
__device__ __forceinline__ void tr_load(const TrDesc& d, float (&v)[32], int lane) {
    const int k0 = 64 * d.kb, c = 32 * d.nb + (lane & 31); const bool ok = c < d.ncols; const float* p = d.src + (size_t)(k0 + (lane >> 5)) * d.ld + c;
#pragma unroll
    for (int i = 0; i < 32; ++i) v[i] = ok ? p[(size_t)(2 * i) * d.ld] : 0.f;
    if (d.gain) {
#pragma unroll
        for (int i = 0; i < 32; ++i) v[i] *= d.gain[k0 + 2 * i + (lane >> 5)]; }
}
__device__ __forceinline__ void tr_finish(const TrDesc& d, const float (&v)[32], LAS float* scr, int lane) {
#pragma unroll
    for (int i = 0; i < 32; ++i) scr[(2 * i + (lane >> 5)) * 33 + (lane & 31)] = v[i];
    LDS_WAIT();
    const int cc = lane & 7, k0 = 64 * d.kb;
#pragma unroll
    for (int j = 0; j < 4; ++j) { const int n = (lane >> 3) + 8 * j; const LAS float* s = scr + (8 * cc) * 33 + n;
        v4u o; o.x = pk2(s[0 * 33], s[1 * 33]); o.y = pk2(s[2 * 33], s[3 * 33]); o.z = pk2(s[4 * 33], s[5 * 33]); o.w = pk2(s[6 * 33], s[7 * 33]);
        *(v4u*)(d.dst + (size_t)(d.drow + n) * d.dld + k0 + 8 * cc) = o; }
    LDS_WAIT();
}
__device__ __forceinline__ void rms_row_to_bf16(const float* xrow, const float* gain, bf16* orow, int lane) {
    const f32x4* xr = (const f32x4*)xrow + lane; const f32x4* gr = (const f32x4*)gain + lane;
    f32x4 v[4]; float s = 0.f;
#pragma unroll
    for (int j = 0; j < 4; ++j) { v[j] = xr[64 * j]; s += (v[j].x * v[j].x + v[j].y * v[j].y) + (v[j].z * v[j].z + v[j].w * v[j].w); }
    const float rstd = 1.0f / sqrtf(wave_sum(s) * (1.f / DM) + EPS);
    unsigned long long* o8 = (unsigned long long*)orow + lane;
#pragma unroll
    for (int j = 0; j < 4; ++j) { const f32x4 gq = gr[64 * j];
        o8[64 * j] = (unsigned long long)pk2(v[j].x * rstd * gq.x, v[j].y * rstd * gq.y) | ((unsigned long long)pk2(v[j].z * rstd * gq.z, v[j].w * rstd * gq.w) << 32); }
}
__device__ __forceinline__ void rms_rows2_to_bf16(const float* x0, const float* x1, const float* gain, bf16* o0, bf16* o1, int lane) {
    const f32x4* xa = (const f32x4*)x0 + lane; const f32x4* xb = (const f32x4*)x1 + lane; const f32x4* gr = (const f32x4*)gain + lane;
    f32x4 va[4], vb[4]; float sa = 0.f, sb = 0.f;
#pragma unroll
    for (int j = 0; j < 4; ++j) { va[j] = xa[64 * j]; vb[j] = xb[64 * j]; }
#pragma unroll
    for (int j = 0; j < 4; ++j) { sa += (va[j].x * va[j].x + va[j].y * va[j].y) + (va[j].z * va[j].z + va[j].w * va[j].w); sb += (vb[j].x * vb[j].x + vb[j].y * vb[j].y) + (vb[j].z * vb[j].z + vb[j].w * vb[j].w); }
    const float ra = 1.0f / sqrtf(wave_sum(sa) * (1.f / DM) + EPS), rb = 1.0f / sqrtf(wave_sum(sb) * (1.f / DM) + EPS);
    unsigned long long* pa = (unsigned long long*)o0 + lane; unsigned long long* pb = (unsigned long long*)o1 + lane;
#pragma unroll
    for (int j = 0; j < 4; ++j) { const f32x4 gq = gr[64 * j];
        pa[64 * j] = (unsigned long long)pk2(va[j].x * ra * gq.x, va[j].y * ra * gq.y) | ((unsigned long long)pk2(va[j].z * ra * gq.z, va[j].w * ra * gq.w) << 32);
        pb[64 * j] = (unsigned long long)pk2(vb[j].x * rb * gq.x, vb[j].y * rb * gq.y) | ((unsigned long long)pk2(vb[j].z * rb * gq.z, vb[j].w * rb * gq.w) << 32); }
}
__device__ __forceinline__ void rms_row_f32(float* xrow, const float* gain, int lane) {
    f32x4* xr = (f32x4*)xrow + lane; const f32x4* gr = (const f32x4*)gain + lane;
    f32x4 v[4]; float s = 0.f;
#pragma unroll
    for (int j = 0; j < 4; ++j) { v[j] = xr[64 * j]; s += (v[j].x * v[j].x + v[j].y * v[j].y) + (v[j].z * v[j].z + v[j].w * v[j].w); }
    const float rstd = 1.0f / sqrtf(wave_sum(s) * (1.f / DM) + EPS);
#pragma unroll
    for (int j = 0; j < 4; ++j) { const f32x4 gq = gr[64 * j]; xr[64 * j] = v[j] * rstd * gq; }
}
__device__ __forceinline__ void s5_tables(const Frame& F, const Args& args, int g) {
    const int lane = F.lane;
    const float* are = args.in[3]; const float* aim = args.in[4]; const float* ldt = args.in[5]; const float* bre = args.in[6]; const float* bim = args.in[7]; const float* cre = args.in[8]; const float* cim = args.in[9];
    const double dt = exp((double)ldt[g]);
    {   const int p = lane; const double ar = are[g * 64 + p], ai = aim[g * 64 + p];
        const double er = exp(ar * dt), lr = er * cos(ai * dt), li = er * sin(ai * dt);
        ((f32x2*)(F.ws + WS_TAB + TAB_LAM))[g * 64 + p] = (f32x2){(float)lr, (float)li};
        const double e2 = exp(ar * dt * 256.0), l2r = e2 * cos(ai * dt * 256.0), l2i = e2 * sin(ai * dt * 256.0);
        ((f32x2*)(F.ws + WS_TAB + TAB_LAM256))[g * 64 + p] = (f32x2){(float)l2r, (float)l2i}; }
#pragma unroll
    for (int nt = 0; nt < 4; ++nt) { const int col = 32 * nt + (lane & 31), p = col >> 1, ri = col & 1;
        const double ar = are[g * 64 + p], ai = aim[g * 64 + p];
        const double er = exp(ar * dt), lr = er * cos(ai * dt) - 1.0, li = er * sin(ai * dt);
        const double den = ar * ar + ai * ai, kr = (lr * ar + li * ai) / den, ki = (li * ar - lr * ai) / den;
        float v[8];
#pragma unroll
        for (int j = 0; j < 8; ++j) { const int c = 8 * (lane >> 5) + j; const double br = bre[(g * 64 + p) * 16 + c], bi = bim[(g * 64 + p) * 16 + c];
            v[j] = (float)(ri ? (kr * bi + ki * br) : (kr * br - ki * bi)); }
        v4u o; o.x = pk2(v[0], v[1]); o.y = pk2(v[2], v[3]); o.z = pk2(v[4], v[5]); o.w = pk2(v[6], v[7]);
        ((v4u*)(F.ws + WS_TAB + TAB_BF))[(g * 4 + nt) * 64 + lane] = o; }
#pragma unroll
    for (int ks = 0; ks < 4; ++ks) { const int ch = lane & 15; float v[8];
#pragma unroll
        for (int j = 0; j < 8; ++j) { const int k = 32 * ks + 8 * (lane >> 4) + j, p = k >> 1, ri = k & 1; v[j] = ri ? -cim[(g * 16 + ch) * 64 + p] : cre[(g * 16 + ch) * 64 + p]; }
        v4u o; o.x = pk2(v[0], v[1]); o.y = pk2(v[2], v[3]); o.z = pk2(v[4], v[5]); o.w = pk2(v[6], v[7]);
        ((v4u*)(F.ws + WS_TAB + TAB_CF))[(g * 4 + ks) * 64 + lane] = o; }
}
__device__ __forceinline__ void p0_prologue(const Frame& F, const Args& args) {
    LAS float* scr = (LAS float*)(F.lds + F.wave * 16384);
    const int gw = F.gw, NGW = F.ngw, lane = F.lane;
    if (F.wave == 0 && blockIdx.x < 32) s5_tables(F, args, (int)blockIdx.x);
    else if (F.wave == 1 && blockIdx.x < 128) {
        const int it = (int)blockIdx.x, kv = it >> 6, part = (it >> 2) & 15, cgp = it & 3;
        const float* pos = kv ? args.in[14] : args.in[13]; const float* w1 = kv ? args.in[17] : args.in[15]; float a = 0.f;
#pragma unroll 1
        for (int r0 = 128 * part; r0 < 128 * part + 128; r0 += 32) { float wv[32];
#pragma unroll
            for (int i = 0; i < 32; ++i) wv[i] = w1[(size_t)(r0 + i) * 256 + cgp * 64 + lane];
#pragma unroll
            for (int i = 0; i < 32; ++i) a += pos[r0 + i] * wv[i]; }
        ((float*)(F.ws + WS_TAB + TAB_POSB))[(kv * 16 + part) * 256 + cgp * 64 + lane] = a;
    }
    { v4u* z = (v4u*)(F.ws + WS_WIN + (size_t)3872 * 1024 * 2); const int n16 = 224 * 1024 * 2 / 16;
      for (int i = blockIdx.x * 512 + F.tid; i < n16; i += F.G * 512) z[i] = (v4u){0u, 0u, 0u, 0u}; }
    bf16* WIN = (bf16*)(F.ws + WS_WIN); bf16* WGU = (bf16*)(F.ws + WS_WGU); bf16* WD = (bf16*)(F.ws + WS_WD); bf16* WOUT = (bf16*)(F.ws + WS_WOUT);
    bf16* WA = (bf16*)(F.ws + WS_WA); bf16* WB = (bf16*)(F.ws + WS_WB); bf16* WGLU = (bf16*)(F.ws + WS_WGLU); bf16* WC1 = (bf16*)(F.ws + WS_WC1);
    constexpr int I1 = 16 * 56, I2 = 16 * 64, I3 = 16, IGLU = 8 * 16, IUP = 8 * 32, IOUT = 16 * 32, IFF = 16 * 88, IDN = 44 * 32, ICM = 16 * 8;
    constexpr int NITEMS = I1 + I2 + I3 + IGLU + 2 * IUP + IOUT + 2 * IFF + IDN + 4 * ICM;
    auto desc = [&](int it) -> TrDesc {
        int r = it;
        if (r < I1) return TrDesc{args.in[2], WIN, INC, 1792, 1024, 32 * (r % 56), r / 56, r % 56, nullptr}; r -= I1;
        if (r < I2) return TrDesc{args.in[2] + 1816, WIN, INC, 2048, 1024, 1792 + 32 * (r % 64), r / 64, r % 64, nullptr}; r -= I2;
        if (r < I3) return TrDesc{args.in[2] + 1792, WIN, INC, 24, 1024, 3840, r, 0, nullptr}; r -= I3;
        if (r < IGLU) return TrDesc{args.in[11], WGLU, 512, 512, 512, 32 * (r % 16), r / 16, r % 16, nullptr}; r -= IGLU;
        if (r < IUP) return TrDesc{args.in[12], WA, 1024, 1024, 512, 32 * (r % 32), r / 32, r % 32, nullptr}; r -= IUP;
        if (r < IUP) return TrDesc{args.in[20], WB, 1024, 1024, 512, 32 * (r % 32), r / 32, r % 32, nullptr}; r -= IUP;
        if (r < IOUT) return TrDesc{args.in[21], WOUT, 1024, 1024, 1024, 32 * (r % 32), r / 32, r % 32, nullptr}; r -= IOUT;
        if (r < IFF) { const int nb = r % 88; return TrDesc{args.in[23], WGU, DFF, DFF, 1024, (nb >> 2) * 256 + (nb & 3) * 32, r / 88, nb, args.in[22]}; } r -= IFF;
        if (r < IFF) { const int nb = r % 88; return TrDesc{args.in[24], WGU, DFF, DFF, 1024, (nb >> 2) * 256 + (nb & 3) * 32 + 128, r / 88, nb, args.in[22]}; } r -= IFF;
        if (r < IDN) return TrDesc{args.in[25], WD, 1024, 1024, DFF, 32 * (r % 32), r / 32, r % 32, nullptr}; r -= IDN;
        const int q = r / ICM, rr = r % ICM;
        return TrDesc{((q >> 1) ? args.in[17] : args.in[15]) + (size_t)(q & 1) * 1024 * 256, WC1, 256, 256, 1024, q * 256 + 32 * (rr % 8), rr / 8, rr % 8, nullptr};
    };
    if (gw < NITEMS) {
        TrDesc dc = desc(gw); float vc[32]; tr_load(dc, vc, lane);
#pragma unroll 1
        for (int it = gw; it < NITEMS; it += NGW) {
            const bool more = it + NGW < NITEMS; TrDesc dn = desc(more ? it + NGW : it); float vn[32]; tr_load(dn, vn, lane);
            tr_finish(dc, vc, scr, lane);
            dc = dn;
#pragma unroll
            for (int i = 0; i < 32; ++i) vc[i] = vn[i];
        }
    }
    bf16* XN = (bf16*)(F.ws + WS_XN);
    for (int m = gw; m < S; m += 2 * NGW) rms_rows2_to_bf16(args.in[0] + (size_t)m * DM, args.in[0] + (size_t)(m + NGW) * DM, args.in[1], XN + (size_t)m * DM, XN + (size_t)(m + NGW) * DM, lane);
}

__device__ __forceinline__ int crow(int r, int hi) { return (r & 3) + 8 * (r >> 2) + 4 * hi; }
template <bool FINAL>
__device__ __forceinline__ void s5_unit(const Frame& F, const Args& args, int c, int g, LAS unsigned char* wl, LAS unsigned char* wx) {
    const int lane = F.lane, hi = lane >> 5;
    const bf16* U = (const bf16*)(F.ws + WS_U); bf16* Z = (bf16*)(F.ws + WS_Z);
    bf16x8 bfg[4], cfg[4], ua[8];
#pragma unroll
    for (int sub = 0; sub < 8; ++sub) ua[sub] = *(const bf16x8*)(U + (size_t)(c * 256 + sub * 32 + (lane & 31)) * 512 + g * 16 + 8 * hi);
#pragma unroll
    for (int nt = 0; nt < 4; ++nt) bfg[nt] = ((const bf16x8*)(F.ws + WS_TAB + TAB_BF))[(g * 4 + nt) * 64 + lane];
    const f32x2 lam = ((const f32x2*)(F.ws + WS_TAB + TAB_LAM))[g * 64 + lane];
    f32x2* Fst = (f32x2*)(F.ws + WS_F);
    float xr = 0.f, xi = 0.f, dsk = 0.f;
    if (FINAL) {
#pragma unroll
        for (int ks = 0; ks < 4; ++ks) cfg[ks] = ((const bf16x8*)(F.ws + WS_TAB + TAB_CF))[(g * 4 + ks) * 64 + lane];
        dsk = args.in[10][g * 16 + (lane & 15)];
        const f32x2 L2 = ((const f32x2*)(F.ws + WS_TAB + TAB_LAM256))[g * 64 + lane];
#pragma unroll 1
        for (int cp0 = 0; cp0 < c; cp0 += 16) { f32x2 fb[16];
#pragma unroll
            for (int i = 0; i < 16; ++i) fb[i] = Fst[(min(cp0 + i, c - 1) * 32 + g) * 64 + lane];
#pragma unroll
            for (int i = 0; i < 16; ++i) if (cp0 + i < c) { const float nr = L2.x * xr - L2.y * xi + fb[i].x, ni = L2.x * xi + L2.y * xr + fb[i].y; xr = nr; xi = ni; } }
    }
#pragma unroll
    for (int sub = 0; sub < 8; ++sub) {
        const int t0 = c * 256 + sub * 32;
        const bf16x8 a = ua[sub];
        if (FINAL) *(LAS bf16x8*)(wx + (lane & 31) * 32 + hi * 16) = a;
#pragma unroll
        for (int nt = 0; nt < 4; ++nt) { f32x16 acc = {}; acc = __builtin_amdgcn_mfma_f32_32x32x16_bf16(a, bfg[nt], acc, 0, 0, 0);
#pragma unroll
            for (int r = 0; r < 16; ++r) ((LAS float*)wl)[crow(r, hi) * 128 + 32 * nt + (lane & 31)] = acc[r]; }
        LDS_WAIT();
        f32x2 bu[32];
#pragma unroll
        for (int tk = 0; tk < 32; ++tk) bu[tk] = ((const LAS f32x2*)wl)[tk * 64 + lane];
        LDS_WAIT();
#pragma unroll
        for (int tk = 0; tk < 32; ++tk) { const float nr = lam.x * xr - lam.y * xi + bu[tk].x, ni = lam.x * xi + lam.y * xr + bu[tk].y; xr = nr; xi = ni;
            if (FINAL) ((LAS unsigned*)wl)[tk * 128 + ((lane + 4 * tk) & 63)] = pk2(xr, xi); }
        if (FINAL) {
            LDS_WAIT();
            LAS unsigned short* zt = (LAS unsigned short*)(wx + 1024);
#pragma unroll
            for (int mt = 0; mt < 2; ++mt) { f32x4 y4 = {0.f, 0.f, 0.f, 0.f}; const int row = 16 * mt + (lane & 15);
#pragma unroll
                for (int ks = 0; ks < 4; ++ks) { const bf16x8 xa = *(const LAS bf16x8*)(wl + row * 512 + ((64 * ks + 16 * (lane >> 4) + 16 * row) & 255)); y4 = __builtin_amdgcn_mfma_f32_16x16x32_bf16(xa, cfg[ks], y4, 0, 0, 0); }
#pragma unroll
                for (int r = 0; r < 4; ++r) { const int tok = 16 * mt + 4 * (lane >> 4) + r; const float uu = bf2f(((const LAS unsigned short*)wx)[tok * 16 + (lane & 15)]);
                    zt[tok * 16 + (lane & 15)] = (unsigned short)f2bf(gelu_tanh(y4[r] + dsk * uu)); } }
            LDS_WAIT();
            *(v4u*)(Z + (size_t)(t0 + (lane >> 1)) * 512 + g * 16 + 8 * (lane & 1)) = *(const LAS v4u*)(wx + 1024 + lane * 16);
            LDS_WAIT();
        }
    }
    if (!FINAL) Fst[(c * 32 + g) * 64 + lane] = (f32x2){xr, xi};
}

__device__ __forceinline__ int krow(int s, int h, int j) { return 16 * s + 8 * (j >> 2) + 4 * h + (j & 3); }
__device__ __forceinline__ void cmp_l2_unit(const Frame& F, const Args& args, int kv, int g, int n, LAS float* hb, const LAS float* w2s) {
    const int lane = F.lane; const float* P1 = F.out;
    float o = 0.f;
    if (n < NCMP) {
        const int rt = kv * 2048 + g * 1024 + n;
        const float* posb = (const float*)(F.ws + WS_TAB + TAB_POSB) + kv * 16 * 256;
#pragma unroll
        for (int i = 0; i < 4; ++i) { const int j = lane + 64 * i; float a = 0.f;
#pragma unroll
            for (int ks = 0; ks < CMP_KS; ++ks) a += P1[((size_t)ks * 4096 + rt) * 512 + j] + P1[((size_t)ks * 4096 + rt + 1) * 512 + 256 + j];
#pragma unroll
            for (int p = 0; p < 16; ++p) a += posb[p * 256 + j];
            hb[j] = gelu_tanh(a); }
        LDS_WAIT();
#pragma unroll 8
        for (int j = 0; j < 256; ++j) o += hb[j] * w2s[j * 64 + lane];
    }
    if (kv == 0) ((bf16*)(F.ws + WS_KCB))[((size_t)g * 1024 + n) * 64 + lane] = (bf16)f2bf(o);
    else { const int grp = n >> 5, kk = n & 31, sx = kk >> 4, rem = kk & 15, hh = (rem >> 2) & 1, j = ((rem >> 3) << 2) | (rem & 3), d0 = lane >> 5, ln = hh * 32 + (lane & 31);
        ((bf16*)(F.ws + WS_VTC))[((((size_t)(g * 32 + grp) * 2 + d0) * 2 + sx) * 64 + ln) * 8 + j] = (bf16)f2bf(o); }
    LDS_WAIT();
}
__device__ __forceinline__ void vtw_item(const Frame& F, int g, int grp, LAS unsigned short* tl) {
    const int lane = F.lane, hi = lane >> 5; const bf16* V = (const bf16*)(F.ws + WS_KVH) + (size_t)(10 + g) * S * 64 + (size_t)32 * grp * 64;
#pragma unroll
    for (int e = 0; e < 4; ++e) ((LAS v4u*)tl)[lane + 64 * e] = ((const v4u*)V)[lane + 64 * e];
    LDS_WAIT();
#pragma unroll
    for (int d0 = 0; d0 < 2; ++d0)
#pragma unroll
        for (int sx = 0; sx < 2; ++sx) { unsigned w[4];
#pragma unroll
            for (int jj = 0; jj < 4; ++jj) { const unsigned a = tl[krow(sx, hi, 2 * jj) * 64 + 32 * d0 + (lane & 31)], b = tl[krow(sx, hi, 2 * jj + 1) * 64 + 32 * d0 + (lane & 31)]; w[jj] = a | (b << 16); }
            ((v4u*)(F.ws + WS_VTW))[(((size_t)(g * 512 + grp) * 2 + d0) * 2 + sx) * 64 + lane] = (v4u){w[0], w[1], w[2], w[3]}; }
    LDS_WAIT();
}
__device__ __forceinline__ int kap(int ks, int q, int j) { return 16 * (2 * ks + (j >> 2)) + 4 * q + (j & 3); }
__device__ __forceinline__ void vts_item(const Frame& F, int g, int blk, LAS unsigned short* tl) {
    const int lane = F.lane, q = lane >> 4; const bf16* V = (const bf16*)(F.ws + WS_KVH) + (size_t)(6 + g) * S * 64 + (size_t)64 * blk * 64;
#pragma unroll
    for (int e = 0; e < 8; ++e) ((LAS v4u*)tl)[lane + 64 * e] = ((const v4u*)V)[lane + 64 * e];
    LDS_WAIT();
#pragma unroll
    for (int dt = 0; dt < 4; ++dt)
#pragma unroll
        for (int ks = 0; ks < 2; ++ks) { unsigned w[4];
#pragma unroll
            for (int jj = 0; jj < 4; ++jj) { const unsigned a = tl[kap(ks, q, 2 * jj) * 64 + 16 * dt + (lane & 15)], b = tl[kap(ks, q, 2 * jj + 1) * 64 + 16 * dt + (lane & 15)]; w[jj] = a | (b << 16); }
            ((v4u*)(F.ws + WS_VTS))[(((size_t)(g * 256 + blk) * 4 + dt) * 2 + ks) * 64 + lane] = (v4u){w[0], w[1], w[2], w[3]}; }
    LDS_WAIT();
}

constexpr int AT_SC = 0;
constexpr int AT_SEL = 67584;
constexpr int AT_CNT = AT_SEL + 4096;
constexpr int AT_LIST = AT_CNT + 1024;
constexpr int AT_BT = AT_LIST + 32768;
constexpr int AT_PARK = AT_BT + 4096;
constexpr int AT_TILE = AT_PARK + 32768;
constexpr int AT_END = AT_TILE + 16384;
static_assert(AT_END <= LDS_BYTES - 64, "attention LDS map");
constexpr int PSLOTS = 832, PSLAB = 458752;
constexpr int PML_OFF = PSLOTS * 512;
constexpr int SCS = 264;
constexpr int XRN = 624;

__device__ __forceinline__ bf16x8 pack8(float a0, float a1, float a2, float a3, float a4, float a5, float a6, float a7) {
    v4u w; w.x = cvt_pk_bf16(a0, a1); w.y = cvt_pk_bf16(a2, a3); w.z = cvt_pk_bf16(a4, a5); w.w = cvt_pk_bf16(a6, a7); return __builtin_bit_cast(bf16x8, w);
}
__device__ __forceinline__ float xmax32(float v) { auto r = __builtin_amdgcn_permlane32_swap(__float_as_uint(v), __float_as_uint(v), false, false); return fmaxf(__uint_as_float(r[0]), __uint_as_float(r[1])); }
__device__ __forceinline__ float xsum32(float v) { auto r = __builtin_amdgcn_permlane32_swap(__float_as_uint(v), __float_as_uint(v), false, false); return __uint_as_float(r[0]) + __uint_as_float(r[1]); }
__device__ __forceinline__ float xmax16(float v) { auto r = __builtin_amdgcn_permlane16_swap(__float_as_uint(v), __float_as_uint(v), false, false); return fmaxf(__uint_as_float(r[0]), __uint_as_float(r[1])); }
__device__ __forceinline__ float xsum16(float v) { auto r = __builtin_amdgcn_permlane16_swap(__float_as_uint(v), __float_as_uint(v), false, false); return __uint_as_float(r[0]) + __uint_as_float(r[1]); }
__device__ __forceinline__ float max16(const f32x16& a) {
    const float m0 = fmaxf(fmaxf(a[0], a[1]), fmaxf(a[2], a[3])), m1 = fmaxf(fmaxf(a[4], a[5]), fmaxf(a[6], a[7])), m2 = fmaxf(fmaxf(a[8], a[9]), fmaxf(a[10], a[11])), m3 = fmaxf(fmaxf(a[12], a[13]), fmaxf(a[14], a[15]));
    return fmaxf(fmaxf(m0, m1), fmaxf(m2, m3)); }
__device__ __forceinline__ float sum16(const f32x16& a) {
    const float s0 = (a[0] + a[1]) + (a[2] + a[3]), s1 = (a[4] + a[5]) + (a[6] + a[7]), s2 = (a[8] + a[9]) + (a[10] + a[11]), s3 = (a[12] + a[13]) + (a[14] + a[15]);
    return (s0 + s1) + (s2 + s3); }
__device__ __forceinline__ int fenc(float f) { int k = __float_as_int(f); return k ^ ((k >> 31) & 0x7fffffff); }
__device__ __forceinline__ float fdec(int k) { return __int_as_float(k ^ ((k >> 31) & 0x7fffffff)); }
#define MFMA32(a, b, c) __builtin_amdgcn_mfma_f32_32x32x16_bf16((a), (b), (c), 0, 0, 0)
#define MFMA16(a, b, c) __builtin_amdgcn_mfma_f32_16x16x32_bf16((a), (b), (c), 0, 0, 0)
#define DPPI(x, ctrl) __builtin_amdgcn_update_dpp(0, (x), (ctrl), 0xF, 0xF, false)

struct AttnPtrs { const bf16* Q; const bf16* KCB; const bf16x8* VTC; const bf16* KW; const bf16x8* VTW; const bf16* KS; const bf16x8* VTS; const bf16* GN; bf16* O; };

__device__ __forceinline__ void attn_stageA(const AttnPtrs& P, int lane, int wave, int tile0, int g, LAS unsigned char* lds) {
    const int hi = lane >> 5, c32 = lane & 31, ti = c32 >> 2, hr = c32 & 3, h = g * 4 + hr, t0 = tile0 + 8 * wave, t = t0 + ti;
    LAS float* scores = (LAS float*)(lds + AT_SC) + (8 * wave) * SCS; const LAS float* BT = (const LAS float*)(lds + AT_BT); LAS int* sel = (LAS int*)(lds + AT_SEL) + (8 * wave) * 16;
    for (int k = lane; k < 8 * SCS / 4; k += 64) ((LAS f32x4*)scores)[k] = (f32x4){0.f, 0.f, 0.f, 0.f};
    bf16x8 bq[4];
#pragma unroll
    for (int ks = 0; ks < 4; ++ks) bq[ks] = *(const bf16x8*)(P.Q + (size_t)t * 512 + h * 64 + 16 * ks + 8 * hi);
    const float cb = BT[hr * 256 + 64];
    const float g0 = bf2f(P.GN[(size_t)t * 32 + h * 3 + 0]), g2 = bf2f(P.GN[(size_t)t * 32 + h * 3 + 2]);
    {   LAS float* XR = (LAS float*)(lds + AT_LIST);
        for (int i = wave * 64 + lane; i < 4 * XRN; i += NWAVES * 64) { const int hh = i / XRN, d = 575 - (i - hh * XRN); XR[i] = (d < 0 || d >= 512) ? -1e30f : BT[hh * 256 + 191 - min(d, 127)]; } }
    LDS_WAIT();
    const int tid = wave * 64 + lane; LAS unsigned char* tb = lds + AT_TILE;
    const int ldrow = tid >> 3, ldch = tid & 7; const unsigned stoff = (tid < 256) ? (unsigned)(ldrow * 128 + ((ldch ^ (ldrow & 7)) << 4)) : (unsigned)(8192 + (tid - 256) * 16);
    const unsigned kof = (unsigned)(c32 * 128), ksw = (unsigned)(c32 & 7);
#define KFRAG(buf, ks) (*(const LAS bf16x8*)(tb + (buf) * 4096 + kof + ((((ks) * 2 + hi) ^ ksw) << 4)))
#define VFRAG(buf, f) (*(const LAS bf16x8*)(tb + 8192 + (buf) * 4096 + ((f) * 64 + lane) * 16))
#define STAGE_LOAD(Kp, kmax, VTp, gmax, n0v) ((tid < 256) ? *(const v4u*)((Kp) + (size_t)min((n0v) + ldrow, (kmax)) * 64 + ldch * 8) : *(const v4u*)((VTp) + (size_t)min((n0v) >> 5, (gmax)) * 256 + (tid - 256)))
#define STAGE_WRITE(v, buf) (*(LAS v4u*)(tb + (buf) * 4096 + stoff) = (v))
#define FRAG_WAIT(fr) asm volatile("s_waitcnt lgkmcnt(0)" : "+v"(fr[0]), "+v"(fr[1]), "+v"(fr[2]), "+v"(fr[3]) :: "memory")
#define KLOAD(kfr, buf) bf16x8 kfr[4]; { _Pragma("unroll") for (int ks = 0; ks < 4; ++ks) kfr[ks] = KFRAG(buf, ks); FRAG_WAIT(kfr); }
#define VLOAD(vfr, buf) bf16x8 vfr[4]; { _Pragma("unroll") for (int f = 0; f < 4; ++f) vfr[f] = VFRAG(buf, f); }
#define PVACC(o0v, o1v, vfr, a) do { const bf16x8 p0_ = pack8(a[0], a[1], a[2], a[3], a[4], a[5], a[6], a[7]), p1_ = pack8(a[8], a[9], a[10], a[11], a[12], a[13], a[14], a[15]); FRAG_WAIT(vfr); \
        o0v = MFMA32(vfr[0], p0_, o0v); o0v = MFMA32(vfr[1], p1_, o0v); o1v = MFMA32(vfr[2], p0_, o1v); o1v = MFMA32(vfr[3], p1_, o1v); } while (0)
    constexpr float SM_THR = 8.0f;
#define REF_EVENT(a, mref, started, d, fs) { const float tm_ = xmax32(max16(a)); const bool need_ = started ? (tm_ > SM_THR) : (tm_ > -1e29f); d = 0.f; fs = 1.f; \
        if (__any(need_)) { d = need_ ? tm_ : 0.f; fs = (need_ && started) ? __builtin_amdgcn_exp2f(-d) : 1.f; mref += d; started = started || need_; _Pragma("unroll") for (int r = 0; r < 16; ++r) a[r] -= d; } }
    const int ncb = (tile0 + 63 >= 31) ? min((tile0 + 63 - 31) / 16 + 1, NCMP) : 0, ntc = (ncb + 31) >> 5;
    const int nfar = (t0 >= 144) ? (t0 - 144) / 16 + 1 : 0;
#define CSCORE(a, buf, n0v, farv, refv) do { KLOAD(kfr_, buf) { const float ini_ = ((farv) ? cb : 0.f) - (refv); _Pragma("unroll") for (int r = 0; r < 16; ++r) a[r] = ini_; } \
        _Pragma("unroll") for (int ks = 0; ks < 4; ++ks) a = MFMA32(kfr_[ks], bq[ks], a); \
        if (!(farv)) { _Pragma("unroll") for (int r = 0; r < 16; ++r) { const int dist = t - (16 * ((n0v) + crow(r, hi)) + 31); a[r] += BT[hr * 256 + 191 - max(min(dist, 127), -1)]; } } } while (0)
#define STAGE_PROLOGUE(Kp, kmax, VTp, gmax, nbase, ntl) v4u RA, RB; { RA = STAGE_LOAD(Kp, kmax, VTp, gmax, nbase); STAGE_WRITE(RA, 0); RB = STAGE_LOAD(Kp, kmax, VTp, gmax, (nbase) + 32 * min(1, (ntl) - 1)); __syncthreads(); }
    float mc = 0.f, lc = 0.f; bool stc = false;
    if (ntc > 0) {
        STAGE_PROLOGUE(P.KCB, 1023, P.VTC, 31, 0, ntc)
#define C1STEP(iv, BUF, RL, RW) { const int i = (iv); if (i >= ntc) break; const int n0 = 32 * i; RL = STAGE_LOAD(P.KCB, 1023, P.VTC, 31, 32 * min(i + 2, ntc - 1)); \
            const bool far = (n0 + 32 <= nfar); f32x16 a; CSCORE(a, BUF, n0, far, mc); \
            float d_, fs_; REF_EVENT(a, mc, stc, d_, fs_) lc *= fs_; \
            _Pragma("unroll") for (int r = 0; r < 16; ++r) a[r] = __builtin_amdgcn_exp2f(a[r]); \
            lc += xsum32(sum16(a)); STAGE_WRITE(RW, (BUF) ^ 1); __syncthreads(); }
        for (int ib = 0; ; ib += 2) { C1STEP(ib, 0, RA, RB) C1STEP(ib + 1, 1, RB, RA) }
#undef C1STEP
    }
    {   const float invl = 1.0f / fmaxf(lc, 1e-30f); f32x16 oc0 = {}, oc1 = {}; float carry = 0.f;
#define CIMP(a, n0v) do { float mq[4], cq[4]; \
            _Pragma("unroll") for (int qg = 0; qg < 4; ++qg) { float mv = (2.0f * (a[4 * qg] + a[4 * qg + 1] + a[4 * qg + 2]) + a[4 * qg + 3]) * invl, cv = a[4 * qg + 3] * invl; \
                mv += __int_as_float(DPPI(__float_as_int(mv), 0xB1)); mv += __int_as_float(DPPI(__float_as_int(mv), 0x4E)); \
                cv += __int_as_float(DPPI(__float_as_int(cv), 0xB1)); cv += __int_as_float(DPPI(__float_as_int(cv), 0x4E)); mq[qg] = mv; cq[qg] = cv; } \
            float oth[4]; \
            _Pragma("unroll") for (int qg = 0; qg < 4; ++qg) { auto rr = __builtin_amdgcn_permlane32_swap(__float_as_uint(cq[qg]), __float_as_uint(cq[qg]), false, false); oth[qg] = __uint_as_float(hi ? rr[0] : rr[1]); } \
            _Pragma("unroll") for (int qg = 0; qg < 4; ++qg) { const float tot = mq[qg] + (hi ? oth[qg] : (qg ? oth[qg - 1] : carry)); if (hr == 0) scores[ti * SCS + (((n0v) + 8 * qg + 4 * hi) >> 2)] = tot; } \
            carry = oth[3]; } while (0)
        if (ntc > 0) {
            STAGE_PROLOGUE(P.KCB, 1023, P.VTC, 31, 0, ntc)
#define C2STEP(iv, BUF, RL, RW) { const int i = (iv); if (i >= ntc) break; const int n0 = 32 * i; RL = STAGE_LOAD(P.KCB, 1023, P.VTC, 31, 32 * min(i + 2, ntc - 1)); \
                const bool far = (n0 + 32 <= nfar); f32x16 a; CSCORE(a, BUF, n0, far, mc); VLOAD(vfr_, BUF) \
                _Pragma("unroll") for (int r = 0; r < 16; ++r) a[r] = __builtin_amdgcn_exp2f(a[r]); \
                CIMP(a, n0); PVACC(oc0, oc1, vfr_, a); STAGE_WRITE(RW, (BUF) ^ 1); __syncthreads(); }
            for (int ib = 0; ; ib += 2) { C2STEP(ib, 0, RA, RB) C2STEP(ib + 1, 1, RB, RA) }
#undef C2STEP
            { const int jn = ntc * 8; if (jn < 256 && hi == 0 && hr == 0) scores[ti * SCS + jn] = carry; }
        }
#undef CIMP
        {   LAS unsigned char* park = lds + AT_PARK + (((8 * wave + ti) * 4 + hr) * 64) * 2;
            const float gs = g0 * invl;
#pragma unroll
            for (int d0 = 0; d0 < 2; ++d0)
#pragma unroll
                for (int r4 = 0; r4 < 4; ++r4) { const f32x16& Wd = d0 ? oc1 : oc0; const int dim = 32 * d0 + 8 * r4 + 4 * hi;
                    *(LAS unsigned long long*)(park + dim * 2) = (unsigned long long)cvt_pk_bf16(Wd[4 * r4] * gs, Wd[4 * r4 + 1] * gs) | ((unsigned long long)cvt_pk_bf16(Wd[4 * r4 + 2] * gs, Wd[4 * r4 + 3] * gs) << 32); } } }
#undef CSCORE
    {   float mw = 0.f, lw = 0.f; bool stw = false; f32x16 o0 = {}, o1 = {};
        const int nlo = max(t0 - 511, 0) & ~31, nhi = (t0 + 7) & ~31;
        const int nlb = max(tile0 - 511, 0) & ~31, ntw = (((tile0 + 63) & ~31) - nlb) / 32 + 1;
        const LAS float* xrb = (const LAS float*)(lds + AT_LIST) + hr * XRN + (575 - ti + 4 * hi);
        STAGE_PROLOGUE(P.KW, S - 1, P.VTW, 511, nlb, ntw)
#define WSTEP(iv, BUF, RL, RW) { const int i = (iv); if (i >= ntw) break; const int n0 = nlb + 32 * i; RL = STAGE_LOAD(P.KW, S - 1, P.VTW, 511, nlb + 32 * min(i + 2, ntw - 1)); \
            if (n0 >= nlo && n0 <= nhi) { const bool mid = (n0 >= t0 - 504) && (n0 <= t0 - 144); \
                f32x16 a; if (mid) { const float ini_ = cb - mw; _Pragma("unroll") for (int r = 0; r < 16; ++r) a[r] = ini_; } \
                else { const LAS float* xr_ = xrb + (n0 - t0); _Pragma("unroll") for (int r = 0; r < 16; ++r) a[r] = xr_[(r & 3) + 8 * (r >> 2)] - mw; } \
                { KLOAD(kfr_, BUF) _Pragma("unroll") for (int ks = 0; ks < 4; ++ks) a = MFMA32(kfr_[ks], bq[ks], a); } VLOAD(vfr_, BUF) \
                float d_, fs_; REF_EVENT(a, mw, stw, d_, fs_) if (fs_ != 1.f || d_ != 0.f) { lw *= fs_; o0 = o0 * fs_; o1 = o1 * fs_; } \
                _Pragma("unroll") for (int r = 0; r < 16; ++r) a[r] = __builtin_amdgcn_exp2f(a[r]); \
                lw += xsum32(sum16(a)); PVACC(o0, o1, vfr_, a); } \
            STAGE_WRITE(RW, (BUF) ^ 1); __syncthreads(); }
        for (int ib = 0; ; ib += 2) { WSTEP(ib, 0, RA, RB) WSTEP(ib + 1, 1, RB, RA) }
#undef WSTEP
        const float sc = g2 / fmaxf(lw, 1e-30f);
        LAS unsigned char* park = lds + AT_PARK + (((8 * wave + ti) * 4 + hr) * 64) * 2;
#pragma unroll
        for (int d0 = 0; d0 < 2; ++d0)
#pragma unroll
            for (int r4 = 0; r4 < 4; ++r4) { const f32x16& Od = d0 ? o1 : o0; const int dim = 32 * d0 + 8 * r4 + 4 * hi; const unsigned long long w = *(const LAS unsigned long long*)(park + dim * 2); const unsigned lo = (unsigned)w, hw = (unsigned)(w >> 32);
                *(LAS unsigned long long*)(park + dim * 2) = (unsigned long long)cvt_pk_bf16(bflo(lo) + Od[4 * r4] * sc, bfhi(lo) + Od[4 * r4 + 1] * sc) | ((unsigned long long)cvt_pk_bf16(bflo(hw) + Od[4 * r4 + 2] * sc, bfhi(hw) + Od[4 * r4 + 3] * sc) << 32); } }
#undef REF_EVENT
#undef STAGE_PROLOGUE
#undef PVACC
#undef KLOAD
#undef FRAG_WAIT
#undef VLOAD
#undef KFRAG
#undef VFRAG
#undef STAGE_LOAD
#undef STAGE_WRITE
    LDS_WAIT();
    {   const int cur = tile0 >> 6, i = lane >> 3, s8 = lane & 7;
        if (cur + 1 <= 16) { for (int e = lane; e < 8 * 16; e += 64) sel[e] = e & 15; }
        else {
            float sv[32];
#pragma unroll
            for (int k = 0; k < 32; ++k) { const int j = s8 + 8 * k; sv[k] = (j >= 1 && j <= cur - 2) ? scores[i * SCS + j] : -3e38f; }
            if (s8 == 0) { sel[i * 16 + 0] = 0; sel[i * 16 + 1] = cur - 1; sel[i * 16 + 2] = cur; }
            for (int it = 3; it < 16; ++it) {
                float bv = sv[0]; int bj = s8;
#pragma unroll
                for (int k = 1; k < 32; ++k) if (sv[k] > bv) { bv = sv[k]; bj = s8 + 8 * k; }
#define SEL_STEP(ctrl) { const float ov = __int_as_float(DPPI(__float_as_int(bv), ctrl)); const int oj = DPPI(bj, ctrl); if (ov > bv || (ov == bv && oj < bj)) { bv = ov; bj = oj; } }
                SEL_STEP(0xB1) SEL_STEP(0x4E) SEL_STEP(0x141)
#undef SEL_STEP
                if (s8 == 0) sel[i * 16 + it] = bj;
#pragma unroll
                for (int k = 0; k < 32; ++k) if (bj == s8 + 8 * k) sv[k] = -3e38f;
            }
        }
    }
}

__device__ __forceinline__ void s_scores(const bf16x8 (&kf)[8], const bf16x8 q0, const bf16x8 q1, bool cst, float cbs, const LAS float* BT, int hd, int tt, int j, int q, float sub, f32x4 (&sa)[4]) {
    if (cst) {
#pragma unroll
        for (int mt = 0; mt < 4; ++mt) { const float ini = cbs - sub; sa[mt] = (f32x4){ini, ini, ini, ini}; } }
    else { const LAS float* xb = BT + hd * 256 + (191 - tt + 64 * j + 4 * q);
#pragma unroll
        for (int mt = 0; mt < 4; ++mt)
#pragma unroll
            for (int r = 0; r < 4; ++r) sa[mt][r] = xb[16 * mt + r] - sub; }
#pragma unroll
    for (int mt = 0; mt < 4; ++mt) { sa[mt] = MFMA16(kf[mt * 2], q0, sa[mt]); sa[mt] = MFMA16(kf[mt * 2 + 1], q1, sa[mt]); }
}
template <bool MASKED> __device__ __forceinline__ void s_softmax(f32x4 (&sa)[4], float& tm, float& ls) {
    tm = sa[0][0];
#pragma unroll
    for (int mt = 0; mt < 4; ++mt)
#pragma unroll
        for (int r = 0; r < 4; ++r) tm = fmaxf(tm, sa[mt][r]);
    tm = xmax32(xmax16(tm)); ls = 0.f;
#pragma unroll
    for (int mt = 0; mt < 4; ++mt)
#pragma unroll
        for (int r = 0; r < 4; ++r) { const float e = __builtin_amdgcn_exp2f(sa[mt][r] - tm); sa[mt][r] = (!MASKED || sa[mt][r] > -1e29f) ? e : 0.f; ls += sa[mt][r]; }
    ls = xsum32(xsum16(ls));
}
__device__ __forceinline__ void load_kf(const AttnPtrs& P, int lane, int j, bf16x8 (&kf)[8]) {
    const bf16* kp = P.KS + (size_t)(64 * j + (lane & 15)) * 64 + 8 * (lane >> 4);
#pragma unroll
    for (int mt = 0; mt < 4; ++mt) { kf[mt * 2] = *(const bf16x8*)(kp + (size_t)mt * 16 * 64); kf[mt * 2 + 1] = *(const bf16x8*)(kp + (size_t)mt * 16 * 64 + 32); }
}
__device__ __forceinline__ void load_vf(const AttnPtrs& P, int lane, int j, bf16x8 (&vf)[8]) {
    const bf16x8* vt = P.VTS + (size_t)j * 8 * 64 + lane;
#pragma unroll
    for (int e = 0; e < 8; ++e) vf[e] = vt[e * 64];
}
__device__ __forceinline__ void s_chunk(const bf16x8 (&kf)[8], const bf16x8 (&vf)[8], int j, int ch, int n, bool cst, float cbs, const LAS float* BT, const LAS unsigned short* list,
                                        const LAS unsigned char* qt, unsigned char* slab, int tile0, int c, int q, int hd, int hs) {
    const int sidx = 4 * ch + (c >> 2); const bool valid = sidx < n; const int sl = (int)list[j * 64 + (valid ? sidx : 0)]; const int tokl = sl / 13, r = tokl * 4 + hd;
    const LAS unsigned char* qr = qt + r * 128; const bf16x8 q0 = *(const LAS bf16x8*)(qr + ((q ^ (r & 7)) << 4)), q1 = *(const LAS bf16x8*)(qr + (((q + 4) ^ (r & 7)) << 4));
    float tm = ((const LAS float*)(qt + 65536))[r], ls; f32x4 sa[4]; bool second = false;
#pragma unroll 1
    for (;;) {
        s_scores(kf, q0, q1, cst, cbs, BT, hd, tile0 + tokl, j, q, tm, sa);
        if (second) { float mx = sa[0][0];
#pragma unroll
            for (int mt = 0; mt < 4; ++mt)
#pragma unroll
                for (int r4 = 0; r4 < 4; ++r4) mx = fmaxf(mx, sa[mt][r4]);
            mx = xmax32(xmax16(mx)); tm += mx;
#pragma unroll
            for (int mt = 0; mt < 4; ++mt)
#pragma unroll
                for (int r4 = 0; r4 < 4; ++r4) sa[mt][r4] -= mx; }
        ls = 0.f;
#pragma unroll
        for (int mt = 0; mt < 4; ++mt)
#pragma unroll
            for (int r4 = 0; r4 < 4; ++r4) { sa[mt][r4] = __builtin_amdgcn_exp2f(sa[mt][r4]); ls += sa[mt][r4]; }
        ls = xsum32(xsum16(ls));
        if (second || !__any(!(ls < 1e30f))) break;
        second = true; }
    const bf16x8 p0 = pack8(sa[0][0], sa[0][1], sa[0][2], sa[0][3], sa[1][0], sa[1][1], sa[1][2], sa[1][3]), p1 = pack8(sa[2][0], sa[2][1], sa[2][2], sa[2][3], sa[3][0], sa[3][1], sa[3][2], sa[3][3]);
    unsigned char* po = slab + ((size_t)(sl * 4 + hd) * 64 + 16 * q) * 2;
    unsigned pw[8];
#pragma unroll
    for (int dt = 0; dt < 4; ++dt) { f32x4 oa = {0.f, 0.f, 0.f, 0.f}; oa = MFMA16(vf[dt * 2], p0, oa); oa = MFMA16(vf[dt * 2 + 1], p1, oa); pw[2 * dt] = cvt_pk_bf16(oa[0], oa[1]); pw[2 * dt + 1] = cvt_pk_bf16(oa[2], oa[3]); }
    if (valid) { *(v4u*)po = (v4u){pw[0], pw[1], pw[2], pw[3]}; *(v4u*)(po + 16) = (v4u){pw[4], pw[5], pw[6], pw[7]}; }
    if (valid && q == 0) *(f32x2*)(slab + PML_OFF + (size_t)(sl * 4 + hd) * 8) = (f32x2){tm, ls};
}
__device__ __forceinline__ void attn_stageB(const AttnPtrs& P, int lane, int wave, int tile0, int g, LAS unsigned char* lds, unsigned char* slab) {
    const int T = tile0 >> 6, c = lane & 15, q = lane >> 4, hd = c & 3, hs = g * 4 + hd;
    if (T <= 15) return;
    LAS unsigned* cnt = (LAS unsigned*)(lds + AT_CNT); const LAS unsigned short* list = (const LAS unsigned short*)(lds + AT_LIST); const LAS float* BT = (const LAS float*)(lds + AT_BT);
    const LAS unsigned char* qt = lds + AT_SC;
    const float cbs = BT[hd * 256 + 64];
#define GRAB_ISSUE(tv) { tv = 0; if (lane == 0) tv = (int)__hip_atomic_fetch_add(&cnt[0], 1u, __ATOMIC_RELAXED, __HIP_MEMORY_SCOPE_WORKGROUP); }
#define GRAB_TAKE(tv, jv, nv) { jv = (int)__builtin_amdgcn_readfirstlane(tv) + 1; nv = 0; if (jv <= T - 2) nv = (int)__builtin_amdgcn_readfirstlane((int)cnt[jv]); }
    bf16x8 KA[8], VA[8], KB[8], VB[8];
    int jc, nc, jn, nn;
    { int t0_, t1_; GRAB_ISSUE(t0_) GRAB_ISSUE(t1_) GRAB_TAKE(t0_, jc, nc) if (jc > T - 2) return; GRAB_TAKE(t1_, jn, nn) }
    load_kf(P, lane, jc, KA); load_vf(P, lane, jc, VA);
    load_kf(P, lane, min(jn, T - 2), KB); load_vf(P, lane, min(jn, T - 2), VB);
#define BSTEP(KX, VX) { int t2_; GRAB_ISSUE(t2_) \
        { const bool cst = (jc <= T - 3);        \
          if (nc > 0) s_chunk(KX, VX, jc, 0, nc, cst, cbs, BT, list, qt, slab, tile0, c, q, hd, hs); \
          if (nc > 4) s_chunk(KX, VX, jc, 1, nc, cst, cbs, BT, list, qt, slab, tile0, c, q, hd, hs); \
          if (nc > 8) { _Pragma("unroll 1") for (int ch = 2; 4 * ch < nc; ++ch) s_chunk(KX, VX, jc, ch, nc, cst, cbs, BT, list, qt, slab, tile0, c, q, hd, hs); } } \
        int j2_, n2_; GRAB_TAKE(t2_, j2_, n2_) \
        load_kf(P, lane, min(j2_, T - 2), KX); load_vf(P, lane, min(j2_, T - 2), VX); \
        jc = jn; nc = nn; jn = j2_; nn = n2_; }
    do { BSTEP(KA, VA) BSTEP(KB, VB) } while (jc <= T - 2);
#undef BSTEP
#undef GRAB_ISSUE
#undef GRAB_TAKE
}
struct SState { float M, L; f32x4 O[4]; };
__device__ __forceinline__ void s_merge(SState& st, float m, float l, const f32x4 (&o)[4]) {
    const float mn = fmaxf(st.M, m), a0 = __builtin_amdgcn_exp2f(st.M - mn), a1 = __builtin_amdgcn_exp2f(m - mn);
    st.L = st.L * a0 + l * a1; st.M = mn;
#pragma unroll
    for (int dt = 0; dt < 4; ++dt) st.O[dt] = st.O[dt] * a0 + o[dt] * a1;
}
__device__ __forceinline__ void attn_stageC_forced(const AttnPtrs& P, int lane, int wave, int tile0, int g, LAS unsigned char* lds, SState (&st)[2]) {
    const int T = tile0 >> 6, c = lane & 15, q = lane >> 4, hd = c & 3, hs = g * 4 + hd; const LAS float* BT = (const LAS float*)(lds + AT_BT); const float cbs = BT[hd * 256 + 64];
    bf16x8 q0[2], q1[2];
#pragma unroll
    for (int k = 0; k < 2; ++k) { const int tt = tile0 + 8 * wave + 4 * k + (c >> 2); q0[k] = *(const bf16x8*)(P.Q + (size_t)tt * 512 + hs * 64 + 8 * q); q1[k] = *(const bf16x8*)(P.Q + (size_t)tt * 512 + hs * 64 + 32 + 8 * q);
        st[k].M = -1e30f; st[k].L = 0.f;
#pragma unroll
        for (int dt = 0; dt < 4; ++dt) st[k].O[dt] = (f32x4){0.f, 0.f, 0.f, 0.f}; }
    const int nf = T <= 15 ? T + 1 : 3;
    auto fblk = [&](int it) -> int { return T <= 15 ? it : (it == 0 ? 0 : (it == 1 ? T - 1 : T)); };
    bf16x8 kf[8], vf[8]; load_kf(P, lane, fblk(0), kf); load_vf(P, lane, fblk(0), vf);
#pragma unroll 1
    for (int it = 0; it < nf; ++it) { const int j = fblk(it);
        bf16x8 kn[8]; load_kf(P, lane, fblk(min(it + 1, nf - 1)), kn);
        const bool cst = (j <= T - 3);
#pragma unroll
        for (int k = 0; k < 2; ++k) { const int tt = tile0 + 8 * wave + 4 * k + (c >> 2);
            f32x4 sa[4]; s_scores(kf, q0[k], q1[k], cst, cbs, BT, hd, tt, j, q, 0.f, sa);
            float tm, ls; s_softmax<true>(sa, tm, ls);
            const bf16x8 p0 = pack8(sa[0][0], sa[0][1], sa[0][2], sa[0][3], sa[1][0], sa[1][1], sa[1][2], sa[1][3]), p1 = pack8(sa[2][0], sa[2][1], sa[2][2], sa[2][3], sa[3][0], sa[3][1], sa[3][2], sa[3][3]);
            f32x4 ob[4];
#pragma unroll
            for (int dt = 0; dt < 4; ++dt) { ob[dt] = (f32x4){0.f, 0.f, 0.f, 0.f}; ob[dt] = MFMA16(vf[dt * 2], p0, ob[dt]); ob[dt] = MFMA16(vf[dt * 2 + 1], p1, ob[dt]); }
            s_merge(st[k], tm, ls, ob); }
#pragma unroll
        for (int e = 0; e < 8; ++e) kf[e] = kn[e];
        if (it + 1 < nf) load_vf(P, lane, fblk(it + 1), vf);
    }
}
__device__ __forceinline__ void attn_stageC_forced_lds(const AttnPtrs& P, int lane, int wave, int tile0, int g, LAS unsigned char* lds, SState (&st)[2]) {
    const int T = tile0 >> 6, c = lane & 15, q = lane >> 4, hd = c & 3, hs = g * 4 + hd; const LAS float* BT = (const LAS float*)(lds + AT_BT); const float cbs = BT[hd * 256 + 64];
    bf16x8 q0[2], q1[2];
#pragma unroll
    for (int k = 0; k < 2; ++k) { const int r = (8 * wave + 4 * k + (c >> 2)) * 4 + hd; const LAS unsigned char* qr = lds + AT_SC + r * 128;
        q0[k] = *(const LAS bf16x8*)(qr + ((q ^ (r & 7)) << 4)); q1[k] = *(const LAS bf16x8*)(qr + (((q + 4) ^ (r & 7)) << 4));
        st[k].M = -1e30f; st[k].L = 0.f;
#pragma unroll
        for (int dt = 0; dt < 4; ++dt) st[k].O[dt] = (f32x4){0.f, 0.f, 0.f, 0.f}; }
#pragma unroll
    for (int it = 0; it < 3; ++it) { const int j = it == 0 ? 0 : (it == 1 ? T - 1 : T); const LAS unsigned char* fb = lds + (it == 2 ? AT_TILE : AT_SC + 32768 + 16384 * it);
        bf16x8 kf[8], vf[8];
#pragma unroll
        for (int mt = 0; mt < 4; ++mt) { const int row = 16 * mt + c; kf[mt * 2] = *(const LAS bf16x8*)(fb + row * 128 + ((q ^ (row & 7)) << 4)); kf[mt * 2 + 1] = *(const LAS bf16x8*)(fb + row * 128 + (((q + 4) ^ (row & 7)) << 4)); }
#pragma unroll
        for (int e = 0; e < 8; ++e) vf[e] = *(const LAS bf16x8*)(fb + 8192 + (e * 64 + lane) * 16);
        const bool cst = (it == 0);
#pragma unroll
        for (int k = 0; k < 2; ++k) { const int tt = tile0 + 8 * wave + 4 * k + (c >> 2);
            f32x4 sa[4]; s_scores(kf, q0[k], q1[k], cst, cbs, BT, hd, tt, j, q, 0.f, sa);
            float tm, ls; s_softmax<true>(sa, tm, ls);
            const bf16x8 p0 = pack8(sa[0][0], sa[0][1], sa[0][2], sa[0][3], sa[1][0], sa[1][1], sa[1][2], sa[1][3]), p1 = pack8(sa[2][0], sa[2][1], sa[2][2], sa[2][3], sa[3][0], sa[3][1], sa[3][2], sa[3][3]);
            f32x4 ob[4];
#pragma unroll
            for (int dt = 0; dt < 4; ++dt) { ob[dt] = (f32x4){0.f, 0.f, 0.f, 0.f}; ob[dt] = MFMA16(vf[dt * 2], p0, ob[dt]); ob[dt] = MFMA16(vf[dt * 2 + 1], p1, ob[dt]); }
            s_merge(st[k], tm, ls, ob); } }
}
__device__ __forceinline__ void attn_stageC_merge(const AttnPtrs& P, int lane, int wave, int tile0, int g, LAS unsigned char* lds, const unsigned char* slab, SState (&st)[2]) {
    const int T = tile0 >> 6, c = lane & 15, q = lane >> 4, hd = c & 3, hs = g * 4 + hd;
#pragma unroll
    for (int k = 0; k < 2; ++k) { const int tok = 8 * wave + 4 * k + (c >> 2), tt = tile0 + tok;
        if (T > 15) {
#pragma unroll
            for (int b0 = 0; b0 < 13; b0 += 13) {
                f32x2 mlv[13]; v4u ow[13][2];
#pragma unroll
                for (int bb = 0; bb < 13; ++bb) if (b0 + bb < 13) { const int sl = tok * 13 + b0 + bb;
                    mlv[bb] = *(const f32x2*)(slab + PML_OFF + (size_t)(sl * 4 + hd) * 8);
                    const unsigned char* po = slab + ((size_t)(sl * 4 + hd) * 64 + 16 * q) * 2; ow[bb][0] = *(const v4u*)po; ow[bb][1] = *(const v4u*)(po + 16); }
#pragma unroll
                for (int bb = 0; bb < 13; ++bb) if (b0 + bb < 13) { f32x4 ob[4];
                    ob[0] = (f32x4){bflo(ow[bb][0].x), bfhi(ow[bb][0].x), bflo(ow[bb][0].y), bfhi(ow[bb][0].y)}; ob[1] = (f32x4){bflo(ow[bb][0].z), bfhi(ow[bb][0].z), bflo(ow[bb][0].w), bfhi(ow[bb][0].w)};
                    ob[2] = (f32x4){bflo(ow[bb][1].x), bfhi(ow[bb][1].x), bflo(ow[bb][1].y), bfhi(ow[bb][1].y)}; ob[3] = (f32x4){bflo(ow[bb][1].z), bfhi(ow[bb][1].z), bflo(ow[bb][1].w), bfhi(ow[bb][1].w)};
                    s_merge(st[k], mlv[bb].x, mlv[bb].y, ob); } } }
        const float g1 = bf2f(P.GN[(size_t)tt * 32 + hs * 3 + 1]) / fmaxf(st[k].L, 1e-30f);
        LAS unsigned char* park = lds + AT_PARK + ((tok * 4 + hd) * 64 + 4 * q) * 2;
#pragma unroll
        for (int dt = 0; dt < 4; ++dt) { const unsigned long long w = *(const LAS unsigned long long*)(park + dt * 32); const unsigned lo = (unsigned)w, hw = (unsigned)(w >> 32);
            const unsigned o0 = cvt_pk_bf16(bflo(lo) + g1 * st[k].O[dt][0], bfhi(lo) + g1 * st[k].O[dt][1]), o1 = cvt_pk_bf16(bflo(hw) + g1 * st[k].O[dt][2], bfhi(hw) + g1 * st[k].O[dt][3]);
            *(LAS unsigned long long*)(park + dt * 32) = (unsigned long long)o0 | ((unsigned long long)o1 << 32); } }
    LDS_WAIT();
#pragma unroll
    for (int e = 0; e < 4; ++e) { const int idx = lane + 64 * e, tokl = idx >> 5, piece = idx & 31;
        *(v4u*)((unsigned char*)P.O + (size_t)(tile0 + 8 * wave + tokl) * 1024 + g * 512 + piece * 16) = *(const LAS v4u*)(lds + AT_PARK + (8 * wave + tokl) * 512 + piece * 16); }
    LDS_WAIT();
}
__device__ __forceinline__ void attn_tile(const Frame& F, unsigned char* ws, const float* pbias, int tile, int g, unsigned soff) {
    int lane = F.lane; asm volatile("" : "+v"(lane));
    const int wave = F.wave, tile0 = tile * 64, T = tile; LAS unsigned char* lds = F.lds;
    if (F.tid < 256) ((LAS unsigned*)(lds + AT_CNT))[F.tid] = 0u;
    {   LAS float* BT = (LAS float*)(lds + AT_BT);
        for (int i = F.tid; i < 4 * 256; i += NWAVES * 64) { const int hh = i >> 8, d = 191 - (i & 255); float v = -1e30f;
            if (d >= 0) { const int dd = min(d, 127); int bk = dd; if (dd >= 16) { bk = 16 + (int)(logf((float)dd * (1.0f / 16.0f)) / 2.0794415416798357f * 16.0f); if (bk > 31) bk = 31; }
                v = pbias[bk * 8 + g * 4 + hh] * 1.4426950408889634f; }
            BT[i] = v; } }
    __syncthreads();
    AttnPtrs P;
    {   const bf16* KVH = (const bf16*)(ws + WS_KVH);
        P.Q = (const bf16*)(ws + WS_Q); P.KCB = (const bf16*)(ws + WS_KCB) + (size_t)g * 1024 * 64; P.VTC = (const bf16x8*)(ws + WS_VTC) + (size_t)g * 32 * 4 * 64;
        P.KW = KVH + (size_t)(8 + g) * S * 64; P.VTW = (const bf16x8*)(ws + WS_VTW) + (size_t)g * 512 * 4 * 64; P.GN = (const bf16*)(ws + WS_GN);
        P.KS = nullptr; P.VTS = nullptr; P.O = nullptr; }
    attn_stageA(P, lane, wave, tile0, g, lds);
    __syncthreads();
    unsigned char* ws2 = ws;
    {   const bf16* KVH = (const bf16*)(ws2 + WS_KVH);
        P.Q = (const bf16*)(ws2 + WS_Q); P.KS = KVH + (size_t)(4 + g) * S * 64; P.VTS = (const bf16x8*)(ws2 + WS_VTS) + (size_t)g * 256 * 8 * 64; P.GN = (const bf16*)(ws2 + WS_GN); P.O = (bf16*)(ws2 + WS_O);
        P.KCB = nullptr; P.VTC = nullptr; P.KW = nullptr; P.VTW = nullptr; }
    unsigned char* slab = ((blockIdx.x < 128) ? (unsigned char*)F.out : ws2 + WS_PSLAB) + soff;
    if (T > 15) {
        LAS unsigned* cnt = (LAS unsigned*)(lds + AT_CNT); LAS unsigned short* list = (LAS unsigned short*)(lds + AT_LIST); const LAS int* sel = (const LAS int*)(lds + AT_SEL);
        const int tok = F.tid >> 3;
        v4u qv[4];
#pragma unroll
        for (int e = 0; e < 4; ++e) { const int idx = F.tid + 512 * e, row = idx >> 3, piece = idx & 7; qv[e] = *(const v4u*)((const unsigned char*)P.Q + (size_t)(tile0 + (row >> 2)) * 1024 + g * 512 + (row & 3) * 128 + piece * 16); }
#pragma unroll
        for (int e = 0; e < 2; ++e) { const int b = (F.tid & 7) * 2 + e;
            if (b >= 3) { const int j = sel[tok * 16 + b]; const unsigned pos = __hip_atomic_fetch_add(&cnt[j], 1u, __ATOMIC_RELAXED, __HIP_MEMORY_SCOPE_WORKGROUP); list[j * 64 + pos] = (unsigned short)(tok * 13 + b - 3); } }
#pragma unroll
        for (int e = 0; e < 4; ++e) { const int idx = F.tid + 512 * e, row = idx >> 3, piece = idx & 7; *(LAS v4u*)(lds + AT_SC + row * 128 + ((piece ^ (row & 7)) << 4)) = qv[e]; }
        {   v4u fk[3], fv[3];
#pragma unroll
            for (int e = 0; e < 3; ++e) { const int j = e == 0 ? 0 : (e == 1 ? T - 1 : T); fk[e] = *(const v4u*)((const unsigned char*)P.KS + (size_t)j * 8192 + F.tid * 16); fv[e] = *(const v4u*)((const unsigned char*)P.VTS + (size_t)j * 8192 + F.tid * 16); }
            const int row = F.tid >> 3, piece = F.tid & 7;
#pragma unroll
            for (int e = 0; e < 3; ++e) { LAS unsigned char* fb = lds + (e == 2 ? AT_TILE : AT_SC + 32768 + 16384 * e); *(LAS v4u*)(fb + row * 128 + ((piece ^ (row & 7)) << 4)) = fk[e]; *(LAS v4u*)(fb + 8192 + F.tid * 16) = fv[e]; } }
        __syncthreads(); }
    SState st[2];
    if (T > 15) { attn_stageC_forced_lds(P, lane, wave, tile0, g, lds, st);
        if (lane < 16) {
#pragma unroll
            for (int k = 0; k < 2; ++k) ((LAS float*)(lds + AT_SC + 65536))[(8 * wave + 4 * k + (lane >> 2)) * 4 + (lane & 3)] = st[k].M; }
        __syncthreads(); }
    else attn_stageC_forced(P, lane, wave, tile0, g, lds, st);
    attn_stageB(P, lane, wave, tile0, g, lds, slab);
    asm volatile("s_waitcnt vmcnt(0)" ::: "memory");
    __syncthreads();
    __builtin_amdgcn_fence(__ATOMIC_ACQUIRE, "agent");
    attn_stageC_merge(P, lane, wave, tile0, g, lds, slab, st);
    __syncthreads();
}

#define XB_TMO      128
#define XB_XCNT(j)  (256  + 64 * (j))
#define XB_XSUB(j)  (1280 + 64 * (j))
#define XB_XGEN(j)  (2304 + 64 * (j))
#define XB_TOP      3328
#define XB_TOPGEN   3392
#define XCD_BAR_WORDS 3456
#define XB_SPIN_CAP (1u << 22)
__device__ __forceinline__ unsigned xb_ld(unsigned* p)              { return __hip_atomic_load(p, __ATOMIC_RELAXED, __HIP_MEMORY_SCOPE_AGENT); }
__device__ __forceinline__ unsigned xb_add(unsigned* p, unsigned v) { return __hip_atomic_fetch_add(p, v, __ATOMIC_RELAXED, __HIP_MEMORY_SCOPE_AGENT); }
__device__ __forceinline__ unsigned xb_xcc_id() { return (unsigned)__builtin_amdgcn_s_getreg((3 << 11) | 20) & 0xFu; }
#define XB_SPIN(cond, bar) do { unsigned _sp = 0; while (cond) { __builtin_amdgcn_s_sleep(1); \
    if ((++_sp & 255u) == 0u) { if (xb_ld(&(bar)[XB_TMO])) break; if (_sp > XB_SPIN_CAP) { atomicAdd(&(bar)[XB_TMO], 1u); break; } } } } while (0)
struct XcdBarrier { unsigned* bar; unsigned x; volatile LAS unsigned* st; };
__device__ __forceinline__ XcdBarrier xcd_barrier_post(unsigned* bar, volatile LAS unsigned* st) {
    XcdBarrier b; b.bar = bar; b.x = xb_xcc_id(); b.st = st;
    if (threadIdx.x == 0) (void)xb_add(&bar[XB_XCNT(b.x)], 1u);
    return b;
}
__device__ __forceinline__ void xcd_barrier_complete(unsigned* bar, unsigned x, unsigned& nloc, unsigned& nx) {
    const unsigned G = gridDim.x * gridDim.y * gridDim.z;
    unsigned sum, cnt, mine, sp = 0u;
    for (;;) {
        sum = 0u; cnt = 0u; mine = 0u;
#pragma unroll
        for (unsigned j = 0; j < 16; ++j) { const unsigned c = xb_ld(&bar[XB_XCNT(j)]); sum += c; cnt += (c > 0u) ? 1u : 0u; mine = (j == x) ? c : mine; }
        if (sum == G) break;
        __builtin_amdgcn_s_sleep(1);
        if ((++sp & 255u) == 0u) { if (xb_ld(&bar[XB_TMO])) break; if (sp > XB_SPIN_CAP) { atomicAdd(&bar[XB_TMO], 1u); break; } }
    }
    nloc = mine > 0u ? mine : 1u; nx = cnt > 0u ? cnt : 1u;
}
__device__ __forceinline__ void xcd_barrier(const XcdBarrier& b) {
    asm volatile("s_waitcnt vmcnt(0)" ::: "memory");
    __syncthreads();
    if (threadIdx.x == 0) {
        unsigned* bar = b.bar;
        __builtin_amdgcn_s_waitcnt(0);
        unsigned nloc = b.st[0], nx = b.st[1];
        if (nloc == 0u) { xcd_barrier_complete(bar, b.x, nloc, nx); b.st[0] = nloc; b.st[1] = nx; }
        const unsigned old = xb_add(&bar[XB_XSUB(b.x)], 1u);
        const unsigned gen = old / nloc;
        if (old + 1u == (gen + 1u) * nloc) {
            __builtin_amdgcn_fence(__ATOMIC_RELEASE, "agent");
            asm volatile("s_waitcnt vmcnt(0)" ::: "memory");
            const unsigned og = xb_add(&bar[XB_TOP], 1u);
            const unsigned tg = og / nx;
            if (og + 1u == (tg + 1u) * nx) xb_add(&bar[XB_TOPGEN], 1u);
            else XB_SPIN(xb_ld(&bar[XB_TOPGEN]) == tg, bar);
            __builtin_amdgcn_fence(__ATOMIC_ACQUIRE, "agent");
            xb_add(&bar[XB_XGEN(b.x)], 1u);
            asm volatile("s_waitcnt vmcnt(0)" ::: "memory");
        } else {
            XB_SPIN(xb_ld(&bar[XB_XGEN(b.x)]) == gen, bar);
            __builtin_amdgcn_fence(__ATOMIC_ACQUIRE, "agent");
            asm volatile("s_waitcnt vmcnt(0)" ::: "memory");
        }
    }
    __syncthreads();
}

__global__ void __launch_bounds__(NWAVES * 64, 2) mk_fwd(Args args) {
    extern __shared__ __attribute__((aligned(16))) unsigned char lds_raw[];
    Frame F;
    F.lds = (LAS unsigned char*)lds_raw;
#define REFRESH() do { int t_ = threadIdx.x; asm volatile("" : "+v"(t_)); F.tid = t_; F.lane = t_ & 63; F.wave = __builtin_amdgcn_readfirstlane(t_ >> 6); F.gw = blockIdx.x * NWAVES + F.wave; } while (0)
    F.G = gridDim.x; F.ngw = F.G * NWAVES; REFRESH();
    F.out = args.out; F.ws = args.ws;
    const int lo = args.ph_lo, hi = args.ph_hi;
#define IN(k) (lo <= (k) && (k) < hi)
#ifndef USE_CG_SYNC
#define USE_CG_SYNC 0
#endif
    volatile LAS unsigned* bst = (volatile LAS unsigned*)(F.lds + LDS_BYTES - 64);
    if (F.tid < 16) bst[F.tid] = 0u;
    __syncthreads();
    XcdBarrier gbar; gbar.bar = (unsigned*)(F.ws + WS_CTL); gbar.x = 0; gbar.st = bst;
    if (!USE_CG_SYNC && hi - lo > 1) gbar = xcd_barrier_post((unsigned*)(F.ws + WS_CTL), bst);
#define SEAM(k) do { if (IN(k) && IN((k) + 1)) { if (USE_CG_SYNC) cg::this_grid().sync(); else xcd_barrier(gbar); } } while (0)
    unsigned char* ws = F.ws;
    if (IN(0)) { REFRESH(); p0_prologue(F, args); }
    SEAM(0);
    if (IN(1)) { REFRESH();
        pg8::Gemm g{(const bf16*)(ws + WS_XN), (const bf16*)(ws + WS_WIN), S, NPJ, 1024, 1024}; pg8::StaticOrder So; So.init(S, NPJ, F.G, (int)blockIdx.x);
        EpiProj E{(bf16*)(ws + WS_U), (bf16*)(ws + WS_Q), (bf16*)(ws + WS_KVH), (bf16*)(ws + WS_G), (bf16*)(ws + WS_GN)};
        pg8::gemm_phase<EpiProj, pg8::StaticOrder>(F.lds, g, So, E);
    }
    SEAM(1);
    if (IN(2)) { REFRESH();
        for (int u = F.gw; u < 64 * 32; u += F.ngw) s5_unit<false>(F, args, u >> 5, u & 31, F.lds + F.wave * 16384, F.lds + 131072 + F.wave * 2048);
        __syncthreads();
        pg8::Gemm g{(const bf16*)(ws + WS_KVH), (const bf16*)(ws + WS_WC1), 4096, 1024, 1024 / CMP_KS, 1024}; pg8::CmpOrder So{F.G, (int)blockIdx.x, CMP_KS};
        EpiCmp E{F.out};
        pg8::gemm_phase<EpiCmp, pg8::CmpOrder>(F.lds, g, So, E);
    }
    SEAM(2);
    if (IN(3)) { REFRESH();
        for (int u = F.gw; u < 64 * 32; u += F.ngw) s5_unit<true>(F, args, u >> 5, u & 31, F.lds + F.wave * 16384, F.lds + 131072 + F.wave * 2048);
        for (int u0 = 0; u0 < 4 * 1024; u0 += F.ngw) { const int u = u0 + F.gw; const int kvb = (u0 + (int)blockIdx.x * NWAVES) >> 11;
            __syncthreads();
            { const float* w2 = kvb ? args.in[18] : args.in[16]; LAS f32x4* wd = (LAS f32x4*)(F.lds + 8 * 2048); for (int e = F.tid; e < 256 * 64 / 4; e += NWAVES * 64) wd[e] = ((const f32x4*)w2)[e]; }
            __syncthreads();
            if (u < 4 * 1024) { const int kvg = u >> 10, n = u & 1023; cmp_l2_unit(F, args, kvg >> 1, kvg & 1, n, (LAS float*)(F.lds + F.wave * 2048), (const LAS float*)(F.lds + 8 * 2048)); } }
        __syncthreads();
        for (int u = F.gw; u < 2 * 512; u += F.ngw) vtw_item(F, u >> 9, u & 511, (LAS unsigned short*)(F.lds + 81920 + F.wave * 8192));
        for (int u = F.gw; u < 2 * 256; u += F.ngw) vts_item(F, u >> 8, u & 255, (LAS unsigned short*)(F.lds + 81920 + F.wave * 8192));
    }
    SEAM(3);
    if (IN(4)) { REFRESH();
        for (int u = blockIdx.x; u < 256; u += F.G) {
#pragma unroll 1
            for (int g = 0; g < 2; ++g) { const int ta = ((u & 7) << 5) | (u >> 3);
                const int tile = g ? 255 - ta : ta;
                const unsigned soff = (unsigned)__builtin_amdgcn_readfirstlane((int)((blockIdx.x & 127u) * (unsigned)PSLAB));
                attn_tile(F, ws, args.in[19], tile, g, soff); } }
    }
    SEAM(4);
    if (IN(5)) { REFRESH();
        pg8::Gemm g{(const bf16*)(ws + WS_Z), (const bf16*)(ws + WS_WGLU), S, 512, 512, 512}; pg8::StaticOrder So; So.init(S, 512, F.G, (int)blockIdx.x);
        EpiGlu E{(const bf16*)(ws + WS_Z), (bf16*)(ws + WS_ZG)};
        pg8::gemm_phase<EpiGlu, pg8::StaticOrder>(F.lds, g, So, E);
    }
    SEAM(5);
    if (IN(6)) { REFRESH();
        pg8::TwoSegOrder So; So.init(S, 1024, F.G, (int)blockIdx.x);
        pg8::Gemm g{(const bf16*)(ws + WS_ZG), (const bf16*)(ws + WS_WA), S, 1024, 512, 512, (const bf16*)(ws + WS_O), (const bf16*)(ws + WS_WB)}; EpiMix2 E{(const bf16*)(ws + WS_G), (bf16*)(ws + WS_MIX)};
        pg8::gemm_phase<EpiMix2, pg8::TwoSegOrder>(F.lds, g, So, E);
    }
    SEAM(6);
    if (IN(7)) { REFRESH();
        pg8::Gemm g{(const bf16*)(ws + WS_MIX), (const bf16*)(ws + WS_WOUT), S, 1024, 1024, 1024}; pg8::StaticOrder So; So.init(S, 1024, F.G, (int)blockIdx.x);
        EpiResNorm E{args.in[0], F.out, (bf16*)(ws + WS_XN), (float*)(ws + WS_SSP), (LAS float*)(F.lds + pg8::STAGE_BYTES)};
        pg8::gemm_phase<EpiResNorm, pg8::StaticOrder>(F.lds, g, So, E);
    }
    SEAM(7);
    if (IN(9)) { REFRESH();
        pg8::Gemm g{(const bf16*)(ws + WS_XN), (const bf16*)(ws + WS_WGU), S, 2 * DFF, 1024, 1024}; pg8::StaticOrder So; So.init(S, 2 * DFF, F.G, (int)blockIdx.x);
        EpiFfn E{(bf16*)(ws + WS_H), (const float*)(ws + WS_SSP)};
        pg8::gemm_phase<EpiFfn, pg8::StaticOrder>(F.lds, g, So, E);
    }
    SEAM(9);
    if (IN(10)) { REFRESH();
        pg8::Gemm g{(const bf16*)(ws + WS_H), (const bf16*)(ws + WS_WD), S, 1024, DFF, DFF}; pg8::StaticOrder So; So.init(S, 1024, F.G, (int)blockIdx.x);
        EpiRes E{F.out, F.out};
        pg8::gemm_phase<EpiRes, pg8::StaticOrder>(F.lds, g, So, E);
    }
    SEAM(10);
    if (IN(11)) { REFRESH(); for (int m = F.gw; m < S; m += F.ngw) rms_row_f32(F.out + (size_t)m * DM, args.in[26], F.lane); }
#undef IN
#undef SEAM
}

extern "C" void kernel_launch(void* const* d_in, const int* in_sizes, int n_in, void* d_out, int out_size, void* d_ws, size_t ws_size, hipStream_t stream) {
    static int grid = 0;
    if (grid == 0) {
        if (n_in != 27 || out_size != S * DM || ws_size < WS_END) { fprintf(stderr, "kernel_launch: unexpected shapes (n_in %d out %d ws %zu)\n", n_in, out_size, ws_size); grid = -1; return; }
        int dev = 0, cus = 0, per_cu = 0;
        if (hipGetDevice(&dev) != hipSuccess || hipDeviceGetAttribute(&cus, hipDeviceAttributeMultiprocessorCount, dev) != hipSuccess) { grid = -1; return; }
        if (hipFuncSetAttribute((const void*)mk_fwd, hipFuncAttributeMaxDynamicSharedMemorySize, LDS_BYTES) != hipSuccess) { fprintf(stderr, "kernel_launch: hipFuncSetAttribute failed\n"); grid = -1; return; }
        if (hipOccupancyMaxActiveBlocksPerMultiprocessor(&per_cu, (const void*)mk_fwd, NWAVES * 64, LDS_BYTES) != hipSuccess || per_cu < 1) { fprintf(stderr, "kernel_launch: occupancy query says %d\n", per_cu); per_cu = 1; }
        (void)hipGetLastError();
        grid = cus * (per_cu < 1 ? 1 : 1);
    }
    if (grid < 0) return;
    if (hipMemsetAsync((char*)d_ws + WS_CTL, 0, 16384, stream) != hipSuccess) { fprintf(stderr, "kernel_launch: hipMemsetAsync failed\n"); return; }
    Args a{};
    for (int i = 0; i < 27; ++i) a.in[i] = (const float*)d_in[i];
    a.out = (float*)d_out; a.ws = (unsigned char*)d_ws;
    if (MK_N_LAUNCHES == 1) {
        a.ph_lo = 0; a.ph_hi = NPH;
        void* kargs[] = {&a};
        hipError_t e = hipLaunchCooperativeKernel((const void*)mk_fwd, dim3(grid), dim3(NWAVES * 64), kargs, LDS_BYTES, stream);
        if (e != hipSuccess) fprintf(stderr, "kernel_launch: cooperative launch failed: %s (grid %d)\n", hipGetErrorString(e), grid);
    } else {
        for (int ph = 0; ph < NPH; ++ph) { a.ph_lo = ph; a.ph_hi = ph + 1; hipLaunchKernelGGL(mk_fwd, dim3(grid), dim3(NWAVES * 64), LDS_BYTES, stream, a); }
    }
}
```

```cpp
#include <hip/hip_runtime.h>
#include <hip/hip_cooperative_groups.h>
#include <cstdio>
#include <cstdint>
namespace cg = cooperative_groups;

#ifndef MK_N_LAUNCHES
#define MK_N_LAUNCHES 1
#endif

namespace pg8 {
#define PG8_LAS __attribute__((address_space(3)))
typedef unsigned short bf16_t;
typedef short bf16x8 __attribute__((ext_vector_type(8)));
typedef float f32x4 __attribute__((ext_vector_type(4)));
typedef unsigned u32x4 __attribute__((ext_vector_type(4)));
constexpr int BM = 256, BK = 64, HALF = 128, HTB = HALF * BK * 2, STAGE_BYTES = 8 * HTB, NXCD = 8, WGM = 8;

__host__ __device__ __forceinline__ int lds_byte(int r, int c) { const int st = (r >> 4) * 2 + (c >> 5), rr = r & 15, cc = c & 31, ob = rr * 64 + cc * 2; return st * 1024 + (ob ^ (((ob >> 9) & 1) << 5)); }
__host__ __device__ __forceinline__ void stage_rc(int b, int& R, int& C) { const int st = b / 1024, sb = b % 1024, swz = sb ^ (((sb >> 9) & 1) << 5); R = (st >> 1) * 16 + swz / 64; C = (st & 1) * 32 + (swz % 64) / 2; }
__host__ __device__ __forceinline__ int perm32(int rho) { const int n = rho >> 4, i = rho & 15; return 8 * (i >> 2) + 4 * n + (i & 3); }

struct Unit { int pm, pn, ks, seg; };
struct Gemm { const bf16_t* A; const bf16_t* Bt; int M, N, K, ld; const bf16_t* A2; const bf16_t* Bt2; };

struct StaticOrder {
    static constexpr bool SINGLE = false;
    int nM, nN, nwg, G, c;
    __host__ __device__ void init(int M, int N, int G_, int c_) { nM = M / BM; nN = N / BM; nwg = nM * nN; G = G_; c = c_; }
    __host__ __device__ bool next(int i, Unit& u) const {
        const long L = (long)i * G + c; if (L >= nwg) return false;
        int wgid = (int)L; { const int q = nwg / NXCD, r = nwg % NXCD, xcd = wgid % NXCD, off = wgid / NXCD; wgid = (xcd < r ? xcd * (q + 1) : r * (q + 1) + (xcd - r) * q) + off; }
        const int nig = WGM * nN, gid = wgid / nig, fm = gid * WGM, gsz = (nM - fm) < WGM ? (nM - fm) : WGM;
        u.pm = fm + ((wgid % nig) % gsz); u.pn = (wgid % nig) / gsz; u.ks = 0; u.seg = 0; return true;
    }
};
struct TwoSegOrder : StaticOrder {
    __host__ __device__ bool next(int i, Unit& u) const { if (!StaticOrder::next(i >> 1, u)) return false; u.seg = i & 1; return true; }
};
struct CmpOrder {
    static constexpr bool SINGLE = true;
    int G, c, KS;
    __host__ __device__ bool next(int i, Unit& u) const {
        const int L = i * G + c; if (L >= 32 * KS) return false;
        const int tile = L / KS; u.ks = L % KS; u.pm = tile >> 1; u.pn = (tile & 1) + (u.pm >= 8 ? 2 : 0); u.seg = 0; return true;
    }
};

typedef float f32x2_t __attribute__((ext_vector_type(2))); typedef __bf16 bf16x2_t __attribute__((ext_vector_type(2)));
__device__ __forceinline__ unsigned cvt_pk_bf16(float lo, float hi) { f32x2_t v = {lo, hi}; bf16x2_t b = __builtin_convertvector(v, bf16x2_t); return __builtin_bit_cast(unsigned, b); }
__device__ __forceinline__ float bflo(unsigned w) { return __uint_as_float(w << 16); }
__device__ __forceinline__ float bfhi(unsigned w) { return __uint_as_float(w & 0xffff0000u); }
__device__ __forceinline__ float sigm(float x) { return __builtin_amdgcn_rcpf(1.0f + __expf(-x)); }

template <class Epi, class Sched>
__device__ __forceinline__ void gemm_phase(PG8_LAS unsigned char* lds, const Gemm g, const Sched& S, const Epi& E) {
    const int tid = threadIdx.x, wid = __builtin_amdgcn_readfirstlane(tid >> 6), lane = tid & 63, wr = wid >> 2, wc = wid & 3, fr = lane & 15, fq = lane >> 4;
    const int K = g.K, ld = g.ld, nt = K / BK;
    unsigned voffA[2], voffB[2];
#pragma unroll
    for (int i = 0; i < 2; ++i) { int R, C; stage_rc(tid * 16 + i * 8192, R, C); const int Rb = Epi::PERM ? ((R & ~31) + perm32(R & 31)) : R;
        voffA[i] = (unsigned)(R * ld + C) * 2u; voffB[i] = (unsigned)(Rb * ld + C) * 2u; }
    const size_t kstep = (size_t)(BK * 2);
    const size_t hstep = (size_t)HALF * ld * 2;
    const size_t tstep = 2 * hstep;
    const unsigned ldsw = (unsigned)wid * 1024u;
    const int aoff = lds_byte(wr * 64 + fr, fq * 8), boff = lds_byte(wc * 32 + fr, fq * 8);
#define PG8_SA(b, h) (((b) * 2 + (h)) * HTB)
#define PG8_SB(b, h) ((4 + (b) * 2 + (h)) * HTB)
#define PG8_STAGE(bufoff, gbase, voff) do { _Pragma("unroll") for (int _i = 0; _i < 2; ++_i) \
        __builtin_amdgcn_global_load_lds((const unsigned*)((const char*)(gbase) + (voff)[_i]), (PG8_LAS unsigned*)(lds + (bufoff) + ldsw + _i * 8192), 16, 0, 0); } while (0)
#define PG8_LDA(dst, b, h) do { _Pragma("unroll") for (int m = 0; m < 4; ++m) _Pragma("unroll") for (int k = 0; k < 2; ++k) dst[m][k] = *(const PG8_LAS bf16x8*)(lds + PG8_SA(b, h) + aoff + m * 2048 + k * 1024); } while (0)
#define PG8_LDB(dst, b, h) do { _Pragma("unroll") for (int n = 0; n < 2; ++n) _Pragma("unroll") for (int k = 0; k < 2; ++k) dst[n][k] = *(const PG8_LAS bf16x8*)(lds + PG8_SB(b, h) + boff + n * 2048 + k * 1024); } while (0)
#define PG8_MMA(ai, bj, At, Bt) do { __builtin_amdgcn_s_setprio(1); _Pragma("unroll") for (int m = 0; m < 4; ++m) _Pragma("unroll") for (int n = 0; n < 2; ++n) _Pragma("unroll") for (int k = 0; k < 2; ++k) \
        acc[ai][bj][m][n] = __builtin_amdgcn_mfma_f32_16x16x32_bf16(Bt[n][k], At[m][k], acc[ai][bj][m][n], 0, 0, 0); __builtin_amdgcn_s_setprio(0); } while (0)
#define PG8_WAIT_V(n) asm volatile("s_waitcnt vmcnt(" #n ")" ::: "memory")
#define PG8_WAIT_L(n) asm volatile("s_waitcnt lgkmcnt(" #n ")" ::: "memory")
#define PG8_BAR __builtin_amdgcn_s_barrier()
#define PG8_SCHED __builtin_amdgcn_sched_barrier(0)
    Unit cur, nxt; int ui = 0;
    if (!S.next(0, cur)) return;
    f32x4 acc[2][2][4][2];
#pragma unroll
    for (int a = 0; a < 2; ++a)
#pragma unroll
        for (int b = 0; b < 2; ++b)
#pragma unroll
            for (int m = 0; m < 4; ++m)
#pragma unroll
                for (int n = 0; n < 2; ++n) acc[a][b][m][n] = (f32x4){0.f, 0.f, 0.f, 0.f};
    bf16x8 At[4][2], B0[2][2], B1[2][2];
    const char* cA = (const char*)(cur.seg ? g.A2 : g.A) + (size_t)cur.pm * tstep + (size_t)cur.ks * K * 2; const char* cB = (const char*)(cur.seg ? g.Bt2 : g.Bt) + (size_t)cur.pn * tstep + (size_t)cur.ks * K * 2;
    PG8_STAGE(PG8_SB(0, 0), cB, voffB); PG8_STAGE(PG8_SB(0, 1), cB + hstep, voffB); PG8_STAGE(PG8_SA(0, 0), cA, voffA); PG8_STAGE(PG8_SA(0, 1), cA + hstep, voffA);
    if (wr == 1) PG8_BAR;
    PG8_WAIT_V(2); PG8_BAR;
    PG8_STAGE(PG8_SB(1, 0), cB + kstep, voffB); PG8_STAGE(PG8_SA(1, 0), cA + kstep, voffA); PG8_STAGE(PG8_SB(1, 1), cB + hstep + kstep, voffB);
    PG8_WAIT_V(6); PG8_BAR;
    for (;;) {
        const bool has_next = Sched::SINGLE ? false : S.next(ui + 1, nxt);
        const char* nA = has_next ? (const char*)(nxt.seg ? g.A2 : g.A) + (size_t)nxt.pm * tstep + (size_t)nxt.ks * K * 2 : cA; const char* nB = has_next ? (const char*)(nxt.seg ? g.Bt2 : g.Bt) + (size_t)nxt.pn * tstep + (size_t)nxt.ks * K * 2 : cB;
        for (int t = 0; t < nt; t += 2) {
            const bool last = (t == nt - 2);
            const char* a1 = cA + (size_t)(t + 1) * kstep;
            const char* a2 = last ? nA : cA + (size_t)(t + 2) * kstep; const char* b2 = last ? nB : cB + (size_t)(t + 2) * kstep;
            const char* a3 = a2 + kstep; const char* b3 = b2 + kstep;
            PG8_LDB(B0, 0, 0); PG8_LDB(B1, 0, 1); PG8_SCHED; PG8_LDA(At, 0, 0); PG8_STAGE(PG8_SA(1, 1), a1 + hstep, voffA);
            PG8_WAIT_V(8); PG8_WAIT_L(0); PG8_BAR; PG8_MMA(0, 0, At, B0); PG8_MMA(0, 1, At, B1); PG8_BAR; PG8_SCHED;
            PG8_LDA(At, 0, 1); PG8_STAGE(PG8_SB(0, 0), b2, voffB); PG8_STAGE(PG8_SB(0, 1), b2 + hstep, voffB); PG8_STAGE(PG8_SA(0, 0), a2, voffA);
            PG8_WAIT_V(8); PG8_WAIT_L(0); PG8_BAR; PG8_MMA(1, 0, At, B0); PG8_MMA(1, 1, At, B1); PG8_BAR; PG8_SCHED;
            PG8_LDB(B0, 1, 0); PG8_LDB(B1, 1, 1); PG8_SCHED; PG8_LDA(At, 1, 0); PG8_STAGE(PG8_SA(0, 1), a2 + hstep, voffA);
            PG8_WAIT_V(8); PG8_WAIT_L(0); PG8_BAR; PG8_MMA(0, 0, At, B0); PG8_MMA(0, 1, At, B1); PG8_BAR; PG8_SCHED;
            PG8_LDA(At, 1, 1); PG8_STAGE(PG8_SB(1, 0), b3, voffB); PG8_STAGE(PG8_SB(1, 1), b3 + hstep, voffB); PG8_STAGE(PG8_SA(1, 0), a3, voffA);
            PG8_WAIT_V(8); PG8_WAIT_L(0); PG8_BAR; PG8_MMA(1, 0, At, B0); PG8_MMA(1, 1, At, B1); PG8_BAR; PG8_SCHED;
        }
        if (wr == 0) PG8_BAR;
        E(acc, cur, wr, wc, fr, fq);
        if (!has_next) break;
        if (!nxt.seg) {
#pragma unroll
        for (int a = 0; a < 2; ++a)
#pragma unroll
            for (int b = 0; b < 2; ++b)
#pragma unroll
                for (int m = 0; m < 4; ++m)
#pragma unroll
                    for (int n = 0; n < 2; ++n) acc[a][b][m][n] = (f32x4){0.f, 0.f, 0.f, 0.f}; }
        cur = nxt; cA = nA; cB = nB; ++ui;
        if (wr == 1) PG8_BAR;
    }
    PG8_WAIT_V(0);
    PG8_BAR;
#undef PG8_SA
#undef PG8_SB
#undef PG8_STAGE
#undef PG8_LDA
#undef PG8_LDB
#undef PG8_MMA
#undef PG8_WAIT_V
#undef PG8_WAIT_L
#undef PG8_BAR
#undef PG8_SCHED
}
}

constexpr int S = 16384, DM = 1024, INC = 3864, NPJ = 4096, SSW = 512, NSW = 512, HD = 64, DFF = 2816;
constexpr int NGRP = 32, NST = 64, NCMP = 1023;
constexpr int NWAVES = 8;
constexpr int NPH = 12;
constexpr int CMP_KS = 4;
constexpr float EPS = 1e-6f;

constexpr size_t MiB = 1u << 20;
constexpr size_t WS_CTL = 0;
constexpr size_t WS_TAB = 1 * MiB;
constexpr size_t TAB_BF = 0, TAB_CF = 128 * 1024, TAB_LAM = 256 * 1024, TAB_LAM256 = 272 * 1024, TAB_POSB = 288 * 1024;
constexpr size_t WS_SSP = 1 * MiB + 512 * 1024;
constexpr size_t WS_F = 2 * MiB;
constexpr size_t WS_KVC = 3 * MiB;
constexpr size_t WS_WIN = 4 * MiB, WS_WGU = 12 * MiB, WS_WD = 23 * MiB, WS_WOUT = 29 * MiB, WS_WA = 31 * MiB, WS_WB = 32 * MiB, WS_WGLU = 33 * MiB, WS_WC1 = 34 * MiB;
constexpr size_t WS_XN = 36 * MiB;
constexpr size_t WS_Z = WS_XN, WS_ZG = WS_XN + 16 * MiB;
constexpr size_t WS_U = 68 * MiB, WS_O = WS_U;
constexpr size_t WS_Q = 84 * MiB;
constexpr size_t WS_KVH = 100 * MiB;
constexpr size_t WS_G = 124 * MiB;
constexpr size_t WS_GN = 188 * MiB;
constexpr size_t WS_MIX = 84 * MiB;
constexpr size_t WS_H = 100 * MiB;
constexpr size_t WS_VTW = 189 * MiB;
constexpr size_t WS_VTS = 193 * MiB;
constexpr size_t WS_KCB = 197 * MiB;
constexpr size_t WS_VTC = 197 * MiB + 512 * 1024;
constexpr size_t WS_PSLAB = 198 * MiB;
constexpr size_t WS_END = 254 * MiB;

constexpr int LDS_BYTES = 163840;

#define GAS __attribute__((address_space(1)))
#define LAS __attribute__((address_space(3)))
typedef unsigned short bf16;
typedef unsigned v4u __attribute__((ext_vector_type(4)));
typedef float f32x4 __attribute__((ext_vector_type(4)));
typedef float f32x2 __attribute__((ext_vector_type(2)));
typedef float f32x16 __attribute__((ext_vector_type(16)));
typedef short bf16x8 __attribute__((ext_vector_type(8)));
#define LDS_WAIT() asm volatile("s_waitcnt lgkmcnt(0)" ::: "memory")
#define VM_WAIT() asm volatile("s_waitcnt vmcnt(0)" ::: "memory")
typedef float f32x2c_t __attribute__((ext_vector_type(2))); typedef __bf16 bf16x2c_t __attribute__((ext_vector_type(2)));
__device__ __forceinline__ unsigned pk2(float lo, float hi) { f32x2c_t v = {lo, hi}; bf16x2c_t b = __builtin_convertvector(v, bf16x2c_t); return __builtin_bit_cast(unsigned, b); }
__device__ __forceinline__ unsigned f2bf(float f) { return pk2(f, 0.f) & 0xffffu; }
__device__ __forceinline__ float bf2f(bf16 v) { return __uint_as_float((unsigned)v << 16); }
using pg8::bflo; using pg8::bfhi; using pg8::sigm; using pg8::cvt_pk_bf16;
__device__ __forceinline__ float gelu_tanh(float y) {
    const float a = 0.7978845608028654f * (y + 0.044715f * y * y * y);
    const float e = __expf(2.0f * a);
    const float th = 1.0f - 2.0f * __builtin_amdgcn_rcpf(e + 1.0f);
    return 0.5f * y * (1.0f + th);
}
__device__ __forceinline__ float wave_sum(float v) {
#pragma unroll
    for (int o = 1; o < 64; o <<= 1) v += __shfl_xor(v, o);
    return v;
}
__device__ __forceinline__ float wave_max(float v) {
#pragma unroll
    for (int o = 1; o < 64; o <<= 1) v = fmaxf(v, __shfl_xor(v, o));
    return v;
}

struct Args { const float* in[27]; float* out; unsigned char* ws; int ph_lo, ph_hi; };

struct Frame {
    LAS unsigned char* lds;
    int tid, lane, wave, G, gw, ngw;
    float* out; unsigned char* ws;
};

using pg8::Unit; using pg8::BM; using pg8::HALF;
struct EpiProj {
    static constexpr bool PERM = true;
    bf16 *U, *Q, *KVH, *Gt, *GN;
    __device__ __forceinline__ void operator()(const f32x4 (&acc)[2][2][4][2], const Unit& u, int wr, int wc, int fr, int fq) const {
        const int row0 = u.pm * BM + wr * 64 + fr, pn = u.pn;
#pragma unroll
        for (int ai = 0; ai < 2; ++ai)
#pragma unroll
            for (int m = 0; m < 4; ++m) { const int row = row0 + ai * HALF + m * 16;
#pragma unroll
                for (int bj = 0; bj < 2; ++bj) { f32x4 v0 = acc[ai][bj][m][0], v1 = acc[ai][bj][m][1]; const int col = bj * HALF + wc * 32 + 8 * fq; bf16* dst;
                    if (pn < 2) dst = U + (size_t)row * 512 + pn * 256 + col;
                    else if (pn < 4) { v0 = v0 * (0.125f * 1.4426950408889634f); v1 = v1 * (0.125f * 1.4426950408889634f); dst = Q + (size_t)row * 512 + (pn - 2) * 256 + col; }
                    else if (pn < 7) dst = KVH + ((size_t)((pn - 4) * 4 + (col >> 6)) * S + row) * 64 + (col & 63);
                    else { v0 = (f32x4){sigm(v0[0]), sigm(v0[1]), sigm(v0[2]), sigm(v0[3])}; v1 = (f32x4){sigm(v1[0]), sigm(v1[1]), sigm(v1[2]), sigm(v1[3])};
                        if (pn < 15) dst = Gt + (size_t)row * 2048 + (pn - 7) * 256 + col; else { if (col >= 32) continue; dst = GN + (size_t)row * 32 + col; } }
                    v4u w; w.x = cvt_pk_bf16(v0[0], v0[1]); w.y = cvt_pk_bf16(v0[2], v0[3]); w.z = cvt_pk_bf16(v1[0], v1[1]); w.w = cvt_pk_bf16(v1[2], v1[3]);
                    *(v4u*)dst = w; } }
    }
};
struct EpiCmp {
    static constexpr bool PERM = false;
    float* C;
    __device__ __forceinline__ void operator()(const f32x4 (&acc)[2][2][4][2], const Unit& u, int wr, int wc, int fr, int fq) const {
        const int row0 = u.pm * BM + wr * 64 + fr, col0 = (u.pn & 1) * BM + wc * 32 + 4 * fq; float* base = C + (size_t)u.ks * 4096 * 512;
#pragma unroll
        for (int ai = 0; ai < 2; ++ai)
#pragma unroll
            for (int m = 0; m < 4; ++m) { float* rowp = base + (size_t)(row0 + ai * HALF + m * 16) * 512 + col0;
#pragma unroll
                for (int bj = 0; bj < 2; ++bj)
#pragma unroll
                    for (int n = 0; n < 2; ++n) *(f32x4*)(rowp + bj * HALF + n * 16) = acc[ai][bj][m][n]; }
    }
};
struct EpiGlu {
    static constexpr bool PERM = true;
    const bf16* Z; bf16* ZG;
    __device__ __forceinline__ void operator()(const f32x4 (&acc)[2][2][4][2], const Unit& u, int wr, int wc, int fr, int fq) const {
        const int row0 = u.pm * BM + wr * 64 + fr;
#pragma unroll
        for (int ai = 0; ai < 2; ++ai)
#pragma unroll
            for (int m = 0; m < 4; ++m) { const int row = row0 + ai * HALF + m * 16;
#pragma unroll
                for (int bj = 0; bj < 2; ++bj) { const f32x4 v0 = acc[ai][bj][m][0], v1 = acc[ai][bj][m][1]; const size_t off = (size_t)row * 512 + u.pn * BM + bj * HALF + wc * 32 + 8 * fq;
                    const v4u z = *(const v4u*)(Z + off); v4u w;
                    w.x = cvt_pk_bf16(bflo(z.x) * sigm(v0[0]), bfhi(z.x) * sigm(v0[1])); w.y = cvt_pk_bf16(bflo(z.y) * sigm(v0[2]), bfhi(z.y) * sigm(v0[3]));
                    w.z = cvt_pk_bf16(bflo(z.z) * sigm(v1[0]), bfhi(z.z) * sigm(v1[1])); w.w = cvt_pk_bf16(bflo(z.w) * sigm(v1[2]), bfhi(z.w) * sigm(v1[3]));
                    *(v4u*)(ZG + off) = w; } }
    }
};
struct EpiMix2 {
    static constexpr bool PERM = true;
    const bf16* Gt; bf16* MIX;
    __device__ __forceinline__ void operator()(f32x4 (&acc)[2][2][4][2], const Unit& u, int wr, int wc, int fr, int fq) const {
        const int row0 = u.pm * BM + wr * 64 + fr;
#pragma unroll
        for (int ai = 0; ai < 2; ++ai)
#pragma unroll
            for (int m = 0; m < 4; ++m) { const int row = row0 + ai * HALF + m * 16;
#pragma unroll
                for (int bj = 0; bj < 2; ++bj) { const int col = u.pn * BM + bj * HALF + wc * 32 + 8 * fq;
                    const v4u gb = *(const v4u*)(Gt + (size_t)row * 2048 + 1024 + col);
                    const float b8[8] = {bflo(gb.x), bfhi(gb.x), bflo(gb.y), bfhi(gb.y), bflo(gb.z), bfhi(gb.z), bflo(gb.w), bfhi(gb.w)};
                    if (u.seg == 0) { const v4u ga = *(const v4u*)(Gt + (size_t)row * 2048 + col);
                        const float a8[8] = {bflo(ga.x), bfhi(ga.x), bflo(ga.y), bfhi(ga.y), bflo(ga.z), bfhi(ga.z), bflo(ga.w), bfhi(ga.w)};
#pragma unroll
                        for (int e = 0; e < 4; ++e) { acc[ai][bj][m][0][e] *= a8[e] * __builtin_amdgcn_rcpf(b8[e]); acc[ai][bj][m][1][e] *= a8[4 + e] * __builtin_amdgcn_rcpf(b8[4 + e]); }
                    } else { const f32x4 v0 = acc[ai][bj][m][0], v1 = acc[ai][bj][m][1]; v4u w;
                        w.x = cvt_pk_bf16(v0[0] * b8[0], v0[1] * b8[1]); w.y = cvt_pk_bf16(v0[2] * b8[2], v0[3] * b8[3]); w.z = cvt_pk_bf16(v1[0] * b8[4], v1[1] * b8[5]); w.w = cvt_pk_bf16(v1[2] * b8[6], v1[3] * b8[7]);
                        *(v4u*)(MIX + (size_t)row * 1024 + col) = w; } } }
    }
};
struct EpiRes {
    static constexpr bool PERM = false;
    const float* base; float* out;
    __device__ __forceinline__ void operator()(const f32x4 (&acc)[2][2][4][2], const Unit& u, int wr, int wc, int fr, int fq) const {
        const int row0 = u.pm * BM + wr * 64 + fr, col0 = u.pn * BM + wc * 32 + 4 * fq;
#pragma unroll
        for (int ai = 0; ai < 2; ++ai)
#pragma unroll
            for (int m = 0; m < 4; ++m) { const size_t off = (size_t)(row0 + ai * HALF + m * 16) * 1024 + col0;
#pragma unroll
                for (int bj = 0; bj < 2; ++bj)
#pragma unroll
                    for (int n = 0; n < 2; ++n) { const f32x4 b = *(const f32x4*)(base + off + bj * HALF + n * 16); *(f32x4*)(out + off + bj * HALF + n * 16) = b + acc[ai][bj][m][n]; } }
    }
};
struct EpiResNorm {
    static constexpr bool PERM = false;
    const float* base; float* out; bf16* XN; float* SSP; LAS float* part;
    __device__ __forceinline__ void operator()(const f32x4 (&acc)[2][2][4][2], const Unit& u, int wr, int wc, int fr, int fq) const {
        const int row0 = u.pm * BM + wr * 64 + fr, col0 = u.pn * BM + wc * 32 + 4 * fq;
#pragma unroll
        for (int ai = 0; ai < 2; ++ai)
#pragma unroll
            for (int m = 0; m < 4; ++m) { const size_t off = (size_t)(row0 + ai * HALF + m * 16) * 1024 + col0; float ss = 0.f;
#pragma unroll
                for (int bj = 0; bj < 2; ++bj)
#pragma unroll
                    for (int n = 0; n < 2; ++n) { const f32x4 b = *(const f32x4*)(base + off + bj * HALF + n * 16); const f32x4 x1 = b + acc[ai][bj][m][n]; *(f32x4*)(out + off + bj * HALF + n * 16) = x1;
                        *(unsigned long long*)(XN + off + bj * HALF + n * 16) = (unsigned long long)cvt_pk_bf16(x1[0], x1[1]) | ((unsigned long long)cvt_pk_bf16(x1[2], x1[3]) << 32);
                        ss += (x1[0] * x1[0] + x1[1] * x1[1]) + (x1[2] * x1[2] + x1[3] * x1[3]); }
                ss += __shfl_xor(ss, 16); ss += __shfl_xor(ss, 32);
                if (fq == 0) part[(ai * HALF + wr * 64 + m * 16 + fr) * 4 + wc] = ss; }
        asm volatile("s_waitcnt lgkmcnt(0)" ::: "memory"); __builtin_amdgcn_s_barrier(); asm volatile("" ::: "memory");
        if (threadIdx.x < 256) { const f32x4 p = *(const LAS f32x4*)(part + threadIdx.x * 4); SSP[(size_t)(u.pm * BM + threadIdx.x) * 4 + u.pn] = (p[0] + p[1]) + (p[2] + p[3]); }
    }
};
struct EpiFfn {
    static constexpr bool PERM = true;
    bf16* H; const float* SSP;
    __device__ __forceinline__ void operator()(const f32x4 (&acc)[2][2][4][2], const Unit& u, int wr, int wc, int fr, int fq) const {
        const int row0 = u.pm * BM + wr * 64 + fr;
#pragma unroll
        for (int ai = 0; ai < 2; ++ai)
#pragma unroll
            for (int m = 0; m < 4; ++m) { const int row = row0 + ai * HALF + m * 16;
                const f32x4 sp = *(const f32x4*)(SSP + (size_t)row * 4); const float rs = 1.0f / sqrtf(((sp[0] + sp[1]) + (sp[2] + sp[3])) * (1.f / 1024.f) + 1e-6f);
                float r[8];
#pragma unroll
                for (int n = 0; n < 2; ++n)
#pragma unroll
                    for (int e = 0; e < 4; ++e) { const float gt = acc[ai][0][m][n][e] * rs, up = acc[ai][1][m][n][e] * rs; r[n * 4 + e] = gt * sigm(gt) * up; }
                v4u w; w.x = cvt_pk_bf16(r[0], r[1]); w.y = cvt_pk_bf16(r[2], r[3]); w.z = cvt_pk_bf16(r[4], r[5]); w.w = cvt_pk_bf16(r[6], r[7]);
                *(v4u*)(H + (size_t)row * DFF + u.pn * HALF + wc * 32 + 8 * fq) = w; }
    }
};

struct TrDesc { const float* src; bf16* dst; int ld, ncols, dld, drow, kb, nb; const float* gain; };
__device__ __forceinline__ void tr_load(const TrDesc& d, float (&v)[32], int lane) {
    const int k0 = 64 * d.kb, c = 32 * d.nb + (lane & 31); const bool ok = c < d.ncols; const float* p = d.src + (size_t)(k0 + (lane >> 5)) * d.ld + c;
#pragma unroll
    for (int i = 0; i < 32; ++i) v[i] = ok ? p[(size_t)(2 * i) * d.ld] : 0.f;
    if (d.gain) {
#pragma unroll
        for (int i = 0; i < 32; ++i) v[i] *= d.gain[k0 + 2 * i + (lane >> 5)]; }
}
__device__ __forceinline__ void tr_finish(const TrDesc& d, const float (&v)[32], LAS float* scr, int lane) {
#pragma unroll
    for (int i = 0; i < 32; ++i) scr[(2 * i + (lane >> 5)) * 33 + (lane & 31)] = v[i];
    LDS_WAIT();
    const int cc = lane & 7, k0 = 64 * d.kb;
#pragma unroll
    for (int j = 0; j < 4; ++j) { const int n = (lane >> 3) + 8 * j; const LAS float* s = scr + (8 * cc) * 33 + n;
        v4u o; o.x = pk2(s[0 * 33], s[1 * 33]); o.y = pk2(s[2 * 33], s[3 * 33]); o.z = pk2(s[4 * 33], s[5 * 33]); o.w = pk2(s[6 * 33], s[7 * 33]);
        *(v4u*)(d.dst + (size_t)(d.drow + n) * d.dld + k0 + 8 * cc) = o; }
    LDS_WAIT();
}
__device__ __forceinline__ void rms_row_to_bf16(const float* xrow, const float* gain, bf16* orow, int lane) {
    const f32x4* xr = (const f32x4*)xrow + lane; const f32x4* gr = (const f32x4*)gain + lane;
    f32x4 v[4]; float s = 0.f;
#pragma unroll
    for (int j = 0; j < 4; ++j) { v[j] = xr[64 * j]; s += (v[j].x * v[j].x + v[j].y * v[j].y) + (v[j].z * v[j].z + v[j].w * v[j].w); }
    const float rstd = 1.0f / sqrtf(wave_sum(s) * (1.f / DM) + EPS);
    unsigned long long* o8 = (unsigned long long*)orow + lane;
#pragma unroll
    for (int j = 0; j < 4; ++j) { const f32x4 gq = gr[64 * j];
        o8[64 * j] = (unsigned long long)pk2(v[j].x * rstd * gq.x, v[j].y * rstd * gq.y) | ((unsigned long long)pk2(v[j].z * rstd * gq.z, v[j].w * rstd * gq.w) << 32); }
}
__device__ __forceinline__ void rms_rows2_to_bf16(const float* x0, const float* x1, const float* gain, bf16* o0, bf16* o1, int lane) {
    const f32x4* xa = (const f32x4*)x0 + lane; const f32x4* xb = (const f32x4*)x1 + lane; const f32x4* gr = (const f32x4*)gain + lane;
    f32x4 va[4], vb[4]; float sa = 0.f, sb = 0.f;
#pragma unroll
    for (int j = 0; j < 4; ++j) { va[j] = xa[64 * j]; vb[j] = xb[64 * j]; }
#pragma unroll
    for (int j = 0; j < 4; ++j) { sa += (va[j].x * va[j].x + va[j].y * va[j].y) + (va[j].z * va[j].z + va[j].w * va[j].w); sb += (vb[j].x * vb[j].x + vb[j].y * vb[j].y) + (vb[j].z * vb[j].z + vb[j].w * vb[j].w); }
    const float ra = 1.0f / sqrtf(wave_sum(sa) * (1.f / DM) + EPS), rb = 1.0f / sqrtf(wave_sum(sb) * (1.f / DM) + EPS);
    unsigned long long* pa = (unsigned long long*)o0 + lane; unsigned long long* pb = (unsigned long long*)o1 + lane;
#pragma unroll
    for (int j = 0; j < 4; ++j) { const f32x4 gq = gr[64 * j];
        pa[64 * j] = (unsigned long long)pk2(va[j].x * ra * gq.x, va[j].y * ra * gq.y) | ((unsigned long long)pk2(va[j].z * ra * gq.z, va[j].w * ra * gq.w) << 32);
        pb[64 * j] = (unsigned long long)pk2(vb[j].x * rb * gq.x, vb[j].y * rb * gq.y) | ((unsigned long long)pk2(vb[j].z * rb * gq.z, vb[j].w * rb * gq.w) << 32); }
}
__device__ __forceinline__ void rms_row_f32(float* xrow, const float* gain, int lane) {
    f32x4* xr = (f32x4*)xrow + lane; const f32x4* gr = (const f32x4*)gain + lane;
    f32x4 v[4]; float s = 0.f;
#pragma unroll
    for (int j = 0; j < 4; ++j) { v[j] = xr[64 * j]; s += (v[j].x * v[j].x + v[j].y * v[j].y) + (v[j].z * v[j].z + v[j].w * v[j].w); }
    const float rstd = 1.0f / sqrtf(wave_sum(s) * (1.f / DM) + EPS);
#pragma unroll
    for (int j = 0; j < 4; ++j) { const f32x4 gq = gr[64 * j]; xr[64 * j] = v[j] * rstd * gq; }
}
__device__ __forceinline__ void s5_tables(const Frame& F, const Args& args, int g) {
    const int lane = F.lane;
    const float* are = args.in[3]; const float* aim = args.in[4]; const float* ldt = args.in[5]; const float* bre = args.in[6]; const float* bim = args.in[7]; const float* cre = args.in[8]; const float* cim = args.in[9];
    const double dt = exp((double)ldt[g]);
    {   const int p = lane; const double ar = are[g * 64 + p], ai = aim[g * 64 + p];
        const double er = exp(ar * dt), lr = er * cos(ai * dt), li = er * sin(ai * dt);
        ((f32x2*)(F.ws + WS_TAB + TAB_LAM))[g * 64 + p] = (f32x2){(float)lr, (float)li};
        const double e2 = exp(ar * dt * 256.0), l2r = e2 * cos(ai * dt * 256.0), l2i = e2 * sin(ai * dt * 256.0);
        ((f32x2*)(F.ws + WS_TAB + TAB_LAM256))[g * 64 + p] = (f32x2){(float)l2r, (float)l2i}; }
#pragma unroll
    for (int nt = 0; nt < 4; ++nt) { const int col = 32 * nt + (lane & 31), p = col >> 1, ri = col & 1;
        const double ar = are[g * 64 + p], ai = aim[g * 64 + p];
        const double er = exp(ar * dt), lr = er * cos(ai * dt) - 1.0, li = er * sin(ai * dt);
        const double den = ar * ar + ai * ai, kr = (lr * ar + li * ai) / den, ki = (li * ar - lr * ai) / den;
        float v[8];
#pragma unroll
        for (int j = 0; j < 8; ++j) { const int c = 8 * (lane >> 5) + j; const double br = bre[(g * 64 + p) * 16 + c], bi = bim[(g * 64 + p) * 16 + c];
            v[j] = (float)(ri ? (kr * bi + ki * br) : (kr * br - ki * bi)); }
        v4u o; o.x = pk2(v[0], v[1]); o.y = pk2(v[2], v[3]); o.z = pk2(v[4], v[5]); o.w = pk2(v[6], v[7]);
        ((v4u*)(F.ws + WS_TAB + TAB_BF))[(g * 4 + nt) * 64 + lane] = o; }
#pragma unroll
    for (int ks = 0; ks < 4; ++ks) { const int ch = lane & 15; float v[8];
#pragma unroll
        for (int j = 0; j < 8; ++j) { const int k = 32 * ks + 8 * (lane >> 4) + j, p = k >> 1, ri = k & 1; v[j] = ri ? -cim[(g * 16 + ch) * 64 + p] : cre[(g * 16 + ch) * 64 + p]; }
        v4u o; o.x = pk2(v[0], v[1]); o.y = pk2(v[2], v[3]); o.z = pk2(v[4], v[5]); o.w = pk2(v[6], v[7]);
        ((v4u*)(F.ws + WS_TAB + TAB_CF))[(g * 4 + ks) * 64 + lane] = o; }
}
__device__ __forceinline__ void p0_prologue(const Frame& F, const Args& args) {
    LAS float* scr = (LAS float*)(F.lds + F.wave * 16384);
    const int gw = F.gw, NGW = F.ngw, lane = F.lane;
    if (F.wave == 0 && blockIdx.x < 32) s5_tables(F, args, (int)blockIdx.x);
    else if (F.wave == 1 && blockIdx.x < 128) {
        const int it = (int)blockIdx.x, kv = it >> 6, part = (it >> 2) & 15, cgp = it & 3;
        const float* pos = kv ? args.in[14] : args.in[13]; const float* w1 = kv ? args.in[17] : args.in[15]; float a = 0.f;
#pragma unroll 1
        for (int r0 = 128 * part; r0 < 128 * part + 128; r0 += 32) { float wv[32];
#pragma unroll
            for (int i = 0; i < 32; ++i) wv[i] = w1[(size_t)(r0 + i) * 256 + cgp * 64 + lane];
#pragma unroll
            for (int i = 0; i < 32; ++i) a += pos[r0 + i] * wv[i]; }
        ((float*)(F.ws + WS_TAB + TAB_POSB))[(kv * 16 + part) * 256 + cgp * 64 + lane] = a;
    }
    { v4u* z = (v4u*)(F.ws + WS_WIN + (size_t)3872 * 1024 * 2); const int n16 = 224 * 1024 * 2 / 16;
      for (int i = blockIdx.x * 512 + F.tid; i < n16; i += F.G * 512) z[i] = (v4u){0u, 0u, 0u, 0u}; }
    bf16* WIN = (bf16*)(F.ws + WS_WIN); bf16* WGU = (bf16*)(F.ws + WS_WGU); bf16* WD = (bf16*)(F.ws + WS_WD); bf16* WOUT = (bf16*)(F.ws + WS_WOUT);
    bf16* WA = (bf16*)(F.ws + WS_WA); bf16* WB = (bf16*)(F.ws + WS_WB); bf16* WGLU = (bf16*)(F.ws + WS_WGLU); bf16* WC1 = (bf16*)(F.ws + WS_WC1);
    constexpr int I1 = 16 * 56, I2 = 16 * 64, I3 = 16, IGLU = 8 * 16, IUP = 8 * 32, IOUT = 16 * 32, IFF = 16 * 88, IDN = 44 * 32, ICM = 16 * 8;
    constexpr int NITEMS = I1 + I2 + I3 + IGLU + 2 * IUP + IOUT + 2 * IFF + IDN + 4 * ICM;
    auto desc = [&](int it) -> TrDesc {
        int r = it;
        if (r < I1) return TrDesc{args.in[2], WIN, INC, 1792, 1024, 32 * (r % 56), r / 56, r % 56, nullptr}; r -= I1;
        if (r < I2) return TrDesc{args.in[2] + 1816, WIN, INC, 2048, 1024, 1792 + 32 * (r % 64), r / 64, r % 64, nullptr}; r -= I2;
        if (r < I3) return TrDesc{args.in[2] + 1792, WIN, INC, 24, 1024, 3840, r, 0, nullptr}; r -= I3;
        if (r < IGLU) return TrDesc{args.in[11], WGLU, 512, 512, 512, 32 * (r % 16), r / 16, r % 16, nullptr}; r -= IGLU;
        if (r < IUP) return TrDesc{args.in[12], WA, 1024, 1024, 512, 32 * (r % 32), r / 32, r % 32, nullptr}; r -= IUP;
        if (r < IUP) return TrDesc{args.in[20], WB, 1024, 1024, 512, 32 * (r % 32), r / 32, r % 32, nullptr}; r -= IUP;
        if (r < IOUT) return TrDesc{args.in[21], WOUT, 1024, 1024, 1024, 32 * (r % 32), r / 32, r % 32, nullptr}; r -= IOUT;
        if (r < IFF) { const int nb = r % 88; return TrDesc{args.in[23], WGU, DFF, DFF, 1024, (nb >> 2) * 256 + (nb & 3) * 32, r / 88, nb, args.in[22]}; } r -= IFF;
        if (r < IFF) { const int nb = r % 88; return TrDesc{args.in[24], WGU, DFF, DFF, 1024, (nb >> 2) * 256 + (nb & 3) * 32 + 128, r / 88, nb, args.in[22]}; } r -= IFF;
        if (r < IDN) return TrDesc{args.in[25], WD, 1024, 1024, DFF, 32 * (r % 32), r / 32, r % 32, nullptr}; r -= IDN;
        const int q = r / ICM, rr = r % ICM;
        return TrDesc{((q >> 1) ? args.in[17] : args.in[15]) + (size_t)(q & 1) * 1024 * 256, WC1, 256, 256, 1024, q * 256 + 32 * (rr % 8), rr / 8, rr % 8, nullptr};
    };
    if (gw < NITEMS) {
        TrDesc dc = desc(gw); float vc[32]; tr_load(dc, vc, lane);
#pragma unroll 1
        for (int it = gw; it < NITEMS; it += NGW) {
            const bool more = it + NGW < NITEMS; TrDesc dn = desc(more ? it + NGW : it); float vn[32]; tr_load(dn, vn, lane);
            tr_finish(dc, vc, scr, lane);
            dc = dn;
#pragma unroll
            for (int i = 0; i < 32; ++i) vc[i] = vn[i];
        }
    }
    bf16* XN = (bf16*)(F.ws + WS_XN);
    for (int m = gw; m < S; m += 2 * NGW) rms_rows2_to_bf16(args.in[0] + (size_t)m * DM, args.in[0] + (size_t)(m + NGW) * DM, args.in[1], XN + (size_t)m * DM, XN + (size_t)(m + NGW) * DM, lane);
}

__device__ __forceinline__ int crow(int r, int hi) { return (r & 3) + 8 * (r >> 2) + 4 * hi; }
template <bool FINAL>
__device__ __forceinline__ void s5_unit(const Frame& F, const Args& args, int c, int g, LAS unsigned char* wl, LAS unsigned char* wx) {
    const int lane = F.lane, hi = lane >> 5;
    const bf16* U = (const bf16*)(F.ws + WS_U); bf16* Z = (bf16*)(F.ws + WS_Z);
    bf16x8 bfg[4], cfg[4], ua[8];
#pragma unroll
    for (int sub = 0; sub < 8; ++sub) ua[sub] = *(const bf16x8*)(U + (size_t)(c * 256 + sub * 32 + (lane & 31)) * 512 + g * 16 + 8 * hi);
#pragma unroll
    for (int nt = 0; nt < 4; ++nt) bfg[nt] = ((const bf16x8*)(F.ws + WS_TAB + TAB_BF))[(g * 4 + nt) * 64 + lane];
    const f32x2 lam = ((const f32x2*)(F.ws + WS_TAB + TAB_LAM))[g * 64 + lane];
    f32x2* Fst = (f32x2*)(F.ws + WS_F);
    float xr = 0.f, xi = 0.f, dsk = 0.f;
    if (FINAL) {
#pragma unroll
        for (int ks = 0; ks < 4; ++ks) cfg[ks] = ((const bf16x8*)(F.ws + WS_TAB + TAB_CF))[(g * 4 + ks) * 64 + lane];
        dsk = args.in[10][g * 16 + (lane & 15)];
        const f32x2 L2 = ((const f32x2*)(F.ws + WS_TAB + TAB_LAM256))[g * 64 + lane];
#pragma unroll 1
        for (int cp0 = 0; cp0 < c; cp0 += 16) { f32x2 fb[16];
#pragma unroll
            for (int i = 0; i < 16; ++i) fb[i] = Fst[(min(cp0 + i, c - 1) * 32 + g) * 64 + lane];
#pragma unroll
            for (int i = 0; i < 16; ++i) if (cp0 + i < c) { const float nr = L2.x * xr - L2.y * xi + fb[i].x, ni = L2.x * xi + L2.y * xr + fb[i].y; xr = nr; xi = ni; } }
    }
#pragma unroll
    for (int sub = 0; sub < 8; ++sub) {
        const int t0 = c * 256 + sub * 32;
        const bf16x8 a = ua[sub];
        if (FINAL) *(LAS bf16x8*)(wx + (lane & 31) * 32 + hi * 16) = a;
#pragma unroll
        for (int nt = 0; nt < 4; ++nt) { f32x16 acc = {}; acc = __builtin_amdgcn_mfma_f32_32x32x16_bf16(a, bfg[nt], acc, 0, 0, 0);
#pragma unroll
            for (int r = 0; r < 16; ++r) ((LAS float*)wl)[crow(r, hi) * 128 + 32 * nt + (lane & 31)] = acc[r]; }
        LDS_WAIT();
        f32x2 bu[32];
#pragma unroll
        for (int tk = 0; tk < 32; ++tk) bu[tk] = ((const LAS f32x2*)wl)[tk * 64 + lane];
        LDS_WAIT();
#pragma unroll
        for (int tk = 0; tk < 32; ++tk) { const float nr = lam.x * xr - lam.y * xi + bu[tk].x, ni = lam.x * xi + lam.y * xr + bu[tk].y; xr = nr; xi = ni;
            if (FINAL) ((LAS unsigned*)wl)[tk * 128 + ((lane + 4 * tk) & 63)] = pk2(xr, xi); }
        if (FINAL) {
            LDS_WAIT();
            LAS unsigned short* zt = (LAS unsigned short*)(wx + 1024);
#pragma unroll
            for (int mt = 0; mt < 2; ++mt) { f32x4 y4 = {0.f, 0.f, 0.f, 0.f}; const int row = 16 * mt + (lane & 15);
#pragma unroll
                for (int ks = 0; ks < 4; ++ks) { const bf16x8 xa = *(const LAS bf16x8*)(wl + row * 512 + ((64 * ks + 16 * (lane >> 4) + 16 * row) & 255)); y4 = __builtin_amdgcn_mfma_f32_16x16x32_bf16(xa, cfg[ks], y4, 0, 0, 0); }
#pragma unroll
                for (int r = 0; r < 4; ++r) { const int tok = 16 * mt + 4 * (lane >> 4) + r; const float uu = bf2f(((const LAS unsigned short*)wx)[tok * 16 + (lane & 15)]);
                    zt[tok * 16 + (lane & 15)] = (unsigned short)f2bf(gelu_tanh(y4[r] + dsk * uu)); } }
            LDS_WAIT();
            *(v4u*)(Z + (size_t)(t0 + (lane >> 1)) * 512 + g * 16 + 8 * (lane & 1)) = *(const LAS v4u*)(wx + 1024 + lane * 16);
            LDS_WAIT();
        }
    }
    if (!FINAL) Fst[(c * 32 + g) * 64 + lane] = (f32x2){xr, xi};
}

__device__ __forceinline__ int krow(int s, int h, int j) { return 16 * s + 8 * (j >> 2) + 4 * h + (j & 3); }
__device__ __forceinline__ void cmp_l2_unit(const Frame& F, const Args& args, int kv, int g, int n, LAS float* hb, const LAS float* w2s) {
    const int lane = F.lane; const float* P1 = F.out;
    float o = 0.f;
    if (n < NCMP) {
        const int rt = kv * 2048 + g * 1024 + n;
        const float* posb = (const float*)(F.ws + WS_TAB + TAB_POSB) + kv * 16 * 256;
#pragma unroll
        for (int i = 0; i < 4; ++i) { const int j = lane + 64 * i; float a = 0.f;
#pragma unroll
            for (int ks = 0; ks < CMP_KS; ++ks) a += P1[((size_t)ks * 4096 + rt) * 512 + j] + P1[((size_t)ks * 4096 + rt + 1) * 512 + 256 + j];
#pragma unroll
            for (int p = 0; p < 16; ++p) a += posb[p * 256 + j];
            hb[j] = gelu_tanh(a); }
        LDS_WAIT();
#pragma unroll 8
        for (int j = 0; j < 256; ++j) o += hb[j] * w2s[j * 64 + lane];
    }
    if (kv == 0) ((bf16*)(F.ws + WS_KCB))[((size_t)g * 1024 + n) * 64 + lane] = (bf16)f2bf(o);
    else { const int grp = n >> 5, kk = n & 31, sx = kk >> 4, rem = kk & 15, hh = (rem >> 2) & 1, j = ((rem >> 3) << 2) | (rem & 3), d0 = lane >> 5, ln = hh * 32 + (lane & 31);
        ((bf16*)(F.ws + WS_VTC))[((((size_t)(g * 32 + grp) * 2 + d0) * 2 + sx) * 64 + ln) * 8 + j] = (bf16)f2bf(o); }
    LDS_WAIT();
}
__device__ __forceinline__ void vtw_item(const Frame& F, int g, int grp, LAS unsigned short* tl) {
    const int lane = F.lane, hi = lane >> 5; const bf16* V = (const bf16*)(F.ws + WS_KVH) + (size_t)(10 + g) * S * 64 + (size_t)32 * grp * 64;
#pragma unroll
    for (int e = 0; e < 4; ++e) ((LAS v4u*)tl)[lane + 64 * e] = ((const v4u*)V)[lane + 64 * e];
    LDS_WAIT();
#pragma unroll
    for (int d0 = 0; d0 < 2; ++d0)
#pragma unroll
        for (int sx = 0; sx < 2; ++sx) { unsigned w[4];
#pragma unroll
            for (int jj = 0; jj < 4; ++jj) { const unsigned a = tl[krow(sx, hi, 2 * jj) * 64 + 32 * d0 + (lane & 31)], b = tl[krow(sx, hi, 2 * jj + 1) * 64 + 32 * d0 + (lane & 31)]; w[jj] = a | (b << 16); }
            ((v4u*)(F.ws + WS_VTW))[(((size_t)(g * 512 + grp) * 2 + d0) * 2 + sx) * 64 + lane] = (v4u){w[0], w[1], w[2], w[3]}; }
    LDS_WAIT();
}
__device__ __forceinline__ int kap(int ks, int q, int j) { return 16 * (2 * ks + (j >> 2)) + 4 * q + (j & 3); }
__device__ __forceinline__ void vts_item(const Frame& F, int g, int blk, LAS unsigned short* tl) {
    const int lane = F.lane, q = lane >> 4; const bf16* V = (const bf16*)(F.ws + WS_KVH) + (size_t)(6 + g) * S * 64 + (size_t)64 * blk * 64;
#pragma unroll
    for (int e = 0; e < 8; ++e) ((LAS v4u*)tl)[lane + 64 * e] = ((const v4u*)V)[lane + 64 * e];
    LDS_WAIT();
#pragma unroll
    for (int dt = 0; dt < 4; ++dt)
#pragma unroll
        for (int ks = 0; ks < 2; ++ks) { unsigned w[4];
#pragma unroll
            for (int jj = 0; jj < 4; ++jj) { const unsigned a = tl[kap(ks, q, 2 * jj) * 64 + 16 * dt + (lane & 15)], b = tl[kap(ks, q, 2 * jj + 1) * 64 + 16 * dt + (lane & 15)]; w[jj] = a | (b << 16); }
            ((v4u*)(F.ws + WS_VTS))[(((size_t)(g * 256 + blk) * 4 + dt) * 2 + ks) * 64 + lane] = (v4u){w[0], w[1], w[2], w[3]}; }
    LDS_WAIT();
}

constexpr int AT_SC = 0;
constexpr int AT_SEL = 67584;
constexpr int AT_CNT = AT_SEL + 4096;
constexpr int AT_LIST = AT_CNT + 1024;
constexpr int AT_BT = AT_LIST + 32768;
constexpr int AT_PARK = AT_BT + 4096;
constexpr int AT_TILE = AT_PARK + 32768;
constexpr int AT_END = AT_TILE + 16384;
static_assert(AT_END <= LDS_BYTES - 64, "attention LDS map");
constexpr int PSLOTS = 832, PSLAB = 458752;
constexpr int PML_OFF = PSLOTS * 512;
constexpr int SCS = 264;
constexpr int XRN = 624;

__device__ __forceinline__ bf16x8 pack8(float a0, float a1, float a2, float a3, float a4, float a5, float a6, float a7) {
    v4u w; w.x = cvt_pk_bf16(a0, a1); w.y = cvt_pk_bf16(a2, a3); w.z = cvt_pk_bf16(a4, a5); w.w = cvt_pk_bf16(a6, a7); return __builtin_bit_cast(bf16x8, w);
}
__device__ __forceinline__ float xmax32(float v) { auto r = __builtin_amdgcn_permlane32_swap(__float_as_uint(v), __float_as_uint(v), false, false); return fmaxf(__uint_as_float(r[0]), __uint_as_float(r[1])); }
__device__ __forceinline__ float xsum32(float v) { auto r = __builtin_amdgcn_permlane32_swap(__float_as_uint(v), __float_as_uint(v), false, false); return __uint_as_float(r[0]) + __uint_as_float(r[1]); }
__device__ __forceinline__ float xmax16(float v) { auto r = __builtin_amdgcn_permlane16_swap(__float_as_uint(v), __float_as_uint(v), false, false); return fmaxf(__uint_as_float(r[0]), __uint_as_float(r[1])); }
__device__ __forceinline__ float xsum16(float v) { auto r = __builtin_amdgcn_permlane16_swap(__float_as_uint(v), __float_as_uint(v), false, false); return __uint_as_float(r[0]) + __uint_as_float(r[1]); }
__device__ __forceinline__ float max16(const f32x16& a) {
    const float m0 = fmaxf(fmaxf(a[0], a[1]), fmaxf(a[2], a[3])), m1 = fmaxf(fmaxf(a[4], a[5]), fmaxf(a[6], a[7])), m2 = fmaxf(fmaxf(a[8], a[9]), fmaxf(a[10], a[11])), m3 = fmaxf(fmaxf(a[12], a[13]), fmaxf(a[14], a[15]));
    return fmaxf(fmaxf(m0, m1), fmaxf(m2, m3)); }
__device__ __forceinline__ float sum16(const f32x16& a) {
    const float s0 = (a[0] + a[1]) + (a[2] + a[3]), s1 = (a[4] + a[5]) + (a[6] + a[7]), s2 = (a[8] + a[9]) + (a[10] + a[11]), s3 = (a[12] + a[13]) + (a[14] + a[15]);
    return (s0 + s1) + (s2 + s3); }
__device__ __forceinline__ int fenc(float f) { int k = __float_as_int(f); return k ^ ((k >> 31) & 0x7fffffff); }
__device__ __forceinline__ float fdec(int k) { return __int_as_float(k ^ ((k >> 31) & 0x7fffffff)); }
#define MFMA32(a, b, c) __builtin_amdgcn_mfma_f32_32x32x16_bf16((a), (b), (c), 0, 0, 0)
#define MFMA16(a, b, c) __builtin_amdgcn_mfma_f32_16x16x32_bf16((a), (b), (c), 0, 0, 0)
#define DPPI(x, ctrl) __builtin_amdgcn_update_dpp(0, (x), (ctrl), 0xF, 0xF, false)

struct AttnPtrs { const bf16* Q; const bf16* KCB; const bf16x8* VTC; const bf16* KW; const bf16x8* VTW; const bf16* KS; const bf16x8* VTS; const bf16* GN; bf16* O; };

__device__ __forceinline__ void attn_stageA(const AttnPtrs& P, int lane, int wave, int tile0, int g, LAS unsigned char* lds) {
    const int hi = lane >> 5, c32 = lane & 31, ti = c32 >> 2, hr = c32 & 3, h = g * 4 + hr, t0 = tile0 + 8 * wave, t = t0 + ti;
    LAS float* scores = (LAS float*)(lds + AT_SC) + (8 * wave) * SCS; const LAS float* BT = (const LAS float*)(lds + AT_BT); LAS int* sel = (LAS int*)(lds + AT_SEL) + (8 * wave) * 16;
    for (int k = lane; k < 8 * SCS / 4; k += 64) ((LAS f32x4*)scores)[k] = (f32x4){0.f, 0.f, 0.f, 0.f};
    bf16x8 bq[4];
#pragma unroll
    for (int ks = 0; ks < 4; ++ks) bq[ks] = *(const bf16x8*)(P.Q + (size_t)t * 512 + h * 64 + 16 * ks + 8 * hi);
    const float cb = BT[hr * 256 + 64];
    const float g0 = bf2f(P.GN[(size_t)t * 32 + h * 3 + 0]), g2 = bf2f(P.GN[(size_t)t * 32 + h * 3 + 2]);
    {   LAS float* XR = (LAS float*)(lds + AT_LIST);
        for (int i = wave * 64 + lane; i < 4 * XRN; i += NWAVES * 64) { const int hh = i / XRN, d = 575 - (i - hh * XRN); XR[i] = (d < 0 || d >= 512) ? -1e30f : BT[hh * 256 + 191 - min(d, 127)]; } }
    LDS_WAIT();
    const int tid = wave * 64 + lane; LAS unsigned char* tb = lds + AT_TILE;
    const int ldrow = tid >> 3, ldch = tid & 7; const unsigned stoff = (tid < 256) ? (unsigned)(ldrow * 128 + ((ldch ^ (ldrow & 7)) << 4)) : (unsigned)(8192 + (tid - 256) * 16);
    const unsigned kof = (unsigned)(c32 * 128), ksw = (unsigned)(c32 & 7);
#define KFRAG(buf, ks) (*(const LAS bf16x8*)(tb + (buf) * 4096 + kof + ((((ks) * 2 + hi) ^ ksw) << 4)))
#define VFRAG(buf, f) (*(const LAS bf16x8*)(tb + 8192 + (buf) * 4096 + ((f) * 64 + lane) * 16))
#define STAGE_LOAD(Kp, kmax, VTp, gmax, n0v) ((tid < 256) ? *(const v4u*)((Kp) + (size_t)min((n0v) + ldrow, (kmax)) * 64 + ldch * 8) : *(const v4u*)((VTp) + (size_t)min((n0v) >> 5, (gmax)) * 256 + (tid - 256)))
#define STAGE_WRITE(v, buf) (*(LAS v4u*)(tb + (buf) * 4096 + stoff) = (v))
#define FRAG_WAIT(fr) asm volatile("s_waitcnt lgkmcnt(0)" : "+v"(fr[0]), "+v"(fr[1]), "+v"(fr[2]), "+v"(fr[3]) :: "memory")
#define KLOAD(kfr, buf) bf16x8 kfr[4]; { _Pragma("unroll") for (int ks = 0; ks < 4; ++ks) kfr[ks] = KFRAG(buf, ks); FRAG_WAIT(kfr); }
#define VLOAD(vfr, buf) bf16x8 vfr[4]; { _Pragma("unroll") for (int f = 0; f < 4; ++f) vfr[f] = VFRAG(buf, f); }
#define PVACC(o0v, o1v, vfr, a) do { const bf16x8 p0_ = pack8(a[0], a[1], a[2], a[3], a[4], a[5], a[6], a[7]), p1_ = pack8(a[8], a[9], a[10], a[11], a[12], a[13], a[14], a[15]); FRAG_WAIT(vfr); \
        o0v = MFMA32(vfr[0], p0_, o0v); o0v = MFMA32(vfr[1], p1_, o0v); o1v = MFMA32(vfr[2], p0_, o1v); o1v = MFMA32(vfr[3], p1_, o1v); } while (0)
    constexpr float SM_THR = 8.0f;
#define REF_EVENT(a, mref, started, d, fs) { const float tm_ = xmax32(max16(a)); const bool need_ = started ? (tm_ > SM_THR) : (tm_ > -1e29f); d = 0.f; fs = 1.f; \
        if (__any(need_)) { d = need_ ? tm_ : 0.f; fs = (need_ && started) ? __builtin_amdgcn_exp2f(-d) : 1.f; mref += d; started = started || need_; _Pragma("unroll") for (int r = 0; r < 16; ++r) a[r] -= d; } }
    const int ncb = (tile0 + 63 >= 31) ? min((tile0 + 63 - 31) / 16 + 1, NCMP) : 0, ntc = (ncb + 31) >> 5;
    const int nfar = (t0 >= 144) ? (t0 - 144) / 16 + 1 : 0;
#define CSCORE(a, buf, n0v, farv, refv) do { KLOAD(kfr_, buf) { const float ini_ = ((farv) ? cb : 0.f) - (refv); _Pragma("unroll") for (int r = 0; r < 16; ++r) a[r] = ini_; } \
        _Pragma("unroll") for (int ks = 0; ks < 4; ++ks) a = MFMA32(kfr_[ks], bq[ks], a); \
        if (!(farv)) { _Pragma("unroll") for (int r = 0; r < 16; ++r) { const int dist = t - (16 * ((n0v) + crow(r, hi)) + 31); a[r] += BT[hr * 256 + 191 - max(min(dist, 127), -1)]; } } } while (0)
#define STAGE_PROLOGUE(Kp, kmax, VTp, gmax, nbase, ntl) v4u RA, RB; { RA = STAGE_LOAD(Kp, kmax, VTp, gmax, nbase); STAGE_WRITE(RA, 0); RB = STAGE_LOAD(Kp, kmax, VTp, gmax, (nbase) + 32 * min(1, (ntl) - 1)); __syncthreads(); }
    float mc = 0.f, lc = 0.f; bool stc = false;
    if (ntc > 0) {
        STAGE_PROLOGUE(P.KCB, 1023, P.VTC, 31, 0, ntc)
#define C1STEP(iv, BUF, RL, RW) { const int i = (iv); if (i >= ntc) break; const int n0 = 32 * i; RL = STAGE_LOAD(P.KCB, 1023, P.VTC, 31, 32 * min(i + 2, ntc - 1)); \
            const bool far = (n0 + 32 <= nfar); f32x16 a; CSCORE(a, BUF, n0, far, mc); \
            float d_, fs_; REF_EVENT(a, mc, stc, d_, fs_) lc *= fs_; \
            _Pragma("unroll") for (int r = 0; r < 16; ++r) a[r] = __builtin_amdgcn_exp2f(a[r]); \
            lc += xsum32(sum16(a)); STAGE_WRITE(RW, (BUF) ^ 1); __syncthreads(); }
        for (int ib = 0; ; ib += 2) { C1STEP(ib, 0, RA, RB) C1STEP(ib + 1, 1, RB, RA) }
#undef C1STEP
    }
    {   const float invl = 1.0f / fmaxf(lc, 1e-30f); f32x16 oc0 = {}, oc1 = {}; float carry = 0.f;
#define CIMP(a, n0v) do { float mq[4], cq[4]; \
            _Pragma("unroll") for (int qg = 0; qg < 4; ++qg) { float mv = (2.0f * (a[4 * qg] + a[4 * qg + 1] + a[4 * qg + 2]) + a[4 * qg + 3]) * invl, cv = a[4 * qg + 3] * invl; \
                mv += __int_as_float(DPPI(__float_as_int(mv), 0xB1)); mv += __int_as_float(DPPI(__float_as_int(mv), 0x4E)); \
                cv += __int_as_float(DPPI(__float_as_int(cv), 0xB1)); cv += __int_as_float(DPPI(__float_as_int(cv), 0x4E)); mq[qg] = mv; cq[qg] = cv; } \
            float oth[4]; \
            _Pragma("unroll") for (int qg = 0; qg < 4; ++qg) { auto rr = __builtin_amdgcn_permlane32_swap(__float_as_uint(cq[qg]), __float_as_uint(cq[qg]), false, false); oth[qg] = __uint_as_float(hi ? rr[0] : rr[1]); } \
            _Pragma("unroll") for (int qg = 0; qg < 4; ++qg) { const float tot = mq[qg] + (hi ? oth[qg] : (qg ? oth[qg - 1] : carry)); if (hr == 0) scores[ti * SCS + (((n0v) + 8 * qg + 4 * hi) >> 2)] = tot; } \
            carry = oth[3]; } while (0)
        if (ntc > 0) {
            STAGE_PROLOGUE(P.KCB, 1023, P.VTC, 31, 0, ntc)
#define C2STEP(iv, BUF, RL, RW) { const int i = (iv); if (i >= ntc) break; const int n0 = 32 * i; RL = STAGE_LOAD(P.KCB, 1023, P.VTC, 31, 32 * min(i + 2, ntc - 1)); \
                const bool far = (n0 + 32 <= nfar); f32x16 a; CSCORE(a, BUF, n0, far, mc); VLOAD(vfr_, BUF) \
                _Pragma("unroll") for (int r = 0; r < 16; ++r) a[r] = __builtin_amdgcn_exp2f(a[r]); \
                CIMP(a, n0); PVACC(oc0, oc1, vfr_, a); STAGE_WRITE(RW, (BUF) ^ 1); __syncthreads(); }
            for (int ib = 0; ; ib += 2) { C2STEP(ib, 0, RA, RB) C2STEP(ib + 1, 1, RB, RA) }
#undef C2STEP
            { const int jn = ntc * 8; if (jn < 256 && hi == 0 && hr == 0) scores[ti * SCS + jn] = carry; }
        }
#undef CIMP
        {   LAS unsigned char* park = lds + AT_PARK + (((8 * wave + ti) * 4 + hr) * 64) * 2;
            const float gs = g0 * invl;
#pragma unroll
            for (int d0 = 0; d0 < 2; ++d0)
#pragma unroll
                for (int r4 = 0; r4 < 4; ++r4) { const f32x16& Wd = d0 ? oc1 : oc0; const int dim = 32 * d0 + 8 * r4 + 4 * hi;
                    *(LAS unsigned long long*)(park + dim * 2) = (unsigned long long)cvt_pk_bf16(Wd[4 * r4] * gs, Wd[4 * r4 + 1] * gs) | ((unsigned long long)cvt_pk_bf16(Wd[4 * r4 + 2] * gs, Wd[4 * r4 + 3] * gs) << 32); } } }
#undef CSCORE
    {   float mw = 0.f, lw = 0.f; bool stw = false; f32x16 o0 = {}, o1 = {};
        const int nlo = max(t0 - 511, 0) & ~31, nhi = (t0 + 7) & ~31;
        const int nlb = max(tile0 - 511, 0) & ~31, ntw = (((tile0 + 63) & ~31) - nlb) / 32 + 1;
        const LAS float* xrb = (const LAS float*)(lds + AT_LIST) + hr * XRN + (575 - ti + 4 * hi);
        STAGE_PROLOGUE(P.KW, S - 1, P.VTW, 511, nlb, ntw)
#define WSTEP(iv, BUF, RL, RW) { const int i = (iv); if (i >= ntw) break; const int n0 = nlb + 32 * i; RL = STAGE_LOAD(P.KW, S - 1, P.VTW, 511, nlb + 32 * min(i + 2, ntw - 1)); \
            if (n0 >= nlo && n0 <= nhi) { const bool mid = (n0 >= t0 - 504) && (n0 <= t0 - 144); \
                f32x16 a; if (mid) { const float ini_ = cb - mw; _Pragma("unroll") for (int r = 0; r < 16; ++r) a[r] = ini_; } \
                else { const LAS float* xr_ = xrb + (n0 - t0); _Pragma("unroll") for (int r = 0; r < 16; ++r) a[r] = xr_[(r & 3) + 8 * (r >> 2)] - mw; } \
                { KLOAD(kfr_, BUF) _Pragma("unroll") for (int ks = 0; ks < 4; ++ks) a = MFMA32(kfr_[ks], bq[ks], a); } VLOAD(vfr_, BUF) \
                float d_, fs_; REF_EVENT(a, mw, stw, d_, fs_) if (fs_ != 1.f || d_ != 0.f) { lw *= fs_; o0 = o0 * fs_; o1 = o1 * fs_; } \
                _Pragma("unroll") for (int r = 0; r < 16; ++r) a[r] = __builtin_amdgcn_exp2f(a[r]); \
                lw += xsum32(sum16(a)); PVACC(o0, o1, vfr_, a); } \
            STAGE_WRITE(RW, (BUF) ^ 1); __syncthreads(); }
        for (int ib = 0; ; ib += 2) { WSTEP(ib, 0, RA, RB) WSTEP(ib + 1, 1, RB, RA) }
#undef WSTEP
        const float sc = g2 / fmaxf(lw, 1e-30f);
        LAS unsigned char* park = lds + AT_PARK + (((8 * wave + ti) * 4 + hr) * 64) * 2;
#pragma unroll
        for (int d0 = 0; d0 < 2; ++d0)
#pragma unroll
            for (int r4 = 0; r4 < 4; ++r4) { const f32x16& Od = d0 ? o1 : o0; const int dim = 32 * d0 + 8 * r4 + 4 * hi; const unsigned long long w = *(const LAS unsigned long long*)(park + dim * 2); const unsigned lo = (unsigned)w, hw = (unsigned)(w >> 32);
                *(LAS unsigned long long*)(park + dim * 2) = (unsigned long long)cvt_pk_bf16(bflo(lo) + Od[4 * r4] * sc, bfhi(lo) + Od[4 * r4 + 1] * sc) | ((unsigned long long)cvt_pk_bf16(bflo(hw) + Od[4 * r4 + 2] * sc, bfhi(hw) + Od[4 * r4 + 3] * sc) << 32); } }
#undef REF_EVENT
#undef STAGE_PROLOGUE
#undef PVACC
#undef KLOAD
#undef FRAG_WAIT
#undef VLOAD
#undef KFRAG
#undef VFRAG
#undef STAGE_LOAD
#undef STAGE_WRITE
    LDS_WAIT();
    {   const int cur = tile0 >> 6, i = lane >> 3, s8 = lane & 7;
        if (cur + 1 <= 16) { for (int e = lane; e < 8 * 16; e += 64) sel[e] = e & 15; }
        else {
            float sv[32];
#pragma unroll
            for (int k = 0; k < 32; ++k) { const int j = s8 + 8 * k; sv[k] = (j >= 1 && j <= cur - 2) ? scores[i * SCS + j] : -3e38f; }
            if (s8 == 0) { sel[i * 16 + 0] = 0; sel[i * 16 + 1] = cur - 1; sel[i * 16 + 2] = cur; }
            for (int it = 3; it < 16; ++it) {
                float bv = sv[0]; int bj = s8;
#pragma unroll
                for (int k = 1; k < 32; ++k) if (sv[k] > bv) { bv = sv[k]; bj = s8 + 8 * k; }
#define SEL_STEP(ctrl) { const float ov = __int_as_float(DPPI(__float_as_int(bv), ctrl)); const int oj = DPPI(bj, ctrl); if (ov > bv || (ov == bv && oj < bj)) { bv = ov; bj = oj; } }
                SEL_STEP(0xB1) SEL_STEP(0x4E) SEL_STEP(0x141)
#undef SEL_STEP
                if (s8 == 0) sel[i * 16 + it] = bj;
#pragma unroll
                for (int k = 0; k < 32; ++k) if (bj == s8 + 8 * k) sv[k] = -3e38f;
            }
        }
    }
}

__device__ __forceinline__ void s_scores(const bf16x8 (&kf)[8], const bf16x8 q0, const bf16x8 q1, bool cst, float cbs, const LAS float* BT, int hd, int tt, int j, int q, float sub, f32x4 (&sa)[4]) {
    if (cst) {
#pragma unroll
        for (int mt = 0; mt < 4; ++mt) { const float ini = cbs - sub; sa[mt] = (f32x4){ini, ini, ini, ini}; } }
    else { const LAS float* xb = BT + hd * 256 + (191 - tt + 64 * j + 4 * q);
#pragma unroll
        for (int mt = 0; mt < 4; ++mt)
#pragma unroll
            for (int r = 0; r < 4; ++r) sa[mt][r] = xb[16 * mt + r] - sub; }
#pragma unroll
    for (int mt = 0; mt < 4; ++mt) { sa[mt] = MFMA16(kf[mt * 2], q0, sa[mt]); sa[mt] = MFMA16(kf[mt * 2 + 1], q1, sa[mt]); }
}
template <bool MASKED> __device__ __forceinline__ void s_softmax(f32x4 (&sa)[4], float& tm, float& ls) {
    tm = sa[0][0];
#pragma unroll
    for (int mt = 0; mt < 4; ++mt)
#pragma unroll
        for (int r = 0; r < 4; ++r) tm = fmaxf(tm, sa[mt][r]);
    tm = xmax32(xmax16(tm)); ls = 0.f;
#pragma unroll
    for (int mt = 0; mt < 4; ++mt)
#pragma unroll
        for (int r = 0; r < 4; ++r) { const float e = __builtin_amdgcn_exp2f(sa[mt][r] - tm); sa[mt][r] = (!MASKED || sa[mt][r] > -1e29f) ? e : 0.f; ls += sa[mt][r]; }
    ls = xsum32(xsum16(ls));
}
__device__ __forceinline__ void load_kf(const AttnPtrs& P, int lane, int j, bf16x8 (&kf)[8]) {
    const bf16* kp = P.KS + (size_t)(64 * j + (lane & 15)) * 64 + 8 * (lane >> 4);
#pragma unroll
    for (int mt = 0; mt < 4; ++mt) { kf[mt * 2] = *(const bf16x8*)(kp + (size_t)mt * 16 * 64); kf[mt * 2 + 1] = *(const bf16x8*)(kp + (size_t)mt * 16 * 64 + 32); }
}
__device__ __forceinline__ void load_vf(const AttnPtrs& P, int lane, int j, bf16x8 (&vf)[8]) {
    const bf16x8* vt = P.VTS + (size_t)j * 8 * 64 + lane;
#pragma unroll
    for (int e = 0; e < 8; ++e) vf[e] = vt[e * 64];
}
__device__ __forceinline__ void s_chunk(const bf16x8 (&kf)[8], const bf16x8 (&vf)[8], int j, int ch, int n, bool cst, float cbs, const LAS float* BT, const LAS unsigned short* list,
                                        const LAS unsigned char* qt, unsigned char* slab, int tile0, int c, int q, int hd, int hs) {
    const int sidx = 4 * ch + (c >> 2); const bool valid = sidx < n; const int sl = (int)list[j * 64 + (valid ? sidx : 0)]; const int tokl = sl / 13, r = tokl * 4 + hd;
    const LAS unsigned char* qr = qt + r * 128; const bf16x8 q0 = *(const LAS bf16x8*)(qr + ((q ^ (r & 7)) << 4)), q1 = *(const LAS bf16x8*)(qr + (((q + 4) ^ (r & 7)) << 4));
    float tm = ((const LAS float*)(qt + 65536))[r], ls; f32x4 sa[4]; bool second = false;
#pragma unroll 1
    for (;;) {
        s_scores(kf, q0, q1, cst, cbs, BT, hd, tile0 + tokl, j, q, tm, sa);
        if (second) { float mx = sa[0][0];
#pragma unroll
            for (int mt = 0; mt < 4; ++mt)
#pragma unroll
                for (int r4 = 0; r4 < 4; ++r4) mx = fmaxf(mx, sa[mt][r4]);
            mx = xmax32(xmax16(mx)); tm += mx;
#pragma unroll
            for (int mt = 0; mt < 4; ++mt)
#pragma unroll
                for (int r4 = 0; r4 < 4; ++r4) sa[mt][r4] -= mx; }
        ls = 0.f;
#pragma unroll
        for (int mt = 0; mt < 4; ++mt)
#pragma unroll
            for (int r4 = 0; r4 < 4; ++r4) { sa[mt][r4] = __builtin_amdgcn_exp2f(sa[mt][r4]); ls += sa[mt][r4]; }
        ls = xsum32(xsum16(ls));
        if (second || !__any(!(ls < 1e30f))) break;
        second = true; }
    const bf16x8 p0 = pack8(sa[0][0], sa[0][1], sa[0][2], sa[0][3], sa[1][0], sa[1][1], sa[1][2], sa[1][3]), p1 = pack8(sa[2][0], sa[2][1], sa[2][2], sa[2][3], sa[3][0], sa[3][1], sa[3][2], sa[3][3]);
    unsigned char* po = slab + ((size_t)(sl * 4 + hd) * 64 + 16 * q) * 2;
    unsigned pw[8];
#pragma unroll
    for (int dt = 0; dt < 4; ++dt) { f32x4 oa = {0.f, 0.f, 0.f, 0.f}; oa = MFMA16(vf[dt * 2], p0, oa); oa = MFMA16(vf[dt * 2 + 1], p1, oa); pw[2 * dt] = cvt_pk_bf16(oa[0], oa[1]); pw[2 * dt + 1] = cvt_pk_bf16(oa[2], oa[3]); }
    if (valid) { *(v4u*)po = (v4u){pw[0], pw[1], pw[2], pw[3]}; *(v4u*)(po + 16) = (v4u){pw[4], pw[5], pw[6], pw[7]}; }
    if (valid && q == 0) *(f32x2*)(slab + PML_OFF + (size_t)(sl * 4 + hd) * 8) = (f32x2){tm, ls};
}
__device__ __forceinline__ void attn_stageB(const AttnPtrs& P, int lane, int wave, int tile0, int g, LAS unsigned char* lds, unsigned char* slab) {
    const int T = tile0 >> 6, c = lane & 15, q = lane >> 4, hd = c & 3, hs = g * 4 + hd;
    if (T <= 15) return;
    LAS unsigned* cnt = (LAS unsigned*)(lds + AT_CNT); const LAS unsigned short* list = (const LAS unsigned short*)(lds + AT_LIST); const LAS float* BT = (const LAS float*)(lds + AT_BT);
    const LAS unsigned char* qt = lds + AT_SC;
    const float cbs = BT[hd * 256 + 64];
#define GRAB_ISSUE(tv) { tv = 0; if (lane == 0) tv = (int)__hip_atomic_fetch_add(&cnt[0], 1u, __ATOMIC_RELAXED, __HIP_MEMORY_SCOPE_WORKGROUP); }
#define GRAB_TAKE(tv, jv, nv) { jv = (int)__builtin_amdgcn_readfirstlane(tv) + 1; nv = 0; if (jv <= T - 2) nv = (int)__builtin_amdgcn_readfirstlane((int)cnt[jv]); }
    bf16x8 KA[8], VA[8], KB[8], VB[8];
    int jc, nc, jn, nn;
    { int t0_, t1_; GRAB_ISSUE(t0_) GRAB_ISSUE(t1_) GRAB_TAKE(t0_, jc, nc) if (jc > T - 2) return; GRAB_TAKE(t1_, jn, nn) }
    load_kf(P, lane, jc, KA); load_vf(P, lane, jc, VA);
    load_kf(P, lane, min(jn, T - 2), KB); load_vf(P, lane, min(jn, T - 2), VB);
#define BSTEP(KX, VX) { int t2_; GRAB_ISSUE(t2_) \
        { const bool cst = (jc <= T - 3);        \
          if (nc > 0) s_chunk(KX, VX, jc, 0, nc, cst, cbs, BT, list, qt, slab, tile0, c, q, hd, hs); \
          if (nc > 4) s_chunk(KX, VX, jc, 1, nc, cst, cbs, BT, list, qt, slab, tile0, c, q, hd, hs); \
          if (nc > 8) { _Pragma("unroll 1") for (int ch = 2; 4 * ch < nc; ++ch) s_chunk(KX, VX, jc, ch, nc, cst, cbs, BT, list, qt, slab, tile0, c, q, hd, hs); } } \
        int j2_, n2_; GRAB_TAKE(t2_, j2_, n2_) \
        load_kf(P, lane, min(j2_, T - 2), KX); load_vf(P, lane, min(j2_, T - 2), VX); \
        jc = jn; nc = nn; jn = j2_; nn = n2_; }
    do { BSTEP(KA, VA) BSTEP(KB, VB) } while (jc <= T - 2);
#undef BSTEP
#undef GRAB_ISSUE
#undef GRAB_TAKE
}
struct SState { float M, L; f32x4 O[4]; };
__device__ __forceinline__ void s_merge(SState& st, float m, float l, const f32x4 (&o)[4]) {
    const float mn = fmaxf(st.M, m), a0 = __builtin_amdgcn_exp2f(st.M - mn), a1 = __builtin_amdgcn_exp2f(m - mn);
    st.L = st.L * a0 + l * a1; st.M = mn;
#pragma unroll
    for (int dt = 0; dt < 4; ++dt) st.O[dt] = st.O[dt] * a0 + o[dt] * a1;
}
__device__ __forceinline__ void attn_stageC_forced(const AttnPtrs& P, int lane, int wave, int tile0, int g, LAS unsigned char* lds, SState (&st)[2]) {
    const int T = tile0 >> 6, c = lane & 15, q = lane >> 4, hd = c & 3, hs = g * 4 + hd; const LAS float* BT = (const LAS float*)(lds + AT_BT); const float cbs = BT[hd * 256 + 64];
    bf16x8 q0[2], q1[2];
#pragma unroll
    for (int k = 0; k < 2; ++k) { const int tt = tile0 + 8 * wave + 4 * k + (c >> 2); q0[k] = *(const bf16x8*)(P.Q + (size_t)tt * 512 + hs * 64 + 8 * q); q1[k] = *(const bf16x8*)(P.Q + (size_t)tt * 512 + hs * 64 + 32 + 8 * q);
        st[k].M = -1e30f; st[k].L = 0.f;
#pragma unroll
        for (int dt = 0; dt < 4; ++dt) st[k].O[dt] = (f32x4){0.f, 0.f, 0.f, 0.f}; }
    const int nf = T <= 15 ? T + 1 : 3;
    auto fblk = [&](int it) -> int { return T <= 15 ? it : (it == 0 ? 0 : (it == 1 ? T - 1 : T)); };
    bf16x8 kf[8], vf[8]; load_kf(P, lane, fblk(0), kf); load_vf(P, lane, fblk(0), vf);
#pragma unroll 1
    for (int it = 0; it < nf; ++it) { const int j = fblk(it);
        bf16x8 kn[8]; load_kf(P, lane, fblk(min(it + 1, nf - 1)), kn);
        const bool cst = (j <= T - 3);
#pragma unroll
        for (int k = 0; k < 2; ++k) { const int tt = tile0 + 8 * wave + 4 * k + (c >> 2);
            f32x4 sa[4]; s_scores(kf, q0[k], q1[k], cst, cbs, BT, hd, tt, j, q, 0.f, sa);
            float tm, ls; s_softmax<true>(sa, tm, ls);
            const bf16x8 p0 = pack8(sa[0][0], sa[0][1], sa[0][2], sa[0][3], sa[1][0], sa[1][1], sa[1][2], sa[1][3]), p1 = pack8(sa[2][0], sa[2][1], sa[2][2], sa[2][3], sa[3][0], sa[3][1], sa[3][2], sa[3][3]);
            f32x4 ob[4];
#pragma unroll
            for (int dt = 0; dt < 4; ++dt) { ob[dt] = (f32x4){0.f, 0.f, 0.f, 0.f}; ob[dt] = MFMA16(vf[dt * 2], p0, ob[dt]); ob[dt] = MFMA16(vf[dt * 2 + 1], p1, ob[dt]); }
            s_merge(st[k], tm, ls, ob); }
#pragma unroll
        for (int e = 0; e < 8; ++e) kf[e] = kn[e];
        if (it + 1 < nf) load_vf(P, lane, fblk(it + 1), vf);
    }
}
__device__ __forceinline__ void attn_stageC_forced_lds(const AttnPtrs& P, int lane, int wave, int tile0, int g, LAS unsigned char* lds, SState (&st)[2]) {
    const int T = tile0 >> 6, c = lane & 15, q = lane >> 4, hd = c & 3, hs = g * 4 + hd; const LAS float* BT = (const LAS float*)(lds + AT_BT); const float cbs = BT[hd * 256 + 64];
    bf16x8 q0[2], q1[2];
#pragma unroll
    for (int k = 0; k < 2; ++k) { const int r = (8 * wave + 4 * k + (c >> 2)) * 4 + hd; const LAS unsigned char* qr = lds + AT_SC + r * 128;
        q0[k] = *(const LAS bf16x8*)(qr + ((q ^ (r & 7)) << 4)); q1[k] = *(const LAS bf16x8*)(qr + (((q + 4) ^ (r & 7)) << 4));
        st[k].M = -1e30f; st[k].L = 0.f;
#pragma unroll
        for (int dt = 0; dt < 4; ++dt) st[k].O[dt] = (f32x4){0.f, 0.f, 0.f, 0.f}; }
#pragma unroll
    for (int it = 0; it < 3; ++it) { const int j = it == 0 ? 0 : (it == 1 ? T - 1 : T); const LAS unsigned char* fb = lds + (it == 2 ? AT_TILE : AT_SC + 32768 + 16384 * it);
        bf16x8 kf[8], vf[8];
#pragma unroll
        for (int mt = 0; mt < 4; ++mt) { const int row = 16 * mt + c; kf[mt * 2] = *(const LAS bf16x8*)(fb + row * 128 + ((q ^ (row & 7)) << 4)); kf[mt * 2 + 1] = *(const LAS bf16x8*)(fb + row * 128 + (((q + 4) ^ (row & 7)) << 4)); }
#pragma unroll
        for (int e = 0; e < 8; ++e) vf[e] = *(const LAS bf16x8*)(fb + 8192 + (e * 64 + lane) * 16);
        const bool cst = (it == 0);
#pragma unroll
        for (int k = 0; k < 2; ++k) { const int tt = tile0 + 8 * wave + 4 * k + (c >> 2);
            f32x4 sa[4]; s_scores(kf, q0[k], q1[k], cst, cbs, BT, hd, tt, j, q, 0.f, sa);
            float tm, ls; s_softmax<true>(sa, tm, ls);
            const bf16x8 p0 = pack8(sa[0][0], sa[0][1], sa[0][2], sa[0][3], sa[1][0], sa[1][1], sa[1][2], sa[1][3]), p1 = pack8(sa[2][0], sa[2][1], sa[2][2], sa[2][3], sa[3][0], sa[3][1], sa[3][2], sa[3][3]);
            f32x4 ob[4];
#pragma unroll
            for (int dt = 0; dt < 4; ++dt) { ob[dt] = (f32x4){0.f, 0.f, 0.f, 0.f}; ob[dt] = MFMA16(vf[dt * 2], p0, ob[dt]); ob[dt] = MFMA16(vf[dt * 2 + 1], p1, ob[dt]); }
            s_merge(st[k], tm, ls, ob); } }
}
__device__ __forceinline__ void attn_stageC_merge(const AttnPtrs& P, int lane, int wave, int tile0, int g, LAS unsigned char* lds, const unsigned char* slab, SState (&st)[2]) {
    const int T = tile0 >> 6, c = lane & 15, q = lane >> 4, hd = c & 3, hs = g * 4 + hd;
#pragma unroll
    for (int k = 0; k < 2; ++k) { const int tok = 8 * wave + 4 * k + (c >> 2), tt = tile0 + tok;
        if (T > 15) {
#pragma unroll
            for (int b0 = 0; b0 < 13; b0 += 13) {
                f32x2 mlv[13]; v4u ow[13][2];
#pragma unroll
                for (int bb = 0; bb < 13; ++bb) if (b0 + bb < 13) { const int sl = tok * 13 + b0 + bb;
                    mlv[bb] = *(const f32x2*)(slab + PML_OFF + (size_t)(sl * 4 + hd) * 8);
                    const unsigned char* po = slab + ((size_t)(sl * 4 + hd) * 64 + 16 * q) * 2; ow[bb][0] = *(const v4u*)po; ow[bb][1] = *(const v4u*)(po + 16); }
#pragma unroll
                for (int bb = 0; bb < 13; ++bb) if (b0 + bb < 13) { f32x4 ob[4];
                    ob[0] = (f32x4){bflo(ow[bb][0].x), bfhi(ow[bb][0].x), bflo(ow[bb][0].y), bfhi(ow[bb][0].y)}; ob[1] = (f32x4){bflo(ow[bb][0].z), bfhi(ow[bb][0].z), bflo(ow[bb][0].w), bfhi(ow[bb][0].w)};
                    ob[2] = (f32x4){bflo(ow[bb][1].x), bfhi(ow[bb][1].x), bflo(ow[bb][1].y), bfhi(ow[bb][1].y)}; ob[3] = (f32x4){bflo(ow[bb][1].z), bfhi(ow[bb][1].z), bflo(ow[bb][1].w), bfhi(ow[bb][1].w)};
                    s_merge(st[k], mlv[bb].x, mlv[bb].y, ob); } } }
        const float g1 = bf2f(P.GN[(size_t)tt * 32 + hs * 3 + 1]) / fmaxf(st[k].L, 1e-30f);
        LAS unsigned char* park = lds + AT_PARK + ((tok * 4 + hd) * 64 + 4 * q) * 2;
#pragma unroll
        for (int dt = 0; dt < 4; ++dt) { const unsigned long long w = *(const LAS unsigned long long*)(park + dt * 32); const unsigned lo = (unsigned)w, hw = (unsigned)(w >> 32);
            const unsigned o0 = cvt_pk_bf16(bflo(lo) + g1 * st[k].O[dt][0], bfhi(lo) + g1 * st[k].O[dt][1]), o1 = cvt_pk_bf16(bflo(hw) + g1 * st[k].O[dt][2], bfhi(hw) + g1 * st[k].O[dt][3]);
            *(LAS unsigned long long*)(park + dt * 32) = (unsigned long long)o0 | ((unsigned long long)o1 << 32); } }
    LDS_WAIT();
#pragma unroll
    for (int e = 0; e < 4; ++e) { const int idx = lane + 64 * e, tokl = idx >> 5, piece = idx & 31;
        *(v4u*)((unsigned char*)P.O + (size_t)(tile0 + 8 * wave + tokl) * 1024 + g * 512 + piece * 16) = *(const LAS v4u*)(lds + AT_PARK + (8 * wave + tokl) * 512 + piece * 16); }
    LDS_WAIT();
}
__device__ __forceinline__ void attn_tile(const Frame& F, unsigned char* ws, const float* pbias, int tile, int g, unsigned soff) {
    int lane = F.lane; asm volatile("" : "+v"(lane));
    const int wave = F.wave, tile0 = tile * 64, T = tile; LAS unsigned char* lds = F.lds;
    if (F.tid < 256) ((LAS unsigned*)(lds + AT_CNT))[F.tid] = 0u;
    {   LAS float* BT = (LAS float*)(lds + AT_BT);
        for (int i = F.tid; i < 4 * 256; i += NWAVES * 64) { const int hh = i >> 8, d = 191 - (i & 255); float v = -1e30f;
            if (d >= 0) { const int dd = min(d, 127); int bk = dd; if (dd >= 16) { bk = 16 + (int)(logf((float)dd * (1.0f / 16.0f)) / 2.0794415416798357f * 16.0f); if (bk > 31) bk = 31; }
                v = pbias[bk * 8 + g * 4 + hh] * 1.4426950408889634f; }
            BT[i] = v; } }
    __syncthreads();
    AttnPtrs P;
    {   const bf16* KVH = (const bf16*)(ws + WS_KVH);
        P.Q = (const bf16*)(ws + WS_Q); P.KCB = (const bf16*)(ws + WS_KCB) + (size_t)g * 1024 * 64; P.VTC = (const bf16x8*)(ws + WS_VTC) + (size_t)g * 32 * 4 * 64;
        P.KW = KVH + (size_t)(8 + g) * S * 64; P.VTW = (const bf16x8*)(ws + WS_VTW) + (size_t)g * 512 * 4 * 64; P.GN = (const bf16*)(ws + WS_GN);
        P.KS = nullptr; P.VTS = nullptr; P.O = nullptr; }
    attn_stageA(P, lane, wave, tile0, g, lds);
    __syncthreads();
    unsigned char* ws2 = ws;
    {   const bf16* KVH = (const bf16*)(ws2 + WS_KVH);
        P.Q = (const bf16*)(ws2 + WS_Q); P.KS = KVH + (size_t)(4 + g) * S * 64; P.VTS = (const bf16x8*)(ws2 + WS_VTS) + (size_t)g * 256 * 8 * 64; P.GN = (const bf16*)(ws2 + WS_GN); P.O = (bf16*)(ws2 + WS_O);
        P.KCB = nullptr; P.VTC = nullptr; P.KW = nullptr; P.VTW = nullptr; }
    unsigned char* slab = ((blockIdx.x < 128) ? (unsigned char*)F.out : ws2 + WS_PSLAB) + soff;
    if (T > 15) {
        LAS unsigned* cnt = (LAS unsigned*)(lds + AT_CNT); LAS unsigned short* list = (LAS unsigned short*)(lds + AT_LIST); const LAS int* sel = (const LAS int*)(lds + AT_SEL);
        const int tok = F.tid >> 3;
        v4u qv[4];
#pragma unroll
        for (int e = 0; e < 4; ++e) { const int idx = F.tid + 512 * e, row = idx >> 3, piece = idx & 7; qv[e] = *(const v4u*)((const unsigned char*)P.Q + (size_t)(tile0 + (row >> 2)) * 1024 + g * 512 + (row & 3) * 128 + piece * 16); }
#pragma unroll
        for (int e = 0; e < 2; ++e) { const int b = (F.tid & 7) * 2 + e;
            if (b >= 3) { const int j = sel[tok * 16 + b]; const unsigned pos = __hip_atomic_fetch_add(&cnt[j], 1u, __ATOMIC_RELAXED, __HIP_MEMORY_SCOPE_WORKGROUP); list[j * 64 + pos] = (unsigned short)(tok * 13 + b - 3); } }
#pragma unroll
        for (int e = 0; e < 4; ++e) { const int idx = F.tid + 512 * e, row = idx >> 3, piece = idx & 7; *(LAS v4u*)(lds + AT_SC + row * 128 + ((piece ^ (row & 7)) << 4)) = qv[e]; }
        {   v4u fk[3], fv[3];
#pragma unroll
            for (int e = 0; e < 3; ++e) { const int j = e == 0 ? 0 : (e == 1 ? T - 1 : T); fk[e] = *(const v4u*)((const unsigned char*)P.KS + (size_t)j * 8192 + F.tid * 16); fv[e] = *(const v4u*)((const unsigned char*)P.VTS + (size_t)j * 8192 + F.tid * 16); }
            const int row = F.tid >> 3, piece = F.tid & 7;
#pragma unroll
            for (int e = 0; e < 3; ++e) { LAS unsigned char* fb = lds + (e == 2 ? AT_TILE : AT_SC + 32768 + 16384 * e); *(LAS v4u*)(fb + row * 128 + ((piece ^ (row & 7)) << 4)) = fk[e]; *(LAS v4u*)(fb + 8192 + F.tid * 16) = fv[e]; } }
        __syncthreads(); }
    SState st[2];
    if (T > 15) { attn_stageC_forced_lds(P, lane, wave, tile0, g, lds, st);
        if (lane < 16) {
#pragma unroll
            for (int k = 0; k < 2; ++k) ((LAS float*)(lds + AT_SC + 65536))[(8 * wave + 4 * k + (lane >> 2)) * 4 + (lane & 3)] = st[k].M; }
        __syncthreads(); }
    else attn_stageC_forced(P, lane, wave, tile0, g, lds, st);
    attn_stageB(P, lane, wave, tile0, g, lds, slab);
    asm volatile("s_waitcnt vmcnt(0)" ::: "memory");
    __syncthreads();
    __builtin_amdgcn_fence(__ATOMIC_ACQUIRE, "agent");
    attn_stageC_merge(P, lane, wave, tile0, g, lds, slab, st);
    __syncthreads();
}

#define XB_TMO      128
#define XB_XCNT(j)  (256  + 64 * (j))
#define XB_XSUB(j)  (1280 + 64 * (j))
#define XB_XGEN(j)  (2304 + 64 * (j))
#define XB_TOP      3328
#define XB_TOPGEN   3392
#define XCD_BAR_WORDS 3456
#define XB_SPIN_CAP (1u << 22)
__device__ __forceinline__ unsigned xb_ld(unsigned* p)              { return __hip_atomic_load(p, __ATOMIC_RELAXED, __HIP_MEMORY_SCOPE_AGENT); }
__device__ __forceinline__ unsigned xb_add(unsigned* p, unsigned v) { return __hip_atomic_fetch_add(p, v, __ATOMIC_RELAXED, __HIP_MEMORY_SCOPE_AGENT); }
__device__ __forceinline__ unsigned xb_xcc_id() { return (unsigned)__builtin_amdgcn_s_getreg((3 << 11) | 20) & 0xFu; }
#define XB_SPIN(cond, bar) do { unsigned _sp = 0; while (cond) { __builtin_amdgcn_s_sleep(1); \
    if ((++_sp & 255u) == 0u) { if (xb_ld(&(bar)[XB_TMO])) break; if (_sp > XB_SPIN_CAP) { atomicAdd(&(bar)[XB_TMO], 1u); break; } } } } while (0)
struct XcdBarrier { unsigned* bar; unsigned x; volatile LAS unsigned* st; };
__device__ __forceinline__ XcdBarrier xcd_barrier_post(unsigned* bar, volatile LAS unsigned* st) {
    XcdBarrier b; b.bar = bar; b.x = xb_xcc_id(); b.st = st;
    if (threadIdx.x == 0) (void)xb_add(&bar[XB_XCNT(b.x)], 1u);
    return b;
}
__device__ __forceinline__ void xcd_barrier_complete(unsigned* bar, unsigned x, unsigned& nloc, unsigned& nx) {
    const unsigned G = gridDim.x * gridDim.y * gridDim.z;
    unsigned sum, cnt, mine, sp = 0u;
    for (;;) {
        sum = 0u; cnt = 0u; mine = 0u;
#pragma unroll
        for (unsigned j = 0; j < 16; ++j) { const unsigned c = xb_ld(&bar[XB_XCNT(j)]); sum += c; cnt += (c > 0u) ? 1u : 0u; mine = (j == x) ? c : mine; }
        if (sum == G) break;
        __builtin_amdgcn_s_sleep(1);
        if ((++sp & 255u) == 0u) { if (xb_ld(&bar[XB_TMO])) break; if (sp > XB_SPIN_CAP) { atomicAdd(&bar[XB_TMO], 1u); break; } }
    }
    nloc = mine > 0u ? mine : 1u; nx = cnt > 0u ? cnt : 1u;
}
__device__ __forceinline__ void xcd_barrier(const XcdBarrier& b) {
    asm volatile("s_waitcnt vmcnt(0)" ::: "memory");
    __syncthreads();
    if (threadIdx.x == 0) {
        unsigned* bar = b.bar;
        __builtin_amdgcn_s_waitcnt(0);
        unsigned nloc = b.st[0], nx = b.st[1];
        if (nloc == 0u) { xcd_barrier_complete(bar, b.x, nloc, nx); b.st[0] = nloc; b.st[1] = nx; }
        const unsigned old = xb_add(&bar[XB_XSUB(b.x)], 1u);
        const unsigned gen = old / nloc;
        if (old + 1u == (gen + 1u) * nloc) {
            __builtin_amdgcn_fence(__ATOMIC_RELEASE, "agent");
            asm volatile("s_waitcnt vmcnt(0)" ::: "memory");
            const unsigned og = xb_add(&bar[XB_TOP], 1u);
            const unsigned tg = og / nx;
            if (og + 1u == (tg + 1u) * nx) xb_add(&bar[XB_TOPGEN], 1u);
            else XB_SPIN(xb_ld(&bar[XB_TOPGEN]) == tg, bar);
            __builtin_amdgcn_fence(__ATOMIC_ACQUIRE, "agent");
            xb_add(&bar[XB_XGEN(b.x)], 1u);
            asm volatile("s_waitcnt vmcnt(0)" ::: "memory");
        } else {
            XB_SPIN(xb_ld(&bar[XB_XGEN(b.x)]) == gen, bar);
            __builtin_amdgcn_fence(__ATOMIC_ACQUIRE, "agent");
            asm volatile("s_waitcnt vmcnt(0)" ::: "memory");
        }
    }
    __syncthreads();
}

struct EpiResFinal {
    static constexpr bool PERM = false;
    const float* base; float* out; const float* gain; float* RS; unsigned* ctl; LAS float* part;
    __device__ __forceinline__ void operator()(f32x4 (&acc)[2][2][4][2], const pg8::Unit& u, int wr, int wc, int fr, int fq) const {
        using namespace pg8;
        const int row0 = u.pm * BM + wr * 64 + fr, col0 = u.pn * BM + wc * 32 + 4 * fq;
#pragma unroll
        for (int ai = 0; ai < 2; ++ai)
#pragma unroll
            for (int m = 0; m < 4; ++m) { const size_t off = (size_t)(row0 + ai * HALF + m * 16) * 1024 + col0; float ss = 0.f;
#pragma unroll
                for (int bj = 0; bj < 2; ++bj)
#pragma unroll
                    for (int n = 0; n < 2; ++n) { const f32x4 b = *(const f32x4*)(base + off + bj * HALF + n * 16); acc[ai][bj][m][n] += b; const f32x4 x2 = acc[ai][bj][m][n];
                        ss += (x2[0] * x2[0] + x2[1] * x2[1]) + (x2[2] * x2[2] + x2[3] * x2[3]); }
                ss += __shfl_xor(ss, 16); ss += __shfl_xor(ss, 32);
                if (fq == 0) part[(ai * HALF + wr * 64 + m * 16 + fr) * 4 + wc] = ss; }
        asm volatile("s_waitcnt lgkmcnt(0)" ::: "memory"); __builtin_amdgcn_s_barrier(); asm volatile("" ::: "memory");
        if (threadIdx.x < 256) { const f32x4 p = *(const LAS f32x4*)(part + threadIdx.x * 4); __hip_atomic_store(&RS[(size_t)(u.pm * BM + threadIdx.x) * 4 + u.pn], (p[0] + p[1]) + (p[2] + p[3]), __ATOMIC_RELAXED, __HIP_MEMORY_SCOPE_AGENT); }
        asm volatile("s_waitcnt vmcnt(0)" ::: "memory"); __builtin_amdgcn_s_barrier();
        if (threadIdx.x == 0) { xb_add(&ctl[3840 + u.pm], 1u); XB_SPIN(xb_ld(&ctl[3840 + u.pm]) < 4u, ctl); }
        asm volatile("s_waitcnt vmcnt(0) lgkmcnt(0)" ::: "memory"); __builtin_amdgcn_s_barrier(); asm volatile("" ::: "memory");
#pragma unroll
        for (int ai = 0; ai < 2; ++ai)
#pragma unroll
            for (int m = 0; m < 4; ++m) { const int row = row0 + ai * HALF + m * 16; const size_t off = (size_t)row * 1024 + col0;
                float rs[4];
#pragma unroll
                for (int k = 0; k < 4; ++k) rs[k] = __hip_atomic_load(&RS[(size_t)row * 4 + k], __ATOMIC_RELAXED, __HIP_MEMORY_SCOPE_AGENT);
                const float rstd = 1.0f / sqrtf(((rs[0] + rs[1]) + (rs[2] + rs[3])) * (1.f / 1024.f) + 1e-6f);
#pragma unroll
                for (int bj = 0; bj < 2; ++bj)
#pragma unroll
                    for (int n = 0; n < 2; ++n) { const f32x4 gq = *(const f32x4*)(gain + col0 + bj * HALF + n * 16); *(f32x4*)(out + off + bj * HALF + n * 16) = acc[ai][bj][m][n] * rstd * gq; } }
    }
};

__global__ void __launch_bounds__(NWAVES * 64, 2) mk_fwd(Args args) {
    extern __shared__ __attribute__((aligned(16))) unsigned char lds_raw[];
    Frame F;
    F.lds = (LAS unsigned char*)lds_raw;
#define REFRESH() do { int t_ = threadIdx.x; asm volatile("" : "+v"(t_)); F.tid = t_; F.lane = t_ & 63; F.wave = __builtin_amdgcn_readfirstlane(t_ >> 6); F.gw = blockIdx.x * NWAVES + F.wave; } while (0)
    F.G = gridDim.x; F.ngw = F.G * NWAVES; REFRESH();
    F.out = args.out; F.ws = args.ws;
    const int lo = args.ph_lo, hi = args.ph_hi;
#define IN(k) (lo <= (k) && (k) < hi)
#ifndef USE_CG_SYNC
#define USE_CG_SYNC 0
#endif
    volatile LAS unsigned* bst = (volatile LAS unsigned*)(F.lds + LDS_BYTES - 64);
    if (F.tid < 16) bst[F.tid] = 0u;
    __syncthreads();
    XcdBarrier gbar; gbar.bar = (unsigned*)(F.ws + WS_CTL); gbar.x = 0; gbar.st = bst;
    if (!USE_CG_SYNC && hi - lo > 1) gbar = xcd_barrier_post((unsigned*)(F.ws + WS_CTL), bst);
#define SEAM(k) do { if (IN(k) && IN((k) + 1)) { if (USE_CG_SYNC) cg::this_grid().sync(); else xcd_barrier(gbar); } } while (0)
    unsigned char* ws = F.ws;
    if (IN(0)) { REFRESH(); p0_prologue(F, args); }
    SEAM(0);
    if (IN(1)) { REFRESH();
        pg8::Gemm g{(const bf16*)(ws + WS_XN), (const bf16*)(ws + WS_WIN), S, NPJ, 1024, 1024}; pg8::StaticOrder So; So.init(S, NPJ, F.G, (int)blockIdx.x);
        EpiProj E{(bf16*)(ws + WS_U), (bf16*)(ws + WS_Q), (bf16*)(ws + WS_KVH), (bf16*)(ws + WS_G), (bf16*)(ws + WS_GN)};
        pg8::gemm_phase<EpiProj, pg8::StaticOrder>(F.lds, g, So, E);
    }
    SEAM(1);
    if (IN(2)) { REFRESH();
        for (int u = F.gw; u < 64 * 32; u += F.ngw) s5_unit<false>(F, args, u >> 5, u & 31, F.lds + F.wave * 16384, F.lds + 131072 + F.wave * 2048);
        __syncthreads();
        pg8::Gemm g{(const bf16*)(ws + WS_KVH), (const bf16*)(ws + WS_WC1), 4096, 1024, 1024 / CMP_KS, 1024}; pg8::CmpOrder So{F.G, (int)blockIdx.x, CMP_KS};
        EpiCmp E{F.out};
        pg8::gemm_phase<EpiCmp, pg8::CmpOrder>(F.lds, g, So, E);
    }
    SEAM(2);
    if (IN(3)) { REFRESH();
        for (int u = F.gw; u < 64 * 32; u += F.ngw) s5_unit<true>(F, args, u >> 5, u & 31, F.lds + F.wave * 16384, F.lds + 131072 + F.wave * 2048);
        for (int u0 = 0; u0 < 4 * 1024; u0 += F.ngw) { const int u = u0 + F.gw; const int kvb = (u0 + (int)blockIdx.x * NWAVES) >> 11;
            __syncthreads();
            { const float* w2 = kvb ? args.in[18] : args.in[16]; LAS f32x4* wd = (LAS f32x4*)(F.lds + 8 * 2048); for (int e = F.tid; e < 256 * 64 / 4; e += NWAVES * 64) wd[e] = ((const f32x4*)w2)[e]; }
            __syncthreads();
            if (u < 4 * 1024) { const int kvg = u >> 10, n = u & 1023; cmp_l2_unit(F, args, kvg >> 1, kvg & 1, n, (LAS float*)(F.lds + F.wave * 2048), (const LAS float*)(F.lds + 8 * 2048)); } }
        __syncthreads();
        for (int u = F.gw; u < 2 * 512; u += F.ngw) vtw_item(F, u >> 9, u & 511, (LAS unsigned short*)(F.lds + 81920 + F.wave * 8192));
        for (int u = F.gw; u < 2 * 256; u += F.ngw) vts_item(F, u >> 8, u & 255, (LAS unsigned short*)(F.lds + 81920 + F.wave * 8192));
    }
    SEAM(3);
    if (IN(4)) { REFRESH();
        for (int u = blockIdx.x; u < 256; u += F.G) {
#pragma unroll 1
            for (int g = 0; g < 2; ++g) { const int ta = ((u & 7) << 5) | (u >> 3);
                const int tile = g ? 255 - ta : ta;
                const unsigned soff = (unsigned)__builtin_amdgcn_readfirstlane((int)((blockIdx.x & 127u) * (unsigned)PSLAB));
                attn_tile(F, ws, args.in[19], tile, g, soff); } }
    }
    SEAM(4);
    if (IN(5)) { REFRESH();
        pg8::Gemm g{(const bf16*)(ws + WS_Z), (const bf16*)(ws + WS_WGLU), S, 512, 512, 512}; pg8::StaticOrder So; So.init(S, 512, F.G, (int)blockIdx.x);
        EpiGlu E{(const bf16*)(ws + WS_Z), (bf16*)(ws + WS_ZG)};
        pg8::gemm_phase<EpiGlu, pg8::StaticOrder>(F.lds, g, So, E);
    }
    SEAM(5);
    if (IN(6)) { REFRESH();
        pg8::TwoSegOrder So; So.init(S, 1024, F.G, (int)blockIdx.x);
        pg8::Gemm g{(const bf16*)(ws + WS_ZG), (const bf16*)(ws + WS_WA), S, 1024, 512, 512, (const bf16*)(ws + WS_O), (const bf16*)(ws + WS_WB)}; EpiMix2 E{(const bf16*)(ws + WS_G), (bf16*)(ws + WS_MIX)};
        pg8::gemm_phase<EpiMix2, pg8::TwoSegOrder>(F.lds, g, So, E);
    }
    SEAM(6);
    if (IN(7)) { REFRESH();
        pg8::Gemm g{(const bf16*)(ws + WS_MIX), (const bf16*)(ws + WS_WOUT), S, 1024, 1024, 1024}; pg8::StaticOrder So; So.init(S, 1024, F.G, (int)blockIdx.x);
        EpiResNorm E{args.in[0], F.out, (bf16*)(ws + WS_XN), (float*)(ws + WS_SSP), (LAS float*)(F.lds + pg8::STAGE_BYTES)};
        pg8::gemm_phase<EpiResNorm, pg8::StaticOrder>(F.lds, g, So, E);
    }
    SEAM(7);
    if (IN(9)) { REFRESH();
        pg8::Gemm g{(const bf16*)(ws + WS_XN), (const bf16*)(ws + WS_WGU), S, 2 * DFF, 1024, 1024}; pg8::StaticOrder So; So.init(S, 2 * DFF, F.G, (int)blockIdx.x);
        EpiFfn E{(bf16*)(ws + WS_H), (const float*)(ws + WS_SSP)};
        pg8::gemm_phase<EpiFfn, pg8::StaticOrder>(F.lds, g, So, E);
    }
    SEAM(9);
    const bool fuse_final = (F.G == 256) && IN(10) && IN(11);
    if (IN(10)) { REFRESH();
        pg8::Gemm g{(const bf16*)(ws + WS_H), (const bf16*)(ws + WS_WD), S, 1024, DFF, DFF}; pg8::StaticOrder So; So.init(S, 1024, F.G, (int)blockIdx.x);
        if (fuse_final) { EpiResFinal E{F.out, F.out, args.in[26], (float*)(ws + WS_SSP), (unsigned*)(ws + WS_CTL), (LAS float*)(F.lds + pg8::STAGE_BYTES)}; pg8::gemm_phase<EpiResFinal, pg8::StaticOrder>(F.lds, g, So, E); }
        else { EpiRes E{F.out, F.out}; pg8::gemm_phase<EpiRes, pg8::StaticOrder>(F.lds, g, So, E); }
    }
    if (!fuse_final) {
    SEAM(10);
    if (IN(11)) { REFRESH(); for (int m = F.gw; m < S; m += F.ngw) rms_row_f32(F.out + (size_t)m * DM, args.in[26], F.lane); }
    }
#undef IN
#undef SEAM
}

extern "C" void kernel_launch(void* const* d_in, const int* in_sizes, int n_in, void* d_out, int out_size, void* d_ws, size_t ws_size, hipStream_t stream) {
    static int grid = 0;
    if (grid == 0) {
        if (n_in != 27 || out_size != S * DM || ws_size < WS_END) { fprintf(stderr, "kernel_launch: unexpected shapes (n_in %d out %d ws %zu)\n", n_in, out_size, ws_size); grid = -1; return; }
        int dev = 0, cus = 0, per_cu = 0;
        if (hipGetDevice(&dev) != hipSuccess || hipDeviceGetAttribute(&cus, hipDeviceAttributeMultiprocessorCount, dev) != hipSuccess) { grid = -1; return; }
        if (hipFuncSetAttribute((const void*)mk_fwd, hipFuncAttributeMaxDynamicSharedMemorySize, LDS_BYTES) != hipSuccess) { fprintf(stderr, "kernel_launch: hipFuncSetAttribute failed\n"); grid = -1; return; }
        if (hipOccupancyMaxActiveBlocksPerMultiprocessor(&per_cu, (const void*)mk_fwd, NWAVES * 64, LDS_BYTES) != hipSuccess || per_cu < 1) { fprintf(stderr, "kernel_launch: occupancy query says %d\n", per_cu); per_cu = 1; }
        (void)hipGetLastError();
        grid = cus * (per_cu < 1 ? 1 : 1);
    }
    if (grid < 0) return;
    if (hipMemsetAsync((char*)d_ws + WS_CTL, 0, 16384, stream) != hipSuccess) { fprintf(stderr, "kernel_launch: hipMemsetAsync failed\n"); return; }
    Args a{};
    for (int i = 0; i < 27; ++i) a.in[i] = (const float*)d_in[i];
    a.out = (float*)d_out; a.ws = (unsigned char*)d_ws;
    if (MK_N_LAUNCHES == 1) {
        a.ph_lo = 0; a.ph_hi = NPH;
        void* kargs[] = {&a};
        hipError_t e = hipLaunchCooperativeKernel((const void*)mk_fwd, dim3(grid), dim3(NWAVES * 64), kargs, LDS_BYTES, stream);
        if (e != hipSuccess) fprintf(stderr, "kernel_launch: cooperative launch failed: %s (grid %d)\n", hipGetErrorString(e), grid);
    } else {
        for (int ph = 0; ph < NPH; ++ph) { a.ph_lo = ph; a.ph_hi = ph + 1; hipLaunchKernelGGL(mk_fwd, dim3(grid), dim3(NWAVES * 64), LDS_BYTES, stream, a); }
    }
}
```

```cpp
#include <hip/hip_runtime.h>
#include <hip/hip_cooperative_groups.h>
#include <cstdio>
#include <cstdint>
namespace cg = cooperative_groups;

#ifndef MK_N_LAUNCHES
#define MK_N_LAUNCHES 1
#endif

namespace pg8 {
#define PG8_LAS __attribute__((address_space(3)))
typedef unsigned short bf16_t;
typedef short bf16x8 __attribute__((ext_vector_type(8)));
typedef float f32x4 __attribute__((ext_vector_type(4)));
typedef unsigned u32x4 __attribute__((ext_vector_type(4)));
constexpr int BM = 256, BK = 64, HALF = 128, HTB = HALF * BK * 2, STAGE_BYTES = 8 * HTB, NXCD = 8, WGM = 8;

__host__ __device__ __forceinline__ int lds_byte(int r, int c) { const int st = (r >> 4) * 2 + (c >> 5), rr = r & 15, cc = c & 31, ob = rr * 64 + cc * 2; return st * 1024 + (ob ^ (((ob >> 9) & 1) << 5)); }
__host__ __device__ __forceinline__ void stage_rc(int b, int& R, int& C) { const int st = b / 1024, sb = b % 1024, swz = sb ^ (((sb >> 9) & 1) << 5); R = (st >> 1) * 16 + swz / 64; C = (st & 1) * 32 + (swz % 64) / 2; }
__host__ __device__ __forceinline__ int perm32(int rho) { const int n = rho >> 4, i = rho & 15; return 8 * (i >> 2) + 4 * n + (i & 3); }

struct Unit { int pm, pn, ks, seg; };
struct Gemm { const bf16_t* A; const bf16_t* Bt; int M, N, K, ld; const bf16_t* A2; const bf16_t* Bt2; };

struct StaticOrder {
    static constexpr bool SINGLE = false;
    int nM, nN, nwg, G, c;
    __host__ __device__ void init(int M, int N, int G_, int c_) { nM = M / BM; nN = N / BM; nwg = nM * nN; G = G_; c = c_; }
    __host__ __device__ bool next(int i, Unit& u) const {
        const long L = (long)i * G + c; if (L >= nwg) return false;
        int wgid = (int)L; { const int q = nwg / NXCD, r = nwg % NXCD, xcd = wgid % NXCD, off = wgid / NXCD; wgid = (xcd < r ? xcd * (q + 1) : r * (q + 1) + (xcd - r) * q) + off; }
        const int nig = WGM * nN, gid = wgid / nig, fm = gid * WGM, gsz = (nM - fm) < WGM ? (nM - fm) : WGM;
        u.pm = fm + ((wgid % nig) % gsz); u.pn = (wgid % nig) / gsz; u.ks = 0; u.seg = 0; return true;
    }
};
struct TwoSegOrder : StaticOrder {
    __host__ __device__ bool next(int i, Unit& u) const { if (!StaticOrder::next(i >> 1, u)) return false; u.seg = i & 1; return true; }
};
struct CmpOrder {
    static constexpr bool SINGLE = true;
    int G, c, KS;
    __host__ __device__ bool next(int i, Unit& u) const {
        const int L = i * G + c; if (L >= 32 * KS) return false;
        const int tile = L / KS; u.ks = L % KS; u.pm = tile >> 1; u.pn = (tile & 1) + (u.pm >= 8 ? 2 : 0); u.seg = 0; return true;
    }
};

typedef float f32x2_t __attribute__((ext_vector_type(2))); typedef __bf16 bf16x2_t __attribute__((ext_vector_type(2)));
__device__ __forceinline__ unsigned cvt_pk_bf16(float lo, float hi) { f32x2_t v = {lo, hi}; bf16x2_t b = __builtin_convertvector(v, bf16x2_t); return __builtin_bit_cast(unsigned, b); }
__device__ __forceinline__ float bflo(unsigned w) { return __uint_as_float(w << 16); }
__device__ __forceinline__ float bfhi(unsigned w) { return __uint_as_float(w & 0xffff0000u); }
__device__ __forceinline__ float sigm(float x) { return __builtin_amdgcn_rcpf(1.0f + __expf(-x)); }

template <class Epi, class Sched>
__device__ __forceinline__ void gemm_phase(PG8_LAS unsigned char* lds, const Gemm g, const Sched& S, const Epi& E) {
    const int tid = threadIdx.x, wid = __builtin_amdgcn_readfirstlane(tid >> 6), lane = tid & 63, wr = wid >> 2, wc = wid & 3, fr = lane & 15, fq = lane >> 4;
    const int K = g.K, ld = g.ld, nt = K / BK;
    unsigned voffA[2], voffB[2];
#pragma unroll
    for (int i = 0; i < 2; ++i) { int R, C; stage_rc(tid * 16 + i * 8192, R, C); const int Rb = Epi::PERM ? ((R & ~31) + perm32(R & 31)) : R;
        voffA[i] = (unsigned)(R * ld + C) * 2u; voffB[i] = (unsigned)(Rb * ld + C) * 2u; }
    const size_t kstep = (size_t)(BK * 2);
    const size_t hstep = (size_t)HALF * ld * 2;
    const size_t tstep = 2 * hstep;
    const unsigned ldsw = (unsigned)wid * 1024u;
    const int aoff = lds_byte(wr * 64 + fr, fq * 8), boff = lds_byte(wc * 32 + fr, fq * 8);
#define PG8_SA(b, h) (((b) * 2 + (h)) * HTB)
#define PG8_SB(b, h) ((4 + (b) * 2 + (h)) * HTB)
#define PG8_STAGE(bufoff, gbase, voff) do { _Pragma("unroll") for (int _i = 0; _i < 2; ++_i) \
        __builtin_amdgcn_global_load_lds((const unsigned*)((const char*)(gbase) + (voff)[_i]), (PG8_LAS unsigned*)(lds + (bufoff) + ldsw + _i * 8192), 16, 0, 0); } while (0)
#define PG8_LDA(dst, b, h) do { _Pragma("unroll") for (int m = 0; m < 4; ++m) _Pragma("unroll") for (int k = 0; k < 2; ++k) dst[m][k] = *(const PG8_LAS bf16x8*)(lds + PG8_SA(b, h) + aoff + m * 2048 + k * 1024); } while (0)
#define PG8_LDB(dst, b, h) do { _Pragma("unroll") for (int n = 0; n < 2; ++n) _Pragma("unroll") for (int k = 0; k < 2; ++k) dst[n][k] = *(const PG8_LAS bf16x8*)(lds + PG8_SB(b, h) + boff + n * 2048 + k * 1024); } while (0)
#define PG8_MMA(ai, bj, At, Bt) do { __builtin_amdgcn_s_setprio(1); _Pragma("unroll") for (int m = 0; m < 4; ++m) _Pragma("unroll") for (int n = 0; n < 2; ++n) _Pragma("unroll") for (int k = 0; k < 2; ++k) \
        acc[ai][bj][m][n] = __builtin_amdgcn_mfma_f32_16x16x32_bf16(Bt[n][k], At[m][k], acc[ai][bj][m][n], 0, 0, 0); __builtin_amdgcn_s_setprio(0); } while (0)
#define PG8_WAIT_V(n) asm volatile("s_waitcnt vmcnt(" #n ")" ::: "memory")
#define PG8_WAIT_L(n) asm volatile("s_waitcnt lgkmcnt(" #n ")" ::: "memory")
#define PG8_BAR __builtin_amdgcn_s_barrier()
#define PG8_SCHED __builtin_amdgcn_sched_barrier(0)
    Unit cur, nxt; int ui = 0;
    if (!S.next(0, cur)) return;
    f32x4 acc[2][2][4][2];
#pragma unroll
    for (int a = 0; a < 2; ++a)
#pragma unroll
        for (int b = 0; b < 2; ++b)
#pragma unroll
            for (int m = 0; m < 4; ++m)
#pragma unroll
                for (int n = 0; n < 2; ++n) acc[a][b][m][n] = (f32x4){0.f, 0.f, 0.f, 0.f};
    bf16x8 At[4][2], B0[2][2], B1[2][2];
    const char* cA = (const char*)(cur.seg ? g.A2 : g.A) + (size_t)cur.pm * tstep + (size_t)cur.ks * K * 2; const char* cB = (const char*)(cur.seg ? g.Bt2 : g.Bt) + (size_t)cur.pn * tstep + (size_t)cur.ks * K * 2;
    PG8_STAGE(PG8_SB(0, 0), cB, voffB); PG8_STAGE(PG8_SB(0, 1), cB + hstep, voffB); PG8_STAGE(PG8_SA(0, 0), cA, voffA); PG8_STAGE(PG8_SA(0, 1), cA + hstep, voffA);
    if (wr == 1) PG8_BAR;
    PG8_WAIT_V(2); PG8_BAR;
    PG8_STAGE(PG8_SB(1, 0), cB + kstep, voffB); PG8_STAGE(PG8_SA(1, 0), cA + kstep, voffA); PG8_STAGE(PG8_SB(1, 1), cB + hstep + kstep, voffB);
    PG8_WAIT_V(6); PG8_BAR;
    for (;;) {
        const bool has_next = Sched::SINGLE ? false : S.next(ui + 1, nxt);
        const char* nA = has_next ? (const char*)(nxt.seg ? g.A2 : g.A) + (size_t)nxt.pm * tstep + (size_t)nxt.ks * K * 2 : cA; const char* nB = has_next ? (const char*)(nxt.seg ? g.Bt2 : g.Bt) + (size_t)nxt.pn * tstep + (size_t)nxt.ks * K * 2 : cB;
        for (int t = 0; t < nt; t += 2) {
            const bool last = (t == nt - 2);
            const char* a1 = cA + (size_t)(t + 1) * kstep;
            const char* a2 = last ? nA : cA + (size_t)(t + 2) * kstep; const char* b2 = last ? nB : cB + (size_t)(t + 2) * kstep;
            const char* a3 = a2 + kstep; const char* b3 = b2 + kstep;
            PG8_LDB(B0, 0, 0); PG8_LDB(B1, 0, 1); PG8_SCHED; PG8_LDA(At, 0, 0); PG8_STAGE(PG8_SA(1, 1), a1 + hstep, voffA);
            PG8_WAIT_V(8); PG8_WAIT_L(0); PG8_BAR; PG8_MMA(0, 0, At, B0); PG8_MMA(0, 1, At, B1); PG8_BAR; PG8_SCHED;
            PG8_LDA(At, 0, 1); PG8_STAGE(PG8_SB(0, 0), b2, voffB); PG8_STAGE(PG8_SB(0, 1), b2 + hstep, voffB); PG8_STAGE(PG8_SA(0, 0), a2, voffA);
            PG8_WAIT_V(8); PG8_WAIT_L(0); PG8_BAR; PG8_MMA(1, 0, At, B0); PG8_MMA(1, 1, At, B1); PG8_BAR; PG8_SCHED;
            PG8_LDB(B0, 1, 0); PG8_LDB(B1, 1, 1); PG8_SCHED; PG8_LDA(At, 1, 0); PG8_STAGE(PG8_SA(0, 1), a2 + hstep, voffA);
            PG8_WAIT_V(8); PG8_WAIT_L(0); PG8_BAR; PG8_MMA(0, 0, At, B0); PG8_MMA(0, 1, At, B1); PG8_BAR; PG8_SCHED;
            PG8_LDA(At, 1, 1); PG8_STAGE(PG8_SB(1, 0), b3, voffB); PG8_STAGE(PG8_SB(1, 1), b3 + hstep, voffB); PG8_STAGE(PG8_SA(1, 0), a3, voffA);
            PG8_WAIT_V(8); PG8_WAIT_L(0); PG8_BAR; PG8_MMA(1, 0, At, B0); PG8_MMA(1, 1, At, B1); PG8_BAR; PG8_SCHED;
        }
        if (wr == 0) PG8_BAR;
        E(acc, cur, wr, wc, fr, fq);
        if (!has_next) break;
        if (!nxt.seg) {
#pragma unroll
        for (int a = 0; a < 2; ++a)
#pragma unroll
            for (int b = 0; b < 2; ++b)
#pragma unroll
                for (int m = 0; m < 4; ++m)
#pragma unroll
                    for (int n = 0; n < 2; ++n) acc[a][b][m][n] = (f32x4){0.f, 0.f, 0.f, 0.f}; }
        cur = nxt; cA = nA; cB = nB; ++ui;
        if (wr == 1) PG8_BAR;
    }
    PG8_WAIT_V(0);
    PG8_BAR;
#undef PG8_SA
#undef PG8_SB
#undef PG8_STAGE
#undef PG8_LDA
#undef PG8_LDB
#undef PG8_MMA
#undef PG8_WAIT_V
#undef PG8_WAIT_L
#undef PG8_BAR
#undef PG8_SCHED
}
}

constexpr int S = 16384, DM = 1024, INC = 3864, NPJ = 4096, SSW = 512, NSW = 512, HD = 64, DFF = 2816;
constexpr int NGRP = 32, NST = 64, NCMP = 1023;
constexpr int NWAVES = 8;
constexpr int NPH = 12;
constexpr int CMP_KS = 4;
constexpr float EPS = 1e-6f;

constexpr size_t MiB = 1u << 20;
constexpr size_t WS_CTL = 0;
constexpr size_t WS_TAB = 1 * MiB;
constexpr size_t TAB_BF = 0, TAB_CF = 128 * 1024, TAB_LAM = 256 * 1024, TAB_LAM256 = 272 * 1024, TAB_POSB = 288 * 1024, TAB_POSBS = 420 * 1024;
constexpr size_t WS_SSP = 1 * MiB + 512 * 1024;
constexpr size_t WS_F = 2 * MiB;
constexpr size_t WS_KVC = 3 * MiB;
constexpr size_t WS_WIN = 4 * MiB, WS_WGU = 12 * MiB, WS_WD = 23 * MiB, WS_WOUT = 29 * MiB, WS_WA = 31 * MiB, WS_WB = 32 * MiB, WS_WGLU = 33 * MiB, WS_WC1 = 34 * MiB;
constexpr size_t WS_XN = 36 * MiB;
constexpr size_t WS_Z = WS_XN, WS_ZG = WS_XN + 16 * MiB;
constexpr size_t WS_U = 68 * MiB, WS_O = WS_U;
constexpr size_t WS_Q = 84 * MiB;
constexpr size_t WS_KVH = 100 * MiB;
constexpr size_t WS_G = 124 * MiB;
constexpr size_t WS_GN = 188 * MiB;
constexpr size_t WS_MIX = 84 * MiB;
constexpr size_t WS_H = 100 * MiB;
constexpr size_t WS_VTW = 189 * MiB;
constexpr size_t WS_VTS = 193 * MiB;
constexpr size_t WS_KCB = 197 * MiB;
constexpr size_t WS_VTC = 197 * MiB + 512 * 1024;
constexpr size_t WS_PSLAB = 198 * MiB;
constexpr size_t WS_END = 254 * MiB;

constexpr int LDS_BYTES = 163840;

#define GAS __attribute__((address_space(1)))
#define LAS __attribute__((address_space(3)))
typedef unsigned short bf16;
typedef unsigned v4u __attribute__((ext_vector_type(4)));
typedef float f32x4 __attribute__((ext_vector_type(4)));
typedef float f32x2 __attribute__((ext_vector_type(2)));
typedef float f32x16 __attribute__((ext_vector_type(16)));
typedef short bf16x8 __attribute__((ext_vector_type(8)));
#define LDS_WAIT() asm volatile("s_waitcnt lgkmcnt(0)" ::: "memory")
#define VM_WAIT() asm volatile("s_waitcnt vmcnt(0)" ::: "memory")
typedef float f32x2c_t __attribute__((ext_vector_type(2))); typedef __bf16 bf16x2c_t __attribute__((ext_vector_type(2)));
__device__ __forceinline__ unsigned pk2(float lo, float hi) { f32x2c_t v = {lo, hi}; bf16x2c_t b = __builtin_convertvector(v, bf16x2c_t); return __builtin_bit_cast(unsigned, b); }
__device__ __forceinline__ unsigned f2bf(float f) { return pk2(f, 0.f) & 0xffffu; }
__device__ __forceinline__ float bf2f(bf16 v) { return __uint_as_float((unsigned)v << 16); }
using pg8::bflo; using pg8::bfhi; using pg8::sigm; using pg8::cvt_pk_bf16;
__device__ __forceinline__ float gelu_tanh(float y) {
    const float a = 0.7978845608028654f * (y + 0.044715f * y * y * y);
    const float e = __expf(2.0f * a);
    const float th = 1.0f - 2.0f * __builtin_amdgcn_rcpf(e + 1.0f);
    return 0.5f * y * (1.0f + th);
}
__device__ __forceinline__ float wave_sum(float v) {
#pragma unroll
    for (int o = 1; o < 64; o <<= 1) v += __shfl_xor(v, o);
    return v;
}
__device__ __forceinline__ float wave_max(float v) {
#pragma unroll
    for (int o = 1; o < 64; o <<= 1) v = fmaxf(v, __shfl_xor(v, o));
    return v;
}

struct Args { const float* in[27]; float* out; unsigned char* ws; int ph_lo, ph_hi; };

struct Frame {
    LAS unsigned char* lds;
    int tid, lane, wave, G, gw, ngw;
    float* out; unsigned char* ws;
};

using pg8::Unit; using pg8::BM; using pg8::HALF;
struct EpiProj {
    static constexpr bool PERM = true;
    bf16 *U, *Q, *KVH, *Gt, *GN;
    __device__ __forceinline__ void operator()(const f32x4 (&acc)[2][2][4][2], const Unit& u, int wr, int wc, int fr, int fq) const {
        const int row0 = u.pm * BM + wr * 64 + fr, pn = u.pn;
#pragma unroll
        for (int ai = 0; ai < 2; ++ai)
#pragma unroll
            for (int m = 0; m < 4; ++m) { const int row = row0 + ai * HALF + m * 16;
#pragma unroll
                for (int bj = 0; bj < 2; ++bj) { f32x4 v0 = acc[ai][bj][m][0], v1 = acc[ai][bj][m][1]; const int col = bj * HALF + wc * 32 + 8 * fq; bf16* dst;
                    if (pn < 2) dst = U + (size_t)row * 512 + pn * 256 + col;
                    else if (pn < 4) { v0 = v0 * (0.125f * 1.4426950408889634f); v1 = v1 * (0.125f * 1.4426950408889634f); dst = Q + (size_t)row * 512 + (pn - 2) * 256 + col; }
                    else if (pn < 7) dst = KVH + ((size_t)((pn - 4) * 4 + (col >> 6)) * S + row) * 64 + (col & 63);
                    else { v0 = (f32x4){sigm(v0[0]), sigm(v0[1]), sigm(v0[2]), sigm(v0[3])}; v1 = (f32x4){sigm(v1[0]), sigm(v1[1]), sigm(v1[2]), sigm(v1[3])};
                        if (pn < 15) dst = Gt + (size_t)row * 2048 + (pn - 7) * 256 + col; else { if (col >= 32) continue; dst = GN + (size_t)row * 32 + col; } }
                    v4u w; w.x = cvt_pk_bf16(v0[0], v0[1]); w.y = cvt_pk_bf16(v0[2], v0[3]); w.z = cvt_pk_bf16(v1[0], v1[1]); w.w = cvt_pk_bf16(v1[2], v1[3]);
                    *(v4u*)dst = w; } }
    }
};
struct EpiCmp {
    static constexpr bool PERM = false;
    float* C;
    __device__ __forceinline__ void operator()(const f32x4 (&acc)[2][2][4][2], const Unit& u, int wr, int wc, int fr, int fq) const {
        const int row0 = u.pm * BM + wr * 64 + fr, col0 = (u.pn & 1) * BM + wc * 32 + 4 * fq; float* base = C + (size_t)u.ks * 4096 * 512;
#pragma unroll
        for (int ai = 0; ai < 2; ++ai)
#pragma unroll
            for (int m = 0; m < 4; ++m) { float* rowp = base + (size_t)(row0 + ai * HALF + m * 16) * 512 + col0;
#pragma unroll
                for (int bj = 0; bj < 2; ++bj)
#pragma unroll
                    for (int n = 0; n < 2; ++n) *(f32x4*)(rowp + bj * HALF + n * 16) = acc[ai][bj][m][n]; }
    }
};
struct EpiGlu {
    static constexpr bool PERM = true;
    const bf16* Z; bf16* ZG;
    __device__ __forceinline__ void operator()(const f32x4 (&acc)[2][2][4][2], const Unit& u, int wr, int wc, int fr, int fq) const {
        const int row0 = u.pm * BM + wr * 64 + fr;
#pragma unroll
        for (int ai = 0; ai < 2; ++ai)
#pragma unroll
            for (int m = 0; m < 4; ++m) { const int row = row0 + ai * HALF + m * 16;
#pragma unroll
                for (int bj = 0; bj < 2; ++bj) { const f32x4 v0 = acc[ai][bj][m][0], v1 = acc[ai][bj][m][1]; const size_t off = (size_t)row * 512 + u.pn * BM + bj * HALF + wc * 32 + 8 * fq;
                    const v4u z = *(const v4u*)(Z + off); v4u w;
                    w.x = cvt_pk_bf16(bflo(z.x) * sigm(v0[0]), bfhi(z.x) * sigm(v0[1])); w.y = cvt_pk_bf16(bflo(z.y) * sigm(v0[2]), bfhi(z.y) * sigm(v0[3]));
                    w.z = cvt_pk_bf16(bflo(z.z) * sigm(v1[0]), bfhi(z.z) * sigm(v1[1])); w.w = cvt_pk_bf16(bflo(z.w) * sigm(v1[2]), bfhi(z.w) * sigm(v1[3]));
                    *(v4u*)(ZG + off) = w; } }
    }
};
struct EpiMix2 {
    static constexpr bool PERM = true;
    const bf16* Gt; bf16* MIX;
    __device__ __forceinline__ void operator()(f32x4 (&acc)[2][2][4][2], const Unit& u, int wr, int wc, int fr, int fq) const {
        const int row0 = u.pm * BM + wr * 64 + fr;
#pragma unroll
        for (int ai = 0; ai < 2; ++ai)
#pragma unroll
            for (int m = 0; m < 4; ++m) { const int row = row0 + ai * HALF + m * 16;
#pragma unroll
                for (int bj = 0; bj < 2; ++bj) { const int col = u.pn * BM + bj * HALF + wc * 32 + 8 * fq;
                    const v4u gb = *(const v4u*)(Gt + (size_t)row * 2048 + 1024 + col);
                    const float b8[8] = {bflo(gb.x), bfhi(gb.x), bflo(gb.y), bfhi(gb.y), bflo(gb.z), bfhi(gb.z), bflo(gb.w), bfhi(gb.w)};
                    if (u.seg == 0) { const v4u ga = *(const v4u*)(Gt + (size_t)row * 2048 + col);
                        const float a8[8] = {bflo(ga.x), bfhi(ga.x), bflo(ga.y), bfhi(ga.y), bflo(ga.z), bfhi(ga.z), bflo(ga.w), bfhi(ga.w)};
#pragma unroll
                        for (int e = 0; e < 4; ++e) { acc[ai][bj][m][0][e] *= a8[e] * __builtin_amdgcn_rcpf(b8[e]); acc[ai][bj][m][1][e] *= a8[4 + e] * __builtin_amdgcn_rcpf(b8[4 + e]); }
                    } else { const f32x4 v0 = acc[ai][bj][m][0], v1 = acc[ai][bj][m][1]; v4u w;
                        w.x = cvt_pk_bf16(v0[0] * b8[0], v0[1] * b8[1]); w.y = cvt_pk_bf16(v0[2] * b8[2], v0[3] * b8[3]); w.z = cvt_pk_bf16(v1[0] * b8[4], v1[1] * b8[5]); w.w = cvt_pk_bf16(v1[2] * b8[6], v1[3] * b8[7]);
                        *(v4u*)(MIX + (size_t)row * 1024 + col) = w; } } }
    }
};
struct EpiRes {
    static constexpr bool PERM = false;
    const float* base; float* out;
    __device__ __forceinline__ void operator()(const f32x4 (&acc)[2][2][4][2], const Unit& u, int wr, int wc, int fr, int fq) const {
        const int row0 = u.pm * BM + wr * 64 + fr, col0 = u.pn * BM + wc * 32 + 4 * fq;
#pragma unroll
        for (int ai = 0; ai < 2; ++ai)
#pragma unroll
            for (int m = 0; m < 4; ++m) { const size_t off = (size_t)(row0 + ai * HALF + m * 16) * 1024 + col0;
#pragma unroll
                for (int bj = 0; bj < 2; ++bj)
#pragma unroll
                    for (int n = 0; n < 2; ++n) { const f32x4 b = *(const f32x4*)(base + off + bj * HALF + n * 16); *(f32x4*)(out + off + bj * HALF + n * 16) = b + acc[ai][bj][m][n]; } }
    }
};
struct EpiResNorm {
    static constexpr bool PERM = false;
    const float* base; float* out; bf16* XN; float* SSP; LAS float* part;
    __device__ __forceinline__ void operator()(const f32x4 (&acc)[2][2][4][2], const Unit& u, int wr, int wc, int fr, int fq) const {
        const int row0 = u.pm * BM + wr * 64 + fr, col0 = u.pn * BM + wc * 32 + 4 * fq;
#pragma unroll
        for (int ai = 0; ai < 2; ++ai)
#pragma unroll
            for (int m = 0; m < 4; ++m) { const size_t off = (size_t)(row0 + ai * HALF + m * 16) * 1024 + col0; float ss = 0.f;
#pragma unroll
                for (int bj = 0; bj < 2; ++bj)
#pragma unroll
                    for (int n = 0; n < 2; ++n) { const f32x4 b = *(const f32x4*)(base + off + bj * HALF + n * 16); const f32x4 x1 = b + acc[ai][bj][m][n]; *(f32x4*)(out + off + bj * HALF + n * 16) = x1;
                        *(unsigned long long*)(XN + off + bj * HALF + n * 16) = (unsigned long long)cvt_pk_bf16(x1[0], x1[1]) | ((unsigned long long)cvt_pk_bf16(x1[2], x1[3]) << 32);
                        ss += (x1[0] * x1[0] + x1[1] * x1[1]) + (x1[2] * x1[2] + x1[3] * x1[3]); }
                ss += __shfl_xor(ss, 16); ss += __shfl_xor(ss, 32);
                if (fq == 0) part[(ai * HALF + wr * 64 + m * 16 + fr) * 4 + wc] = ss; }
        asm volatile("s_waitcnt lgkmcnt(0)" ::: "memory"); __builtin_amdgcn_s_barrier(); asm volatile("" ::: "memory");
        if (threadIdx.x < 256) { const f32x4 p = *(const LAS f32x4*)(part + threadIdx.x * 4); SSP[(size_t)(u.pm * BM + threadIdx.x) * 4 + u.pn] = (p[0] + p[1]) + (p[2] + p[3]); }
    }
};
struct EpiFfn {
    static constexpr bool PERM = true;
    bf16* H; const float* SSP;
    __device__ __forceinline__ void operator()(const f32x4 (&acc)[2][2][4][2], const Unit& u, int wr, int wc, int fr, int fq) const {
        const int row0 = u.pm * BM + wr * 64 + fr;
#pragma unroll
        for (int ai = 0; ai < 2; ++ai)
#pragma unroll
            for (int m = 0; m < 4; ++m) { const int row = row0 + ai * HALF + m * 16;
                const f32x4 sp = *(const f32x4*)(SSP + (size_t)row * 4); const float rs = 1.0f / sqrtf(((sp[0] + sp[1]) + (sp[2] + sp[3])) * (1.f / 1024.f) + 1e-6f);
                float r[8];
#pragma unroll
                for (int n = 0; n < 2; ++n)
#pragma unroll
                    for (int e = 0; e < 4; ++e) { const float gt = acc[ai][0][m][n][e] * rs, up = acc[ai][1][m][n][e] * rs; r[n * 4 + e] = gt * sigm(gt) * up; }
                v4u w; w.x = cvt_pk_bf16(r[0], r[1]); w.y = cvt_pk_bf16(r[2], r[3]); w.z = cvt_pk_bf16(r[4], r[5]); w.w = cvt_pk_bf16(r[6], r[7]);
                *(v4u*)(H + (size_t)row * DFF + u.pn * HALF + wc * 32 + 8 * fq) = w; }
    }
};

struct TrDesc { const float* src; bf16* dst; int ld, ncols, dld, drow, kb, nb; const float* gain; };
__device__ __forceinline__ void tr_load(const TrDesc& d, float (&v)[32], int lane) {
    const int k0 = 64 * d.kb, c = 32 * d.nb + (lane & 31); const bool ok = c < d.ncols; const float* p = d.src + (size_t)(k0 + (lane >> 5)) * d.ld + c;
#pragma unroll
    for (int i = 0; i < 32; ++i) v[i] = ok ? p[(size_t)(2 * i) * d.ld] : 0.f;
    if (d.gain) {
#pragma unroll
        for (int i = 0; i < 32; ++i) v[i] *= d.gain[k0 + 2 * i + (lane >> 5)]; }
}
__device__ __forceinline__ void tr_finish(const TrDesc& d, const float (&v)[32], LAS float* scr, int lane) {
#pragma unroll
    for (int i = 0; i < 32; ++i) scr[(2 * i + (lane >> 5)) * 33 + (lane & 31)] = v[i];
    LDS_WAIT();
    const int cc = lane & 7, k0 = 64 * d.kb;
#pragma unroll
    for (int j = 0; j < 4; ++j) { const int n = (lane >> 3) + 8 * j; const LAS float* s = scr + (8 * cc) * 33 + n;
        v4u o; o.x = pk2(s[0 * 33], s[1 * 33]); o.y = pk2(s[2 * 33], s[3 * 33]); o.z = pk2(s[4 * 33], s[5 * 33]); o.w = pk2(s[6 * 33], s[7 * 33]);
        *(v4u*)(d.dst + (size_t)(d.drow + n) * d.dld + k0 + 8 * cc) = o; }
    LDS_WAIT();
}
__device__ __forceinline__ void rms_row_to_bf16(const float* xrow, const float* gain, bf16* orow, int lane) {
    const f32x4* xr = (const f32x4*)xrow + lane; const f32x4* gr = (const f32x4*)gain + lane;
    f32x4 v[4]; float s = 0.f;
#pragma unroll
    for (int j = 0; j < 4; ++j) { v[j] = xr[64 * j]; s += (v[j].x * v[j].x + v[j].y * v[j].y) + (v[j].z * v[j].z + v[j].w * v[j].w); }
    const float rstd = 1.0f / sqrtf(wave_sum(s) * (1.f / DM) + EPS);
    unsigned long long* o8 = (unsigned long long*)orow + lane;
#pragma unroll
    for (int j = 0; j < 4; ++j) { const f32x4 gq = gr[64 * j];
        o8[64 * j] = (unsigned long long)pk2(v[j].x * rstd * gq.x, v[j].y * rstd * gq.y) | ((unsigned long long)pk2(v[j].z * rstd * gq.z, v[j].w * rstd * gq.w) << 32); }
}
__device__ __forceinline__ void rms_rows2_to_bf16(const float* x0, const float* x1, const float* gain, bf16* o0, bf16* o1, int lane) {
    const f32x4* xa = (const f32x4*)x0 + lane; const f32x4* xb = (const f32x4*)x1 + lane; const f32x4* gr = (const f32x4*)gain + lane;
    f32x4 va[4], vb[4]; float sa = 0.f, sb = 0.f;
#pragma unroll
    for (int j = 0; j < 4; ++j) { va[j] = xa[64 * j]; vb[j] = xb[64 * j]; }
#pragma unroll
    for (int j = 0; j < 4; ++j) { sa += (va[j].x * va[j].x + va[j].y * va[j].y) + (va[j].z * va[j].z + va[j].w * va[j].w); sb += (vb[j].x * vb[j].x + vb[j].y * vb[j].y) + (vb[j].z * vb[j].z + vb[j].w * vb[j].w); }
    const float ra = 1.0f / sqrtf(wave_sum(sa) * (1.f / DM) + EPS), rb = 1.0f / sqrtf(wave_sum(sb) * (1.f / DM) + EPS);
    unsigned long long* pa = (unsigned long long*)o0 + lane; unsigned long long* pb = (unsigned long long*)o1 + lane;
#pragma unroll
    for (int j = 0; j < 4; ++j) { const f32x4 gq = gr[64 * j];
        pa[64 * j] = (unsigned long long)pk2(va[j].x * ra * gq.x, va[j].y * ra * gq.y) | ((unsigned long long)pk2(va[j].z * ra * gq.z, va[j].w * ra * gq.w) << 32);
        pb[64 * j] = (unsigned long long)pk2(vb[j].x * rb * gq.x, vb[j].y * rb * gq.y) | ((unsigned long long)pk2(vb[j].z * rb * gq.z, vb[j].w * rb * gq.w) << 32); }
}
__device__ __forceinline__ void rms_row_f32(float* xrow, const float* gain, int lane) {
    f32x4* xr = (f32x4*)xrow + lane; const f32x4* gr = (const f32x4*)gain + lane;
    f32x4 v[4]; float s = 0.f;
#pragma unroll
    for (int j = 0; j < 4; ++j) { v[j] = xr[64 * j]; s += (v[j].x * v[j].x + v[j].y * v[j].y) + (v[j].z * v[j].z + v[j].w * v[j].w); }
    const float rstd = 1.0f / sqrtf(wave_sum(s) * (1.f / DM) + EPS);
#pragma unroll
    for (int j = 0; j < 4; ++j) { const f32x4 gq = gr[64 * j]; xr[64 * j] = v[j] * rstd * gq; }
}
__device__ __forceinline__ void s5_tables(const Frame& F, const Args& args, int g, int part) {
    const int lane = F.lane;
    const float* are = args.in[3]; const float* aim = args.in[4]; const float* ldt = args.in[5]; const float* bre = args.in[6]; const float* bim = args.in[7]; const float* cre = args.in[8]; const float* cim = args.in[9];
    const double dt = exp((double)ldt[g]);
    if (part == 0) {   const int p = lane; const double ar = are[g * 64 + p], ai = aim[g * 64 + p];
        const double er = exp(ar * dt), lr = er * cos(ai * dt), li = er * sin(ai * dt);
        ((f32x2*)(F.ws + WS_TAB + TAB_LAM))[g * 64 + p] = (f32x2){(float)lr, (float)li};
        const double e2 = exp(ar * dt * 256.0), l2r = e2 * cos(ai * dt * 256.0), l2i = e2 * sin(ai * dt * 256.0);
        ((f32x2*)(F.ws + WS_TAB + TAB_LAM256))[g * 64 + p] = (f32x2){(float)l2r, (float)l2i}; }
    if (part >= 1 && part <= 4) { const int nt = part - 1; const int col = 32 * nt + (lane & 31), p = col >> 1, ri = col & 1;
        const double ar = are[g * 64 + p], ai = aim[g * 64 + p];
        const double er = exp(ar * dt), lr = er * cos(ai * dt) - 1.0, li = er * sin(ai * dt);
        const double den = ar * ar + ai * ai, kr = (lr * ar + li * ai) / den, ki = (li * ar - lr * ai) / den;
        float v[8];
#pragma unroll
        for (int j = 0; j < 8; ++j) { const int c = 8 * (lane >> 5) + j; const double br = bre[(g * 64 + p) * 16 + c], bi = bim[(g * 64 + p) * 16 + c];
            v[j] = (float)(ri ? (kr * bi + ki * br) : (kr * br - ki * bi)); }
        v4u o; o.x = pk2(v[0], v[1]); o.y = pk2(v[2], v[3]); o.z = pk2(v[4], v[5]); o.w = pk2(v[6], v[7]);
        ((v4u*)(F.ws + WS_TAB + TAB_BF))[(g * 4 + nt) * 64 + lane] = o; }
    if (part == 5)
#pragma unroll
    for (int ks = 0; ks < 4; ++ks) { const int ch = lane & 15; float v[8];
#pragma unroll
        for (int j = 0; j < 8; ++j) { const int k = 32 * ks + 8 * (lane >> 4) + j, p = k >> 1, ri = k & 1; v[j] = ri ? -cim[(g * 16 + ch) * 64 + p] : cre[(g * 16 + ch) * 64 + p]; }
        v4u o; o.x = pk2(v[0], v[1]); o.y = pk2(v[2], v[3]); o.z = pk2(v[4], v[5]); o.w = pk2(v[6], v[7]);
        ((v4u*)(F.ws + WS_TAB + TAB_CF))[(g * 4 + ks) * 64 + lane] = o; }
}
__device__ __forceinline__ void p0_prologue(const Frame& F, const Args& args) {
    LAS float* scr = (LAS float*)(F.lds + F.wave * 16384);
    const int gw = F.gw, NGW = F.ngw, lane = F.lane;
    if (F.wave == 0 && blockIdx.x < 192) s5_tables(F, args, (int)blockIdx.x & 31, (int)blockIdx.x >> 5);
    else if (F.wave == 1 || F.wave == 2) {
        for (int it = (int)blockIdx.x * 2 + (F.wave - 1); it < 512; it += F.G * 2) { const int kv = it >> 8, part = (it >> 2) & 63, cgp = it & 3;
            const float* pos = kv ? args.in[14] : args.in[13]; const float* w1 = kv ? args.in[17] : args.in[15]; float a = 0.f; const int r0 = 32 * part; float wv[32];
#pragma unroll
            for (int i = 0; i < 32; ++i) wv[i] = w1[(size_t)(r0 + i) * 256 + cgp * 64 + lane];
#pragma unroll
            for (int i = 0; i < 32; ++i) a += pos[r0 + i] * wv[i];
            ((float*)(F.ws + WS_TAB + TAB_POSB))[(kv * 64 + part) * 256 + cgp * 64 + lane] = a; }
    }
    { v4u* z = (v4u*)(F.ws + WS_WIN + (size_t)3872 * 1024 * 2); const int n16 = 224 * 1024 * 2 / 16;
      for (int i = blockIdx.x * 512 + F.tid; i < n16; i += F.G * 512) z[i] = (v4u){0u, 0u, 0u, 0u}; }
    bf16* WIN = (bf16*)(F.ws + WS_WIN); bf16* WGU = (bf16*)(F.ws + WS_WGU); bf16* WD = (bf16*)(F.ws + WS_WD); bf16* WOUT = (bf16*)(F.ws + WS_WOUT);
    bf16* WA = (bf16*)(F.ws + WS_WA); bf16* WB = (bf16*)(F.ws + WS_WB); bf16* WGLU = (bf16*)(F.ws + WS_WGLU); bf16* WC1 = (bf16*)(F.ws + WS_WC1);
    constexpr int I1 = 16 * 56, I2 = 16 * 64, I3 = 16, IGLU = 8 * 16, IUP = 8 * 32, IOUT = 16 * 32, IFF = 16 * 88, IDN = 44 * 32, ICM = 16 * 8;
    constexpr int NITEMS = I1 + I2 + I3 + IGLU + 2 * IUP + IOUT + 2 * IFF + IDN + 4 * ICM;
    auto desc = [&](int it) -> TrDesc {
        int r = it;
        if (r < I1) return TrDesc{args.in[2], WIN, INC, 1792, 1024, 32 * (r % 56), r / 56, r % 56, nullptr}; r -= I1;
        if (r < I2) return TrDesc{args.in[2] + 1816, WIN, INC, 2048, 1024, 1792 + 32 * (r % 64), r / 64, r % 64, nullptr}; r -= I2;
        if (r < I3) return TrDesc{args.in[2] + 1792, WIN, INC, 24, 1024, 3840, r, 0, nullptr}; r -= I3;
        if (r < IGLU) return TrDesc{args.in[11], WGLU, 512, 512, 512, 32 * (r % 16), r / 16, r % 16, nullptr}; r -= IGLU;
        if (r < IUP) return TrDesc{args.in[12], WA, 1024, 1024, 512, 32 * (r % 32), r / 32, r % 32, nullptr}; r -= IUP;
        if (r < IUP) return TrDesc{args.in[20], WB, 1024, 1024, 512, 32 * (r % 32), r / 32, r % 32, nullptr}; r -= IUP;
        if (r < IOUT) return TrDesc{args.in[21], WOUT, 1024, 1024, 1024, 32 * (r % 32), r / 32, r % 32, nullptr}; r -= IOUT;
        if (r < IFF) { const int nb = r % 88; return TrDesc{args.in[23], WGU, DFF, DFF, 1024, (nb >> 2) * 256 + (nb & 3) * 32, r / 88, nb, args.in[22]}; } r -= IFF;
        if (r < IFF) { const int nb = r % 88; return TrDesc{args.in[24], WGU, DFF, DFF, 1024, (nb >> 2) * 256 + (nb & 3) * 32 + 128, r / 88, nb, args.in[22]}; } r -= IFF;
        if (r < IDN) return TrDesc{args.in[25], WD, 1024, 1024, DFF, 32 * (r % 32), r / 32, r % 32, nullptr}; r -= IDN;
        const int q = r / ICM, rr = r % ICM;
        return TrDesc{((q >> 1) ? args.in[17] : args.in[15]) + (size_t)(q & 1) * 1024 * 256, WC1, 256, 256, 1024, q * 256 + 32 * (rr % 8), rr / 8, rr % 8, nullptr};
    };
    if (gw < NITEMS) {
        TrDesc dc = desc(gw); float vc[32]; tr_load(dc, vc, lane);
#pragma unroll 1
        for (int it = gw; it < NITEMS; it += NGW) {
            const bool more = it + NGW < NITEMS; TrDesc dn = desc(more ? it + NGW : it); float vn[32]; tr_load(dn, vn, lane);
            tr_finish(dc, vc, scr, lane);
            dc = dn;
#pragma unroll
            for (int i = 0; i < 32; ++i) vc[i] = vn[i];
        }
    }
    bf16* XN = (bf16*)(F.ws + WS_XN);
    for (int m = gw; m < S; m += 2 * NGW) rms_rows2_to_bf16(args.in[0] + (size_t)m * DM, args.in[0] + (size_t)(m + NGW) * DM, args.in[1], XN + (size_t)m * DM, XN + (size_t)(m + NGW) * DM, lane);
}

__device__ __forceinline__ int crow(int r, int hi) { return (r & 3) + 8 * (r >> 2) + 4 * hi; }
template <bool FINAL>
__device__ __forceinline__ void s5_unit(const Frame& F, const Args& args, int c, int g, LAS unsigned char* wl, LAS unsigned char* wx) {
    const int lane = F.lane, hi = lane >> 5;
    const bf16* U = (const bf16*)(F.ws + WS_U); bf16* Z = (bf16*)(F.ws + WS_Z);
    bf16x8 bfg[4], cfg[4], ua[8];
#pragma unroll
    for (int sub = 0; sub < 8; ++sub) ua[sub] = *(const bf16x8*)(U + (size_t)(c * 256 + sub * 32 + (lane & 31)) * 512 + g * 16 + 8 * hi);
#pragma unroll
    for (int nt = 0; nt < 4; ++nt) bfg[nt] = ((const bf16x8*)(F.ws + WS_TAB + TAB_BF))[(g * 4 + nt) * 64 + lane];
    const f32x2 lam = ((const f32x2*)(F.ws + WS_TAB + TAB_LAM))[g * 64 + lane];
    f32x2* Fst = (f32x2*)(F.ws + WS_F);
    float xr = 0.f, xi = 0.f, dsk = 0.f;
    if (FINAL) {
#pragma unroll
        for (int ks = 0; ks < 4; ++ks) cfg[ks] = ((const bf16x8*)(F.ws + WS_TAB + TAB_CF))[(g * 4 + ks) * 64 + lane];
        dsk = args.in[10][g * 16 + (lane & 15)];
        const f32x2 L2 = ((const f32x2*)(F.ws + WS_TAB + TAB_LAM256))[g * 64 + lane];
#pragma unroll 1
        for (int cp0 = 0; cp0 < c; cp0 += 16) { f32x2 fb[16];
#pragma unroll
            for (int i = 0; i < 16; ++i) fb[i] = Fst[(min(cp0 + i, c - 1) * 32 + g) * 64 + lane];
#pragma unroll
            for (int i = 0; i < 16; ++i) if (cp0 + i < c) { const float nr = L2.x * xr - L2.y * xi + fb[i].x, ni = L2.x * xi + L2.y * xr + fb[i].y; xr = nr; xi = ni; } }
    }
#pragma unroll
    for (int sub = 0; sub < 8; ++sub) {
        const int t0 = c * 256 + sub * 32;
        const bf16x8 a = ua[sub];
        if (FINAL) *(LAS bf16x8*)(wx + (lane & 31) * 32 + hi * 16) = a;
#pragma unroll
        for (int nt = 0; nt < 4; ++nt) { f32x16 acc = {}; acc = __builtin_amdgcn_mfma_f32_32x32x16_bf16(a, bfg[nt], acc, 0, 0, 0);
#pragma unroll
            for (int r = 0; r < 16; ++r) ((LAS float*)wl)[crow(r, hi) * 128 + 32 * nt + (lane & 31)] = acc[r]; }
        LDS_WAIT();
        f32x2 bu[32];
#pragma unroll
        for (int tk = 0; tk < 32; ++tk) bu[tk] = ((const LAS f32x2*)wl)[tk * 64 + lane];
        LDS_WAIT();
#pragma unroll
        for (int tk = 0; tk < 32; ++tk) { const float nr = lam.x * xr - lam.y * xi + bu[tk].x, ni = lam.x * xi + lam.y * xr + bu[tk].y; xr = nr; xi = ni;
            if (FINAL) ((LAS unsigned*)wl)[tk * 128 + ((lane + 4 * tk) & 63)] = pk2(xr, xi); }
        if (FINAL) {
            LDS_WAIT();
            LAS unsigned short* zt = (LAS unsigned short*)(wx + 1024);
#pragma unroll
            for (int mt = 0; mt < 2; ++mt) { f32x4 y4 = {0.f, 0.f, 0.f, 0.f}; const int row = 16 * mt + (lane & 15);
#pragma unroll
                for (int ks = 0; ks < 4; ++ks) { const bf16x8 xa = *(const LAS bf16x8*)(wl + row * 512 + ((64 * ks + 16 * (lane >> 4) + 16 * row) & 255)); y4 = __builtin_amdgcn_mfma_f32_16x16x32_bf16(xa, cfg[ks], y4, 0, 0, 0); }
#pragma unroll
                for (int r = 0; r < 4; ++r) { const int tok = 16 * mt + 4 * (lane >> 4) + r; const float uu = bf2f(((const LAS unsigned short*)wx)[tok * 16 + (lane & 15)]);
                    zt[tok * 16 + (lane & 15)] = (unsigned short)f2bf(gelu_tanh(y4[r] + dsk * uu)); } }
            LDS_WAIT();
            *(v4u*)(Z + (size_t)(t0 + (lane >> 1)) * 512 + g * 16 + 8 * (lane & 1)) = *(const LAS v4u*)(wx + 1024 + lane * 16);
            LDS_WAIT();
        }
    }
    if (!FINAL) Fst[(c * 32 + g) * 64 + lane] = (f32x2){xr, xi};
}

__device__ __forceinline__ int krow(int s, int h, int j) { return 16 * s + 8 * (j >> 2) + 4 * h + (j & 3); }
__device__ __forceinline__ void cmp_l2_unit(const Frame& F, const Args& args, int kv, int g, int n, LAS float* hb, const LAS float* w2s) {
    const int lane = F.lane; const float* P1 = F.out;
    float o = 0.f;
    if (n < NCMP) {
        const int rt = kv * 2048 + g * 1024 + n;
        const float* posb = (const float*)(F.ws + WS_TAB + TAB_POSBS) + kv * 256;
#pragma unroll
        for (int i = 0; i < 4; ++i) { const int j = lane + 64 * i; float a = 0.f;
#pragma unroll
            for (int ks = 0; ks < CMP_KS; ++ks) a += P1[((size_t)ks * 4096 + rt) * 512 + j] + P1[((size_t)ks * 4096 + rt + 1) * 512 + 256 + j];
            a += posb[j];
            hb[j] = gelu_tanh(a); }
        LDS_WAIT();
#pragma unroll 8
        for (int j = 0; j < 256; ++j) o += hb[j] * w2s[j * 64 + lane];
    }
    if (kv == 0) ((bf16*)(F.ws + WS_KCB))[((size_t)g * 1024 + n) * 64 + lane] = (bf16)f2bf(o);
    else { const int grp = n >> 5, kk = n & 31, sx = kk >> 4, rem = kk & 15, hh = (rem >> 2) & 1, j = ((rem >> 3) << 2) | (rem & 3), d0 = lane >> 5, ln = hh * 32 + (lane & 31);
        ((bf16*)(F.ws + WS_VTC))[((((size_t)(g * 32 + grp) * 2 + d0) * 2 + sx) * 64 + ln) * 8 + j] = (bf16)f2bf(o); }
    LDS_WAIT();
}
__device__ __forceinline__ void vtw_item(const Frame& F, int g, int grp, LAS unsigned short* tl) {
    const int lane = F.lane, hi = lane >> 5; const bf16* V = (const bf16*)(F.ws + WS_KVH) + (size_t)(10 + g) * S * 64 + (size_t)32 * grp * 64;
#pragma unroll
    for (int e = 0; e < 4; ++e) ((LAS v4u*)tl)[lane + 64 * e] = ((const v4u*)V)[lane + 64 * e];
    LDS_WAIT();
#pragma unroll
    for (int d0 = 0; d0 < 2; ++d0)
#pragma unroll
        for (int sx = 0; sx < 2; ++sx) { unsigned w[4];
#pragma unroll
            for (int jj = 0; jj < 4; ++jj) { const unsigned a = tl[krow(sx, hi, 2 * jj) * 64 + 32 * d0 + (lane & 31)], b = tl[krow(sx, hi, 2 * jj + 1) * 64 + 32 * d0 + (lane & 31)]; w[jj] = a | (b << 16); }
            ((v4u*)(F.ws + WS_VTW))[(((size_t)(g * 512 + grp) * 2 + d0) * 2 + sx) * 64 + lane] = (v4u){w[0], w[1], w[2], w[3]}; }
    LDS_WAIT();
}
__device__ __forceinline__ int kap(int ks, int q, int j) { return 16 * (2 * ks + (j >> 2)) + 4 * q + (j & 3); }
__device__ __forceinline__ void vts_item(const Frame& F, int g, int blk, LAS unsigned short* tl) {
    const int lane = F.lane, q = lane >> 4; const bf16* V = (const bf16*)(F.ws + WS_KVH) + (size_t)(6 + g) * S * 64 + (size_t)64 * blk * 64;
#pragma unroll
    for (int e = 0; e < 8; ++e) ((LAS v4u*)tl)[lane + 64 * e] = ((const v4u*)V)[lane + 64 * e];
    LDS_WAIT();
#pragma unroll
    for (int dt = 0; dt < 4; ++dt)
#pragma unroll
        for (int ks = 0; ks < 2; ++ks) { unsigned w[4];
#pragma unroll
            for (int jj = 0; jj < 4; ++jj) { const unsigned a = tl[kap(ks, q, 2 * jj) * 64 + 16 * dt + (lane & 15)], b = tl[kap(ks, q, 2 * jj + 1) * 64 + 16 * dt + (lane & 15)]; w[jj] = a | (b << 16); }
            ((v4u*)(F.ws + WS_VTS))[(((size_t)(g * 256 + blk) * 4 + dt) * 2 + ks) * 64 + lane] = (v4u){w[0], w[1], w[2], w[3]}; }
    LDS_WAIT();
}

constexpr int AT_SC = 0;
constexpr int AT_SEL = 67584;
constexpr int AT_CNT = AT_SEL + 4096;
constexpr int AT_LIST = AT_CNT + 1024;
constexpr int AT_BT = AT_LIST + 32768;
constexpr int AT_PARK = AT_BT + 4096;
constexpr int AT_TILE = AT_PARK + 32768;
constexpr int AT_END = AT_TILE + 16384;
static_assert(AT_END <= LDS_BYTES - 64, "attention LDS map");
constexpr int PSLOTS = 832, PSLAB = 458752;
constexpr int PML_OFF = PSLOTS * 512;
constexpr int SCS = 264;
constexpr int XRN = 624;

__device__ __forceinline__ bf16x8 pack8(float a0, float a1, float a2, float a3, float a4, float a5, float a6, float a7) {
    v4u w; w.x = cvt_pk_bf16(a0, a1); w.y = cvt_pk_bf16(a2, a3); w.z = cvt_pk_bf16(a4, a5); w.w = cvt_pk_bf16(a6, a7); return __builtin_bit_cast(bf16x8, w);
}
__device__ __forceinline__ float xmax32(float v) { auto r = __builtin_amdgcn_permlane32_swap(__float_as_uint(v), __float_as_uint(v), false, false); return fmaxf(__uint_as_float(r[0]), __uint_as_float(r[1])); }
__device__ __forceinline__ float xsum32(float v) { auto r = __builtin_amdgcn_permlane32_swap(__float_as_uint(v), __float_as_uint(v), false, false); return __uint_as_float(r[0]) + __uint_as_float(r[1]); }
__device__ __forceinline__ float xmax16(float v) { auto r = __builtin_amdgcn_permlane16_swap(__float_as_uint(v), __float_as_uint(v), false, false); return fmaxf(__uint_as_float(r[0]), __uint_as_float(r[1])); }
__device__ __forceinline__ float xsum16(float v) { auto r = __builtin_amdgcn_permlane16_swap(__float_as_uint(v), __float_as_uint(v), false, false); return __uint_as_float(r[0]) + __uint_as_float(r[1]); }
__device__ __forceinline__ float max16(const f32x16& a) {
    const float m0 = fmaxf(fmaxf(a[0], a[1]), fmaxf(a[2], a[3])), m1 = fmaxf(fmaxf(a[4], a[5]), fmaxf(a[6], a[7])), m2 = fmaxf(fmaxf(a[8], a[9]), fmaxf(a[10], a[11])), m3 = fmaxf(fmaxf(a[12], a[13]), fmaxf(a[14], a[15]));
    return fmaxf(fmaxf(m0, m1), fmaxf(m2, m3)); }
__device__ __forceinline__ float sum16(const f32x16& a) {
    const float s0 = (a[0] + a[1]) + (a[2] + a[3]), s1 = (a[4] + a[5]) + (a[6] + a[7]), s2 = (a[8] + a[9]) + (a[10] + a[11]), s3 = (a[12] + a[13]) + (a[14] + a[15]);
    return (s0 + s1) + (s2 + s3); }
__device__ __forceinline__ int fenc(float f) { int k = __float_as_int(f); return k ^ ((k >> 31) & 0x7fffffff); }
__device__ __forceinline__ float fdec(int k) { return __int_as_float(k ^ ((k >> 31) & 0x7fffffff)); }
#define MFMA32(a, b, c) __builtin_amdgcn_mfma_f32_32x32x16_bf16((a), (b), (c), 0, 0, 0)
#define MFMA16(a, b, c) __builtin_amdgcn_mfma_f32_16x16x32_bf16((a), (b), (c), 0, 0, 0)
#define DPPI(x, ctrl) __builtin_amdgcn_update_dpp(0, (x), (ctrl), 0xF, 0xF, false)

struct AttnPtrs { const bf16* Q; const bf16* KCB; const bf16x8* VTC; const bf16* KW; const bf16x8* VTW; const bf16* KS; const bf16x8* VTS; const bf16* GN; bf16* O; };

__device__ __forceinline__ void attn_stageA(const AttnPtrs& P, int lane, int wave, int tile0, int g, LAS unsigned char* lds) {
    const int hi = lane >> 5, c32 = lane & 31, ti = c32 >> 2, hr = c32 & 3, h = g * 4 + hr, t0 = tile0 + 8 * wave, t = t0 + ti;
    LAS float* scores = (LAS float*)(lds + AT_SC) + (8 * wave) * SCS; const LAS float* BT = (const LAS float*)(lds + AT_BT); LAS int* sel = (LAS int*)(lds + AT_SEL) + (8 * wave) * 16;
    for (int k = lane; k < 8 * SCS / 4; k += 64) ((LAS f32x4*)scores)[k] = (f32x4){0.f, 0.f, 0.f, 0.f};
    bf16x8 bq[4];
#pragma unroll
    for (int ks = 0; ks < 4; ++ks) bq[ks] = *(const bf16x8*)(P.Q + (size_t)t * 512 + h * 64 + 16 * ks + 8 * hi);
    const float cb = BT[hr * 256 + 64];
    const float g0 = bf2f(P.GN[(size_t)t * 32 + h * 3 + 0]), g2 = bf2f(P.GN[(size_t)t * 32 + h * 3 + 2]);
    {   LAS float* XR = (LAS float*)(lds + AT_LIST);
        for (int i = wave * 64 + lane; i < 4 * XRN; i += NWAVES * 64) { const int hh = i / XRN, d = 575 - (i - hh * XRN); XR[i] = (d < 0 || d >= 512) ? -1e30f : BT[hh * 256 + 191 - min(d, 127)]; } }
    LDS_WAIT();
    const int tid = wave * 64 + lane; LAS unsigned char* tb = lds + AT_TILE;
    const int ldrow = tid >> 3, ldch = tid & 7; const unsigned stoff = (tid < 256) ? (unsigned)(ldrow * 128 + ((ldch ^ (ldrow & 7)) << 4)) : (unsigned)(8192 + (tid - 256) * 16);
    const unsigned kof = (unsigned)(c32 * 128), ksw = (unsigned)(c32 & 7);
#define KFRAG(buf, ks) (*(const LAS bf16x8*)(tb + (buf) * 4096 + kof + ((((ks) * 2 + hi) ^ ksw) << 4)))
#define VFRAG(buf, f) (*(const LAS bf16x8*)(tb + 8192 + (buf) * 4096 + ((f) * 64 + lane) * 16))
#define STAGE_LOAD(Kp, kmax, VTp, gmax, n0v) ((tid < 256) ? *(const v4u*)((Kp) + (size_t)min((n0v) + ldrow, (kmax)) * 64 + ldch * 8) : *(const v4u*)((VTp) + (size_t)min((n0v) >> 5, (gmax)) * 256 + (tid - 256)))
#define STAGE_WRITE(v, buf) (*(LAS v4u*)(tb + (buf) * 4096 + stoff) = (v))
#define FRAG_WAIT(fr) asm volatile("s_waitcnt lgkmcnt(0)" : "+v"(fr[0]), "+v"(fr[1]), "+v"(fr[2]), "+v"(fr[3]) :: "memory")
#define KLOAD(kfr, buf) bf16x8 kfr[4]; { _Pragma("unroll") for (int ks = 0; ks < 4; ++ks) kfr[ks] = KFRAG(buf, ks); FRAG_WAIT(kfr); }
#define VLOAD(vfr, buf) bf16x8 vfr[4]; { _Pragma("unroll") for (int f = 0; f < 4; ++f) vfr[f] = VFRAG(buf, f); }
#define PVACC(o0v, o1v, vfr, a) do { const bf16x8 p0_ = pack8(a[0], a[1], a[2], a[3], a[4], a[5], a[6], a[7]), p1_ = pack8(a[8], a[9], a[10], a[11], a[12], a[13], a[14], a[15]); FRAG_WAIT(vfr); \
        o0v = MFMA32(vfr[0], p0_, o0v); o0v = MFMA32(vfr[1], p1_, o0v); o1v = MFMA32(vfr[2], p0_, o1v); o1v = MFMA32(vfr[3], p1_, o1v); } while (0)
    constexpr float SM_THR = 8.0f;
#define REF_EVENT(a, mref, started, d, fs) { const float tm_ = xmax32(max16(a)); const bool need_ = started ? (tm_ > SM_THR) : (tm_ > -1e29f); d = 0.f; fs = 1.f; \
        if (__any(need_)) { d = need_ ? tm_ : 0.f; fs = (need_ && started) ? __builtin_amdgcn_exp2f(-d) : 1.f; mref += d; started = started || need_; _Pragma("unroll") for (int r = 0; r < 16; ++r) a[r] -= d; } }
    const int ncb = (tile0 + 63 >= 31) ? min((tile0 + 63 - 31) / 16 + 1, NCMP) : 0, ntc = (ncb + 31) >> 5;
    const int nfar = (t0 >= 144) ? (t0 - 144) / 16 + 1 : 0;
#define CSCORE(a, buf, n0v, farv, refv) do { KLOAD(kfr_, buf) { const float ini_ = ((farv) ? cb : 0.f) - (refv); _Pragma("unroll") for (int r = 0; r < 16; ++r) a[r] = ini_; } \
        _Pragma("unroll") for (int ks = 0; ks < 4; ++ks) a = MFMA32(kfr_[ks], bq[ks], a); \
        if (!(farv)) { _Pragma("unroll") for (int r = 0; r < 16; ++r) { const int dist = t - (16 * ((n0v) + crow(r, hi)) + 31); a[r] += BT[hr * 256 + 191 - max(min(dist, 127), -1)]; } } } while (0)
#define STAGE_PROLOGUE(Kp, kmax, VTp, gmax, nbase, ntl) v4u RA, RB; { RA = STAGE_LOAD(Kp, kmax, VTp, gmax, nbase); STAGE_WRITE(RA, 0); RB = STAGE_LOAD(Kp, kmax, VTp, gmax, (nbase) + 32 * min(1, (ntl) - 1)); __syncthreads(); }
    float mc = 0.f, lc = 0.f; bool stc = false;
    if (ntc > 0) {
        STAGE_PROLOGUE(P.KCB, 1023, P.VTC, 31, 0, ntc)
#define C1STEP(iv, BUF, RL, RW) { const int i = (iv); if (i >= ntc) break; const int n0 = 32 * i; RL = STAGE_LOAD(P.KCB, 1023, P.VTC, 31, 32 * min(i + 2, ntc - 1)); \
            const bool far = (n0 + 32 <= nfar); f32x16 a; CSCORE(a, BUF, n0, far, mc); \
            float d_, fs_; REF_EVENT(a, mc, stc, d_, fs_) lc *= fs_; \
            _Pragma("unroll") for (int r = 0; r < 16; ++r) a[r] = __builtin_amdgcn_exp2f(a[r]); \
            lc += xsum32(sum16(a)); STAGE_WRITE(RW, (BUF) ^ 1); __syncthreads(); }
        for (int ib = 0; ; ib += 2) { C1STEP(ib, 0, RA, RB) C1STEP(ib + 1, 1, RB, RA) }
#undef C1STEP
    }
    {   const float invl = 1.0f / fmaxf(lc, 1e-30f); f32x16 oc0 = {}, oc1 = {}; float carry = 0.f;
#define CIMP(a, n0v) do { float mq[4], cq[4]; \
            _Pragma("unroll") for (int qg = 0; qg < 4; ++qg) { float mv = (2.0f * (a[4 * qg] + a[4 * qg + 1] + a[4 * qg + 2]) + a[4 * qg + 3]) * invl, cv = a[4 * qg + 3] * invl; \
                mv += __int_as_float(DPPI(__float_as_int(mv), 0xB1)); mv += __int_as_float(DPPI(__float_as_int(mv), 0x4E)); \
                cv += __int_as_float(DPPI(__float_as_int(cv), 0xB1)); cv += __int_as_float(DPPI(__float_as_int(cv), 0x4E)); mq[qg] = mv; cq[qg] = cv; } \
            float oth[4]; \
            _Pragma("unroll") for (int qg = 0; qg < 4; ++qg) { auto rr = __builtin_amdgcn_permlane32_swap(__float_as_uint(cq[qg]), __float_as_uint(cq[qg]), false, false); oth[qg] = __uint_as_float(hi ? rr[0] : rr[1]); } \
            _Pragma("unroll") for (int qg = 0; qg < 4; ++qg) { const float tot = mq[qg] + (hi ? oth[qg] : (qg ? oth[qg - 1] : carry)); if (hr == 0) scores[ti * SCS + (((n0v) + 8 * qg + 4 * hi) >> 2)] = tot; } \
            carry = oth[3]; } while (0)
        if (ntc > 0) {
            STAGE_PROLOGUE(P.KCB, 1023, P.VTC, 31, 0, ntc)
#define C2STEP(iv, BUF, RL, RW) { const int i = (iv); if (i >= ntc) break; const int n0 = 32 * i; RL = STAGE_LOAD(P.KCB, 1023, P.VTC, 31, 32 * min(i + 2, ntc - 1)); \
                const bool far = (n0 + 32 <= nfar); f32x16 a; CSCORE(a, BUF, n0, far, mc); VLOAD(vfr_, BUF) \
                _Pragma("unroll") for (int r = 0; r < 16; ++r) a[r] = __builtin_amdgcn_exp2f(a[r]); \
                CIMP(a, n0); PVACC(oc0, oc1, vfr_, a); STAGE_WRITE(RW, (BUF) ^ 1); __syncthreads(); }
            for (int ib = 0; ; ib += 2) { C2STEP(ib, 0, RA, RB) C2STEP(ib + 1, 1, RB, RA) }
#undef C2STEP
            { const int jn = ntc * 8; if (jn < 256 && hi == 0 && hr == 0) scores[ti * SCS + jn] = carry; }
        }
#undef CIMP
        {   LAS unsigned char* park = lds + AT_PARK + (((8 * wave + ti) * 4 + hr) * 64) * 2;
            const float gs = g0 * invl;
#pragma unroll
            for (int d0 = 0; d0 < 2; ++d0)
#pragma unroll
                for (int r4 = 0; r4 < 4; ++r4) { const f32x16& Wd = d0 ? oc1 : oc0; const int dim = 32 * d0 + 8 * r4 + 4 * hi;
                    *(LAS unsigned long long*)(park + dim * 2) = (unsigned long long)cvt_pk_bf16(Wd[4 * r4] * gs, Wd[4 * r4 + 1] * gs) | ((unsigned long long)cvt_pk_bf16(Wd[4 * r4 + 2] * gs, Wd[4 * r4 + 3] * gs) << 32); } } }
#undef CSCORE
    {   float mw = 0.f, lw = 0.f; bool stw = false; f32x16 o0 = {}, o1 = {};
        const int nlo = max(t0 - 511, 0) & ~31, nhi = (t0 + 7) & ~31;
        const int nlb = max(tile0 - 511, 0) & ~31, ntw = (((tile0 + 63) & ~31) - nlb) / 32 + 1;
        const LAS float* xrb = (const LAS float*)(lds + AT_LIST) + hr * XRN + (575 - ti + 4 * hi);
        STAGE_PROLOGUE(P.KW, S - 1, P.VTW, 511, nlb, ntw)
#define WSTEP(iv, BUF, RL, RW) { const int i = (iv); if (i >= ntw) break; const int n0 = nlb + 32 * i; RL = STAGE_LOAD(P.KW, S - 1, P.VTW, 511, nlb + 32 * min(i + 2, ntw - 1)); \
            if (n0 >= nlo && n0 <= nhi) { const bool mid = (n0 >= t0 - 504) && (n0 <= t0 - 144); \
                f32x16 a; if (mid) { const float ini_ = cb - mw; _Pragma("unroll") for (int r = 0; r < 16; ++r) a[r] = ini_; } \
                else { const LAS float* xr_ = xrb + (n0 - t0); _Pragma("unroll") for (int r = 0; r < 16; ++r) a[r] = xr_[(r & 3) + 8 * (r >> 2)] - mw; } \
                { KLOAD(kfr_, BUF) _Pragma("unroll") for (int ks = 0; ks < 4; ++ks) a = MFMA32(kfr_[ks], bq[ks], a); } VLOAD(vfr_, BUF) \
                float d_, fs_; REF_EVENT(a, mw, stw, d_, fs_) if (fs_ != 1.f || d_ != 0.f) { lw *= fs_; o0 = o0 * fs_; o1 = o1 * fs_; } \
                _Pragma("unroll") for (int r = 0; r < 16; ++r) a[r] = __builtin_amdgcn_exp2f(a[r]); \
                lw += xsum32(sum16(a)); PVACC(o0, o1, vfr_, a); } \
            STAGE_WRITE(RW, (BUF) ^ 1); __syncthreads(); }
        for (int ib = 0; ; ib += 2) { WSTEP(ib, 0, RA, RB) WSTEP(ib + 1, 1, RB, RA) }
#undef WSTEP
        const float sc = g2 / fmaxf(lw, 1e-30f);
        LAS unsigned char* park = lds + AT_PARK + (((8 * wave + ti) * 4 + hr) * 64) * 2;
#pragma unroll
        for (int d0 = 0; d0 < 2; ++d0)
#pragma unroll
            for (int r4 = 0; r4 < 4; ++r4) { const f32x16& Od = d0 ? o1 : o0; const int dim = 32 * d0 + 8 * r4 + 4 * hi; const unsigned long long w = *(const LAS unsigned long long*)(park + dim * 2); const unsigned lo = (unsigned)w, hw = (unsigned)(w >> 32);
                *(LAS unsigned long long*)(park + dim * 2) = (unsigned long long)cvt_pk_bf16(bflo(lo) + Od[4 * r4] * sc, bfhi(lo) + Od[4 * r4 + 1] * sc) | ((unsigned long long)cvt_pk_bf16(bflo(hw) + Od[4 * r4 + 2] * sc, bfhi(hw) + Od[4 * r4 + 3] * sc) << 32); } }
#undef REF_EVENT
#undef STAGE_PROLOGUE
#undef PVACC
#undef KLOAD
#undef FRAG_WAIT
#undef VLOAD
#undef KFRAG
#undef VFRAG
#undef STAGE_LOAD
#undef STAGE_WRITE
    LDS_WAIT();
    {   const int cur = tile0 >> 6, i = lane >> 3, s8 = lane & 7;
        if (cur + 1 <= 16) { for (int e = lane; e < 8 * 16; e += 64) sel[e] = e & 15; }
        else {
            float sv[32];
#pragma unroll
            for (int k = 0; k < 32; ++k) { const int j = s8 + 8 * k; sv[k] = (j >= 1 && j <= cur - 2) ? scores[i * SCS + j] : -3e38f; }
            if (s8 == 0) { sel[i * 16 + 0] = 0; sel[i * 16 + 1] = cur - 1; sel[i * 16 + 2] = cur; }
            for (int it = 3; it < 16; ++it) {
                float bv = sv[0]; int bj = s8;
#pragma unroll
                for (int k = 1; k < 32; ++k) if (sv[k] > bv) { bv = sv[k]; bj = s8 + 8 * k; }
#define SEL_STEP(ctrl) { const float ov = __int_as_float(DPPI(__float_as_int(bv), ctrl)); const int oj = DPPI(bj, ctrl); if (ov > bv || (ov == bv && oj < bj)) { bv = ov; bj = oj; } }
                SEL_STEP(0xB1) SEL_STEP(0x4E) SEL_STEP(0x141)
#undef SEL_STEP
                if (s8 == 0) sel[i * 16 + it] = bj;
#pragma unroll
                for (int k = 0; k < 32; ++k) if (bj == s8 + 8 * k) sv[k] = -3e38f;
            }
        }
    }
}

__device__ __forceinline__ void s_scores(const bf16x8 (&kf)[8], const bf16x8 q0, const bf16x8 q1, bool cst, float cbs, const LAS float* BT, int hd, int tt, int j, int q, float sub, f32x4 (&sa)[4]) {
    if (cst) {
#pragma unroll
        for (int mt = 0; mt < 4; ++mt) { const float ini = cbs - sub; sa[mt] = (f32x4){ini, ini, ini, ini}; } }
    else { const LAS float* xb = BT + hd * 256 + (191 - tt + 64 * j + 4 * q);
#pragma unroll
        for (int mt = 0; mt < 4; ++mt)
#pragma unroll
            for (int r = 0; r < 4; ++r) sa[mt][r] = xb[16 * mt + r] - sub; }
#pragma unroll
    for (int mt = 0; mt < 4; ++mt) { sa[mt] = MFMA16(kf[mt * 2], q0, sa[mt]); sa[mt] = MFMA16(kf[mt * 2 + 1], q1, sa[mt]); }
}
template <bool MASKED> __device__ __forceinline__ void s_softmax(f32x4 (&sa)[4], float& tm, float& ls) {
    tm = sa[0][0];
#pragma unroll
    for (int mt = 0; mt < 4; ++mt)
#pragma unroll
        for (int r = 0; r < 4; ++r) tm = fmaxf(tm, sa[mt][r]);
    tm = xmax32(xmax16(tm)); ls = 0.f;
#pragma unroll
    for (int mt = 0; mt < 4; ++mt)
#pragma unroll
        for (int r = 0; r < 4; ++r) { const float e = __builtin_amdgcn_exp2f(sa[mt][r] - tm); sa[mt][r] = (!MASKED || sa[mt][r] > -1e29f) ? e : 0.f; ls += sa[mt][r]; }
    ls = xsum32(xsum16(ls));
}
__device__ __forceinline__ void load_kf(const AttnPtrs& P, int lane, int j, bf16x8 (&kf)[8]) {
    const bf16* kp = P.KS + (size_t)(64 * j + (lane & 15)) * 64 + 8 * (lane >> 4);
#pragma unroll
    for (int mt = 0; mt < 4; ++mt) { kf[mt * 2] = *(const bf16x8*)(kp + (size_t)mt * 16 * 64); kf[mt * 2 + 1] = *(const bf16x8*)(kp + (size_t)mt * 16 * 64 + 32); }
}
__device__ __forceinline__ void load_vf(const AttnPtrs& P, int lane, int j, bf16x8 (&vf)[8]) {
    const bf16x8* vt = P.VTS + (size_t)j * 8 * 64 + lane;
#pragma unroll
    for (int e = 0; e < 8; ++e) vf[e] = vt[e * 64];
}
__device__ __forceinline__ void s_chunk(const bf16x8 (&kf)[8], const bf16x8 (&vf)[8], int j, int ch, int n, bool cst, float cbs, const LAS float* BT, const LAS unsigned short* list,
                                        const LAS unsigned char* qt, unsigned char* slab, int tile0, int c, int q, int hd, int hs) {
    const int sidx = 4 * ch + (c >> 2); const bool valid = sidx < n; const int sl = (int)list[j * 64 + (valid ? sidx : 0)]; const int tokl = sl / 13, r = tokl * 4 + hd;
    const LAS unsigned char* qr = qt + r * 128; const bf16x8 q0 = *(const LAS bf16x8*)(qr + ((q ^ (r & 7)) << 4)), q1 = *(const LAS bf16x8*)(qr + (((q + 4) ^ (r & 7)) << 4));
    float tm = ((const LAS float*)(qt + 65536))[r], ls; f32x4 sa[4]; bool second = false;
#pragma unroll 1
    for (;;) {
        s_scores(kf, q0, q1, cst, cbs, BT, hd, tile0 + tokl, j, q, tm, sa);
        if (second) { float mx = sa[0][0];
#pragma unroll
            for (int mt = 0; mt < 4; ++mt)
#pragma unroll
                for (int r4 = 0; r4 < 4; ++r4) mx = fmaxf(mx, sa[mt][r4]);
            mx = xmax32(xmax16(mx)); tm += mx;
#pragma unroll
            for (int mt = 0; mt < 4; ++mt)
#pragma unroll
                for (int r4 = 0; r4 < 4; ++r4) sa[mt][r4] -= mx; }
        ls = 0.f;
#pragma unroll
        for (int mt = 0; mt < 4; ++mt)
#pragma unroll
            for (int r4 = 0; r4 < 4; ++r4) { sa[mt][r4] = __builtin_amdgcn_exp2f(sa[mt][r4]); ls += sa[mt][r4]; }
        ls = xsum32(xsum16(ls));
        if (second || !__any(!(ls < 1e30f))) break;
        second = true; }
    const bf16x8 p0 = pack8(sa[0][0], sa[0][1], sa[0][2], sa[0][3], sa[1][0], sa[1][1], sa[1][2], sa[1][3]), p1 = pack8(sa[2][0], sa[2][1], sa[2][2], sa[2][3], sa[3][0], sa[3][1], sa[3][2], sa[3][3]);
    unsigned char* po = slab + ((size_t)(sl * 4 + hd) * 64 + 16 * q) * 2;
    unsigned pw[8];
#pragma unroll
    for (int dt = 0; dt < 4; ++dt) { f32x4 oa = {0.f, 0.f, 0.f, 0.f}; oa = MFMA16(vf[dt * 2], p0, oa); oa = MFMA16(vf[dt * 2 + 1], p1, oa); pw[2 * dt] = cvt_pk_bf16(oa[0], oa[1]); pw[2 * dt + 1] = cvt_pk_bf16(oa[2], oa[3]); }
    if (valid) { *(v4u*)po = (v4u){pw[0], pw[1], pw[2], pw[3]}; *(v4u*)(po + 16) = (v4u){pw[4], pw[5], pw[6], pw[7]}; }
    if (valid && q == 0) *(f32x2*)(slab + PML_OFF + (size_t)(sl * 4 + hd) * 8) = (f32x2){tm, ls};
}
__device__ __forceinline__ void attn_stageB(const AttnPtrs& P, int lane, int wave, int tile0, int g, LAS unsigned char* lds, unsigned char* slab) {
    const int T = tile0 >> 6, c = lane & 15, q = lane >> 4, hd = c & 3, hs = g * 4 + hd;
    if (T <= 15) return;
    LAS unsigned* cnt = (LAS unsigned*)(lds + AT_CNT); const LAS unsigned short* list = (const LAS unsigned short*)(lds + AT_LIST); const LAS float* BT = (const LAS float*)(lds + AT_BT);
    const LAS unsigned char* qt = lds + AT_SC;
    const float cbs = BT[hd * 256 + 64];
#define GRAB_ISSUE(tv) { tv = 0; if (lane == 0) tv = (int)__hip_atomic_fetch_add(&cnt[0], 1u, __ATOMIC_RELAXED, __HIP_MEMORY_SCOPE_WORKGROUP); }
#define GRAB_TAKE(tv, jv, nv) { jv = (int)__builtin_amdgcn_readfirstlane(tv) + 1; nv = 0; if (jv <= T - 2) nv = (int)__builtin_amdgcn_readfirstlane((int)cnt[jv]); }
    bf16x8 KA[8], VA[8], KB[8], VB[8];
    int jc, nc, jn, nn;
    { int t0_, t1_; GRAB_ISSUE(t0_) GRAB_ISSUE(t1_) GRAB_TAKE(t0_, jc, nc) if (jc > T - 2) return; GRAB_TAKE(t1_, jn, nn) }
    load_kf(P, lane, jc, KA); load_vf(P, lane, jc, VA);
    load_kf(P, lane, min(jn, T - 2), KB); load_vf(P, lane, min(jn, T - 2), VB);
#define BSTEP(KX, VX) { int t2_; GRAB_ISSUE(t2_) \
        { const bool cst = (jc <= T - 3);        \
          if (nc > 0) s_chunk(KX, VX, jc, 0, nc, cst, cbs, BT, list, qt, slab, tile0, c, q, hd, hs); \
          if (nc > 4) s_chunk(KX, VX, jc, 1, nc, cst, cbs, BT, list, qt, slab, tile0, c, q, hd, hs); \
          if (nc > 8) { _Pragma("unroll 1") for (int ch = 2; 4 * ch < nc; ++ch) s_chunk(KX, VX, jc, ch, nc, cst, cbs, BT, list, qt, slab, tile0, c, q, hd, hs); } } \
        int j2_, n2_; GRAB_TAKE(t2_, j2_, n2_) \
        load_kf(P, lane, min(j2_, T - 2), KX); load_vf(P, lane, min(j2_, T - 2), VX); \
        jc = jn; nc = nn; jn = j2_; nn = n2_; }
    do { BSTEP(KA, VA) BSTEP(KB, VB) } while (jc <= T - 2);
#undef BSTEP
#undef GRAB_ISSUE
#undef GRAB_TAKE
}
struct SState { float M, L; f32x4 O[4]; };
__device__ __forceinline__ void s_merge(SState& st, float m, float l, const f32x4 (&o)[4]) {
    const float mn = fmaxf(st.M, m), a0 = __builtin_amdgcn_exp2f(st.M - mn), a1 = __builtin_amdgcn_exp2f(m - mn);
    st.L = st.L * a0 + l * a1; st.M = mn;
#pragma unroll
    for (int dt = 0; dt < 4; ++dt) st.O[dt] = st.O[dt] * a0 + o[dt] * a1;
}
__device__ __forceinline__ void attn_stageC_forced(const AttnPtrs& P, int lane, int wave, int tile0, int g, LAS unsigned char* lds, SState (&st)[2]) {
    const int T = tile0 >> 6, c = lane & 15, q = lane >> 4, hd = c & 3, hs = g * 4 + hd; const LAS float* BT = (const LAS float*)(lds + AT_BT); const float cbs = BT[hd * 256 + 64];
    bf16x8 q0[2], q1[2];
#pragma unroll
    for (int k = 0; k < 2; ++k) { const int tt = tile0 + 8 * wave + 4 * k + (c >> 2); q0[k] = *(const bf16x8*)(P.Q + (size_t)tt * 512 + hs * 64 + 8 * q); q1[k] = *(const bf16x8*)(P.Q + (size_t)tt * 512 + hs * 64 + 32 + 8 * q);
        st[k].M = -1e30f; st[k].L = 0.f;
#pragma unroll
        for (int dt = 0; dt < 4; ++dt) st[k].O[dt] = (f32x4){0.f, 0.f, 0.f, 0.f}; }
    const int nf = T <= 15 ? T + 1 : 3;
    auto fblk = [&](int it) -> int { return T <= 15 ? it : (it == 0 ? 0 : (it == 1 ? T - 1 : T)); };
    bf16x8 kf[8], vf[8]; load_kf(P, lane, fblk(0), kf); load_vf(P, lane, fblk(0), vf);
#pragma unroll 1
    for (int it = 0; it < nf; ++it) { const int j = fblk(it);
        bf16x8 kn[8]; load_kf(P, lane, fblk(min(it + 1, nf - 1)), kn);
        const bool cst = (j <= T - 3);
#pragma unroll
        for (int k = 0; k < 2; ++k) { const int tt = tile0 + 8 * wave + 4 * k + (c >> 2);
            f32x4 sa[4]; s_scores(kf, q0[k], q1[k], cst, cbs, BT, hd, tt, j, q, 0.f, sa);
            float tm, ls; s_softmax<true>(sa, tm, ls);
            const bf16x8 p0 = pack8(sa[0][0], sa[0][1], sa[0][2], sa[0][3], sa[1][0], sa[1][1], sa[1][2], sa[1][3]), p1 = pack8(sa[2][0], sa[2][1], sa[2][2], sa[2][3], sa[3][0], sa[3][1], sa[3][2], sa[3][3]);
            f32x4 ob[4];
#pragma unroll
            for (int dt = 0; dt < 4; ++dt) { ob[dt] = (f32x4){0.f, 0.f, 0.f, 0.f}; ob[dt] = MFMA16(vf[dt * 2], p0, ob[dt]); ob[dt] = MFMA16(vf[dt * 2 + 1], p1, ob[dt]); }
            s_merge(st[k], tm, ls, ob); }
#pragma unroll
        for (int e = 0; e < 8; ++e) kf[e] = kn[e];
        if (it + 1 < nf) load_vf(P, lane, fblk(it + 1), vf);
    }
}
__device__ __forceinline__ void attn_stageC_forced_lds(const AttnPtrs& P, int lane, int wave, int tile0, int g, LAS unsigned char* lds, SState (&st)[2]) {
    const int T = tile0 >> 6, c = lane & 15, q = lane >> 4, hd = c & 3, hs = g * 4 + hd; const LAS float* BT = (const LAS float*)(lds + AT_BT); const float cbs = BT[hd * 256 + 64];
    bf16x8 q0[2], q1[2];
#pragma unroll
    for (int k = 0; k < 2; ++k) { const int r = (8 * wave + 4 * k + (c >> 2)) * 4 + hd; const LAS unsigned char* qr = lds + AT_SC + r * 128;
        q0[k] = *(const LAS bf16x8*)(qr + ((q ^ (r & 7)) << 4)); q1[k] = *(const LAS bf16x8*)(qr + (((q + 4) ^ (r & 7)) << 4));
        st[k].M = -1e30f; st[k].L = 0.f;
#pragma unroll
        for (int dt = 0; dt < 4; ++dt) st[k].O[dt] = (f32x4){0.f, 0.f, 0.f, 0.f}; }
#pragma unroll
    for (int it = 0; it < 3; ++it) { const int j = it == 0 ? 0 : (it == 1 ? T - 1 : T); const LAS unsigned char* fb = lds + (it == 2 ? AT_TILE : AT_SC + 32768 + 16384 * it);
        bf16x8 kf[8], vf[8];
#pragma unroll
        for (int mt = 0; mt < 4; ++mt) { const int row = 16 * mt + c; kf[mt * 2] = *(const LAS bf16x8*)(fb + row * 128 + ((q ^ (row & 7)) << 4)); kf[mt * 2 + 1] = *(const LAS bf16x8*)(fb + row * 128 + (((q + 4) ^ (row & 7)) << 4)); }
#pragma unroll
        for (int e = 0; e < 8; ++e) vf[e] = *(const LAS bf16x8*)(fb + 8192 + (e * 64 + lane) * 16);
        const bool cst = (it == 0);
#pragma unroll
        for (int k = 0; k < 2; ++k) { const int tt = tile0 + 8 * wave + 4 * k + (c >> 2);
            f32x4 sa[4]; s_scores(kf, q0[k], q1[k], cst, cbs, BT, hd, tt, j, q, 0.f, sa);
            float tm, ls; s_softmax<true>(sa, tm, ls);
            const bf16x8 p0 = pack8(sa[0][0], sa[0][1], sa[0][2], sa[0][3], sa[1][0], sa[1][1], sa[1][2], sa[1][3]), p1 = pack8(sa[2][0], sa[2][1], sa[2][2], sa[2][3], sa[3][0], sa[3][1], sa[3][2], sa[3][3]);
            f32x4 ob[4];
#pragma unroll
            for (int dt = 0; dt < 4; ++dt) { ob[dt] = (f32x4){0.f, 0.f, 0.f, 0.f}; ob[dt] = MFMA16(vf[dt * 2], p0, ob[dt]); ob[dt] = MFMA16(vf[dt * 2 + 1], p1, ob[dt]); }
            s_merge(st[k], tm, ls, ob); } }
}
__device__ __forceinline__ void attn_stageC_merge(const AttnPtrs& P, int lane, int wave, int tile0, int g, LAS unsigned char* lds, const unsigned char* slab, SState (&st)[2]) {
    const int T = tile0 >> 6, c = lane & 15, q = lane >> 4, hd = c & 3, hs = g * 4 + hd;
#pragma unroll
    for (int k = 0; k < 2; ++k) { const int tok = 8 * wave + 4 * k + (c >> 2), tt = tile0 + tok;
        if (T > 15) {
#pragma unroll
            for (int b0 = 0; b0 < 13; b0 += 13) {
                f32x2 mlv[13]; v4u ow[13][2];
#pragma unroll
                for (int bb = 0; bb < 13; ++bb) if (b0 + bb < 13) { const int sl = tok * 13 + b0 + bb;
                    mlv[bb] = *(const f32x2*)(slab + PML_OFF + (size_t)(sl * 4 + hd) * 8);
                    const unsigned char* po = slab + ((size_t)(sl * 4 + hd) * 64 + 16 * q) * 2; ow[bb][0] = *(const v4u*)po; ow[bb][1] = *(const v4u*)(po + 16); }
#pragma unroll
                for (int bb = 0; bb < 13; ++bb) if (b0 + bb < 13) { f32x4 ob[4];
                    ob[0] = (f32x4){bflo(ow[bb][0].x), bfhi(ow[bb][0].x), bflo(ow[bb][0].y), bfhi(ow[bb][0].y)}; ob[1] = (f32x4){bflo(ow[bb][0].z), bfhi(ow[bb][0].z), bflo(ow[bb][0].w), bfhi(ow[bb][0].w)};
                    ob[2] = (f32x4){bflo(ow[bb][1].x), bfhi(ow[bb][1].x), bflo(ow[bb][1].y), bfhi(ow[bb][1].y)}; ob[3] = (f32x4){bflo(ow[bb][1].z), bfhi(ow[bb][1].z), bflo(ow[bb][1].w), bfhi(ow[bb][1].w)};
                    s_merge(st[k], mlv[bb].x, mlv[bb].y, ob); } } }
        const float g1 = bf2f(P.GN[(size_t)tt * 32 + hs * 3 + 1]) / fmaxf(st[k].L, 1e-30f);
        LAS unsigned char* park = lds + AT_PARK + ((tok * 4 + hd) * 64 + 4 * q) * 2;
#pragma unroll
        for (int dt = 0; dt < 4; ++dt) { const unsigned long long w = *(const LAS unsigned long long*)(park + dt * 32); const unsigned lo = (unsigned)w, hw = (unsigned)(w >> 32);
            const unsigned o0 = cvt_pk_bf16(bflo(lo) + g1 * st[k].O[dt][0], bfhi(lo) + g1 * st[k].O[dt][1]), o1 = cvt_pk_bf16(bflo(hw) + g1 * st[k].O[dt][2], bfhi(hw) + g1 * st[k].O[dt][3]);
            *(LAS unsigned long long*)(park + dt * 32) = (unsigned long long)o0 | ((unsigned long long)o1 << 32); } }
    LDS_WAIT();
#pragma unroll
    for (int e = 0; e < 4; ++e) { const int idx = lane + 64 * e, tokl = idx >> 5, piece = idx & 31;
        *(v4u*)((unsigned char*)P.O + (size_t)(tile0 + 8 * wave + tokl) * 1024 + g * 512 + piece * 16) = *(const LAS v4u*)(lds + AT_PARK + (8 * wave + tokl) * 512 + piece * 16); }
    LDS_WAIT();
}
__device__ __forceinline__ void attn_tile(const Frame& F, unsigned char* ws, const float* pbias, int tile, int g, unsigned soff) {
    int lane = F.lane; asm volatile("" : "+v"(lane));
    const int wave = F.wave, tile0 = tile * 64, T = tile; LAS unsigned char* lds = F.lds;
    if (F.tid < 256) ((LAS unsigned*)(lds + AT_CNT))[F.tid] = 0u;
    {   LAS float* BT = (LAS float*)(lds + AT_BT);
        for (int i = F.tid; i < 4 * 256; i += NWAVES * 64) { const int hh = i >> 8, d = 191 - (i & 255); float v = -1e30f;
            if (d >= 0) { const int dd = min(d, 127); int bk = dd; if (dd >= 16) { bk = 16 + (int)(logf((float)dd * (1.0f / 16.0f)) / 2.0794415416798357f * 16.0f); if (bk > 31) bk = 31; }
                v = pbias[bk * 8 + g * 4 + hh] * 1.4426950408889634f; }
            BT[i] = v; } }
    __syncthreads();
    AttnPtrs P;
    {   const bf16* KVH = (const bf16*)(ws + WS_KVH);
        P.Q = (const bf16*)(ws + WS_Q); P.KCB = (const bf16*)(ws + WS_KCB) + (size_t)g * 1024 * 64; P.VTC = (const bf16x8*)(ws + WS_VTC) + (size_t)g * 32 * 4 * 64;
        P.KW = KVH + (size_t)(8 + g) * S * 64; P.VTW = (const bf16x8*)(ws + WS_VTW) + (size_t)g * 512 * 4 * 64; P.GN = (const bf16*)(ws + WS_GN);
        P.KS = nullptr; P.VTS = nullptr; P.O = nullptr; }
    attn_stageA(P, lane, wave, tile0, g, lds);
    __syncthreads();
    unsigned char* ws2 = ws;
    {   const bf16* KVH = (const bf16*)(ws2 + WS_KVH);
        P.Q = (const bf16*)(ws2 + WS_Q); P.KS = KVH + (size_t)(4 + g) * S * 64; P.VTS = (const bf16x8*)(ws2 + WS_VTS) + (size_t)g * 256 * 8 * 64; P.GN = (const bf16*)(ws2 + WS_GN); P.O = (bf16*)(ws2 + WS_O);
        P.KCB = nullptr; P.VTC = nullptr; P.KW = nullptr; P.VTW = nullptr; }
    unsigned char* slab = ((blockIdx.x < 128) ? (unsigned char*)F.out : ws2 + WS_PSLAB) + soff;
    if (T > 15) {
        LAS unsigned* cnt = (LAS unsigned*)(lds + AT_CNT); LAS unsigned short* list = (LAS unsigned short*)(lds + AT_LIST); const LAS int* sel = (const LAS int*)(lds + AT_SEL);
        const int tok = F.tid >> 3;
        v4u qv[4];
#pragma unroll
        for (int e = 0; e < 4; ++e) { const int idx = F.tid + 512 * e, row = idx >> 3, piece = idx & 7; qv[e] = *(const v4u*)((const unsigned char*)P.Q + (size_t)(tile0 + (row >> 2)) * 1024 + g * 512 + (row & 3) * 128 + piece * 16); }
#pragma unroll
        for (int e = 0; e < 2; ++e) { const int b = (F.tid & 7) * 2 + e;
            if (b >= 3) { const int j = sel[tok * 16 + b]; const unsigned pos = __hip_atomic_fetch_add(&cnt[j], 1u, __ATOMIC_RELAXED, __HIP_MEMORY_SCOPE_WORKGROUP); list[j * 64 + pos] = (unsigned short)(tok * 13 + b - 3); } }
#pragma unroll
        for (int e = 0; e < 4; ++e) { const int idx = F.tid + 512 * e, row = idx >> 3, piece = idx & 7; *(LAS v4u*)(lds + AT_SC + row * 128 + ((piece ^ (row & 7)) << 4)) = qv[e]; }
        {   v4u fk[3], fv[3];
#pragma unroll
            for (int e = 0; e < 3; ++e) { const int j = e == 0 ? 0 : (e == 1 ? T - 1 : T); fk[e] = *(const v4u*)((const unsigned char*)P.KS + (size_t)j * 8192 + F.tid * 16); fv[e] = *(const v4u*)((const unsigned char*)P.VTS + (size_t)j * 8192 + F.tid * 16); }
            const int row = F.tid >> 3, piece = F.tid & 7;
#pragma unroll
            for (int e = 0; e < 3; ++e) { LAS unsigned char* fb = lds + (e == 2 ? AT_TILE : AT_SC + 32768 + 16384 * e); *(LAS v4u*)(fb + row * 128 + ((piece ^ (row & 7)) << 4)) = fk[e]; *(LAS v4u*)(fb + 8192 + F.tid * 16) = fv[e]; } }
        __syncthreads(); }
    SState st[2];
    if (T > 15) { attn_stageC_forced_lds(P, lane, wave, tile0, g, lds, st);
        if (lane < 16) {
#pragma unroll
            for (int k = 0; k < 2; ++k) ((LAS float*)(lds + AT_SC + 65536))[(8 * wave + 4 * k + (lane >> 2)) * 4 + (lane & 3)] = st[k].M; }
        __syncthreads(); }
    else attn_stageC_forced(P, lane, wave, tile0, g, lds, st);
    attn_stageB(P, lane, wave, tile0, g, lds, slab);
    asm volatile("s_waitcnt vmcnt(0)" ::: "memory");
    __syncthreads();
    __builtin_amdgcn_fence(__ATOMIC_ACQUIRE, "agent");
    attn_stageC_merge(P, lane, wave, tile0, g, lds, slab, st);
    __syncthreads();
}

#define XB_TMO      128
#define XB_XCNT(j)  (256  + 64 * (j))
#define XB_XSUB(j)  (1280 + 64 * (j))
#define XB_XGEN(j)  (2304 + 64 * (j))
#define XB_TOP      3328
#define XB_TOPGEN   3392
#define XCD_BAR_WORDS 3456
#define XB_SPIN_CAP (1u << 22)
__device__ __forceinline__ unsigned xb_ld(unsigned* p)              { return __hip_atomic_load(p, __ATOMIC_RELAXED, __HIP_MEMORY_SCOPE_AGENT); }
__device__ __forceinline__ unsigned xb_add(unsigned* p, unsigned v) { return __hip_atomic_fetch_add(p, v, __ATOMIC_RELAXED, __HIP_MEMORY_SCOPE_AGENT); }
__device__ __forceinline__ unsigned xb_xcc_id() { return (unsigned)__builtin_amdgcn_s_getreg((3 << 11) | 20) & 0xFu; }
#define XB_SPIN(cond, bar) do { unsigned _sp = 0; while (cond) { __builtin_amdgcn_s_sleep(1); \
    if ((++_sp & 255u) == 0u) { if (xb_ld(&(bar)[XB_TMO])) break; if (_sp > XB_SPIN_CAP) { atomicAdd(&(bar)[XB_TMO], 1u); break; } } } } while (0)
struct XcdBarrier { unsigned* bar; unsigned x; volatile LAS unsigned* st; };
__device__ __forceinline__ XcdBarrier xcd_barrier_post(unsigned* bar, volatile LAS unsigned* st) {
    XcdBarrier b; b.bar = bar; b.x = xb_xcc_id(); b.st = st;
    if (threadIdx.x == 0) (void)xb_add(&bar[XB_XCNT(b.x)], 1u);
    return b;
}
__device__ __forceinline__ void xcd_barrier_complete(unsigned* bar, unsigned x, unsigned& nloc, unsigned& nx) {
    const unsigned G = gridDim.x * gridDim.y * gridDim.z;
    unsigned sum, cnt, mine, sp = 0u;
    for (;;) {
        sum = 0u; cnt = 0u; mine = 0u;
#pragma unroll
        for (unsigned j = 0; j < 16; ++j) { const unsigned c = xb_ld(&bar[XB_XCNT(j)]); sum += c; cnt += (c > 0u) ? 1u : 0u; mine = (j == x) ? c : mine; }
        if (sum == G) break;
        __builtin_amdgcn_s_sleep(1);
        if ((++sp & 255u) == 0u) { if (xb_ld(&bar[XB_TMO])) break; if (sp > XB_SPIN_CAP) { atomicAdd(&bar[XB_TMO], 1u); break; } }
    }
    nloc = mine > 0u ? mine : 1u; nx = cnt > 0u ? cnt : 1u;
}
__device__ __forceinline__ void xcd_barrier(const XcdBarrier& b) {
    asm volatile("s_waitcnt vmcnt(0)" ::: "memory");
    __syncthreads();
    if (threadIdx.x == 0) {
        unsigned* bar = b.bar;
        __builtin_amdgcn_s_waitcnt(0);
        unsigned nloc = b.st[0], nx = b.st[1];
        if (nloc == 0u) { xcd_barrier_complete(bar, b.x, nloc, nx); b.st[0] = nloc; b.st[1] = nx; }
        const unsigned old = xb_add(&bar[XB_XSUB(b.x)], 1u);
        const unsigned gen = old / nloc;
        if (old + 1u == (gen + 1u) * nloc) {
            __builtin_amdgcn_fence(__ATOMIC_RELEASE, "agent");
            asm volatile("s_waitcnt vmcnt(0)" ::: "memory");
            const unsigned og = xb_add(&bar[XB_TOP], 1u);
            const unsigned tg = og / nx;
            if (og + 1u == (tg + 1u) * nx) xb_add(&bar[XB_TOPGEN], 1u);
            else XB_SPIN(xb_ld(&bar[XB_TOPGEN]) == tg, bar);
            __builtin_amdgcn_fence(__ATOMIC_ACQUIRE, "agent");
            xb_add(&bar[XB_XGEN(b.x)], 1u);
            asm volatile("s_waitcnt vmcnt(0)" ::: "memory");
        } else {
            XB_SPIN(xb_ld(&bar[XB_XGEN(b.x)]) == gen, bar);
            __builtin_amdgcn_fence(__ATOMIC_ACQUIRE, "agent");
            asm volatile("s_waitcnt vmcnt(0)" ::: "memory");
        }
    }
    __syncthreads();
}

struct EpiResFinal {
    static constexpr bool PERM = false;
    const float* base; float* out; const float* gain; float* RS; unsigned* ctl; LAS float* part;
    __device__ __forceinline__ void operator()(f32x4 (&acc)[2][2][4][2], const pg8::Unit& u, int wr, int wc, int fr, int fq) const {
        using namespace pg8;
        const int row0 = u.pm * BM + wr * 64 + fr, col0 = u.pn * BM + wc * 32 + 4 * fq;
#pragma unroll
        for (int ai = 0; ai < 2; ++ai)
#pragma unroll
            for (int m = 0; m < 4; ++m) { const size_t off = (size_t)(row0 + ai * HALF + m * 16) * 1024 + col0; float ss = 0.f;
#pragma unroll
                for (int bj = 0; bj < 2; ++bj)
#pragma unroll
                    for (int n = 0; n < 2; ++n) { const f32x4 b = *(const f32x4*)(base + off + bj * HALF + n * 16); acc[ai][bj][m][n] += b; const f32x4 x2 = acc[ai][bj][m][n];
                        ss += (x2[0] * x2[0] + x2[1] * x2[1]) + (x2[2] * x2[2] + x2[3] * x2[3]); }
                ss += __shfl_xor(ss, 16); ss += __shfl_xor(ss, 32);
                if (fq == 0) part[(ai * HALF + wr * 64 + m * 16 + fr) * 4 + wc] = ss; }
        asm volatile("s_waitcnt lgkmcnt(0)" ::: "memory"); __builtin_amdgcn_s_barrier(); asm volatile("" ::: "memory");
        if (threadIdx.x < 256) { const f32x4 p = *(const LAS f32x4*)(part + threadIdx.x * 4); __hip_atomic_store(&RS[(size_t)(u.pm * BM + threadIdx.x) * 4 + u.pn], (p[0] + p[1]) + (p[2] + p[3]), __ATOMIC_RELAXED, __HIP_MEMORY_SCOPE_AGENT); }
        asm volatile("s_waitcnt vmcnt(0)" ::: "memory"); __builtin_amdgcn_s_barrier();
        if (threadIdx.x == 0) { xb_add(&ctl[3840 + u.pm], 1u); XB_SPIN(xb_ld(&ctl[3840 + u.pm]) < 4u, ctl); }
        asm volatile("s_waitcnt vmcnt(0) lgkmcnt(0)" ::: "memory"); __builtin_amdgcn_s_barrier(); asm volatile("" ::: "memory");
#pragma unroll
        for (int ai = 0; ai < 2; ++ai)
#pragma unroll
            for (int m = 0; m < 4; ++m) { const int row = row0 + ai * HALF + m * 16; const size_t off = (size_t)row * 1024 + col0;
                float rs[4];
#pragma unroll
                for (int k = 0; k < 4; ++k) rs[k] = __hip_atomic_load(&RS[(size_t)row * 4 + k], __ATOMIC_RELAXED, __HIP_MEMORY_SCOPE_AGENT);
                const float rstd = 1.0f / sqrtf(((rs[0] + rs[1]) + (rs[2] + rs[3])) * (1.f / 1024.f) + 1e-6f);
#pragma unroll
                for (int bj = 0; bj < 2; ++bj)
#pragma unroll
                    for (int n = 0; n < 2; ++n) { const f32x4 gq = *(const f32x4*)(gain + col0 + bj * HALF + n * 16); *(f32x4*)(out + off + bj * HALF + n * 16) = acc[ai][bj][m][n] * rstd * gq; } }
    }
};

__global__ void __launch_bounds__(NWAVES * 64, 2) mk_fwd(Args args) {
    extern __shared__ __attribute__((aligned(16))) unsigned char lds_raw[];
    Frame F;
    F.lds = (LAS unsigned char*)lds_raw;
#define REFRESH() do { int t_ = threadIdx.x; asm volatile("" : "+v"(t_)); F.tid = t_; F.lane = t_ & 63; F.wave = __builtin_amdgcn_readfirstlane(t_ >> 6); F.gw = blockIdx.x * NWAVES + F.wave; } while (0)
    F.G = gridDim.x; F.ngw = F.G * NWAVES; REFRESH();
    F.out = args.out; F.ws = args.ws;
    const int lo = args.ph_lo, hi = args.ph_hi;
#define IN(k) (lo <= (k) && (k) < hi)
#ifndef USE_CG_SYNC
#define USE_CG_SYNC 0
#endif
    volatile LAS unsigned* bst = (volatile LAS unsigned*)(F.lds + LDS_BYTES - 64);
    if (F.tid < 16) bst[F.tid] = 0u;
    __syncthreads();
    XcdBarrier gbar; gbar.bar = (unsigned*)(F.ws + WS_CTL); gbar.x = 0; gbar.st = bst;
    if (!USE_CG_SYNC && hi - lo > 1) gbar = xcd_barrier_post((unsigned*)(F.ws + WS_CTL), bst);
#define SEAM(k) do { if (IN(k) && IN((k) + 1)) { if (USE_CG_SYNC) cg::this_grid().sync(); else xcd_barrier(gbar); } } while (0)
    unsigned char* ws = F.ws;
    if (IN(0)) { REFRESH(); p0_prologue(F, args); }
    SEAM(0);
    if (IN(1)) { REFRESH();
        pg8::Gemm g{(const bf16*)(ws + WS_XN), (const bf16*)(ws + WS_WIN), S, NPJ, 1024, 1024}; pg8::StaticOrder So; So.init(S, NPJ, F.G, (int)blockIdx.x);
        EpiProj E{(bf16*)(ws + WS_U), (bf16*)(ws + WS_Q), (bf16*)(ws + WS_KVH), (bf16*)(ws + WS_G), (bf16*)(ws + WS_GN)};
        pg8::gemm_phase<EpiProj, pg8::StaticOrder>(F.lds, g, So, E);
    }
    SEAM(1);
    if (IN(2)) { REFRESH();
        for (int u = F.gw; u < 64 * 32; u += F.ngw) s5_unit<false>(F, args, u >> 5, u & 31, F.lds + F.wave * 16384, F.lds + 131072 + F.wave * 2048);
        if (blockIdx.x == F.G - 1) { const float* pp = (const float*)(ws + WS_TAB + TAB_POSB) + (F.tid >> 8) * 64 * 256 + (F.tid & 255); float a = 0.f;
#pragma unroll 16
            for (int p = 0; p < 64; ++p) a += pp[p * 256];
            ((float*)(ws + WS_TAB + TAB_POSBS))[F.tid] = a; }
        __syncthreads();
        pg8::Gemm g{(const bf16*)(ws + WS_KVH), (const bf16*)(ws + WS_WC1), 4096, 1024, 1024 / CMP_KS, 1024}; pg8::CmpOrder So{F.G, (int)blockIdx.x, CMP_KS};
        EpiCmp E{F.out};
        pg8::gemm_phase<EpiCmp, pg8::CmpOrder>(F.lds, g, So, E);
    }
    SEAM(2);
    if (IN(3)) { REFRESH();
        for (int u = F.gw; u < 64 * 32; u += F.ngw) s5_unit<true>(F, args, u >> 5, u & 31, F.lds + F.wave * 16384, F.lds + 131072 + F.wave * 2048);
        __syncthreads();
        {   LAS f32x4* wd = (LAS f32x4*)(F.lds + 8 * 2048);
            for (int e = F.tid; e < 256 * 64 / 4; e += NWAVES * 64) { wd[e] = ((const f32x4*)args.in[16])[e]; wd[256 * 64 / 4 + e] = ((const f32x4*)args.in[18])[e]; } }
        __syncthreads();
        for (int u = F.gw; u < 4 * 1024; u += F.ngw) { const int kvg = u >> 10, n = u & 1023; cmp_l2_unit(F, args, kvg >> 1, kvg & 1, n, (LAS float*)(F.lds + F.wave * 2048), (const LAS float*)(F.lds + 8 * 2048) + (kvg >> 1) * 256 * 64); }
        __syncthreads();
        for (int u = F.gw; u < 2 * 512; u += F.ngw) vtw_item(F, u >> 9, u & 511, (LAS unsigned short*)(F.lds + 81920 + F.wave * 8192));
        for (int u = F.gw; u < 2 * 256; u += F.ngw) vts_item(F, u >> 8, u & 255, (LAS unsigned short*)(F.lds + 81920 + F.wave * 8192));
    }
    SEAM(3);
    if (IN(4)) { REFRESH();
        for (int u = blockIdx.x; u < 256; u += F.G) {
#pragma unroll 1
            for (int g = 0; g < 2; ++g) { const int ta = ((u & 7) << 5) | (u >> 3);
                const int tile = g ? 255 - ta : ta;
                const unsigned soff = (unsigned)__builtin_amdgcn_readfirstlane((int)((blockIdx.x & 127u) * (unsigned)PSLAB));
                attn_tile(F, ws, args.in[19], tile, g, soff); } }
    }
    SEAM(4);
    if (IN(5)) { REFRESH();
        pg8::Gemm g{(const bf16*)(ws + WS_Z), (const bf16*)(ws + WS_WGLU), S, 512, 512, 512}; pg8::StaticOrder So; So.init(S, 512, F.G, (int)blockIdx.x);
        EpiGlu E{(const bf16*)(ws + WS_Z), (bf16*)(ws + WS_ZG)};
        pg8::gemm_phase<EpiGlu, pg8::StaticOrder>(F.lds, g, So, E);
    }
    SEAM(5);
    if (IN(6)) { REFRESH();
        pg8::TwoSegOrder So; So.init(S, 1024, F.G, (int)blockIdx.x);
        pg8::Gemm g{(const bf16*)(ws + WS_ZG), (const bf16*)(ws + WS_WA), S, 1024, 512, 512, (const bf16*)(ws + WS_O), (const bf16*)(ws + WS_WB)}; EpiMix2 E{(const bf16*)(ws + WS_G), (bf16*)(ws + WS_MIX)};
        pg8::gemm_phase<EpiMix2, pg8::TwoSegOrder>(F.lds, g, So, E);
    }
    SEAM(6);
    if (IN(7)) { REFRESH();
        pg8::Gemm g{(const bf16*)(ws + WS_MIX), (const bf16*)(ws + WS_WOUT), S, 1024, 1024, 1024}; pg8::StaticOrder So; So.init(S, 1024, F.G, (int)blockIdx.x);
        EpiResNorm E{args.in[0], F.out, (bf16*)(ws + WS_XN), (float*)(ws + WS_SSP), (LAS float*)(F.lds + pg8::STAGE_BYTES)};
        pg8::gemm_phase<EpiResNorm, pg8::StaticOrder>(F.lds, g, So, E);
    }
    SEAM(7);
    if (IN(9)) { REFRESH();
        pg8::Gemm g{(const bf16*)(ws + WS_XN), (const bf16*)(ws + WS_WGU), S, 2 * DFF, 1024, 1024}; pg8::StaticOrder So; So.init(S, 2 * DFF, F.G, (int)blockIdx.x);
        EpiFfn E{(bf16*)(ws + WS_H), (const float*)(ws + WS_SSP)};
        pg8::gemm_phase<EpiFfn, pg8::StaticOrder>(F.lds, g, So, E);
    }
    SEAM(9);
    const bool fuse_final = (F.G == 256) && IN(10) && IN(11);
    if (IN(10)) { REFRESH();
        pg8::Gemm g{(const bf16*)(ws + WS_H), (const bf16*)(ws + WS_WD), S, 1024, DFF, DFF}; pg8::StaticOrder So; So.init(S, 1024, F.G, (int)blockIdx.x);
        if (fuse_final) { EpiResFinal E{F.out, F.out, args.in[26], (float*)(ws + WS_SSP), (unsigned*)(ws + WS_CTL), (LAS float*)(F.lds + pg8::STAGE_BYTES)}; pg8::gemm_phase<EpiResFinal, pg8::StaticOrder>(F.lds, g, So, E); }
        else { EpiRes E{F.out, F.out}; pg8::gemm_phase<EpiRes, pg8::StaticOrder>(F.lds, g, So, E); }
    }
    if (!fuse_final) {
    SEAM(10);
    if (IN(11)) { REFRESH(); for (int m = F.gw; m < S; m += F.ngw) rms_row_f32(F.out + (size_t)m * DM, args.in[26], F.lane); }
    }
#undef IN
#undef SEAM
}

extern "C" void kernel_launch(void* const* d_in, const int* in_sizes, int n_in, void* d_out, int out_size, void* d_ws, size_t ws_size, hipStream_t stream) {
    static int grid = 0;
    if (grid == 0) {
        if (n_in != 27 || out_size != S * DM || ws_size < WS_END) { fprintf(stderr, "kernel_launch: unexpected shapes (n_in %d out %d ws %zu)\n", n_in, out_size, ws_size); grid = -1; return; }
        int dev = 0, cus = 0, per_cu = 0;
        if (hipGetDevice(&dev) != hipSuccess || hipDeviceGetAttribute(&cus, hipDeviceAttributeMultiprocessorCount, dev) != hipSuccess) { grid = -1; return; }
        if (hipFuncSetAttribute((const void*)mk_fwd, hipFuncAttributeMaxDynamicSharedMemorySize, LDS_BYTES) != hipSuccess) { fprintf(stderr, "kernel_launch: hipFuncSetAttribute failed\n"); grid = -1; return; }
        if (hipOccupancyMaxActiveBlocksPerMultiprocessor(&per_cu, (const void*)mk_fwd, NWAVES * 64, LDS_BYTES) != hipSuccess || per_cu < 1) { fprintf(stderr, "kernel_launch: occupancy query says %d\n", per_cu); per_cu = 1; }
        (void)hipGetLastError();
        grid = cus * (per_cu < 1 ? 1 : 1);
    }
    if (grid < 0) return;
    if (hipMemsetAsync((char*)d_ws + WS_CTL, 0, 16384, stream) != hipSuccess) { fprintf(stderr, "kernel_launch: hipMemsetAsync failed\n"); return; }
    Args a{};
    for (int i = 0; i < 27; ++i) a.in[i] = (const float*)d_in[i];
    a.out = (float*)d_out; a.ws = (unsigned char*)d_ws;
    if (MK_N_LAUNCHES == 1) {
        a.ph_lo = 0; a.ph_hi = NPH;
        void* kargs[] = {&a};
        hipError_t e = hipLaunchCooperativeKernel((const void*)mk_fwd, dim3(grid), dim3(NWAVES * 64), kargs, LDS_BYTES, stream);
        if (e != hipSuccess) fprintf(stderr, "kernel_launch: cooperative launch failed: %s (grid %d)\n", hipGetErrorString(e), grid);
    } else {
        for (int ph = 0; ph < NPH; ++ph) { a.ph_lo = ph; a.ph_hi = ph + 1; hipLaunchKernelGGL(mk_fwd, dim3(grid), dim3(NWAVES * 64), LDS_BYTES, stream, a); }
    }
}
```

```cpp
#include <hip/hip_runtime.h>
#include <hip/hip_cooperative_groups.h>
#include <cstdio>
#include <cstdint>
namespace cg = cooperative_groups;

#ifndef MK_N_LAUNCHES
#define MK_N_LAUNCHES 1
#endif

namespace pg8 {
#define PG8_LAS __attribute__((address_space(3)))
typedef unsigned short bf16_t;
typedef short bf16x8 __attribute__((ext_vector_type(8)));
typedef float f32x4 __attribute__((ext_vector_type(4)));
typedef unsigned u32x4 __attribute__((ext_vector_type(4)));
constexpr int BM = 256, BK = 64, HALF = 128, HTB = HALF * BK * 2, STAGE_BYTES = 8 * HTB, NXCD = 8, WGM = 8;

__host__ __device__ __forceinline__ int lds_byte(int r, int c) { const int st = (r >> 4) * 2 + (c >> 5), rr = r & 15, cc = c & 31, ob = rr * 64 + cc * 2; return st * 1024 + (ob ^ (((ob >> 9) & 1) << 5)); }
__host__ __device__ __forceinline__ void stage_rc(int b, int& R, int& C) { const int st = b / 1024, sb = b % 1024, swz = sb ^ (((sb >> 9) & 1) << 5); R = (st >> 1) * 16 + swz / 64; C = (st & 1) * 32 + (swz % 64) / 2; }
__host__ __device__ __forceinline__ int perm32(int rho) { const int n = rho >> 4, i = rho & 15; return 8 * (i >> 2) + 4 * n + (i & 3); }

struct Unit { int pm, pn, ks, seg; };
struct Gemm { const bf16_t* A; const bf16_t* Bt; int M, N, K, ld; const bf16_t* A2; const bf16_t* Bt2; };

struct StaticOrder {
    static constexpr bool SINGLE = false;
    int nM, nN, nwg, G, c;
    __host__ __device__ void init(int M, int N, int G_, int c_) { nM = M / BM; nN = N / BM; nwg = nM * nN; G = G_; c = c_; }
    __host__ __device__ bool next(int i, Unit& u) const {
        const long L = (long)i * G + c; if (L >= nwg) return false;
        int wgid = (int)L; { const int q = nwg / NXCD, r = nwg % NXCD, xcd = wgid % NXCD, off = wgid / NXCD; wgid = (xcd < r ? xcd * (q + 1) : r * (q + 1) + (xcd - r) * q) + off; }
        const int nig = WGM * nN, gid = wgid / nig, fm = gid * WGM, gsz = (nM - fm) < WGM ? (nM - fm) : WGM;
        u.pm = fm + ((wgid % nig) % gsz); u.pn = (wgid % nig) / gsz; u.ks = 0; u.seg = 0; return true;
    }
};
struct TwoSegOrder : StaticOrder {
    __host__ __device__ bool next(int i, Unit& u) const { if (!StaticOrder::next(i >> 1, u)) return false; u.seg = i & 1; return true; }
};
struct CmpOrder {
    static constexpr bool SINGLE = true;
    int G, c, KS;
    __host__ __device__ bool next(int i, Unit& u) const {
        const int L = i * G + c; if (L >= 32 * KS) return false;
        const int tile = L / KS; u.ks = L % KS; u.pm = tile >> 1; u.pn = (tile & 1) + (u.pm >= 8 ? 2 : 0); u.seg = 0; return true;
    }
};

typedef float f32x2_t __attribute__((ext_vector_type(2))); typedef __bf16 bf16x2_t __attribute__((ext_vector_type(2)));
__device__ __forceinline__ unsigned cvt_pk_bf16(float lo, float hi) { f32x2_t v = {lo, hi}; bf16x2_t b = __builtin_convertvector(v, bf16x2_t); return __builtin_bit_cast(unsigned, b); }
__device__ __forceinline__ float bflo(unsigned w) { return __uint_as_float(w << 16); }
__device__ __forceinline__ float bfhi(unsigned w) { return __uint_as_float(w & 0xffff0000u); }
__device__ __forceinline__ float sigm(float x) { return __builtin_amdgcn_rcpf(1.0f + __expf(-x)); }

template <class Epi, class Sched>
__device__ __forceinline__ void gemm_phase(PG8_LAS unsigned char* lds, const Gemm g, const Sched& S, const Epi& E) {
    const int tid = threadIdx.x, wid = __builtin_amdgcn_readfirstlane(tid >> 6), lane = tid & 63, wr = wid >> 2, wc = wid & 3, fr = lane & 15, fq = lane >> 4;
    const int K = g.K, ld = g.ld, nt = K / BK;
    unsigned voffA[2], voffB[2];
#pragma unroll
    for (int i = 0; i < 2; ++i) { int R, C; stage_rc(tid * 16 + i * 8192, R, C); const int Rb = Epi::PERM ? ((R & ~31) + perm32(R & 31)) : R;
        voffA[i] = (unsigned)(R * ld + C) * 2u; voffB[i] = (unsigned)(Rb * ld + C) * 2u; }
    const size_t kstep = (size_t)(BK * 2);
    const size_t hstep = (size_t)HALF * ld * 2;
    const size_t tstep = 2 * hstep;
    const unsigned ldsw = (unsigned)wid * 1024u;
    const int aoff = lds_byte(wr * 64 + fr, fq * 8), boff = lds_byte(wc * 32 + fr, fq * 8);
#define PG8_SA(b, h) (((b) * 2 + (h)) * HTB)
#define PG8_SB(b, h) ((4 + (b) * 2 + (h)) * HTB)
#define PG8_STAGE(bufoff, gbase, voff) do { _Pragma("unroll") for (int _i = 0; _i < 2; ++_i) \
        __builtin_amdgcn_global_load_lds((const unsigned*)((const char*)(gbase) + (voff)[_i]), (PG8_LAS unsigned*)(lds + (bufoff) + ldsw + _i * 8192), 16, 0, 0); } while (0)
#define PG8_LDA(dst, b, h) do { _Pragma("unroll") for (int m = 0; m < 4; ++m) _Pragma("unroll") for (int k = 0; k < 2; ++k) dst[m][k] = *(const PG8_LAS bf16x8*)(lds + PG8_SA(b, h) + aoff + m * 2048 + k * 1024); } while (0)
#define PG8_LDB(dst, b, h) do { _Pragma("unroll") for (int n = 0; n < 2; ++n) _Pragma("unroll") for (int k = 0; k < 2; ++k) dst[n][k] = *(const PG8_LAS bf16x8*)(lds + PG8_SB(b, h) + boff + n * 2048 + k * 1024); } while (0)
#define PG8_MMA(ai, bj, At, Bt) do { __builtin_amdgcn_s_setprio(1); _Pragma("unroll") for (int m = 0; m < 4; ++m) _Pragma("unroll") for (int n = 0; n < 2; ++n) _Pragma("unroll") for (int k = 0; k < 2; ++k) \
        acc[ai][bj][m][n] = __builtin_amdgcn_mfma_f32_16x16x32_bf16(Bt[n][k], At[m][k], acc[ai][bj][m][n], 0, 0, 0); __builtin_amdgcn_s_setprio(0); } while (0)
#define PG8_WAIT_V(n) asm volatile("s_waitcnt vmcnt(" #n ")" ::: "memory")
#define PG8_WAIT_L(n) asm volatile("s_waitcnt lgkmcnt(" #n ")" ::: "memory")
#define PG8_BAR __builtin_amdgcn_s_barrier()
#define PG8_SCHED __builtin_amdgcn_sched_barrier(0)
    Unit cur, nxt; int ui = 0;
    if (!S.next(0, cur)) return;
    f32x4 acc[2][2][4][2];
#pragma unroll
    for (int a = 0; a < 2; ++a)
#pragma unroll
        for (int b = 0; b < 2; ++b)
#pragma unroll
            for (int m = 0; m < 4; ++m)
#pragma unroll
                for (int n = 0; n < 2; ++n) acc[a][b][m][n] = (f32x4){0.f, 0.f, 0.f, 0.f};
    bf16x8 At[4][2], B0[2][2], B1[2][2];
    const char* cA = (const char*)(cur.seg ? g.A2 : g.A) + (size_t)cur.pm * tstep + (size_t)cur.ks * K * 2; const char* cB = (const char*)(cur.seg ? g.Bt2 : g.Bt) + (size_t)cur.pn * tstep + (size_t)cur.ks * K * 2;
    PG8_STAGE(PG8_SB(0, 0), cB, voffB); PG8_STAGE(PG8_SB(0, 1), cB + hstep, voffB); PG8_STAGE(PG8_SA(0, 0), cA, voffA); PG8_STAGE(PG8_SA(0, 1), cA + hstep, voffA);
    if (wr == 1) PG8_BAR;
    PG8_WAIT_V(2); PG8_BAR;
    PG8_STAGE(PG8_SB(1, 0), cB + kstep, voffB); PG8_STAGE(PG8_SA(1, 0), cA + kstep, voffA); PG8_STAGE(PG8_SB(1, 1), cB + hstep + kstep, voffB);
    PG8_WAIT_V(6); PG8_BAR;
    for (;;) {
        const bool has_next = Sched::SINGLE ? false : S.next(ui + 1, nxt);
        const char* nA = has_next ? (const char*)(nxt.seg ? g.A2 : g.A) + (size_t)nxt.pm * tstep + (size_t)nxt.ks * K * 2 : cA; const char* nB = has_next ? (const char*)(nxt.seg ? g.Bt2 : g.Bt) + (size_t)nxt.pn * tstep + (size_t)nxt.ks * K * 2 : cB;
        for (int t = 0; t < nt; t += 2) {
            const bool last = (t == nt - 2);
            const char* a1 = cA + (size_t)(t + 1) * kstep;
            const char* a2 = last ? nA : cA + (size_t)(t + 2) * kstep; const char* b2 = last ? nB : cB + (size_t)(t + 2) * kstep;
            const char* a3 = a2 + kstep; const char* b3 = b2 + kstep;
            PG8_LDB(B0, 0, 0); PG8_LDB(B1, 0, 1); PG8_SCHED; PG8_LDA(At, 0, 0); PG8_STAGE(PG8_SA(1, 1), a1 + hstep, voffA);
            PG8_WAIT_V(8); PG8_WAIT_L(0); PG8_BAR; PG8_MMA(0, 0, At, B0); PG8_MMA(0, 1, At, B1); PG8_BAR; PG8_SCHED;
            PG8_LDA(At, 0, 1); PG8_STAGE(PG8_SB(0, 0), b2, voffB); PG8_STAGE(PG8_SB(0, 1), b2 + hstep, voffB); PG8_STAGE(PG8_SA(0, 0), a2, voffA);
            PG8_WAIT_V(8); PG8_WAIT_L(0); PG8_BAR; PG8_MMA(1, 0, At, B0); PG8_MMA(1, 1, At, B1); PG8_BAR; PG8_SCHED;
            PG8_LDB(B0, 1, 0); PG8_LDB(B1, 1, 1); PG8_SCHED; PG8_LDA(At, 1, 0); PG8_STAGE(PG8_SA(0, 1), a2 + hstep, voffA);
            PG8_WAIT_V(8); PG8_WAIT_L(0); PG8_BAR; PG8_MMA(0, 0, At, B0); PG8_MMA(0, 1, At, B1); PG8_BAR; PG8_SCHED;
            PG8_LDA(At, 1, 1); PG8_STAGE(PG8_SB(1, 0), b3, voffB); PG8_STAGE(PG8_SB(1, 1), b3 + hstep, voffB); PG8_STAGE(PG8_SA(1, 0), a3, voffA);
            PG8_WAIT_V(8); PG8_WAIT_L(0); PG8_BAR; PG8_MMA(1, 0, At, B0); PG8_MMA(1, 1, At, B1); PG8_BAR; PG8_SCHED;
        }
        if (wr == 0) PG8_BAR;
        E(acc, cur, wr, wc, fr, fq);
        if (!has_next) break;
        if (!nxt.seg) {
#pragma unroll
        for (int a = 0; a < 2; ++a)
#pragma unroll
            for (int b = 0; b < 2; ++b)
#pragma unroll
                for (int m = 0; m < 4; ++m)
#pragma unroll
                    for (int n = 0; n < 2; ++n) acc[a][b][m][n] = (f32x4){0.f, 0.f, 0.f, 0.f}; }
        cur = nxt; cA = nA; cB = nB; ++ui;
        if (wr == 1) PG8_BAR;
    }
    PG8_WAIT_V(0);
    PG8_BAR;
#undef PG8_SA
#undef PG8_SB
#undef PG8_STAGE
#undef PG8_LDA
#undef PG8_LDB
#undef PG8_MMA
#undef PG8_WAIT_V
#undef PG8_WAIT_L
#undef PG8_BAR
#undef PG8_SCHED
}
}

constexpr int S = 16384, DM = 1024, INC = 3864, NPJ = 4096, SSW = 512, NSW = 512, HD = 64, DFF = 2816;
constexpr int NGRP = 32, NST = 64, NCMP = 1023;
constexpr int NWAVES = 8;
constexpr int NPH = 12;
constexpr int CMP_KS = 4;
constexpr float EPS = 1e-6f;

constexpr size_t MiB = 1u << 20;
constexpr size_t WS_CTL = 0;
constexpr size_t WS_TAB = 1 * MiB;
constexpr size_t TAB_BF = 0, TAB_CF = 128 * 1024, TAB_LAM = 256 * 1024, TAB_LAM256 = 272 * 1024, TAB_POSB = 288 * 1024, TAB_POSBS = 420 * 1024;
constexpr size_t WS_SSP = 1 * MiB + 512 * 1024;
constexpr size_t WS_F = 2 * MiB;
constexpr size_t WS_KVC = 3 * MiB;
constexpr size_t WS_WIN = 4 * MiB, WS_WGU = 12 * MiB, WS_WD = 23 * MiB, WS_WOUT = 29 * MiB, WS_WA = 31 * MiB, WS_WB = 32 * MiB, WS_WGLU = 33 * MiB, WS_WC1 = 34 * MiB;
constexpr size_t WS_XN = 36 * MiB;
constexpr size_t WS_Z = WS_XN, WS_ZG = WS_XN + 16 * MiB;
constexpr size_t WS_U = 68 * MiB, WS_O = WS_U;
constexpr size_t WS_Q = 84 * MiB;
constexpr size_t WS_KVH = 100 * MiB;
constexpr size_t WS_G = 124 * MiB;
constexpr size_t WS_GN = 188 * MiB;
constexpr size_t WS_MIX = 84 * MiB;
constexpr size_t WS_H = 100 * MiB;
constexpr size_t WS_VTW = 189 * MiB;
constexpr size_t WS_KTS = 4 * MiB;
constexpr size_t WS_VTS = 193 * MiB;
constexpr size_t WS_KCB = 197 * MiB;
constexpr size_t WS_VTC = 197 * MiB + 512 * 1024;
constexpr size_t WS_PSLAB = 198 * MiB;
constexpr size_t WS_END = 254 * MiB;

constexpr int LDS_BYTES = 163840;

#define GAS __attribute__((address_space(1)))
#define LAS __attribute__((address_space(3)))
typedef unsigned short bf16;
typedef unsigned v4u __attribute__((ext_vector_type(4)));
typedef float f32x4 __attribute__((ext_vector_type(4)));
typedef float f32x2 __attribute__((ext_vector_type(2)));
typedef float f32x16 __attribute__((ext_vector_type(16)));
typedef short bf16x8 __attribute__((ext_vector_type(8)));
#define LDS_WAIT() asm volatile("s_waitcnt lgkmcnt(0)" ::: "memory")
#define VM_WAIT() asm volatile("s_waitcnt vmcnt(0)" ::: "memory")
typedef float f32x2c_t __attribute__((ext_vector_type(2))); typedef __bf16 bf16x2c_t __attribute__((ext_vector_type(2)));
__device__ __forceinline__ unsigned pk2(float lo, float hi) { f32x2c_t v = {lo, hi}; bf16x2c_t b = __builtin_convertvector(v, bf16x2c_t); return __builtin_bit_cast(unsigned, b); }
__device__ __forceinline__ unsigned f2bf(float f) { return pk2(f, 0.f) & 0xffffu; }
__device__ __forceinline__ float bf2f(bf16 v) { return __uint_as_float((unsigned)v << 16); }
using pg8::bflo; using pg8::bfhi; using pg8::sigm; using pg8::cvt_pk_bf16;
__device__ __forceinline__ float gelu_tanh(float y) {
    const float a = 0.7978845608028654f * (y + 0.044715f * y * y * y);
    const float e = __expf(2.0f * a);
    const float th = 1.0f - 2.0f * __builtin_amdgcn_rcpf(e + 1.0f);
    return 0.5f * y * (1.0f + th);
}
__device__ __forceinline__ float wave_sum(float v) {
#pragma unroll
    for (int o = 1; o < 64; o <<= 1) v += __shfl_xor(v, o);
    return v;
}
__device__ __forceinline__ float wave_max(float v) {
#pragma unroll
    for (int o = 1; o < 64; o <<= 1) v = fmaxf(v, __shfl_xor(v, o));
    return v;
}

struct Args { const float* in[27]; float* out; unsigned char* ws; int ph_lo, ph_hi; };

struct Frame {
    LAS unsigned char* lds;
    int tid, lane, wave, G, gw, ngw;
    float* out; unsigned char* ws;
};

using pg8::Unit; using pg8::BM; using pg8::HALF;
struct EpiProj {
    static constexpr bool PERM = true;
    bf16 *U, *Q, *KVH, *Gt, *GN;
    __device__ __forceinline__ void operator()(const f32x4 (&acc)[2][2][4][2], const Unit& u, int wr, int wc, int fr, int fq) const {
        const int row0 = u.pm * BM + wr * 64 + fr, pn = u.pn;
#pragma unroll
        for (int ai = 0; ai < 2; ++ai)
#pragma unroll
            for (int m = 0; m < 4; ++m) { const int row = row0 + ai * HALF + m * 16;
#pragma unroll
                for (int bj = 0; bj < 2; ++bj) { f32x4 v0 = acc[ai][bj][m][0], v1 = acc[ai][bj][m][1]; const int col = bj * HALF + wc * 32 + 8 * fq; bf16* dst;
                    if (pn < 2) dst = U + (size_t)row * 512 + pn * 256 + col;
                    else if (pn < 4) { v0 = v0 * (0.125f * 1.4426950408889634f); v1 = v1 * (0.125f * 1.4426950408889634f); dst = Q + (size_t)row * 512 + (pn - 2) * 256 + col; }
                    else if (pn < 7) dst = KVH + ((size_t)((pn - 4) * 4 + (col >> 6)) * S + row) * 64 + (col & 63);
                    else { v0 = (f32x4){sigm(v0[0]), sigm(v0[1]), sigm(v0[2]), sigm(v0[3])}; v1 = (f32x4){sigm(v1[0]), sigm(v1[1]), sigm(v1[2]), sigm(v1[3])};
                        if (pn < 15) dst = Gt + (size_t)row * 2048 + (pn - 7) * 256 + col; else { if (col >= 32) continue; dst = GN + (size_t)row * 32 + col; } }
                    v4u w; w.x = cvt_pk_bf16(v0[0], v0[1]); w.y = cvt_pk_bf16(v0[2], v0[3]); w.z = cvt_pk_bf16(v1[0], v1[1]); w.w = cvt_pk_bf16(v1[2], v1[3]);
                    *(v4u*)dst = w; } }
    }
};
struct EpiCmp {
    static constexpr bool PERM = false;
    float* C;
    __device__ __forceinline__ void operator()(const f32x4 (&acc)[2][2][4][2], const Unit& u, int wr, int wc, int fr, int fq) const {
        const int row0 = u.pm * BM + wr * 64 + fr, col0 = (u.pn & 1) * BM + wc * 32 + 4 * fq; float* base = C + (size_t)u.ks * 4096 * 512;
#pragma unroll
        for (int ai = 0; ai < 2; ++ai)
#pragma unroll
            for (int m = 0; m < 4; ++m) { float* rowp = base + (size_t)(row0 + ai * HALF + m * 16) * 512 + col0;
#pragma unroll
                for (int bj = 0; bj < 2; ++bj)
#pragma unroll
                    for (int n = 0; n < 2; ++n) *(f32x4*)(rowp + bj * HALF + n * 16) = acc[ai][bj][m][n]; }
    }
};
struct EpiGlu {
    static constexpr bool PERM = true;
    const bf16* Z; bf16* ZG;
    __device__ __forceinline__ void operator()(const f32x4 (&acc)[2][2][4][2], const Unit& u, int wr, int wc, int fr, int fq) const {
        const int row0 = u.pm * BM + wr * 64 + fr;
#pragma unroll
        for (int ai = 0; ai < 2; ++ai)
#pragma unroll
            for (int m = 0; m < 4; ++m) { const int row = row0 + ai * HALF + m * 16;
#pragma unroll
                for (int bj = 0; bj < 2; ++bj) { const f32x4 v0 = acc[ai][bj][m][0], v1 = acc[ai][bj][m][1]; const size_t off = (size_t)row * 512 + u.pn * BM + bj * HALF + wc * 32 + 8 * fq;
                    const v4u z = *(const v4u*)(Z + off); v4u w;
                    w.x = cvt_pk_bf16(bflo(z.x) * sigm(v0[0]), bfhi(z.x) * sigm(v0[1])); w.y = cvt_pk_bf16(bflo(z.y) * sigm(v0[2]), bfhi(z.y) * sigm(v0[3]));
                    w.z = cvt_pk_bf16(bflo(z.z) * sigm(v1[0]), bfhi(z.z) * sigm(v1[1])); w.w = cvt_pk_bf16(bflo(z.w) * sigm(v1[2]), bfhi(z.w) * sigm(v1[3]));
                    *(v4u*)(ZG + off) = w; } }
    }
};
struct EpiMix2 {
    static constexpr bool PERM = true;
    const bf16* Gt; bf16* MIX;
    __device__ __forceinline__ void operator()(f32x4 (&acc)[2][2][4][2], const Unit& u, int wr, int wc, int fr, int fq) const {
        const int row0 = u.pm * BM + wr * 64 + fr;
#pragma unroll
        for (int ai = 0; ai < 2; ++ai)
#pragma unroll
            for (int m = 0; m < 4; ++m) { const int row = row0 + ai * HALF + m * 16;
#pragma unroll
                for (int bj = 0; bj < 2; ++bj) { const int col = u.pn * BM + bj * HALF + wc * 32 + 8 * fq;
                    const v4u gb = *(const v4u*)(Gt + (size_t)row * 2048 + 1024 + col);
                    const float b8[8] = {bflo(gb.x), bfhi(gb.x), bflo(gb.y), bfhi(gb.y), bflo(gb.z), bfhi(gb.z), bflo(gb.w), bfhi(gb.w)};
                    if (u.seg == 0) { const v4u ga = *(const v4u*)(Gt + (size_t)row * 2048 + col);
                        const float a8[8] = {bflo(ga.x), bfhi(ga.x), bflo(ga.y), bfhi(ga.y), bflo(ga.z), bfhi(ga.z), bflo(ga.w), bfhi(ga.w)};
#pragma unroll
                        for (int e = 0; e < 4; ++e) { acc[ai][bj][m][0][e] *= a8[e] * __builtin_amdgcn_rcpf(b8[e]); acc[ai][bj][m][1][e] *= a8[4 + e] * __builtin_amdgcn_rcpf(b8[4 + e]); }
                    } else { const f32x4 v0 = acc[ai][bj][m][0], v1 = acc[ai][bj][m][1]; v4u w;
                        w.x = cvt_pk_bf16(v0[0] * b8[0], v0[1] * b8[1]); w.y = cvt_pk_bf16(v0[2] * b8[2], v0[3] * b8[3]); w.z = cvt_pk_bf16(v1[0] * b8[4], v1[1] * b8[5]); w.w = cvt_pk_bf16(v1[2] * b8[6], v1[3] * b8[7]);
                        *(v4u*)(MIX + (size_t)row * 1024 + col) = w; } } }
    }
};
struct EpiRes {
    static constexpr bool PERM = false;
    const float* base; float* out;
    __device__ __forceinline__ void operator()(const f32x4 (&acc)[2][2][4][2], const Unit& u, int wr, int wc, int fr, int fq) const {
        const int row0 = u.pm * BM + wr * 64 + fr, col0 = u.pn * BM + wc * 32 + 4 * fq;
#pragma unroll
        for (int ai = 0; ai < 2; ++ai)
#pragma unroll
            for (int m = 0; m < 4; ++m) { const size_t off = (size_t)(row0 + ai * HALF + m * 16) * 1024 + col0;
#pragma unroll
                for (int bj = 0; bj < 2; ++bj)
#pragma unroll
                    for (int n = 0; n < 2; ++n) { const f32x4 b = *(const f32x4*)(base + off + bj * HALF + n * 16); *(f32x4*)(out + off + bj * HALF + n * 16) = b + acc[ai][bj][m][n]; } }
    }
};
struct EpiResNorm {
    static constexpr bool PERM = false;
    const float* base; float* out; bf16* XN; float* SSP; LAS float* part;
    __device__ __forceinline__ void operator()(const f32x4 (&acc)[2][2][4][2], const Unit& u, int wr, int wc, int fr, int fq) const {
        const int row0 = u.pm * BM + wr * 64 + fr, col0 = u.pn * BM + wc * 32 + 4 * fq;
#pragma unroll
        for (int ai = 0; ai < 2; ++ai)
#pragma unroll
            for (int m = 0; m < 4; ++m) { const size_t off = (size_t)(row0 + ai * HALF + m * 16) * 1024 + col0; float ss = 0.f;
#pragma unroll
                for (int bj = 0; bj < 2; ++bj)
#pragma unroll
                    for (int n = 0; n < 2; ++n) { const f32x4 b = *(const f32x4*)(base + off + bj * HALF + n * 16); const f32x4 x1 = b + acc[ai][bj][m][n]; *(f32x4*)(out + off + bj * HALF + n * 16) = x1;
                        *(unsigned long long*)(XN + off + bj * HALF + n * 16) = (unsigned long long)cvt_pk_bf16(x1[0], x1[1]) | ((unsigned long long)cvt_pk_bf16(x1[2], x1[3]) << 32);
                        ss += (x1[0] * x1[0] + x1[1] * x1[1]) + (x1[2] * x1[2] + x1[3] * x1[3]); }
                ss += __shfl_xor(ss, 16); ss += __shfl_xor(ss, 32);
                if (fq == 0) part[(ai * HALF + wr * 64 + m * 16 + fr) * 4 + wc] = ss; }
        asm volatile("s_waitcnt lgkmcnt(0)" ::: "memory"); __builtin_amdgcn_s_barrier(); asm volatile("" ::: "memory");
        if (threadIdx.x < 256) { const f32x4 p = *(const LAS f32x4*)(part + threadIdx.x * 4); SSP[(size_t)(u.pm * BM + threadIdx.x) * 4 + u.pn] = (p[0] + p[1]) + (p[2] + p[3]); }
    }
};
struct EpiFfn {
    static constexpr bool PERM = true;
    bf16* H; const float* SSP;
    __device__ __forceinline__ void operator()(const f32x4 (&acc)[2][2][4][2], const Unit& u, int wr, int wc, int fr, int fq) const {
        const int row0 = u.pm * BM + wr * 64 + fr;
#pragma unroll
        for (int ai = 0; ai < 2; ++ai)
#pragma unroll
            for (int m = 0; m < 4; ++m) { const int row = row0 + ai * HALF + m * 16;
                const f32x4 sp = *(const f32x4*)(SSP + (size_t)row * 4); const float rs = 1.0f / sqrtf(((sp[0] + sp[1]) + (sp[2] + sp[3])) * (1.f / 1024.f) + 1e-6f);
                float r[8];
#pragma unroll
                for (int n = 0; n < 2; ++n)
#pragma unroll
                    for (int e = 0; e < 4; ++e) { const float gt = acc[ai][0][m][n][e] * rs, up = acc[ai][1][m][n][e] * rs; r[n * 4 + e] = gt * sigm(gt) * up; }
                v4u w; w.x = cvt_pk_bf16(r[0], r[1]); w.y = cvt_pk_bf16(r[2], r[3]); w.z = cvt_pk_bf16(r[4], r[5]); w.w = cvt_pk_bf16(r[6], r[7]);
                *(v4u*)(H + (size_t)row * DFF + u.pn * HALF + wc * 32 + 8 * fq) = w; }
    }
};

struct TrDesc { const float* src; bf16* dst; int ld, ncols, dld, drow, kb, nb; const float* gain; };
__device__ __forceinline__ void tr_load(const TrDesc& d, float (&v)[32], int lane) {
    const int k0 = 64 * d.kb, c = 32 * d.nb + (lane & 31); const bool ok = c < d.ncols; const float* p = d.src + (size_t)(k0 + (lane >> 5)) * d.ld + c;
#pragma unroll
    for (int i = 0; i < 32; ++i) v[i] = ok ? p[(size_t)(2 * i) * d.ld] : 0.f;
    if (d.gain) {
#pragma unroll
        for (int i = 0; i < 32; ++i) v[i] *= d.gain[k0 + 2 * i + (lane >> 5)]; }
}
__device__ __forceinline__ void tr_finish(const TrDesc& d, const float (&v)[32], LAS float* scr, int lane) {
#pragma unroll
    for (int i = 0; i < 32; ++i) scr[(2 * i + (lane >> 5)) * 33 + (lane & 31)] = v[i];
    LDS_WAIT();
    const int cc = lane & 7, k0 = 64 * d.kb;
#pragma unroll
    for (int j = 0; j < 4; ++j) { const int n = (lane >> 3) + 8 * j; const LAS float* s = scr + (8 * cc) * 33 + n;
        v4u o; o.x = pk2(s[0 * 33], s[1 * 33]); o.y = pk2(s[2 * 33], s[3 * 33]); o.z = pk2(s[4 * 33], s[5 * 33]); o.w = pk2(s[6 * 33], s[7 * 33]);
        *(v4u*)(d.dst + (size_t)(d.drow + n) * d.dld + k0 + 8 * cc) = o; }
    LDS_WAIT();
}
__device__ __forceinline__ void rms_row_to_bf16(const float* xrow, const float* gain, bf16* orow, int lane) {
    const f32x4* xr = (const f32x4*)xrow + lane; const f32x4* gr = (const f32x4*)gain + lane;
    f32x4 v[4]; float s = 0.f;
#pragma unroll
    for (int j = 0; j < 4; ++j) { v[j] = xr[64 * j]; s += (v[j].x * v[j].x + v[j].y * v[j].y) + (v[j].z * v[j].z + v[j].w * v[j].w); }
    const float rstd = 1.0f / sqrtf(wave_sum(s) * (1.f / DM) + EPS);
    unsigned long long* o8 = (unsigned long long*)orow + lane;
#pragma unroll
    for (int j = 0; j < 4; ++j) { const f32x4 gq = gr[64 * j];
        o8[64 * j] = (unsigned long long)pk2(v[j].x * rstd * gq.x, v[j].y * rstd * gq.y) | ((unsigned long long)pk2(v[j].z * rstd * gq.z, v[j].w * rstd * gq.w) << 32); }
}
__device__ __forceinline__ void rms_rows2_to_bf16(const float* x0, const float* x1, const float* gain, bf16* o0, bf16* o1, int lane) {
    const f32x4* xa = (const f32x4*)x0 + lane; const f32x4* xb = (const f32x4*)x1 + lane; const f32x4* gr = (const f32x4*)gain + lane;
    f32x4 va[4], vb[4]; float sa = 0.f, sb = 0.f;
#pragma unroll
    for (int j = 0; j < 4; ++j) { va[j] = xa[64 * j]; vb[j] = xb[64 * j]; }
#pragma unroll
    for (int j = 0; j < 4; ++j) { sa += (va[j].x * va[j].x + va[j].y * va[j].y) + (va[j].z * va[j].z + va[j].w * va[j].w); sb += (vb[j].x * vb[j].x + vb[j].y * vb[j].y) + (vb[j].z * vb[j].z + vb[j].w * vb[j].w); }
    const float ra = 1.0f / sqrtf(wave_sum(sa) * (1.f / DM) + EPS), rb = 1.0f / sqrtf(wave_sum(sb) * (1.f / DM) + EPS);
    unsigned long long* pa = (unsigned long long*)o0 + lane; unsigned long long* pb = (unsigned long long*)o1 + lane;
#pragma unroll
    for (int j = 0; j < 4; ++j) { const f32x4 gq = gr[64 * j];
        pa[64 * j] = (unsigned long long)pk2(va[j].x * ra * gq.x, va[j].y * ra * gq.y) | ((unsigned long long)pk2(va[j].z * ra * gq.z, va[j].w * ra * gq.w) << 32);
        pb[64 * j] = (unsigned long long)pk2(vb[j].x * rb * gq.x, vb[j].y * rb * gq.y) | ((unsigned long long)pk2(vb[j].z * rb * gq.z, vb[j].w * rb * gq.w) << 32); }
}
__device__ __forceinline__ void rms_row_f32(float* xrow, const float* gain, int lane) {
    f32x4* xr = (f32x4*)xrow + lane; const f32x4* gr = (const f32x4*)gain + lane;
    f32x4 v[4]; float s = 0.f;
#pragma unroll
    for (int j = 0; j < 4; ++j) { v[j] = xr[64 * j]; s += (v[j].x * v[j].x + v[j].y * v[j].y) + (v[j].z * v[j].z + v[j].w * v[j].w); }
    const float rstd = 1.0f / sqrtf(wave_sum(s) * (1.f / DM) + EPS);
#pragma unroll
    for (int j = 0; j < 4; ++j) { const f32x4 gq = gr[64 * j]; xr[64 * j] = v[j] * rstd * gq; }
}
__device__ __forceinline__ void s5_tables(const Frame& F, const Args& args, int g, int part) {
    const int lane = F.lane;
    const float* are = args.in[3]; const float* aim = args.in[4]; const float* ldt = args.in[5]; const float* bre = args.in[6]; const float* bim = args.in[7]; const float* cre = args.in[8]; const float* cim = args.in[9];
    const double dt = exp((double)ldt[g]);
    if (part == 0) {   const int p = lane; const double ar = are[g * 64 + p], ai = aim[g * 64 + p];
        const double er = exp(ar * dt), lr = er * cos(ai * dt), li = er * sin(ai * dt);
        ((f32x2*)(F.ws + WS_TAB + TAB_LAM))[g * 64 + p] = (f32x2){(float)lr, (float)li};
        const double e2 = exp(ar * dt * 256.0), l2r = e2 * cos(ai * dt * 256.0), l2i = e2 * sin(ai * dt * 256.0);
        ((f32x2*)(F.ws + WS_TAB + TAB_LAM256))[g * 64 + p] = (f32x2){(float)l2r, (float)l2i}; }
    if (part >= 1 && part <= 4) { const int nt = part - 1; const int col = 32 * nt + (lane & 31), p = col >> 1, ri = col & 1;
        const double ar = are[g * 64 + p], ai = aim[g * 64 + p];
        const double er = exp(ar * dt), lr = er * cos(ai * dt) - 1.0, li = er * sin(ai * dt);
        const double den = ar * ar + ai * ai, kr = (lr * ar + li * ai) / den, ki = (li * ar - lr * ai) / den;
        float v[8];
#pragma unroll
        for (int j = 0; j < 8; ++j) { const int c = 8 * (lane >> 5) + j; const double br = bre[(g * 64 + p) * 16 + c], bi = bim[(g * 64 + p) * 16 + c];
            v[j] = (float)(ri ? (kr * bi + ki * br) : (kr * br - ki * bi)); }
        v4u o; o.x = pk2(v[0], v[1]); o.y = pk2(v[2], v[3]); o.z = pk2(v[4], v[5]); o.w = pk2(v[6], v[7]);
        ((v4u*)(F.ws + WS_TAB + TAB_BF))[(g * 4 + nt) * 64 + lane] = o; }
    if (part == 5)
#pragma unroll
    for (int ks = 0; ks < 4; ++ks) { const int ch = lane & 15; float v[8];
#pragma unroll
        for (int j = 0; j < 8; ++j) { const int k = 32 * ks + 8 * (lane >> 4) + j, p = k >> 1, ri = k & 1; v[j] = ri ? -cim[(g * 16 + ch) * 64 + p] : cre[(g * 16 + ch) * 64 + p]; }
        v4u o; o.x = pk2(v[0], v[1]); o.y = pk2(v[2], v[3]); o.z = pk2(v[4], v[5]); o.w = pk2(v[6], v[7]);
        ((v4u*)(F.ws + WS_TAB + TAB_CF))[(g * 4 + ks) * 64 + lane] = o; }
}
constexpr int TR_I1 = 16 * 56, TR_I2 = 16 * 64, TR_I3 = 16, TR_IGLU = 8 * 16, TR_IUP = 8 * 32, TR_IOUT = 16 * 32, TR_IFF = 16 * 88, TR_IDN = 44 * 32, TR_ICM = 16 * 8;
constexpr int TR_NITEMS0 = TR_I1 + TR_I2 + TR_I3 + 4 * TR_ICM + TR_IGLU;
constexpr int TR_NITEMS = TR_NITEMS0 + 2 * TR_IUP + TR_IOUT + 2 * TR_IFF + TR_IDN;
__device__ __forceinline__ TrDesc tr_desc(const Args& args, unsigned char* ws, int it) {
    bf16* WIN = (bf16*)(ws + WS_WIN); bf16* WGU = (bf16*)(ws + WS_WGU); bf16* WD = (bf16*)(ws + WS_WD); bf16* WOUT = (bf16*)(ws + WS_WOUT);
    bf16* WA = (bf16*)(ws + WS_WA); bf16* WB = (bf16*)(ws + WS_WB); bf16* WGLU = (bf16*)(ws + WS_WGLU); bf16* WC1 = (bf16*)(ws + WS_WC1);
    int r = it;
    if (r < TR_I1) return TrDesc{args.in[2], WIN, INC, 1792, 1024, 32 * (r % 56), r / 56, r % 56, nullptr}; r -= TR_I1;
    if (r < TR_I2) return TrDesc{args.in[2] + 1816, WIN, INC, 2048, 1024, 1792 + 32 * (r % 64), r / 64, r % 64, nullptr}; r -= TR_I2;
    if (r < TR_I3) return TrDesc{args.in[2] + 1792, WIN, INC, 24, 1024, 3840, r, 0, nullptr}; r -= TR_I3;
    if (r < 4 * TR_ICM) { const int q = r / TR_ICM, rr = r % TR_ICM;
        return TrDesc{((q >> 1) ? args.in[17] : args.in[15]) + (size_t)(q & 1) * 1024 * 256, WC1, 256, 256, 1024, q * 256 + 32 * (rr % 8), rr / 8, rr % 8, nullptr}; } r -= 4 * TR_ICM;
    if (r < TR_IGLU) return TrDesc{args.in[11], WGLU, 512, 512, 512, 32 * (r % 16), r / 16, r % 16, nullptr}; r -= TR_IGLU;
    if (r < TR_IUP) return TrDesc{args.in[12], WA, 1024, 1024, 512, 32 * (r % 32), r / 32, r % 32, nullptr}; r -= TR_IUP;
    if (r < TR_IUP) return TrDesc{args.in[20], WB, 1024, 1024, 512, 32 * (r % 32), r / 32, r % 32, nullptr}; r -= TR_IUP;
    if (r < TR_IOUT) return TrDesc{args.in[21], WOUT, 1024, 1024, 1024, 32 * (r % 32), r / 32, r % 32, nullptr}; r -= TR_IOUT;
    if (r < TR_IFF) { const int nb = r % 88; return TrDesc{args.in[23], WGU, DFF, DFF, 1024, (nb >> 2) * 256 + (nb & 3) * 32, r / 88, nb, args.in[22]}; } r -= TR_IFF;
    if (r < TR_IFF) { const int nb = r % 88; return TrDesc{args.in[24], WGU, DFF, DFF, 1024, (nb >> 2) * 256 + (nb & 3) * 32 + 128, r / 88, nb, args.in[22]}; } r -= TR_IFF;
    return TrDesc{args.in[25], WD, 1024, 1024, DFF, 32 * (r % 32), r / 32, r % 32, nullptr};
}
__device__ __forceinline__ void p0_prologue(const Frame& F, const Args& args, bool defer) {
    LAS float* scr = (LAS float*)(F.lds + F.wave * 16384);
    const int gw = F.gw, NGW = F.ngw, lane = F.lane;
    if (F.wave == 0 && blockIdx.x < 192) s5_tables(F, args, (int)blockIdx.x & 31, (int)blockIdx.x >> 5);
    else if (F.wave == 1 || F.wave == 2) {
        for (int it = (int)blockIdx.x * 2 + (F.wave - 1); it < 512; it += F.G * 2) { const int kv = it >> 8, part = (it >> 2) & 63, cgp = it & 3;
            const float* pos = kv ? args.in[14] : args.in[13]; const float* w1 = kv ? args.in[17] : args.in[15]; float a = 0.f; const int r0 = 32 * part; float wv[32];
#pragma unroll
            for (int i = 0; i < 32; ++i) wv[i] = w1[(size_t)(r0 + i) * 256 + cgp * 64 + lane];
#pragma unroll
            for (int i = 0; i < 32; ++i) a += pos[r0 + i] * wv[i];
            ((float*)(F.ws + WS_TAB + TAB_POSB))[(kv * 64 + part) * 256 + cgp * 64 + lane] = a; }
    }
    { v4u* z = (v4u*)(F.ws + WS_WIN + (size_t)3872 * 1024 * 2); const int n16 = 224 * 1024 * 2 / 16;
      for (int i = blockIdx.x * 512 + F.tid; i < n16; i += F.G * 512) z[i] = (v4u){0u, 0u, 0u, 0u}; }
    const int n_p0 = defer ? TR_NITEMS0 : TR_NITEMS;
    if (gw < n_p0) {
        TrDesc dc = tr_desc(args, F.ws, gw); float vc[32]; tr_load(dc, vc, lane);
#pragma unroll 1
        for (int it = gw; it < n_p0; it += NGW) {
            const bool more = it + NGW < n_p0; TrDesc dn = tr_desc(args, F.ws, more ? it + NGW : it); float vn[32]; tr_load(dn, vn, lane);
            tr_finish(dc, vc, scr, lane);
            dc = dn;
#pragma unroll
            for (int i = 0; i < 32; ++i) vc[i] = vn[i];
        }
    }
    bf16* XN = (bf16*)(F.ws + WS_XN);
    for (int m = gw; m < S; m += 2 * NGW) rms_rows2_to_bf16(args.in[0] + (size_t)m * DM, args.in[0] + (size_t)(m + NGW) * DM, args.in[1], XN + (size_t)m * DM, XN + (size_t)(m + NGW) * DM, lane);
}

__device__ __forceinline__ int crow(int r, int hi) { return (r & 3) + 8 * (r >> 2) + 4 * hi; }
template <bool FINAL>
__device__ __forceinline__ void s5_unit(const Frame& F, const Args& args, int c, int g, LAS unsigned char* wl, LAS unsigned char* wx) {
    const int lane = F.lane, hi = lane >> 5;
    const bf16* U = (const bf16*)(F.ws + WS_U); bf16* Z = (bf16*)(F.ws + WS_Z);
    bf16x8 bfg[4], cfg[4], ua[8];
#pragma unroll
    for (int sub = 0; sub < 8; ++sub) ua[sub] = *(const bf16x8*)(U + (size_t)(c * 256 + sub * 32 + (lane & 31)) * 512 + g * 16 + 8 * hi);
#pragma unroll
    for (int nt = 0; nt < 4; ++nt) bfg[nt] = ((const bf16x8*)(F.ws + WS_TAB + TAB_BF))[(g * 4 + nt) * 64 + lane];
    const f32x2 lam = ((const f32x2*)(F.ws + WS_TAB + TAB_LAM))[g * 64 + lane];
    f32x2* Fst = (f32x2*)(F.ws + WS_F);
    float xr = 0.f, xi = 0.f, dsk = 0.f;
    if (FINAL) {
#pragma unroll
        for (int ks = 0; ks < 4; ++ks) cfg[ks] = ((const bf16x8*)(F.ws + WS_TAB + TAB_CF))[(g * 4 + ks) * 64 + lane];
        dsk = args.in[10][g * 16 + (lane & 15)];
        const f32x2 L2 = ((const f32x2*)(F.ws + WS_TAB + TAB_LAM256))[g * 64 + lane];
#pragma unroll 1
        for (int cp0 = 0; cp0 < c; cp0 += 16) { f32x2 fb[16];
#pragma unroll
            for (int i = 0; i < 16; ++i) fb[i] = Fst[(min(cp0 + i, c - 1) * 32 + g) * 64 + lane];
#pragma unroll
            for (int i = 0; i < 16; ++i) if (cp0 + i < c) { const float nr = L2.x * xr - L2.y * xi + fb[i].x, ni = L2.x * xi + L2.y * xr + fb[i].y; xr = nr; xi = ni; } }
    }
#pragma unroll
    for (int sub = 0; sub < 8; ++sub) {
        const int t0 = c * 256 + sub * 32;
        const bf16x8 a = ua[sub];
        if (FINAL) *(LAS bf16x8*)(wx + (lane & 31) * 32 + hi * 16) = a;
#pragma unroll
        for (int nt = 0; nt < 4; ++nt) { f32x16 acc = {}; acc = __builtin_amdgcn_mfma_f32_32x32x16_bf16(a, bfg[nt], acc, 0, 0, 0);
#pragma unroll
            for (int r = 0; r < 16; ++r) ((LAS float*)wl)[crow(r, hi) * 128 + 32 * nt + (lane & 31)] = acc[r]; }
        LDS_WAIT();
        f32x2 bu[32];
#pragma unroll
        for (int tk = 0; tk < 32; ++tk) bu[tk] = ((const LAS f32x2*)wl)[tk * 64 + lane];
        LDS_WAIT();
#pragma unroll
        for (int tk = 0; tk < 32; ++tk) { const float nr = lam.x * xr - lam.y * xi + bu[tk].x, ni = lam.x * xi + lam.y * xr + bu[tk].y; xr = nr; xi = ni;
            if (FINAL) ((LAS unsigned*)wl)[tk * 128 + ((lane + 4 * tk) & 63)] = pk2(xr, xi); }
        if (FINAL) {
            LDS_WAIT();
            LAS unsigned short* zt = (LAS unsigned short*)(wx + 1024);
#pragma unroll
            for (int mt = 0; mt < 2; ++mt) { f32x4 y4 = {0.f, 0.f, 0.f, 0.f}; const int row = 16 * mt + (lane & 15);
#pragma unroll
                for (int ks = 0; ks < 4; ++ks) { const bf16x8 xa = *(const LAS bf16x8*)(wl + row * 512 + ((64 * ks + 16 * (lane >> 4) + 16 * row) & 255)); y4 = __builtin_amdgcn_mfma_f32_16x16x32_bf16(xa, cfg[ks], y4, 0, 0, 0); }
#pragma unroll
                for (int r = 0; r < 4; ++r) { const int tok = 16 * mt + 4 * (lane >> 4) + r; const float uu = bf2f(((const LAS unsigned short*)wx)[tok * 16 + (lane & 15)]);
                    zt[tok * 16 + (lane & 15)] = (unsigned short)f2bf(gelu_tanh(y4[r] + dsk * uu)); } }
            LDS_WAIT();
            *(v4u*)(Z + (size_t)(t0 + (lane >> 1)) * 512 + g * 16 + 8 * (lane & 1)) = *(const LAS v4u*)(wx + 1024 + lane * 16);
            LDS_WAIT();
        }
    }
    if (!FINAL) Fst[(c * 32 + g) * 64 + lane] = (f32x2){xr, xi};
}

__device__ __forceinline__ int krow(int s, int h, int j) { return 16 * s + 8 * (j >> 2) + 4 * h + (j & 3); }
__device__ __forceinline__ void cmp_l2_unit(const Frame& F, const Args& args, int kv, int g, int n, LAS float* hb, const LAS float* w2s) {
    const int lane = F.lane; const float* P1 = F.out;
    float o = 0.f;
    if (n < NCMP) {
        const int rt = kv * 2048 + g * 1024 + n;
        const float* posb = (const float*)(F.ws + WS_TAB + TAB_POSBS) + kv * 256;
#pragma unroll
        for (int i = 0; i < 4; ++i) { const int j = lane + 64 * i; float a = 0.f;
#pragma unroll
            for (int ks = 0; ks < CMP_KS; ++ks) a += P1[((size_t)ks * 4096 + rt) * 512 + j] + P1[((size_t)ks * 4096 + rt + 1) * 512 + 256 + j];
            a += posb[j];
            hb[j] = gelu_tanh(a); }
        LDS_WAIT();
#pragma unroll 8
        for (int j = 0; j < 256; ++j) o += hb[j] * w2s[j * 64 + lane];
    }
    if (kv == 0) ((bf16*)(F.ws + WS_KCB))[((size_t)g * 1024 + n) * 64 + lane] = (bf16)f2bf(o);
    else { const int grp = n >> 5, kk = n & 31, sx = kk >> 4, rem = kk & 15, hh = (rem >> 2) & 1, j = ((rem >> 3) << 2) | (rem & 3), d0 = lane >> 5, ln = hh * 32 + (lane & 31);
        ((bf16*)(F.ws + WS_VTC))[((((size_t)(g * 32 + grp) * 2 + d0) * 2 + sx) * 64 + ln) * 8 + j] = (bf16)f2bf(o); }
    LDS_WAIT();
}
__device__ __forceinline__ void vtw_item(const Frame& F, int g, int grp, LAS unsigned short* tl) {
    const int lane = F.lane, hi = lane >> 5; const bf16* V = (const bf16*)(F.ws + WS_KVH) + (size_t)(10 + g) * S * 64 + (size_t)32 * grp * 64;
#pragma unroll
    for (int e = 0; e < 4; ++e) ((LAS v4u*)tl)[lane + 64 * e] = ((const v4u*)V)[lane + 64 * e];
    LDS_WAIT();
#pragma unroll
    for (int d0 = 0; d0 < 2; ++d0)
#pragma unroll
        for (int sx = 0; sx < 2; ++sx) { unsigned w[4];
#pragma unroll
            for (int jj = 0; jj < 4; ++jj) { const unsigned a = tl[krow(sx, hi, 2 * jj) * 64 + 32 * d0 + (lane & 31)], b = tl[krow(sx, hi, 2 * jj + 1) * 64 + 32 * d0 + (lane & 31)]; w[jj] = a | (b << 16); }
            ((v4u*)(F.ws + WS_VTW))[(((size_t)(g * 512 + grp) * 2 + d0) * 2 + sx) * 64 + lane] = (v4u){w[0], w[1], w[2], w[3]}; }
    LDS_WAIT();
}
__device__ __forceinline__ void kts_item(const Frame& F, int g, int blk) {
    const int lane = F.lane; const bf16* K = (const bf16*)(F.ws + WS_KVH) + (size_t)(4 + g) * S * 64 + (size_t)(64 * blk + (lane & 15)) * 64 + 8 * (lane >> 4);
    v4u t[8];
#pragma unroll
    for (int e = 0; e < 8; ++e) t[e] = *(const v4u*)(K + (size_t)(e >> 1) * 16 * 64 + 32 * (e & 1));
#pragma unroll
    for (int e = 0; e < 8; ++e) ((v4u*)(F.ws + WS_KTS))[((size_t)(g * 256 + blk) * 8 + e) * 64 + lane] = t[e];
}
__device__ __forceinline__ int kap(int ks, int q, int j) { return 16 * (2 * ks + (j >> 2)) + 4 * q + (j & 3); }
__device__ __forceinline__ void vts_item(const Frame& F, int g, int blk, LAS unsigned short* tl) {
    const int lane = F.lane, q = lane >> 4; const bf16* V = (const bf16*)(F.ws + WS_KVH) + (size_t)(6 + g) * S * 64 + (size_t)64 * blk * 64;
#pragma unroll
    for (int e = 0; e < 8; ++e) ((LAS v4u*)tl)[lane + 64 * e] = ((const v4u*)V)[lane + 64 * e];
    LDS_WAIT();
#pragma unroll
    for (int dt = 0; dt < 4; ++dt)
#pragma unroll
        for (int ks = 0; ks < 2; ++ks) { unsigned w[4];
#pragma unroll
            for (int jj = 0; jj < 4; ++jj) { const unsigned a = tl[kap(ks, q, 2 * jj) * 64 + 16 * dt + (lane & 15)], b = tl[kap(ks, q, 2 * jj + 1) * 64 + 16 * dt + (lane & 15)]; w[jj] = a | (b << 16); }
            ((v4u*)(F.ws + WS_VTS))[(((size_t)(g * 256 + blk) * 4 + dt) * 2 + ks) * 64 + lane] = (v4u){w[0], w[1], w[2], w[3]}; }
    LDS_WAIT();
}

constexpr int AT_SC = 0;
constexpr int AT_SEL = 67584;
constexpr int AT_CNT = AT_SEL + 4096;
constexpr int AT_LIST = AT_CNT + 1024;
constexpr int AT_BT = AT_LIST + 32768;
constexpr int AT_PARK = AT_BT + 4096;
constexpr int AT_TILE = AT_PARK + 32768;
constexpr int AT_END = AT_TILE + 16384;
static_assert(AT_END <= LDS_BYTES - 64, "attention LDS map");
constexpr int PSLOTS = 832, PSLAB = 458752;
constexpr int PML_OFF = PSLOTS * 512;
constexpr int SCS = 264;
constexpr int XRN = 624;

__device__ __forceinline__ bf16x8 pack8(float a0, float a1, float a2, float a3, float a4, float a5, float a6, float a7) {
    v4u w; w.x = cvt_pk_bf16(a0, a1); w.y = cvt_pk_bf16(a2, a3); w.z = cvt_pk_bf16(a4, a5); w.w = cvt_pk_bf16(a6, a7); return __builtin_bit_cast(bf16x8, w);
}
__device__ __forceinline__ float xmax32(float v) { auto r = __builtin_amdgcn_permlane32_swap(__float_as_uint(v), __float_as_uint(v), false, false); return fmaxf(__uint_as_float(r[0]), __uint_as_float(r[1])); }
__device__ __forceinline__ float xsum32(float v) { auto r = __builtin_amdgcn_permlane32_swap(__float_as_uint(v), __float_as_uint(v), false, false); return __uint_as_float(r[0]) + __uint_as_float(r[1]); }
__device__ __forceinline__ float xmax16(float v) { auto r = __builtin_amdgcn_permlane16_swap(__float_as_uint(v), __float_as_uint(v), false, false); return fmaxf(__uint_as_float(r[0]), __uint_as_float(r[1])); }
__device__ __forceinline__ float xsum16(float v) { auto r = __builtin_amdgcn_permlane16_swap(__float_as_uint(v), __float_as_uint(v), false, false); return __uint_as_float(r[0]) + __uint_as_float(r[1]); }
__device__ __forceinline__ float max16(const f32x16& a) {
    const float m0 = fmaxf(fmaxf(a[0], a[1]), fmaxf(a[2], a[3])), m1 = fmaxf(fmaxf(a[4], a[5]), fmaxf(a[6], a[7])), m2 = fmaxf(fmaxf(a[8], a[9]), fmaxf(a[10], a[11])), m3 = fmaxf(fmaxf(a[12], a[13]), fmaxf(a[14], a[15]));
    return fmaxf(fmaxf(m0, m1), fmaxf(m2, m3)); }
__device__ __forceinline__ float sum16(const f32x16& a) {
    const float s0 = (a[0] + a[1]) + (a[2] + a[3]), s1 = (a[4] + a[5]) + (a[6] + a[7]), s2 = (a[8] + a[9]) + (a[10] + a[11]), s3 = (a[12] + a[13]) + (a[14] + a[15]);
    return (s0 + s1) + (s2 + s3); }
__device__ __forceinline__ int fenc(float f) { int k = __float_as_int(f); return k ^ ((k >> 31) & 0x7fffffff); }
__device__ __forceinline__ float fdec(int k) { return __int_as_float(k ^ ((k >> 31) & 0x7fffffff)); }
#define MFMA32(a, b, c) __builtin_amdgcn_mfma_f32_32x32x16_bf16((a), (b), (c), 0, 0, 0)
#define MFMA16(a, b, c) __builtin_amdgcn_mfma_f32_16x16x32_bf16((a), (b), (c), 0, 0, 0)
#define DPPI(x, ctrl) __builtin_amdgcn_update_dpp(0, (x), (ctrl), 0xF, 0xF, false)

typedef int v4i __attribute__((ext_vector_type(4)));
struct AttnPtrs { const bf16* Q; const bf16* KCB; const bf16x8* VTC; const bf16* KW; const bf16x8* VTW; const bf16* KS; const bf16x8* VTS; const bf16* GN; bf16* O; const bf16x8* KTS; };

__device__ __forceinline__ void attn_stageA(const AttnPtrs& P, int lane, int wave, int tile0, int g, LAS unsigned char* lds) {
    const int hi = lane >> 5, c32 = lane & 31, ti = c32 >> 2, hr = c32 & 3, h = g * 4 + hr, t0 = tile0 + 8 * wave, t = t0 + ti;
    LAS float* scores = (LAS float*)(lds + AT_SC) + (8 * wave) * SCS; const LAS float* BT = (const LAS float*)(lds + AT_BT); LAS int* sel = (LAS int*)(lds + AT_SEL) + (8 * wave) * 16;
    for (int k = lane; k < 8 * SCS / 4; k += 64) ((LAS f32x4*)scores)[k] = (f32x4){0.f, 0.f, 0.f, 0.f};
    bf16x8 bq[4];
#pragma unroll
    for (int ks = 0; ks < 4; ++ks) bq[ks] = *(const bf16x8*)(P.Q + (size_t)t * 512 + h * 64 + 16 * ks + 8 * hi);
    const float cb = BT[hr * 256 + 64];
    const float g0 = bf2f(P.GN[(size_t)t * 32 + h * 3 + 0]), g2 = bf2f(P.GN[(size_t)t * 32 + h * 3 + 2]);
    {   LAS float* XR = (LAS float*)(lds + AT_LIST);
        for (int i = wave * 64 + lane; i < 4 * XRN; i += NWAVES * 64) { const int hh = i / XRN, d = 575 - (i - hh * XRN); XR[i] = (d < 0 || d >= 512) ? -1e30f : BT[hh * 256 + 191 - min(d, 127)]; } }
    LDS_WAIT();
    const int tid = wave * 64 + lane; LAS unsigned char* tb = lds + AT_TILE;
    const int ldrow = tid >> 3, ldch = tid & 7; const unsigned stoff = (tid < 256) ? (unsigned)(ldrow * 128 + ((ldch ^ (ldrow & 7)) << 4)) : (unsigned)(8192 + (tid - 256) * 16);
    const unsigned kof = (unsigned)(c32 * 128), ksw = (unsigned)(c32 & 7);
#define KFRAG(buf, ks) (*(const LAS bf16x8*)(tb + (buf) * 4096 + kof + ((((ks) * 2 + hi) ^ ksw) << 4)))
#define VFRAG(buf, f) (*(const LAS bf16x8*)(tb + 8192 + (buf) * 4096 + ((f) * 64 + lane) * 16))
#define STAGE_LOAD(Kp, kmax, VTp, gmax, n0v) ((tid < 256) ? *(const v4u*)((Kp) + (size_t)min((n0v) + ldrow, (kmax)) * 64 + ldch * 8) : *(const v4u*)((VTp) + (size_t)min((n0v) >> 5, (gmax)) * 256 + (tid - 256)))
#define STAGE_WRITE(v, buf) (*(LAS v4u*)(tb + (buf) * 4096 + stoff) = (v))
#define FRAG_WAIT(fr) asm volatile("s_waitcnt lgkmcnt(0)" : "+v"(fr[0]), "+v"(fr[1]), "+v"(fr[2]), "+v"(fr[3]) :: "memory")
#define KLOAD(kfr, buf) bf16x8 kfr[4]; { _Pragma("unroll") for (int ks = 0; ks < 4; ++ks) kfr[ks] = KFRAG(buf, ks); FRAG_WAIT(kfr); }
#define VLOAD(vfr, buf) bf16x8 vfr[4]; { _Pragma("unroll") for (int f = 0; f < 4; ++f) vfr[f] = VFRAG(buf, f); }
#define PVACC(o0v, o1v, vfr, a) do { const bf16x8 p0_ = pack8(a[0], a[1], a[2], a[3], a[4], a[5], a[6], a[7]), p1_ = pack8(a[8], a[9], a[10], a[11], a[12], a[13], a[14], a[15]); FRAG_WAIT(vfr); \
        o0v = MFMA32(vfr[0], p0_, o0v); o0v = MFMA32(vfr[1], p1_, o0v); o1v = MFMA32(vfr[2], p0_, o1v); o1v = MFMA32(vfr[3], p1_, o1v); } while (0)
    constexpr float SM_THR = 8.0f;
#define REF_EVENT(a, mref, started, d, fs) { const float tm_ = xmax32(max16(a)); const bool need_ = started ? (tm_ > SM_THR) : (tm_ > -1e29f); d = 0.f; fs = 1.f; \
        if (__any(need_)) { d = need_ ? tm_ : 0.f; fs = (need_ && started) ? __builtin_amdgcn_exp2f(-d) : 1.f; mref += d; started = started || need_; _Pragma("unroll") for (int r = 0; r < 16; ++r) a[r] -= d; } }
    const int ncb = (tile0 + 63 >= 31) ? min((tile0 + 63 - 31) / 16 + 1, NCMP) : 0, ntc = (ncb + 31) >> 5;
    const int nfar = (t0 >= 144) ? (t0 - 144) / 16 + 1 : 0;
#define CSCORE(a, buf, n0v, farv, refv) do { KLOAD(kfr_, buf) { const float ini_ = ((farv) ? cb : 0.f) - (refv); _Pragma("unroll") for (int r = 0; r < 16; ++r) a[r] = ini_; } \
        _Pragma("unroll") for (int ks = 0; ks < 4; ++ks) a = MFMA32(kfr_[ks], bq[ks], a); \
        if (!(farv)) { _Pragma("unroll") for (int r = 0; r < 16; ++r) { const int dist = t - (16 * ((n0v) + crow(r, hi)) + 31); a[r] += BT[hr * 256 + 191 - max(min(dist, 127), -1)]; } } } while (0)
#define STAGE_PROLOGUE(Kp, kmax, VTp, gmax, nbase, ntl) v4u RA, RB; { RA = STAGE_LOAD(Kp, kmax, VTp, gmax, nbase); STAGE_WRITE(RA, 0); RB = STAGE_LOAD(Kp, kmax, VTp, gmax, (nbase) + 32 * min(1, (ntl) - 1)); __syncthreads(); }
    float mc = 0.f, lc = 0.f; bool stc = false;
    if (ntc > 0) {
        STAGE_PROLOGUE(P.KCB, 1023, P.VTC, 31, 0, ntc)
#define C1STEP(iv, BUF, RL, RW) { const int i = (iv); if (i >= ntc) break; const int n0 = 32 * i; RL = STAGE_LOAD(P.KCB, 1023, P.VTC, 31, 32 * min(i + 2, ntc - 1)); \
            const bool far = (n0 + 32 <= nfar); f32x16 a; CSCORE(a, BUF, n0, far, mc); \
            float d_, fs_; REF_EVENT(a, mc, stc, d_, fs_) lc *= fs_; \
            _Pragma("unroll") for (int r = 0; r < 16; ++r) a[r] = __builtin_amdgcn_exp2f(a[r]); \
            lc += xsum32(sum16(a)); STAGE_WRITE(RW, (BUF) ^ 1); __syncthreads(); }
        for (int ib = 0; ; ib += 2) { C1STEP(ib, 0, RA, RB) C1STEP(ib + 1, 1, RB, RA) }
#undef C1STEP
    }
    {   const float invl = 1.0f / fmaxf(lc, 1e-30f); f32x16 oc0 = {}, oc1 = {}; float carry = 0.f;
#define CIMP(a, n0v) do { float mq[4], cq[4]; \
            _Pragma("unroll") for (int qg = 0; qg < 4; ++qg) { float mv = (2.0f * (a[4 * qg] + a[4 * qg + 1] + a[4 * qg + 2]) + a[4 * qg + 3]) * invl, cv = a[4 * qg + 3] * invl; \
                mv += __int_as_float(DPPI(__float_as_int(mv), 0xB1)); mv += __int_as_float(DPPI(__float_as_int(mv), 0x4E)); \
                cv += __int_as_float(DPPI(__float_as_int(cv), 0xB1)); cv += __int_as_float(DPPI(__float_as_int(cv), 0x4E)); mq[qg] = mv; cq[qg] = cv; } \
            float oth[4]; \
            _Pragma("unroll") for (int qg = 0; qg < 4; ++qg) { auto rr = __builtin_amdgcn_permlane32_swap(__float_as_uint(cq[qg]), __float_as_uint(cq[qg]), false, false); oth[qg] = __uint_as_float(hi ? rr[0] : rr[1]); } \
            _Pragma("unroll") for (int qg = 0; qg < 4; ++qg) { const float tot = mq[qg] + (hi ? oth[qg] : (qg ? oth[qg - 1] : carry)); if (hr == 0) scores[ti * SCS + (((n0v) + 8 * qg + 4 * hi) >> 2)] = tot; } \
            carry = oth[3]; } while (0)
        if (ntc > 0) {
            STAGE_PROLOGUE(P.KCB, 1023, P.VTC, 31, 0, ntc)
#define C2STEP(iv, BUF, RL, RW) { const int i = (iv); if (i >= ntc) break; const int n0 = 32 * i; RL = STAGE_LOAD(P.KCB, 1023, P.VTC, 31, 32 * min(i + 2, ntc - 1)); \
                const bool far = (n0 + 32 <= nfar); f32x16 a; CSCORE(a, BUF, n0, far, mc); VLOAD(vfr_, BUF) \
                _Pragma("unroll") for (int r = 0; r < 16; ++r) a[r] = __builtin_amdgcn_exp2f(a[r]); \
                CIMP(a, n0); PVACC(oc0, oc1, vfr_, a); STAGE_WRITE(RW, (BUF) ^ 1); __syncthreads(); }
            for (int ib = 0; ; ib += 2) { C2STEP(ib, 0, RA, RB) C2STEP(ib + 1, 1, RB, RA) }
#undef C2STEP
            { const int jn = ntc * 8; if (jn < 256 && hi == 0 && hr == 0) scores[ti * SCS + jn] = carry; }
        }
#undef CIMP
        {   LAS unsigned char* park = lds + AT_PARK + (((8 * wave + ti) * 4 + hr) * 64) * 2;
            const float gs = g0 * invl;
#pragma unroll
            for (int d0 = 0; d0 < 2; ++d0)
#pragma unroll
                for (int r4 = 0; r4 < 4; ++r4) { const f32x16& Wd = d0 ? oc1 : oc0; const int dim = 32 * d0 + 8 * r4 + 4 * hi;
                    *(LAS unsigned long long*)(park + dim * 2) = (unsigned long long)cvt_pk_bf16(Wd[4 * r4] * gs, Wd[4 * r4 + 1] * gs) | ((unsigned long long)cvt_pk_bf16(Wd[4 * r4 + 2] * gs, Wd[4 * r4 + 3] * gs) << 32); } } }
#undef CSCORE
    {   float mw = 0.f, lw = 0.f; bool stw = false; f32x16 o0 = {}, o1 = {};
        const int nlo = max(t0 - 511, 0) & ~31, nhi = (t0 + 7) & ~31;
        const int nlb = max(tile0 - 511, 0) & ~31, ntw = (((tile0 + 63) & ~31) - nlb) / 32 + 1;
        const LAS float* xrb = (const LAS float*)(lds + AT_LIST) + hr * XRN + (575 - ti + 4 * hi);
        STAGE_PROLOGUE(P.KW, S - 1, P.VTW, 511, nlb, ntw)
#define WSTEP(iv, BUF, RL, RW) { const int i = (iv); if (i >= ntw) break; const int n0 = nlb + 32 * i; RL = STAGE_LOAD(P.KW, S - 1, P.VTW, 511, nlb + 32 * min(i + 2, ntw - 1)); \
            if (n0 >= nlo && n0 <= nhi) { const bool mid = (n0 >= t0 - 504) && (n0 <= t0 - 144); \
                f32x16 a; if (mid) { const float ini_ = cb - mw; _Pragma("unroll") for (int r = 0; r < 16; ++r) a[r] = ini_; } \
                else { const LAS float* xr_ = xrb + (n0 - t0); _Pragma("unroll") for (int r = 0; r < 16; ++r) a[r] = xr_[(r & 3) + 8 * (r >> 2)] - mw; } \
                { KLOAD(kfr_, BUF) _Pragma("unroll") for (int ks = 0; ks < 4; ++ks) a = MFMA32(kfr_[ks], bq[ks], a); } VLOAD(vfr_, BUF) \
                float d_, fs_; REF_EVENT(a, mw, stw, d_, fs_) if (fs_ != 1.f || d_ != 0.f) { lw *= fs_; o0 = o0 * fs_; o1 = o1 * fs_; } \
                _Pragma("unroll") for (int r = 0; r < 16; ++r) a[r] = __builtin_amdgcn_exp2f(a[r]); \
                lw += xsum32(sum16(a)); PVACC(o0, o1, vfr_, a); } \
            STAGE_WRITE(RW, (BUF) ^ 1); __syncthreads(); }
        for (int ib = 0; ; ib += 2) { WSTEP(ib, 0, RA, RB) WSTEP(ib + 1, 1, RB, RA) }
#undef WSTEP
        const float sc = g2 / fmaxf(lw, 1e-30f);
        LAS unsigned char* park = lds + AT_PARK + (((8 * wave + ti) * 4 + hr) * 64) * 2;
#pragma unroll
        for (int d0 = 0; d0 < 2; ++d0)
#pragma unroll
            for (int r4 = 0; r4 < 4; ++r4) { const f32x16& Od = d0 ? o1 : o0; const int dim = 32 * d0 + 8 * r4 + 4 * hi; const unsigned long long w = *(const LAS unsigned long long*)(park + dim * 2); const unsigned lo = (unsigned)w, hw = (unsigned)(w >> 32);
                *(LAS unsigned long long*)(park + dim * 2) = (unsigned long long)cvt_pk_bf16(bflo(lo) + Od[4 * r4] * sc, bfhi(lo) + Od[4 * r4 + 1] * sc) | ((unsigned long long)cvt_pk_bf16(bflo(hw) + Od[4 * r4 + 2] * sc, bfhi(hw) + Od[4 * r4 + 3] * sc) << 32); } }
#undef REF_EVENT
#undef STAGE_PROLOGUE
#undef PVACC
#undef KLOAD
#undef FRAG_WAIT
#undef VLOAD
#undef KFRAG
#undef VFRAG
#undef STAGE_LOAD
#undef STAGE_WRITE
    LDS_WAIT();
    {   const int cur = tile0 >> 6, i = lane >> 3, s8 = lane & 7;
        if (cur + 1 <= 16) { for (int e = lane; e < 8 * 16; e += 64) sel[e] = e & 15; }
        else {
            LAS int* krow = (LAS int*)scores + i * SCS + 32 * s8;
            {   v4i kk[8];
#pragma unroll
                for (int e = 0; e < 8; ++e) kk[e] = *(const LAS v4i*)(krow + 4 * e);
#pragma unroll
                for (int e = 0; e < 8; ++e)
#pragma unroll
                    for (int x = 0; x < 4; ++x) { const int j = 32 * s8 + 4 * e + x; kk[e][x] = (j >= 1 && j <= cur - 2) ? ((kk[e][x] & ~255) | (255 - j)) : -1; }
#pragma unroll
                for (int e = 0; e < 8; ++e) *(LAS v4i*)(krow + 4 * e) = kk[e]; }
            if (s8 == 0) { sel[i * 16 + 0] = 0; sel[i * 16 + 1] = cur - 1; sel[i * 16 + 2] = cur; }
#pragma unroll 1
            for (int it = 3; it < 16; ++it) {
                v4i kk[8];
#pragma unroll
                for (int e = 0; e < 8; ++e) kk[e] = *(const LAS v4i*)(krow + 4 * e);
                int m = kk[0][0];
#pragma unroll
                for (int e = 0; e < 8; ++e)
#pragma unroll
                    for (int x = 0; x < 4; ++x) m = max(m, kk[e][x]);
                m = max(m, DPPI(m, 0xB1)); m = max(m, DPPI(m, 0x4E)); m = max(m, DPPI(m, 0x141));
                const int bj = 255 - (m & 255);
                if (s8 == 0) sel[i * 16 + it] = bj;
                if ((bj >> 5) == s8) ((LAS int*)scores)[i * SCS + bj] = -1;
            }
        }
    }
}

__device__ __forceinline__ void s_scores(const bf16x8 (&kf)[8], const bf16x8 q0, const bf16x8 q1, bool cst, float cbs, const LAS float* BT, int hd, int tt, int j, int q, float sub, f32x4 (&sa)[4]) {
    if (cst) {
#pragma unroll
        for (int mt = 0; mt < 4; ++mt) { const float ini = cbs - sub; sa[mt] = (f32x4){ini, ini, ini, ini}; } }
    else { const LAS float* xb = BT + hd * 256 + (191 - tt + 64 * j + 4 * q);
#pragma unroll
        for (int mt = 0; mt < 4; ++mt)
#pragma unroll
            for (int r = 0; r < 4; ++r) sa[mt][r] = xb[16 * mt + r] - sub; }
#pragma unroll
    for (int mt = 0; mt < 4; ++mt) { sa[mt] = MFMA16(kf[mt * 2], q0, sa[mt]); sa[mt] = MFMA16(kf[mt * 2 + 1], q1, sa[mt]); }
}
template <bool MASKED> __device__ __forceinline__ void s_softmax(f32x4 (&sa)[4], float& tm, float& ls) {
    tm = sa[0][0];
#pragma unroll
    for (int mt = 0; mt < 4; ++mt)
#pragma unroll
        for (int r = 0; r < 4; ++r) tm = fmaxf(tm, sa[mt][r]);
    tm = xmax32(xmax16(tm)); ls = 0.f;
#pragma unroll
    for (int mt = 0; mt < 4; ++mt)
#pragma unroll
        for (int r = 0; r < 4; ++r) { const float e = __builtin_amdgcn_exp2f(sa[mt][r] - tm); sa[mt][r] = (!MASKED || sa[mt][r] > -1e29f) ? e : 0.f; ls += sa[mt][r]; }
    ls = xsum32(xsum16(ls));
}
__device__ __forceinline__ void load_kf(const AttnPtrs& P, int lane, int j, bf16x8 (&kf)[8]) {
    const bf16* kp = P.KS + (size_t)(64 * j + (lane & 15)) * 64 + 8 * (lane >> 4);
#pragma unroll
    for (int mt = 0; mt < 4; ++mt) { kf[mt * 2] = *(const bf16x8*)(kp + (size_t)mt * 16 * 64); kf[mt * 2 + 1] = *(const bf16x8*)(kp + (size_t)mt * 16 * 64 + 32); }
}
__device__ __forceinline__ void load_kfs(const AttnPtrs& P, int lane, int j, bf16x8 (&kf)[8]) {
    const bf16x8* kt = P.KTS + (size_t)j * 8 * 64 + lane;
#pragma unroll
    for (int e = 0; e < 8; ++e) kf[e] = kt[e * 64];
}
__device__ __forceinline__ void load_vf(const AttnPtrs& P, int lane, int j, bf16x8 (&vf)[8]) {
    const bf16x8* vt = P.VTS + (size_t)j * 8 * 64 + lane;
#pragma unroll
    for (int e = 0; e < 8; ++e) vf[e] = vt[e * 64];
}
__device__ __forceinline__ void s_chunk(const bf16x8 (&kf)[8], const bf16x8 (&vf)[8], int j, int ch, int n, bool cst, float cbs, const LAS float* BT, const LAS unsigned short* list,
                                        const LAS unsigned char* qt, unsigned char* slab, int tile0, int c, int q, int hd, int hs) {
    const int sidx = 4 * ch + (c >> 2); const bool valid = sidx < n; const int sl = (int)list[j * 64 + (valid ? sidx : 0)]; const int tokl = sl / 13, r = tokl * 4 + hd;
    const LAS unsigned char* qr = qt + r * 128; const bf16x8 q0 = *(const LAS bf16x8*)(qr + ((q ^ (r & 7)) << 4)), q1 = *(const LAS bf16x8*)(qr + (((q + 4) ^ (r & 7)) << 4));
    float tm = ((const LAS float*)(qt + 65536))[r], ls; f32x4 sa[4]; bool second = false;
#pragma unroll 1
    for (;;) {
        s_scores(kf, q0, q1, cst, cbs, BT, hd, tile0 + tokl, j, q, tm, sa);
        if (second) { float mx = sa[0][0];
#pragma unroll
            for (int mt = 0; mt < 4; ++mt)
#pragma unroll
                for (int r4 = 0; r4 < 4; ++r4) mx = fmaxf(mx, sa[mt][r4]);
            mx = xmax32(xmax16(mx)); tm += mx;
#pragma unroll
            for (int mt = 0; mt < 4; ++mt)
#pragma unroll
                for (int r4 = 0; r4 < 4; ++r4) sa[mt][r4] -= mx; }
        ls = 0.f;
#pragma unroll
        for (int mt = 0; mt < 4; ++mt)
#pragma unroll
            for (int r4 = 0; r4 < 4; ++r4) { sa[mt][r4] = __builtin_amdgcn_exp2f(sa[mt][r4]); ls += sa[mt][r4]; }
        ls = xsum32(xsum16(ls));
        if (second || !__any(!(ls < 1e30f))) break;
        second = true; }
    const bf16x8 p0 = pack8(sa[0][0], sa[0][1], sa[0][2], sa[0][3], sa[1][0], sa[1][1], sa[1][2], sa[1][3]), p1 = pack8(sa[2][0], sa[2][1], sa[2][2], sa[2][3], sa[3][0], sa[3][1], sa[3][2], sa[3][3]);
    unsigned char* po = slab + ((size_t)(sl * 4 + hd) * 64 + 8 * q) * 2;
    unsigned pw[8];
#pragma unroll
    for (int dt = 0; dt < 4; ++dt) { f32x4 oa = {0.f, 0.f, 0.f, 0.f}; oa = MFMA16(vf[dt * 2], p0, oa); oa = MFMA16(vf[dt * 2 + 1], p1, oa); pw[2 * dt] = cvt_pk_bf16(oa[0], oa[1]); pw[2 * dt + 1] = cvt_pk_bf16(oa[2], oa[3]); }
    if (valid) { *(v4u*)po = (v4u){pw[0], pw[1], pw[2], pw[3]}; *(v4u*)(po + 64) = (v4u){pw[4], pw[5], pw[6], pw[7]}; }
    if (valid && q == 0) *(LAS f32x2*)(qt + 32768 + (sl * 4 + hd) * 8) = (f32x2){tm, ls};
}
__device__ __forceinline__ void attn_stageB(const AttnPtrs& P, int lane, int wave, int tile0, int g, LAS unsigned char* lds, unsigned char* slab) {
    const int T = tile0 >> 6, c = lane & 15, q = lane >> 4, hd = c & 3, hs = g * 4 + hd;
    if (T <= 15) return;
    LAS unsigned* cnt = (LAS unsigned*)(lds + AT_CNT); const LAS unsigned short* list = (const LAS unsigned short*)(lds + AT_LIST); const LAS float* BT = (const LAS float*)(lds + AT_BT);
    const LAS unsigned char* qt = lds + AT_SC;
    const float cbs = BT[hd * 256 + 64];
    const unsigned cnt0a = (unsigned)(__UINTPTR_TYPE__)cnt; const unsigned one0 = lane == 0 ? 1u : 0u;
#define GRAB_ISSUE(tv) { tv = 0; if (lane == 0) asm volatile("ds_add_rtn_u32 %0, %1, %2" : "=v"(tv) : "v"(cnt0a), "v"(one0) : "memory"); }
#define GRAB_TAKE(tv, jv, nv) { asm volatile("s_waitcnt lgkmcnt(0)" : "+v"(tv) :: "memory"); jv = (int)__builtin_amdgcn_readfirstlane(tv) + 1; nv = 0; if (jv <= T - 2) nv = (int)__builtin_amdgcn_readfirstlane((int)cnt[jv]); }
    bf16x8 KA[8], VA[8], KB[8], VB[8];
    int jc, nc, jn, nn;
    { int t0_, t1_; GRAB_ISSUE(t0_) GRAB_ISSUE(t1_) GRAB_TAKE(t0_, jc, nc) if (jc > T - 2) return; GRAB_TAKE(t1_, jn, nn) }
    load_kfs(P, lane, jc, KA); load_vf(P, lane, jc, VA);
    load_kfs(P, lane, min(jn, T - 2), KB); load_vf(P, lane, min(jn, T - 2), VB);
#define BSTEP(KX, VX) { int t2_; GRAB_ISSUE(t2_) \
        { const bool cst = (jc <= T - 3);        \
          if (nc > 0) s_chunk(KX, VX, jc, 0, nc, cst, cbs, BT, list, qt, slab, tile0, c, q, hd, hs); \
          if (nc > 4) s_chunk(KX, VX, jc, 1, nc, cst, cbs, BT, list, qt, slab, tile0, c, q, hd, hs); \
          if (nc > 8) { _Pragma("unroll 1") for (int ch = 2; 4 * ch < nc; ++ch) s_chunk(KX, VX, jc, ch, nc, cst, cbs, BT, list, qt, slab, tile0, c, q, hd, hs); } } \
        int j2_, n2_; GRAB_TAKE(t2_, j2_, n2_) \
        load_kfs(P, lane, min(j2_, T - 2), KX); load_vf(P, lane, min(j2_, T - 2), VX); \
        jc = jn; nc = nn; jn = j2_; nn = n2_; }
    do { BSTEP(KA, VA) BSTEP(KB, VB) } while (jc <= T - 2);
#undef BSTEP
#undef GRAB_ISSUE
#undef GRAB_TAKE
}
struct SState { float M, L; f32x4 O[4]; };
__device__ __forceinline__ void s_merge(SState& st, float m, float l, const f32x4 (&o)[4]) {
    const float mn = fmaxf(st.M, m), a0 = __builtin_amdgcn_exp2f(st.M - mn), a1 = __builtin_amdgcn_exp2f(m - mn);
    st.L = st.L * a0 + l * a1; st.M = mn;
#pragma unroll
    for (int dt = 0; dt < 4; ++dt) st.O[dt] = st.O[dt] * a0 + o[dt] * a1;
}
__device__ __forceinline__ void attn_stageC_forced(const AttnPtrs& P, int lane, int wave, int tile0, int g, LAS unsigned char* lds, SState (&st)[2]) {
    const int T = tile0 >> 6, c = lane & 15, q = lane >> 4, hd = c & 3, hs = g * 4 + hd; const LAS float* BT = (const LAS float*)(lds + AT_BT); const float cbs = BT[hd * 256 + 64];
    bf16x8 q0[2], q1[2];
#pragma unroll
    for (int k = 0; k < 2; ++k) { const int tt = tile0 + 8 * wave + 4 * k + (c >> 2); q0[k] = *(const bf16x8*)(P.Q + (size_t)tt * 512 + hs * 64 + 8 * q); q1[k] = *(const bf16x8*)(P.Q + (size_t)tt * 512 + hs * 64 + 32 + 8 * q);
        st[k].M = -1e30f; st[k].L = 0.f;
#pragma unroll
        for (int dt = 0; dt < 4; ++dt) st[k].O[dt] = (f32x4){0.f, 0.f, 0.f, 0.f}; }
    const int nf = T <= 15 ? T + 1 : 3;
    auto fblk = [&](int it) -> int { return T <= 15 ? it : (it == 0 ? 0 : (it == 1 ? T - 1 : T)); };
    bf16x8 kf[8], vf[8]; load_kf(P, lane, fblk(0), kf); load_vf(P, lane, fblk(0), vf);
#pragma unroll 1
    for (int it = 0; it < nf; ++it) { const int j = fblk(it);
        bf16x8 kn[8]; load_kf(P, lane, fblk(min(it + 1, nf - 1)), kn);
        const bool cst = (j <= T - 3);
#pragma unroll
        for (int k = 0; k < 2; ++k) { const int tt = tile0 + 8 * wave + 4 * k + (c >> 2);
            f32x4 sa[4]; s_scores(kf, q0[k], q1[k], cst, cbs, BT, hd, tt, j, q, 0.f, sa);
            float tm, ls; s_softmax<true>(sa, tm, ls);
            const bf16x8 p0 = pack8(sa[0][0], sa[0][1], sa[0][2], sa[0][3], sa[1][0], sa[1][1], sa[1][2], sa[1][3]), p1 = pack8(sa[2][0], sa[2][1], sa[2][2], sa[2][3], sa[3][0], sa[3][1], sa[3][2], sa[3][3]);
            f32x4 ob[4];
#pragma unroll
            for (int dt = 0; dt < 4; ++dt) { ob[dt] = (f32x4){0.f, 0.f, 0.f, 0.f}; ob[dt] = MFMA16(vf[dt * 2], p0, ob[dt]); ob[dt] = MFMA16(vf[dt * 2 + 1], p1, ob[dt]); }
            s_merge(st[k], tm, ls, ob); }
#pragma unroll
        for (int e = 0; e < 8; ++e) kf[e] = kn[e];
        if (it + 1 < nf) load_vf(P, lane, fblk(it + 1), vf);
    }
}
__device__ __forceinline__ void attn_stageC_forced_lds(const AttnPtrs& P, int lane, int wave, int tile0, int g, LAS unsigned char* lds, SState (&st)[2]) {
    const int T = tile0 >> 6, c = lane & 15, q = lane >> 4, hd = c & 3, hs = g * 4 + hd; const LAS float* BT = (const LAS float*)(lds + AT_BT); const float cbs = BT[hd * 256 + 64];
    bf16x8 q0[2], q1[2];
#pragma unroll
    for (int k = 0; k < 2; ++k) { const int r = (8 * wave + 4 * k + (c >> 2)) * 4 + hd; const LAS unsigned char* qr = lds + AT_SC + r * 128;
        q0[k] = *(const LAS bf16x8*)(qr + ((q ^ (r & 7)) << 4)); q1[k] = *(const LAS bf16x8*)(qr + (((q + 4) ^ (r & 7)) << 4));
        st[k].M = -1e30f; st[k].L = 0.f;
#pragma unroll
        for (int dt = 0; dt < 4; ++dt) st[k].O[dt] = (f32x4){0.f, 0.f, 0.f, 0.f}; }
#pragma unroll
    for (int it = 0; it < 3; ++it) { const int j = it == 0 ? 0 : (it == 1 ? T - 1 : T); const LAS unsigned char* fb = lds + (it == 2 ? AT_TILE : AT_SC + 32768 + 16384 * it);
        bf16x8 kf[8], vf[8];
#pragma unroll
        for (int mt = 0; mt < 4; ++mt) { const int row = 16 * mt + c; kf[mt * 2] = *(const LAS bf16x8*)(fb + row * 128 + ((q ^ (row & 7)) << 4)); kf[mt * 2 + 1] = *(const LAS bf16x8*)(fb + row * 128 + (((q + 4) ^ (row & 7)) << 4)); }
#pragma unroll
        for (int e = 0; e < 8; ++e) vf[e] = *(const LAS bf16x8*)(fb + 8192 + (e * 64 + lane) * 16);
        const bool cst = (it == 0);
#pragma unroll
        for (int k = 0; k < 2; ++k) { const int tt = tile0 + 8 * wave + 4 * k + (c >> 2);
            f32x4 sa[4]; s_scores(kf, q0[k], q1[k], cst, cbs, BT, hd, tt, j, q, 0.f, sa);
            float tm, ls; s_softmax<true>(sa, tm, ls);
            const bf16x8 p0 = pack8(sa[0][0], sa[0][1], sa[0][2], sa[0][3], sa[1][0], sa[1][1], sa[1][2], sa[1][3]), p1 = pack8(sa[2][0], sa[2][1], sa[2][2], sa[2][3], sa[3][0], sa[3][1], sa[3][2], sa[3][3]);
            f32x4 ob[4];
#pragma unroll
            for (int dt = 0; dt < 4; ++dt) { ob[dt] = (f32x4){0.f, 0.f, 0.f, 0.f}; ob[dt] = MFMA16(vf[dt * 2], p0, ob[dt]); ob[dt] = MFMA16(vf[dt * 2 + 1], p1, ob[dt]); }
            s_merge(st[k], tm, ls, ob); } }
}
__device__ __forceinline__ void attn_stageC_merge(const AttnPtrs& P, int lane, int wave, int tile0, int g, LAS unsigned char* lds, const unsigned char* slab, SState (&st)[2]) {
    const int T = tile0 >> 6;
    LAS unsigned char* sv = lds + (wave < 4 ? AT_SC + wave * 8192 : AT_LIST + (wave - 4) * 8192);
    LAS float* stl = (LAS float*)(lds + AT_SC + 66560);
    {   const int c = lane & 15, q = lane >> 4, hd = c & 3;
#pragma unroll
        for (int k = 0; k < 2; ++k) { const int tokl = 4 * k + (c >> 2); LAS unsigned char* base = sv + (tokl * 4 + hd) * 256;
#pragma unroll
            for (int dt = 0; dt < 4; ++dt) *(LAS f32x4*)(base + ((dt >> 1) * 4 + q) * 32 + (dt & 1) * 16) = st[k].O[dt];
            if (q == 0) stl[(8 * wave + tokl) * 4 + hd] = st[k].L; } }
    LDS_WAIT();
    const int ts = lane >> 5, hd = (lane >> 3) & 3, p = lane & 7, hs = g * 4 + hd;
    const LAS float* mrefp = (const LAS float*)(lds + AT_SC + 65536);
#pragma unroll 1
    for (int h2 = 0; h2 < 2; ++h2) {
        v4u ow[2][13]; float gq[2];
#pragma unroll
        for (int u = 0; u < 2; ++u) { const int tok = 8 * wave + 2 * (2 * h2 + u) + ts; gq[u] = bf2f(P.GN[(size_t)(tile0 + tok) * 32 + hs * 3 + 1]);
            if (T > 15) {
#pragma unroll
                for (int b = 0; b < 13; ++b) { const int sl = tok * 13 + b; ow[u][b] = *(const v4u*)(slab + (size_t)(sl * 4 + hd) * 128 + p * 16); } } }
#pragma unroll
        for (int u = 0; u < 2; ++u) { const int tokl = 2 * (2 * h2 + u) + ts, tok = 8 * wave + tokl, r = tok * 4 + hd;
            float M = 0.f, L = 0.f, acc[8];
#pragma unroll
            for (int i = 0; i < 8; ++i) acc[i] = 0.f;
            if (T > 15) { M = mrefp[r];
#pragma unroll
                for (int b = 0; b < 13; ++b) { const v4u w = ow[u][b]; const float o[8] = {bflo(w.x), bfhi(w.x), bflo(w.y), bfhi(w.y), bflo(w.z), bfhi(w.z), bflo(w.w), bfhi(w.w)};
                    const f32x2 mlv = *(const LAS f32x2*)(lds + AT_SC + 32768 + ((tok * 13 + b) * 4 + hd) * 8); const float m = mlv.x, l = mlv.y;
                    if (__all(m == M)) { L += l;
#pragma unroll
                        for (int i = 0; i < 8; ++i) acc[i] += o[i]; }
                    else { const float mn = fmaxf(M, m), a0 = __builtin_amdgcn_exp2f(M - mn), a1 = __builtin_amdgcn_exp2f(m - mn); L = L * a0 + l * a1; M = mn;
#pragma unroll
                        for (int i = 0; i < 8; ++i) acc[i] = acc[i] * a0 + o[i] * a1; } } }
            const f32x4 s0 = *(const LAS f32x4*)(sv + (tokl * 4 + hd) * 256 + p * 32), s1 = *(const LAS f32x4*)(sv + (tokl * 4 + hd) * 256 + p * 32 + 16);
            const float ast = (T > 15) ? __builtin_amdgcn_exp2f(mrefp[r] - M) : 1.0f, Lt = L + stl[r] * ast;
            const float g1 = gq[u] / fmaxf(Lt, 1e-30f);
            const float O[8] = {acc[0] + s0[0] * ast, acc[1] + s0[1] * ast, acc[2] + s0[2] * ast, acc[3] + s0[3] * ast, acc[4] + s1[0] * ast, acc[5] + s1[1] * ast, acc[6] + s1[2] * ast, acc[7] + s1[3] * ast};
            LAS unsigned char* park = lds + AT_PARK + ((tok * 4 + hd) * 64 + 32 * (p >> 2) + 4 * (p & 3)) * 2;
#pragma unroll
            for (int x = 0; x < 2; ++x) { const unsigned long long w = *(const LAS unsigned long long*)(park + x * 32); const unsigned lo = (unsigned)w, hw = (unsigned)(w >> 32);
                const unsigned o0 = cvt_pk_bf16(bflo(lo) + g1 * O[4 * x], bfhi(lo) + g1 * O[4 * x + 1]), o1 = cvt_pk_bf16(bflo(hw) + g1 * O[4 * x + 2], bfhi(hw) + g1 * O[4 * x + 3]);
                *(LAS unsigned long long*)(park + x * 32) = (unsigned long long)o0 | ((unsigned long long)o1 << 32); } } }
    LDS_WAIT();
#pragma unroll
    for (int e = 0; e < 4; ++e) { const int idx = lane + 64 * e, tokl = idx >> 5, piece = idx & 31;
        *(v4u*)((unsigned char*)P.O + (size_t)(tile0 + 8 * wave + tokl) * 1024 + g * 512 + piece * 16) = *(const LAS v4u*)(lds + AT_PARK + (8 * wave + tokl) * 512 + piece * 16); }
    LDS_WAIT();
}
__device__ __forceinline__ void attn_tile(const Frame& F, unsigned char* ws, const float* pbias, int tile, int g, unsigned soff) {
    int lane = F.lane; asm volatile("" : "+v"(lane));
    const int wave = F.wave, tile0 = tile * 64, T = tile; LAS unsigned char* lds = F.lds;
    if (F.tid < 256) ((LAS unsigned*)(lds + AT_CNT))[F.tid] = 0u;
    {   LAS float* BT = (LAS float*)(lds + AT_BT);
        for (int i = F.tid; i < 4 * 256; i += NWAVES * 64) { const int hh = i >> 8, d = 191 - (i & 255); float v = -1e30f;
            if (d >= 0) { const int dd = min(d, 127); int bk = dd; if (dd >= 16) { bk = 16 + (int)(logf((float)dd * (1.0f / 16.0f)) / 2.0794415416798357f * 16.0f); if (bk > 31) bk = 31; }
                v = pbias[bk * 8 + g * 4 + hh] * 1.4426950408889634f; }
            BT[i] = v; } }
    __syncthreads();
    AttnPtrs P;
    {   const bf16* KVH = (const bf16*)(ws + WS_KVH);
        P.Q = (const bf16*)(ws + WS_Q); P.KCB = (const bf16*)(ws + WS_KCB) + (size_t)g * 1024 * 64; P.VTC = (const bf16x8*)(ws + WS_VTC) + (size_t)g * 32 * 4 * 64;
        P.KW = KVH + (size_t)(8 + g) * S * 64; P.VTW = (const bf16x8*)(ws + WS_VTW) + (size_t)g * 512 * 4 * 64; P.GN = (const bf16*)(ws + WS_GN);
        P.KS = nullptr; P.VTS = nullptr; P.O = nullptr; P.KTS = nullptr; }
    attn_stageA(P, lane, wave, tile0, g, lds);
    __syncthreads();
    unsigned char* ws2 = ws;
    {   const bf16* KVH = (const bf16*)(ws2 + WS_KVH);
        P.Q = (const bf16*)(ws2 + WS_Q); P.KS = KVH + (size_t)(4 + g) * S * 64; P.VTS = (const bf16x8*)(ws2 + WS_VTS) + (size_t)g * 256 * 8 * 64; P.KTS = (const bf16x8*)(ws2 + WS_KTS) + (size_t)g * 256 * 8 * 64; P.GN = (const bf16*)(ws2 + WS_GN); P.O = (bf16*)(ws2 + WS_O);
        P.KCB = nullptr; P.VTC = nullptr; P.KW = nullptr; P.VTW = nullptr; }
    unsigned char* slab = ((blockIdx.x < 128) ? (unsigned char*)F.out : ws2 + WS_PSLAB) + soff;
    if (T > 15) {
        LAS unsigned* cnt = (LAS unsigned*)(lds + AT_CNT); LAS unsigned short* list = (LAS unsigned short*)(lds + AT_LIST); const LAS int* sel = (const LAS int*)(lds + AT_SEL);
        const int tok = F.tid >> 3;
        v4u qv[4];
#pragma unroll
        for (int e = 0; e < 4; ++e) { const int idx = F.tid + 512 * e, row = idx >> 3, piece = idx & 7; qv[e] = *(const v4u*)((const unsigned char*)P.Q + (size_t)(tile0 + (row >> 2)) * 1024 + g * 512 + (row & 3) * 128 + piece * 16); }
#pragma unroll
        for (int e = 0; e < 2; ++e) { const int b = (F.tid & 7) * 2 + e;
            if (b >= 3) { const int j = sel[tok * 16 + b]; const unsigned pos = __hip_atomic_fetch_add(&cnt[j], 1u, __ATOMIC_RELAXED, __HIP_MEMORY_SCOPE_WORKGROUP); list[j * 64 + pos] = (unsigned short)(tok * 13 + b - 3); } }
#pragma unroll
        for (int e = 0; e < 4; ++e) { const int idx = F.tid + 512 * e, row = idx >> 3, piece = idx & 7; *(LAS v4u*)(lds + AT_SC + row * 128 + ((piece ^ (row & 7)) << 4)) = qv[e]; }
        {   v4u fk[3], fv[3];
#pragma unroll
            for (int e = 0; e < 3; ++e) { const int j = e == 0 ? 0 : (e == 1 ? T - 1 : T); fk[e] = *(const v4u*)((const unsigned char*)P.KS + (size_t)j * 8192 + F.tid * 16); fv[e] = *(const v4u*)((const unsigned char*)P.VTS + (size_t)j * 8192 + F.tid * 16); }
            const int row = F.tid >> 3, piece = F.tid & 7;
#pragma unroll
            for (int e = 0; e < 3; ++e) { LAS unsigned char* fb = lds + (e == 2 ? AT_TILE : AT_SC + 32768 + 16384 * e); *(LAS v4u*)(fb + row * 128 + ((piece ^ (row & 7)) << 4)) = fk[e]; *(LAS v4u*)(fb + 8192 + F.tid * 16) = fv[e]; } }
        __syncthreads(); }
    SState st[2];
    if (T > 15) { attn_stageC_forced_lds(P, lane, wave, tile0, g, lds, st);
        if (lane < 16) {
#pragma unroll
            for (int k = 0; k < 2; ++k) ((LAS float*)(lds + AT_SC + 65536))[(8 * wave + 4 * k + (lane >> 2)) * 4 + (lane & 3)] = st[k].M; }
        __syncthreads(); }
    else attn_stageC_forced(P, lane, wave, tile0, g, lds, st);
    attn_stageB(P, lane, wave, tile0, g, lds, slab);
    asm volatile("s_waitcnt vmcnt(0)" ::: "memory");
    __syncthreads();
    __builtin_amdgcn_fence(__ATOMIC_ACQUIRE, "workgroup");
    attn_stageC_merge(P, lane, wave, tile0, g, lds, slab, st);
    __syncthreads();
}

#define XB_TMO      128
#define XB_XCNT(j)  (256  + 64 * (j))
#define XB_XSUB(j)  (1280 + 64 * (j))
#define XB_XGEN(j)  (2304 + 64 * (j))
#define XB_TOP      3328
#define XB_TOPGEN   3392
#define XCD_BAR_WORDS 3456
#define XB_SPIN_CAP (1u << 22)
__device__ __forceinline__ unsigned xb_ld(unsigned* p)              { return __hip_atomic_load(p, __ATOMIC_RELAXED, __HIP_MEMORY_SCOPE_AGENT); }
__device__ __forceinline__ unsigned xb_add(unsigned* p, unsigned v) { return __hip_atomic_fetch_add(p, v, __ATOMIC_RELAXED, __HIP_MEMORY_SCOPE_AGENT); }
__device__ __forceinline__ unsigned xb_xcc_id() { return (unsigned)__builtin_amdgcn_s_getreg((3 << 11) | 20) & 0xFu; }
#define XB_SPIN(cond, bar) do { unsigned _sp = 0; while (cond) { __builtin_amdgcn_s_sleep(1); \
    if ((++_sp & 255u) == 0u) { if (xb_ld(&(bar)[XB_TMO])) break; if (_sp > XB_SPIN_CAP) { atomicAdd(&(bar)[XB_TMO], 1u); break; } } } } while (0)
struct XcdBarrier { unsigned* bar; unsigned x; volatile LAS unsigned* st; };
__device__ __forceinline__ XcdBarrier xcd_barrier_post(unsigned* bar, volatile LAS unsigned* st) {
    XcdBarrier b; b.bar = bar; b.x = xb_xcc_id(); b.st = st;
    if (threadIdx.x == 0) (void)xb_add(&bar[XB_XCNT(b.x)], 1u);
    return b;
}
__device__ __forceinline__ void xcd_barrier_complete(unsigned* bar, unsigned x, unsigned& nloc, unsigned& nx) {
    const unsigned G = gridDim.x * gridDim.y * gridDim.z;
    unsigned sum, cnt, mine, sp = 0u;
    for (;;) {
        sum = 0u; cnt = 0u; mine = 0u;
#pragma unroll
        for (unsigned j = 0; j < 16; ++j) { const unsigned c = xb_ld(&bar[XB_XCNT(j)]); sum += c; cnt += (c > 0u) ? 1u : 0u; mine = (j == x) ? c : mine; }
        if (sum == G) break;
        __builtin_amdgcn_s_sleep(1);
        if ((++sp & 255u) == 0u) { if (xb_ld(&bar[XB_TMO])) break; if (sp > XB_SPIN_CAP) { atomicAdd(&bar[XB_TMO], 1u); break; } }
    }
    nloc = mine > 0u ? mine : 1u; nx = cnt > 0u ? cnt : 1u;
}
__device__ __forceinline__ void xcd_barrier(const XcdBarrier& b) {
    asm volatile("s_waitcnt vmcnt(0)" ::: "memory");
    __syncthreads();
    if (threadIdx.x == 0) {
        unsigned* bar = b.bar;
        __builtin_amdgcn_s_waitcnt(0);
        unsigned nloc = b.st[0], nx = b.st[1];
        if (nloc == 0u) { xcd_barrier_complete(bar, b.x, nloc, nx); b.st[0] = nloc; b.st[1] = nx; }
        const unsigned old = xb_add(&bar[XB_XSUB(b.x)], 1u);
        const unsigned gen = old / nloc;
        if (old + 1u == (gen + 1u) * nloc) {
            __builtin_amdgcn_fence(__ATOMIC_RELEASE, "agent");
            asm volatile("s_waitcnt vmcnt(0)" ::: "memory");
            const unsigned og = xb_add(&bar[XB_TOP], 1u);
            const unsigned tg = og / nx;
            if (og + 1u == (tg + 1u) * nx) xb_add(&bar[XB_TOPGEN], 1u);
            else XB_SPIN(xb_ld(&bar[XB_TOPGEN]) == tg, bar);
            __builtin_amdgcn_fence(__ATOMIC_ACQUIRE, "agent");
            xb_add(&bar[XB_XGEN(b.x)], 1u);
            asm volatile("s_waitcnt vmcnt(0)" ::: "memory");
        } else {
            __builtin_amdgcn_fence(__ATOMIC_ACQUIRE, "agent");
            XB_SPIN(xb_ld(&bar[XB_XGEN(b.x)]) == gen, bar);
            asm volatile("s_waitcnt vmcnt(0)" ::: "memory");
        }
    }
    __syncthreads();
}

struct EpiResFinal {
    static constexpr bool PERM = false;
    const float* base; float* out; const float* gain; float* RS; unsigned* ctl; LAS float* part;
    __device__ __forceinline__ void operator()(f32x4 (&acc)[2][2][4][2], const pg8::Unit& u, int wr, int wc, int fr, int fq) const {
        using namespace pg8;
        const int row0 = u.pm * BM + wr * 64 + fr, col0 = u.pn * BM + wc * 32 + 4 * fq;
#pragma unroll
        for (int ai = 0; ai < 2; ++ai)
#pragma unroll
            for (int m = 0; m < 4; ++m) { const size_t off = (size_t)(row0 + ai * HALF + m * 16) * 1024 + col0; float ss = 0.f;
#pragma unroll
                for (int bj = 0; bj < 2; ++bj)
#pragma unroll
                    for (int n = 0; n < 2; ++n) { const f32x4 b = *(const f32x4*)(base + off + bj * HALF + n * 16); acc[ai][bj][m][n] += b; const f32x4 x2 = acc[ai][bj][m][n];
                        ss += (x2[0] * x2[0] + x2[1] * x2[1]) + (x2[2] * x2[2] + x2[3] * x2[3]); }
                ss += __shfl_xor(ss, 16); ss += __shfl_xor(ss, 32);
                if (fq == 0) part[(ai * HALF + wr * 64 + m * 16 + fr) * 4 + wc] = ss; }
        asm volatile("s_waitcnt lgkmcnt(0)" ::: "memory"); __builtin_amdgcn_s_barrier(); asm volatile("" ::: "memory");
        if (threadIdx.x < 256) { const f32x4 p = *(const LAS f32x4*)(part + threadIdx.x * 4); __hip_atomic_store(&RS[(size_t)(u.pm * BM + threadIdx.x) * 4 + u.pn], (p[0] + p[1]) + (p[2] + p[3]), __ATOMIC_RELAXED, __HIP_MEMORY_SCOPE_AGENT); }
        asm volatile("s_waitcnt vmcnt(0)" ::: "memory"); __builtin_amdgcn_s_barrier();
        if (threadIdx.x == 0) { xb_add(&ctl[3840 + u.pm], 1u); XB_SPIN(xb_ld(&ctl[3840 + u.pm]) < 4u, ctl); }
        asm volatile("s_waitcnt vmcnt(0) lgkmcnt(0)" ::: "memory"); __builtin_amdgcn_s_barrier(); asm volatile("" ::: "memory");
#pragma unroll
        for (int ai = 0; ai < 2; ++ai)
#pragma unroll
            for (int m = 0; m < 4; ++m) { const int row = row0 + ai * HALF + m * 16; const size_t off = (size_t)row * 1024 + col0;
                float rs[4];
#pragma unroll
                for (int k = 0; k < 4; ++k) rs[k] = __hip_atomic_load(&RS[(size_t)row * 4 + k], __ATOMIC_RELAXED, __HIP_MEMORY_SCOPE_AGENT);
                const float rstd = 1.0f / sqrtf(((rs[0] + rs[1]) + (rs[2] + rs[3])) * (1.f / 1024.f) + 1e-6f);
#pragma unroll
                for (int bj = 0; bj < 2; ++bj)
#pragma unroll
                    for (int n = 0; n < 2; ++n) { const f32x4 gq = *(const f32x4*)(gain + col0 + bj * HALF + n * 16); *(f32x4*)(out + off + bj * HALF + n * 16) = acc[ai][bj][m][n] * rstd * gq; } }
    }
};

__global__ void __launch_bounds__(NWAVES * 64, 2) mk_fwd(Args args) {
    extern __shared__ __attribute__((aligned(16))) unsigned char lds_raw[];
    Frame F;
    F.lds = (LAS unsigned char*)lds_raw;
#define REFRESH() do { int t_ = threadIdx.x; asm volatile("" : "+v"(t_)); F.tid = t_; F.lane = t_ & 63; F.wave = __builtin_amdgcn_readfirstlane(t_ >> 6); F.gw = blockIdx.x * NWAVES + F.wave; } while (0)
    F.G = gridDim.x; F.ngw = F.G * NWAVES; REFRESH();
    F.out = args.out; F.ws = args.ws;
    const int lo = args.ph_lo, hi = args.ph_hi;
#define IN(k) (lo <= (k) && (k) < hi)
#ifndef USE_CG_SYNC
#define USE_CG_SYNC 0
#endif
    volatile LAS unsigned* bst = (volatile LAS unsigned*)(F.lds + LDS_BYTES - 64);
    if (F.tid < 16) bst[F.tid] = 0u;
    __syncthreads();
    XcdBarrier gbar; gbar.bar = (unsigned*)(F.ws + WS_CTL); gbar.x = 0; gbar.st = bst;
    if (!USE_CG_SYNC && hi - lo > 1) gbar = xcd_barrier_post((unsigned*)(F.ws + WS_CTL), bst);
#define SEAM(k) do { if (IN(k) && IN((k) + 1)) { if (USE_CG_SYNC) cg::this_grid().sync(); else xcd_barrier(gbar); } } while (0)
    unsigned char* ws = F.ws;
    const bool tr_defer = (F.G == 256) && IN(0) && IN(4) && IN(5);
    if (IN(0)) { REFRESH(); p0_prologue(F, args, tr_defer); }
    SEAM(0);
    if (IN(1)) { REFRESH();
        pg8::Gemm g{(const bf16*)(ws + WS_XN), (const bf16*)(ws + WS_WIN), S, NPJ, 1024, 1024}; pg8::StaticOrder So; So.init(S, NPJ, F.G, (int)blockIdx.x);
        EpiProj E{(bf16*)(ws + WS_U), (bf16*)(ws + WS_Q), (bf16*)(ws + WS_KVH), (bf16*)(ws + WS_G), (bf16*)(ws + WS_GN)};
        pg8::gemm_phase<EpiProj, pg8::StaticOrder>(F.lds, g, So, E);
    }
    SEAM(1);
    const bool vt_in_p2 = (F.G >= 32 * CMP_KS + 64) && IN(2) && IN(3);
    if (IN(2)) { REFRESH();
        for (int u = F.gw; u < 64 * 32; u += F.ngw) s5_unit<false>(F, args, u >> 5, u & 31, F.lds + F.wave * 16384, F.lds + 131072 + F.wave * 2048);
        if (vt_in_p2 && (int)blockIdx.x >= 32 * CMP_KS) {
            __syncthreads();
            const int w0 = F.gw - 32 * CMP_KS * NWAVES, nw = (F.G - 32 * CMP_KS) * NWAVES;
            for (int u = w0; u < 2 * 512; u += nw) vtw_item(F, u >> 9, u & 511, (LAS unsigned short*)(F.lds + 81920 + F.wave * 8192));
            for (int u = w0; u < 2 * 256; u += nw) vts_item(F, u >> 8, u & 255, (LAS unsigned short*)(F.lds + 81920 + F.wave * 8192));
            for (int u = w0; u < 2 * 256; u += nw) kts_item(F, u >> 8, u & 255); }
        if (blockIdx.x == F.G - 1) { const float* pp = (const float*)(ws + WS_TAB + TAB_POSB) + (F.tid >> 8) * 64 * 256 + (F.tid & 255); float a = 0.f;
#pragma unroll 16
            for (int p = 0; p < 64; ++p) a += pp[p * 256];
            ((float*)(ws + WS_TAB + TAB_POSBS))[F.tid] = a; }
        __syncthreads();
        pg8::Gemm g{(const bf16*)(ws + WS_KVH), (const bf16*)(ws + WS_WC1), 4096, 1024, 1024 / CMP_KS, 1024}; pg8::CmpOrder So{F.G, (int)blockIdx.x, CMP_KS};
        EpiCmp E{F.out};
        pg8::gemm_phase<EpiCmp, pg8::CmpOrder>(F.lds, g, So, E);
    }
    SEAM(2);
    if (IN(3)) { REFRESH();
        for (int u = F.gw; u < 64 * 32; u += F.ngw) s5_unit<true>(F, args, u >> 5, u & 31, F.lds + F.wave * 16384, F.lds + 131072 + F.wave * 2048);
        __syncthreads();
        {   LAS f32x4* wd = (LAS f32x4*)(F.lds + 8 * 2048);
            for (int e = F.tid; e < 256 * 64 / 4; e += NWAVES * 64) { wd[e] = ((const f32x4*)args.in[16])[e]; wd[256 * 64 / 4 + e] = ((const f32x4*)args.in[18])[e]; } }
        __syncthreads();
        for (int u = F.gw; u < 4 * 1024; u += F.ngw) { const int kvg = u >> 10, n = u & 1023; cmp_l2_unit(F, args, kvg >> 1, kvg & 1, n, (LAS float*)(F.lds + F.wave * 2048), (const LAS float*)(F.lds + 8 * 2048) + (kvg >> 1) * 256 * 64); }
        __syncthreads();
        if (!vt_in_p2) {
            for (int u = F.gw; u < 2 * 512; u += F.ngw) vtw_item(F, u >> 9, u & 511, (LAS unsigned short*)(F.lds + 81920 + F.wave * 8192));
            for (int u = F.gw; u < 2 * 256; u += F.ngw) vts_item(F, u >> 8, u & 255, (LAS unsigned short*)(F.lds + 81920 + F.wave * 8192));
            for (int u = F.gw; u < 2 * 256; u += F.ngw) kts_item(F, u >> 8, u & 255); }
    }
    SEAM(3);
    if (IN(4)) { REFRESH();
        for (int u = blockIdx.x; u < 256; u += F.G) {
#pragma unroll 1
            for (int g = 0; g < 2; ++g) { const int ta = ((u & 7) << 5) | (u >> 3);
                const int tile = g ? 255 - ta : ta;
                const unsigned soff = (unsigned)__builtin_amdgcn_readfirstlane((int)((blockIdx.x & 127u) * (unsigned)PSLAB));
                attn_tile(F, ws, args.in[19], tile, g, soff); } }
    }
    if (tr_defer && blockIdx.x >= 128) { REFRESH();
        LAS float* scr = (LAS float*)(F.lds + F.wave * 16384); const int w0 = F.gw - 128 * NWAVES, nw = 128 * NWAVES;
        if (TR_NITEMS0 + w0 < TR_NITEMS) {
            TrDesc da = tr_desc(args, ws, TR_NITEMS0 + w0), db = da; float va[32], vb[32]; tr_load(da, va, F.lane);
#pragma unroll 1
            for (int it = TR_NITEMS0 + w0; ; it += 2 * nw) {
                const bool hb = it + nw < TR_NITEMS; if (hb) { db = tr_desc(args, ws, it + nw); tr_load(db, vb, F.lane); }
                tr_finish(da, va, scr, F.lane);
                if (!hb) break;
                const bool ha = it + 2 * nw < TR_NITEMS; if (ha) { da = tr_desc(args, ws, it + 2 * nw); tr_load(da, va, F.lane); }
                tr_finish(db, vb, scr, F.lane);
                if (!ha) break; } } }
    if (IN(5)) { REFRESH();
        pg8::Gemm g{(const bf16*)(ws + WS_Z), (const bf16*)(ws + WS_WGLU), S, 512, 512, 512}; pg8::StaticOrder So; So.init(S, 512, F.G, (int)blockIdx.x);
        EpiGlu E{(const bf16*)(ws + WS_Z), (bf16*)(ws + WS_ZG)};
        pg8::gemm_phase<EpiGlu, pg8::StaticOrder>(F.lds, g, So, E);
    }
    SEAM(5);
    if (IN(6)) { REFRESH();
        pg8::TwoSegOrder So; So.init(S, 1024, F.G, (int)blockIdx.x);
        pg8::Gemm g{(const bf16*)(ws + WS_ZG), (const bf16*)(ws + WS_WA), S, 1024, 512, 512, (const bf16*)(ws + WS_O), (const bf16*)(ws + WS_WB)}; EpiMix2 E{(const bf16*)(ws + WS_G), (bf16*)(ws + WS_MIX)};
        pg8::gemm_phase<EpiMix2, pg8::TwoSegOrder>(F.lds, g, So, E);
    }
    SEAM(6);
    if (IN(7)) { REFRESH();
        pg8::Gemm g{(const bf16*)(ws + WS_MIX), (const bf16*)(ws + WS_WOUT), S, 1024, 1024, 1024}; pg8::StaticOrder So; So.init(S, 1024, F.G, (int)blockIdx.x);
        EpiResNorm E{args.in[0], F.out, (bf16*)(ws + WS_XN), (float*)(ws + WS_SSP), (LAS float*)(F.lds + pg8::STAGE_BYTES)};
        pg8::gemm_phase<EpiResNorm, pg8::StaticOrder>(F.lds, g, So, E);
    }
    SEAM(7);
    if (IN(9)) { REFRESH();
        pg8::Gemm g{(const bf16*)(ws + WS_XN), (const bf16*)(ws + WS_WGU), S, 2 * DFF, 1024, 1024}; pg8::StaticOrder So; So.init(S, 2 * DFF, F.G, (int)blockIdx.x);
        EpiFfn E{(bf16*)(ws + WS_H), (const float*)(ws + WS_SSP)};
        pg8::gemm_phase<EpiFfn, pg8::StaticOrder>(F.lds, g, So, E);
    }
    SEAM(9);
    const bool fuse_final = (F.G == 256) && IN(10) && IN(11);
    if (IN(10)) { REFRESH();
        pg8::Gemm g{(const bf16*)(ws + WS_H), (const bf16*)(ws + WS_WD), S, 1024, DFF, DFF}; pg8::StaticOrder So; So.init(S, 1024, F.G, (int)blockIdx.x);
        if (fuse_final) { EpiResFinal E{F.out, F.out, args.in[26], (float*)(ws + WS_SSP), (unsigned*)(ws + WS_CTL), (LAS float*)(F.lds + pg8::STAGE_BYTES)}; pg8::gemm_phase<EpiResFinal, pg8::StaticOrder>(F.lds, g, So, E); }
        else { EpiRes E{F.out, F.out}; pg8::gemm_phase<EpiRes, pg8::StaticOrder>(F.lds, g, So, E); }
    }
    if (!fuse_final) {
    SEAM(10);
    if (IN(11)) { REFRESH(); for (int m = F.gw; m < S; m += F.ngw) rms_row_f32(F.out + (size_t)m * DM, args.in[26], F.lane); }
    }
#undef IN
#undef SEAM
}

extern "C" void kernel_launch(void* const* d_in, const int* in_sizes, int n_in, void* d_out, int out_size, void* d_ws, size_t ws_size, hipStream_t stream) {
    static int grid = 0;
    if (grid == 0) {
        if (n_in != 27 || out_size != S * DM || ws_size < WS_END) { fprintf(stderr, "kernel_launch: unexpected shapes (n_in %d out %d ws %zu)\n", n_in, out_size, ws_size); grid = -1; return; }
        int dev = 0, cus = 0, per_cu = 0;
        if (hipGetDevice(&dev) != hipSuccess || hipDeviceGetAttribute(&cus, hipDeviceAttributeMultiprocessorCount, dev) != hipSuccess) { grid = -1; return; }
        if (hipFuncSetAttribute((const void*)mk_fwd, hipFuncAttributeMaxDynamicSharedMemorySize, LDS_BYTES) != hipSuccess) { fprintf(stderr, "kernel_launch: hipFuncSetAttribute failed\n"); grid = -1; return; }
        if (hipOccupancyMaxActiveBlocksPerMultiprocessor(&per_cu, (const void*)mk_fwd, NWAVES * 64, LDS_BYTES) != hipSuccess || per_cu < 1) { fprintf(stderr, "kernel_launch: occupancy query says %d\n", per_cu); per_cu = 1; }
        (void)hipGetLastError();
        grid = cus * (per_cu < 1 ? 1 : 1);
    }
    if (grid < 0) return;
    if (hipMemsetAsync((char*)d_ws + WS_CTL, 0, 16384, stream) != hipSuccess) { fprintf(stderr, "kernel_launch: hipMemsetAsync failed\n"); return; }
    Args a{};
    for (int i = 0; i < 27; ++i) a.in[i] = (const float*)d_in[i];
    a.out = (float*)d_out; a.ws = (unsigned char*)d_ws;
    if (MK_N_LAUNCHES == 1) {
        a.ph_lo = 0; a.ph_hi = NPH;
        void* kargs[] = {&a};
        hipError_t e = hipLaunchCooperativeKernel((const void*)mk_fwd, dim3(grid), dim3(NWAVES * 64), kargs, LDS_BYTES, stream);
        if (e != hipSuccess) fprintf(stderr, "kernel_launch: cooperative launch failed: %s (grid %d)\n", hipGetErrorString(e), grid);
    } else {
        for (int ph = 0; ph < NPH; ++ph) { a.ph_lo = ph; a.ph_hi = ph + 1; hipLaunchKernelGGL(mk_fwd, dim3(grid), dim3(NWAVES * 64), LDS_BYTES, stream, a); }
    }
}
```
